# Optimizing an MI355X kernel written in HIP

```python
import math
import jax, jax.numpy as jnp
from jax import lax
import numpy as np

D_MODEL = 1024
BATCH = 4
SEQ = 4096
DEPTH = 1

D_INNER = D_MODEL
M_WIDTH = D_INNER // 2
M_HEADS = 4
M_HEAD_DIM = M_WIDTH // M_HEADS
H_WIDTH = D_INNER - M_WIDTH
H_GROUPS = 8
HYENA_ORDER = 2
N_DIR = 2
CHUNK = 128
FILTER_EMB = 33
FILTER_HIDDEN = 64
N_SIN = 3
DECAY_TARGET = 1e-2
FAST_DECAY_PCT = 0.3
SLOW_DECAY_PCT = 1.5
D_FF = 4 * D_MODEL
N_GATE = 2 * N_DIR * M_HEADS
EPS = 1e-6

OFF_MQ = 0
OFF_MK = OFF_MQ + M_WIDTH
OFF_HV = OFF_MK + M_WIDTH
OFF_HX1 = OFF_HV + H_WIDTH
OFF_HX2 = OFF_HX1 + H_WIDTH
N_CONV = OFF_HX2 + H_WIDTH
OFF_MV = N_CONV
OFF_MO = OFF_MV + M_WIDTH
OFF_GATE = OFF_MO + M_WIDTH
N_IN = OFF_GATE + N_GATE

kernel_name = "hybrid_mlstm_hyena_sandwich_block"


def rms_norm(x, w):
    xf = x.astype(jnp.float32)
    y = xf * lax.rsqrt(jnp.mean(xf * xf, axis=-1, keepdims=True) + EPS)
    return (y * w.astype(jnp.float32)).astype(x.dtype)


def short_conv3(u, w, b):
    up = jnp.pad(u, ((0, 0), (1, 1), (0, 0)))
    return up[:, :-2] * w[0] + up[:, 1:-1] * w[1] + up[:, 2:] * w[2] + b


def mlstm_chunkwise(q, k, v, log_i, log_f):
    B, H, S, D = q.shape
    L = CHUNK
    NC = S // L
    qc = q.reshape(B, H, NC, L, D)
    kc = k.reshape(B, H, NC, L, D)
    vc = v.reshape(B, H, NC, L, D)
    li = log_i.reshape(B, H, NC, L)
    bcum = jnp.cumsum(log_f.reshape(B, H, NC, L), axis=-1)
    g = bcum[..., -1]
    a = g[..., None] - bcum + li

    def step(carry, xs):
        C, n, m = carry
        k_c, v_c, a_c, g_c = xs
        m_new = jnp.maximum(g_c + m, jnp.max(a_c, axis=-1))
        decay = jnp.exp(g_c + m - m_new)
        w = jnp.exp(a_c - m_new[..., None])
        C_new = decay[..., None, None] * C + jnp.einsum('bhl,bhld,bhle->bhde', w, k_c, v_c)
        n_new = decay[..., None] * n + jnp.einsum('bhl,bhld->bhd', w, k_c)
        return (C_new, n_new, m_new), (C, n, m)

    init = (jnp.zeros((B, H, D, D), jnp.float32),
            jnp.zeros((B, H, D), jnp.float32),
            jnp.zeros((B, H), jnp.float32))
    xs = (jnp.moveaxis(kc, 2, 0), jnp.moveaxis(vc, 2, 0),
          jnp.moveaxis(a, 2, 0), jnp.moveaxis(g, 2, 0))
    _, (C_s, n_s, m_s) = lax.scan(step, init, xs)
    C_s = jnp.moveaxis(C_s, 0, 2)
    n_s = jnp.moveaxis(n_s, 0, 2)
    m_s = jnp.moveaxis(m_s, 0, 2)

    causal = jnp.tril(jnp.ones((L, L), dtype=bool))
    dmat = bcum[..., :, None] - bcum[..., None, :] + li[..., None, :]
    dmat = jnp.where(causal, dmat, -jnp.inf)
    inter_log = bcum + m_s[..., None]
    m_t = jnp.maximum(inter_log, jnp.max(dmat, axis=-1))
    wts = jnp.exp(dmat - m_t[..., None])
    s_qk = jnp.einsum('bhctd,bhcsd->bhcts', qc, kc) * wts
    inter_scale = jnp.exp(inter_log - m_t)
    num = (jnp.einsum('bhcts,bhcse->bhcte', s_qk, vc)
           + inter_scale[..., None] * jnp.einsum('bhctd,bhcde->bhcte', qc, C_s))
    den = s_qk.sum(-1) + inter_scale * jnp.einsum('bhctd,bhcd->bhct', qc, n_s)
    h = num / jnp.maximum(jnp.abs(den), jnp.exp(-m_t))[..., None]
    return h.reshape(B, H, S, D)


def hyena_filters(L, w1, b1, w2, b2, w3, b3, w4, freq):
    bands = (FILTER_EMB - 1) // 2
    t = jnp.linspace(0.0, 1.0, L, dtype=jnp.float32)[:, None]
    t_resc = jnp.arange(L, dtype=jnp.float32)[:, None]
    ang = 2.0 * math.pi * t_resc / L
    f = jnp.linspace(1e-4, bands - 1, bands, dtype=jnp.float32)[None, :]
    z = jnp.concatenate([t, jnp.cos(f * ang), -jnp.sin(f * ang)], axis=-1)
    fr = freq.astype(jnp.float32)
    h = jnp.sin(fr[0] * (z @ w1.astype(jnp.float32) + b1.astype(jnp.float32)))
    h = jnp.sin(fr[1] * (h @ w2.astype(jnp.float32) + b2.astype(jnp.float32)))
    h = jnp.sin(fr[2] * (h @ w3.astype(jnp.float32) + b3.astype(jnp.float32)))
    h = (h @ w4.astype(jnp.float32)).reshape(L, N_DIR, HYENA_ORDER, H_WIDTH)
    max_decay = math.log(DECAY_TARGET) / FAST_DECAY_PCT
    min_decay = math.log(DECAY_TARGET) / SLOW_DECAY_PCT
    deltas = jnp.linspace(min_decay, max_decay, H_WIDTH, dtype=jnp.float32)
    window = jnp.exp(-t[:, :, None, None] * jnp.abs(deltas))
    return h * window


def two_sided_fft_conv(u, k_fwd, k_bwd, bias):
    S = u.shape[1]
    kern = jnp.concatenate([k_fwd, jnp.zeros_like(k_fwd[:1]), k_bwd[:0:-1]], axis=0)
    K = jnp.fft.rfft(kern, axis=0)
    U = jnp.fft.rfft(u, n=2 * S, axis=1)
    y = jnp.fft.irfft(U * K[None], n=2 * S, axis=1)[:, :S]
    return y + u * bias


def group_rms(u, n_groups, w):
    B, S, C = u.shape
    ug = u.reshape(B, S, n_groups, C // n_groups)
    ug = ug * lax.rsqrt(jnp.mean(ug * ug, axis=-1, keepdims=True) + EPS)
    return ug.reshape(B, S, C) * w.astype(jnp.float32)


def setup_inputs(seed: int = 0) -> dict:
    key = jax.random.key(seed)
    ks = jax.random.split(key, 32)
    f32 = jnp.float32
    nrm = lambda k, shape, scale: jax.random.normal(k, shape, f32) * scale
    gain = lambda k, n: 1.0 + 0.05 * jax.random.normal(k, (n,), f32)
    i_bias = nrm(ks[6], (M_HEADS,), 0.1)
    f_bias = jnp.linspace(3.0, 6.0, M_HEADS, dtype=f32) + nrm(ks[7], (M_HEADS,), 0.1)
    i_bias_b = nrm(ks[8], (M_HEADS,), 0.1)
    f_bias_b = jnp.linspace(3.0, 6.0, M_HEADS, dtype=f32) + nrm(ks[9], (M_HEADS,), 0.1)
    return {
        "x": jax.random.normal(ks[0], (BATCH, SEQ, D_MODEL), f32),
        "norm_mix_pre": gain(ks[1], D_MODEL),
        "norm_mix_post": gain(ks[2], D_MODEL),
        "norm_mlp_pre": gain(ks[3], D_MODEL),
        "norm_mlp_post": gain(ks[4], D_MODEL),
        "w_in": nrm(ks[5], (D_MODEL, N_IN), D_MODEL ** -0.5),
        "b_gates": jnp.concatenate([i_bias, f_bias, i_bias_b, f_bias_b]),
        "conv_w": nrm(ks[10], (3, N_CONV), 3 ** -0.5),
        "conv_b": nrm(ks[11], (N_CONV,), 0.02),
        "mlstm_norm_w": gain(ks[12], M_WIDTH),
        "hyena_norm_w": gain(ks[13], H_WIDTH),
        "filt_w1": nrm(ks[14], (FILTER_EMB, FILTER_HIDDEN), FILTER_EMB ** -0.5),
        "filt_b1": nrm(ks[15], (FILTER_HIDDEN,), 0.02),
        "filt_w2": nrm(ks[16], (FILTER_HIDDEN, FILTER_HIDDEN), FILTER_HIDDEN ** -0.5),
        "filt_b2": nrm(ks[17], (FILTER_HIDDEN,), 0.02),
        "filt_w3": nrm(ks[18], (FILTER_HIDDEN, FILTER_HIDDEN), FILTER_HIDDEN ** -0.5),
        "filt_b3": nrm(ks[19], (FILTER_HIDDEN,), 0.02),
        "filt_w4": nrm(ks[20], (FILTER_HIDDEN, N_DIR * HYENA_ORDER * H_WIDTH), FILTER_HIDDEN ** -0.5),
        "filt_freq": 1.0 + 0.05 * jax.random.normal(ks[21], (N_SIN, FILTER_HIDDEN), f32),
        "filt_bias": nrm(ks[22], (HYENA_ORDER, H_WIDTH), 0.1),
        "w_out": nrm(ks[23], (D_INNER, D_MODEL), D_INNER ** -0.5),
        "w_mlp_in": nrm(ks[24], (D_MODEL, D_FF), D_MODEL ** -0.5),
        "w_mlp_out": nrm(ks[25], (D_FF, D_MODEL), D_FF ** -0.5),
    }


def reference(x, norm_mix_pre, norm_mix_post, norm_mlp_pre, norm_mlp_post, w_in, b_gates,
              conv_w, conv_b, mlstm_norm_w, hyena_norm_w, filt_w1, filt_b1, filt_w2, filt_b2,
              filt_w3, filt_b3, filt_w4, filt_freq, filt_bias, w_out, w_mlp_in, w_mlp_out):
    B, S, _ = x.shape
    f32 = jnp.float32
    for _layer in range(DEPTH):
        hn = rms_norm(x, norm_mix_pre)
        proj = (hn @ w_in).astype(f32)
        cv = short_conv3(proj[..., :N_CONV], conv_w.astype(f32), conv_b.astype(f32))

        def heads(u):
            return u.reshape(B, S, M_HEADS, M_HEAD_DIM).transpose(0, 2, 1, 3)
        q = heads(jax.nn.silu(cv[..., OFF_MQ:OFF_MQ + M_WIDTH]))
        k = heads(jax.nn.silu(cv[..., OFF_MK:OFF_MK + M_WIDTH])) * (M_HEAD_DIM ** -0.5)
        v = heads(proj[..., OFF_MV:OFF_MV + M_WIDTH])
        o_gate = jax.nn.sigmoid(proj[..., OFF_MO:OFF_MO + M_WIDTH])
        gates = (proj[..., OFF_GATE:OFF_GATE + N_GATE] + b_gates.astype(f32)).transpose(0, 2, 1)
        gates = gates.reshape(B, 2 * N_DIR, M_HEADS, S)
        h_fwd = mlstm_chunkwise(q, k, v, gates[:, 0], jax.nn.log_sigmoid(gates[:, 1]))
        flip = lambda u: jnp.flip(u, axis=2)
        h_bwd = flip(mlstm_chunkwise(flip(q), flip(k), flip(v), flip(gates[:, 2]),
                                     flip(jax.nn.log_sigmoid(gates[:, 3]))))
        h_m = (h_fwd + h_bwd).transpose(0, 2, 1, 3).reshape(B, S, M_WIDTH) * o_gate
        y_m = group_rms(h_m, M_HEADS, mlstm_norm_w)

        filt = hyena_filters(S, filt_w1, filt_b1, filt_w2, filt_b2, filt_w3, filt_b3,
                             filt_w4, filt_freq)
        fb = filt_bias.astype(f32)
        z = cv[..., OFF_HV:OFF_HV + H_WIDTH]
        z = cv[..., OFF_HX1:OFF_HX1 + H_WIDTH] * two_sided_fft_conv(z, filt[:, 0, 0], filt[:, 1, 0], fb[0])
        z = cv[..., OFF_HX2:OFF_HX2 + H_WIDTH] * two_sided_fft_conv(z, filt[:, 0, 1], filt[:, 1, 1], fb[1])
        y_h = group_rms(z, H_GROUPS, hyena_norm_w)

        mix = jnp.concatenate([y_m, y_h], axis=-1).astype(x.dtype) @ w_out
        x = x + rms_norm(mix, norm_mix_post)

        hm = rms_norm(x, norm_mlp_pre)
        ff = jnp.square(jax.nn.relu(hm @ w_mlp_in)) @ w_mlp_out
        x = x + rms_norm(ff, norm_mlp_post)
    return x
```

```cpp
#include <hip/hip_runtime.h>
#include <hip/hip_cooperative_groups.h>
#include <cstdio>
namespace cg = cooperative_groups;

#ifndef MULTI_LAUNCH
#define MULTI_LAUNCH 0
#endif

typedef unsigned short u16;
using bf16x8 = __attribute__((ext_vector_type(8))) short;
using f32x16 = __attribute__((ext_vector_type(16))) float;
#define DI __device__ __forceinline__
#define MFMA(a, b, c) __builtin_amdgcn_mfma_f32_32x32x16_bf16((a), (b), (c), 0, 0, 0)

constexpr int SEQ = 4096, DM = 1024, NTOK = 16384, NIN = 3600, NINP = 3712, DFF = 4096;
constexpr float EPS = 1e-6f;
constexpr size_t MiB = 1u << 20;
constexpr size_t OFF_WINT = 0, OFF_WOUTT = 8 * MiB, OFF_W1T = 10 * MiB, OFF_W2T = 18 * MiB;
constexpr size_t OFF_XN = 26 * MiB, OFF_QA = 26 * MiB, OFF_KA = 42 * MiB;
constexpr size_t OFF_FILT = 58 * MiB, OFF_QKPRE = 90 * MiB, OFF_A2 = 90 * MiB;
constexpr size_t OFF_HYT = 122 * MiB, OFF_VT = 170 * MiB, OFF_OG = 186 * MiB, OFF_GATES = 202 * MiB;
constexpr size_t OFF_NL = 203 * MiB, OFF_MLOC = 203 * MiB + 512 * 1024, OFF_GSUM = OFF_MLOC + 4096, OFF_MS = OFF_GSUM + 4096;
constexpr size_t OFF_KAT = 205 * MiB, OFF_Z2T = 221 * MiB;
constexpr size_t OFF_TW = 204 * MiB;
constexpr size_t OFF_X1 = 26 * MiB, OFF_HM = 90 * MiB, OFF_H = 122 * MiB;

struct Params {
  const float *x, *norm_mix_pre, *norm_mix_post, *norm_mlp_pre, *norm_mlp_post, *w_in, *b_gates, *conv_w, *conv_b,
      *mlstm_norm_w, *hyena_norm_w, *filt_w1, *filt_b1, *filt_w2, *filt_b2, *filt_w3, *filt_b3, *filt_w4, *filt_freq,
      *filt_bias, *w_out, *w_mlp_in, *w_mlp_out;
  float* out;
  char* ws;
};

DI u16 f2bf(float x) { unsigned u = __float_as_uint(x); u += 0x7fffu + ((u >> 16) & 1u); return (u16)(u >> 16); }
DI float bf2f(u16 v) { return __uint_as_float(((unsigned)v) << 16); }
DI int crow(int r, int hh) { return (r & 3) + 8 * (r >> 2) + 4 * hh; }
DI float log_sigmoid(float x) { return fminf(x, 0.f) - log1pf(expf(-fabsf(x))); }
DI float sigmoidf(float x) { return 1.f / (1.f + expf(-x)); }
DI float red2pi(float x) {
  const float k = rintf(x * 0.15915494309189535f);
  float r = fmaf(-k, 6.28125f, x);
  return fmaf(-k, 1.9353071795864769e-3f, r);
}
DI float fsin(float x) { return sinf(x); }
DI float fcos(float x) { return cosf(x); }
DI bf16x8 pack8(const float* v) {
  bf16x8 r;
#pragma unroll
  for (int i = 0; i < 8; ++i) r[i] = (short)f2bf(v[i]);
  return r;
}
DI bf16x8 scale8(bf16x8 a, float s) {
  bf16x8 r;
#pragma unroll
  for (int i = 0; i < 8; ++i) r[i] = (short)f2bf(bf2f((u16)a[i]) * s);
  return r;
}

template <bool SWAP>
DI void gemm_core(const u16* __restrict__ A, const u16* __restrict__ Bt, int K, int m0, int n0, char* smem, f32x16 (&acc)[2][2]) {
  const int tid = threadIdx.x, lane = tid & 63, wave = tid >> 6, wr = wave >> 1, wc = wave & 1;
  const int lr = lane & 31, hh = lane >> 5;
#pragma unroll
  for (int i = 0; i < 2; ++i)
#pragma unroll
    for (int j = 0; j < 2; ++j)
#pragma unroll
      for (int r = 0; r < 16; ++r) acc[i][j][r] = 0.f;
  const int c = tid & 7, r0 = tid >> 3;
  const u16* Ag = A + (size_t)(m0 + r0) * K + c * 8;
  const u16* Bg = Bt + (size_t)(n0 + r0) * K + c * 8;
  const int soff = r0 * 128 + ((c ^ ((r0 >> 1) & 7)) << 4);
  uint4 ra[4], rb[4];
#pragma unroll
  for (int i = 0; i < 4; ++i) {
    ra[i] = *(const uint4*)(Ag + (size_t)(32 * i) * K);
    rb[i] = *(const uint4*)(Bg + (size_t)(32 * i) * K);
  }
#pragma unroll
  for (int i = 0; i < 4; ++i) {
    *(uint4*)(smem + soff + i * 4096) = ra[i];
    *(uint4*)(smem + 16384 + soff + i * 4096) = rb[i];
  }
  __syncthreads();
  const int nk = K >> 6;
  for (int kt = 0; kt < nk; ++kt) {
    if (kt + 1 < nk) {
      const int k0 = (kt + 1) << 6;
#pragma unroll
      for (int i = 0; i < 4; ++i) {
        ra[i] = *(const uint4*)(Ag + (size_t)(32 * i) * K + k0);
        rb[i] = *(const uint4*)(Bg + (size_t)(32 * i) * K + k0);
      }
    }
    const char* As = smem + (kt & 1) * 32768;
    const char* Bs = As + 16384;
#pragma unroll
    for (int kk = 0; kk < 4; ++kk) {
      bf16x8 a[2], b[2];
      const int cc = kk * 2 + hh;
#pragma unroll
      for (int i = 0; i < 2; ++i) {
        const int r = wr * 64 + i * 32 + lr;
        a[i] = *(const bf16x8*)(As + r * 128 + ((cc ^ ((r >> 1) & 7)) << 4));
      }
#pragma unroll
      for (int j = 0; j < 2; ++j) {
        const int r = wc * 64 + j * 32 + lr;
        b[j] = *(const bf16x8*)(Bs + r * 128 + ((cc ^ ((r >> 1) & 7)) << 4));
      }
#pragma unroll
      for (int i = 0; i < 2; ++i)
#pragma unroll
        for (int j = 0; j < 2; ++j) acc[i][j] = SWAP ? MFMA(b[j], a[i], acc[i][j]) : MFMA(a[i], b[j], acc[i][j]);
    }
    if (kt + 1 < nk) {
      char* dst = smem + ((kt + 1) & 1) * 32768;
#pragma unroll
      for (int i = 0; i < 4; ++i) {
        *(uint4*)(dst + soff + i * 4096) = ra[i];
        *(uint4*)(dst + 16384 + soff + i * 4096) = rb[i];
      }
    }
    __syncthreads();
  }
}

DI void tile_map(int id, int ntn, int& mt, int& nt) {
  const int per = 16 * ntn;
  const int g = id / per, rem = id - g * per;
  mt = g * 16 + (rem & 15);
  nt = rem >> 4;
}

DI void transpose_tile(const float* __restrict__ src, int R, int C, u16* __restrict__ dst, int kt, int nt, char* smem) {
  float* tile = (float*)smem;
  const int tid = threadIdx.x;
  const int k0 = kt * 64, n0 = nt * 64;
#pragma unroll 4
  for (int it = 0; it < 16; ++it) {
    const int kk = it * 4 + (tid >> 6), nn = tid & 63;
    const int n = n0 + nn;
    tile[kk * 65 + nn] = (n < C) ? src[(size_t)(k0 + kk) * C + n] : 0.f;
  }
  __syncthreads();
#pragma unroll 4
  for (int it = 0; it < 16; ++it) {
    const int nn = it * 4 + (tid >> 6), kk = tid & 63;
    dst[(size_t)(n0 + nn) * R + k0 + kk] = f2bf(tile[kk * 65 + nn]);
  }
  __syncthreads();
}

DI float wave_sum(float v) {
#pragma unroll
  for (int o = 32; o; o >>= 1) v += __shfl_xor(v, o, 64);
  return v;
}

DI void filter_unit(const Params& p, int unit, char* smem) {
  float* sz = (float*)smem;
  float* hA = sz + 16 * 33;
  float* hB = hA + 16 * 64;
  const int tid = threadIdx.x;
  const int l0 = unit * 16;
  for (int idx = tid; idx < 16 * 33; idx += 256) {
    const int pp = idx / 33, f = idx - pp * 33;
    const float l = (float)(l0 + pp);
    float v;
    if (f == 0) v = l / 4095.f;
    else {
      const int jb = (f - 1) & 15;
      const float fj = 1e-4f + (float)jb * ((15.f - 1e-4f) / 15.f);
      const float ang = 6.283185307179586f * l / 4096.f;
      v = (f <= 16) ? fcos(fj * ang) : -fsin(fj * ang);
    }
    sz[idx] = v;
  }
  __syncthreads();
  {
    const int o = tid & 63;
#pragma unroll 1
    for (int i = 0; i < 4; ++i) {
      const int pp = (tid >> 6) + 4 * i;
      float s = p.filt_b1[o];
#pragma unroll 3
      for (int f = 0; f < 33; ++f) s += sz[pp * 33 + f] * p.filt_w1[f * 64 + o];
      hA[pp * 64 + o] = fsin(p.filt_freq[o] * s);
    }
  }
  __syncthreads();
  {
    const int o = tid & 63;
#pragma unroll 1
    for (int i = 0; i < 4; ++i) {
      const int pp = (tid >> 6) + 4 * i;
      float s = p.filt_b2[o];
#pragma unroll 4
      for (int k = 0; k < 64; ++k) s += hA[pp * 64 + k] * p.filt_w2[k * 64 + o];
      hB[pp * 64 + o] = fsin(p.filt_freq[64 + o] * s);
    }
  }
  __syncthreads();
  {
    const int o = tid & 63;
#pragma unroll 1
    for (int i = 0; i < 4; ++i) {
      const int pp = (tid >> 6) + 4 * i;
      float s = p.filt_b3[o];
#pragma unroll 4
      for (int k = 0; k < 64; ++k) s += hB[pp * 64 + k] * p.filt_w3[k * 64 + o];
      hA[pp * 64 + o] = fsin(p.filt_freq[128 + o] * s);
    }
  }
  __syncthreads();
  float* filt = (float*)(p.ws + OFF_FILT);
  const float min_decay = -3.0701134573253944f, max_decay = -15.350567286626973f;
#pragma unroll 1
  for (int cc = 0; cc < 8; ++cc) {
    const int col = tid + 256 * cc;
    float acc[16];
#pragma unroll
    for (int q = 0; q < 16; ++q) acc[q] = 0.f;
#pragma unroll 2
    for (int k = 0; k < 64; ++k) {
      const float w = p.filt_w4[k * 2048 + col];
#pragma unroll
      for (int q = 0; q < 16; ++q) acc[q] += hA[q * 64 + k] * w;
    }
    const int ch = col & 511;
    const float delta = fabsf(min_decay + (float)ch * ((max_decay - min_decay) / 511.f));
#pragma unroll
    for (int q = 0; q < 16; ++q) {
      const float t = (float)(l0 + q) / 4095.f;
      acc[q] *= expf(-t * delta);
    }
    float4* dst = (float4*)(filt + (size_t)col * 4096 + l0);
    dst[0] = make_float4(acc[0], acc[1], acc[2], acc[3]);
    dst[1] = make_float4(acc[4], acc[5], acc[6], acc[7]);
    dst[2] = make_float4(acc[8], acc[9], acc[10], acc[11]);
    dst[3] = make_float4(acc[12], acc[13], acc[14], acc[15]);
  }
  __syncthreads();
}

DI void phase0(const Params& p, char* smem) {
  const int tid = threadIdx.x, lane = tid & 63, wave = tid >> 6;
  const int U_W = 16, U_F = 256, U_X = 1024, U_T1 = 58 * 16, U_T2 = 256, U_T3 = 1024, U_T4 = 1024;
  const int total = U_W + U_F + U_X + U_T1 + U_T2 + U_T3 + U_T4;
  for (int u = blockIdx.x; u < total; u += gridDim.x) {
    int v = u;
    if (v < U_W) {
      const int m = v * 256 + tid;
      float2* twp = (float2*)(p.ws + OFF_TW);
      const float ang = -3.14159265358979f * (float)m * (1.f / 4096.f);
      twp[m] = make_float2(cosf(ang), sinf(ang));
      continue;
    }
    v -= U_W;
    if (v < U_F) { filter_unit(p, v, smem); continue; }
    v -= U_F;
    if (v < U_X) {
      u16* xn = (u16*)(p.ws + OFF_XN);
#pragma unroll 1
      for (int rr = 0; rr < 4; ++rr) {
        const int row = v * 16 + wave * 4 + rr;
        const float4* xr = (const float4*)(p.x + (size_t)row * DM);
        float4 xv[4];
        float ss = 0.f;
#pragma unroll
        for (int i = 0; i < 4; ++i) {
          xv[i] = xr[lane + 64 * i];
          ss += xv[i].x * xv[i].x + xv[i].y * xv[i].y + xv[i].z * xv[i].z + xv[i].w * xv[i].w;
        }
        ss = wave_sum(ss);
        const float rs = rsqrtf(ss * (1.f / DM) + EPS);
#pragma unroll
        for (int i = 0; i < 4; ++i) {
          const float4 w = ((const float4*)p.norm_mix_pre)[lane + 64 * i];
          ushort4 o;
          o.x = f2bf(xv[i].x * rs * w.x); o.y = f2bf(xv[i].y * rs * w.y); o.z = f2bf(xv[i].z * rs * w.z); o.w = f2bf(xv[i].w * rs * w.w);
          *(ushort4*)(xn + (size_t)row * DM + (lane + 64 * i) * 4) = o;
        }
      }
      continue;
    }
    v -= U_X;
    if (v < U_T1) { transpose_tile(p.w_in, DM, NIN, (u16*)(p.ws + OFF_WINT), v & 15, v >> 4, smem); continue; }
    v -= U_T1;
    if (v < U_T2) { transpose_tile(p.w_out, DM, DM, (u16*)(p.ws + OFF_WOUTT), v & 15, v >> 4, smem); continue; }
    v -= U_T2;
    if (v < U_T3) { transpose_tile(p.w_mlp_in, DM, DFF, (u16*)(p.ws + OFF_W1T), v & 15, v >> 4, smem); continue; }
    v -= U_T3;
    transpose_tile(p.w_mlp_out, DFF, DM, (u16*)(p.ws + OFF_W2T), v & 63, v >> 6, smem);
  }
}

DI void phase1(const Params& p, char* smem) {
  const int tid = threadIdx.x, lane = tid & 63, wave = tid >> 6, wr = wave >> 1, wc = wave & 1, lr = lane & 31, hh = lane >> 5;
  const u16* xn = (const u16*)(p.ws + OFF_XN);
  const u16* wt = (const u16*)(p.ws + OFF_WINT);
  u16* qkpre = (u16*)(p.ws + OFF_QKPRE);
  u16* hyT = (u16*)(p.ws + OFF_HYT);
  u16* vT = (u16*)(p.ws + OFF_VT);
  u16* og = (u16*)(p.ws + OFF_OG);
  float* gates = (float*)(p.ws + OFF_GATES);
  const int ntn = 29, ntiles = 128 * ntn;
  for (int id = blockIdx.x; id < ntiles; id += gridDim.x) {
    int mt, nt;
    tile_map(id, ntn, mt, nt);
    const int m0 = mt * 128, n0 = nt * 128;
    f32x16 acc[2][2];
    const bool swap = (nt >= 8 && nt < 24);
    if (swap) gemm_core<true>(xn, wt, DM, m0, n0, smem, acc);
    else gemm_core<false>(xn, wt, DM, m0, n0, smem, acc);
#pragma unroll
    for (int i = 0; i < 2; ++i)
#pragma unroll
      for (int j = 0; j < 2; ++j)
#pragma unroll
        for (int r = 0; r < 16; ++r) {
          const float val = acc[i][j][r];
          if (!swap) {
            const int row = m0 + wr * 64 + i * 32 + crow(r, hh);
            const int col = n0 + wc * 64 + j * 32 + lr;
            if (nt < 8) qkpre[(size_t)row * 1024 + col] = f2bf(val);
            else if (nt < 28) og[(size_t)row * 512 + (col - 3072)] = f2bf(sigmoidf(val));
            else if (col < 3600) gates[(size_t)row * 16 + (col - 3584)] = val;
          } else {
            const int n = n0 + wc * 64 + j * 32 + crow(r, hh);
            const int m = m0 + wr * 64 + i * 32 + lr;
            const int b = m >> 12, t = m & 4095;
            if (nt < 20) {
              const int cc = n - 1024, g = cc >> 9, ch = cc & 511;
              hyT[((size_t)((g * 4 + b) * 512 + ch)) * 4096 + t] = f2bf(val);
            } else {
              const int cc = n - 2560;
              vT[((size_t)(b * 512 + cc)) * 4096 + t] = f2bf(val);
            }
          }
        }
  }
}

DI void phase_qk(const Params& p, char* smem) {
  u16* tile = (u16*)smem;
  const int tid = threadIdx.x;
  const u16* qkpre = (const u16*)(p.ws + OFF_QKPRE);
  u16* qa = (u16*)(p.ws + OFF_QA);
  u16* ka = (u16*)(p.ws + OFF_KA);
  u16* kaT = (u16*)(p.ws + OFF_KAT);
  for (int u = blockIdx.x; u < 4096; u += gridDim.x) {
    const int ct = u & 15, tt = u >> 4;
    const int C = ct * 64 + (tid & 63);
    const float w0 = p.conv_w[C], w1 = p.conv_w[2560 + C], w2 = p.conv_w[5120 + C], cb = p.conv_b[C];
#pragma unroll 4
    for (int i = 0; i < 16; ++i) {
      const int row = (tid >> 6) + 4 * i;
      const int T = tt * 64 + row, t = T & 4095;
      const float pm = t > 0 ? bf2f(qkpre[(size_t)(T - 1) * 1024 + C]) : 0.f;
      const float p0 = bf2f(qkpre[(size_t)T * 1024 + C]);
      const float pp = t < 4095 ? bf2f(qkpre[(size_t)(T + 1) * 1024 + C]) : 0.f;
      const float val = w0 * pm + w1 * p0 + w2 * pp + cb;
      float s = val * sigmoidf(val);
      if (C < 512) qa[(size_t)T * 512 + C] = f2bf(s);
      else {
        s *= 0.08838834764831845f;
        const u16 sb = f2bf(s);
        ka[(size_t)T * 512 + (C - 512)] = sb;
        tile[(tid & 63) * 66 + row] = sb;
      }
    }
    if (ct >= 8) {
      __syncthreads();
      const int b = (tt * 64) >> 12, t0 = (tt * 64) & 4095;
      const int d0 = (ct - 8) * 64;
#pragma unroll 4
      for (int i = 0; i < 16; ++i) {
        const int dl = (tid >> 6) + 4 * i, tl = tid & 63;
        kaT[((size_t)(b * 512 + d0 + dl)) * 4096 + t0 + tl] = tile[dl * 66 + tl];
      }
      __syncthreads();
    }
  }
}

DI void fft_fwd(float2* x, int tid, const float2* __restrict__ tw) {
#ifdef DBG_NOFFT
  __syncthreads(); return;
#endif
#pragma unroll 1
  for (int lh = 12; lh >= 0; --lh) {
    const int h = 1 << lh;
    __syncthreads();
    const int sh = 12 - lh;
#pragma unroll 4
    for (int i = 0; i < 16; ++i) {
      const int k = tid + (i << 8);
      const int j = k & (h - 1);
      const int i0 = ((k - j) << 1) + j;
      const float2 a = x[i0], b = x[i0 + h];
      const float2 w = tw[j << sh];
      const float cs = w.x, sn = w.y;
      const float dx = a.x - b.x, dy = a.y - b.y;
      x[i0] = make_float2(a.x + b.x, a.y + b.y);
      x[i0 + h] = make_float2(dx * cs - dy * sn, dx * sn + dy * cs);
    }
  }
  __syncthreads();
}
DI void fft_inv(float2* x, int tid, const float2* __restrict__ tw) {
#ifdef DBG_NOFFT
  __syncthreads(); return;
#endif
#pragma unroll 1
  for (int lh = 0; lh <= 12; ++lh) {
    const int h = 1 << lh;
    __syncthreads();
    const int sh = 12 - lh;
#pragma unroll 4
    for (int i = 0; i < 16; ++i) {
      const int k = tid + (i << 8);
      const int j = k & (h - 1);
      const int i0 = ((k - j) << 1) + j;
      const float2 a = x[i0], b = x[i0 + h];
      const float2 w = tw[j << sh];
      const float cs = w.x, sn = -w.y;
      const float bx = b.x * cs - b.y * sn, by = b.x * sn + b.y * cs;
      x[i0] = make_float2(a.x + bx, a.y + by);
      x[i0 + h] = make_float2(a.x - bx, a.y - by);
    }
  }
  __syncthreads();
}

DI float hy_conv(const u16* __restrict__ pr, int t, float w0, float w1, float w2, float cb) {
  const float a = t > 0 ? bf2f(pr[t - 1]) : 0.f;
  const float b = bf2f(pr[t]);
  const float c = t < 4095 ? bf2f(pr[t + 1]) : 0.f;
  return w0 * a + w1 * b + w2 * c + cb;
}

DI void hyena_unit(const Params& p, int ch, char* smem) {
  float2* buf = (float2*)smem;
  const int tid = threadIdx.x;
  const u16* hyT = (const u16*)(p.ws + OFF_HYT);
  const float* filt = (const float*)(p.ws + OFF_FILT);
  float* z2T = (float*)(p.ws + OFF_Z2T);
  const float2* tw = (const float2*)(p.ws + OFF_TW);
  float2 Kr[32];
#pragma unroll 1
  for (int ord = 0; ord < 2; ++ord) {
    const float* kf = filt + (size_t)((0 * 2 + ord) * 512 + ch) * 4096;
    const float* kb = filt + (size_t)((1 * 2 + ord) * 512 + ch) * 4096;
    const float fb = p.filt_bias[ord * 512 + ch];
    __syncthreads();
#pragma unroll 4
    for (int n = tid; n < 8192; n += 256) {
      float v;
      if (n < 4096) v = kf[n];
      else if (n == 4096) v = 0.f;
      else v = kb[8192 - n];
      if (n == 0) v += fb;
      buf[n] = make_float2(v, 0.f);
    }
    fft_fwd(buf, tid, tw);
#pragma unroll
    for (int j = 0; j < 32; ++j) {
      const float2 v = buf[tid + 256 * j];
      Kr[j] = make_float2(v.x * (1.f / 8192.f), v.y * (1.f / 8192.f));
    }
    const int gcol = 1024 + (1 + ord) * 512 + ch;
    const float gw0 = p.conv_w[gcol], gw1 = p.conv_w[2560 + gcol], gw2 = p.conv_w[5120 + gcol], gcb = p.conv_b[gcol];
    const int vcol = 1024 + ch;
    const float vw0 = p.conv_w[vcol], vw1 = p.conv_w[2560 + vcol], vw2 = p.conv_w[5120 + vcol], vcb = p.conv_b[vcol];
#pragma unroll 1
    for (int pr = 0; pr < 2; ++pr) {
      const int b0 = 2 * pr, b1 = 2 * pr + 1;
      __syncthreads();
      if (ord == 0) {
        const u16* u0 = hyT + ((size_t)((0 * 4 + b0) * 512 + ch)) * 4096;
        const u16* u1 = hyT + ((size_t)((0 * 4 + b1) * 512 + ch)) * 4096;
#pragma unroll 2
        for (int i = 0; i < 16; ++i) {
          const int t = tid + 256 * i;
          buf[t] = make_float2(hy_conv(u0, t, vw0, vw1, vw2, vcb), hy_conv(u1, t, vw0, vw1, vw2, vcb));
          buf[4096 + t] = make_float2(0.f, 0.f);
        }
      } else {
        const float* u0 = z2T + ((size_t)(b0 * 512 + ch)) * 4096;
        const float* u1 = z2T + ((size_t)(b1 * 512 + ch)) * 4096;
#pragma unroll 4
        for (int i = 0; i < 16; ++i) {
          const int t = tid + 256 * i;
          buf[t] = make_float2(u0[t], u1[t]);
          buf[4096 + t] = make_float2(0.f, 0.f);
        }
      }
      fft_fwd(buf, tid, tw);
#pragma unroll
      for (int j = 0; j < 32; ++j) {
        const float2 v = buf[tid + 256 * j];
        buf[tid + 256 * j] = make_float2(v.x * Kr[j].x - v.y * Kr[j].y, v.x * Kr[j].y + v.y * Kr[j].x);
      }
      fft_inv(buf, tid, tw);
      const u16* g0 = hyT + ((size_t)(((1 + ord) * 4 + b0) * 512 + ch)) * 4096;
      const u16* g1 = hyT + ((size_t)(((1 + ord) * 4 + b1) * 512 + ch)) * 4096;
      float* o0 = z2T + ((size_t)(b0 * 512 + ch)) * 4096;
      float* o1 = z2T + ((size_t)(b1 * 512 + ch)) * 4096;
#pragma unroll 2
      for (int i = 0; i < 16; ++i) {
        const int t = tid + 256 * i;
        const float2 y = buf[t];
        o0[t] = hy_conv(g0, t, gw0, gw1, gw2, gcb) * y.x;
        o1[t] = hy_conv(g1, t, gw0, gw1, gw2, gcb) * y.y;
      }
    }
  }
  __syncthreads();
}

DI void mlstm_local_unit(const Params& p, int u, char* smem) {
  float* s_gi = (float*)smem;
  float* s_lf = s_gi + 128;
  float* s_a = s_lf + 128;
  float* s_w = s_a + 128;
  const int tid = threadIdx.x, lane = tid & 63, wave = tid >> 6, lr = lane & 31, hh = lane >> 5;
  const int j = u & 31, dir = (u >> 5) & 1, bh = u >> 6, h = bh & 3, b = bh >> 2;
  const int T0 = b * 4096 + j * 128;
  const float* gates = (const float*)(p.ws + OFF_GATES);
  const u16* vT = (const u16*)(p.ws + OFF_VT);
  const u16* kaT = (const u16*)(p.ws + OFF_KAT);
  float* CL = p.out;
  float* nl = (float*)(p.ws + OFF_NL);
  float* mloc = (float*)(p.ws + OFF_MLOC);
  float* gsum = (float*)(p.ws + OFF_GSUM);
  __syncthreads();
  if (tid < 128) {
    const int T = T0 + tid;
    s_gi[tid] = gates[(size_t)T * 16 + dir * 8 + h] + p.b_gates[dir * 8 + h];
    s_lf[tid] = log_sigmoid(gates[(size_t)T * 16 + dir * 8 + 4 + h] + p.b_gates[dir * 8 + 4 + h]);
  }
  __syncthreads();
  float gtot = 0.f;
  if (tid < 128) {
    float pre = 0.f;
    for (int m = 0; m < 128; ++m) {
      const float v = s_lf[m];
      if (m < tid) pre += v;
      gtot += v;
    }
    s_a[tid] = (dir == 0) ? (gtot - pre - s_lf[tid] + s_gi[tid]) : (pre + s_gi[tid]);
  }
  __syncthreads();
  if (tid < 128) {
    float mx = -3.0e38f;
    for (int m = 0; m < 128; ++m) mx = fmaxf(mx, s_a[m]);
    s_w[tid] = expf(s_a[tid] - mx);
    if (tid == 0) { mloc[u] = mx; gsum[u] = gtot; }
  }
  __syncthreads();
  f32x16 acc[4];
#pragma unroll
  for (int d = 0; d < 4; ++d)
#pragma unroll
    for (int r = 0; r < 16; ++r) acc[d][r] = 0.f;
  const u16* vrow = vT + ((size_t)(bh * 128 + wave * 32 + lr)) * 4096 + j * 128 + hh * 8;
  const u16* kbase = kaT + ((size_t)(bh * 128 + lr)) * 4096 + j * 128 + hh * 8;
#pragma unroll 2
  for (int ks = 0; ks < 8; ++ks) {
    const bf16x8 av = *(const bf16x8*)(vrow + ks * 16);
    bf16x8 a;
#pragma unroll
    for (int i = 0; i < 8; ++i) a[i] = (short)f2bf(bf2f((u16)av[i]) * s_w[ks * 16 + hh * 8 + i]);
#pragma unroll
    for (int dt = 0; dt < 4; ++dt) {
      const bf16x8 bk = *(const bf16x8*)(kbase + (size_t)(dt * 32) * 4096 + ks * 16);
      acc[dt] = MFMA(a, bk, acc[dt]);
    }
  }
  float* dst = CL + (size_t)u * 16384;
#pragma unroll
  for (int dt = 0; dt < 4; ++dt)
#pragma unroll
    for (int r = 0; r < 16; ++r) dst[(wave * 32 + crow(r, hh)) * 128 + dt * 32 + lr] = acc[dt][r];
  if (tid < 128) {
    const u16* kr = kaT + ((size_t)(bh * 128 + tid)) * 4096 + j * 128;
    float s = 0.f;
    for (int l = 0; l < 128; l += 8) {
      const bf16x8 kv = *(const bf16x8*)(kr + l);
#pragma unroll
      for (int i = 0; i < 8; ++i) s += s_w[l + i] * bf2f((u16)kv[i]);
    }
    nl[(size_t)u * 128 + tid] = s;
  }
}

DI void scan_unit(const Params& p, int unit) {
  const int tid = threadIdx.x;
  const int sc = unit >> 4, part = unit & 15, dir = sc & 1;
  float* CL = p.out;
  float* nl = (float*)(p.ws + OFF_NL);
  const float* mloc = (const float*)(p.ws + OFF_MLOC);
  const float* gsum = (const float*)(p.ws + OFF_GSUM);
  float* ms = (float*)(p.ws + OFF_MS);
  const int idx = part * 1024 + tid * 4;
  float4 C = make_float4(0.f, 0.f, 0.f, 0.f);
  float nst = 0.f, m = 0.f;
  const bool do_n = (part == 0) && (tid < 128);
  float4 pf[4];
#pragma unroll
  for (int q = 0; q < 4; ++q) {
    const int jj = dir ? 31 - q : q;
    pf[q] = *(const float4*)(CL + (size_t)(sc * 32 + jj) * 16384 + idx);
  }
#pragma unroll 1
  for (int c0 = 0; c0 < 32; c0 += 4) {
#pragma unroll
    for (int q = 0; q < 4; ++q) {
      const int c = c0 + q;
      const int jj = dir ? 31 - c : c;
      const int u = sc * 32 + jj;
      const float4 cl = pf[q];
      *(float4*)(CL + (size_t)u * 16384 + idx) = C;
      if (c + 4 < 32) {
        const int j2 = dir ? 31 - (c + 4) : (c + 4);
        pf[q] = *(const float4*)(CL + (size_t)(sc * 32 + j2) * 16384 + idx);
      }
      const float g = gsum[u], ml = mloc[u];
      const float mn = fmaxf(g + m, ml);
      const float dec = expf(g + m - mn), scl = expf(ml - mn);
      C.x = dec * C.x + scl * cl.x; C.y = dec * C.y + scl * cl.y; C.z = dec * C.z + scl * cl.z; C.w = dec * C.w + scl * cl.w;
      if (do_n) {
        const float nv = nl[(size_t)u * 128 + tid];
        nl[(size_t)u * 128 + tid] = nst;
        nst = dec * nst + scl * nv;
      }
      if (part == 0 && tid == 0) ms[u] = m;
      m = mn;
    }
  }
}

DI void mlstm_out_unit(const Params& p, int unit, char* smem) {
  float* s_gi = (float*)smem;
  float* s_lf = s_gi + 128;
  float* s_bc = s_lf + 128;
  float* s_r = s_bc + 128;
  float* s_al = s_r + 128;
  float* s_fl = s_al + 128;
  float* s_is = s_fl + 128;
  const int tid = threadIdx.x, lane = tid & 63, wave = tid >> 6, lr = lane & 31, hh = lane >> 5;
  u16* Pl = (u16*)(smem + 4096) + wave * (32 * 136);
  const int j = unit & 31, bh = unit >> 5, h = bh & 3, b = bh >> 2;
  const int T0 = b * 4096 + j * 128;
  const float* gates = (const float*)(p.ws + OFF_GATES);
  const u16* qa = (const u16*)(p.ws + OFF_QA);
  const u16* ka = (const u16*)(p.ws + OFF_KA);
  const u16* vT = (const u16*)(p.ws + OFF_VT);
  const u16* og = (const u16*)(p.ws + OFF_OG);
  const float* CS = p.out;
  const float* ns = (const float*)(p.ws + OFF_NL);
  const float* ms = (const float*)(p.ws + OFF_MS);
  u16* A2 = (u16*)(p.ws + OFF_A2);

  f32x16 hs[4];
#pragma unroll
  for (int e = 0; e < 4; ++e)
#pragma unroll
    for (int r = 0; r < 16; ++r) hs[e][r] = 0.f;
  bf16x8 ones;
#pragma unroll
  for (int i = 0; i < 8; ++i) ones[i] = (short)0x3F80;

  const u16* qrow = qa + (size_t)(T0 + wave * 32 + lr) * 512 + h * 128 + hh * 8;
#pragma unroll 1
  for (int dir = 0; dir < 2; ++dir) {
    const int u = (bh * 2 + dir) * 32 + j;
    const float msu = ms[u];
    __syncthreads();
    if (tid < 128) {
      const int T = T0 + tid;
      s_gi[tid] = gates[(size_t)T * 16 + dir * 8 + h] + p.b_gates[dir * 8 + h];
      s_lf[tid] = log_sigmoid(gates[(size_t)T * 16 + dir * 8 + 4 + h] + p.b_gates[dir * 8 + 4 + h]);
    }
    __syncthreads();
    if (tid < 128) {
      float a = 0.f;
      for (int m = 0; m < 128; ++m) {
        const bool in = (dir == 0) ? (m <= tid) : (m >= tid);
        a += in ? s_lf[m] : 0.f;
      }
      s_bc[tid] = a;
      s_r[tid] = s_gi[tid] - a;
    }
    __syncthreads();
    if (tid < 128) {
      float cm = -3.0e38f;
      for (int m = 0; m < 128; ++m) {
        const bool in = (dir == 0) ? (m <= tid) : (m >= tid);
        cm = in ? fmaxf(cm, s_r[m]) : cm;
      }
      const float bc = s_bc[tid];
      const float mt = bc + fmaxf(msu, cm);
      s_al[tid] = bc - mt;
      s_fl[tid] = expf(-mt);
      s_is[tid] = expf(bc + msu - mt);
    }
    __syncthreads();
    {
      f32x16 S[4];
#pragma unroll
      for (int st = 0; st < 4; ++st)
#pragma unroll
        for (int r = 0; r < 16; ++r) S[st][r] = 0.f;
      const u16* kbase = ka + (size_t)(T0 + lr) * 512 + h * 128 + hh * 8;
#pragma unroll 1
      for (int ks = 0; ks < 8; ++ks) {
        const bf16x8 a = *(const bf16x8*)(qrow + ks * 16);
#pragma unroll
        for (int st = 0; st < 4; ++st) {
          const bf16x8 bk = *(const bf16x8*)(kbase + (size_t)(st * 32) * 512 + ks * 16);
          S[st] = MFMA(a, bk, S[st]);
        }
      }
#pragma unroll
      for (int st = 0; st < 4; ++st) {
        const int sl = st * 32 + lr;
        const float rs = s_r[sl];
#pragma unroll
        for (int r = 0; r < 16; ++r) {
          const int tl = wave * 32 + crow(r, hh);
          const bool valid = (dir == 0) ? (sl <= tl) : (sl >= tl);
          const float pv = valid ? S[st][r] * __expf(s_al[tl] + rs) : 0.f;
          Pl[crow(r, hh) * 136 + sl] = f2bf(pv);
        }
      }
    }
    __syncthreads();
    f32x16 N[5];
#pragma unroll
    for (int e = 0; e < 5; ++e)
#pragma unroll
      for (int r = 0; r < 16; ++r) N[e][r] = 0.f;
    {
      const u16* vbase = vT + ((size_t)(bh * 128 + lr)) * 4096 + j * 128 + hh * 8;
#pragma unroll 1
      for (int ks = 0; ks < 8; ++ks) {
        const bf16x8 a = *(const bf16x8*)(Pl + lr * 136 + ks * 16 + hh * 8);
#pragma unroll
        for (int et = 0; et < 4; ++et) {
          const bf16x8 bv = *(const bf16x8*)(vbase + (size_t)(et * 32) * 4096 + ks * 16);
          N[et] = MFMA(a, bv, N[et]);
        }
        N[4] = MFMA(a, ones, N[4]);
      }
    }
    {
      const float isc = s_is[wave * 32 + lr];
      const float* cbase = CS + (size_t)u * 16384 + (size_t)lr * 128 + hh * 8;
      const float* nbase = ns + (size_t)u * 128 + hh * 8;
#pragma unroll 1
      for (int ks = 0; ks < 8; ++ks) {
        const bf16x8 aq = *(const bf16x8*)(qrow + ks * 16);
        const bf16x8 a = scale8(aq, isc);
#pragma unroll
        for (int et = 0; et < 4; ++et) {
          const float4 c0 = *(const float4*)(cbase + (size_t)(et * 32) * 128 + ks * 16);
          const float4 c1 = *(const float4*)(cbase + (size_t)(et * 32) * 128 + ks * 16 + 4);
          const float cv[8] = {c0.x, c0.y, c0.z, c0.w, c1.x, c1.y, c1.z, c1.w};
          N[et] = MFMA(a, pack8(cv), N[et]);
        }
        const float4 n0 = *(const float4*)(nbase + ks * 16);
        const float4 n1 = *(const float4*)(nbase + ks * 16 + 4);
        const float nv[8] = {n0.x, n0.y, n0.z, n0.w, n1.x, n1.y, n1.z, n1.w};
        N[4] = MFMA(a, pack8(nv), N[4]);
      }
    }
#pragma unroll
    for (int r = 0; r < 16; ++r) {
      const int tl = wave * 32 + crow(r, hh);
      const float den = fmaxf(fabsf(N[4][r]), s_fl[tl]);
      const float inv = 1.f / den;
#pragma unroll
      for (int et = 0; et < 4; ++et) hs[et][r] += N[et][r] * inv;
    }
  }
#pragma unroll
  for (int r = 0; r < 16; ++r) {
    const int T = T0 + wave * 32 + crow(r, hh);
    float ss = 0.f;
#pragma unroll
    for (int et = 0; et < 4; ++et) {
      const float o = bf2f(og[(size_t)T * 512 + h * 128 + et * 32 + lr]);
      hs[et][r] *= o;
      ss += hs[et][r] * hs[et][r];
    }
#pragma unroll
    for (int o = 1; o < 32; o <<= 1) ss += __shfl_xor(ss, o, 64);
    const float rs = rsqrtf(ss * (1.f / 128.f) + EPS);
#pragma unroll
    for (int et = 0; et < 4; ++et) {
      const int e = h * 128 + et * 32 + lr;
      A2[(size_t)T * 1024 + e] = f2bf(hs[et][r] * rs * p.mlstm_norm_w[e]);
    }
  }
}

DI void hyena_norm_unit(const Params& p, int unit, char* smem) {
  float* tile = (float*)smem;
  const int tid = threadIdx.x;
  const int tt = unit & 63, g = (unit >> 6) & 7, b = unit >> 9;
  const float* z2T = (const float*)(p.ws + OFF_Z2T);
  u16* A2 = (u16*)(p.ws + OFF_A2);
  __syncthreads();
#pragma unroll 4
  for (int i = 0; i < 16; ++i) {
    const int cl = (tid >> 6) + 4 * i, tl = tid & 63;
    tile[cl * 65 + tl] = z2T[((size_t)(b * 512 + g * 64 + cl)) * 4096 + tt * 64 + tl];
  }
  __syncthreads();
  const int tl = tid >> 2, qd = tid & 3;
  float v[16];
  float ss = 0.f;
#pragma unroll
  for (int i = 0; i < 16; ++i) {
    v[i] = tile[(qd * 16 + i) * 65 + tl];
    ss += v[i] * v[i];
  }
  ss += __shfl_xor(ss, 1, 64);
  ss += __shfl_xor(ss, 2, 64);
  const float rs = rsqrtf(ss * (1.f / 64.f) + EPS);
  const size_t T = (size_t)b * 4096 + tt * 64 + tl;
  u16* dst = A2 + T * 1024 + 512 + g * 64 + qd * 16;
  const float* w = p.hyena_norm_w + g * 64 + qd * 16;
  float o[16];
#pragma unroll
  for (int i = 0; i < 16; ++i) o[i] = v[i] * rs * w[i];
  *(bf16x8*)(dst) = pack8(o);
  *(bf16x8*)(dst + 8) = pack8(o + 8);
}

template <int EPI>
DI void gemm_phase(const u16* A, const u16* Bt, int K, int ntn, void* outp, char* smem) {
  const int tid = threadIdx.x, lane = tid & 63, wave = tid >> 6, wr = wave >> 1, wc = wave & 1, lr = lane & 31, hh = lane >> 5;
  const int ntiles = 128 * ntn;
  for (int id = blockIdx.x; id < ntiles; id += gridDim.x) {
    int mt, nt;
    tile_map(id, ntn, mt, nt);
    const int m0 = mt * 128, n0 = nt * 128;
    f32x16 acc[2][2];
    gemm_core<false>(A, Bt, K, m0, n0, smem, acc);
#pragma unroll
    for (int i = 0; i < 2; ++i)
#pragma unroll
      for (int j = 0; j < 2; ++j)
#pragma unroll
        for (int r = 0; r < 16; ++r) {
          const int row = m0 + wr * 64 + i * 32 + crow(r, hh);
          const int col = n0 + wc * 64 + j * 32 + lr;
          const float val = acc[i][j][r];
          if (EPI == 0) ((float*)outp)[(size_t)row * 1024 + col] = val;
          else {
            const float rl = fmaxf(val, 0.f);
            ((u16*)outp)[(size_t)row * 4096 + col] = f2bf(rl * rl);
          }
        }
  }
}

DI void phase_post_mix(const Params& p) {
  const int tid = threadIdx.x, lane = tid & 63, wave = tid >> 6;
  const float* mix = p.out;
  float* x1 = (float*)(p.ws + OFF_X1);
  u16* hm = (u16*)(p.ws + OFF_HM);
  for (int u = blockIdx.x; u < 1024; u += gridDim.x) {
#pragma unroll 1
    for (int rr = 0; rr < 4; ++rr) {
      const size_t row = (size_t)u * 16 + wave * 4 + rr;
      float4 mv[4], xv[4];
      float ss = 0.f;
#pragma unroll
      for (int i = 0; i < 4; ++i) {
        mv[i] = ((const float4*)(mix + row * DM))[lane + 64 * i];
        xv[i] = ((const float4*)(p.x + row * DM))[lane + 64 * i];
        ss += mv[i].x * mv[i].x + mv[i].y * mv[i].y + mv[i].z * mv[i].z + mv[i].w * mv[i].w;
      }
      ss = wave_sum(ss);
      const float rs = rsqrtf(ss * (1.f / DM) + EPS);
      float s2 = 0.f;
#pragma unroll
      for (int i = 0; i < 4; ++i) {
        const float4 w = ((const float4*)p.norm_mix_post)[lane + 64 * i];
        xv[i].x += mv[i].x * rs * w.x; xv[i].y += mv[i].y * rs * w.y; xv[i].z += mv[i].z * rs * w.z; xv[i].w += mv[i].w * rs * w.w;
        s2 += xv[i].x * xv[i].x + xv[i].y * xv[i].y + xv[i].z * xv[i].z + xv[i].w * xv[i].w;
        ((float4*)(x1 + row * DM))[lane + 64 * i] = xv[i];
      }
      s2 = wave_sum(s2);
      const float r2 = rsqrtf(s2 * (1.f / DM) + EPS);
#pragma unroll
      for (int i = 0; i < 4; ++i) {
        const float4 w = ((const float4*)p.norm_mlp_pre)[lane + 64 * i];
        ushort4 o;
        o.x = f2bf(xv[i].x * r2 * w.x); o.y = f2bf(xv[i].y * r2 * w.y); o.z = f2bf(xv[i].z * r2 * w.z); o.w = f2bf(xv[i].w * r2 * w.w);
        *(ushort4*)(hm + row * DM + (lane + 64 * i) * 4) = o;
      }
    }
  }
}

DI void phase_final(const Params& p) {
  const int tid = threadIdx.x, lane = tid & 63, wave = tid >> 6;
  const float* x1 = (const float*)(p.ws + OFF_X1);
  for (int u = blockIdx.x; u < 1024; u += gridDim.x) {
#pragma unroll 1
    for (int rr = 0; rr < 4; ++rr) {
      const size_t row = (size_t)u * 16 + wave * 4 + rr;
      float4 fv[4];
      float ss = 0.f;
#pragma unroll
      for (int i = 0; i < 4; ++i) {
        fv[i] = ((const float4*)(p.out + row * DM))[lane + 64 * i];
        ss += fv[i].x * fv[i].x + fv[i].y * fv[i].y + fv[i].z * fv[i].z + fv[i].w * fv[i].w;
      }
      ss = wave_sum(ss);
      const float rs = rsqrtf(ss * (1.f / DM) + EPS);
#pragma unroll
      for (int i = 0; i < 4; ++i) {
        const float4 w = ((const float4*)p.norm_mlp_post)[lane + 64 * i];
        const float4 xv = ((const float4*)(x1 + row * DM))[lane + 64 * i];
        float4 o;
        o.x = xv.x + fv[i].x * rs * w.x; o.y = xv.y + fv[i].y * rs * w.y; o.z = xv.z + fv[i].z * rs * w.z; o.w = xv.w + fv[i].w * rs * w.w;
        ((float4*)(p.out + row * DM))[lane + 64 * i] = o;
      }
    }
  }
}

DI void run_phase(const Params& p, int ph, char* smem) {
  switch (ph) {
    case 0: phase0(p, smem); break;
    case 1: phase1(p, smem); break;
    case 2: phase_qk(p, smem); break;
    case 3:
      for (int u = blockIdx.x; u < 512 + 1024; u += gridDim.x) {
        if (u < 512) hyena_unit(p, u, smem);
        else mlstm_local_unit(p, u - 512, smem);
      }
      break;
    case 4:
      for (int u = blockIdx.x; u < 512; u += gridDim.x) scan_unit(p, u);
      break;
    case 5:
      for (int u = blockIdx.x; u < 512 + 2048; u += gridDim.x) {
#ifndef DBG_SKIP_MLSTM
        if (u < 512) mlstm_out_unit(p, u, smem);
#else
        if (u < 512) { u16* A2 = (u16*)(p.ws + OFF_A2); const int T0 = (u >> 5 >> 2) * 4096 + (u & 31) * 128, hq = (u >> 5) & 3;
          for (int i = threadIdx.x; i < 128 * 128; i += 256) A2[(size_t)(T0 + (i >> 7)) * 1024 + hq * 128 + (i & 127)] = 0; }
#endif
#ifndef DBG_SKIP_HYENA
        else hyena_norm_unit(p, u - 512, smem);
#else
        else { const int un = u - 512; const int tt = un & 63, g = (un >> 6) & 7, b = un >> 9; u16* A2 = (u16*)(p.ws + OFF_A2);
          for (int i = threadIdx.x; i < 64 * 64; i += 256) A2[((size_t)b * 4096 + tt * 64 + (i >> 6)) * 1024 + 512 + g * 64 + (i & 63)] = 0x3F80; }
#endif
      }
      break;
    case 6: gemm_phase<0>((const u16*)(p.ws + OFF_A2), (const u16*)(p.ws + OFF_WOUTT), 1024, 8, p.out, smem); break;
    case 7: phase_post_mix(p); break;
    case 8: gemm_phase<1>((const u16*)(p.ws + OFF_HM), (const u16*)(p.ws + OFF_W1T), 1024, 32, p.ws + OFF_H, smem); break;
    case 9: gemm_phase<0>((const u16*)(p.ws + OFF_H), (const u16*)(p.ws + OFF_W2T), 4096, 8, p.out, smem); break;
    case 10: phase_final(p); break;
  }
}
constexpr int NPHASE = 11;

#if MULTI_LAUNCH
template <int PH>
__global__ void __launch_bounds__(256, 2) phase_kernel(Params p) {
  __shared__ __attribute__((aligned(16))) char smem[65536];
  run_phase(p, PH, smem);
}
template <int PH>
static void launch_phase(const Params& p, hipStream_t stream) {
  hipLaunchKernelGGL(phase_kernel<PH>, dim3(512), dim3(256), 0, stream, p);
}
#else
__global__ void __launch_bounds__(256, 2) mega_kernel(Params p) {
  __shared__ __attribute__((aligned(16))) char smem[65536];
  cg::grid_group grid = cg::this_grid();
  run_phase(p, 0, smem); grid.sync();
  run_phase(p, 1, smem); grid.sync();
  run_phase(p, 2, smem); grid.sync();
  run_phase(p, 3, smem); grid.sync();
  run_phase(p, 4, smem); grid.sync();
  run_phase(p, 5, smem); grid.sync();
  run_phase(p, 6, smem); grid.sync();
  run_phase(p, 7, smem); grid.sync();
  run_phase(p, 8, smem); grid.sync();
  run_phase(p, 9, smem); grid.sync();
  run_phase(p, 10, smem);
}
#endif

extern "C" void kernel_launch(void* const* d_in, const int* in_sizes, int n_in, void* d_out, int out_size, void* d_ws,
                              size_t ws_size, hipStream_t stream) {
  Params p{};
  const float** pp = (const float**)&p;
  for (int i = 0; i < 23; ++i) pp[i] = (const float*)d_in[i];
  p.out = (float*)d_out;
  p.ws = (char*)d_ws;
#if MULTI_LAUNCH
  launch_phase<0>(p, stream); launch_phase<1>(p, stream); launch_phase<2>(p, stream); launch_phase<3>(p, stream);
  launch_phase<4>(p, stream); launch_phase<5>(p, stream); launch_phase<6>(p, stream); launch_phase<7>(p, stream);
  launch_phase<8>(p, stream); launch_phase<9>(p, stream); launch_phase<10>(p, stream);
#else
  static int grid_blocks = 0;
  if (!grid_blocks) {
    int dev = 0, cus = 0, per_cu = 0;
    hipGetDevice(&dev);
    hipDeviceGetAttribute(&cus, hipDeviceAttributeMultiprocessorCount, dev);
    hipOccupancyMaxActiveBlocksPerMultiprocessor(&per_cu, mega_kernel, 256, 0);
    if (per_cu > 2) per_cu = 2;
    if (per_cu < 1) per_cu = 1;
    grid_blocks = cus * per_cu;
  }
  void* args[] = {&p};
  hipError_t e = hipLaunchCooperativeKernel((void*)mega_kernel, dim3(grid_blocks), dim3(256), args, 0, stream);
  if (e != hipSuccess) fprintf(stderr, "cooperative launch failed: %s (grid %d)\n", hipGetErrorString(e), grid_blocks);
#endif
}
```

```cpp
#include <hip/hip_runtime.h>
#include <hip/hip_cooperative_groups.h>
#include <cstdio>
namespace cg = cooperative_groups;

#ifndef MULTI_LAUNCH
#define MULTI_LAUNCH 0
#endif

typedef unsigned short u16;
using bf16x8 = __attribute__((ext_vector_type(8))) short;
using f32x16 = __attribute__((ext_vector_type(16))) float;
#define DI __device__ __forceinline__
#define MFMA(a, b, c) __builtin_amdgcn_mfma_f32_32x32x16_bf16((a), (b), (c), 0, 0, 0)

constexpr int SEQ = 4096, DM = 1024, NTOK = 16384, NIN = 3600, NINP = 3712, DFF = 4096;
constexpr float EPS = 1e-6f;
constexpr size_t MiB = 1u << 20;
constexpr size_t OFF_WINT = 0, OFF_WOUTT = 8 * MiB, OFF_W1T = 10 * MiB, OFF_W2T = 18 * MiB;
constexpr size_t OFF_XN = 26 * MiB, OFF_QA = 26 * MiB, OFF_KA = 42 * MiB;
constexpr size_t OFF_FILT = 58 * MiB, OFF_QKPRE = 90 * MiB, OFF_A2 = 90 * MiB;
constexpr size_t OFF_HYT = 122 * MiB, OFF_VT = 170 * MiB, OFF_OG = 186 * MiB, OFF_GATES = 202 * MiB;
constexpr size_t OFF_NL = 203 * MiB, OFF_MLOC = 203 * MiB + 512 * 1024, OFF_GSUM = OFF_MLOC + 4096, OFF_MS = OFF_GSUM + 4096;
constexpr size_t OFF_KAT = 205 * MiB, OFF_Z2T = 221 * MiB;
constexpr size_t OFF_TW = 204 * MiB, OFF_BAR = 204 * MiB + 65536;
constexpr size_t OFF_X1 = 26 * MiB, OFF_HM = 90 * MiB, OFF_H = 122 * MiB;

struct Params {
  const float *x, *norm_mix_pre, *norm_mix_post, *norm_mlp_pre, *norm_mlp_post, *w_in, *b_gates, *conv_w, *conv_b,
      *mlstm_norm_w, *hyena_norm_w, *filt_w1, *filt_b1, *filt_w2, *filt_b2, *filt_w3, *filt_b3, *filt_w4, *filt_freq,
      *filt_bias, *w_out, *w_mlp_in, *w_mlp_out;
  float* out;
  char* ws;
};

DI u16 f2bf(float x) { unsigned u = __float_as_uint(x); u += 0x7fffu + ((u >> 16) & 1u); return (u16)(u >> 16); }
DI float bf2f(u16 v) { return __uint_as_float(((unsigned)v) << 16); }
DI int opaque_tid() { int t = threadIdx.x; asm volatile("" : "+v"(t)); return t; }
DI int crow(int r, int hh) { return (r & 3) + 8 * (r >> 2) + 4 * hh; }
DI float log_sigmoid(float x) { return fminf(x, 0.f) - log1pf(expf(-fabsf(x))); }
DI float sigmoidf(float x) { return 1.f / (1.f + expf(-x)); }
DI float red2pi(float x) {
  const float k = rintf(x * 0.15915494309189535f);
  float r = fmaf(-k, 6.28125f, x);
  return fmaf(-k, 1.9353071795864769e-3f, r);
}
DI float fsin(float x) { return sinf(x); }
DI float fcos(float x) { return cosf(x); }
DI bf16x8 pack8(const float* v) {
  bf16x8 r;
#pragma unroll
  for (int i = 0; i < 8; ++i) r[i] = (short)f2bf(v[i]);
  return r;
}
DI bf16x8 scale8(bf16x8 a, float s) {
  bf16x8 r;
#pragma unroll
  for (int i = 0; i < 8; ++i) r[i] = (short)f2bf(bf2f((u16)a[i]) * s);
  return r;
}

template <bool SWAP>
DI void gemm_core(const u16* __restrict__ A, const u16* __restrict__ Bt, int K, int m0, int n0, char* smem, f32x16 (&acc)[2][2]) {
  const int tid = threadIdx.x, lane = tid & 63, wave = tid >> 6, wr = wave >> 1, wc = wave & 1;
  const int lr = lane & 31, hh = lane >> 5;
#pragma unroll
  for (int i = 0; i < 2; ++i)
#pragma unroll
    for (int j = 0; j < 2; ++j)
#pragma unroll
      for (int r = 0; r < 16; ++r) acc[i][j][r] = 0.f;
  const int c = tid & 7, r0 = tid >> 3;
  const u16* Ag = A + (size_t)(m0 + r0) * K + c * 8;
  const u16* Bg = Bt + (size_t)(n0 + r0) * K + c * 8;
  const int soff = r0 * 128 + ((c ^ ((r0 >> 1) & 7)) << 4);
  uint4 ra[4], rb[4];
#pragma unroll
  for (int i = 0; i < 4; ++i) {
    ra[i] = *(const uint4*)(Ag + (size_t)(32 * i) * K);
    rb[i] = *(const uint4*)(Bg + (size_t)(32 * i) * K);
  }
#pragma unroll
  for (int i = 0; i < 4; ++i) {
    *(uint4*)(smem + soff + i * 4096) = ra[i];
    *(uint4*)(smem + 16384 + soff + i * 4096) = rb[i];
  }
  __syncthreads();
  const int nk = K >> 6;
  for (int kt = 0; kt < nk; ++kt) {
    if (kt + 1 < nk) {
      const int k0 = (kt + 1) << 6;
#pragma unroll
      for (int i = 0; i < 4; ++i) {
        ra[i] = *(const uint4*)(Ag + (size_t)(32 * i) * K + k0);
        rb[i] = *(const uint4*)(Bg + (size_t)(32 * i) * K + k0);
      }
    }
    const char* As = smem + (kt & 1) * 32768;
    const char* Bs = As + 16384;
#pragma unroll
    for (int kk = 0; kk < 4; ++kk) {
      bf16x8 a[2], b[2];
      const int cc = kk * 2 + hh;
#pragma unroll
      for (int i = 0; i < 2; ++i) {
        const int r = wr * 64 + i * 32 + lr;
        a[i] = *(const bf16x8*)(As + r * 128 + ((cc ^ ((r >> 1) & 7)) << 4));
      }
#pragma unroll
      for (int j = 0; j < 2; ++j) {
        const int r = wc * 64 + j * 32 + lr;
        b[j] = *(const bf16x8*)(Bs + r * 128 + ((cc ^ ((r >> 1) & 7)) << 4));
      }
#pragma unroll
      for (int i = 0; i < 2; ++i)
#pragma unroll
        for (int j = 0; j < 2; ++j) acc[i][j] = SWAP ? MFMA(b[j], a[i], acc[i][j]) : MFMA(a[i], b[j], acc[i][j]);
    }
    if (kt + 1 < nk) {
      char* dst = smem + ((kt + 1) & 1) * 32768;
#pragma unroll
      for (int i = 0; i < 4; ++i) {
        *(uint4*)(dst + soff + i * 4096) = ra[i];
        *(uint4*)(dst + 16384 + soff + i * 4096) = rb[i];
      }
    }
    __syncthreads();
  }
}

DI void tile_map(int id, int ntn, int& mt, int& nt) {
  const int per = 16 * ntn;
  const int g = id / per, rem = id - g * per;
  mt = g * 16 + (rem & 15);
  nt = rem >> 4;
}

DI void transpose_tile(const float* __restrict__ src, int R, int C, u16* __restrict__ dst, int kt, int nt, char* smem) {
  float* tile = (float*)smem;
  const int tid = threadIdx.x;
  const int k0 = kt * 64, n0 = nt * 64;
#pragma unroll 4
  for (int it = 0; it < 16; ++it) {
    const int kk = it * 4 + (tid >> 6), nn = tid & 63;
    const int n = n0 + nn;
    tile[kk * 65 + nn] = (n < C) ? src[(size_t)(k0 + kk) * C + n] : 0.f;
  }
  __syncthreads();
#pragma unroll 4
  for (int it = 0; it < 16; ++it) {
    const int nn = it * 4 + (tid >> 6), kk = tid & 63;
    dst[(size_t)(n0 + nn) * R + k0 + kk] = f2bf(tile[kk * 65 + nn]);
  }
  __syncthreads();
}

DI float wave_sum(float v) {
#pragma unroll
  for (int o = 32; o; o >>= 1) v += __shfl_xor(v, o, 64);
  return v;
}

DI void filter_unit(const Params& p, int unit, char* smem) {
  float* sz = (float*)smem;
  float* hA = sz + 16 * 33;
  float* hB = hA + 16 * 64;
  const int tid = threadIdx.x;
  const int l0 = unit * 16;
  for (int idx = tid; idx < 16 * 33; idx += 256) {
    const int pp = idx / 33, f = idx - pp * 33;
    const float l = (float)(l0 + pp);
    float v;
    if (f == 0) v = l / 4095.f;
    else {
      const int jb = (f - 1) & 15;
      const float fj = 1e-4f + (float)jb * ((15.f - 1e-4f) / 15.f);
      const float ang = 6.283185307179586f * l / 4096.f;
      v = (f <= 16) ? fcos(fj * ang) : -fsin(fj * ang);
    }
    sz[idx] = v;
  }
  __syncthreads();
  {
    const int o = tid & 63;
#pragma unroll 1
    for (int i = 0; i < 4; ++i) {
      const int pp = (tid >> 6) + 4 * i;
      float s = p.filt_b1[o];
#pragma unroll 3
      for (int f = 0; f < 33; ++f) s += sz[pp * 33 + f] * p.filt_w1[f * 64 + o];
      hA[pp * 64 + o] = fsin(p.filt_freq[o] * s);
    }
  }
  __syncthreads();
  {
    const int o = tid & 63;
#pragma unroll 1
    for (int i = 0; i < 4; ++i) {
      const int pp = (tid >> 6) + 4 * i;
      float s = p.filt_b2[o];
#pragma unroll 4
      for (int k = 0; k < 64; ++k) s += hA[pp * 64 + k] * p.filt_w2[k * 64 + o];
      hB[pp * 64 + o] = fsin(p.filt_freq[64 + o] * s);
    }
  }
  __syncthreads();
  {
    const int o = tid & 63;
#pragma unroll 1
    for (int i = 0; i < 4; ++i) {
      const int pp = (tid >> 6) + 4 * i;
      float s = p.filt_b3[o];
#pragma unroll 4
      for (int k = 0; k < 64; ++k) s += hB[pp * 64 + k] * p.filt_w3[k * 64 + o];
      hA[pp * 64 + o] = fsin(p.filt_freq[128 + o] * s);
    }
  }
  __syncthreads();
  float* filt = (float*)(p.ws + OFF_FILT);
  const float min_decay = -3.0701134573253944f, max_decay = -15.350567286626973f;
#pragma unroll 1
  for (int cc = 0; cc < 8; ++cc) {
    const int col = tid + 256 * cc;
    float acc[16];
#pragma unroll
    for (int q = 0; q < 16; ++q) acc[q] = 0.f;
#pragma unroll 2
    for (int k = 0; k < 64; ++k) {
      const float w = p.filt_w4[k * 2048 + col];
#pragma unroll
      for (int q = 0; q < 16; ++q) acc[q] += hA[q * 64 + k] * w;
    }
    const int ch = col & 511;
    const float delta = fabsf(min_decay + (float)ch * ((max_decay - min_decay) / 511.f));
#pragma unroll
    for (int q = 0; q < 16; ++q) {
      const float t = (float)(l0 + q) / 4095.f;
      acc[q] *= expf(-t * delta);
    }
    float4* dst = (float4*)(filt + (size_t)col * 4096 + l0);
    dst[0] = make_float4(acc[0], acc[1], acc[2], acc[3]);
    dst[1] = make_float4(acc[4], acc[5], acc[6], acc[7]);
    dst[2] = make_float4(acc[8], acc[9], acc[10], acc[11]);
    dst[3] = make_float4(acc[12], acc[13], acc[14], acc[15]);
  }
  __syncthreads();
}

DI void phase0(const Params& p, char* smem) {
  const int tid = threadIdx.x, lane = tid & 63, wave = tid >> 6;
  const int U_W = 32, U_F = 256, U_X = 1024, U_T1 = 58 * 16, U_T2 = 256, U_T3 = 1024, U_T4 = 1024;
  const int total = U_W + U_F + U_X + U_T1 + U_T2 + U_T3 + U_T4;
  for (int u = blockIdx.x; u < total; u += gridDim.x) {
    int v = u;
    if (v < U_W) {
      const int idx = v * 256 + tid;
      if (idx < 8191) {
        const int lh = 31 - __clz(idx + 1);
        const int h = 1 << lh, jj = idx + 1 - h;
        float2* twp = (float2*)(p.ws + OFF_TW);
        const float ang = -3.14159265358979f * (float)jj / (float)h;
        twp[idx] = make_float2(cosf(ang), sinf(ang));
      }
      continue;
    }
    v -= U_W;
    if (v < U_F) { filter_unit(p, v, smem); continue; }
    v -= U_F;
    if (v < U_X) {
      u16* xn = (u16*)(p.ws + OFF_XN);
#pragma unroll 1
      for (int rr = 0; rr < 4; ++rr) {
        const int row = v * 16 + wave * 4 + rr;
        const float4* xr = (const float4*)(p.x + (size_t)row * DM);
        float4 xv[4];
        float ss = 0.f;
#pragma unroll
        for (int i = 0; i < 4; ++i) {
          xv[i] = xr[lane + 64 * i];
          ss += xv[i].x * xv[i].x + xv[i].y * xv[i].y + xv[i].z * xv[i].z + xv[i].w * xv[i].w;
        }
        ss = wave_sum(ss);
        const float rs = rsqrtf(ss * (1.f / DM) + EPS);
#pragma unroll
        for (int i = 0; i < 4; ++i) {
          const float4 w = ((const float4*)p.norm_mix_pre)[lane + 64 * i];
          ushort4 o;
          o.x = f2bf(xv[i].x * rs * w.x); o.y = f2bf(xv[i].y * rs * w.y); o.z = f2bf(xv[i].z * rs * w.z); o.w = f2bf(xv[i].w * rs * w.w);
          *(ushort4*)(xn + (size_t)row * DM + (lane + 64 * i) * 4) = o;
        }
      }
      continue;
    }
    v -= U_X;
    if (v < U_T1) { transpose_tile(p.w_in, DM, NIN, (u16*)(p.ws + OFF_WINT), v & 15, v >> 4, smem); continue; }
    v -= U_T1;
    if (v < U_T2) { transpose_tile(p.w_out, DM, DM, (u16*)(p.ws + OFF_WOUTT), v & 15, v >> 4, smem); continue; }
    v -= U_T2;
    if (v < U_T3) { transpose_tile(p.w_mlp_in, DM, DFF, (u16*)(p.ws + OFF_W1T), v & 15, v >> 4, smem); continue; }
    v -= U_T3;
    transpose_tile(p.w_mlp_out, DFF, DM, (u16*)(p.ws + OFF_W2T), v & 63, v >> 6, smem);
  }
}

DI void phase1(const Params& p, char* smem) {
  const int tid = threadIdx.x, lane = tid & 63, wave = tid >> 6, wr = wave >> 1, wc = wave & 1, lr = lane & 31, hh = lane >> 5;
  const u16* xn = (const u16*)(p.ws + OFF_XN);
  const u16* wt = (const u16*)(p.ws + OFF_WINT);
  u16* qkpre = (u16*)(p.ws + OFF_QKPRE);
  u16* hyT = (u16*)(p.ws + OFF_HYT);
  u16* vT = (u16*)(p.ws + OFF_VT);
  u16* og = (u16*)(p.ws + OFF_OG);
  float* gates = (float*)(p.ws + OFF_GATES);
  const int ntn = 29, ntiles = 128 * ntn;
  for (int id = blockIdx.x; id < ntiles; id += gridDim.x) {
    int mt, nt;
    tile_map(id, ntn, mt, nt);
    const int m0 = mt * 128, n0 = nt * 128;
    f32x16 acc[2][2];
    const bool swap = (nt >= 8 && nt < 24);
    if (swap) gemm_core<true>(xn, wt, DM, m0, n0, smem, acc);
    else gemm_core<false>(xn, wt, DM, m0, n0, smem, acc);
#pragma unroll
    for (int i = 0; i < 2; ++i)
#pragma unroll
      for (int j = 0; j < 2; ++j)
#pragma unroll
        for (int r = 0; r < 16; ++r) {
          const float val = acc[i][j][r];
          if (!swap) {
            const int row = m0 + wr * 64 + i * 32 + crow(r, hh);
            const int col = n0 + wc * 64 + j * 32 + lr;
            if (nt < 8) qkpre[(size_t)row * 1024 + col] = f2bf(val);
            else if (nt < 28) og[(size_t)row * 512 + (col - 3072)] = f2bf(sigmoidf(val));
            else if (col < 3600) gates[(size_t)row * 16 + (col - 3584)] = val;
          } else {
            const int n = n0 + wc * 64 + j * 32 + crow(r, hh);
            const int m = m0 + wr * 64 + i * 32 + lr;
            const int b = m >> 12, t = m & 4095;
            if (nt < 20) {
              const int cc = n - 1024, g = cc >> 9, ch = cc & 511;
              hyT[((size_t)((g * 4 + b) * 512 + ch)) * 4096 + t] = f2bf(val);
            } else {
              const int cc = n - 2560;
              vT[((size_t)(b * 512 + cc)) * 4096 + t] = f2bf(val);
            }
          }
        }
  }
}

DI void phase_qk(const Params& p, char* smem) {
  u16* tile = (u16*)smem;
  const int tid = threadIdx.x;
  const u16* qkpre = (const u16*)(p.ws + OFF_QKPRE);
  u16* qa = (u16*)(p.ws + OFF_QA);
  u16* ka = (u16*)(p.ws + OFF_KA);
  u16* kaT = (u16*)(p.ws + OFF_KAT);
  for (int u = blockIdx.x; u < 4096; u += gridDim.x) {
    const int ct = u & 15, tt = u >> 4;
    const int C = ct * 64 + (tid & 63);
    const float w0 = p.conv_w[C], w1 = p.conv_w[2560 + C], w2 = p.conv_w[5120 + C], cb = p.conv_b[C];
#pragma unroll 4
    for (int i = 0; i < 16; ++i) {
      const int row = (tid >> 6) + 4 * i;
      const int T = tt * 64 + row, t = T & 4095;
      const float pm = t > 0 ? bf2f(qkpre[(size_t)(T - 1) * 1024 + C]) : 0.f;
      const float p0 = bf2f(qkpre[(size_t)T * 1024 + C]);
      const float pp = t < 4095 ? bf2f(qkpre[(size_t)(T + 1) * 1024 + C]) : 0.f;
      const float val = w0 * pm + w1 * p0 + w2 * pp + cb;
      float s = val * sigmoidf(val);
      if (C < 512) qa[(size_t)T * 512 + C] = f2bf(s);
      else {
        s *= 0.08838834764831845f;
        const u16 sb = f2bf(s);
        ka[(size_t)T * 512 + (C - 512)] = sb;
        tile[(tid & 63) * 66 + row] = sb;
      }
    }
    if (ct >= 8) {
      __syncthreads();
      const int b = (tt * 64) >> 12, t0 = (tt * 64) & 4095;
      const int d0 = (ct - 8) * 64;
#pragma unroll 4
      for (int i = 0; i < 16; ++i) {
        const int dl = (tid >> 6) + 4 * i, tl = tid & 63;
        kaT[((size_t)(b * 512 + d0 + dl)) * 4096 + t0 + tl] = tile[dl * 66 + tl];
      }
      __syncthreads();
    }
  }
}

DI void fft_fwd(float2* x, int tid, const float2* __restrict__ tw) {
#ifdef DBG_NOFFT
  __syncthreads(); return;
#endif
#pragma unroll 1
  for (int lh = 12; lh >= 0; --lh) {
    const int h = 1 << lh;
    __syncthreads();
#pragma unroll 4
    for (int i = 0; i < 16; ++i) {
      const int k = tid + (i << 8);
      const int j = k & (h - 1);
      const int i0 = ((k - j) << 1) + j;
      const float2 a = x[i0], b = x[i0 + h];
      const float2 w = tw[(h - 1) + j];
      const float cs = w.x, sn = w.y;
      const float dx = a.x - b.x, dy = a.y - b.y;
      x[i0] = make_float2(a.x + b.x, a.y + b.y);
      x[i0 + h] = make_float2(dx * cs - dy * sn, dx * sn + dy * cs);
    }
  }
  __syncthreads();
}
DI void fft_inv(float2* x, int tid, const float2* __restrict__ tw) {
#ifdef DBG_NOFFT
  __syncthreads(); return;
#endif
#pragma unroll 1
  for (int lh = 0; lh <= 12; ++lh) {
    const int h = 1 << lh;
    __syncthreads();
#pragma unroll 4
    for (int i = 0; i < 16; ++i) {
      const int k = tid + (i << 8);
      const int j = k & (h - 1);
      const int i0 = ((k - j) << 1) + j;
      const float2 a = x[i0], b = x[i0 + h];
      const float2 w = tw[(h - 1) + j];
      const float cs = w.x, sn = -w.y;
      const float bx = b.x * cs - b.y * sn, by = b.x * sn + b.y * cs;
      x[i0] = make_float2(a.x + bx, a.y + by);
      x[i0 + h] = make_float2(a.x - bx, a.y - by);
    }
  }
  __syncthreads();
}

DI float hy_conv(const u16* __restrict__ pr, int t, float w0, float w1, float w2, float cb) {
  const float a = t > 0 ? bf2f(pr[t - 1]) : 0.f;
  const float b = bf2f(pr[t]);
  const float c = t < 4095 ? bf2f(pr[t + 1]) : 0.f;
  return w0 * a + w1 * b + w2 * c + cb;
}

DI void hyena_unit(const Params& p, int ch, char* smem) {
  float2* buf = (float2*)smem;
  const int tid = opaque_tid();
  const u16* hyT = (const u16*)(p.ws + OFF_HYT);
  const float* filt = (const float*)(p.ws + OFF_FILT);
  float* z2T = (float*)(p.ws + OFF_Z2T);
  const float2* tw = (const float2*)(p.ws + OFF_TW);
  float2 Kr[32];
#pragma unroll 1
  for (int ord = 0; ord < 2; ++ord) {
    const float* kf = filt + (size_t)((0 * 2 + ord) * 512 + ch) * 4096;
    const float* kb = filt + (size_t)((1 * 2 + ord) * 512 + ch) * 4096;
    const float fb = p.filt_bias[ord * 512 + ch];
    __syncthreads();
#pragma unroll 4
    for (int n = tid; n < 8192; n += 256) {
      float v;
      if (n < 4096) v = kf[n];
      else if (n == 4096) v = 0.f;
      else v = kb[8192 - n];
      if (n == 0) v += fb;
      buf[n] = make_float2(v, 0.f);
    }
    fft_fwd(buf, tid, tw);
#pragma unroll
    for (int j = 0; j < 32; ++j) {
      const float2 v = buf[tid + 256 * j];
      Kr[j] = make_float2(v.x * (1.f / 8192.f), v.y * (1.f / 8192.f));
    }
    const int gcol = 1024 + (1 + ord) * 512 + ch;
    const float gw0 = p.conv_w[gcol], gw1 = p.conv_w[2560 + gcol], gw2 = p.conv_w[5120 + gcol], gcb = p.conv_b[gcol];
    const int vcol = 1024 + ch;
    const float vw0 = p.conv_w[vcol], vw1 = p.conv_w[2560 + vcol], vw2 = p.conv_w[5120 + vcol], vcb = p.conv_b[vcol];
#pragma unroll 1
    for (int pr = 0; pr < 2; ++pr) {
      const int b0 = 2 * pr, b1 = 2 * pr + 1;
      __syncthreads();
      if (ord == 0) {
        const u16* u0 = hyT + ((size_t)((0 * 4 + b0) * 512 + ch)) * 4096;
        const u16* u1 = hyT + ((size_t)((0 * 4 + b1) * 512 + ch)) * 4096;
#pragma unroll 2
        for (int i = 0; i < 16; ++i) {
          const int t = tid + 256 * i;
          buf[t] = make_float2(hy_conv(u0, t, vw0, vw1, vw2, vcb), hy_conv(u1, t, vw0, vw1, vw2, vcb));
          buf[4096 + t] = make_float2(0.f, 0.f);
        }
      } else {
        const float* u0 = z2T + ((size_t)(b0 * 512 + ch)) * 4096;
        const float* u1 = z2T + ((size_t)(b1 * 512 + ch)) * 4096;
#pragma unroll 4
        for (int i = 0; i < 16; ++i) {
          const int t = tid + 256 * i;
          buf[t] = make_float2(u0[t], u1[t]);
          buf[4096 + t] = make_float2(0.f, 0.f);
        }
      }
      fft_fwd(buf, tid, tw);
#pragma unroll
      for (int j = 0; j < 32; ++j) {
        const float2 v = buf[tid + 256 * j];
        buf[tid + 256 * j] = make_float2(v.x * Kr[j].x - v.y * Kr[j].y, v.x * Kr[j].y + v.y * Kr[j].x);
      }
      fft_inv(buf, tid, tw);
      const u16* g0 = hyT + ((size_t)(((1 + ord) * 4 + b0) * 512 + ch)) * 4096;
      const u16* g1 = hyT + ((size_t)(((1 + ord) * 4 + b1) * 512 + ch)) * 4096;
      float* o0 = z2T + ((size_t)(b0 * 512 + ch)) * 4096;
      float* o1 = z2T + ((size_t)(b1 * 512 + ch)) * 4096;
#pragma unroll 2
      for (int i = 0; i < 16; ++i) {
        const int t = tid + 256 * i;
        const float2 y = buf[t];
        o0[t] = hy_conv(g0, t, gw0, gw1, gw2, gcb) * y.x;
        o1[t] = hy_conv(g1, t, gw0, gw1, gw2, gcb) * y.y;
      }
    }
  }
  __syncthreads();
}

DI void mlstm_local_unit(const Params& p, int u, char* smem) {
  float* s_gi = (float*)smem;
  float* s_lf = s_gi + 128;
  float* s_a = s_lf + 128;
  float* s_w = s_a + 128;
  const int tid = opaque_tid(), lane = tid & 63, wave = tid >> 6, lr = lane & 31, hh = lane >> 5;
  const int j = u & 31, dir = (u >> 5) & 1, bh = u >> 6, h = bh & 3, b = bh >> 2;
  const int T0 = b * 4096 + j * 128;
  const float* gates = (const float*)(p.ws + OFF_GATES);
  const u16* vT = (const u16*)(p.ws + OFF_VT);
  const u16* kaT = (const u16*)(p.ws + OFF_KAT);
  float* CL = p.out;
  float* nl = (float*)(p.ws + OFF_NL);
  float* mloc = (float*)(p.ws + OFF_MLOC);
  float* gsum = (float*)(p.ws + OFF_GSUM);
  __syncthreads();
  if (tid < 128) {
    const int T = T0 + tid;
    s_gi[tid] = gates[(size_t)T * 16 + dir * 8 + h] + p.b_gates[dir * 8 + h];
    s_lf[tid] = log_sigmoid(gates[(size_t)T * 16 + dir * 8 + 4 + h] + p.b_gates[dir * 8 + 4 + h]);
  }
  __syncthreads();
  float gtot = 0.f;
  if (tid < 128) {
    float pre = 0.f;
#pragma unroll 4
    for (int m = 0; m < 128; ++m) {
      const float v = s_lf[m];
      if (m < tid) pre += v;
      gtot += v;
    }
    s_a[tid] = (dir == 0) ? (gtot - pre - s_lf[tid] + s_gi[tid]) : (pre + s_gi[tid]);
  }
  __syncthreads();
  if (tid < 128) {
    float mx = -3.0e38f;
#pragma unroll 4
    for (int m = 0; m < 128; ++m) mx = fmaxf(mx, s_a[m]);
    s_w[tid] = expf(s_a[tid] - mx);
    if (tid == 0) { mloc[u] = mx; gsum[u] = gtot; }
  }
  __syncthreads();
  f32x16 acc[4];
#pragma unroll
  for (int d = 0; d < 4; ++d)
#pragma unroll
    for (int r = 0; r < 16; ++r) acc[d][r] = 0.f;
  const u16* vrow = vT + ((size_t)(bh * 128 + wave * 32 + lr)) * 4096 + j * 128 + hh * 8;
  const u16* kbase = kaT + ((size_t)(bh * 128 + lr)) * 4096 + j * 128 + hh * 8;
#pragma unroll 2
  for (int ks = 0; ks < 8; ++ks) {
    const bf16x8 av = *(const bf16x8*)(vrow + ks * 16);
    bf16x8 a;
#pragma unroll
    for (int i = 0; i < 8; ++i) a[i] = (short)f2bf(bf2f((u16)av[i]) * s_w[ks * 16 + hh * 8 + i]);
#pragma unroll
    for (int dt = 0; dt < 4; ++dt) {
      const bf16x8 bk = *(const bf16x8*)(kbase + (size_t)(dt * 32) * 4096 + ks * 16);
      acc[dt] = MFMA(a, bk, acc[dt]);
    }
  }
  float* dst = CL + (size_t)u * 16384;
#pragma unroll
  for (int dt = 0; dt < 4; ++dt)
#pragma unroll
    for (int r = 0; r < 16; ++r) dst[(wave * 32 + crow(r, hh)) * 128 + dt * 32 + lr] = acc[dt][r];
  if (tid < 128) {
    const u16* kr = kaT + ((size_t)(bh * 128 + tid)) * 4096 + j * 128;
    float s = 0.f;
#pragma unroll 2
    for (int l = 0; l < 128; l += 8) {
      const bf16x8 kv = *(const bf16x8*)(kr + l);
#pragma unroll
      for (int i = 0; i < 8; ++i) s += s_w[l + i] * bf2f((u16)kv[i]);
    }
    nl[(size_t)u * 128 + tid] = s;
  }
}

DI void scan_unit(const Params& p, int unit) {
  const int tid = opaque_tid();
  const int sc = unit >> 4, part = unit & 15, dir = sc & 1;
  float* CL = p.out;
  float* nl = (float*)(p.ws + OFF_NL);
  const float* mloc = (const float*)(p.ws + OFF_MLOC);
  const float* gsum = (const float*)(p.ws + OFF_GSUM);
  float* ms = (float*)(p.ws + OFF_MS);
  const int idx = part * 1024 + tid * 4;
  float4 C = make_float4(0.f, 0.f, 0.f, 0.f);
  float nst = 0.f, m = 0.f;
  const bool do_n = (part == 0) && (tid < 128);
  float4 pf[4];
#pragma unroll
  for (int q = 0; q < 4; ++q) {
    const int jj = dir ? 31 - q : q;
    pf[q] = *(const float4*)(CL + (size_t)(sc * 32 + jj) * 16384 + idx);
  }
#pragma unroll 1
  for (int c0 = 0; c0 < 32; c0 += 4) {
#pragma unroll
    for (int q = 0; q < 4; ++q) {
      const int c = c0 + q;
      const int jj = dir ? 31 - c : c;
      const int u = sc * 32 + jj;
      const float4 cl = pf[q];
      *(float4*)(CL + (size_t)u * 16384 + idx) = C;
      if (c + 4 < 32) {
        const int j2 = dir ? 31 - (c + 4) : (c + 4);
        pf[q] = *(const float4*)(CL + (size_t)(sc * 32 + j2) * 16384 + idx);
      }
      const float g = gsum[u], ml = mloc[u];
      const float mn = fmaxf(g + m, ml);
      const float dec = expf(g + m - mn), scl = expf(ml - mn);
      C.x = dec * C.x + scl * cl.x; C.y = dec * C.y + scl * cl.y; C.z = dec * C.z + scl * cl.z; C.w = dec * C.w + scl * cl.w;
      if (do_n) {
        const float nv = nl[(size_t)u * 128 + tid];
        nl[(size_t)u * 128 + tid] = nst;
        nst = dec * nst + scl * nv;
      }
      if (part == 0 && tid == 0) ms[u] = m;
      m = mn;
    }
  }
}

template <int DIR>
DI void mlstm_dir(const Params& p, int bh, int j, char* smem, f32x16 (&hs)[4]) {
  float* s_gi = (float*)smem;
  float* s_lf = s_gi + 128;
  float* s_bc = s_lf + 128;
  float* s_r = s_bc + 128;
  float* s_al = s_r + 128;
  float* s_fl = s_al + 128;
  float* s_is = s_fl + 128;
  const int tid = opaque_tid(), lane = tid & 63, wave = tid >> 6, lr = lane & 31, hh = lane >> 5;
  u16* Pl = (u16*)(smem + 4096) + wave * (32 * 136);
  const int h = bh & 3, b = bh >> 2;
  const int T0 = b * 4096 + j * 128;
  const float* gates = (const float*)(p.ws + OFF_GATES);
  const u16* qa = (const u16*)(p.ws + OFF_QA);
  const u16* ka = (const u16*)(p.ws + OFF_KA);
  const u16* vT = (const u16*)(p.ws + OFF_VT);
  const float* CS = p.out;
  const float* ns = (const float*)(p.ws + OFF_NL);
  const float* ms = (const float*)(p.ws + OFF_MS);
  u16* A2 = (u16*)(p.ws + OFF_A2);
  bf16x8 ones;
#pragma unroll
  for (int i = 0; i < 8; ++i) ones[i] = (short)0x3F80;
  const u16* qrow = qa + (size_t)(T0 + wave * 32 + lr) * 512 + h * 128 + hh * 8;
  const int u = (bh * 2 + DIR) * 32 + j;
  const float msu = ms[u];
  __syncthreads();
  if (tid < 128) {
    const int T = T0 + tid;
    s_gi[tid] = gates[(size_t)T * 16 + DIR * 8 + h] + p.b_gates[DIR * 8 + h];
    s_lf[tid] = log_sigmoid(gates[(size_t)T * 16 + DIR * 8 + 4 + h] + p.b_gates[DIR * 8 + 4 + h]);
  }
  __syncthreads();
  if (tid < 128) {
    float a = 0.f;
#pragma unroll 4
    for (int m = 0; m < 128; ++m) {
      const bool in = (DIR == 0) ? (m <= tid) : (m >= tid);
      a += in ? s_lf[m] : 0.f;
    }
    s_bc[tid] = a;
    s_r[tid] = s_gi[tid] - a;
  }
  __syncthreads();
  if (tid < 128) {
    float cm = -3.0e38f;
#pragma unroll 4
    for (int m = 0; m < 128; ++m) {
      const bool in = (DIR == 0) ? (m <= tid) : (m >= tid);
      cm = in ? fmaxf(cm, s_r[m]) : cm;
    }
    const float bc = s_bc[tid];
    const float mt = bc + fmaxf(msu, cm);
    s_al[tid] = bc - mt;
    s_fl[tid] = expf(-mt);
    s_is[tid] = expf(bc + msu - mt);
  }
  __syncthreads();
  {
    f32x16 S[4];
#pragma unroll
    for (int st = 0; st < 4; ++st)
#pragma unroll
      for (int r = 0; r < 16; ++r) S[st][r] = 0.f;
    const u16* kbase = ka + (size_t)(T0 + lr) * 512 + h * 128 + hh * 8;
#pragma unroll 2
    for (int ks = 0; ks < 8; ++ks) {
      const bf16x8 a = *(const bf16x8*)(qrow + ks * 16);
#pragma unroll
      for (int st = 0; st < 4; ++st) {
        const bf16x8 bk = *(const bf16x8*)(kbase + (size_t)(st * 32) * 512 + ks * 16);
        S[st] = MFMA(a, bk, S[st]);
      }
    }
#pragma unroll
    for (int st = 0; st < 4; ++st) {
      const int sl = st * 32 + lr;
      const float rs = s_r[sl];
#pragma unroll
      for (int r = 0; r < 16; ++r) {
        const int tl = wave * 32 + crow(r, hh);
        const bool valid = (DIR == 0) ? (sl <= tl) : (sl >= tl);
        const float pv = valid ? S[st][r] * __expf(s_al[tl] + rs) : 0.f;
        Pl[crow(r, hh) * 136 + sl] = f2bf(pv);
      }
    }
  }
  __syncthreads();
#pragma unroll
  for (int eh = 0; eh < 2; ++eh) {
    f32x16 N[3];
#pragma unroll
    for (int e = 0; e < 3; ++e)
#pragma unroll
      for (int r = 0; r < 16; ++r) N[e][r] = 0.f;
    {
      const u16* vbase = vT + ((size_t)(bh * 128 + eh * 64 + lr)) * 4096 + j * 128 + hh * 8;
#pragma unroll 2
      for (int ks = 0; ks < 8; ++ks) {
        const bf16x8 a = *(const bf16x8*)(Pl + lr * 136 + ks * 16 + hh * 8);
#pragma unroll
        for (int e2 = 0; e2 < 2; ++e2) {
          const bf16x8 bv = *(const bf16x8*)(vbase + (size_t)(e2 * 32) * 4096 + ks * 16);
          N[e2] = MFMA(a, bv, N[e2]);
        }
        N[2] = MFMA(a, ones, N[2]);
      }
    }
    {
      const float isc = s_is[wave * 32 + lr];
      const float* cbase = CS + (size_t)u * 16384 + (size_t)(eh * 64 + lr) * 128 + hh * 8;
      const float* nbase = ns + (size_t)u * 128 + hh * 8;
#pragma unroll 2
      for (int ks = 0; ks < 8; ++ks) {
        const bf16x8 aq = *(const bf16x8*)(qrow + ks * 16);
        const bf16x8 a = scale8(aq, isc);
#pragma unroll
        for (int e2 = 0; e2 < 2; ++e2) {
          const float4 c0 = *(const float4*)(cbase + (size_t)(e2 * 32) * 128 + ks * 16);
          const float4 c1 = *(const float4*)(cbase + (size_t)(e2 * 32) * 128 + ks * 16 + 4);
          const float cv[8] = {c0.x, c0.y, c0.z, c0.w, c1.x, c1.y, c1.z, c1.w};
          N[e2] = MFMA(a, pack8(cv), N[e2]);
        }
        const float4 n0 = *(const float4*)(nbase + ks * 16);
        const float4 n1 = *(const float4*)(nbase + ks * 16 + 4);
        const float nv[8] = {n0.x, n0.y, n0.z, n0.w, n1.x, n1.y, n1.z, n1.w};
        N[2] = MFMA(a, pack8(nv), N[2]);
      }
    }
#pragma unroll
    for (int r = 0; r < 16; ++r) {
      const int tl = wave * 32 + crow(r, hh);
      const float den = fmaxf(fabsf(N[2][r]), s_fl[tl]);
      const float inv = 1.f / den;
#pragma unroll
      for (int e2 = 0; e2 < 2; ++e2) {
        const float hv = N[e2][r] * inv;
        u16* tp = A2 + (size_t)(T0 + tl) * 1024 + h * 128 + (eh * 2 + e2) * 32 + lr;
        if (DIR == 0) *tp = f2bf(hv);
        else hs[eh * 2 + e2][r] = hv + bf2f(*tp);
      }
    }
  }
}

DI void mlstm_out_unit(const Params& p, int unit, char* smem) {
  const int tid = opaque_tid(), lane = tid & 63, wave = tid >> 6, lr = lane & 31, hh = lane >> 5;
  const int j = unit & 31, bh = unit >> 5, h = bh & 3, b = bh >> 2;
  const int T0 = b * 4096 + j * 128;
  const u16* og = (const u16*)(p.ws + OFF_OG);
  u16* A2 = (u16*)(p.ws + OFF_A2);
  f32x16 hs[4];
  mlstm_dir<0>(p, bh, j, smem, hs);
  mlstm_dir<1>(p, bh, j, smem, hs);
#pragma unroll
  for (int r = 0; r < 16; ++r) {
    const int T = T0 + wave * 32 + crow(r, hh);
    float ss = 0.f;
#pragma unroll
    for (int et = 0; et < 4; ++et) {
      const float o = bf2f(og[(size_t)T * 512 + h * 128 + et * 32 + lr]);
      hs[et][r] *= o;
      ss += hs[et][r] * hs[et][r];
    }
#pragma unroll
    for (int o = 1; o < 32; o <<= 1) ss += __shfl_xor(ss, o, 64);
    const float rs = rsqrtf(ss * (1.f / 128.f) + EPS);
#pragma unroll
    for (int et = 0; et < 4; ++et) {
      const int e = h * 128 + et * 32 + lr;
      A2[(size_t)T * 1024 + e] = f2bf(hs[et][r] * rs * p.mlstm_norm_w[e]);
    }
  }
}

DI void hyena_norm_unit(const Params& p, int unit, char* smem) {
  float* tile = (float*)smem;
  const int tid = opaque_tid();
  const int tt = unit & 63, g = (unit >> 6) & 7, b = unit >> 9;
  const float* z2T = (const float*)(p.ws + OFF_Z2T);
  u16* A2 = (u16*)(p.ws + OFF_A2);
  __syncthreads();
#pragma unroll 4
  for (int i = 0; i < 16; ++i) {
    const int cl = (tid >> 6) + 4 * i, tl = tid & 63;
    tile[cl * 65 + tl] = z2T[((size_t)(b * 512 + g * 64 + cl)) * 4096 + tt * 64 + tl];
  }
  __syncthreads();
  const int tl = tid >> 2, qd = tid & 3;
  float v[16];
  float ss = 0.f;
#pragma unroll
  for (int i = 0; i < 16; ++i) {
    v[i] = tile[(qd * 16 + i) * 65 + tl];
    ss += v[i] * v[i];
  }
  ss += __shfl_xor(ss, 1, 64);
  ss += __shfl_xor(ss, 2, 64);
  const float rs = rsqrtf(ss * (1.f / 64.f) + EPS);
  const size_t T = (size_t)b * 4096 + tt * 64 + tl;
  u16* dst = A2 + T * 1024 + 512 + g * 64 + qd * 16;
  const float* w = p.hyena_norm_w + g * 64 + qd * 16;
  float o[16];
#pragma unroll
  for (int i = 0; i < 16; ++i) o[i] = v[i] * rs * w[i];
  *(bf16x8*)(dst) = pack8(o);
  *(bf16x8*)(dst + 8) = pack8(o + 8);
}

template <int EPI>
DI void gemm_phase(const u16* A, const u16* Bt, int K, int ntn, void* outp, char* smem) {
  const int tid = threadIdx.x, lane = tid & 63, wave = tid >> 6, wr = wave >> 1, wc = wave & 1, lr = lane & 31, hh = lane >> 5;
  const int ntiles = 128 * ntn;
  for (int id = blockIdx.x; id < ntiles; id += gridDim.x) {
    int mt, nt;
    tile_map(id, ntn, mt, nt);
    const int m0 = mt * 128, n0 = nt * 128;
    f32x16 acc[2][2];
    gemm_core<false>(A, Bt, K, m0, n0, smem, acc);
#pragma unroll
    for (int i = 0; i < 2; ++i)
#pragma unroll
      for (int j = 0; j < 2; ++j)
#pragma unroll
        for (int r = 0; r < 16; ++r) {
          const int row = m0 + wr * 64 + i * 32 + crow(r, hh);
          const int col = n0 + wc * 64 + j * 32 + lr;
          const float val = acc[i][j][r];
          if (EPI == 0) ((float*)outp)[(size_t)row * 1024 + col] = val;
          else {
            const float rl = fmaxf(val, 0.f);
            ((u16*)outp)[(size_t)row * 4096 + col] = f2bf(rl * rl);
          }
        }
  }
}

DI void phase_post_mix(const Params& p) {
  const int tid = threadIdx.x, lane = tid & 63, wave = tid >> 6;
  const float* mix = p.out;
  float* x1 = (float*)(p.ws + OFF_X1);
  u16* hm = (u16*)(p.ws + OFF_HM);
  for (int u = blockIdx.x; u < 1024; u += gridDim.x) {
#pragma unroll 1
    for (int rr = 0; rr < 4; ++rr) {
      const size_t row = (size_t)u * 16 + wave * 4 + rr;
      float4 mv[4], xv[4];
      float ss = 0.f;
#pragma unroll
      for (int i = 0; i < 4; ++i) {
        mv[i] = ((const float4*)(mix + row * DM))[lane + 64 * i];
        xv[i] = ((const float4*)(p.x + row * DM))[lane + 64 * i];
        ss += mv[i].x * mv[i].x + mv[i].y * mv[i].y + mv[i].z * mv[i].z + mv[i].w * mv[i].w;
      }
      ss = wave_sum(ss);
      const float rs = rsqrtf(ss * (1.f / DM) + EPS);
      float s2 = 0.f;
#pragma unroll
      for (int i = 0; i < 4; ++i) {
        const float4 w = ((const float4*)p.norm_mix_post)[lane + 64 * i];
        xv[i].x += mv[i].x * rs * w.x; xv[i].y += mv[i].y * rs * w.y; xv[i].z += mv[i].z * rs * w.z; xv[i].w += mv[i].w * rs * w.w;
        s2 += xv[i].x * xv[i].x + xv[i].y * xv[i].y + xv[i].z * xv[i].z + xv[i].w * xv[i].w;
        ((float4*)(x1 + row * DM))[lane + 64 * i] = xv[i];
      }
      s2 = wave_sum(s2);
      const float r2 = rsqrtf(s2 * (1.f / DM) + EPS);
#pragma unroll
      for (int i = 0; i < 4; ++i) {
        const float4 w = ((const float4*)p.norm_mlp_pre)[lane + 64 * i];
        ushort4 o;
        o.x = f2bf(xv[i].x * r2 * w.x); o.y = f2bf(xv[i].y * r2 * w.y); o.z = f2bf(xv[i].z * r2 * w.z); o.w = f2bf(xv[i].w * r2 * w.w);
        *(ushort4*)(hm + row * DM + (lane + 64 * i) * 4) = o;
      }
    }
  }
}

DI void phase_final(const Params& p) {
  const int tid = threadIdx.x, lane = tid & 63, wave = tid >> 6;
  const float* x1 = (const float*)(p.ws + OFF_X1);
  for (int u = blockIdx.x; u < 1024; u += gridDim.x) {
#pragma unroll 1
    for (int rr = 0; rr < 4; ++rr) {
      const size_t row = (size_t)u * 16 + wave * 4 + rr;
      float4 fv[4];
      float ss = 0.f;
#pragma unroll
      for (int i = 0; i < 4; ++i) {
        fv[i] = ((const float4*)(p.out + row * DM))[lane + 64 * i];
        ss += fv[i].x * fv[i].x + fv[i].y * fv[i].y + fv[i].z * fv[i].z + fv[i].w * fv[i].w;
      }
      ss = wave_sum(ss);
      const float rs = rsqrtf(ss * (1.f / DM) + EPS);
#pragma unroll
      for (int i = 0; i < 4; ++i) {
        const float4 w = ((const float4*)p.norm_mlp_post)[lane + 64 * i];
        const float4 xv = ((const float4*)(x1 + row * DM))[lane + 64 * i];
        float4 o;
        o.x = xv.x + fv[i].x * rs * w.x; o.y = xv.y + fv[i].y * rs * w.y; o.z = xv.z + fv[i].z * rs * w.z; o.w = xv.w + fv[i].w * rs * w.w;
        ((float4*)(p.out + row * DM))[lane + 64 * i] = o;
      }
    }
  }
}

DI void run_phase(const Params& p, int ph, char* smem) {
  switch (ph) {
    case 0: phase0(p, smem); break;
    case 1: phase1(p, smem); break;
    case 2: phase_qk(p, smem); break;
    case 3:
      for (int u = blockIdx.x; u < 512 + 1024; u += gridDim.x) {
        if (u < 512) hyena_unit(p, u, smem);
        else mlstm_local_unit(p, u - 512, smem);
      }
      break;
    case 4:
      for (int u = blockIdx.x; u < 512; u += gridDim.x) scan_unit(p, u);
      break;
    case 5:
      for (int u = blockIdx.x; u < 512 + 2048; u += gridDim.x) {
#ifndef DBG_SKIP_MLSTM
        if (u < 512) mlstm_out_unit(p, u, smem);
#else
        if (u < 512) { u16* A2 = (u16*)(p.ws + OFF_A2); const int T0 = (u >> 5 >> 2) * 4096 + (u & 31) * 128, hq = (u >> 5) & 3;
          for (int i = threadIdx.x; i < 128 * 128; i += 256) A2[(size_t)(T0 + (i >> 7)) * 1024 + hq * 128 + (i & 127)] = 0; }
#endif
#ifndef DBG_SKIP_HYENA
        else hyena_norm_unit(p, u - 512, smem);
#else
        else { const int un = u - 512; const int tt = un & 63, g = (un >> 6) & 7, b = un >> 9; u16* A2 = (u16*)(p.ws + OFF_A2);
          for (int i = threadIdx.x; i < 64 * 64; i += 256) A2[((size_t)b * 4096 + tt * 64 + (i >> 6)) * 1024 + 512 + g * 64 + (i & 63)] = 0x3F80; }
#endif
      }
      break;
    case 6: gemm_phase<0>((const u16*)(p.ws + OFF_A2), (const u16*)(p.ws + OFF_WOUTT), 1024, 8, p.out, smem); break;
    case 7: phase_post_mix(p); break;
    case 8: gemm_phase<1>((const u16*)(p.ws + OFF_HM), (const u16*)(p.ws + OFF_W1T), 1024, 32, p.ws + OFF_H, smem); break;
    case 9: gemm_phase<0>((const u16*)(p.ws + OFF_H), (const u16*)(p.ws + OFF_W2T), 4096, 8, p.out, smem); break;
    case 10: phase_final(p); break;
  }
}
constexpr int NPHASE = 11;

DI void grid_barrier(unsigned* bar, unsigned& target) {
  __builtin_amdgcn_fence(__ATOMIC_RELEASE, "agent");
  asm volatile("s_waitcnt vmcnt(0)" ::: "memory");
  __syncthreads();
  target += gridDim.x;
  if (threadIdx.x == 0) {
    __hip_atomic_fetch_add(bar, 1u, __ATOMIC_RELAXED, __HIP_MEMORY_SCOPE_AGENT);
    while (__hip_atomic_load(bar, __ATOMIC_RELAXED, __HIP_MEMORY_SCOPE_AGENT) < target) __builtin_amdgcn_s_sleep(1);
  }
  __syncthreads();
  __builtin_amdgcn_fence(__ATOMIC_ACQUIRE, "agent");
  asm volatile("s_waitcnt vmcnt(0)" ::: "memory");
}

#if MULTI_LAUNCH
template <int PH>
__global__ void __launch_bounds__(256, 2) phase_kernel(Params p) {
  __shared__ __attribute__((aligned(16))) char smem[65536];
  run_phase(p, PH, smem);
}
template <int PH>
static void launch_phase(const Params& p, hipStream_t stream) {
  hipLaunchKernelGGL(phase_kernel<PH>, dim3(512), dim3(256), 0, stream, p);
}
#else
__global__ void __launch_bounds__(256, 2) mega_kernel(Params p) {
  __shared__ __attribute__((aligned(16))) char smem[65536];
  cg::grid_group grid = cg::this_grid();
  unsigned* bar = (unsigned*)(p.ws + OFF_BAR);
  unsigned target = 0;
  if (blockIdx.x == 0 && threadIdx.x == 0) __hip_atomic_store(bar, 0u, __ATOMIC_RELAXED, __HIP_MEMORY_SCOPE_AGENT);
#define GSYNC grid.sync()
  run_phase(p, 0, smem); grid.sync();
  run_phase(p, 1, smem); GSYNC;
#ifdef DBL_GEMM
  run_phase(p, 1, smem); grid.sync();
#endif
  run_phase(p, 2, smem); GSYNC;
  run_phase(p, 3, smem); GSYNC;
#ifdef DBL_HY
  run_phase(p, 3, smem); GSYNC;
#endif
  run_phase(p, 4, smem); GSYNC;
  run_phase(p, 5, smem); GSYNC;
  run_phase(p, 6, smem); GSYNC;
#ifdef DBL_GEMM
  run_phase(p, 6, smem); GSYNC;
#endif
  run_phase(p, 7, smem); GSYNC;
  run_phase(p, 8, smem); GSYNC;
#ifdef DBL_GEMM
  run_phase(p, 8, smem); GSYNC;
#endif
  run_phase(p, 9, smem); GSYNC;
#ifdef DBL_GEMM
  run_phase(p, 9, smem); GSYNC;
#endif
#ifdef XSYNC
  for (int q = 0; q < 10; ++q) GSYNC;
#endif
  run_phase(p, 10, smem);
}
#endif

extern "C" void kernel_launch(void* const* d_in, const int* in_sizes, int n_in, void* d_out, int out_size, void* d_ws,
                              size_t ws_size, hipStream_t stream) {
  Params p{};
  const float** pp = (const float**)&p;
  for (int i = 0; i < 23; ++i) pp[i] = (const float*)d_in[i];
  p.out = (float*)d_out;
  p.ws = (char*)d_ws;
#if MULTI_LAUNCH
  launch_phase<0>(p, stream);
#ifdef DBL_P0
  launch_phase<0>(p, stream);
#endif
 launch_phase<1>(p, stream); launch_phase<2>(p, stream); launch_phase<3>(p, stream);
#ifdef DBL_HY
  launch_phase<3>(p, stream);
#endif

  launch_phase<4>(p, stream); launch_phase<5>(p, stream);
#ifdef DBL_P5
  launch_phase<5>(p, stream);
#endif
 launch_phase<6>(p, stream); launch_phase<7>(p, stream);
  launch_phase<8>(p, stream); launch_phase<9>(p, stream); launch_phase<10>(p, stream);
#else
  static int grid_blocks = 0;
  if (!grid_blocks) {
    int dev = 0, cus = 0, per_cu = 0;
    hipGetDevice(&dev);
    hipDeviceGetAttribute(&cus, hipDeviceAttributeMultiprocessorCount, dev);
    hipOccupancyMaxActiveBlocksPerMultiprocessor(&per_cu, mega_kernel, 256, 0);
    if (per_cu > 2) per_cu = 2;
    if (per_cu < 1) per_cu = 1;
#ifdef FORCE2
    per_cu = 2;
#endif
    grid_blocks = cus * per_cu;
  }
  void* args[] = {&p};
  hipError_t e = hipLaunchCooperativeKernel((void*)mega_kernel, dim3(grid_blocks), dim3(256), args, 0, stream);
  if (e != hipSuccess) fprintf(stderr, "cooperative launch failed: %s (grid %d)\n", hipGetErrorString(e), grid_blocks);
#endif
}
```

```cpp
#include <hip/hip_runtime.h>
#include <hip/hip_cooperative_groups.h>
#include <cstdio>
namespace cg = cooperative_groups;

#ifndef MULTI_LAUNCH
#define MULTI_LAUNCH 0
#endif

typedef unsigned short u16;
using bf16x8 = __attribute__((ext_vector_type(8))) short;
using f32x16 = __attribute__((ext_vector_type(16))) float;
#define DI __device__ __forceinline__
#define MFMA(a, b, c) __builtin_amdgcn_mfma_f32_32x32x16_bf16((a), (b), (c), 0, 0, 0)

constexpr int SEQ = 4096, DM = 1024, NTOK = 16384, NIN = 3600, NINP = 3712, DFF = 4096;
constexpr float EPS = 1e-6f;
constexpr size_t MiB = 1u << 20;
constexpr size_t OFF_WINT = 0, OFF_WOUTT = 8 * MiB, OFF_W1T = 10 * MiB, OFF_W2T = 18 * MiB;
constexpr size_t OFF_XN = 26 * MiB, OFF_QA = 26 * MiB, OFF_KA = 42 * MiB;
constexpr size_t OFF_FILT = 58 * MiB, OFF_QKPRE = 90 * MiB, OFF_A2 = 90 * MiB;
constexpr size_t OFF_HYT = 122 * MiB, OFF_VT = 170 * MiB, OFF_OG = 186 * MiB, OFF_GATES = 202 * MiB;
constexpr size_t OFF_NL = 203 * MiB, OFF_MLOC = 203 * MiB + 512 * 1024, OFF_GSUM = OFF_MLOC + 4096, OFF_MS = OFF_GSUM + 4096;
constexpr size_t OFF_KAT = 205 * MiB, OFF_Z2T = 221 * MiB;
constexpr size_t OFF_TW = 204 * MiB, OFF_BAR = 254 * MiB;
constexpr size_t OFF_X1 = 26 * MiB, OFF_HM = 90 * MiB, OFF_H = 122 * MiB;

struct Params {
  const float *x, *norm_mix_pre, *norm_mix_post, *norm_mlp_pre, *norm_mlp_post, *w_in, *b_gates, *conv_w, *conv_b,
      *mlstm_norm_w, *hyena_norm_w, *filt_w1, *filt_b1, *filt_w2, *filt_b2, *filt_w3, *filt_b3, *filt_w4, *filt_freq,
      *filt_bias, *w_out, *w_mlp_in, *w_mlp_out;
  float* out;
  char* ws;
};

DI u16 f2bf(float x) { unsigned u = __float_as_uint(x); u += 0x7fffu + ((u >> 16) & 1u); return (u16)(u >> 16); }
DI float bf2f(u16 v) { return __uint_as_float(((unsigned)v) << 16); }
DI int opaque_tid() { int t = threadIdx.x; asm volatile("" : "+v"(t)); return t; }
DI int crow(int r, int hh) { return (r & 3) + 8 * (r >> 2) + 4 * hh; }
DI float log_sigmoid(float x) { return fminf(x, 0.f) - log1pf(expf(-fabsf(x))); }
DI float sigmoidf(float x) { return 1.f / (1.f + expf(-x)); }
DI float red2pi(float x) {
  const float k = rintf(x * 0.15915494309189535f);
  float r = fmaf(-k, 6.28125f, x);
  return fmaf(-k, 1.9353071795864769e-3f, r);
}
DI float fsin(float x) { return sinf(x); }
DI float fcos(float x) { return cosf(x); }
DI bf16x8 pack8(const float* v) {
  bf16x8 r;
#pragma unroll
  for (int i = 0; i < 8; ++i) r[i] = (short)f2bf(v[i]);
  return r;
}
DI bf16x8 scale8(bf16x8 a, float s) {
  bf16x8 r;
#pragma unroll
  for (int i = 0; i < 8; ++i) r[i] = (short)f2bf(bf2f((u16)a[i]) * s);
  return r;
}

template <bool SWAP>
DI void gemm_core(const u16* __restrict__ A, const u16* __restrict__ Bt, int K, int m0, int n0, char* smem, f32x16 (&acc)[2][2]) {
  const int tid = threadIdx.x, lane = tid & 63, wave = tid >> 6, wr = wave >> 1, wc = wave & 1;
  const int lr = lane & 31, hh = lane >> 5;
#pragma unroll
  for (int i = 0; i < 2; ++i)
#pragma unroll
    for (int j = 0; j < 2; ++j)
#pragma unroll
      for (int r = 0; r < 16; ++r) acc[i][j][r] = 0.f;
  const int c = tid & 7, r0 = tid >> 3;
  const u16* Ag = A + (size_t)(m0 + r0) * K + c * 8;
  const u16* Bg = Bt + (size_t)(n0 + r0) * K + c * 8;
  const int soff = r0 * 128 + ((c ^ ((r0 >> 1) & 7)) << 4);
  uint4 ra[4], rb[4];
#pragma unroll
  for (int i = 0; i < 4; ++i) {
    ra[i] = *(const uint4*)(Ag + (size_t)(32 * i) * K);
    rb[i] = *(const uint4*)(Bg + (size_t)(32 * i) * K);
  }
#pragma unroll
  for (int i = 0; i < 4; ++i) {
    *(uint4*)(smem + soff + i * 4096) = ra[i];
    *(uint4*)(smem + 16384 + soff + i * 4096) = rb[i];
  }
  __syncthreads();
  const int nk = K >> 6;
  for (int kt = 0; kt < nk; ++kt) {
    if (kt + 1 < nk) {
      const int k0 = (kt + 1) << 6;
#pragma unroll
      for (int i = 0; i < 4; ++i) {
        ra[i] = *(const uint4*)(Ag + (size_t)(32 * i) * K + k0);
        rb[i] = *(const uint4*)(Bg + (size_t)(32 * i) * K + k0);
      }
    }
    const char* As = smem + (kt & 1) * 32768;
    const char* Bs = As + 16384;
#pragma unroll
    for (int kk = 0; kk < 4; ++kk) {
      bf16x8 a[2], b[2];
      const int cc = kk * 2 + hh;
#pragma unroll
      for (int i = 0; i < 2; ++i) {
        const int r = wr * 64 + i * 32 + lr;
        a[i] = *(const bf16x8*)(As + r * 128 + ((cc ^ ((r >> 1) & 7)) << 4));
      }
#pragma unroll
      for (int j = 0; j < 2; ++j) {
        const int r = wc * 64 + j * 32 + lr;
        b[j] = *(const bf16x8*)(Bs + r * 128 + ((cc ^ ((r >> 1) & 7)) << 4));
      }
#pragma unroll
      for (int i = 0; i < 2; ++i)
#pragma unroll
        for (int j = 0; j < 2; ++j) acc[i][j] = SWAP ? MFMA(b[j], a[i], acc[i][j]) : MFMA(a[i], b[j], acc[i][j]);
    }
    if (kt + 1 < nk) {
      char* dst = smem + ((kt + 1) & 1) * 32768;
#pragma unroll
      for (int i = 0; i < 4; ++i) {
        *(uint4*)(dst + soff + i * 4096) = ra[i];
        *(uint4*)(dst + 16384 + soff + i * 4096) = rb[i];
      }
    }
    __syncthreads();
  }
}

DI void tile_map(int id, int ntn, int& mt, int& nt) {
  const int per = 16 * ntn;
  const int g = id / per, rem = id - g * per;
  mt = g * 16 + (rem & 15);
  nt = rem >> 4;
}

DI void transpose_tile(const float* __restrict__ src, int R, int C, u16* __restrict__ dst, int kt, int nt, char* smem) {
  float* tile = (float*)smem;
  const int tid = threadIdx.x;
  const int k0 = kt * 64, n0 = nt * 64;
#pragma unroll 4
  for (int it = 0; it < 16; ++it) {
    const int kk = it * 4 + (tid >> 6), nn = tid & 63;
    const int n = n0 + nn;
    tile[kk * 65 + nn] = (n < C) ? src[(size_t)(k0 + kk) * C + n] : 0.f;
  }
  __syncthreads();
#pragma unroll 4
  for (int it = 0; it < 16; ++it) {
    const int nn = it * 4 + (tid >> 6), kk = tid & 63;
    dst[(size_t)(n0 + nn) * R + k0 + kk] = f2bf(tile[kk * 65 + nn]);
  }
  __syncthreads();
}

DI float wave_sum(float v) {
#pragma unroll
  for (int o = 32; o; o >>= 1) v += __shfl_xor(v, o, 64);
  return v;
}

DI void filter_unit(const Params& p, int unit, char* smem) {
  float* sz = (float*)smem;
  float* hA = sz + 16 * 33;
  float* hB = hA + 16 * 64;
  const int tid = threadIdx.x;
  const int l0 = unit * 16;
  for (int idx = tid; idx < 16 * 33; idx += 256) {
    const int pp = idx / 33, f = idx - pp * 33;
    const float l = (float)(l0 + pp);
    float v;
    if (f == 0) v = l / 4095.f;
    else {
      const int jb = (f - 1) & 15;
      const float fj = 1e-4f + (float)jb * ((15.f - 1e-4f) / 15.f);
      const float ang = 6.283185307179586f * l / 4096.f;
      v = (f <= 16) ? fcos(fj * ang) : -fsin(fj * ang);
    }
    sz[idx] = v;
  }
  __syncthreads();
  {
    const int o = tid & 63;
#pragma unroll 1
    for (int i = 0; i < 4; ++i) {
      const int pp = (tid >> 6) + 4 * i;
      float s = p.filt_b1[o];
#pragma unroll 3
      for (int f = 0; f < 33; ++f) s += sz[pp * 33 + f] * p.filt_w1[f * 64 + o];
      hA[pp * 64 + o] = fsin(p.filt_freq[o] * s);
    }
  }
  __syncthreads();
  {
    const int o = tid & 63;
#pragma unroll 1
    for (int i = 0; i < 4; ++i) {
      const int pp = (tid >> 6) + 4 * i;
      float s = p.filt_b2[o];
#pragma unroll 4
      for (int k = 0; k < 64; ++k) s += hA[pp * 64 + k] * p.filt_w2[k * 64 + o];
      hB[pp * 64 + o] = fsin(p.filt_freq[64 + o] * s);
    }
  }
  __syncthreads();
  {
    const int o = tid & 63;
#pragma unroll 1
    for (int i = 0; i < 4; ++i) {
      const int pp = (tid >> 6) + 4 * i;
      float s = p.filt_b3[o];
#pragma unroll 4
      for (int k = 0; k < 64; ++k) s += hB[pp * 64 + k] * p.filt_w3[k * 64 + o];
      hA[pp * 64 + o] = fsin(p.filt_freq[128 + o] * s);
    }
  }
  __syncthreads();
  float* filt = (float*)(p.ws + OFF_FILT);
  const float min_decay = -3.0701134573253944f, max_decay = -15.350567286626973f;
#pragma unroll 1
  for (int cc = 0; cc < 8; ++cc) {
    const int col = tid + 256 * cc;
    float acc[16];
#pragma unroll
    for (int q = 0; q < 16; ++q) acc[q] = 0.f;
#pragma unroll 2
    for (int k = 0; k < 64; ++k) {
      const float w = p.filt_w4[k * 2048 + col];
#pragma unroll
      for (int q = 0; q < 16; ++q) acc[q] += hA[q * 64 + k] * w;
    }
    const int ch = col & 511;
    const float delta = fabsf(min_decay + (float)ch * ((max_decay - min_decay) / 511.f));
#pragma unroll
    for (int q = 0; q < 16; ++q) {
      const float t = (float)(l0 + q) / 4095.f;
      acc[q] *= expf(-t * delta);
    }
    float4* dst = (float4*)(filt + (size_t)col * 4096 + l0);
    dst[0] = make_float4(acc[0], acc[1], acc[2], acc[3]);
    dst[1] = make_float4(acc[4], acc[5], acc[6], acc[7]);
    dst[2] = make_float4(acc[8], acc[9], acc[10], acc[11]);
    dst[3] = make_float4(acc[12], acc[13], acc[14], acc[15]);
  }
  __syncthreads();
}

DI void phase0(const Params& p, char* smem) {
  const int tid = threadIdx.x, lane = tid & 63, wave = tid >> 6;
  const int U_W = 32, U_F = 256, U_X = 1024, U_T1 = 58 * 16, U_T2 = 256, U_T3 = 1024, U_T4 = 1024;
  const int total = U_W + U_F + U_X + U_T1 + U_T2 + U_T3 + U_T4;
  for (int u = blockIdx.x; u < total; u += gridDim.x) {
    int v = u;
    if (v < U_W) {
      const int idx = v * 256 + tid;
      if (idx < 8191) {
        const int lh = 31 - __clz(idx + 1);
        const int h = 1 << lh, jj = idx + 1 - h;
        float2* twp = (float2*)(p.ws + OFF_TW);
        const float ang = -3.14159265358979f * (float)jj / (float)h;
        twp[idx] = make_float2(cosf(ang), sinf(ang));
      }
      continue;
    }
    v -= U_W;
    if (v < U_F) { filter_unit(p, v, smem); continue; }
    v -= U_F;
    if (v < U_X) {
      u16* xn = (u16*)(p.ws + OFF_XN);
#pragma unroll 1
      for (int rr = 0; rr < 4; ++rr) {
        const int row = v * 16 + wave * 4 + rr;
        const float4* xr = (const float4*)(p.x + (size_t)row * DM);
        float4 xv[4];
        float ss = 0.f;
#pragma unroll
        for (int i = 0; i < 4; ++i) {
          xv[i] = xr[lane + 64 * i];
          ss += xv[i].x * xv[i].x + xv[i].y * xv[i].y + xv[i].z * xv[i].z + xv[i].w * xv[i].w;
        }
        ss = wave_sum(ss);
        const float rs = rsqrtf(ss * (1.f / DM) + EPS);
#pragma unroll
        for (int i = 0; i < 4; ++i) {
          const float4 w = ((const float4*)p.norm_mix_pre)[lane + 64 * i];
          ushort4 o;
          o.x = f2bf(xv[i].x * rs * w.x); o.y = f2bf(xv[i].y * rs * w.y); o.z = f2bf(xv[i].z * rs * w.z); o.w = f2bf(xv[i].w * rs * w.w);
          *(ushort4*)(xn + (size_t)row * DM + (lane + 64 * i) * 4) = o;
        }
      }
      continue;
    }
    v -= U_X;
    if (v < U_T1) { transpose_tile(p.w_in, DM, NIN, (u16*)(p.ws + OFF_WINT), v & 15, v >> 4, smem); continue; }
    v -= U_T1;
    if (v < U_T2) { transpose_tile(p.w_out, DM, DM, (u16*)(p.ws + OFF_WOUTT), v & 15, v >> 4, smem); continue; }
    v -= U_T2;
    if (v < U_T3) { transpose_tile(p.w_mlp_in, DM, DFF, (u16*)(p.ws + OFF_W1T), v & 15, v >> 4, smem); continue; }
    v -= U_T3;
    transpose_tile(p.w_mlp_out, DFF, DM, (u16*)(p.ws + OFF_W2T), v & 63, v >> 6, smem);
  }
}

DI void phase1(const Params& p, char* smem) {
  const int tid = threadIdx.x, lane = tid & 63, wave = tid >> 6, wr = wave >> 1, wc = wave & 1, lr = lane & 31, hh = lane >> 5;
  const u16* xn = (const u16*)(p.ws + OFF_XN);
  const u16* wt = (const u16*)(p.ws + OFF_WINT);
  u16* qkpre = (u16*)(p.ws + OFF_QKPRE);
  u16* hyT = (u16*)(p.ws + OFF_HYT);
  u16* vT = (u16*)(p.ws + OFF_VT);
  u16* og = (u16*)(p.ws + OFF_OG);
  float* gates = (float*)(p.ws + OFF_GATES);
  const int ntn = 29, ntiles = 128 * ntn;
  for (int id = blockIdx.x; id < ntiles; id += gridDim.x) {
    int mt, nt;
    tile_map(id, ntn, mt, nt);
    const int m0 = mt * 128, n0 = nt * 128;
    f32x16 acc[2][2];
    const bool swap = (nt >= 8 && nt < 24);
    if (swap) gemm_core<true>(xn, wt, DM, m0, n0, smem, acc);
    else gemm_core<false>(xn, wt, DM, m0, n0, smem, acc);
#pragma unroll
    for (int i = 0; i < 2; ++i)
#pragma unroll
      for (int j = 0; j < 2; ++j)
#pragma unroll
        for (int r = 0; r < 16; ++r) {
          const float val = acc[i][j][r];
          if (!swap) {
            const int row = m0 + wr * 64 + i * 32 + crow(r, hh);
            const int col = n0 + wc * 64 + j * 32 + lr;
            if (nt < 8) qkpre[(size_t)row * 1024 + col] = f2bf(val);
            else if (nt < 28) og[(size_t)row * 512 + (col - 3072)] = f2bf(sigmoidf(val));
            else if (col < 3600) gates[(size_t)row * 16 + (col - 3584)] = val;
          } else {
            const int n = n0 + wc * 64 + j * 32 + crow(r, hh);
            const int m = m0 + wr * 64 + i * 32 + lr;
            const int b = m >> 12, t = m & 4095;
            if (nt < 20) {
              const int cc = n - 1024, g = cc >> 9, ch = cc & 511;
              hyT[((size_t)((g * 4 + b) * 512 + ch)) * 4096 + t] = f2bf(val);
            } else {
              const int cc = n - 2560;
              vT[((size_t)(b * 512 + cc)) * 4096 + t] = f2bf(val);
            }
          }
        }
  }
}

DI void phase_qk(const Params& p, char* smem) {
  u16* tile = (u16*)smem;
  const int tid = threadIdx.x;
  const u16* qkpre = (const u16*)(p.ws + OFF_QKPRE);
  u16* qa = (u16*)(p.ws + OFF_QA);
  u16* ka = (u16*)(p.ws + OFF_KA);
  u16* kaT = (u16*)(p.ws + OFF_KAT);
  for (int u = blockIdx.x; u < 4096; u += gridDim.x) {
    const int ct = u & 15, tt = u >> 4;
    const int C = ct * 64 + (tid & 63);
    const float w0 = p.conv_w[C], w1 = p.conv_w[2560 + C], w2 = p.conv_w[5120 + C], cb = p.conv_b[C];
#pragma unroll 4
    for (int i = 0; i < 16; ++i) {
      const int row = (tid >> 6) + 4 * i;
      const int T = tt * 64 + row, t = T & 4095;
      const float pm = t > 0 ? bf2f(qkpre[(size_t)(T - 1) * 1024 + C]) : 0.f;
      const float p0 = bf2f(qkpre[(size_t)T * 1024 + C]);
      const float pp = t < 4095 ? bf2f(qkpre[(size_t)(T + 1) * 1024 + C]) : 0.f;
      const float val = w0 * pm + w1 * p0 + w2 * pp + cb;
      float s = val * sigmoidf(val);
      if (C < 512) qa[(size_t)T * 512 + C] = f2bf(s);
      else {
        s *= 0.08838834764831845f;
        const u16 sb = f2bf(s);
        ka[(size_t)T * 512 + (C - 512)] = sb;
        tile[(tid & 63) * 66 + row] = sb;
      }
    }
    if (ct >= 8) {
      __syncthreads();
      const int b = (tt * 64) >> 12, t0 = (tt * 64) & 4095;
      const int d0 = (ct - 8) * 64;
#pragma unroll 4
      for (int i = 0; i < 16; ++i) {
        const int dl = (tid >> 6) + 4 * i, tl = tid & 63;
        kaT[((size_t)(b * 512 + d0 + dl)) * 4096 + t0 + tl] = tile[dl * 66 + tl];
      }
      __syncthreads();
    }
  }
}

DI void fft_fwd(float2* x, int tid, const float2* __restrict__ tw) {
#ifdef DBG_NOFFT
  __syncthreads(); return;
#endif
#pragma unroll 1
  for (int lh = 12; lh >= 0; --lh) {
    const int h = 1 << lh;
    __syncthreads();
#pragma unroll 4
    for (int i = 0; i < 16; ++i) {
      const int k = tid + (i << 8);
      const int j = k & (h - 1);
      const int i0 = ((k - j) << 1) + j;
      const float2 a = x[i0], b = x[i0 + h];
      const float2 w = tw[(h - 1) + j];
      const float cs = w.x, sn = w.y;
      const float dx = a.x - b.x, dy = a.y - b.y;
      x[i0] = make_float2(a.x + b.x, a.y + b.y);
      x[i0 + h] = make_float2(dx * cs - dy * sn, dx * sn + dy * cs);
    }
  }
  __syncthreads();
}
DI void fft_inv(float2* x, int tid, const float2* __restrict__ tw) {
#ifdef DBG_NOFFT
  __syncthreads(); return;
#endif
#pragma unroll 1
  for (int lh = 0; lh <= 12; ++lh) {
    const int h = 1 << lh;
    __syncthreads();
#pragma unroll 4
    for (int i = 0; i < 16; ++i) {
      const int k = tid + (i << 8);
      const int j = k & (h - 1);
      const int i0 = ((k - j) << 1) + j;
      const float2 a = x[i0], b = x[i0 + h];
      const float2 w = tw[(h - 1) + j];
      const float cs = w.x, sn = -w.y;
      const float bx = b.x * cs - b.y * sn, by = b.x * sn + b.y * cs;
      x[i0] = make_float2(a.x + bx, a.y + by);
      x[i0 + h] = make_float2(a.x - bx, a.y - by);
    }
  }
  __syncthreads();
}

DI float hy_conv(const u16* __restrict__ pr, int t, float w0, float w1, float w2, float cb) {
  const float a = t > 0 ? bf2f(pr[t - 1]) : 0.f;
  const float b = bf2f(pr[t]);
  const float c = t < 4095 ? bf2f(pr[t + 1]) : 0.f;
  return w0 * a + w1 * b + w2 * c + cb;
}

DI void hyena_unit(const Params& p, int ch, char* smem) {
  float2* buf = (float2*)smem;
  const int tid = opaque_tid();
  const u16* hyT = (const u16*)(p.ws + OFF_HYT);
  const float* filt = (const float*)(p.ws + OFF_FILT);
  float* z2T = (float*)(p.ws + OFF_Z2T);
  const float2* tw = (const float2*)(p.ws + OFF_TW);
  float2 Kr[32];
#pragma unroll 1
  for (int ord = 0; ord < 2; ++ord) {
    const float* kf = filt + (size_t)((0 * 2 + ord) * 512 + ch) * 4096;
    const float* kb = filt + (size_t)((1 * 2 + ord) * 512 + ch) * 4096;
    const float fb = p.filt_bias[ord * 512 + ch];
    __syncthreads();
#pragma unroll 4
    for (int n = tid; n < 8192; n += 256) {
      float v;
      if (n < 4096) v = kf[n];
      else if (n == 4096) v = 0.f;
      else v = kb[8192 - n];
      if (n == 0) v += fb;
      buf[n] = make_float2(v, 0.f);
    }
    fft_fwd(buf, tid, tw);
#pragma unroll
    for (int j = 0; j < 32; ++j) {
      const float2 v = buf[tid + 256 * j];
      Kr[j] = make_float2(v.x * (1.f / 8192.f), v.y * (1.f / 8192.f));
    }
    const int gcol = 1024 + (1 + ord) * 512 + ch;
    const float gw0 = p.conv_w[gcol], gw1 = p.conv_w[2560 + gcol], gw2 = p.conv_w[5120 + gcol], gcb = p.conv_b[gcol];
    const int vcol = 1024 + ch;
    const float vw0 = p.conv_w[vcol], vw1 = p.conv_w[2560 + vcol], vw2 = p.conv_w[5120 + vcol], vcb = p.conv_b[vcol];
#pragma unroll 1
    for (int pr = 0; pr < 2; ++pr) {
      const int b0 = 2 * pr, b1 = 2 * pr + 1;
      __syncthreads();
      if (ord == 0) {
        const u16* u0 = hyT + ((size_t)((0 * 4 + b0) * 512 + ch)) * 4096;
        const u16* u1 = hyT + ((size_t)((0 * 4 + b1) * 512 + ch)) * 4096;
#pragma unroll 2
        for (int i = 0; i < 16; ++i) {
          const int t = tid + 256 * i;
          buf[t] = make_float2(hy_conv(u0, t, vw0, vw1, vw2, vcb), hy_conv(u1, t, vw0, vw1, vw2, vcb));
          buf[4096 + t] = make_float2(0.f, 0.f);
        }
      } else {
        const float* u0 = z2T + ((size_t)(b0 * 512 + ch)) * 4096;
        const float* u1 = z2T + ((size_t)(b1 * 512 + ch)) * 4096;
#pragma unroll 4
        for (int i = 0; i < 16; ++i) {
          const int t = tid + 256 * i;
          buf[t] = make_float2(u0[t], u1[t]);
          buf[4096 + t] = make_float2(0.f, 0.f);
        }
      }
      fft_fwd(buf, tid, tw);
#pragma unroll
      for (int j = 0; j < 32; ++j) {
        const float2 v = buf[tid + 256 * j];
        buf[tid + 256 * j] = make_float2(v.x * Kr[j].x - v.y * Kr[j].y, v.x * Kr[j].y + v.y * Kr[j].x);
      }
      fft_inv(buf, tid, tw);
      const u16* g0 = hyT + ((size_t)(((1 + ord) * 4 + b0) * 512 + ch)) * 4096;
      const u16* g1 = hyT + ((size_t)(((1 + ord) * 4 + b1) * 512 + ch)) * 4096;
      float* o0 = z2T + ((size_t)(b0 * 512 + ch)) * 4096;
      float* o1 = z2T + ((size_t)(b1 * 512 + ch)) * 4096;
#pragma unroll 2
      for (int i = 0; i < 16; ++i) {
        const int t = tid + 256 * i;
        const float2 y = buf[t];
        o0[t] = hy_conv(g0, t, gw0, gw1, gw2, gcb) * y.x;
        o1[t] = hy_conv(g1, t, gw0, gw1, gw2, gcb) * y.y;
      }
    }
  }
  __syncthreads();
}

DI void mlstm_local_unit(const Params& p, int u, char* smem) {
  float* s_gi = (float*)smem;
  float* s_lf = s_gi + 128;
  float* s_a = s_lf + 128;
  float* s_w = s_a + 128;
  const int tid = opaque_tid(), lane = tid & 63, wave = tid >> 6, lr = lane & 31, hh = lane >> 5;
  const int j = u & 31, dir = (u >> 5) & 1, bh = u >> 6, h = bh & 3, b = bh >> 2;
  const int T0 = b * 4096 + j * 128;
  const float* gates = (const float*)(p.ws + OFF_GATES);
  const u16* vT = (const u16*)(p.ws + OFF_VT);
  const u16* kaT = (const u16*)(p.ws + OFF_KAT);
  float* CL = p.out;
  float* nl = (float*)(p.ws + OFF_NL);
  float* mloc = (float*)(p.ws + OFF_MLOC);
  float* gsum = (float*)(p.ws + OFF_GSUM);
  __syncthreads();
  if (tid < 128) {
    const int T = T0 + tid;
    s_gi[tid] = gates[(size_t)T * 16 + dir * 8 + h] + p.b_gates[dir * 8 + h];
    s_lf[tid] = log_sigmoid(gates[(size_t)T * 16 + dir * 8 + 4 + h] + p.b_gates[dir * 8 + 4 + h]);
  }
  __syncthreads();
  float gtot = 0.f;
  if (tid < 128) {
    float pre = 0.f;
#pragma unroll 4
    for (int m = 0; m < 128; ++m) {
      const float v = s_lf[m];
      if (m < tid) pre += v;
      gtot += v;
    }
    s_a[tid] = (dir == 0) ? (gtot - pre - s_lf[tid] + s_gi[tid]) : (pre + s_gi[tid]);
  }
  __syncthreads();
  if (tid < 128) {
    float mx = -3.0e38f;
#pragma unroll 4
    for (int m = 0; m < 128; ++m) mx = fmaxf(mx, s_a[m]);
    s_w[tid] = expf(s_a[tid] - mx);
    if (tid == 0) { mloc[u] = mx; gsum[u] = gtot; }
  }
  __syncthreads();
  f32x16 acc[4];
#pragma unroll
  for (int d = 0; d < 4; ++d)
#pragma unroll
    for (int r = 0; r < 16; ++r) acc[d][r] = 0.f;
  const u16* vrow = vT + ((size_t)(bh * 128 + wave * 32 + lr)) * 4096 + j * 128 + hh * 8;
  const u16* kbase = kaT + ((size_t)(bh * 128 + lr)) * 4096 + j * 128 + hh * 8;
#pragma unroll 2
  for (int ks = 0; ks < 8; ++ks) {
    const bf16x8 av = *(const bf16x8*)(vrow + ks * 16);
    bf16x8 a;
#pragma unroll
    for (int i = 0; i < 8; ++i) a[i] = (short)f2bf(bf2f((u16)av[i]) * s_w[ks * 16 + hh * 8 + i]);
#pragma unroll
    for (int dt = 0; dt < 4; ++dt) {
      const bf16x8 bk = *(const bf16x8*)(kbase + (size_t)(dt * 32) * 4096 + ks * 16);
      acc[dt] = MFMA(a, bk, acc[dt]);
    }
  }
  float* dst = CL + (size_t)u * 16384;
#pragma unroll
  for (int dt = 0; dt < 4; ++dt)
#pragma unroll
    for (int r = 0; r < 16; ++r) dst[(wave * 32 + crow(r, hh)) * 128 + dt * 32 + lr] = acc[dt][r];
  if (tid < 128) {
    const u16* kr = kaT + ((size_t)(bh * 128 + tid)) * 4096 + j * 128;
    float s = 0.f;
#pragma unroll 2
    for (int l = 0; l < 128; l += 8) {
      const bf16x8 kv = *(const bf16x8*)(kr + l);
#pragma unroll
      for (int i = 0; i < 8; ++i) s += s_w[l + i] * bf2f((u16)kv[i]);
    }
    nl[(size_t)u * 128 + tid] = s;
  }
}

DI void scan_unit(const Params& p, int unit) {
  const int tid = opaque_tid();
  const int sc = unit >> 4, part = unit & 15, dir = sc & 1;
  float* CL = p.out;
  float* nl = (float*)(p.ws + OFF_NL);
  const float* mloc = (const float*)(p.ws + OFF_MLOC);
  const float* gsum = (const float*)(p.ws + OFF_GSUM);
  float* ms = (float*)(p.ws + OFF_MS);
  const int idx = part * 1024 + tid * 4;
  float4 C = make_float4(0.f, 0.f, 0.f, 0.f);
  float nst = 0.f, m = 0.f;
  const bool do_n = (part == 0) && (tid < 128);
  float4 pf[4];
#pragma unroll
  for (int q = 0; q < 4; ++q) {
    const int jj = dir ? 31 - q : q;
    pf[q] = *(const float4*)(CL + (size_t)(sc * 32 + jj) * 16384 + idx);
  }
#pragma unroll 1
  for (int c0 = 0; c0 < 32; c0 += 4) {
#pragma unroll
    for (int q = 0; q < 4; ++q) {
      const int c = c0 + q;
      const int jj = dir ? 31 - c : c;
      const int u = sc * 32 + jj;
      const float4 cl = pf[q];
      *(float4*)(CL + (size_t)u * 16384 + idx) = C;
      if (c + 4 < 32) {
        const int j2 = dir ? 31 - (c + 4) : (c + 4);
        pf[q] = *(const float4*)(CL + (size_t)(sc * 32 + j2) * 16384 + idx);
      }
      const float g = gsum[u], ml = mloc[u];
      const float mn = fmaxf(g + m, ml);
      const float dec = expf(g + m - mn), scl = expf(ml - mn);
      C.x = dec * C.x + scl * cl.x; C.y = dec * C.y + scl * cl.y; C.z = dec * C.z + scl * cl.z; C.w = dec * C.w + scl * cl.w;
      if (do_n) {
        const float nv = nl[(size_t)u * 128 + tid];
        nl[(size_t)u * 128 + tid] = nst;
        nst = dec * nst + scl * nv;
      }
      if (part == 0 && tid == 0) ms[u] = m;
      m = mn;
    }
  }
}

template <int DIR>
DI void mlstm_dir(const Params& p, int bh, int j, char* smem, f32x16 (&hs)[4]) {
  float* s_gi = (float*)smem;
  float* s_lf = s_gi + 128;
  float* s_bc = s_lf + 128;
  float* s_r = s_bc + 128;
  float* s_al = s_r + 128;
  float* s_fl = s_al + 128;
  float* s_is = s_fl + 128;
  const int tid = opaque_tid(), lane = tid & 63, wave = tid >> 6, lr = lane & 31, hh = lane >> 5;
  u16* Pl = (u16*)(smem + 4096) + wave * (32 * 136);
  const int h = bh & 3, b = bh >> 2;
  const int T0 = b * 4096 + j * 128;
  const float* gates = (const float*)(p.ws + OFF_GATES);
  const u16* qa = (const u16*)(p.ws + OFF_QA);
  const u16* ka = (const u16*)(p.ws + OFF_KA);
  const u16* vT = (const u16*)(p.ws + OFF_VT);
  const float* CS = p.out;
  const float* ns = (const float*)(p.ws + OFF_NL);
  const float* ms = (const float*)(p.ws + OFF_MS);
  u16* A2 = (u16*)(p.ws + OFF_A2);
  bf16x8 ones;
#pragma unroll
  for (int i = 0; i < 8; ++i) ones[i] = (short)0x3F80;
  const u16* qrow = qa + (size_t)(T0 + wave * 32 + lr) * 512 + h * 128 + hh * 8;
  const int u = (bh * 2 + DIR) * 32 + j;
  const float msu = ms[u];
  __syncthreads();
  if (tid < 128) {
    const int T = T0 + tid;
    s_gi[tid] = gates[(size_t)T * 16 + DIR * 8 + h] + p.b_gates[DIR * 8 + h];
    s_lf[tid] = log_sigmoid(gates[(size_t)T * 16 + DIR * 8 + 4 + h] + p.b_gates[DIR * 8 + 4 + h]);
  }
  __syncthreads();
  if (tid < 128) {
    float a = 0.f;
#pragma unroll 4
    for (int m = 0; m < 128; ++m) {
      const bool in = (DIR == 0) ? (m <= tid) : (m >= tid);
      a += in ? s_lf[m] : 0.f;
    }
    s_bc[tid] = a;
    s_r[tid] = s_gi[tid] - a;
  }
  __syncthreads();
  if (tid < 128) {
    float cm = -3.0e38f;
#pragma unroll 4
    for (int m = 0; m < 128; ++m) {
      const bool in = (DIR == 0) ? (m <= tid) : (m >= tid);
      cm = in ? fmaxf(cm, s_r[m]) : cm;
    }
    const float bc = s_bc[tid];
    const float mt = bc + fmaxf(msu, cm);
    s_al[tid] = bc - mt;
    s_fl[tid] = expf(-mt);
    s_is[tid] = expf(bc + msu - mt);
  }
  __syncthreads();
  {
    f32x16 S[4];
#pragma unroll
    for (int st = 0; st < 4; ++st)
#pragma unroll
      for (int r = 0; r < 16; ++r) S[st][r] = 0.f;
    const u16* kbase = ka + (size_t)(T0 + lr) * 512 + h * 128 + hh * 8;
#pragma unroll 2
    for (int ks = 0; ks < 8; ++ks) {
      const bf16x8 a = *(const bf16x8*)(qrow + ks * 16);
#pragma unroll
      for (int st = 0; st < 4; ++st) {
        const bf16x8 bk = *(const bf16x8*)(kbase + (size_t)(st * 32) * 512 + ks * 16);
        S[st] = MFMA(a, bk, S[st]);
      }
    }
#pragma unroll
    for (int st = 0; st < 4; ++st) {
      const int sl = st * 32 + lr;
      const float rs = s_r[sl];
#pragma unroll
      for (int r = 0; r < 16; ++r) {
        const int tl = wave * 32 + crow(r, hh);
        const bool valid = (DIR == 0) ? (sl <= tl) : (sl >= tl);
        const float pv = valid ? S[st][r] * __expf(s_al[tl] + rs) : 0.f;
        Pl[crow(r, hh) * 136 + sl] = f2bf(pv);
      }
    }
  }
  __syncthreads();
#pragma unroll
  for (int eh = 0; eh < 2; ++eh) {
    f32x16 N[3];
#pragma unroll
    for (int e = 0; e < 3; ++e)
#pragma unroll
      for (int r = 0; r < 16; ++r) N[e][r] = 0.f;
    {
      const u16* vbase = vT + ((size_t)(bh * 128 + eh * 64 + lr)) * 4096 + j * 128 + hh * 8;
#pragma unroll 2
      for (int ks = 0; ks < 8; ++ks) {
        const bf16x8 a = *(const bf16x8*)(Pl + lr * 136 + ks * 16 + hh * 8);
#pragma unroll
        for (int e2 = 0; e2 < 2; ++e2) {
          const bf16x8 bv = *(const bf16x8*)(vbase + (size_t)(e2 * 32) * 4096 + ks * 16);
          N[e2] = MFMA(a, bv, N[e2]);
        }
        N[2] = MFMA(a, ones, N[2]);
      }
    }
    {
      const float isc = s_is[wave * 32 + lr];
      const float* cbase = CS + (size_t)u * 16384 + (size_t)(eh * 64 + lr) * 128 + hh * 8;
      const float* nbase = ns + (size_t)u * 128 + hh * 8;
#pragma unroll 2
      for (int ks = 0; ks < 8; ++ks) {
        const bf16x8 aq = *(const bf16x8*)(qrow + ks * 16);
        const bf16x8 a = scale8(aq, isc);
#pragma unroll
        for (int e2 = 0; e2 < 2; ++e2) {
          const float4 c0 = *(const float4*)(cbase + (size_t)(e2 * 32) * 128 + ks * 16);
          const float4 c1 = *(const float4*)(cbase + (size_t)(e2 * 32) * 128 + ks * 16 + 4);
          const float cv[8] = {c0.x, c0.y, c0.z, c0.w, c1.x, c1.y, c1.z, c1.w};
          N[e2] = MFMA(a, pack8(cv), N[e2]);
        }
        const float4 n0 = *(const float4*)(nbase + ks * 16);
        const float4 n1 = *(const float4*)(nbase + ks * 16 + 4);
        const float nv[8] = {n0.x, n0.y, n0.z, n0.w, n1.x, n1.y, n1.z, n1.w};
        N[2] = MFMA(a, pack8(nv), N[2]);
      }
    }
#pragma unroll
    for (int r = 0; r < 16; ++r) {
      const int tl = wave * 32 + crow(r, hh);
      const float den = fmaxf(fabsf(N[2][r]), s_fl[tl]);
      const float inv = 1.f / den;
#pragma unroll
      for (int e2 = 0; e2 < 2; ++e2) {
        const float hv = N[e2][r] * inv;
        u16* tp = A2 + (size_t)(T0 + tl) * 1024 + h * 128 + (eh * 2 + e2) * 32 + lr;
        if (DIR == 0) *tp = f2bf(hv);
        else hs[eh * 2 + e2][r] = hv + bf2f(*tp);
      }
    }
  }
}

DI void mlstm_out_unit(const Params& p, int unit, char* smem) {
  const int tid = opaque_tid(), lane = tid & 63, wave = tid >> 6, lr = lane & 31, hh = lane >> 5;
  const int j = unit & 31, bh = unit >> 5, h = bh & 3, b = bh >> 2;
  const int T0 = b * 4096 + j * 128;
  const u16* og = (const u16*)(p.ws + OFF_OG);
  u16* A2 = (u16*)(p.ws + OFF_A2);
  f32x16 hs[4];
  mlstm_dir<0>(p, bh, j, smem, hs);
  mlstm_dir<1>(p, bh, j, smem, hs);
#pragma unroll
  for (int r = 0; r < 16; ++r) {
    const int T = T0 + wave * 32 + crow(r, hh);
    float ss = 0.f;
#pragma unroll
    for (int et = 0; et < 4; ++et) {
      const float o = bf2f(og[(size_t)T * 512 + h * 128 + et * 32 + lr]);
      hs[et][r] *= o;
      ss += hs[et][r] * hs[et][r];
    }
#pragma unroll
    for (int o = 1; o < 32; o <<= 1) ss += __shfl_xor(ss, o, 64);
    const float rs = rsqrtf(ss * (1.f / 128.f) + EPS);
#pragma unroll
    for (int et = 0; et < 4; ++et) {
      const int e = h * 128 + et * 32 + lr;
      A2[(size_t)T * 1024 + e] = f2bf(hs[et][r] * rs * p.mlstm_norm_w[e]);
    }
  }
}

DI void hyena_norm_unit(const Params& p, int unit, char* smem) {
  float* tile = (float*)smem;
  const int tid = opaque_tid();
  const int tt = unit & 63, g = (unit >> 6) & 7, b = unit >> 9;
  const float* z2T = (const float*)(p.ws + OFF_Z2T);
  u16* A2 = (u16*)(p.ws + OFF_A2);
  __syncthreads();
#pragma unroll 4
  for (int i = 0; i < 16; ++i) {
    const int cl = (tid >> 6) + 4 * i, tl = tid & 63;
    tile[cl * 65 + tl] = z2T[((size_t)(b * 512 + g * 64 + cl)) * 4096 + tt * 64 + tl];
  }
  __syncthreads();
  const int tl = tid >> 2, qd = tid & 3;
  float v[16];
  float ss = 0.f;
#pragma unroll
  for (int i = 0; i < 16; ++i) {
    v[i] = tile[(qd * 16 + i) * 65 + tl];
    ss += v[i] * v[i];
  }
  ss += __shfl_xor(ss, 1, 64);
  ss += __shfl_xor(ss, 2, 64);
  const float rs = rsqrtf(ss * (1.f / 64.f) + EPS);
  const size_t T = (size_t)b * 4096 + tt * 64 + tl;
  u16* dst = A2 + T * 1024 + 512 + g * 64 + qd * 16;
  const float* w = p.hyena_norm_w + g * 64 + qd * 16;
  float o[16];
#pragma unroll
  for (int i = 0; i < 16; ++i) o[i] = v[i] * rs * w[i];
  *(bf16x8*)(dst) = pack8(o);
  *(bf16x8*)(dst + 8) = pack8(o + 8);
}

template <int EPI>
DI void gemm_phase(const u16* A, const u16* Bt, int K, int ntn, void* outp, char* smem) {
  const int tid = threadIdx.x, lane = tid & 63, wave = tid >> 6, wr = wave >> 1, wc = wave & 1, lr = lane & 31, hh = lane >> 5;
  const int ntiles = 128 * ntn;
  for (int id = blockIdx.x; id < ntiles; id += gridDim.x) {
    int mt, nt;
    tile_map(id, ntn, mt, nt);
    const int m0 = mt * 128, n0 = nt * 128;
    f32x16 acc[2][2];
    gemm_core<false>(A, Bt, K, m0, n0, smem, acc);
#pragma unroll
    for (int i = 0; i < 2; ++i)
#pragma unroll
      for (int j = 0; j < 2; ++j)
#pragma unroll
        for (int r = 0; r < 16; ++r) {
          const int row = m0 + wr * 64 + i * 32 + crow(r, hh);
          const int col = n0 + wc * 64 + j * 32 + lr;
          const float val = acc[i][j][r];
          if (EPI == 0) ((float*)outp)[(size_t)row * 1024 + col] = val;
          else {
            const float rl = fmaxf(val, 0.f);
            ((u16*)outp)[(size_t)row * 4096 + col] = f2bf(rl * rl);
          }
        }
  }
}

DI void phase_post_mix(const Params& p) {
  const int tid = threadIdx.x, lane = tid & 63, wave = tid >> 6;
  const float* mix = p.out;
  float* x1 = (float*)(p.ws + OFF_X1);
  u16* hm = (u16*)(p.ws + OFF_HM);
  for (int u = blockIdx.x; u < 1024; u += gridDim.x) {
#pragma unroll 1
    for (int rr = 0; rr < 4; ++rr) {
      const size_t row = (size_t)u * 16 + wave * 4 + rr;
      float4 mv[4], xv[4];
      float ss = 0.f;
#pragma unroll
      for (int i = 0; i < 4; ++i) {
        mv[i] = ((const float4*)(mix + row * DM))[lane + 64 * i];
        xv[i] = ((const float4*)(p.x + row * DM))[lane + 64 * i];
        ss += mv[i].x * mv[i].x + mv[i].y * mv[i].y + mv[i].z * mv[i].z + mv[i].w * mv[i].w;
      }
      ss = wave_sum(ss);
      const float rs = rsqrtf(ss * (1.f / DM) + EPS);
      float s2 = 0.f;
#pragma unroll
      for (int i = 0; i < 4; ++i) {
        const float4 w = ((const float4*)p.norm_mix_post)[lane + 64 * i];
        xv[i].x += mv[i].x * rs * w.x; xv[i].y += mv[i].y * rs * w.y; xv[i].z += mv[i].z * rs * w.z; xv[i].w += mv[i].w * rs * w.w;
        s2 += xv[i].x * xv[i].x + xv[i].y * xv[i].y + xv[i].z * xv[i].z + xv[i].w * xv[i].w;
        ((float4*)(x1 + row * DM))[lane + 64 * i] = xv[i];
      }
      s2 = wave_sum(s2);
      const float r2 = rsqrtf(s2 * (1.f / DM) + EPS);
#pragma unroll
      for (int i = 0; i < 4; ++i) {
        const float4 w = ((const float4*)p.norm_mlp_pre)[lane + 64 * i];
        ushort4 o;
        o.x = f2bf(xv[i].x * r2 * w.x); o.y = f2bf(xv[i].y * r2 * w.y); o.z = f2bf(xv[i].z * r2 * w.z); o.w = f2bf(xv[i].w * r2 * w.w);
        *(ushort4*)(hm + row * DM + (lane + 64 * i) * 4) = o;
      }
    }
  }
}

DI void phase_final(const Params& p) {
  const int tid = threadIdx.x, lane = tid & 63, wave = tid >> 6;
  const float* x1 = (const float*)(p.ws + OFF_X1);
  for (int u = blockIdx.x; u < 1024; u += gridDim.x) {
#pragma unroll 1
    for (int rr = 0; rr < 4; ++rr) {
      const size_t row = (size_t)u * 16 + wave * 4 + rr;
      float4 fv[4];
      float ss = 0.f;
#pragma unroll
      for (int i = 0; i < 4; ++i) {
        fv[i] = ((const float4*)(p.out + row * DM))[lane + 64 * i];
        ss += fv[i].x * fv[i].x + fv[i].y * fv[i].y + fv[i].z * fv[i].z + fv[i].w * fv[i].w;
      }
      ss = wave_sum(ss);
      const float rs = rsqrtf(ss * (1.f / DM) + EPS);
#pragma unroll
      for (int i = 0; i < 4; ++i) {
        const float4 w = ((const float4*)p.norm_mlp_post)[lane + 64 * i];
        const float4 xv = ((const float4*)(x1 + row * DM))[lane + 64 * i];
        float4 o;
        o.x = xv.x + fv[i].x * rs * w.x; o.y = xv.y + fv[i].y * rs * w.y; o.z = xv.z + fv[i].z * rs * w.z; o.w = xv.w + fv[i].w * rs * w.w;
        ((float4*)(p.out + row * DM))[lane + 64 * i] = o;
      }
    }
  }
}

DI void run_phase(const Params& p, int ph, char* smem) {
  switch (ph) {
    case 0: phase0(p, smem); break;
    case 1: phase1(p, smem); break;
    case 2: phase_qk(p, smem); break;
    case 3:
      for (int u = blockIdx.x; u < 512 + 1024; u += gridDim.x) {
        if (u < 512) hyena_unit(p, u, smem);
        else mlstm_local_unit(p, u - 512, smem);
      }
      break;
    case 4:
      for (int u = blockIdx.x; u < 512; u += gridDim.x) scan_unit(p, u);
      break;
    case 5:
      for (int u = blockIdx.x; u < 512 + 2048; u += gridDim.x) {
#ifndef DBG_SKIP_MLSTM
        if (u < 512) mlstm_out_unit(p, u, smem);
#else
        if (u < 512) { u16* A2 = (u16*)(p.ws + OFF_A2); const int T0 = (u >> 5 >> 2) * 4096 + (u & 31) * 128, hq = (u >> 5) & 3;
          for (int i = threadIdx.x; i < 128 * 128; i += 256) A2[(size_t)(T0 + (i >> 7)) * 1024 + hq * 128 + (i & 127)] = 0; }
#endif
#ifndef DBG_SKIP_HYENA
        else hyena_norm_unit(p, u - 512, smem);
#else
        else { const int un = u - 512; const int tt = un & 63, g = (un >> 6) & 7, b = un >> 9; u16* A2 = (u16*)(p.ws + OFF_A2);
          for (int i = threadIdx.x; i < 64 * 64; i += 256) A2[((size_t)b * 4096 + tt * 64 + (i >> 6)) * 1024 + 512 + g * 64 + (i & 63)] = 0x3F80; }
#endif
      }
      break;
    case 6: gemm_phase<0>((const u16*)(p.ws + OFF_A2), (const u16*)(p.ws + OFF_WOUTT), 1024, 8, p.out, smem); break;
    case 7: phase_post_mix(p); break;
    case 8: gemm_phase<1>((const u16*)(p.ws + OFF_HM), (const u16*)(p.ws + OFF_W1T), 1024, 32, p.ws + OFF_H, smem); break;
    case 9: gemm_phase<0>((const u16*)(p.ws + OFF_H), (const u16*)(p.ws + OFF_W2T), 4096, 8, p.out, smem); break;
    case 10: phase_final(p); break;
  }
}
constexpr int NPHASE = 11;

#define XB_XCNT(j)  (256  + 64 * (j))
#define XB_XSUB(j)  (1280 + 64 * (j))
#define XB_XGEN(j)  (2304 + 64 * (j))
#define XB_TOP      3328
#define XB_TOPGEN   3392
#define XCD_BAR_WORDS 3456
DI unsigned xb_ld(unsigned* p) { return __hip_atomic_load(p, __ATOMIC_RELAXED, __HIP_MEMORY_SCOPE_AGENT); }
DI unsigned xb_add(unsigned* p, unsigned v) { return __hip_atomic_fetch_add(p, v, __ATOMIC_RELAXED, __HIP_MEMORY_SCOPE_AGENT); }
DI unsigned xb_xcc_id() { return (unsigned)__builtin_amdgcn_s_getreg((3 << 11) | 20) & 0xFu; }
struct XcdBar { unsigned* bar; unsigned x, nloc, nx; };
DI void xcd_barrier(XcdBar& b) {
  asm volatile("s_waitcnt vmcnt(0)" ::: "memory");
  __syncthreads();
  if (threadIdx.x == 0) {
    unsigned* bar = b.bar;
    __builtin_amdgcn_s_waitcnt(0);
    if (b.nloc == 0u) {
      const unsigned G = gridDim.x;
      unsigned sum, cnt, mine;
      for (;;) {
        sum = 0u; cnt = 0u; mine = 0u;
#pragma unroll
        for (unsigned j = 0; j < 16; ++j) { const unsigned c = xb_ld(&bar[XB_XCNT(j)]); sum += c; cnt += (c > 0u) ? 1u : 0u; mine = (j == b.x) ? c : mine; }
        if (sum == G) break;
        __builtin_amdgcn_s_sleep(1);
      }
      b.nloc = mine > 0u ? mine : 1u; b.nx = cnt > 0u ? cnt : 1u;
    }
    const unsigned nloc = b.nloc, nx = b.nx;
    const unsigned old = xb_add(&bar[XB_XSUB(b.x)], 1u);
    const unsigned gen = old / nloc;
    if (old + 1u == (gen + 1u) * nloc) {
      __builtin_amdgcn_fence(__ATOMIC_RELEASE, "agent");
      asm volatile("s_waitcnt vmcnt(0)" ::: "memory");
      const unsigned og = xb_add(&bar[XB_TOP], 1u);
      const unsigned tg = og / nx;
      if (og + 1u == (tg + 1u) * nx) xb_add(&bar[XB_TOPGEN], 1u);
      else while (xb_ld(&bar[XB_TOPGEN]) == tg) __builtin_amdgcn_s_sleep(1);
      __builtin_amdgcn_fence(__ATOMIC_ACQUIRE, "agent");
      xb_add(&bar[XB_XGEN(b.x)], 1u);
      asm volatile("s_waitcnt vmcnt(0)" ::: "memory");
    } else {
      while (xb_ld(&bar[XB_XGEN(b.x)]) == gen) __builtin_amdgcn_s_sleep(1);
      __builtin_amdgcn_fence(__ATOMIC_ACQUIRE, "agent");
      asm volatile("s_waitcnt vmcnt(0)" ::: "memory");
    }
  }
  __syncthreads();
}

#if MULTI_LAUNCH
template <int PH>
__global__ void __launch_bounds__(256, 2) phase_kernel(Params p) {
  __shared__ __attribute__((aligned(16))) char smem[65536];
  run_phase(p, PH, smem);
}
template <int PH>
static void launch_phase(const Params& p, hipStream_t stream) {
  hipLaunchKernelGGL(phase_kernel<PH>, dim3(512), dim3(256), 0, stream, p);
}
#else
__global__ void __launch_bounds__(256, 2) mega_kernel(Params p) {
  __shared__ __attribute__((aligned(16))) char smem[65536];
  cg::grid_group grid = cg::this_grid();
  XcdBar xb;
  xb.bar = (unsigned*)(p.ws + OFF_BAR); xb.x = xb_xcc_id(); xb.nloc = 0u; xb.nx = 0u;
  if (blockIdx.x == 0) for (int i = threadIdx.x; i < XCD_BAR_WORDS; i += 256) __hip_atomic_store(xb.bar + i, 0u, __ATOMIC_RELAXED, __HIP_MEMORY_SCOPE_AGENT);
#define GSYNC xcd_barrier(xb)
  run_phase(p, 0, smem); grid.sync();
  if (threadIdx.x == 0) (void)xb_add(&xb.bar[XB_XCNT(xb.x)], 1u);
  run_phase(p, 1, smem); GSYNC;
#ifdef DBL_GEMM
  run_phase(p, 1, smem); grid.sync();
#endif
  run_phase(p, 2, smem); GSYNC;
  run_phase(p, 3, smem); GSYNC;
#ifdef DBL_HY
  run_phase(p, 3, smem); GSYNC;
#endif
  run_phase(p, 4, smem); GSYNC;
  run_phase(p, 5, smem); GSYNC;
  run_phase(p, 6, smem); GSYNC;
#ifdef DBL_GEMM
  run_phase(p, 6, smem); GSYNC;
#endif
  run_phase(p, 7, smem); GSYNC;
  run_phase(p, 8, smem); GSYNC;
#ifdef DBL_GEMM
  run_phase(p, 8, smem); GSYNC;
#endif
  run_phase(p, 9, smem); GSYNC;
#ifdef DBL_GEMM
  run_phase(p, 9, smem); GSYNC;
#endif
#ifdef XSYNC
  for (int q = 0; q < 10; ++q) GSYNC;
#endif
  run_phase(p, 10, smem);
}
#endif

extern "C" void kernel_launch(void* const* d_in, const int* in_sizes, int n_in, void* d_out, int out_size, void* d_ws,
                              size_t ws_size, hipStream_t stream) {
  Params p{};
  const float** pp = (const float**)&p;
  for (int i = 0; i < 23; ++i) pp[i] = (const float*)d_in[i];
  p.out = (float*)d_out;
  p.ws = (char*)d_ws;
#if MULTI_LAUNCH
  launch_phase<0>(p, stream);
#ifdef DBL_P0
  launch_phase<0>(p, stream);
#endif
 launch_phase<1>(p, stream); launch_phase<2>(p, stream); launch_phase<3>(p, stream);
#ifdef DBL_HY
  launch_phase<3>(p, stream);
#endif

  launch_phase<4>(p, stream); launch_phase<5>(p, stream);
#ifdef DBL_P5
  launch_phase<5>(p, stream);
#endif
 launch_phase<6>(p, stream); launch_phase<7>(p, stream);
  launch_phase<8>(p, stream); launch_phase<9>(p, stream); launch_phase<10>(p, stream);
#else
  static int grid_blocks = 0;
  if (!grid_blocks) {
    int dev = 0, cus = 0, per_cu = 0;
    hipGetDevice(&dev);
    hipDeviceGetAttribute(&cus, hipDeviceAttributeMultiprocessorCount, dev);
    hipOccupancyMaxActiveBlocksPerMultiprocessor(&per_cu, mega_kernel, 256, 0);
    if (per_cu > 2) per_cu = 2;
    if (per_cu < 1) per_cu = 1;
#ifdef FORCE2
    per_cu = 2;
#endif
    grid_blocks = cus * per_cu;
  }
  void* args[] = {&p};
  hipError_t e = hipLaunchCooperativeKernel((void*)mega_kernel, dim3(grid_blocks), dim3(256), args, 0, stream);
  if (e != hipSuccess) fprintf(stderr, "cooperative launch failed: %s (grid %d)\n", hipGetErrorString(e), grid_blocks);
#endif
}
```

```cpp
#include <hip/hip_runtime.h>
#include <hip/hip_cooperative_groups.h>
#include <cstdio>
namespace cg = cooperative_groups;

#ifndef MULTI_LAUNCH
#define MULTI_LAUNCH 0
#endif

typedef unsigned short u16;
using bf16x8 = __attribute__((ext_vector_type(8))) short;
using f32x16 = __attribute__((ext_vector_type(16))) float;
#define DI __device__ __forceinline__
#define MFMA(a, b, c) __builtin_amdgcn_mfma_f32_32x32x16_bf16((a), (b), (c), 0, 0, 0)

constexpr int SEQ = 4096, DM = 1024, NTOK = 16384, NIN = 3600, NINP = 3712, DFF = 4096;
constexpr float EPS = 1e-6f;
constexpr size_t MiB = 1u << 20;
constexpr size_t OFF_WINT = 0, OFF_WOUTT = 8 * MiB, OFF_W1T = 10 * MiB, OFF_W2T = 18 * MiB;
constexpr size_t OFF_XN = 26 * MiB, OFF_QA = 26 * MiB, OFF_KA = 42 * MiB;
constexpr size_t OFF_FILT = 58 * MiB, OFF_QKPRE = 90 * MiB, OFF_A2 = 90 * MiB;
constexpr size_t OFF_HYT = 122 * MiB, OFF_VT = 170 * MiB, OFF_OG = 186 * MiB, OFF_GATES = 202 * MiB;
constexpr size_t OFF_NL = 203 * MiB, OFF_MLOC = 203 * MiB + 512 * 1024, OFF_GSUM = OFF_MLOC + 4096, OFF_MS = OFF_GSUM + 4096;
constexpr size_t OFF_KAT = 205 * MiB, OFF_Z2T = 221 * MiB;
constexpr size_t OFF_TW = 204 * MiB, OFF_BAR = 254 * MiB;
constexpr size_t OFF_X1 = 26 * MiB, OFF_HM = 90 * MiB, OFF_H = 122 * MiB;

struct Params {
  const float *x, *norm_mix_pre, *norm_mix_post, *norm_mlp_pre, *norm_mlp_post, *w_in, *b_gates, *conv_w, *conv_b,
      *mlstm_norm_w, *hyena_norm_w, *filt_w1, *filt_b1, *filt_w2, *filt_b2, *filt_w3, *filt_b3, *filt_w4, *filt_freq,
      *filt_bias, *w_out, *w_mlp_in, *w_mlp_out;
  float* out;
  char* ws;
};

DI u16 f2bf(float x) { unsigned u = __float_as_uint(x); u += 0x7fffu + ((u >> 16) & 1u); return (u16)(u >> 16); }
DI float bf2f(u16 v) { return __uint_as_float(((unsigned)v) << 16); }
DI int opaque_tid() { int t = threadIdx.x; asm volatile("" : "+v"(t)); return t; }
DI int crow(int r, int hh) { return (r & 3) + 8 * (r >> 2) + 4 * hh; }
DI float log_sigmoid(float x) { return fminf(x, 0.f) - log1pf(expf(-fabsf(x))); }
DI float sigmoidf(float x) { return 1.f / (1.f + expf(-x)); }
DI float red2pi(float x) {
  const float k = rintf(x * 0.15915494309189535f);
  float r = fmaf(-k, 6.28125f, x);
  return fmaf(-k, 1.9353071795864769e-3f, r);
}
DI float fsin(float x) { return sinf(x); }
DI float fcos(float x) { return cosf(x); }
DI bf16x8 pack8(const float* v) {
  bf16x8 r;
#pragma unroll
  for (int i = 0; i < 8; ++i) r[i] = (short)f2bf(v[i]);
  return r;
}
DI bf16x8 scale8(bf16x8 a, float s) {
  bf16x8 r;
#pragma unroll
  for (int i = 0; i < 8; ++i) r[i] = (short)f2bf(bf2f((u16)a[i]) * s);
  return r;
}

template <bool SWAP>
DI void gemm_core(const u16* __restrict__ A, const u16* __restrict__ Bt, int K, int m0, int n0, char* smem, f32x16 (&acc)[4][2]) {
  const int tid = opaque_tid(), lane = tid & 63, wave = tid >> 6, wr = wave >> 1, wc = wave & 1;
  const int lr = lane & 31, hh = lane >> 5;
#pragma unroll
  for (int i = 0; i < 4; ++i)
#pragma unroll
    for (int j = 0; j < 2; ++j)
#pragma unroll
      for (int r = 0; r < 16; ++r) acc[i][j][r] = 0.f;
  const int c = tid & 7, r0 = tid >> 3;
  const u16* Ag = A + (size_t)(m0 + r0) * K + c * 8;
  const u16* Bg = Bt + (size_t)(n0 + r0) * K + c * 8;
  const int soff = r0 * 128 + ((c ^ ((r0 >> 1) & 7)) << 4);
  char* As = smem;
  char* Bs = smem + 32768;
  uint4 ra0, ra1, ra2, ra3, ra4, ra5, ra6, ra7, rb0, rb1, rb2, rb3;
#define GLOAD_ALL(k0)                                                                                             \
  ra0 = *(const uint4*)(Ag + (size_t)(0) * K + (k0));   ra1 = *(const uint4*)(Ag + (size_t)(32) * K + (k0));      \
  ra2 = *(const uint4*)(Ag + (size_t)(64) * K + (k0));  ra3 = *(const uint4*)(Ag + (size_t)(96) * K + (k0));      \
  ra4 = *(const uint4*)(Ag + (size_t)(128) * K + (k0)); ra5 = *(const uint4*)(Ag + (size_t)(160) * K + (k0));     \
  ra6 = *(const uint4*)(Ag + (size_t)(192) * K + (k0)); ra7 = *(const uint4*)(Ag + (size_t)(224) * K + (k0));     \
  rb0 = *(const uint4*)(Bg + (size_t)(0) * K + (k0));   rb1 = *(const uint4*)(Bg + (size_t)(32) * K + (k0));      \
  rb2 = *(const uint4*)(Bg + (size_t)(64) * K + (k0));  rb3 = *(const uint4*)(Bg + (size_t)(96) * K + (k0));
  GLOAD_ALL(0)
  const int nk = K >> 6;
#pragma unroll 1
  for (int kt = 0; kt < nk; ++kt) {
    __syncthreads();
    *(uint4*)(As + soff + 0 * 4096) = ra0; *(uint4*)(As + soff + 1 * 4096) = ra1; *(uint4*)(As + soff + 2 * 4096) = ra2; *(uint4*)(As + soff + 3 * 4096) = ra3;
    *(uint4*)(As + soff + 4 * 4096) = ra4; *(uint4*)(As + soff + 5 * 4096) = ra5; *(uint4*)(As + soff + 6 * 4096) = ra6; *(uint4*)(As + soff + 7 * 4096) = ra7;
    *(uint4*)(Bs + soff + 0 * 4096) = rb0; *(uint4*)(Bs + soff + 1 * 4096) = rb1; *(uint4*)(Bs + soff + 2 * 4096) = rb2; *(uint4*)(Bs + soff + 3 * 4096) = rb3;
    __syncthreads();
    if (kt + 1 < nk) {
      const int k0 = (kt + 1) << 6;
      GLOAD_ALL(k0)
    }
#pragma unroll
    for (int kk = 0; kk < 4; ++kk) {
      bf16x8 a[4], b[2];
      const int cc = kk * 2 + hh;
#pragma unroll
      for (int i = 0; i < 4; ++i) {
        const int r = wr * 128 + i * 32 + lr;
        a[i] = *(const bf16x8*)(As + r * 128 + ((cc ^ ((r >> 1) & 7)) << 4));
      }
#pragma unroll
      for (int j = 0; j < 2; ++j) {
        const int r = wc * 64 + j * 32 + lr;
        b[j] = *(const bf16x8*)(Bs + r * 128 + ((cc ^ ((r >> 1) & 7)) << 4));
      }
#pragma unroll
      for (int i = 0; i < 4; ++i)
#pragma unroll
        for (int j = 0; j < 2; ++j) acc[i][j] = SWAP ? MFMA(b[j], a[i], acc[i][j]) : MFMA(a[i], b[j], acc[i][j]);
    }
  }
  __syncthreads();
}

DI void tile_map(int id, int ntn, int& mt, int& nt) {
  const int per = 16 * ntn;
  const int g = id / per, rem = id - g * per;
  mt = g * 16 + (rem & 15);
  nt = rem >> 4;
}

DI void transpose_tile(const float* __restrict__ src, int R, int C, u16* __restrict__ dst, int kt, int nt, char* smem) {
  float* tile = (float*)smem;
  const int tid = threadIdx.x;
  const int k0 = kt * 64, n0 = nt * 64;
#pragma unroll 4
  for (int it = 0; it < 16; ++it) {
    const int kk = it * 4 + (tid >> 6), nn = tid & 63;
    const int n = n0 + nn;
    tile[kk * 65 + nn] = (n < C) ? src[(size_t)(k0 + kk) * C + n] : 0.f;
  }
  __syncthreads();
#pragma unroll 4
  for (int it = 0; it < 16; ++it) {
    const int nn = it * 4 + (tid >> 6), kk = tid & 63;
    dst[(size_t)(n0 + nn) * R + k0 + kk] = f2bf(tile[kk * 65 + nn]);
  }
  __syncthreads();
}

DI float wave_sum(float v) {
#pragma unroll
  for (int o = 32; o; o >>= 1) v += __shfl_xor(v, o, 64);
  return v;
}

DI void filter_unit(const Params& p, int unit, char* smem) {
  float* sz = (float*)smem;
  float* hA = sz + 8 * 33 + 8;
  float* hB = hA + 8 * 64;
  float* hT = hB + 8 * 64;
  const int tid = opaque_tid();
  const int l0 = unit * 8;
  for (int idx = tid; idx < 8 * 33; idx += 256) {
    const int pp = idx / 33, f = idx - pp * 33;
    const float l = (float)(l0 + pp);
    float v;
    if (f == 0) v = l / 4095.f;
    else {
      const int jb = (f - 1) & 15;
      const float fj = 1e-4f + (float)jb * ((15.f - 1e-4f) / 15.f);
      const float ang = 6.283185307179586f * l / 4096.f;
      v = (f <= 16) ? fcos(fj * ang) : -fsin(fj * ang);
    }
    sz[idx] = v;
  }
  const int o = tid & 63, pq = tid >> 6;
  {
    const float bb = p.filt_b1[o], fr = p.filt_freq[o];
    __syncthreads();
    float s0 = bb, s1 = bb;
#pragma unroll 1
    for (int f0 = 0; f0 < 33; f0 += 11) {
      float wc[11];
#pragma unroll
      for (int f = 0; f < 11; ++f) wc[f] = p.filt_w1[(f0 + f) * 64 + o];
#pragma unroll
      for (int f = 0; f < 11; ++f) { s0 += sz[pq * 33 + f0 + f] * wc[f]; s1 += sz[(pq + 4) * 33 + f0 + f] * wc[f]; }
    }
    hA[pq * 64 + o] = fsin(fr * s0);
    hA[(pq + 4) * 64 + o] = fsin(fr * s1);
  }
  {
    const float bb = p.filt_b2[o], fr = p.filt_freq[64 + o];
    __syncthreads();
    float s0 = bb, s1 = bb;
#pragma unroll 1
    for (int k0 = 0; k0 < 64; k0 += 16) {
      float wc[16];
#pragma unroll
      for (int k = 0; k < 16; ++k) wc[k] = p.filt_w2[(k0 + k) * 64 + o];
#pragma unroll
      for (int k = 0; k < 16; ++k) { s0 += hA[pq * 64 + k0 + k] * wc[k]; s1 += hA[(pq + 4) * 64 + k0 + k] * wc[k]; }
    }
    hB[pq * 64 + o] = fsin(fr * s0);
    hB[(pq + 4) * 64 + o] = fsin(fr * s1);
  }
  {
    const float bb = p.filt_b3[o], fr = p.filt_freq[128 + o];
    __syncthreads();
    float s0 = bb, s1 = bb;
#pragma unroll 1
    for (int k0 = 0; k0 < 64; k0 += 16) {
      float wc[16];
#pragma unroll
      for (int k = 0; k < 16; ++k) wc[k] = p.filt_w3[(k0 + k) * 64 + o];
#pragma unroll
      for (int k = 0; k < 16; ++k) { s0 += hB[pq * 64 + k0 + k] * wc[k]; s1 += hB[(pq + 4) * 64 + k0 + k] * wc[k]; }
    }
    hT[o * 8 + pq] = fsin(fr * s0);
    hT[o * 8 + pq + 4] = fsin(fr * s1);
  }
  __syncthreads();
  float* filt = (float*)(p.ws + OFF_FILT);
  const float min_decay = -3.0701134573253944f, max_decay = -15.350567286626973f;
#pragma unroll 1
  for (int cc = 0; cc < 8; ++cc) {
    const int col = tid + 256 * cc;
    float acc[8];
#pragma unroll
    for (int q = 0; q < 8; ++q) acc[q] = 0.f;
#pragma unroll 1
    for (int k0 = 0; k0 < 64; k0 += 16) {
      float wc[16];
#pragma unroll
      for (int k = 0; k < 16; ++k) wc[k] = p.filt_w4[(k0 + k) * 2048 + col];
#pragma unroll
      for (int k = 0; k < 16; ++k) {
        const float4 h0 = *(const float4*)(hT + (k0 + k) * 8);
        const float4 h1 = *(const float4*)(hT + (k0 + k) * 8 + 4);
        acc[0] += h0.x * wc[k]; acc[1] += h0.y * wc[k]; acc[2] += h0.z * wc[k]; acc[3] += h0.w * wc[k];
        acc[4] += h1.x * wc[k]; acc[5] += h1.y * wc[k]; acc[6] += h1.z * wc[k]; acc[7] += h1.w * wc[k];
      }
    }
    const int ch = col & 511;
    const float delta = fabsf(min_decay + (float)ch * ((max_decay - min_decay) / 511.f));
#pragma unroll
    for (int q = 0; q < 8; ++q) {
      const float t = (float)(l0 + q) / 4095.f;
      acc[q] *= expf(-t * delta);
    }
    float4* dst = (float4*)(filt + (size_t)col * 4096 + l0);
    dst[0] = make_float4(acc[0], acc[1], acc[2], acc[3]);
    dst[1] = make_float4(acc[4], acc[5], acc[6], acc[7]);
  }
  __syncthreads();
}

DI void phase0(const Params& p, char* smem) {
  const int tid = threadIdx.x, lane = tid & 63, wave = tid >> 6;
  const int U_W = 32, U_F = 512, U_X = 1024, U_T1 = 58 * 16, U_T2 = 256, U_T3 = 1024, U_T4 = 1024;
  const int total = U_W + U_F + U_X + U_T1 + U_T2 + U_T3 + U_T4;
  for (int u = blockIdx.x; u < total; u += gridDim.x) {
    int v = u;
    if (v < U_W) {
      const int idx = v * 256 + tid;
      if (idx < 8191) {
        const int lh = 31 - __clz(idx + 1);
        const int h = 1 << lh, jj = idx + 1 - h;
        float2* twp = (float2*)(p.ws + OFF_TW);
        const float ang = -3.14159265358979f * (float)jj / (float)h;
        twp[idx] = make_float2(cosf(ang), sinf(ang));
      }
      continue;
    }
    v -= U_W;
    if (v < U_F) { filter_unit(p, v, smem); continue; }
    v -= U_F;
    if (v < U_X) {
      u16* xn = (u16*)(p.ws + OFF_XN);
#pragma unroll 1
      for (int rr = 0; rr < 4; ++rr) {
        const int row = v * 16 + wave * 4 + rr;
        const float4* xr = (const float4*)(p.x + (size_t)row * DM);
        float4 xv[4];
        float ss = 0.f;
#pragma unroll
        for (int i = 0; i < 4; ++i) {
          xv[i] = xr[lane + 64 * i];
          ss += xv[i].x * xv[i].x + xv[i].y * xv[i].y + xv[i].z * xv[i].z + xv[i].w * xv[i].w;
        }
        ss = wave_sum(ss);
        const float rs = rsqrtf(ss * (1.f / DM) + EPS);
#pragma unroll
        for (int i = 0; i < 4; ++i) {
          const float4 w = ((const float4*)p.norm_mix_pre)[lane + 64 * i];
          ushort4 o;
          o.x = f2bf(xv[i].x * rs * w.x); o.y = f2bf(xv[i].y * rs * w.y); o.z = f2bf(xv[i].z * rs * w.z); o.w = f2bf(xv[i].w * rs * w.w);
          *(ushort4*)(xn + (size_t)row * DM + (lane + 64 * i) * 4) = o;
        }
      }
      continue;
    }
    v -= U_X;
    if (v < U_T1) { transpose_tile(p.w_in, DM, NIN, (u16*)(p.ws + OFF_WINT), v & 15, v >> 4, smem); continue; }
    v -= U_T1;
    if (v < U_T2) { transpose_tile(p.w_out, DM, DM, (u16*)(p.ws + OFF_WOUTT), v & 15, v >> 4, smem); continue; }
    v -= U_T2;
    if (v < U_T3) { transpose_tile(p.w_mlp_in, DM, DFF, (u16*)(p.ws + OFF_W1T), v & 15, v >> 4, smem); continue; }
    v -= U_T3;
    transpose_tile(p.w_mlp_out, DFF, DM, (u16*)(p.ws + OFF_W2T), v & 63, v >> 6, smem);
  }
}

DI void phase1(const Params& p, char* smem) {
  const int tid = threadIdx.x, lane = tid & 63, wave = tid >> 6, wr = wave >> 1, wc = wave & 1, lr = lane & 31, hh = lane >> 5;
  const u16* xn = (const u16*)(p.ws + OFF_XN);
  const u16* wt = (const u16*)(p.ws + OFF_WINT);
  u16* qkpre = (u16*)(p.ws + OFF_QKPRE);
  u16* hyT = (u16*)(p.ws + OFF_HYT);
  u16* vT = (u16*)(p.ws + OFF_VT);
  u16* og = (u16*)(p.ws + OFF_OG);
  float* gates = (float*)(p.ws + OFF_GATES);
  const int ntn = 29, ntiles = 64 * ntn;
  for (int id = blockIdx.x; id < ntiles; id += gridDim.x) {
    int mt, nt;
    tile_map(id, ntn, mt, nt);
    const int m0 = mt * 256, n0 = nt * 128;
    f32x16 acc[4][2];
    const bool swap = (nt >= 8 && nt < 24);
    if (swap) gemm_core<true>(xn, wt, DM, m0, n0, smem, acc);
    else gemm_core<false>(xn, wt, DM, m0, n0, smem, acc);
#pragma unroll
    for (int i = 0; i < 4; ++i)
#pragma unroll
      for (int j = 0; j < 2; ++j)
#pragma unroll
        for (int r = 0; r < 16; ++r) {
          const float val = acc[i][j][r];
          if (!swap) {
            const int row = m0 + wr * 128 + i * 32 + crow(r, hh);
            const int col = n0 + wc * 64 + j * 32 + lr;
            if (nt < 8) qkpre[(size_t)row * 1024 + col] = f2bf(val);
            else if (nt < 28) og[(size_t)row * 512 + (col - 3072)] = f2bf(sigmoidf(val));
            else if (col < 3600) gates[(size_t)row * 16 + (col - 3584)] = val;
          } else {
            const int n = n0 + wc * 64 + j * 32 + crow(r, hh);
            const int m = m0 + wr * 128 + i * 32 + lr;
            const int b = m >> 12, t = m & 4095;
            if (nt < 20) {
              const int cc = n - 1024, g = cc >> 9, ch = cc & 511;
              hyT[((size_t)((g * 4 + b) * 512 + ch)) * 4096 + t] = f2bf(val);
            } else {
              const int cc = n - 2560;
              vT[((size_t)(b * 512 + cc)) * 4096 + t] = f2bf(val);
            }
          }
        }
  }
}

DI void phase_qk(const Params& p, char* smem) {
  u16* tile = (u16*)smem;
  const int tid = threadIdx.x;
  const u16* qkpre = (const u16*)(p.ws + OFF_QKPRE);
  u16* qa = (u16*)(p.ws + OFF_QA);
  u16* ka = (u16*)(p.ws + OFF_KA);
  u16* kaT = (u16*)(p.ws + OFF_KAT);
  for (int u = blockIdx.x; u < 4096; u += gridDim.x) {
    const int ct = u & 15, tt = u >> 4;
    const int C = ct * 64 + (tid & 63);
    const float w0 = p.conv_w[C], w1 = p.conv_w[2560 + C], w2 = p.conv_w[5120 + C], cb = p.conv_b[C];
#pragma unroll 4
    for (int i = 0; i < 16; ++i) {
      const int row = (tid >> 6) + 4 * i;
      const int T = tt * 64 + row, t = T & 4095;
      const float pm = t > 0 ? bf2f(qkpre[(size_t)(T - 1) * 1024 + C]) : 0.f;
      const float p0 = bf2f(qkpre[(size_t)T * 1024 + C]);
      const float pp = t < 4095 ? bf2f(qkpre[(size_t)(T + 1) * 1024 + C]) : 0.f;
      const float val = w0 * pm + w1 * p0 + w2 * pp + cb;
      float s = val * sigmoidf(val);
      if (C < 512) qa[(size_t)T * 512 + C] = f2bf(s);
      else {
        s *= 0.08838834764831845f;
        const u16 sb = f2bf(s);
        ka[(size_t)T * 512 + (C - 512)] = sb;
        tile[(tid & 63) * 66 + row] = sb;
      }
    }
    if (ct >= 8) {
      __syncthreads();
      const int b = (tt * 64) >> 12, t0 = (tt * 64) & 4095;
      const int d0 = (ct - 8) * 64;
#pragma unroll 4
      for (int i = 0; i < 16; ++i) {
        const int dl = (tid >> 6) + 4 * i, tl = tid & 63;
        kaT[((size_t)(b * 512 + d0 + dl)) * 4096 + t0 + tl] = tile[dl * 66 + tl];
      }
      __syncthreads();
    }
  }
}

DI void fft_fwd(float2* x, int tid, const float2* __restrict__ tw) {
#ifdef DBG_NOFFT
  __syncthreads(); return;
#endif
#pragma unroll 1
  for (int lh = 12; lh >= 0; --lh) {
    const int h = 1 << lh;
    __syncthreads();
#pragma unroll 4
    for (int i = 0; i < 16; ++i) {
      const int k = tid + (i << 8);
      const int j = k & (h - 1);
      const int i0 = ((k - j) << 1) + j;
      const float2 a = x[i0], b = x[i0 + h];
      const float2 w = tw[(h - 1) + j];
      const float cs = w.x, sn = w.y;
      const float dx = a.x - b.x, dy = a.y - b.y;
      x[i0] = make_float2(a.x + b.x, a.y + b.y);
      x[i0 + h] = make_float2(dx * cs - dy * sn, dx * sn + dy * cs);
    }
  }
  __syncthreads();
}
DI void fft_inv(float2* x, int tid, const float2* __restrict__ tw) {
#ifdef DBG_NOFFT
  __syncthreads(); return;
#endif
#pragma unroll 1
  for (int lh = 0; lh <= 12; ++lh) {
    const int h = 1 << lh;
    __syncthreads();
#pragma unroll 4
    for (int i = 0; i < 16; ++i) {
      const int k = tid + (i << 8);
      const int j = k & (h - 1);
      const int i0 = ((k - j) << 1) + j;
      const float2 a = x[i0], b = x[i0 + h];
      const float2 w = tw[(h - 1) + j];
      const float cs = w.x, sn = -w.y;
      const float bx = b.x * cs - b.y * sn, by = b.x * sn + b.y * cs;
      x[i0] = make_float2(a.x + bx, a.y + by);
      x[i0 + h] = make_float2(a.x - bx, a.y - by);
    }
  }
  __syncthreads();
}

DI float hy_conv(const u16* __restrict__ pr, int t, float w0, float w1, float w2, float cb) {
  const float a = t > 0 ? bf2f(pr[t - 1]) : 0.f;
  const float b = bf2f(pr[t]);
  const float c = t < 4095 ? bf2f(pr[t + 1]) : 0.f;
  return w0 * a + w1 * b + w2 * c + cb;
}

DI void hyena_unit(const Params& p, int ch, char* smem) {
  float2* buf = (float2*)smem;
  const int tid = opaque_tid();
  const u16* hyT = (const u16*)(p.ws + OFF_HYT);
  const float* filt = (const float*)(p.ws + OFF_FILT);
  float* z2T = (float*)(p.ws + OFF_Z2T);
  const float2* tw = (const float2*)(p.ws + OFF_TW);
  float2 Kr[32];
#pragma unroll 1
  for (int ord = 0; ord < 2; ++ord) {
    const float* kf = filt + (size_t)((0 * 2 + ord) * 512 + ch) * 4096;
    const float* kb = filt + (size_t)((1 * 2 + ord) * 512 + ch) * 4096;
    const float fb = p.filt_bias[ord * 512 + ch];
    __syncthreads();
#pragma unroll 4
    for (int n = tid; n < 8192; n += 256) {
      float v;
      if (n < 4096) v = kf[n];
      else if (n == 4096) v = 0.f;
      else v = kb[8192 - n];
      if (n == 0) v += fb;
      buf[n] = make_float2(v, 0.f);
    }
    fft_fwd(buf, tid, tw);
#pragma unroll
    for (int j = 0; j < 32; ++j) {
      const float2 v = buf[tid + 256 * j];
      Kr[j] = make_float2(v.x * (1.f / 8192.f), v.y * (1.f / 8192.f));
    }
    const int gcol = 1024 + (1 + ord) * 512 + ch;
    const float gw0 = p.conv_w[gcol], gw1 = p.conv_w[2560 + gcol], gw2 = p.conv_w[5120 + gcol], gcb = p.conv_b[gcol];
    const int vcol = 1024 + ch;
    const float vw0 = p.conv_w[vcol], vw1 = p.conv_w[2560 + vcol], vw2 = p.conv_w[5120 + vcol], vcb = p.conv_b[vcol];
#pragma unroll 1
    for (int pr = 0; pr < 2; ++pr) {
      const int b0 = 2 * pr, b1 = 2 * pr + 1;
      __syncthreads();
      if (ord == 0) {
        const u16* u0 = hyT + ((size_t)((0 * 4 + b0) * 512 + ch)) * 4096;
        const u16* u1 = hyT + ((size_t)((0 * 4 + b1) * 512 + ch)) * 4096;
#pragma unroll 2
        for (int i = 0; i < 16; ++i) {
          const int t = tid + 256 * i;
          buf[t] = make_float2(hy_conv(u0, t, vw0, vw1, vw2, vcb), hy_conv(u1, t, vw0, vw1, vw2, vcb));
          buf[4096 + t] = make_float2(0.f, 0.f);
        }
      } else {
        const float* u0 = z2T + ((size_t)(b0 * 512 + ch)) * 4096;
        const float* u1 = z2T + ((size_t)(b1 * 512 + ch)) * 4096;
#pragma unroll 4
        for (int i = 0; i < 16; ++i) {
          const int t = tid + 256 * i;
          buf[t] = make_float2(u0[t], u1[t]);
          buf[4096 + t] = make_float2(0.f, 0.f);
        }
      }
      fft_fwd(buf, tid, tw);
#pragma unroll
      for (int j = 0; j < 32; ++j) {
        const float2 v = buf[tid + 256 * j];
        buf[tid + 256 * j] = make_float2(v.x * Kr[j].x - v.y * Kr[j].y, v.x * Kr[j].y + v.y * Kr[j].x);
      }
      fft_inv(buf, tid, tw);
      const u16* g0 = hyT + ((size_t)(((1 + ord) * 4 + b0) * 512 + ch)) * 4096;
      const u16* g1 = hyT + ((size_t)(((1 + ord) * 4 + b1) * 512 + ch)) * 4096;
      float* o0 = z2T + ((size_t)(b0 * 512 + ch)) * 4096;
      float* o1 = z2T + ((size_t)(b1 * 512 + ch)) * 4096;
#pragma unroll 2
      for (int i = 0; i < 16; ++i) {
        const int t = tid + 256 * i;
        const float2 y = buf[t];
        o0[t] = hy_conv(g0, t, gw0, gw1, gw2, gcb) * y.x;
        o1[t] = hy_conv(g1, t, gw0, gw1, gw2, gcb) * y.y;
      }
    }
  }
  __syncthreads();
}

DI void mlstm_local_unit(const Params& p, int u, char* smem) {
  float* s_gi = (float*)smem;
  float* s_lf = s_gi + 128;
  float* s_a = s_lf + 128;
  float* s_w = s_a + 128;
  const int tid = opaque_tid(), lane = tid & 63, wave = tid >> 6, lr = lane & 31, hh = lane >> 5;
  const int j = u & 31, dir = (u >> 5) & 1, bh = u >> 6, h = bh & 3, b = bh >> 2;
  const int T0 = b * 4096 + j * 128;
  const float* gates = (const float*)(p.ws + OFF_GATES);
  const u16* vT = (const u16*)(p.ws + OFF_VT);
  const u16* kaT = (const u16*)(p.ws + OFF_KAT);
  float* CL = p.out;
  float* nl = (float*)(p.ws + OFF_NL);
  float* mloc = (float*)(p.ws + OFF_MLOC);
  float* gsum = (float*)(p.ws + OFF_GSUM);
  __syncthreads();
  if (tid < 128) {
    const int T = T0 + tid;
    s_gi[tid] = gates[(size_t)T * 16 + dir * 8 + h] + p.b_gates[dir * 8 + h];
    s_lf[tid] = log_sigmoid(gates[(size_t)T * 16 + dir * 8 + 4 + h] + p.b_gates[dir * 8 + 4 + h]);
  }
  __syncthreads();
  float gtot = 0.f;
  if (tid < 128) {
    float pre = 0.f;
#pragma unroll 4
    for (int m = 0; m < 128; ++m) {
      const float v = s_lf[m];
      if (m < tid) pre += v;
      gtot += v;
    }
    s_a[tid] = (dir == 0) ? (gtot - pre - s_lf[tid] + s_gi[tid]) : (pre + s_gi[tid]);
  }
  __syncthreads();
  if (tid < 128) {
    float mx = -3.0e38f;
#pragma unroll 4
    for (int m = 0; m < 128; ++m) mx = fmaxf(mx, s_a[m]);
    s_w[tid] = expf(s_a[tid] - mx);
    if (tid == 0) { mloc[u] = mx; gsum[u] = gtot; }
  }
  __syncthreads();
  f32x16 acc[4];
#pragma unroll
  for (int d = 0; d < 4; ++d)
#pragma unroll
    for (int r = 0; r < 16; ++r) acc[d][r] = 0.f;
  const u16* vrow = vT + ((size_t)(bh * 128 + wave * 32 + lr)) * 4096 + j * 128 + hh * 8;
  const u16* kbase = kaT + ((size_t)(bh * 128 + lr)) * 4096 + j * 128 + hh * 8;
#pragma unroll 2
  for (int ks = 0; ks < 8; ++ks) {
    const bf16x8 av = *(const bf16x8*)(vrow + ks * 16);
    bf16x8 a;
#pragma unroll
    for (int i = 0; i < 8; ++i) a[i] = (short)f2bf(bf2f((u16)av[i]) * s_w[ks * 16 + hh * 8 + i]);
#pragma unroll
    for (int dt = 0; dt < 4; ++dt) {
      const bf16x8 bk = *(const bf16x8*)(kbase + (size_t)(dt * 32) * 4096 + ks * 16);
      acc[dt] = MFMA(a, bk, acc[dt]);
    }
  }
  float* dst = CL + (size_t)u * 16384;
#pragma unroll
  for (int dt = 0; dt < 4; ++dt)
#pragma unroll
    for (int r = 0; r < 16; ++r) dst[(wave * 32 + crow(r, hh)) * 128 + dt * 32 + lr] = acc[dt][r];
  if (tid < 128) {
    const u16* kr = kaT + ((size_t)(bh * 128 + tid)) * 4096 + j * 128;
    float s = 0.f;
#pragma unroll 2
    for (int l = 0; l < 128; l += 8) {
      const bf16x8 kv = *(const bf16x8*)(kr + l);
#pragma unroll
      for (int i = 0; i < 8; ++i) s += s_w[l + i] * bf2f((u16)kv[i]);
    }
    nl[(size_t)u * 128 + tid] = s;
  }
}

DI void scan_unit(const Params& p, int unit) {
  const int tid = opaque_tid();
  const int sc = unit >> 4, part = unit & 15, dir = sc & 1;
  float* CL = p.out;
  float* nl = (float*)(p.ws + OFF_NL);
  const float* mloc = (const float*)(p.ws + OFF_MLOC);
  const float* gsum = (const float*)(p.ws + OFF_GSUM);
  float* ms = (float*)(p.ws + OFF_MS);
  const int idx = part * 1024 + tid * 4;
  float4 C = make_float4(0.f, 0.f, 0.f, 0.f);
  float nst = 0.f, m = 0.f;
  const bool do_n = (part == 0) && (tid < 128);
  float4 pf[4];
#pragma unroll
  for (int q = 0; q < 4; ++q) {
    const int jj = dir ? 31 - q : q;
    pf[q] = *(const float4*)(CL + (size_t)(sc * 32 + jj) * 16384 + idx);
  }
#pragma unroll 1
  for (int c0 = 0; c0 < 32; c0 += 4) {
#pragma unroll
    for (int q = 0; q < 4; ++q) {
      const int c = c0 + q;
      const int jj = dir ? 31 - c : c;
      const int u = sc * 32 + jj;
      const float4 cl = pf[q];
      *(float4*)(CL + (size_t)u * 16384 + idx) = C;
      if (c + 4 < 32) {
        const int j2 = dir ? 31 - (c + 4) : (c + 4);
        pf[q] = *(const float4*)(CL + (size_t)(sc * 32 + j2) * 16384 + idx);
      }
      const float g = gsum[u], ml = mloc[u];
      const float mn = fmaxf(g + m, ml);
      const float dec = expf(g + m - mn), scl = expf(ml - mn);
      C.x = dec * C.x + scl * cl.x; C.y = dec * C.y + scl * cl.y; C.z = dec * C.z + scl * cl.z; C.w = dec * C.w + scl * cl.w;
      if (do_n) {
        const float nv = nl[(size_t)u * 128 + tid];
        nl[(size_t)u * 128 + tid] = nst;
        nst = dec * nst + scl * nv;
      }
      if (part == 0 && tid == 0) ms[u] = m;
      m = mn;
    }
  }
}

template <int DIR>
DI void mlstm_dir(const Params& p, int bh, int j, char* smem, f32x16 (&hs)[4]) {
  float* s_gi = (float*)smem;
  float* s_lf = s_gi + 128;
  float* s_bc = s_lf + 128;
  float* s_r = s_bc + 128;
  float* s_al = s_r + 128;
  float* s_fl = s_al + 128;
  float* s_is = s_fl + 128;
  const int tid = opaque_tid(), lane = tid & 63, wave = tid >> 6, lr = lane & 31, hh = lane >> 5;
  u16* Pl = (u16*)(smem + 4096) + wave * (32 * 136);
  const int h = bh & 3, b = bh >> 2;
  const int T0 = b * 4096 + j * 128;
  const float* gates = (const float*)(p.ws + OFF_GATES);
  const u16* qa = (const u16*)(p.ws + OFF_QA);
  const u16* ka = (const u16*)(p.ws + OFF_KA);
  const u16* vT = (const u16*)(p.ws + OFF_VT);
  const float* CS = p.out;
  const float* ns = (const float*)(p.ws + OFF_NL);
  const float* ms = (const float*)(p.ws + OFF_MS);
  u16* A2 = (u16*)(p.ws + OFF_A2);
  bf16x8 ones;
#pragma unroll
  for (int i = 0; i < 8; ++i) ones[i] = (short)0x3F80;
  const u16* qrow = qa + (size_t)(T0 + wave * 32 + lr) * 512 + h * 128 + hh * 8;
  const int u = (bh * 2 + DIR) * 32 + j;
  const float msu = ms[u];
  __syncthreads();
  if (tid < 128) {
    const int T = T0 + tid;
    s_gi[tid] = gates[(size_t)T * 16 + DIR * 8 + h] + p.b_gates[DIR * 8 + h];
    s_lf[tid] = log_sigmoid(gates[(size_t)T * 16 + DIR * 8 + 4 + h] + p.b_gates[DIR * 8 + 4 + h]);
  }
  __syncthreads();
  if (tid < 128) {
    float a = 0.f;
#pragma unroll 4
    for (int m = 0; m < 128; ++m) {
      const bool in = (DIR == 0) ? (m <= tid) : (m >= tid);
      a += in ? s_lf[m] : 0.f;
    }
    s_bc[tid] = a;
    s_r[tid] = s_gi[tid] - a;
  }
  __syncthreads();
  if (tid < 128) {
    float cm = -3.0e38f;
#pragma unroll 4
    for (int m = 0; m < 128; ++m) {
      const bool in = (DIR == 0) ? (m <= tid) : (m >= tid);
      cm = in ? fmaxf(cm, s_r[m]) : cm;
    }
    const float bc = s_bc[tid];
    const float mt = bc + fmaxf(msu, cm);
    s_al[tid] = bc - mt;
    s_fl[tid] = expf(-mt);
    s_is[tid] = expf(bc + msu - mt);
  }
  __syncthreads();
  {
    f32x16 S[4];
#pragma unroll
    for (int st = 0; st < 4; ++st)
#pragma unroll
      for (int r = 0; r < 16; ++r) S[st][r] = 0.f;
    const u16* kbase = ka + (size_t)(T0 + lr) * 512 + h * 128 + hh * 8;
#pragma unroll 2
    for (int ks = 0; ks < 8; ++ks) {
      const bf16x8 a = *(const bf16x8*)(qrow + ks * 16);
#pragma unroll
      for (int st = 0; st < 4; ++st) {
        const bf16x8 bk = *(const bf16x8*)(kbase + (size_t)(st * 32) * 512 + ks * 16);
        S[st] = MFMA(a, bk, S[st]);
      }
    }
#pragma unroll
    for (int st = 0; st < 4; ++st) {
      const int sl = st * 32 + lr;
      const float rs = s_r[sl];
#pragma unroll
      for (int r = 0; r < 16; ++r) {
        const int tl = wave * 32 + crow(r, hh);
        const bool valid = (DIR == 0) ? (sl <= tl) : (sl >= tl);
        const float pv = valid ? S[st][r] * __expf(s_al[tl] + rs) : 0.f;
        Pl[crow(r, hh) * 136 + sl] = f2bf(pv);
      }
    }
  }
  __syncthreads();
#pragma unroll
  for (int eh = 0; eh < 2; ++eh) {
    f32x16 N[3];
#pragma unroll
    for (int e = 0; e < 3; ++e)
#pragma unroll
      for (int r = 0; r < 16; ++r) N[e][r] = 0.f;
    {
      const u16* vbase = vT + ((size_t)(bh * 128 + eh * 64 + lr)) * 4096 + j * 128 + hh * 8;
#pragma unroll 2
      for (int ks = 0; ks < 8; ++ks) {
        const bf16x8 a = *(const bf16x8*)(Pl + lr * 136 + ks * 16 + hh * 8);
#pragma unroll
        for (int e2 = 0; e2 < 2; ++e2) {
          const bf16x8 bv = *(const bf16x8*)(vbase + (size_t)(e2 * 32) * 4096 + ks * 16);
          N[e2] = MFMA(a, bv, N[e2]);
        }
        N[2] = MFMA(a, ones, N[2]);
      }
    }
    {
      const float isc = s_is[wave * 32 + lr];
      const float* cbase = CS + (size_t)u * 16384 + (size_t)(eh * 64 + lr) * 128 + hh * 8;
      const float* nbase = ns + (size_t)u * 128 + hh * 8;
#pragma unroll 2
      for (int ks = 0; ks < 8; ++ks) {
        const bf16x8 aq = *(const bf16x8*)(qrow + ks * 16);
        const bf16x8 a = scale8(aq, isc);
#pragma unroll
        for (int e2 = 0; e2 < 2; ++e2) {
          const float4 c0 = *(const float4*)(cbase + (size_t)(e2 * 32) * 128 + ks * 16);
          const float4 c1 = *(const float4*)(cbase + (size_t)(e2 * 32) * 128 + ks * 16 + 4);
          const float cv[8] = {c0.x, c0.y, c0.z, c0.w, c1.x, c1.y, c1.z, c1.w};
          N[e2] = MFMA(a, pack8(cv), N[e2]);
        }
        const float4 n0 = *(const float4*)(nbase + ks * 16);
        const float4 n1 = *(const float4*)(nbase + ks * 16 + 4);
        const float nv[8] = {n0.x, n0.y, n0.z, n0.w, n1.x, n1.y, n1.z, n1.w};
        N[2] = MFMA(a, pack8(nv), N[2]);
      }
    }
#pragma unroll
    for (int r = 0; r < 16; ++r) {
      const int tl = wave * 32 + crow(r, hh);
      const float den = fmaxf(fabsf(N[2][r]), s_fl[tl]);
      const float inv = 1.f / den;
#pragma unroll
      for (int e2 = 0; e2 < 2; ++e2) {
        const float hv = N[e2][r] * inv;
        u16* tp = A2 + (size_t)(T0 + tl) * 1024 + h * 128 + (eh * 2 + e2) * 32 + lr;
        if (DIR == 0) *tp = f2bf(hv);
        else hs[eh * 2 + e2][r] = hv + bf2f(*tp);
      }
    }
  }
}

DI void mlstm_out_unit(const Params& p, int unit, char* smem) {
  const int tid = opaque_tid(), lane = tid & 63, wave = tid >> 6, lr = lane & 31, hh = lane >> 5;
  const int j = unit & 31, bh = unit >> 5, h = bh & 3, b = bh >> 2;
  const int T0 = b * 4096 + j * 128;
  const u16* og = (const u16*)(p.ws + OFF_OG);
  u16* A2 = (u16*)(p.ws + OFF_A2);
  f32x16 hs[4];
  mlstm_dir<0>(p, bh, j, smem, hs);
  mlstm_dir<1>(p, bh, j, smem, hs);
#pragma unroll
  for (int r = 0; r < 16; ++r) {
    const int T = T0 + wave * 32 + crow(r, hh);
    float ss = 0.f;
#pragma unroll
    for (int et = 0; et < 4; ++et) {
      const float o = bf2f(og[(size_t)T * 512 + h * 128 + et * 32 + lr]);
      hs[et][r] *= o;
      ss += hs[et][r] * hs[et][r];
    }
#pragma unroll
    for (int o = 1; o < 32; o <<= 1) ss += __shfl_xor(ss, o, 64);
    const float rs = rsqrtf(ss * (1.f / 128.f) + EPS);
#pragma unroll
    for (int et = 0; et < 4; ++et) {
      const int e = h * 128 + et * 32 + lr;
      A2[(size_t)T * 1024 + e] = f2bf(hs[et][r] * rs * p.mlstm_norm_w[e]);
    }
  }
}

DI void hyena_norm_unit(const Params& p, int unit, char* smem) {
  float* tile = (float*)smem;
  const int tid = opaque_tid();
  const int tt = unit & 63, g = (unit >> 6) & 7, b = unit >> 9;
  const float* z2T = (const float*)(p.ws + OFF_Z2T);
  u16* A2 = (u16*)(p.ws + OFF_A2);
  __syncthreads();
#pragma unroll 4
  for (int i = 0; i < 16; ++i) {
    const int cl = (tid >> 6) + 4 * i, tl = tid & 63;
    tile[cl * 65 + tl] = z2T[((size_t)(b * 512 + g * 64 + cl)) * 4096 + tt * 64 + tl];
  }
  __syncthreads();
  const int tl = tid >> 2, qd = tid & 3;
  float v[16];
  float ss = 0.f;
#pragma unroll
  for (int i = 0; i < 16; ++i) {
    v[i] = tile[(qd * 16 + i) * 65 + tl];
    ss += v[i] * v[i];
  }
  ss += __shfl_xor(ss, 1, 64);
  ss += __shfl_xor(ss, 2, 64);
  const float rs = rsqrtf(ss * (1.f / 64.f) + EPS);
  const size_t T = (size_t)b * 4096 + tt * 64 + tl;
  u16* dst = A2 + T * 1024 + 512 + g * 64 + qd * 16;
  const float* w = p.hyena_norm_w + g * 64 + qd * 16;
  float o[16];
#pragma unroll
  for (int i = 0; i < 16; ++i) o[i] = v[i] * rs * w[i];
  *(bf16x8*)(dst) = pack8(o);
  *(bf16x8*)(dst + 8) = pack8(o + 8);
}

template <int EPI>
DI void gemm_phase(const u16* A, const u16* Bt, int K, int ntn, void* outp, char* smem) {
  const int tid = threadIdx.x, lane = tid & 63, wave = tid >> 6, wr = wave >> 1, wc = wave & 1, lr = lane & 31, hh = lane >> 5;
  const int ntiles = 64 * ntn;
  for (int id = blockIdx.x; id < ntiles; id += gridDim.x) {
    int mt, nt;
    tile_map(id, ntn, mt, nt);
    const int m0 = mt * 256, n0 = nt * 128;
    f32x16 acc[4][2];
    gemm_core<false>(A, Bt, K, m0, n0, smem, acc);
#pragma unroll
    for (int i = 0; i < 4; ++i)
#pragma unroll
      for (int j = 0; j < 2; ++j)
#pragma unroll
        for (int r = 0; r < 16; ++r) {
          const int row = m0 + wr * 128 + i * 32 + crow(r, hh);
          const int col = n0 + wc * 64 + j * 32 + lr;
          const float val = acc[i][j][r];
          if (EPI == 0) ((float*)outp)[(size_t)row * 1024 + col] = val;
          else {
            const float rl = fmaxf(val, 0.f);
            ((u16*)outp)[(size_t)row * 4096 + col] = f2bf(rl * rl);
          }
        }
  }
}

DI void phase_post_mix(const Params& p) {
  const int tid = threadIdx.x, lane = tid & 63, wave = tid >> 6;
  const float* mix = p.out;
  float* x1 = (float*)(p.ws + OFF_X1);
  u16* hm = (u16*)(p.ws + OFF_HM);
  for (int u = blockIdx.x; u < 1024; u += gridDim.x) {
#pragma unroll 1
    for (int rr = 0; rr < 4; ++rr) {
      const size_t row = (size_t)u * 16 + wave * 4 + rr;
      float4 mv[4], xv[4];
      float ss = 0.f;
#pragma unroll
      for (int i = 0; i < 4; ++i) {
        mv[i] = ((const float4*)(mix + row * DM))[lane + 64 * i];
        xv[i] = ((const float4*)(p.x + row * DM))[lane + 64 * i];
        ss += mv[i].x * mv[i].x + mv[i].y * mv[i].y + mv[i].z * mv[i].z + mv[i].w * mv[i].w;
      }
      ss = wave_sum(ss);
      const float rs = rsqrtf(ss * (1.f / DM) + EPS);
      float s2 = 0.f;
#pragma unroll
      for (int i = 0; i < 4; ++i) {
        const float4 w = ((const float4*)p.norm_mix_post)[lane + 64 * i];
        xv[i].x += mv[i].x * rs * w.x; xv[i].y += mv[i].y * rs * w.y; xv[i].z += mv[i].z * rs * w.z; xv[i].w += mv[i].w * rs * w.w;
        s2 += xv[i].x * xv[i].x + xv[i].y * xv[i].y + xv[i].z * xv[i].z + xv[i].w * xv[i].w;
        ((float4*)(x1 + row * DM))[lane + 64 * i] = xv[i];
      }
      s2 = wave_sum(s2);
      const float r2 = rsqrtf(s2 * (1.f / DM) + EPS);
#pragma unroll
      for (int i = 0; i < 4; ++i) {
        const float4 w = ((const float4*)p.norm_mlp_pre)[lane + 64 * i];
        ushort4 o;
        o.x = f2bf(xv[i].x * r2 * w.x); o.y = f2bf(xv[i].y * r2 * w.y); o.z = f2bf(xv[i].z * r2 * w.z); o.w = f2bf(xv[i].w * r2 * w.w);
        *(ushort4*)(hm + row * DM + (lane + 64 * i) * 4) = o;
      }
    }
  }
}

DI void phase_final(const Params& p) {
  const int tid = threadIdx.x, lane = tid & 63, wave = tid >> 6;
  const float* x1 = (const float*)(p.ws + OFF_X1);
  for (int u = blockIdx.x; u < 1024; u += gridDim.x) {
#pragma unroll 1
    for (int rr = 0; rr < 4; ++rr) {
      const size_t row = (size_t)u * 16 + wave * 4 + rr;
      float4 fv[4];
      float ss = 0.f;
#pragma unroll
      for (int i = 0; i < 4; ++i) {
        fv[i] = ((const float4*)(p.out + row * DM))[lane + 64 * i];
        ss += fv[i].x * fv[i].x + fv[i].y * fv[i].y + fv[i].z * fv[i].z + fv[i].w * fv[i].w;
      }
      ss = wave_sum(ss);
      const float rs = rsqrtf(ss * (1.f / DM) + EPS);
#pragma unroll
      for (int i = 0; i < 4; ++i) {
        const float4 w = ((const float4*)p.norm_mlp_post)[lane + 64 * i];
        const float4 xv = ((const float4*)(x1 + row * DM))[lane + 64 * i];
        float4 o;
        o.x = xv.x + fv[i].x * rs * w.x; o.y = xv.y + fv[i].y * rs * w.y; o.z = xv.z + fv[i].z * rs * w.z; o.w = xv.w + fv[i].w * rs * w.w;
        ((float4*)(p.out + row * DM))[lane + 64 * i] = o;
      }
    }
  }
}

DI void run_phase(const Params& p, int ph, char* smem) {
  switch (ph) {
    case 0: phase0(p, smem); break;
    case 1: phase1(p, smem); break;
    case 2: phase_qk(p, smem); break;
    case 3:
      for (int u = blockIdx.x; u < 512 + 1024; u += gridDim.x) {
        if (u < 512) hyena_unit(p, u, smem);
        else mlstm_local_unit(p, u - 512, smem);
      }
      break;
    case 4:
      for (int u = blockIdx.x; u < 512; u += gridDim.x) scan_unit(p, u);
      break;
    case 5:
      for (int u = blockIdx.x; u < 512 + 2048; u += gridDim.x) {
#ifndef DBG_SKIP_MLSTM
        if (u < 512) mlstm_out_unit(p, u, smem);
#else
        if (u < 512) { u16* A2 = (u16*)(p.ws + OFF_A2); const int T0 = (u >> 5 >> 2) * 4096 + (u & 31) * 128, hq = (u >> 5) & 3;
          for (int i = threadIdx.x; i < 128 * 128; i += 256) A2[(size_t)(T0 + (i >> 7)) * 1024 + hq * 128 + (i & 127)] = 0; }
#endif
#ifndef DBG_SKIP_HYENA
        else hyena_norm_unit(p, u - 512, smem);
#else
        else { const int un = u - 512; const int tt = un & 63, g = (un >> 6) & 7, b = un >> 9; u16* A2 = (u16*)(p.ws + OFF_A2);
          for (int i = threadIdx.x; i < 64 * 64; i += 256) A2[((size_t)b * 4096 + tt * 64 + (i >> 6)) * 1024 + 512 + g * 64 + (i & 63)] = 0x3F80; }
#endif
      }
      break;
    case 6: gemm_phase<0>((const u16*)(p.ws + OFF_A2), (const u16*)(p.ws + OFF_WOUTT), 1024, 8, p.out, smem); break;
    case 7: phase_post_mix(p); break;
    case 8: gemm_phase<1>((const u16*)(p.ws + OFF_HM), (const u16*)(p.ws + OFF_W1T), 1024, 32, p.ws + OFF_H, smem); break;
    case 9: gemm_phase<0>((const u16*)(p.ws + OFF_H), (const u16*)(p.ws + OFF_W2T), 4096, 8, p.out, smem); break;
    case 10: phase_final(p); break;
  }
}
constexpr int NPHASE = 11;

#define XB_XCNT(j)  (256  + 64 * (j))
#define XB_XSUB(j)  (1280 + 64 * (j))
#define XB_XGEN(j)  (2304 + 64 * (j))
#define XB_TOP      3328
#define XB_TOPGEN   3392
#define XCD_BAR_WORDS 3456
DI unsigned xb_ld(unsigned* p) { return __hip_atomic_load(p, __ATOMIC_RELAXED, __HIP_MEMORY_SCOPE_AGENT); }
DI unsigned xb_add(unsigned* p, unsigned v) { return __hip_atomic_fetch_add(p, v, __ATOMIC_RELAXED, __HIP_MEMORY_SCOPE_AGENT); }
DI unsigned xb_xcc_id() { return (unsigned)__builtin_amdgcn_s_getreg((3 << 11) | 20) & 0xFu; }
struct XcdBar { unsigned* bar; unsigned x, nloc, nx; };
DI void xcd_barrier(XcdBar& b) {
  asm volatile("s_waitcnt vmcnt(0)" ::: "memory");
  __syncthreads();
  if (threadIdx.x == 0) {
    unsigned* bar = b.bar;
    __builtin_amdgcn_s_waitcnt(0);
    if (b.nloc == 0u) {
      const unsigned G = gridDim.x;
      unsigned sum, cnt, mine;
      for (;;) {
        sum = 0u; cnt = 0u; mine = 0u;
#pragma unroll
        for (unsigned j = 0; j < 16; ++j) { const unsigned c = xb_ld(&bar[XB_XCNT(j)]); sum += c; cnt += (c > 0u) ? 1u : 0u; mine = (j == b.x) ? c : mine; }
        if (sum == G) break;
        __builtin_amdgcn_s_sleep(1);
      }
      b.nloc = mine > 0u ? mine : 1u; b.nx = cnt > 0u ? cnt : 1u;
    }
    const unsigned nloc = b.nloc, nx = b.nx;
    const unsigned old = xb_add(&bar[XB_XSUB(b.x)], 1u);
    const unsigned gen = old / nloc;
    if (old + 1u == (gen + 1u) * nloc) {
      __builtin_amdgcn_fence(__ATOMIC_RELEASE, "agent");
      asm volatile("s_waitcnt vmcnt(0)" ::: "memory");
      const unsigned og = xb_add(&bar[XB_TOP], 1u);
      const unsigned tg = og / nx;
      if (og + 1u == (tg + 1u) * nx) xb_add(&bar[XB_TOPGEN], 1u);
      else while (xb_ld(&bar[XB_TOPGEN]) == tg) __builtin_amdgcn_s_sleep(1);
      __builtin_amdgcn_fence(__ATOMIC_ACQUIRE, "agent");
      xb_add(&bar[XB_XGEN(b.x)], 1u);
      asm volatile("s_waitcnt vmcnt(0)" ::: "memory");
    } else {
      while (xb_ld(&bar[XB_XGEN(b.x)]) == gen) __builtin_amdgcn_s_sleep(1);
      __builtin_amdgcn_fence(__ATOMIC_ACQUIRE, "agent");
      asm volatile("s_waitcnt vmcnt(0)" ::: "memory");
    }
  }
  __syncthreads();
}

#if MULTI_LAUNCH
template <int PH>
__global__ void __launch_bounds__(256, 2) phase_kernel(Params p) {
  __shared__ __attribute__((aligned(16))) char smem[65536];
  run_phase(p, PH, smem);
}
template <int PH>
static void launch_phase(const Params& p, hipStream_t stream) {
  hipLaunchKernelGGL(phase_kernel<PH>, dim3(512), dim3(256), 0, stream, p);
}
#else
__global__ void __launch_bounds__(256, 2) mega_kernel(Params p) {
  __shared__ __attribute__((aligned(16))) char smem[65536];
  cg::grid_group grid = cg::this_grid();
  XcdBar xb;
  xb.bar = (unsigned*)(p.ws + OFF_BAR); xb.x = xb_xcc_id(); xb.nloc = 0u; xb.nx = 0u;
  if (blockIdx.x == 0) for (int i = threadIdx.x; i < XCD_BAR_WORDS; i += 256) __hip_atomic_store(xb.bar + i, 0u, __ATOMIC_RELAXED, __HIP_MEMORY_SCOPE_AGENT);
#define GSYNC xcd_barrier(xb)
#ifdef DBL_P0
  run_phase(p, 0, smem);
#endif
  run_phase(p, 0, smem); grid.sync();
  if (threadIdx.x == 0) (void)xb_add(&xb.bar[XB_XCNT(xb.x)], 1u);
  run_phase(p, 1, smem); GSYNC;
#ifdef DBL_GEMM
  run_phase(p, 1, smem); grid.sync();
#endif
  run_phase(p, 2, smem); GSYNC;
#ifdef DBL_P2
  run_phase(p, 2, smem); GSYNC;
#endif
  run_phase(p, 3, smem); GSYNC;
#ifdef DBL_HY
  run_phase(p, 3, smem); GSYNC;
#endif
  run_phase(p, 4, smem); GSYNC;
  run_phase(p, 5, smem); GSYNC;
#ifdef DBL_P5
  run_phase(p, 5, smem); GSYNC;
#endif
  run_phase(p, 6, smem); GSYNC;
#ifdef DBL_GEMM
  run_phase(p, 6, smem); GSYNC;
#endif
  run_phase(p, 7, smem); GSYNC;
#ifdef DBL_P7
  run_phase(p, 7, smem); GSYNC;
#endif
  run_phase(p, 8, smem); GSYNC;
#ifdef DBL_GEMM
  run_phase(p, 8, smem); GSYNC;
#endif
  run_phase(p, 9, smem); GSYNC;
#ifdef DBL_GEMM
  run_phase(p, 9, smem); GSYNC;
#endif
#ifdef XSYNC
  for (int q = 0; q < 10; ++q) GSYNC;
#endif
  run_phase(p, 10, smem);
}
#endif

extern "C" void kernel_launch(void* const* d_in, const int* in_sizes, int n_in, void* d_out, int out_size, void* d_ws,
                              size_t ws_size, hipStream_t stream) {
  Params p{};
  const float** pp = (const float**)&p;
  for (int i = 0; i < 23; ++i) pp[i] = (const float*)d_in[i];
  p.out = (float*)d_out;
  p.ws = (char*)d_ws;
#if MULTI_LAUNCH
  launch_phase<0>(p, stream);
#ifdef DBL_P0
  launch_phase<0>(p, stream);
#endif
 launch_phase<1>(p, stream); launch_phase<2>(p, stream); launch_phase<3>(p, stream);
#ifdef DBL_HY
  launch_phase<3>(p, stream);
#endif

  launch_phase<4>(p, stream); launch_phase<5>(p, stream);
#ifdef DBL_P5
  launch_phase<5>(p, stream);
#endif
 launch_phase<6>(p, stream); launch_phase<7>(p, stream);
  launch_phase<8>(p, stream); launch_phase<9>(p, stream); launch_phase<10>(p, stream);
#else
  static int grid_blocks = 0;
  if (!grid_blocks) {
    int dev = 0, cus = 0, per_cu = 0;
    hipGetDevice(&dev);
    hipDeviceGetAttribute(&cus, hipDeviceAttributeMultiprocessorCount, dev);
    hipOccupancyMaxActiveBlocksPerMultiprocessor(&per_cu, mega_kernel, 256, 0);
    if (per_cu > 2) per_cu = 2;
    if (per_cu < 1) per_cu = 1;
#ifdef FORCE2
    per_cu = 2;
#endif
    grid_blocks = cus * per_cu;
  }
  void* args[] = {&p};
  hipError_t e = hipLaunchCooperativeKernel((void*)mega_kernel, dim3(grid_blocks), dim3(256), args, 0, stream);
  if (e != hipSuccess) fprintf(stderr, "cooperative launch failed: %s (grid %d)\n", hipGetErrorString(e), grid_blocks);
#endif
}
```

```cpp
#include <hip/hip_runtime.h>
#include <hip/hip_cooperative_groups.h>
#include <cstdio>
namespace cg = cooperative_groups;

#ifndef MULTI_LAUNCH
#define MULTI_LAUNCH 0
#endif

typedef unsigned short u16;
using bf16x8 = __attribute__((ext_vector_type(8))) short;
using f32x16 = __attribute__((ext_vector_type(16))) float;
#define DI __device__ __forceinline__
#define MFMA(a, b, c) __builtin_amdgcn_mfma_f32_32x32x16_bf16((a), (b), (c), 0, 0, 0)

constexpr int SEQ = 4096, DM = 1024, NTOK = 16384, NIN = 3600, NINP = 3712, DFF = 4096;
constexpr float EPS = 1e-6f;
constexpr size_t MiB = 1u << 20;
constexpr size_t OFF_WINT = 0, OFF_WOUTT = 8 * MiB, OFF_W1T = 10 * MiB, OFF_W2T = 18 * MiB;
constexpr size_t OFF_XN = 26 * MiB, OFF_QA = 26 * MiB, OFF_KA = 42 * MiB;
constexpr size_t OFF_FILT = 58 * MiB, OFF_QKPRE = 90 * MiB, OFF_A2 = 90 * MiB;
constexpr size_t OFF_HYT = 122 * MiB, OFF_VT = 170 * MiB, OFF_OG = 186 * MiB, OFF_GATES = 202 * MiB;
constexpr size_t OFF_NL = 203 * MiB, OFF_MLOC = 203 * MiB + 512 * 1024, OFF_GSUM = OFF_MLOC + 4096, OFF_MS = OFF_GSUM + 4096;
constexpr size_t OFF_KAT = 205 * MiB, OFF_Z2T = 221 * MiB;
constexpr size_t OFF_TW = 204 * MiB, OFF_BAR = 254 * MiB;
constexpr size_t OFF_X1 = 26 * MiB, OFF_HM = 90 * MiB, OFF_H = 122 * MiB;

struct Params {
  const float *x, *norm_mix_pre, *norm_mix_post, *norm_mlp_pre, *norm_mlp_post, *w_in, *b_gates, *conv_w, *conv_b,
      *mlstm_norm_w, *hyena_norm_w, *filt_w1, *filt_b1, *filt_w2, *filt_b2, *filt_w3, *filt_b3, *filt_w4, *filt_freq,
      *filt_bias, *w_out, *w_mlp_in, *w_mlp_out;
  float* out;
  char* ws;
};

DI u16 f2bf(float x) { unsigned u = __float_as_uint(x); u += 0x7fffu + ((u >> 16) & 1u); return (u16)(u >> 16); }
DI float bf2f(u16 v) { return __uint_as_float(((unsigned)v) << 16); }
DI int opaque_tid() { int t = threadIdx.x; asm volatile("" : "+v"(t)); return t; }
DI int crow(int r, int hh) { return (r & 3) + 8 * (r >> 2) + 4 * hh; }
DI float log_sigmoid(float x) { return fminf(x, 0.f) - log1pf(expf(-fabsf(x))); }
DI float sigmoidf(float x) { return 1.f / (1.f + expf(-x)); }
DI float red2pi(float x) {
  const float k = rintf(x * 0.15915494309189535f);
  float r = fmaf(-k, 6.28125f, x);
  return fmaf(-k, 1.9353071795864769e-3f, r);
}
DI float fsin(float x) { return sinf(x); }
DI float fcos(float x) { return cosf(x); }
DI bf16x8 pack8(const float* v) {
  bf16x8 r;
#pragma unroll
  for (int i = 0; i < 8; ++i) r[i] = (short)f2bf(v[i]);
  return r;
}
DI bf16x8 scale8(bf16x8 a, float s) {
  bf16x8 r;
#pragma unroll
  for (int i = 0; i < 8; ++i) r[i] = (short)f2bf(bf2f((u16)a[i]) * s);
  return r;
}

template <bool SWAP>
DI void gemm_core(const u16* __restrict__ A, const u16* __restrict__ Bt, int K, int m0, int n0, char* smem, f32x16 (&acc)[4][2]) {
  const int tid = opaque_tid(), lane = tid & 63, wave = tid >> 6, wr = wave >> 1, wc = wave & 1;
  const int lr = lane & 31, hh = lane >> 5;
#pragma unroll
  for (int i = 0; i < 4; ++i)
#pragma unroll
    for (int j = 0; j < 2; ++j)
#pragma unroll
      for (int r = 0; r < 16; ++r) acc[i][j][r] = 0.f;
  const int c = tid & 7, r0 = tid >> 3;
  const u16* Ag = A + (size_t)(m0 + r0) * K + c * 8;
  const u16* Bg = Bt + (size_t)(n0 + r0) * K + c * 8;
  const int soff = r0 * 128 + ((c ^ ((r0 >> 1) & 7)) << 4);
  char* As = smem;
  char* Bs = smem + 32768;
  uint4 ra0, ra1, ra2, ra3, ra4, ra5, ra6, ra7, rb0, rb1, rb2, rb3;
#define GLOAD_ALL(k0)                                                                                             \
  ra0 = *(const uint4*)(Ag + (size_t)(0) * K + (k0));   ra1 = *(const uint4*)(Ag + (size_t)(32) * K + (k0));      \
  ra2 = *(const uint4*)(Ag + (size_t)(64) * K + (k0));  ra3 = *(const uint4*)(Ag + (size_t)(96) * K + (k0));      \
  ra4 = *(const uint4*)(Ag + (size_t)(128) * K + (k0)); ra5 = *(const uint4*)(Ag + (size_t)(160) * K + (k0));     \
  ra6 = *(const uint4*)(Ag + (size_t)(192) * K + (k0)); ra7 = *(const uint4*)(Ag + (size_t)(224) * K + (k0));     \
  rb0 = *(const uint4*)(Bg + (size_t)(0) * K + (k0));   rb1 = *(const uint4*)(Bg + (size_t)(32) * K + (k0));      \
  rb2 = *(const uint4*)(Bg + (size_t)(64) * K + (k0));  rb3 = *(const uint4*)(Bg + (size_t)(96) * K + (k0));
  GLOAD_ALL(0)
  const int nk = K >> 6;
#pragma unroll 1
  for (int kt = 0; kt < nk; ++kt) {
    __syncthreads();
    *(uint4*)(As + soff + 0 * 4096) = ra0; *(uint4*)(As + soff + 1 * 4096) = ra1; *(uint4*)(As + soff + 2 * 4096) = ra2; *(uint4*)(As + soff + 3 * 4096) = ra3;
    *(uint4*)(As + soff + 4 * 4096) = ra4; *(uint4*)(As + soff + 5 * 4096) = ra5; *(uint4*)(As + soff + 6 * 4096) = ra6; *(uint4*)(As + soff + 7 * 4096) = ra7;
    *(uint4*)(Bs + soff + 0 * 4096) = rb0; *(uint4*)(Bs + soff + 1 * 4096) = rb1; *(uint4*)(Bs + soff + 2 * 4096) = rb2; *(uint4*)(Bs + soff + 3 * 4096) = rb3;
    __syncthreads();
    if (kt + 1 < nk) {
      const int k0 = (kt + 1) << 6;
      GLOAD_ALL(k0)
    }
#pragma unroll
    for (int kk = 0; kk < 4; ++kk) {
      bf16x8 a[4], b[2];
      const int cc = kk * 2 + hh;
#pragma unroll
      for (int i = 0; i < 4; ++i) {
        const int r = wr * 128 + i * 32 + lr;
        a[i] = *(const bf16x8*)(As + r * 128 + ((cc ^ ((r >> 1) & 7)) << 4));
      }
#pragma unroll
      for (int j = 0; j < 2; ++j) {
        const int r = wc * 64 + j * 32 + lr;
        b[j] = *(const bf16x8*)(Bs + r * 128 + ((cc ^ ((r >> 1) & 7)) << 4));
      }
#pragma unroll
      for (int i = 0; i < 4; ++i)
#pragma unroll
        for (int j = 0; j < 2; ++j) acc[i][j] = SWAP ? MFMA(b[j], a[i], acc[i][j]) : MFMA(a[i], b[j], acc[i][j]);
    }
  }
  __syncthreads();
}

DI void tile_map(int id, int ntn, int& mt, int& nt) {
  const int per = 16 * ntn;
  const int g = id / per, rem = id - g * per;
  mt = g * 16 + (rem & 15);
  nt = rem >> 4;
}

DI void transpose_tile(const float* __restrict__ src, int R, int C, u16* __restrict__ dst, int kt, int nt, char* smem) {
  float* tile = (float*)smem;
  const int tid = threadIdx.x;
  const int k0 = kt * 64, n0 = nt * 64;
#pragma unroll 4
  for (int it = 0; it < 16; ++it) {
    const int kk = it * 4 + (tid >> 6), nn = tid & 63;
    const int n = n0 + nn;
    tile[kk * 65 + nn] = (n < C) ? src[(size_t)(k0 + kk) * C + n] : 0.f;
  }
  __syncthreads();
#pragma unroll 4
  for (int it = 0; it < 16; ++it) {
    const int nn = it * 4 + (tid >> 6), kk = tid & 63;
    dst[(size_t)(n0 + nn) * R + k0 + kk] = f2bf(tile[kk * 65 + nn]);
  }
  __syncthreads();
}

DI float wave_sum(float v) {
#pragma unroll
  for (int o = 32; o; o >>= 1) v += __shfl_xor(v, o, 64);
  return v;
}

DI void filter_unit(const Params& p, int unit, char* smem) {
  float* sz = (float*)smem;
  float* hA = sz + 8 * 33 + 8;
  float* hB = hA + 8 * 64;
  float* hT = hB + 8 * 64;
  const int tid = opaque_tid();
  const int l0 = unit * 8;
  for (int idx = tid; idx < 8 * 33; idx += 256) {
    const int pp = idx / 33, f = idx - pp * 33;
    const float l = (float)(l0 + pp);
    float v;
    if (f == 0) v = l / 4095.f;
    else {
      const int jb = (f - 1) & 15;
      const float fj = 1e-4f + (float)jb * ((15.f - 1e-4f) / 15.f);
      const float ang = 6.283185307179586f * l / 4096.f;
      v = (f <= 16) ? fcos(fj * ang) : -fsin(fj * ang);
    }
    sz[idx] = v;
  }
  const int o = tid & 63, pq = tid >> 6;
  {
    const float bb = p.filt_b1[o], fr = p.filt_freq[o];
    __syncthreads();
    float s0 = bb, s1 = bb;
#pragma unroll 1
    for (int f0 = 0; f0 < 33; f0 += 11) {
      float wc[11];
#pragma unroll
      for (int f = 0; f < 11; ++f) wc[f] = p.filt_w1[(f0 + f) * 64 + o];
#pragma unroll
      for (int f = 0; f < 11; ++f) { s0 += sz[pq * 33 + f0 + f] * wc[f]; s1 += sz[(pq + 4) * 33 + f0 + f] * wc[f]; }
    }
    hA[pq * 64 + o] = fsin(fr * s0);
    hA[(pq + 4) * 64 + o] = fsin(fr * s1);
  }
  {
    const float bb = p.filt_b2[o], fr = p.filt_freq[64 + o];
    __syncthreads();
    float s0 = bb, s1 = bb;
#pragma unroll 1
    for (int k0 = 0; k0 < 64; k0 += 16) {
      float wc[16];
#pragma unroll
      for (int k = 0; k < 16; ++k) wc[k] = p.filt_w2[(k0 + k) * 64 + o];
#pragma unroll
      for (int k = 0; k < 16; ++k) { s0 += hA[pq * 64 + k0 + k] * wc[k]; s1 += hA[(pq + 4) * 64 + k0 + k] * wc[k]; }
    }
    hB[pq * 64 + o] = fsin(fr * s0);
    hB[(pq + 4) * 64 + o] = fsin(fr * s1);
  }
  {
    const float bb = p.filt_b3[o], fr = p.filt_freq[128 + o];
    __syncthreads();
    float s0 = bb, s1 = bb;
#pragma unroll 1
    for (int k0 = 0; k0 < 64; k0 += 16) {
      float wc[16];
#pragma unroll
      for (int k = 0; k < 16; ++k) wc[k] = p.filt_w3[(k0 + k) * 64 + o];
#pragma unroll
      for (int k = 0; k < 16; ++k) { s0 += hB[pq * 64 + k0 + k] * wc[k]; s1 += hB[(pq + 4) * 64 + k0 + k] * wc[k]; }
    }
    hT[o * 8 + pq] = fsin(fr * s0);
    hT[o * 8 + pq + 4] = fsin(fr * s1);
  }
  __syncthreads();
  float* filt = (float*)(p.ws + OFF_FILT);
  const float min_decay = -3.0701134573253944f, max_decay = -15.350567286626973f;
#pragma unroll 1
  for (int cc = 0; cc < 8; ++cc) {
    const int col = tid + 256 * cc;
    float acc[8];
#pragma unroll
    for (int q = 0; q < 8; ++q) acc[q] = 0.f;
#pragma unroll 1
    for (int k0 = 0; k0 < 64; k0 += 16) {
      float wc[16];
#pragma unroll
      for (int k = 0; k < 16; ++k) wc[k] = p.filt_w4[(k0 + k) * 2048 + col];
#pragma unroll
      for (int k = 0; k < 16; ++k) {
        const float4 h0 = *(const float4*)(hT + (k0 + k) * 8);
        const float4 h1 = *(const float4*)(hT + (k0 + k) * 8 + 4);
        acc[0] += h0.x * wc[k]; acc[1] += h0.y * wc[k]; acc[2] += h0.z * wc[k]; acc[3] += h0.w * wc[k];
        acc[4] += h1.x * wc[k]; acc[5] += h1.y * wc[k]; acc[6] += h1.z * wc[k]; acc[7] += h1.w * wc[k];
      }
    }
    const int ch = col & 511;
    const float delta = fabsf(min_decay + (float)ch * ((max_decay - min_decay) / 511.f));
#pragma unroll
    for (int q = 0; q < 8; ++q) {
      const float t = (float)(l0 + q) / 4095.f;
      acc[q] *= expf(-t * delta);
    }
    float4* dst = (float4*)(filt + (size_t)col * 4096 + l0);
    dst[0] = make_float4(acc[0], acc[1], acc[2], acc[3]);
    dst[1] = make_float4(acc[4], acc[5], acc[6], acc[7]);
  }
  __syncthreads();
}

DI void phase0(const Params& p, char* smem) {
  const int tid = threadIdx.x, lane = tid & 63, wave = tid >> 6;
  const int U_W = 32, U_F = 512, U_X = 1024, U_T1 = 58 * 16, U_T2 = 256, U_T3 = 1024, U_T4 = 1024;
  const int total = U_W + U_F + U_X + U_T1 + U_T2 + U_T3 + U_T4;
  for (int u = blockIdx.x; u < total; u += gridDim.x) {
    int v = u;
    if (v < U_W) {
      const int idx = v * 256 + tid;
      if (idx < 8191) {
        const int lh = 31 - __clz(idx + 1);
        const int h = 1 << lh, jj = idx + 1 - h;
        float2* twp = (float2*)(p.ws + OFF_TW);
        const float ang = -3.14159265358979f * (float)jj / (float)h;
        twp[idx] = make_float2(cosf(ang), sinf(ang));
      }
      continue;
    }
    v -= U_W;
    if (v < U_F) { filter_unit(p, v, smem); continue; }
    v -= U_F;
    if (v < U_X) {
      u16* xn = (u16*)(p.ws + OFF_XN);
#pragma unroll 1
      for (int rr = 0; rr < 4; ++rr) {
        const int row = v * 16 + wave * 4 + rr;
        const float4* xr = (const float4*)(p.x + (size_t)row * DM);
        float4 xv[4];
        float ss = 0.f;
#pragma unroll
        for (int i = 0; i < 4; ++i) {
          xv[i] = xr[lane + 64 * i];
          ss += xv[i].x * xv[i].x + xv[i].y * xv[i].y + xv[i].z * xv[i].z + xv[i].w * xv[i].w;
        }
        ss = wave_sum(ss);
        const float rs = rsqrtf(ss * (1.f / DM) + EPS);
#pragma unroll
        for (int i = 0; i < 4; ++i) {
          const float4 w = ((const float4*)p.norm_mix_pre)[lane + 64 * i];
          ushort4 o;
          o.x = f2bf(xv[i].x * rs * w.x); o.y = f2bf(xv[i].y * rs * w.y); o.z = f2bf(xv[i].z * rs * w.z); o.w = f2bf(xv[i].w * rs * w.w);
          *(ushort4*)(xn + (size_t)row * DM + (lane + 64 * i) * 4) = o;
        }
      }
      continue;
    }
    v -= U_X;
    if (v < U_T1) { transpose_tile(p.w_in, DM, NIN, (u16*)(p.ws + OFF_WINT), v & 15, v >> 4, smem); continue; }
    v -= U_T1;
    if (v < U_T2) { transpose_tile(p.w_out, DM, DM, (u16*)(p.ws + OFF_WOUTT), v & 15, v >> 4, smem); continue; }
    v -= U_T2;
    if (v < U_T3) { transpose_tile(p.w_mlp_in, DM, DFF, (u16*)(p.ws + OFF_W1T), v & 15, v >> 4, smem); continue; }
    v -= U_T3;
    transpose_tile(p.w_mlp_out, DFF, DM, (u16*)(p.ws + OFF_W2T), v & 63, v >> 6, smem);
  }
}

DI void phase1(const Params& p, char* smem) {
  const int tid = threadIdx.x, lane = tid & 63, wave = tid >> 6, wr = wave >> 1, wc = wave & 1, lr = lane & 31, hh = lane >> 5;
  const u16* xn = (const u16*)(p.ws + OFF_XN);
  const u16* wt = (const u16*)(p.ws + OFF_WINT);
  u16* qkpre = (u16*)(p.ws + OFF_QKPRE);
  u16* hyT = (u16*)(p.ws + OFF_HYT);
  u16* vT = (u16*)(p.ws + OFF_VT);
  u16* og = (u16*)(p.ws + OFF_OG);
  float* gates = (float*)(p.ws + OFF_GATES);
  const int ntn = 29, ntiles = 64 * ntn;
  for (int id = blockIdx.x; id < ntiles; id += gridDim.x) {
    int mt, nt;
    tile_map(id, ntn, mt, nt);
    const int m0 = mt * 256, n0 = nt * 128;
    f32x16 acc[4][2];
    const bool swap = (nt >= 8 && nt < 24);
    if (swap) gemm_core<true>(xn, wt, DM, m0, n0, smem, acc);
    else gemm_core<false>(xn, wt, DM, m0, n0, smem, acc);
#pragma unroll
    for (int i = 0; i < 4; ++i)
#pragma unroll
      for (int j = 0; j < 2; ++j)
#pragma unroll
        for (int r = 0; r < 16; ++r) {
          const float val = acc[i][j][r];
          if (!swap) {
            const int row = m0 + wr * 128 + i * 32 + crow(r, hh);
            const int col = n0 + wc * 64 + j * 32 + lr;
            if (nt < 8) qkpre[(size_t)row * 1024 + col] = f2bf(val);
            else if (nt < 28) og[(size_t)row * 512 + (col - 3072)] = f2bf(sigmoidf(val));
            else if (col < 3600) gates[(size_t)row * 16 + (col - 3584)] = val;
          } else {
            const int n = n0 + wc * 64 + j * 32 + crow(r, hh);
            const int m = m0 + wr * 128 + i * 32 + lr;
            const int b = m >> 12, t = m & 4095;
            if (nt < 20) {
              const int cc = n - 1024, g = cc >> 9, ch = cc & 511;
              hyT[((size_t)((g * 4 + b) * 512 + ch)) * 4096 + t] = f2bf(val);
            } else {
              const int cc = n - 2560;
              vT[((size_t)(b * 512 + cc)) * 4096 + t] = f2bf(val);
            }
          }
        }
  }
}

DI void phase_qk(const Params& p, char* smem) {
  u16* tile = (u16*)smem;
  const int tid = threadIdx.x;
  const u16* qkpre = (const u16*)(p.ws + OFF_QKPRE);
  u16* qa = (u16*)(p.ws + OFF_QA);
  u16* ka = (u16*)(p.ws + OFF_KA);
  u16* kaT = (u16*)(p.ws + OFF_KAT);
  for (int u = blockIdx.x; u < 4096; u += gridDim.x) {
    const int ct = u & 15, tt = u >> 4;
    const int C = ct * 64 + (tid & 63);
    const float w0 = p.conv_w[C], w1 = p.conv_w[2560 + C], w2 = p.conv_w[5120 + C], cb = p.conv_b[C];
#pragma unroll 4
    for (int i = 0; i < 16; ++i) {
      const int row = (tid >> 6) + 4 * i;
      const int T = tt * 64 + row, t = T & 4095;
      const float pm = t > 0 ? bf2f(qkpre[(size_t)(T - 1) * 1024 + C]) : 0.f;
      const float p0 = bf2f(qkpre[(size_t)T * 1024 + C]);
      const float pp = t < 4095 ? bf2f(qkpre[(size_t)(T + 1) * 1024 + C]) : 0.f;
      const float val = w0 * pm + w1 * p0 + w2 * pp + cb;
      float s = val * sigmoidf(val);
      if (C < 512) qa[(size_t)T * 512 + C] = f2bf(s);
      else {
        s *= 0.08838834764831845f;
        const u16 sb = f2bf(s);
        ka[(size_t)T * 512 + (C - 512)] = sb;
        tile[(tid & 63) * 66 + row] = sb;
      }
    }
    if (ct >= 8) {
      __syncthreads();
      const int b = (tt * 64) >> 12, t0 = (tt * 64) & 4095;
      const int d0 = (ct - 8) * 64;
#pragma unroll 4
      for (int i = 0; i < 16; ++i) {
        const int dl = (tid >> 6) + 4 * i, tl = tid & 63;
        kaT[((size_t)(b * 512 + d0 + dl)) * 4096 + t0 + tl] = tile[dl * 66 + tl];
      }
      __syncthreads();
    }
  }
}

DI float lz(float v) { asm volatile("" : "+v"(v)); return v; }
DI float2 mk2(float a, float b) { return make_float2(lz(a), lz(b)); }
DI float2 cmul(float2 a, float2 w) { return mk2(a.x * w.x - a.y * w.y, a.x * w.y + a.y * w.x); }
DI float2 cmulc(float2 a, float2 w) { return mk2(a.x * w.x + a.y * w.y, a.y * w.x - a.x * w.y); }
DI void fft_fwd(float2* x, int tid, const float2* __restrict__ tw) {
#pragma unroll 1
  for (int lq = 11; lq >= 1; lq -= 2) {
    const int q = 1 << lq;
    const float2* t1 = tw + (2 * q - 1);
    const float2* t2 = tw + (q - 1);
    const int jb = tid & (q - 1);
    float2 w1a = t1[jb], w2a = t2[jb];
    __syncthreads();
#pragma unroll 2
    for (int i = 0; i < 8; ++i) {
      const int k = tid + (i << 8);
      const int j = k & (q - 1);
      int base = ((k - j) << 2) + j;
      asm volatile("" : "+v"(base));
      float2 w1 = w1a, w2 = w2a;
      if (lq > 8) { w1 = t1[j]; w2 = t2[j]; }
      const float2 x0 = x[base], x1 = x[base + q], x2 = x[base + 2 * q], x3 = x[base + 3 * q];
      const float2 a0 = mk2(x0.x + x2.x, x0.y + x2.y);
      const float2 a1 = mk2(x1.x + x3.x, x1.y + x3.y);
      const float2 d02 = mk2(x0.x - x2.x, x0.y - x2.y);
      const float2 d13 = mk2(x1.y - x3.y, x3.x - x1.x);
      const float2 a2 = cmul(d02, w1);
      const float2 a3 = cmul(d13, w1);
      x[base] = mk2(a0.x + a1.x, a0.y + a1.y);
      x[base + q] = cmul(mk2(a0.x - a1.x, a0.y - a1.y), w2);
      x[base + 2 * q] = mk2(a2.x + a3.x, a2.y + a3.y);
      x[base + 3 * q] = cmul(mk2(a2.x - a3.x, a2.y - a3.y), w2);
    }
  }
  __syncthreads();
#pragma unroll 4
  for (int i = 0; i < 16; ++i) {
    const int i0 = (tid + (i << 8)) << 1;
    const float2 a = x[i0], b = x[i0 + 1];
    x[i0] = mk2(a.x + b.x, a.y + b.y);
    x[i0 + 1] = mk2(a.x - b.x, a.y - b.y);
  }
  __syncthreads();
}
DI void fft_inv(float2* x, int tid, const float2* __restrict__ tw) {
  __syncthreads();
#pragma unroll 4
  for (int i = 0; i < 16; ++i) {
    const int i0 = (tid + (i << 8)) << 1;
    const float2 a = x[i0], b = x[i0 + 1];
    x[i0] = mk2(a.x + b.x, a.y + b.y);
    x[i0 + 1] = mk2(a.x - b.x, a.y - b.y);
  }
#pragma unroll 1
  for (int lq = 1; lq <= 11; lq += 2) {
    const int q = 1 << lq;
    const float2* t1 = tw + (2 * q - 1);
    const float2* t2 = tw + (q - 1);
    const int jb = tid & (q - 1);
    float2 w1a = t1[jb], w2a = t2[jb];
    __syncthreads();
#pragma unroll 2
    for (int i = 0; i < 8; ++i) {
      const int k = tid + (i << 8);
      const int j = k & (q - 1);
      int base = ((k - j) << 2) + j;
      asm volatile("" : "+v"(base));
      float2 w1 = w1a, w2 = w2a;
      if (lq > 8) { w1 = t1[j]; w2 = t2[j]; }
      const float2 y0 = x[base], y1 = x[base + q], y2 = x[base + 2 * q], y3 = x[base + 3 * q];
      const float2 b1 = cmulc(y1, w2), b3 = cmulc(y3, w2);
      const float2 a0 = mk2(y0.x + b1.x, y0.y + b1.y);
      const float2 a1 = mk2(y0.x - b1.x, y0.y - b1.y);
      const float2 a2 = mk2(y2.x + b3.x, y2.y + b3.y);
      const float2 a3 = mk2(y2.x - b3.x, y2.y - b3.y);
      const float2 c2 = cmulc(a2, w1);
      const float2 c3t = cmulc(a3, w1);
      const float2 c3 = mk2(-c3t.y, c3t.x);
      x[base] = mk2(a0.x + c2.x, a0.y + c2.y);
      x[base + 2 * q] = mk2(a0.x - c2.x, a0.y - c2.y);
      x[base + q] = mk2(a1.x + c3.x, a1.y + c3.y);
      x[base + 3 * q] = mk2(a1.x - c3.x, a1.y - c3.y);
    }
  }
  __syncthreads();
}

DI float hy_conv(const u16* __restrict__ pr, int t, float w0, float w1, float w2, float cb) {
  const float a = t > 0 ? bf2f(pr[t - 1]) : 0.f;
  const float b = bf2f(pr[t]);
  const float c = t < 4095 ? bf2f(pr[t + 1]) : 0.f;
  return w0 * a + w1 * b + w2 * c + cb;
}

DI void hyena_unit(const Params& p, int ch, char* smem) {
  float2* buf = (float2*)smem;
  const int tid = opaque_tid();
  const u16* hyT = (const u16*)(p.ws + OFF_HYT);
  const float* filt = (const float*)(p.ws + OFF_FILT);
  float* z2T = (float*)(p.ws + OFF_Z2T);
  const float2* tw = (const float2*)(p.ws + OFF_TW);
  float2 Kr[32];
#pragma unroll 1
  for (int ord = 0; ord < 2; ++ord) {
    const float* kf = filt + (size_t)((0 * 2 + ord) * 512 + ch) * 4096;
    const float* kb = filt + (size_t)((1 * 2 + ord) * 512 + ch) * 4096;
    const float fb = p.filt_bias[ord * 512 + ch];
    __syncthreads();
#pragma unroll 4
    for (int n = tid; n < 8192; n += 256) {
      float v;
      if (n < 4096) v = kf[n];
      else if (n == 4096) v = 0.f;
      else v = kb[8192 - n];
      if (n == 0) v += fb;
      buf[n] = make_float2(v, 0.f);
    }
    fft_fwd(buf, tid, tw);
#pragma unroll
    for (int j = 0; j < 32; ++j) {
      const float2 v = buf[tid + 256 * j];
      Kr[j] = make_float2(v.x * (1.f / 8192.f), v.y * (1.f / 8192.f));
    }
    const int gcol = 1024 + (1 + ord) * 512 + ch;
    const float gw0 = p.conv_w[gcol], gw1 = p.conv_w[2560 + gcol], gw2 = p.conv_w[5120 + gcol], gcb = p.conv_b[gcol];
    const int vcol = 1024 + ch;
    const float vw0 = p.conv_w[vcol], vw1 = p.conv_w[2560 + vcol], vw2 = p.conv_w[5120 + vcol], vcb = p.conv_b[vcol];
#pragma unroll 1
    for (int pr = 0; pr < 2; ++pr) {
      const int b0 = 2 * pr, b1 = 2 * pr + 1;
      __syncthreads();
      if (ord == 0) {
        const u16* u0 = hyT + ((size_t)((0 * 4 + b0) * 512 + ch)) * 4096;
        const u16* u1 = hyT + ((size_t)((0 * 4 + b1) * 512 + ch)) * 4096;
#pragma unroll 2
        for (int i = 0; i < 16; ++i) {
          const int t = tid + 256 * i;
          buf[t] = make_float2(hy_conv(u0, t, vw0, vw1, vw2, vcb), hy_conv(u1, t, vw0, vw1, vw2, vcb));
          buf[4096 + t] = make_float2(0.f, 0.f);
        }
      } else {
        const float* u0 = z2T + ((size_t)(b0 * 512 + ch)) * 4096;
        const float* u1 = z2T + ((size_t)(b1 * 512 + ch)) * 4096;
#pragma unroll 4
        for (int i = 0; i < 16; ++i) {
          const int t = tid + 256 * i;
          buf[t] = make_float2(u0[t], u1[t]);
          buf[4096 + t] = make_float2(0.f, 0.f);
        }
      }
      fft_fwd(buf, tid, tw);
#pragma unroll
      for (int j = 0; j < 32; ++j) {
        const float2 v = buf[tid + 256 * j];
        buf[tid + 256 * j] = make_float2(v.x * Kr[j].x - v.y * Kr[j].y, v.x * Kr[j].y + v.y * Kr[j].x);
      }
      fft_inv(buf, tid, tw);
      const u16* g0 = hyT + ((size_t)(((1 + ord) * 4 + b0) * 512 + ch)) * 4096;
      const u16* g1 = hyT + ((size_t)(((1 + ord) * 4 + b1) * 512 + ch)) * 4096;
      float* o0 = z2T + ((size_t)(b0 * 512 + ch)) * 4096;
      float* o1 = z2T + ((size_t)(b1 * 512 + ch)) * 4096;
#pragma unroll 2
      for (int i = 0; i < 16; ++i) {
        const int t = tid + 256 * i;
        const float2 y = buf[t];
        o0[t] = hy_conv(g0, t, gw0, gw1, gw2, gcb) * y.x;
        o1[t] = hy_conv(g1, t, gw0, gw1, gw2, gcb) * y.y;
      }
    }
  }
  __syncthreads();
}

DI void mlstm_local_unit(const Params& p, int u, char* smem) {
  float* s_gi = (float*)smem;
  float* s_lf = s_gi + 128;
  float* s_a = s_lf + 128;
  float* s_w = s_a + 128;
  const int tid = opaque_tid(), lane = tid & 63, wave = tid >> 6, lr = lane & 31, hh = lane >> 5;
  const int j = u & 31, dir = (u >> 5) & 1, bh = u >> 6, h = bh & 3, b = bh >> 2;
  const int T0 = b * 4096 + j * 128;
  const float* gates = (const float*)(p.ws + OFF_GATES);
  const u16* vT = (const u16*)(p.ws + OFF_VT);
  const u16* kaT = (const u16*)(p.ws + OFF_KAT);
  float* CL = p.out;
  float* nl = (float*)(p.ws + OFF_NL);
  float* mloc = (float*)(p.ws + OFF_MLOC);
  float* gsum = (float*)(p.ws + OFF_GSUM);
  __syncthreads();
  if (tid < 128) {
    const int T = T0 + tid;
    s_gi[tid] = gates[(size_t)T * 16 + dir * 8 + h] + p.b_gates[dir * 8 + h];
    s_lf[tid] = log_sigmoid(gates[(size_t)T * 16 + dir * 8 + 4 + h] + p.b_gates[dir * 8 + 4 + h]);
  }
  __syncthreads();
  float gtot = 0.f;
  if (tid < 128) {
    float pre = 0.f;
#pragma unroll 4
    for (int m = 0; m < 128; ++m) {
      const float v = s_lf[m];
      if (m < tid) pre += v;
      gtot += v;
    }
    s_a[tid] = (dir == 0) ? (gtot - pre - s_lf[tid] + s_gi[tid]) : (pre + s_gi[tid]);
  }
  __syncthreads();
  if (tid < 128) {
    float mx = -3.0e38f;
#pragma unroll 4
    for (int m = 0; m < 128; ++m) mx = fmaxf(mx, s_a[m]);
    s_w[tid] = expf(s_a[tid] - mx);
    if (tid == 0) { mloc[u] = mx; gsum[u] = gtot; }
  }
  __syncthreads();
  f32x16 acc[4];
#pragma unroll
  for (int d = 0; d < 4; ++d)
#pragma unroll
    for (int r = 0; r < 16; ++r) acc[d][r] = 0.f;
  const u16* vrow = vT + ((size_t)(bh * 128 + wave * 32 + lr)) * 4096 + j * 128 + hh * 8;
  const u16* kbase = kaT + ((size_t)(bh * 128 + lr)) * 4096 + j * 128 + hh * 8;
#pragma unroll 2
  for (int ks = 0; ks < 8; ++ks) {
    const bf16x8 av = *(const bf16x8*)(vrow + ks * 16);
    bf16x8 a;
#pragma unroll
    for (int i = 0; i < 8; ++i) a[i] = (short)f2bf(bf2f((u16)av[i]) * s_w[ks * 16 + hh * 8 + i]);
#pragma unroll
    for (int dt = 0; dt < 4; ++dt) {
      const bf16x8 bk = *(const bf16x8*)(kbase + (size_t)(dt * 32) * 4096 + ks * 16);
      acc[dt] = MFMA(a, bk, acc[dt]);
    }
  }
  float* dst = CL + (size_t)u * 16384;
#pragma unroll
  for (int dt = 0; dt < 4; ++dt)
#pragma unroll
    for (int r = 0; r < 16; ++r) dst[(wave * 32 + crow(r, hh)) * 128 + dt * 32 + lr] = acc[dt][r];
  if (tid < 128) {
    const u16* kr = kaT + ((size_t)(bh * 128 + tid)) * 4096 + j * 128;
    float s = 0.f;
#pragma unroll 2
    for (int l = 0; l < 128; l += 8) {
      const bf16x8 kv = *(const bf16x8*)(kr + l);
#pragma unroll
      for (int i = 0; i < 8; ++i) s += s_w[l + i] * bf2f((u16)kv[i]);
    }
    nl[(size_t)u * 128 + tid] = s;
  }
}

DI void scan_unit(const Params& p, int unit) {
  const int tid = opaque_tid();
  const int sc = unit >> 4, part = unit & 15, dir = sc & 1;
  float* CL = p.out;
  float* nl = (float*)(p.ws + OFF_NL);
  const float* mloc = (const float*)(p.ws + OFF_MLOC);
  const float* gsum = (const float*)(p.ws + OFF_GSUM);
  float* ms = (float*)(p.ws + OFF_MS);
  const int idx = part * 1024 + tid * 4;
  float4 C = make_float4(0.f, 0.f, 0.f, 0.f);
  float nst = 0.f, m = 0.f;
  const bool do_n = (part == 0) && (tid < 128);
  float4 pf[4];
#pragma unroll
  for (int q = 0; q < 4; ++q) {
    const int jj = dir ? 31 - q : q;
    pf[q] = *(const float4*)(CL + (size_t)(sc * 32 + jj) * 16384 + idx);
  }
#pragma unroll 1
  for (int c0 = 0; c0 < 32; c0 += 4) {
#pragma unroll
    for (int q = 0; q < 4; ++q) {
      const int c = c0 + q;
      const int jj = dir ? 31 - c : c;
      const int u = sc * 32 + jj;
      const float4 cl = pf[q];
      *(float4*)(CL + (size_t)u * 16384 + idx) = C;
      if (c + 4 < 32) {
        const int j2 = dir ? 31 - (c + 4) : (c + 4);
        pf[q] = *(const float4*)(CL + (size_t)(sc * 32 + j2) * 16384 + idx);
      }
      const float g = gsum[u], ml = mloc[u];
      const float mn = fmaxf(g + m, ml);
      const float dec = expf(g + m - mn), scl = expf(ml - mn);
      C.x = dec * C.x + scl * cl.x; C.y = dec * C.y + scl * cl.y; C.z = dec * C.z + scl * cl.z; C.w = dec * C.w + scl * cl.w;
      if (do_n) {
        const float nv = nl[(size_t)u * 128 + tid];
        nl[(size_t)u * 128 + tid] = nst;
        nst = dec * nst + scl * nv;
      }
      if (part == 0 && tid == 0) ms[u] = m;
      m = mn;
    }
  }
}

template <int DIR>
DI void mlstm_dir(const Params& p, int bh, int j, char* smem, f32x16 (&hs)[4]) {
  float* s_gi = (float*)smem;
  float* s_lf = s_gi + 128;
  float* s_bc = s_lf + 128;
  float* s_r = s_bc + 128;
  float* s_al = s_r + 128;
  float* s_fl = s_al + 128;
  float* s_is = s_fl + 128;
  const int tid = opaque_tid(), lane = tid & 63, wave = tid >> 6, lr = lane & 31, hh = lane >> 5;
  u16* Pl = (u16*)(smem + 4096) + wave * (32 * 136);
  const int h = bh & 3, b = bh >> 2;
  const int T0 = b * 4096 + j * 128;
  const float* gates = (const float*)(p.ws + OFF_GATES);
  const u16* qa = (const u16*)(p.ws + OFF_QA);
  const u16* ka = (const u16*)(p.ws + OFF_KA);
  const u16* vT = (const u16*)(p.ws + OFF_VT);
  const float* CS = p.out;
  const float* ns = (const float*)(p.ws + OFF_NL);
  const float* ms = (const float*)(p.ws + OFF_MS);
  u16* A2 = (u16*)(p.ws + OFF_A2);
  bf16x8 ones;
#pragma unroll
  for (int i = 0; i < 8; ++i) ones[i] = (short)0x3F80;
  const u16* qrow = qa + (size_t)(T0 + wave * 32 + lr) * 512 + h * 128 + hh * 8;
  const int u = (bh * 2 + DIR) * 32 + j;
  const float msu = ms[u];
  __syncthreads();
  if (tid < 128) {
    const int T = T0 + tid;
    s_gi[tid] = gates[(size_t)T * 16 + DIR * 8 + h] + p.b_gates[DIR * 8 + h];
    s_lf[tid] = log_sigmoid(gates[(size_t)T * 16 + DIR * 8 + 4 + h] + p.b_gates[DIR * 8 + 4 + h]);
  }
  __syncthreads();
  if (tid < 128) {
    float a = 0.f;
#pragma unroll 4
    for (int m = 0; m < 128; ++m) {
      const bool in = (DIR == 0) ? (m <= tid) : (m >= tid);
      a += in ? s_lf[m] : 0.f;
    }
    s_bc[tid] = a;
    s_r[tid] = s_gi[tid] - a;
  }
  __syncthreads();
  if (tid < 128) {
    float cm = -3.0e38f;
#pragma unroll 4
    for (int m = 0; m < 128; ++m) {
      const bool in = (DIR == 0) ? (m <= tid) : (m >= tid);
      cm = in ? fmaxf(cm, s_r[m]) : cm;
    }
    const float bc = s_bc[tid];
    const float mt = bc + fmaxf(msu, cm);
    s_al[tid] = bc - mt;
    s_fl[tid] = expf(-mt);
    s_is[tid] = expf(bc + msu - mt);
  }
  __syncthreads();
  {
    f32x16 S[4];
#pragma unroll
    for (int st = 0; st < 4; ++st)
#pragma unroll
      for (int r = 0; r < 16; ++r) S[st][r] = 0.f;
    const u16* kbase = ka + (size_t)(T0 + lr) * 512 + h * 128 + hh * 8;
#pragma unroll 2
    for (int ks = 0; ks < 8; ++ks) {
      const bf16x8 a = *(const bf16x8*)(qrow + ks * 16);
#pragma unroll
      for (int st = 0; st < 4; ++st) {
        const bf16x8 bk = *(const bf16x8*)(kbase + (size_t)(st * 32) * 512 + ks * 16);
        S[st] = MFMA(a, bk, S[st]);
      }
    }
#pragma unroll
    for (int st = 0; st < 4; ++st) {
      const int sl = st * 32 + lr;
      const float rs = s_r[sl];
#pragma unroll
      for (int r = 0; r < 16; ++r) {
        const int tl = wave * 32 + crow(r, hh);
        const bool valid = (DIR == 0) ? (sl <= tl) : (sl >= tl);
        const float pv = valid ? S[st][r] * __expf(s_al[tl] + rs) : 0.f;
        Pl[crow(r, hh) * 136 + sl] = f2bf(pv);
      }
    }
  }
  __syncthreads();
#pragma unroll
  for (int eh = 0; eh < 2; ++eh) {
    f32x16 N[3];
#pragma unroll
    for (int e = 0; e < 3; ++e)
#pragma unroll
      for (int r = 0; r < 16; ++r) N[e][r] = 0.f;
    {
      const u16* vbase = vT + ((size_t)(bh * 128 + eh * 64 + lr)) * 4096 + j * 128 + hh * 8;
#pragma unroll 2
      for (int ks = 0; ks < 8; ++ks) {
        const bf16x8 a = *(const bf16x8*)(Pl + lr * 136 + ks * 16 + hh * 8);
#pragma unroll
        for (int e2 = 0; e2 < 2; ++e2) {
          const bf16x8 bv = *(const bf16x8*)(vbase + (size_t)(e2 * 32) * 4096 + ks * 16);
          N[e2] = MFMA(a, bv, N[e2]);
        }
        N[2] = MFMA(a, ones, N[2]);
      }
    }
    {
      const float isc = s_is[wave * 32 + lr];
      const float* cbase = CS + (size_t)u * 16384 + (size_t)(eh * 64 + lr) * 128 + hh * 8;
      const float* nbase = ns + (size_t)u * 128 + hh * 8;
#pragma unroll 2
      for (int ks = 0; ks < 8; ++ks) {
        const bf16x8 aq = *(const bf16x8*)(qrow + ks * 16);
        const bf16x8 a = scale8(aq, isc);
#pragma unroll
        for (int e2 = 0; e2 < 2; ++e2) {
          const float4 c0 = *(const float4*)(cbase + (size_t)(e2 * 32) * 128 + ks * 16);
          const float4 c1 = *(const float4*)(cbase + (size_t)(e2 * 32) * 128 + ks * 16 + 4);
          const float cv[8] = {c0.x, c0.y, c0.z, c0.w, c1.x, c1.y, c1.z, c1.w};
          N[e2] = MFMA(a, pack8(cv), N[e2]);
        }
        const float4 n0 = *(const float4*)(nbase + ks * 16);
        const float4 n1 = *(const float4*)(nbase + ks * 16 + 4);
        const float nv[8] = {n0.x, n0.y, n0.z, n0.w, n1.x, n1.y, n1.z, n1.w};
        N[2] = MFMA(a, pack8(nv), N[2]);
      }
    }
#pragma unroll
    for (int r = 0; r < 16; ++r) {
      const int tl = wave * 32 + crow(r, hh);
      const float den = fmaxf(fabsf(N[2][r]), s_fl[tl]);
      const float inv = 1.f / den;
#pragma unroll
      for (int e2 = 0; e2 < 2; ++e2) {
        const float hv = N[e2][r] * inv;
        u16* tp = A2 + (size_t)(T0 + tl) * 1024 + h * 128 + (eh * 2 + e2) * 32 + lr;
        if (DIR == 0) *tp = f2bf(hv);
        else hs[eh * 2 + e2][r] = hv + bf2f(*tp);
      }
    }
  }
}

DI void mlstm_out_unit(const Params& p, int unit, char* smem) {
  const int tid = opaque_tid(), lane = tid & 63, wave = tid >> 6, lr = lane & 31, hh = lane >> 5;
  const int j = unit & 31, bh = unit >> 5, h = bh & 3, b = bh >> 2;
  const int T0 = b * 4096 + j * 128;
  const u16* og = (const u16*)(p.ws + OFF_OG);
  u16* A2 = (u16*)(p.ws + OFF_A2);
  f32x16 hs[4];
  mlstm_dir<0>(p, bh, j, smem, hs);
  mlstm_dir<1>(p, bh, j, smem, hs);
#pragma unroll
  for (int r = 0; r < 16; ++r) {
    const int T = T0 + wave * 32 + crow(r, hh);
    float ss = 0.f;
#pragma unroll
    for (int et = 0; et < 4; ++et) {
      const float o = bf2f(og[(size_t)T * 512 + h * 128 + et * 32 + lr]);
      hs[et][r] *= o;
      ss += hs[et][r] * hs[et][r];
    }
#pragma unroll
    for (int o = 1; o < 32; o <<= 1) ss += __shfl_xor(ss, o, 64);
    const float rs = rsqrtf(ss * (1.f / 128.f) + EPS);
#pragma unroll
    for (int et = 0; et < 4; ++et) {
      const int e = h * 128 + et * 32 + lr;
      A2[(size_t)T * 1024 + e] = f2bf(hs[et][r] * rs * p.mlstm_norm_w[e]);
    }
  }
}

DI void hyena_norm_unit(const Params& p, int unit, char* smem) {
  float* tile = (float*)smem;
  const int tid = opaque_tid();
  const int tt = unit & 63, g = (unit >> 6) & 7, b = unit >> 9;
  const float* z2T = (const float*)(p.ws + OFF_Z2T);
  u16* A2 = (u16*)(p.ws + OFF_A2);
  __syncthreads();
#pragma unroll 4
  for (int i = 0; i < 16; ++i) {
    const int cl = (tid >> 6) + 4 * i, tl = tid & 63;
    tile[cl * 65 + tl] = z2T[((size_t)(b * 512 + g * 64 + cl)) * 4096 + tt * 64 + tl];
  }
  __syncthreads();
  const int tl = tid >> 2, qd = tid & 3;
  float v[16];
  float ss = 0.f;
#pragma unroll
  for (int i = 0; i < 16; ++i) {
    v[i] = tile[(qd * 16 + i) * 65 + tl];
    ss += v[i] * v[i];
  }
  ss += __shfl_xor(ss, 1, 64);
  ss += __shfl_xor(ss, 2, 64);
  const float rs = rsqrtf(ss * (1.f / 64.f) + EPS);
  const size_t T = (size_t)b * 4096 + tt * 64 + tl;
  u16* dst = A2 + T * 1024 + 512 + g * 64 + qd * 16;
  const float* w = p.hyena_norm_w + g * 64 + qd * 16;
  float o[16];
#pragma unroll
  for (int i = 0; i < 16; ++i) o[i] = v[i] * rs * w[i];
  *(bf16x8*)(dst) = pack8(o);
  *(bf16x8*)(dst + 8) = pack8(o + 8);
}

template <int EPI>
DI void gemm_phase(const u16* A, const u16* Bt, int K, int ntn, void* outp, char* smem) {
  const int tid = threadIdx.x, lane = tid & 63, wave = tid >> 6, wr = wave >> 1, wc = wave & 1, lr = lane & 31, hh = lane >> 5;
  const int ntiles = 64 * ntn;
  for (int id = blockIdx.x; id < ntiles; id += gridDim.x) {
    int mt, nt;
    tile_map(id, ntn, mt, nt);
    const int m0 = mt * 256, n0 = nt * 128;
    f32x16 acc[4][2];
    gemm_core<false>(A, Bt, K, m0, n0, smem, acc);
#pragma unroll
    for (int i = 0; i < 4; ++i)
#pragma unroll
      for (int j = 0; j < 2; ++j)
#pragma unroll
        for (int r = 0; r < 16; ++r) {
          const int row = m0 + wr * 128 + i * 32 + crow(r, hh);
          const int col = n0 + wc * 64 + j * 32 + lr;
          const float val = acc[i][j][r];
          if (EPI == 0) ((float*)outp)[(size_t)row * 1024 + col] = val;
          else {
            const float rl = fmaxf(val, 0.f);
            ((u16*)outp)[(size_t)row * 4096 + col] = f2bf(rl * rl);
          }
        }
  }
}

DI void phase_post_mix(const Params& p) {
  const int tid = threadIdx.x, lane = tid & 63, wave = tid >> 6;
  const float* mix = p.out;
  float* x1 = (float*)(p.ws + OFF_X1);
  u16* hm = (u16*)(p.ws + OFF_HM);
  for (int u = blockIdx.x; u < 1024; u += gridDim.x) {
#pragma unroll 1
    for (int rr = 0; rr < 4; ++rr) {
      const size_t row = (size_t)u * 16 + wave * 4 + rr;
      float4 mv[4], xv[4];
      float ss = 0.f;
#pragma unroll
      for (int i = 0; i < 4; ++i) {
        mv[i] = ((const float4*)(mix + row * DM))[lane + 64 * i];
        xv[i] = ((const float4*)(p.x + row * DM))[lane + 64 * i];
        ss += mv[i].x * mv[i].x + mv[i].y * mv[i].y + mv[i].z * mv[i].z + mv[i].w * mv[i].w;
      }
      ss = wave_sum(ss);
      const float rs = rsqrtf(ss * (1.f / DM) + EPS);
      float s2 = 0.f;
#pragma unroll
      for (int i = 0; i < 4; ++i) {
        const float4 w = ((const float4*)p.norm_mix_post)[lane + 64 * i];
        xv[i].x += mv[i].x * rs * w.x; xv[i].y += mv[i].y * rs * w.y; xv[i].z += mv[i].z * rs * w.z; xv[i].w += mv[i].w * rs * w.w;
        s2 += xv[i].x * xv[i].x + xv[i].y * xv[i].y + xv[i].z * xv[i].z + xv[i].w * xv[i].w;
        ((float4*)(x1 + row * DM))[lane + 64 * i] = xv[i];
      }
      s2 = wave_sum(s2);
      const float r2 = rsqrtf(s2 * (1.f / DM) + EPS);
#pragma unroll
      for (int i = 0; i < 4; ++i) {
        const float4 w = ((const float4*)p.norm_mlp_pre)[lane + 64 * i];
        ushort4 o;
        o.x = f2bf(xv[i].x * r2 * w.x); o.y = f2bf(xv[i].y * r2 * w.y); o.z = f2bf(xv[i].z * r2 * w.z); o.w = f2bf(xv[i].w * r2 * w.w);
        *(ushort4*)(hm + row * DM + (lane + 64 * i) * 4) = o;
      }
    }
  }
}

DI void phase_final(const Params& p) {
  const int tid = threadIdx.x, lane = tid & 63, wave = tid >> 6;
  const float* x1 = (const float*)(p.ws + OFF_X1);
  for (int u = blockIdx.x; u < 1024; u += gridDim.x) {
#pragma unroll 1
    for (int rr = 0; rr < 4; ++rr) {
      const size_t row = (size_t)u * 16 + wave * 4 + rr;
      float4 fv[4];
      float ss = 0.f;
#pragma unroll
      for (int i = 0; i < 4; ++i) {
        fv[i] = ((const float4*)(p.out + row * DM))[lane + 64 * i];
        ss += fv[i].x * fv[i].x + fv[i].y * fv[i].y + fv[i].z * fv[i].z + fv[i].w * fv[i].w;
      }
      ss = wave_sum(ss);
      const float rs = rsqrtf(ss * (1.f / DM) + EPS);
#pragma unroll
      for (int i = 0; i < 4; ++i) {
        const float4 w = ((const float4*)p.norm_mlp_post)[lane + 64 * i];
        const float4 xv = ((const float4*)(x1 + row * DM))[lane + 64 * i];
        float4 o;
        o.x = xv.x + fv[i].x * rs * w.x; o.y = xv.y + fv[i].y * rs * w.y; o.z = xv.z + fv[i].z * rs * w.z; o.w = xv.w + fv[i].w * rs * w.w;
        ((float4*)(p.out + row * DM))[lane + 64 * i] = o;
      }
    }
  }
}

DI void run_phase(const Params& p, int ph, char* smem) {
  switch (ph) {
    case 0: phase0(p, smem); break;
    case 1: phase1(p, smem); break;
    case 2: phase_qk(p, smem); break;
    case 3:
      for (int u = blockIdx.x; u < 512 + 1024; u += gridDim.x) {
        if (u < 512) hyena_unit(p, u, smem);
        else mlstm_local_unit(p, u - 512, smem);
      }
      break;
    case 4:
      for (int u = blockIdx.x; u < 512; u += gridDim.x) scan_unit(p, u);
      break;
    case 5:
      for (int u = blockIdx.x; u < 512 + 2048; u += gridDim.x) {
#ifndef DBG_SKIP_MLSTM
        if (u < 512) mlstm_out_unit(p, u, smem);
#else
        if (u < 512) { u16* A2 = (u16*)(p.ws + OFF_A2); const int T0 = (u >> 5 >> 2) * 4096 + (u & 31) * 128, hq = (u >> 5) & 3;
          for (int i = threadIdx.x; i < 128 * 128; i += 256) A2[(size_t)(T0 + (i >> 7)) * 1024 + hq * 128 + (i & 127)] = 0; }
#endif
#ifndef DBG_SKIP_HYENA
        else hyena_norm_unit(p, u - 512, smem);
#else
        else { const int un = u - 512; const int tt = un & 63, g = (un >> 6) & 7, b = un >> 9; u16* A2 = (u16*)(p.ws + OFF_A2);
          for (int i = threadIdx.x; i < 64 * 64; i += 256) A2[((size_t)b * 4096 + tt * 64 + (i >> 6)) * 1024 + 512 + g * 64 + (i & 63)] = 0x3F80; }
#endif
      }
      break;
    case 6: gemm_phase<0>((const u16*)(p.ws + OFF_A2), (const u16*)(p.ws + OFF_WOUTT), 1024, 8, p.out, smem); break;
    case 7: phase_post_mix(p); break;
    case 8: gemm_phase<1>((const u16*)(p.ws + OFF_HM), (const u16*)(p.ws + OFF_W1T), 1024, 32, p.ws + OFF_H, smem); break;
    case 9: gemm_phase<0>((const u16*)(p.ws + OFF_H), (const u16*)(p.ws + OFF_W2T), 4096, 8, p.out, smem); break;
    case 10: phase_final(p); break;
  }
}
constexpr int NPHASE = 11;

#define XB_XCNT(j)  (256  + 64 * (j))
#define XB_XSUB(j)  (1280 + 64 * (j))
#define XB_XGEN(j)  (2304 + 64 * (j))
#define XB_TOP      3328
#define XB_TOPGEN   3392
#define XCD_BAR_WORDS 3456
DI unsigned xb_ld(unsigned* p) { return __hip_atomic_load(p, __ATOMIC_RELAXED, __HIP_MEMORY_SCOPE_AGENT); }
DI unsigned xb_add(unsigned* p, unsigned v) { return __hip_atomic_fetch_add(p, v, __ATOMIC_RELAXED, __HIP_MEMORY_SCOPE_AGENT); }
DI unsigned xb_xcc_id() { return (unsigned)__builtin_amdgcn_s_getreg((3 << 11) | 20) & 0xFu; }
struct XcdBar { unsigned* bar; unsigned x, nloc, nx; };
DI void xcd_barrier(XcdBar& b) {
  asm volatile("s_waitcnt vmcnt(0)" ::: "memory");
  __syncthreads();
  if (threadIdx.x == 0) {
    unsigned* bar = b.bar;
    __builtin_amdgcn_s_waitcnt(0);
    if (b.nloc == 0u) {
      const unsigned G = gridDim.x;
      unsigned sum, cnt, mine;
      for (;;) {
        sum = 0u; cnt = 0u; mine = 0u;
#pragma unroll
        for (unsigned j = 0; j < 16; ++j) { const unsigned c = xb_ld(&bar[XB_XCNT(j)]); sum += c; cnt += (c > 0u) ? 1u : 0u; mine = (j == b.x) ? c : mine; }
        if (sum == G) break;
        __builtin_amdgcn_s_sleep(1);
      }
      b.nloc = mine > 0u ? mine : 1u; b.nx = cnt > 0u ? cnt : 1u;
    }
    const unsigned nloc = b.nloc, nx = b.nx;
    const unsigned old = xb_add(&bar[XB_XSUB(b.x)], 1u);
    const unsigned gen = old / nloc;
    if (old + 1u == (gen + 1u) * nloc) {
      __builtin_amdgcn_fence(__ATOMIC_RELEASE, "agent");
      asm volatile("s_waitcnt vmcnt(0)" ::: "memory");
      const unsigned og = xb_add(&bar[XB_TOP], 1u);
      const unsigned tg = og / nx;
      if (og + 1u == (tg + 1u) * nx) xb_add(&bar[XB_TOPGEN], 1u);
      else while (xb_ld(&bar[XB_TOPGEN]) == tg) __builtin_amdgcn_s_sleep(1);
      __builtin_amdgcn_fence(__ATOMIC_ACQUIRE, "agent");
      xb_add(&bar[XB_XGEN(b.x)], 1u);
      asm volatile("s_waitcnt vmcnt(0)" ::: "memory");
    } else {
      while (xb_ld(&bar[XB_XGEN(b.x)]) == gen) __builtin_amdgcn_s_sleep(1);
      __builtin_amdgcn_fence(__ATOMIC_ACQUIRE, "agent");
      asm volatile("s_waitcnt vmcnt(0)" ::: "memory");
    }
  }
  __syncthreads();
}

#if MULTI_LAUNCH
template <int PH>
__global__ void __launch_bounds__(256, 2) phase_kernel(Params p) {
  __shared__ __attribute__((aligned(16))) char smem[65536];
  run_phase(p, PH, smem);
}
template <int PH>
static void launch_phase(const Params& p, hipStream_t stream) {
  hipLaunchKernelGGL(phase_kernel<PH>, dim3(512), dim3(256), 0, stream, p);
}
#else
__global__ void __launch_bounds__(256, 2) mega_kernel(Params p) {
  __shared__ __attribute__((aligned(16))) char smem[65536];
  cg::grid_group grid = cg::this_grid();
  XcdBar xb;
  xb.bar = (unsigned*)(p.ws + OFF_BAR); xb.x = xb_xcc_id(); xb.nloc = 0u; xb.nx = 0u;
  if (blockIdx.x == 0) for (int i = threadIdx.x; i < XCD_BAR_WORDS; i += 256) __hip_atomic_store(xb.bar + i, 0u, __ATOMIC_RELAXED, __HIP_MEMORY_SCOPE_AGENT);
#define GSYNC xcd_barrier(xb)
#ifdef DBL_P0
  run_phase(p, 0, smem);
#endif
  run_phase(p, 0, smem); grid.sync();
  if (threadIdx.x == 0) (void)xb_add(&xb.bar[XB_XCNT(xb.x)], 1u);
  run_phase(p, 1, smem); GSYNC;
#ifdef DBL_GEMM
  run_phase(p, 1, smem); grid.sync();
#endif
  run_phase(p, 2, smem); GSYNC;
#ifdef DBL_P2
  run_phase(p, 2, smem); GSYNC;
#endif
  run_phase(p, 3, smem); GSYNC;
#ifdef DBL_HY
  run_phase(p, 3, smem); GSYNC;
#endif
  run_phase(p, 4, smem); GSYNC;
  run_phase(p, 5, smem); GSYNC;
#ifdef DBL_P5
  run_phase(p, 5, smem); GSYNC;
#endif
  run_phase(p, 6, smem); GSYNC;
#ifdef DBL_GEMM
  run_phase(p, 6, smem); GSYNC;
#endif
  run_phase(p, 7, smem); GSYNC;
#ifdef DBL_P7
  run_phase(p, 7, smem); GSYNC;
#endif
  run_phase(p, 8, smem); GSYNC;
#ifdef DBL_GEMM
  run_phase(p, 8, smem); GSYNC;
#endif
  run_phase(p, 9, smem); GSYNC;
#ifdef DBL_GEMM
  run_phase(p, 9, smem); GSYNC;
#endif
#ifdef XSYNC
  for (int q = 0; q < 10; ++q) GSYNC;
#endif
  run_phase(p, 10, smem);
}
#endif

extern "C" void kernel_launch(void* const* d_in, const int* in_sizes, int n_in, void* d_out, int out_size, void* d_ws,
                              size_t ws_size, hipStream_t stream) {
  Params p{};
  const float** pp = (const float**)&p;
  for (int i = 0; i < 23; ++i) pp[i] = (const float*)d_in[i];
  p.out = (float*)d_out;
  p.ws = (char*)d_ws;
#if MULTI_LAUNCH
  launch_phase<0>(p, stream);
#ifdef DBL_P0
  launch_phase<0>(p, stream);
#endif
 launch_phase<1>(p, stream); launch_phase<2>(p, stream); launch_phase<3>(p, stream);
#ifdef DBL_HY
  launch_phase<3>(p, stream);
#endif

  launch_phase<4>(p, stream); launch_phase<5>(p, stream);
#ifdef DBL_P5
  launch_phase<5>(p, stream);
#endif
 launch_phase<6>(p, stream); launch_phase<7>(p, stream);
  launch_phase<8>(p, stream); launch_phase<9>(p, stream); launch_phase<10>(p, stream);
#else
  static int grid_blocks = 0;
  if (!grid_blocks) {
    int dev = 0, cus = 0, per_cu = 0;
    hipGetDevice(&dev);
    hipDeviceGetAttribute(&cus, hipDeviceAttributeMultiprocessorCount, dev);
    hipOccupancyMaxActiveBlocksPerMultiprocessor(&per_cu, mega_kernel, 256, 0);
    if (per_cu > 2) per_cu = 2;
    if (per_cu < 1) per_cu = 1;
#ifdef FORCE2
    per_cu = 2;
#endif
    grid_blocks = cus * per_cu;
  }
  void* args[] = {&p};
  hipError_t e = hipLaunchCooperativeKernel((void*)mega_kernel, dim3(grid_blocks), dim3(256), args, 0, stream);
  if (e != hipSuccess) fprintf(stderr, "cooperative launch failed: %s (grid %d)\n", hipGetErrorString(e), grid_blocks);
#endif
}
```

```cpp
#if defined(__HIP_DEVICE_COMPILE__)
#pragma clang attribute push(__attribute__((target("no-packed-fp32-ops"))), apply_to = function)
#endif
#include <hip/hip_runtime.h>
#include <hip/hip_cooperative_groups.h>
#include <cstdio>
namespace cg = cooperative_groups;

#ifndef MULTI_LAUNCH
#define MULTI_LAUNCH 0
#endif

typedef unsigned short u16;
using bf16x8 = __attribute__((ext_vector_type(8))) short;
using f32x16 = __attribute__((ext_vector_type(16))) float;
#define DI __device__ __forceinline__
#define MFMA(a, b, c) __builtin_amdgcn_mfma_f32_32x32x16_bf16((a), (b), (c), 0, 0, 0)

constexpr int SEQ = 4096, DM = 1024, NTOK = 16384, NIN = 3600, NINP = 3712, DFF = 4096;
constexpr float EPS = 1e-6f;
constexpr size_t MiB = 1u << 20;
constexpr size_t OFF_WINT = 0, OFF_WOUTT = 8 * MiB, OFF_W1T = 10 * MiB, OFF_W2T = 18 * MiB;
constexpr size_t OFF_XN = 26 * MiB, OFF_QA = 26 * MiB, OFF_KA = 42 * MiB;
constexpr size_t OFF_FILT = 58 * MiB, OFF_QKPRE = 90 * MiB, OFF_A2 = 90 * MiB;
constexpr size_t OFF_HYT = 122 * MiB, OFF_VT = 170 * MiB, OFF_OG = 186 * MiB, OFF_GATES = 202 * MiB;
constexpr size_t OFF_NL = 203 * MiB, OFF_MLOC = 203 * MiB + 512 * 1024, OFF_GSUM = OFF_MLOC + 4096, OFF_MS = OFF_GSUM + 4096;
constexpr size_t OFF_KAT = 205 * MiB, OFF_Z2T = 221 * MiB;
constexpr size_t OFF_TW = 204 * MiB, OFF_BAR = 254 * MiB;
constexpr size_t OFF_X1 = 26 * MiB, OFF_HM = 90 * MiB, OFF_H = 122 * MiB;

struct Params {
  const float *x, *norm_mix_pre, *norm_mix_post, *norm_mlp_pre, *norm_mlp_post, *w_in, *b_gates, *conv_w, *conv_b,
      *mlstm_norm_w, *hyena_norm_w, *filt_w1, *filt_b1, *filt_w2, *filt_b2, *filt_w3, *filt_b3, *filt_w4, *filt_freq,
      *filt_bias, *w_out, *w_mlp_in, *w_mlp_out;
  float* out;
  char* ws;
};

DI u16 f2bf(float x) { unsigned u = __float_as_uint(x); u += 0x7fffu + ((u >> 16) & 1u); return (u16)(u >> 16); }
DI float bf2f(u16 v) { return __uint_as_float(((unsigned)v) << 16); }
DI int opaque_tid() { int t = threadIdx.x; asm volatile("" : "+v"(t)); return t; }
DI int crow(int r, int hh) { return (r & 3) + 8 * (r >> 2) + 4 * hh; }
DI float log_sigmoid(float x) { return fminf(x, 0.f) - log1pf(expf(-fabsf(x))); }
DI float sigmoidf(float x) { return 1.f / (1.f + expf(-x)); }
DI float red2pi(float x) {
  const float k = rintf(x * 0.15915494309189535f);
  float r = fmaf(-k, 6.28125f, x);
  return fmaf(-k, 1.9353071795864769e-3f, r);
}
DI float fsin(float x) { return sinf(x); }
DI float fcos(float x) { return cosf(x); }
DI bf16x8 pack8(const float* v) {
  bf16x8 r;
#pragma unroll
  for (int i = 0; i < 8; ++i) r[i] = (short)f2bf(v[i]);
  return r;
}
DI bf16x8 scale8(bf16x8 a, float s) {
  bf16x8 r;
#pragma unroll
  for (int i = 0; i < 8; ++i) r[i] = (short)f2bf(bf2f((u16)a[i]) * s);
  return r;
}

template <bool SWAP>
DI void gemm_core(const u16* __restrict__ A, const u16* __restrict__ Bt, int K, int m0, int n0, char* smem, f32x16 (&acc)[4][2]) {
  const int tid = opaque_tid(), lane = tid & 63, wave = tid >> 6, wr = wave >> 1, wc = wave & 1;
  const int lr = lane & 31, hh = lane >> 5;
#pragma unroll
  for (int i = 0; i < 4; ++i)
#pragma unroll
    for (int j = 0; j < 2; ++j)
#pragma unroll
      for (int r = 0; r < 16; ++r) acc[i][j][r] = 0.f;
  const int c = tid & 7, r0 = tid >> 3;
  const u16* Ag = A + (size_t)(m0 + r0) * K + c * 8;
  const u16* Bg = Bt + (size_t)(n0 + r0) * K + c * 8;
  const int soff = r0 * 128 + ((c ^ ((r0 >> 1) & 7)) << 4);
  char* As = smem;
  char* Bs = smem + 32768;
  uint4 ra0, ra1, ra2, ra3, ra4, ra5, ra6, ra7, rb0, rb1, rb2, rb3;
#define GLOAD_ALL(k0)                                                                                             \
  ra0 = *(const uint4*)(Ag + (size_t)(0) * K + (k0));   ra1 = *(const uint4*)(Ag + (size_t)(32) * K + (k0));      \
  ra2 = *(const uint4*)(Ag + (size_t)(64) * K + (k0));  ra3 = *(const uint4*)(Ag + (size_t)(96) * K + (k0));      \
  ra4 = *(const uint4*)(Ag + (size_t)(128) * K + (k0)); ra5 = *(const uint4*)(Ag + (size_t)(160) * K + (k0));     \
  ra6 = *(const uint4*)(Ag + (size_t)(192) * K + (k0)); ra7 = *(const uint4*)(Ag + (size_t)(224) * K + (k0));     \
  rb0 = *(const uint4*)(Bg + (size_t)(0) * K + (k0));   rb1 = *(const uint4*)(Bg + (size_t)(32) * K + (k0));      \
  rb2 = *(const uint4*)(Bg + (size_t)(64) * K + (k0));  rb3 = *(const uint4*)(Bg + (size_t)(96) * K + (k0));
  GLOAD_ALL(0)
  const int nk = K >> 6;
#pragma unroll 1
  for (int kt = 0; kt < nk; ++kt) {
    __syncthreads();
    *(uint4*)(As + soff + 0 * 4096) = ra0; *(uint4*)(As + soff + 1 * 4096) = ra1; *(uint4*)(As + soff + 2 * 4096) = ra2; *(uint4*)(As + soff + 3 * 4096) = ra3;
    *(uint4*)(As + soff + 4 * 4096) = ra4; *(uint4*)(As + soff + 5 * 4096) = ra5; *(uint4*)(As + soff + 6 * 4096) = ra6; *(uint4*)(As + soff + 7 * 4096) = ra7;
    *(uint4*)(Bs + soff + 0 * 4096) = rb0; *(uint4*)(Bs + soff + 1 * 4096) = rb1; *(uint4*)(Bs + soff + 2 * 4096) = rb2; *(uint4*)(Bs + soff + 3 * 4096) = rb3;
    __syncthreads();
    if (kt + 1 < nk) {
      const int k0 = (kt + 1) << 6;
      GLOAD_ALL(k0)
    }
#pragma unroll
    for (int kk = 0; kk < 4; ++kk) {
      bf16x8 a[4], b[2];
      const int cc = kk * 2 + hh;
#pragma unroll
      for (int i = 0; i < 4; ++i) {
        const int r = wr * 128 + i * 32 + lr;
        a[i] = *(const bf16x8*)(As + r * 128 + ((cc ^ ((r >> 1) & 7)) << 4));
      }
#pragma unroll
      for (int j = 0; j < 2; ++j) {
        const int r = wc * 64 + j * 32 + lr;
        b[j] = *(const bf16x8*)(Bs + r * 128 + ((cc ^ ((r >> 1) & 7)) << 4));
      }
#pragma unroll
      for (int i = 0; i < 4; ++i)
#pragma unroll
        for (int j = 0; j < 2; ++j) acc[i][j] = SWAP ? MFMA(b[j], a[i], acc[i][j]) : MFMA(a[i], b[j], acc[i][j]);
    }
  }
  __syncthreads();
}

DI void tile_map(int id, int ntn, int& mt, int& nt) {
  const int per = 16 * ntn;
  const int g = id / per, rem = id - g * per;
  mt = g * 16 + (rem & 15);
  nt = rem >> 4;
}

DI void transpose_tile(const float* __restrict__ src, int R, int C, u16* __restrict__ dst, int kt, int nt, char* smem) {
  float* tile = (float*)smem;
  const int tid = threadIdx.x;
  const int k0 = kt * 64, n0 = nt * 64;
#pragma unroll 4
  for (int it = 0; it < 16; ++it) {
    const int kk = it * 4 + (tid >> 6), nn = tid & 63;
    const int n = n0 + nn;
    tile[kk * 65 + nn] = (n < C) ? src[(size_t)(k0 + kk) * C + n] : 0.f;
  }
  __syncthreads();
#pragma unroll 4
  for (int it = 0; it < 16; ++it) {
    const int nn = it * 4 + (tid >> 6), kk = tid & 63;
    dst[(size_t)(n0 + nn) * R + k0 + kk] = f2bf(tile[kk * 65 + nn]);
  }
  __syncthreads();
}

DI float wave_sum(float v) {
#pragma unroll
  for (int o = 32; o; o >>= 1) v += __shfl_xor(v, o, 64);
  return v;
}

DI void filter_unit(const Params& p, int unit, char* smem) {
  float* sz = (float*)smem;
  float* hA = sz + 8 * 33 + 8;
  float* hB = hA + 8 * 64;
  float* hT = hB + 8 * 64;
  const int tid = opaque_tid();
  const int l0 = unit * 8;
  for (int idx = tid; idx < 8 * 33; idx += 256) {
    const int pp = idx / 33, f = idx - pp * 33;
    const float l = (float)(l0 + pp);
    float v;
    if (f == 0) v = l / 4095.f;
    else {
      const int jb = (f - 1) & 15;
      const float fj = 1e-4f + (float)jb * ((15.f - 1e-4f) / 15.f);
      const float ang = 6.283185307179586f * l / 4096.f;
      v = (f <= 16) ? fcos(fj * ang) : -fsin(fj * ang);
    }
    sz[idx] = v;
  }
  const int o = tid & 63, pq = tid >> 6;
  {
    const float bb = p.filt_b1[o], fr = p.filt_freq[o];
    __syncthreads();
    float s0 = bb, s1 = bb;
#pragma unroll 1
    for (int f0 = 0; f0 < 33; f0 += 11) {
      float wc[11];
#pragma unroll
      for (int f = 0; f < 11; ++f) wc[f] = p.filt_w1[(f0 + f) * 64 + o];
#pragma unroll
      for (int f = 0; f < 11; ++f) { s0 += sz[pq * 33 + f0 + f] * wc[f]; s1 += sz[(pq + 4) * 33 + f0 + f] * wc[f]; }
    }
    hA[pq * 64 + o] = fsin(fr * s0);
    hA[(pq + 4) * 64 + o] = fsin(fr * s1);
  }
  {
    const float bb = p.filt_b2[o], fr = p.filt_freq[64 + o];
    __syncthreads();
    float s0 = bb, s1 = bb;
#pragma unroll 1
    for (int k0 = 0; k0 < 64; k0 += 16) {
      float wc[16];
#pragma unroll
      for (int k = 0; k < 16; ++k) wc[k] = p.filt_w2[(k0 + k) * 64 + o];
#pragma unroll
      for (int k = 0; k < 16; ++k) { s0 += hA[pq * 64 + k0 + k] * wc[k]; s1 += hA[(pq + 4) * 64 + k0 + k] * wc[k]; }
    }
    hB[pq * 64 + o] = fsin(fr * s0);
    hB[(pq + 4) * 64 + o] = fsin(fr * s1);
  }
  {
    const float bb = p.filt_b3[o], fr = p.filt_freq[128 + o];
    __syncthreads();
    float s0 = bb, s1 = bb;
#pragma unroll 1
    for (int k0 = 0; k0 < 64; k0 += 16) {
      float wc[16];
#pragma unroll
      for (int k = 0; k < 16; ++k) wc[k] = p.filt_w3[(k0 + k) * 64 + o];
#pragma unroll
      for (int k = 0; k < 16; ++k) { s0 += hB[pq * 64 + k0 + k] * wc[k]; s1 += hB[(pq + 4) * 64 + k0 + k] * wc[k]; }
    }
    hT[o * 8 + pq] = fsin(fr * s0);
    hT[o * 8 + pq + 4] = fsin(fr * s1);
  }
  __syncthreads();
  float* filt = (float*)(p.ws + OFF_FILT);
  const float min_decay = -3.0701134573253944f, max_decay = -15.350567286626973f;
#pragma unroll 1
  for (int cc = 0; cc < 8; ++cc) {
    const int col = tid + 256 * cc;
    float acc[8];
#pragma unroll
    for (int q = 0; q < 8; ++q) acc[q] = 0.f;
#pragma unroll 1
    for (int k0 = 0; k0 < 64; k0 += 16) {
      float wc[16];
#pragma unroll
      for (int k = 0; k < 16; ++k) wc[k] = p.filt_w4[(k0 + k) * 2048 + col];
#pragma unroll
      for (int k = 0; k < 16; ++k) {
        const float4 h0 = *(const float4*)(hT + (k0 + k) * 8);
        const float4 h1 = *(const float4*)(hT + (k0 + k) * 8 + 4);
        acc[0] += h0.x * wc[k]; acc[1] += h0.y * wc[k]; acc[2] += h0.z * wc[k]; acc[3] += h0.w * wc[k];
        acc[4] += h1.x * wc[k]; acc[5] += h1.y * wc[k]; acc[6] += h1.z * wc[k]; acc[7] += h1.w * wc[k];
      }
    }
    const int ch = col & 511;
    const float delta = fabsf(min_decay + (float)ch * ((max_decay - min_decay) / 511.f));
#pragma unroll
    for (int q = 0; q < 8; ++q) {
      const float t = (float)(l0 + q) / 4095.f;
      acc[q] *= expf(-t * delta);
    }
    float4* dst = (float4*)(filt + (size_t)col * 4096 + l0);
    dst[0] = make_float4(acc[0], acc[1], acc[2], acc[3]);
    dst[1] = make_float4(acc[4], acc[5], acc[6], acc[7]);
  }
  __syncthreads();
}

DI void phase0(const Params& p, char* smem) {
  const int tid = threadIdx.x, lane = tid & 63, wave = tid >> 6;
  const int U_W = 32, U_F = 512, U_X = 1024, U_T1 = 58 * 16, U_T2 = 256, U_T3 = 1024, U_T4 = 1024;
  const int total = U_W + U_F + U_X + U_T1 + U_T2 + U_T3 + U_T4;
  for (int u = blockIdx.x; u < total; u += gridDim.x) {
    int v = u;
    if (v < U_W) {
      const int idx = v * 256 + tid;
      if (idx < 8191) {
        const int lh = 31 - __clz(idx + 1);
        const int h = 1 << lh, jj = idx + 1 - h;
        float2* twp = (float2*)(p.ws + OFF_TW);
        const float ang = -3.14159265358979f * (float)jj / (float)h;
        twp[idx] = make_float2(cosf(ang), sinf(ang));
      }
      continue;
    }
    v -= U_W;
    if (v < U_F) { filter_unit(p, v, smem); continue; }
    v -= U_F;
    if (v < U_X) {
      u16* xn = (u16*)(p.ws + OFF_XN);
#pragma unroll 4
      for (int rr = 0; rr < 4; ++rr) {
        const int row = v * 16 + wave * 4 + rr;
        const float4* xr = (const float4*)(p.x + (size_t)row * DM);
        float4 xv[4];
        float ss = 0.f;
#pragma unroll
        for (int i = 0; i < 4; ++i) {
          xv[i] = xr[lane + 64 * i];
          ss += xv[i].x * xv[i].x + xv[i].y * xv[i].y + xv[i].z * xv[i].z + xv[i].w * xv[i].w;
        }
        ss = wave_sum(ss);
        const float rs = rsqrtf(ss * (1.f / DM) + EPS);
#pragma unroll
        for (int i = 0; i < 4; ++i) {
          const float4 w = ((const float4*)p.norm_mix_pre)[lane + 64 * i];
          ushort4 o;
          o.x = f2bf(xv[i].x * rs * w.x); o.y = f2bf(xv[i].y * rs * w.y); o.z = f2bf(xv[i].z * rs * w.z); o.w = f2bf(xv[i].w * rs * w.w);
          *(ushort4*)(xn + (size_t)row * DM + (lane + 64 * i) * 4) = o;
        }
      }
      continue;
    }
    v -= U_X;
    if (v < U_T1) { transpose_tile(p.w_in, DM, NIN, (u16*)(p.ws + OFF_WINT), v & 15, v >> 4, smem); continue; }
    v -= U_T1;
    if (v < U_T2) { transpose_tile(p.w_out, DM, DM, (u16*)(p.ws + OFF_WOUTT), v & 15, v >> 4, smem); continue; }
    v -= U_T2;
    if (v < U_T3) { transpose_tile(p.w_mlp_in, DM, DFF, (u16*)(p.ws + OFF_W1T), v & 15, v >> 4, smem); continue; }
    v -= U_T3;
    transpose_tile(p.w_mlp_out, DFF, DM, (u16*)(p.ws + OFF_W2T), v & 63, v >> 6, smem);
  }
}

DI void phase1(const Params& p, char* smem) {
  const int tid = threadIdx.x, lane = tid & 63, wave = tid >> 6, wr = wave >> 1, wc = wave & 1, lr = lane & 31, hh = lane >> 5;
  const u16* xn = (const u16*)(p.ws + OFF_XN);
  const u16* wt = (const u16*)(p.ws + OFF_WINT);
  u16* qkpre = (u16*)(p.ws + OFF_QKPRE);
  u16* hyT = (u16*)(p.ws + OFF_HYT);
  u16* vT = (u16*)(p.ws + OFF_VT);
  u16* og = (u16*)(p.ws + OFF_OG);
  float* gates = (float*)(p.ws + OFF_GATES);
  const int ntn = 29, ntiles = 64 * ntn;
  for (int id = blockIdx.x; id < ntiles; id += gridDim.x) {
    int mt, nt;
    tile_map(id, ntn, mt, nt);
    const int m0 = mt * 256, n0 = nt * 128;
    f32x16 acc[4][2];
    const bool swap = (nt >= 8 && nt < 24);
    if (swap) gemm_core<true>(xn, wt, DM, m0, n0, smem, acc);
    else gemm_core<false>(xn, wt, DM, m0, n0, smem, acc);
#pragma unroll
    for (int i = 0; i < 4; ++i)
#pragma unroll
      for (int j = 0; j < 2; ++j)
#pragma unroll
        for (int r = 0; r < 16; ++r) {
          const float val = acc[i][j][r];
          if (!swap) {
            const int row = m0 + wr * 128 + i * 32 + crow(r, hh);
            const int col = n0 + wc * 64 + j * 32 + lr;
            if (nt < 8) qkpre[(size_t)row * 1024 + col] = f2bf(val);
            else if (nt < 28) og[(size_t)row * 512 + (col - 3072)] = f2bf(sigmoidf(val));
            else if (col < 3600) gates[(size_t)row * 16 + (col - 3584)] = val;
          } else {
            const int n = n0 + wc * 64 + j * 32 + crow(r, hh);
            const int m = m0 + wr * 128 + i * 32 + lr;
            const int b = m >> 12, t = m & 4095;
            if (nt < 20) {
              const int cc = n - 1024, g = cc >> 9, ch = cc & 511;
              hyT[((size_t)((g * 4 + b) * 512 + ch)) * 4096 + t] = f2bf(val);
            } else {
              const int cc = n - 2560;
              vT[((size_t)(b * 512 + cc)) * 4096 + t] = f2bf(val);
            }
          }
        }
  }
}

DI void phase_qk(const Params& p, char* smem) {
  u16* tile = (u16*)smem;
  const int tid = threadIdx.x;
  const u16* qkpre = (const u16*)(p.ws + OFF_QKPRE);
  u16* qa = (u16*)(p.ws + OFF_QA);
  u16* ka = (u16*)(p.ws + OFF_KA);
  u16* kaT = (u16*)(p.ws + OFF_KAT);
  for (int u = blockIdx.x; u < 4096; u += gridDim.x) {
    const int ct = u & 15, tt = u >> 4;
    const int C = ct * 64 + (tid & 63);
    const float w0 = p.conv_w[C], w1 = p.conv_w[2560 + C], w2 = p.conv_w[5120 + C], cb = p.conv_b[C];
#pragma unroll 4
    for (int i = 0; i < 16; ++i) {
      const int row = (tid >> 6) + 4 * i;
      const int T = tt * 64 + row, t = T & 4095;
      const float pm = t > 0 ? bf2f(qkpre[(size_t)(T - 1) * 1024 + C]) : 0.f;
      const float p0 = bf2f(qkpre[(size_t)T * 1024 + C]);
      const float pp = t < 4095 ? bf2f(qkpre[(size_t)(T + 1) * 1024 + C]) : 0.f;
      const float val = w0 * pm + w1 * p0 + w2 * pp + cb;
      float s = val * sigmoidf(val);
      if (C < 512) qa[(size_t)T * 512 + C] = f2bf(s);
      else {
        s *= 0.08838834764831845f;
        const u16 sb = f2bf(s);
        ka[(size_t)T * 512 + (C - 512)] = sb;
        tile[(tid & 63) * 66 + row] = sb;
      }
    }
    if (ct >= 8) {
      __syncthreads();
      const int b = (tt * 64) >> 12, t0 = (tt * 64) & 4095;
      const int d0 = (ct - 8) * 64;
#pragma unroll 4
      for (int i = 0; i < 16; ++i) {
        const int dl = (tid >> 6) + 4 * i, tl = tid & 63;
        kaT[((size_t)(b * 512 + d0 + dl)) * 4096 + t0 + tl] = tile[dl * 66 + tl];
      }
      __syncthreads();
    }
  }
}

DI float lz(float v) { asm volatile("" : "+v"(v)); return v; }
DI float2 mk2(float a, float b) { return make_float2(a, b); }
DI float2 cmul(float2 a, float2 w) { return mk2(a.x * w.x - a.y * w.y, a.x * w.y + a.y * w.x); }
DI float2 cmulc(float2 a, float2 w) { return mk2(a.x * w.x + a.y * w.y, a.y * w.x - a.x * w.y); }
template <int NW, bool INV>
DI void r4_pass(float2* x, int tid, int q, const float2* __restrict__ t1, const float2* __restrict__ t2) {
  constexpr int NL = NW > 4 ? 4 : NW;
  constexpr int NB = NW > 4 ? 2 : 1;
  constexpr int CNT = 8 / NB;
#pragma unroll 1
  for (int bt = 0; bt < NB; ++bt) {
    float2 w1[NL], w2[NL];
#pragma unroll
    for (int n = 0; n < NL; ++n) { const int j = (tid + ((bt * CNT + n) << 8)) & (q - 1); w1[n] = t1[j]; w2[n] = t2[j]; }
    if (bt == 0) __syncthreads();
#pragma unroll(NL == 4 ? 4 : 2)
    for (int ii = 0; ii < CNT; ++ii) {
      const int k = tid + ((bt * CNT + ii) << 8);
      const int j = k & (q - 1);
      int base = ((k - j) << 2) + j;
      asm volatile("" : "+v"(base));
      const float2 ww1 = w1[ii % NL], ww2 = w2[ii % NL];
      const float2 x0 = x[base], x1 = x[base + q], x2 = x[base + 2 * q], x3 = x[base + 3 * q];
      if (!INV) {
        const float2 a0 = mk2(x0.x + x2.x, x0.y + x2.y);
        const float2 a1 = mk2(x1.x + x3.x, x1.y + x3.y);
        const float2 d02 = mk2(x0.x - x2.x, x0.y - x2.y);
        const float2 d13 = mk2(x1.y - x3.y, x3.x - x1.x);
        const float2 a2 = cmul(d02, ww1);
        const float2 a3 = cmul(d13, ww1);
        x[base] = mk2(a0.x + a1.x, a0.y + a1.y);
        x[base + q] = cmul(mk2(a0.x - a1.x, a0.y - a1.y), ww2);
        x[base + 2 * q] = mk2(a2.x + a3.x, a2.y + a3.y);
        x[base + 3 * q] = cmul(mk2(a2.x - a3.x, a2.y - a3.y), ww2);
      } else {
        const float2 b1 = cmulc(x1, ww2), b3 = cmulc(x3, ww2);
        const float2 a0 = mk2(x0.x + b1.x, x0.y + b1.y);
        const float2 a1 = mk2(x0.x - b1.x, x0.y - b1.y);
        const float2 a2 = mk2(x2.x + b3.x, x2.y + b3.y);
        const float2 a3 = mk2(x2.x - b3.x, x2.y - b3.y);
        const float2 c2 = cmulc(a2, ww1);
        const float2 c3t = cmulc(a3, ww1);
        const float2 c3 = mk2(-c3t.y, c3t.x);
        x[base] = mk2(a0.x + c2.x, a0.y + c2.y);
        x[base + 2 * q] = mk2(a0.x - c2.x, a0.y - c2.y);
        x[base + q] = mk2(a1.x + c3.x, a1.y + c3.y);
        x[base + 3 * q] = mk2(a1.x - c3.x, a1.y - c3.y);
      }
    }
  }
}
DI void r2_last(float2* x, int tid) {
#pragma unroll 4
  for (int i = 0; i < 16; ++i) {
    const int i0 = (tid + (i << 8)) << 1;
    const float2 a = x[i0], b = x[i0 + 1];
    x[i0] = mk2(a.x + b.x, a.y + b.y);
    x[i0 + 1] = mk2(a.x - b.x, a.y - b.y);
  }
}
DI void fft_fwd(float2* x, int tid, const float2* __restrict__ tw) {
  r4_pass<8, false>(x, tid, 2048, tw + 4095, tw + 2047);
  r4_pass<2, false>(x, tid, 512, tw + 1023, tw + 511);
  r4_pass<1, false>(x, tid, 128, tw + 255, tw + 127);
  r4_pass<1, false>(x, tid, 32, tw + 63, tw + 31);
  r4_pass<1, false>(x, tid, 8, tw + 15, tw + 7);
  r4_pass<1, false>(x, tid, 2, tw + 3, tw + 1);
  __syncthreads();
  r2_last(x, tid);
  __syncthreads();
}
DI void fft_inv(float2* x, int tid, const float2* __restrict__ tw) {
  __syncthreads();
  r2_last(x, tid);
  r4_pass<1, true>(x, tid, 2, tw + 3, tw + 1);
  r4_pass<1, true>(x, tid, 8, tw + 15, tw + 7);
  r4_pass<1, true>(x, tid, 32, tw + 63, tw + 31);
  r4_pass<1, true>(x, tid, 128, tw + 255, tw + 127);
  r4_pass<2, true>(x, tid, 512, tw + 1023, tw + 511);
  r4_pass<8, true>(x, tid, 2048, tw + 4095, tw + 2047);
  __syncthreads();
}

DI float hy_conv(const u16* __restrict__ pr, int t, float w0, float w1, float w2, float cb) {
  const float a = t > 0 ? bf2f(pr[t - 1]) : 0.f;
  const float b = bf2f(pr[t]);
  const float c = t < 4095 ? bf2f(pr[t + 1]) : 0.f;
  return w0 * a + w1 * b + w2 * c + cb;
}

DI void hyena_unit(const Params& p, int ch, char* smem) {
  float2* buf = (float2*)smem;
  const int tid = opaque_tid();
  const u16* hyT = (const u16*)(p.ws + OFF_HYT);
  const float* filt = (const float*)(p.ws + OFF_FILT);
  float* z2T = (float*)(p.ws + OFF_Z2T);
  const float2* tw = (const float2*)(p.ws + OFF_TW);
  float2 Kr[32];
#pragma unroll 1
  for (int ord = 0; ord < 2; ++ord) {
    const float* kf = filt + (size_t)((0 * 2 + ord) * 512 + ch) * 4096;
    const float* kb = filt + (size_t)((1 * 2 + ord) * 512 + ch) * 4096;
    const float fb = p.filt_bias[ord * 512 + ch];
    __syncthreads();
#pragma unroll 4
    for (int n = tid; n < 8192; n += 256) {
      float v;
      if (n < 4096) v = kf[n];
      else if (n == 4096) v = 0.f;
      else v = kb[8192 - n];
      if (n == 0) v += fb;
      buf[n] = make_float2(v, 0.f);
    }
    fft_fwd(buf, tid, tw);
#pragma unroll
    for (int j = 0; j < 32; ++j) {
      const float2 v = buf[tid + 256 * j];
      Kr[j] = make_float2(v.x * (1.f / 8192.f), v.y * (1.f / 8192.f));
    }
    const int gcol = 1024 + (1 + ord) * 512 + ch;
    const float gw0 = p.conv_w[gcol], gw1 = p.conv_w[2560 + gcol], gw2 = p.conv_w[5120 + gcol], gcb = p.conv_b[gcol];
    const int vcol = 1024 + ch;
    const float vw0 = p.conv_w[vcol], vw1 = p.conv_w[2560 + vcol], vw2 = p.conv_w[5120 + vcol], vcb = p.conv_b[vcol];
#pragma unroll 1
    for (int pr = 0; pr < 2; ++pr) {
      const int b0 = 2 * pr, b1 = 2 * pr + 1;
      __syncthreads();
      if (ord == 0) {
        const u16* u0 = hyT + ((size_t)((0 * 4 + b0) * 512 + ch)) * 4096;
        const u16* u1 = hyT + ((size_t)((0 * 4 + b1) * 512 + ch)) * 4096;
#pragma unroll 2
        for (int i = 0; i < 16; ++i) {
          const int t = tid + 256 * i;
          buf[t] = make_float2(hy_conv(u0, t, vw0, vw1, vw2, vcb), hy_conv(u1, t, vw0, vw1, vw2, vcb));
          buf[4096 + t] = make_float2(0.f, 0.f);
        }
      } else {
        const float* u0 = z2T + ((size_t)(b0 * 512 + ch)) * 4096;
        const float* u1 = z2T + ((size_t)(b1 * 512 + ch)) * 4096;
#pragma unroll 4
        for (int i = 0; i < 16; ++i) {
          const int t = tid + 256 * i;
          buf[t] = make_float2(u0[t], u1[t]);
          buf[4096 + t] = make_float2(0.f, 0.f);
        }
      }
      fft_fwd(buf, tid, tw);
#pragma unroll
      for (int j = 0; j < 32; ++j) {
        const float2 v = buf[tid + 256 * j];
        buf[tid + 256 * j] = make_float2(v.x * Kr[j].x - v.y * Kr[j].y, v.x * Kr[j].y + v.y * Kr[j].x);
      }
      fft_inv(buf, tid, tw);
      const u16* g0 = hyT + ((size_t)(((1 + ord) * 4 + b0) * 512 + ch)) * 4096;
      const u16* g1 = hyT + ((size_t)(((1 + ord) * 4 + b1) * 512 + ch)) * 4096;
      float* o0 = z2T + ((size_t)(b0 * 512 + ch)) * 4096;
      float* o1 = z2T + ((size_t)(b1 * 512 + ch)) * 4096;
#pragma unroll 2
      for (int i = 0; i < 16; ++i) {
        const int t = tid + 256 * i;
        const float2 y = buf[t];
        o0[t] = hy_conv(g0, t, gw0, gw1, gw2, gcb) * y.x;
        o1[t] = hy_conv(g1, t, gw0, gw1, gw2, gcb) * y.y;
      }
    }
  }
  __syncthreads();
}

DI void mlstm_local_unit(const Params& p, int u, char* smem) {
  float* s_gi = (float*)smem;
  float* s_lf = s_gi + 128;
  float* s_a = s_lf + 128;
  float* s_w = s_a + 128;
  const int tid = opaque_tid(), lane = tid & 63, wave = tid >> 6, lr = lane & 31, hh = lane >> 5;
  const int j = u & 31, dir = (u >> 5) & 1, bh = u >> 6, h = bh & 3, b = bh >> 2;
  const int T0 = b * 4096 + j * 128;
  const float* gates = (const float*)(p.ws + OFF_GATES);
  const u16* vT = (const u16*)(p.ws + OFF_VT);
  const u16* kaT = (const u16*)(p.ws + OFF_KAT);
  float* CL = p.out;
  float* nl = (float*)(p.ws + OFF_NL);
  float* mloc = (float*)(p.ws + OFF_MLOC);
  float* gsum = (float*)(p.ws + OFF_GSUM);
  __syncthreads();
  if (tid < 128) {
    const int T = T0 + tid;
    s_gi[tid] = gates[(size_t)T * 16 + dir * 8 + h] + p.b_gates[dir * 8 + h];
    s_lf[tid] = log_sigmoid(gates[(size_t)T * 16 + dir * 8 + 4 + h] + p.b_gates[dir * 8 + 4 + h]);
  }
  __syncthreads();
  float gtot = 0.f;
  if (tid < 128) {
    float pre = 0.f;
#pragma unroll 4
    for (int m = 0; m < 128; ++m) {
      const float v = s_lf[m];
      if (m < tid) pre += v;
      gtot += v;
    }
    s_a[tid] = (dir == 0) ? (gtot - pre - s_lf[tid] + s_gi[tid]) : (pre + s_gi[tid]);
  }
  __syncthreads();
  if (tid < 128) {
    float mx = -3.0e38f;
#pragma unroll 4
    for (int m = 0; m < 128; ++m) mx = fmaxf(mx, s_a[m]);
    s_w[tid] = expf(s_a[tid] - mx);
    if (tid == 0) { mloc[u] = mx; gsum[u] = gtot; }
  }
  __syncthreads();
  f32x16 acc[4];
#pragma unroll
  for (int d = 0; d < 4; ++d)
#pragma unroll
    for (int r = 0; r < 16; ++r) acc[d][r] = 0.f;
  const u16* vrow = vT + ((size_t)(bh * 128 + wave * 32 + lr)) * 4096 + j * 128 + hh * 8;
  const u16* kbase = kaT + ((size_t)(bh * 128 + lr)) * 4096 + j * 128 + hh * 8;
#pragma unroll 2
  for (int ks = 0; ks < 8; ++ks) {
    const bf16x8 av = *(const bf16x8*)(vrow + ks * 16);
    bf16x8 a;
#pragma unroll
    for (int i = 0; i < 8; ++i) a[i] = (short)f2bf(bf2f((u16)av[i]) * s_w[ks * 16 + hh * 8 + i]);
#pragma unroll
    for (int dt = 0; dt < 4; ++dt) {
      const bf16x8 bk = *(const bf16x8*)(kbase + (size_t)(dt * 32) * 4096 + ks * 16);
      acc[dt] = MFMA(a, bk, acc[dt]);
    }
  }
  float* dst = CL + (size_t)u * 16384;
#pragma unroll
  for (int dt = 0; dt < 4; ++dt)
#pragma unroll
    for (int r = 0; r < 16; ++r) dst[(wave * 32 + crow(r, hh)) * 128 + dt * 32 + lr] = acc[dt][r];
  if (tid < 128) {
    const u16* kr = kaT + ((size_t)(bh * 128 + tid)) * 4096 + j * 128;
    float s = 0.f;
#pragma unroll 2
    for (int l = 0; l < 128; l += 8) {
      const bf16x8 kv = *(const bf16x8*)(kr + l);
#pragma unroll
      for (int i = 0; i < 8; ++i) s += s_w[l + i] * bf2f((u16)kv[i]);
    }
    nl[(size_t)u * 128 + tid] = s;
  }
}

DI void scan_unit(const Params& p, int unit) {
  const int tid = opaque_tid();
  const int sc = unit >> 4, part = unit & 15, dir = sc & 1;
  float* CL = p.out;
  float* nl = (float*)(p.ws + OFF_NL);
  const float* mloc = (const float*)(p.ws + OFF_MLOC);
  const float* gsum = (const float*)(p.ws + OFF_GSUM);
  float* ms = (float*)(p.ws + OFF_MS);
  const int idx = part * 1024 + tid * 4;
  float4 C = make_float4(0.f, 0.f, 0.f, 0.f);
  float nst = 0.f, m = 0.f;
  const bool do_n = (part == 0) && (tid < 128);
  float4 pf[4];
#pragma unroll
  for (int q = 0; q < 4; ++q) {
    const int jj = dir ? 31 - q : q;
    pf[q] = *(const float4*)(CL + (size_t)(sc * 32 + jj) * 16384 + idx);
  }
#pragma unroll 1
  for (int c0 = 0; c0 < 32; c0 += 4) {
#pragma unroll
    for (int q = 0; q < 4; ++q) {
      const int c = c0 + q;
      const int jj = dir ? 31 - c : c;
      const int u = sc * 32 + jj;
      const float4 cl = pf[q];
      *(float4*)(CL + (size_t)u * 16384 + idx) = C;
      if (c + 4 < 32) {
        const int j2 = dir ? 31 - (c + 4) : (c + 4);
        pf[q] = *(const float4*)(CL + (size_t)(sc * 32 + j2) * 16384 + idx);
      }
      const float g = gsum[u], ml = mloc[u];
      const float mn = fmaxf(g + m, ml);
      const float dec = expf(g + m - mn), scl = expf(ml - mn);
      C.x = dec * C.x + scl * cl.x; C.y = dec * C.y + scl * cl.y; C.z = dec * C.z + scl * cl.z; C.w = dec * C.w + scl * cl.w;
      if (do_n) {
        const float nv = nl[(size_t)u * 128 + tid];
        nl[(size_t)u * 128 + tid] = nst;
        nst = dec * nst + scl * nv;
      }
      if (part == 0 && tid == 0) ms[u] = m;
      m = mn;
    }
  }
}

template <int DIR>
DI void mlstm_dir(const Params& p, int bh, int j, char* smem, f32x16 (&hs)[4]) {
  float* s_gi = (float*)smem;
  float* s_lf = s_gi + 128;
  float* s_bc = s_lf + 128;
  float* s_r = s_bc + 128;
  float* s_al = s_r + 128;
  float* s_fl = s_al + 128;
  float* s_is = s_fl + 128;
  const int tid = opaque_tid(), lane = tid & 63, wave = tid >> 6, lr = lane & 31, hh = lane >> 5;
  u16* Pl = (u16*)(smem + 4096) + wave * (32 * 136);
  const int h = bh & 3, b = bh >> 2;
  const int T0 = b * 4096 + j * 128;
  const float* gates = (const float*)(p.ws + OFF_GATES);
  const u16* qa = (const u16*)(p.ws + OFF_QA);
  const u16* ka = (const u16*)(p.ws + OFF_KA);
  const u16* vT = (const u16*)(p.ws + OFF_VT);
  const float* CS = p.out;
  const float* ns = (const float*)(p.ws + OFF_NL);
  const float* ms = (const float*)(p.ws + OFF_MS);
  u16* A2 = (u16*)(p.ws + OFF_A2);
  bf16x8 ones;
#pragma unroll
  for (int i = 0; i < 8; ++i) ones[i] = (short)0x3F80;
  const u16* qrow = qa + (size_t)(T0 + wave * 32 + lr) * 512 + h * 128 + hh * 8;
  const int u = (bh * 2 + DIR) * 32 + j;
  const float msu = ms[u];
  __syncthreads();
  if (tid < 128) {
    const int T = T0 + tid;
    s_gi[tid] = gates[(size_t)T * 16 + DIR * 8 + h] + p.b_gates[DIR * 8 + h];
    s_lf[tid] = log_sigmoid(gates[(size_t)T * 16 + DIR * 8 + 4 + h] + p.b_gates[DIR * 8 + 4 + h]);
  }
  __syncthreads();
  if (tid < 128) {
    float a = 0.f;
#pragma unroll 4
    for (int m = 0; m < 128; ++m) {
      const bool in = (DIR == 0) ? (m <= tid) : (m >= tid);
      a += in ? s_lf[m] : 0.f;
    }
    s_bc[tid] = a;
    s_r[tid] = s_gi[tid] - a;
  }
  __syncthreads();
  if (tid < 128) {
    float cm = -3.0e38f;
#pragma unroll 4
    for (int m = 0; m < 128; ++m) {
      const bool in = (DIR == 0) ? (m <= tid) : (m >= tid);
      cm = in ? fmaxf(cm, s_r[m]) : cm;
    }
    const float bc = s_bc[tid];
    const float mt = bc + fmaxf(msu, cm);
    s_al[tid] = bc - mt;
    s_fl[tid] = expf(-mt);
    s_is[tid] = expf(bc + msu - mt);
  }
  __syncthreads();
  {
    f32x16 S[4];
#pragma unroll
    for (int st = 0; st < 4; ++st)
#pragma unroll
      for (int r = 0; r < 16; ++r) S[st][r] = 0.f;
    const u16* kbase = ka + (size_t)(T0 + lr) * 512 + h * 128 + hh * 8;
#pragma unroll 2
    for (int ks = 0; ks < 8; ++ks) {
      const bf16x8 a = *(const bf16x8*)(qrow + ks * 16);
#pragma unroll
      for (int st = 0; st < 4; ++st) {
        const bf16x8 bk = *(const bf16x8*)(kbase + (size_t)(st * 32) * 512 + ks * 16);
        S[st] = MFMA(a, bk, S[st]);
      }
    }
#pragma unroll
    for (int st = 0; st < 4; ++st) {
      const int sl = st * 32 + lr;
      const float rs = s_r[sl];
#pragma unroll
      for (int r = 0; r < 16; ++r) {
        const int tl = wave * 32 + crow(r, hh);
        const bool valid = (DIR == 0) ? (sl <= tl) : (sl >= tl);
        const float pv = valid ? S[st][r] * __expf(s_al[tl] + rs) : 0.f;
        Pl[crow(r, hh) * 136 + sl] = f2bf(pv);
      }
    }
  }
  __syncthreads();
#pragma unroll
  for (int eh = 0; eh < 2; ++eh) {
    f32x16 N[3];
#pragma unroll
    for (int e = 0; e < 3; ++e)
#pragma unroll
      for (int r = 0; r < 16; ++r) N[e][r] = 0.f;
    {
      const u16* vbase = vT + ((size_t)(bh * 128 + eh * 64 + lr)) * 4096 + j * 128 + hh * 8;
#pragma unroll 2
      for (int ks = 0; ks < 8; ++ks) {
        const bf16x8 a = *(const bf16x8*)(Pl + lr * 136 + ks * 16 + hh * 8);
#pragma unroll
        for (int e2 = 0; e2 < 2; ++e2) {
          const bf16x8 bv = *(const bf16x8*)(vbase + (size_t)(e2 * 32) * 4096 + ks * 16);
          N[e2] = MFMA(a, bv, N[e2]);
        }
        N[2] = MFMA(a, ones, N[2]);
      }
    }
    {
      const float isc = s_is[wave * 32 + lr];
      const float* cbase = CS + (size_t)u * 16384 + (size_t)(eh * 64 + lr) * 128 + hh * 8;
      const float* nbase = ns + (size_t)u * 128 + hh * 8;
#pragma unroll 2
      for (int ks = 0; ks < 8; ++ks) {
        const bf16x8 aq = *(const bf16x8*)(qrow + ks * 16);
        const bf16x8 a = scale8(aq, isc);
#pragma unroll
        for (int e2 = 0; e2 < 2; ++e2) {
          const float4 c0 = *(const float4*)(cbase + (size_t)(e2 * 32) * 128 + ks * 16);
          const float4 c1 = *(const float4*)(cbase + (size_t)(e2 * 32) * 128 + ks * 16 + 4);
          const float cv[8] = {c0.x, c0.y, c0.z, c0.w, c1.x, c1.y, c1.z, c1.w};
          N[e2] = MFMA(a, pack8(cv), N[e2]);
        }
        const float4 n0 = *(const float4*)(nbase + ks * 16);
        const float4 n1 = *(const float4*)(nbase + ks * 16 + 4);
        const float nv[8] = {n0.x, n0.y, n0.z, n0.w, n1.x, n1.y, n1.z, n1.w};
        N[2] = MFMA(a, pack8(nv), N[2]);
      }
    }
#pragma unroll
    for (int r = 0; r < 16; ++r) {
      const int tl = wave * 32 + crow(r, hh);
      const float den = fmaxf(fabsf(N[2][r]), s_fl[tl]);
      const float inv = 1.f / den;
#pragma unroll
      for (int e2 = 0; e2 < 2; ++e2) {
        const float hv = N[e2][r] * inv;
        u16* tp = A2 + (size_t)(T0 + tl) * 1024 + h * 128 + (eh * 2 + e2) * 32 + lr;
        if (DIR == 0) *tp = f2bf(hv);
        else hs[eh * 2 + e2][r] = hv + bf2f(*tp);
      }
    }
  }
}

DI void mlstm_out_unit(const Params& p, int unit, char* smem) {
  const int tid = opaque_tid(), lane = tid & 63, wave = tid >> 6, lr = lane & 31, hh = lane >> 5;
  const int j = unit & 31, bh = unit >> 5, h = bh & 3, b = bh >> 2;
  const int T0 = b * 4096 + j * 128;
  const u16* og = (const u16*)(p.ws + OFF_OG);
  u16* A2 = (u16*)(p.ws + OFF_A2);
  f32x16 hs[4];
  mlstm_dir<0>(p, bh, j, smem, hs);
  mlstm_dir<1>(p, bh, j, smem, hs);
#pragma unroll
  for (int r = 0; r < 16; ++r) {
    const int T = T0 + wave * 32 + crow(r, hh);
    float ss = 0.f;
#pragma unroll
    for (int et = 0; et < 4; ++et) {
      const float o = bf2f(og[(size_t)T * 512 + h * 128 + et * 32 + lr]);
      hs[et][r] *= o;
      ss += hs[et][r] * hs[et][r];
    }
#pragma unroll
    for (int o = 1; o < 32; o <<= 1) ss += __shfl_xor(ss, o, 64);
    const float rs = rsqrtf(ss * (1.f / 128.f) + EPS);
#pragma unroll
    for (int et = 0; et < 4; ++et) {
      const int e = h * 128 + et * 32 + lr;
      A2[(size_t)T * 1024 + e] = f2bf(hs[et][r] * rs * p.mlstm_norm_w[e]);
    }
  }
}

DI void hyena_norm_unit(const Params& p, int unit, char* smem) {
  float* tile = (float*)smem;
  const int tid = opaque_tid();
  const int tt = unit & 63, g = (unit >> 6) & 7, b = unit >> 9;
  const float* z2T = (const float*)(p.ws + OFF_Z2T);
  u16* A2 = (u16*)(p.ws + OFF_A2);
  __syncthreads();
#pragma unroll 4
  for (int i = 0; i < 16; ++i) {
    const int cl = (tid >> 6) + 4 * i, tl = tid & 63;
    tile[cl * 65 + tl] = z2T[((size_t)(b * 512 + g * 64 + cl)) * 4096 + tt * 64 + tl];
  }
  __syncthreads();
  const int tl = tid >> 2, qd = tid & 3;
  float v[16];
  float ss = 0.f;
#pragma unroll
  for (int i = 0; i < 16; ++i) {
    v[i] = tile[(qd * 16 + i) * 65 + tl];
    ss += v[i] * v[i];
  }
  ss += __shfl_xor(ss, 1, 64);
  ss += __shfl_xor(ss, 2, 64);
  const float rs = rsqrtf(ss * (1.f / 64.f) + EPS);
  const size_t T = (size_t)b * 4096 + tt * 64 + tl;
  u16* dst = A2 + T * 1024 + 512 + g * 64 + qd * 16;
  const float* w = p.hyena_norm_w + g * 64 + qd * 16;
  float o[16];
#pragma unroll
  for (int i = 0; i < 16; ++i) o[i] = v[i] * rs * w[i];
  *(bf16x8*)(dst) = pack8(o);
  *(bf16x8*)(dst + 8) = pack8(o + 8);
}

template <int EPI>
DI void gemm_phase(const u16* A, const u16* Bt, int K, int ntn, void* outp, char* smem) {
  const int tid = threadIdx.x, lane = tid & 63, wave = tid >> 6, wr = wave >> 1, wc = wave & 1, lr = lane & 31, hh = lane >> 5;
  const int ntiles = 64 * ntn;
  for (int id = blockIdx.x; id < ntiles; id += gridDim.x) {
    int mt, nt;
    tile_map(id, ntn, mt, nt);
    const int m0 = mt * 256, n0 = nt * 128;
    f32x16 acc[4][2];
    gemm_core<false>(A, Bt, K, m0, n0, smem, acc);
#pragma unroll
    for (int i = 0; i < 4; ++i)
#pragma unroll
      for (int j = 0; j < 2; ++j)
#pragma unroll
        for (int r = 0; r < 16; ++r) {
          const int row = m0 + wr * 128 + i * 32 + crow(r, hh);
          const int col = n0 + wc * 64 + j * 32 + lr;
          const float val = acc[i][j][r];
          if (EPI == 0) ((float*)outp)[(size_t)row * 1024 + col] = val;
          else {
            const float rl = fmaxf(val, 0.f);
            ((u16*)outp)[(size_t)row * 4096 + col] = f2bf(rl * rl);
          }
        }
  }
}

DI void phase_post_mix(const Params& p) {
  const int tid = threadIdx.x, lane = tid & 63, wave = tid >> 6;
  const float* mix = p.out;
  float* x1 = (float*)(p.ws + OFF_X1);
  u16* hm = (u16*)(p.ws + OFF_HM);
  for (int u = blockIdx.x; u < 1024; u += gridDim.x) {
#pragma unroll 2
    for (int rr = 0; rr < 4; ++rr) {
      const size_t row = (size_t)u * 16 + wave * 4 + rr;
      float4 mv[4], xv[4];
      float ss = 0.f;
#pragma unroll
      for (int i = 0; i < 4; ++i) {
        mv[i] = ((const float4*)(mix + row * DM))[lane + 64 * i];
        xv[i] = ((const float4*)(p.x + row * DM))[lane + 64 * i];
        ss += mv[i].x * mv[i].x + mv[i].y * mv[i].y + mv[i].z * mv[i].z + mv[i].w * mv[i].w;
      }
      ss = wave_sum(ss);
      const float rs = rsqrtf(ss * (1.f / DM) + EPS);
      float s2 = 0.f;
#pragma unroll
      for (int i = 0; i < 4; ++i) {
        const float4 w = ((const float4*)p.norm_mix_post)[lane + 64 * i];
        xv[i].x += mv[i].x * rs * w.x; xv[i].y += mv[i].y * rs * w.y; xv[i].z += mv[i].z * rs * w.z; xv[i].w += mv[i].w * rs * w.w;
        s2 += xv[i].x * xv[i].x + xv[i].y * xv[i].y + xv[i].z * xv[i].z + xv[i].w * xv[i].w;
        ((float4*)(x1 + row * DM))[lane + 64 * i] = xv[i];
      }
      s2 = wave_sum(s2);
      const float r2 = rsqrtf(s2 * (1.f / DM) + EPS);
#pragma unroll
      for (int i = 0; i < 4; ++i) {
        const float4 w = ((const float4*)p.norm_mlp_pre)[lane + 64 * i];
        ushort4 o;
        o.x = f2bf(xv[i].x * r2 * w.x); o.y = f2bf(xv[i].y * r2 * w.y); o.z = f2bf(xv[i].z * r2 * w.z); o.w = f2bf(xv[i].w * r2 * w.w);
        *(ushort4*)(hm + row * DM + (lane + 64 * i) * 4) = o;
      }
    }
  }
}

DI void phase_final(const Params& p) {
  const int tid = threadIdx.x, lane = tid & 63, wave = tid >> 6;
  const float* x1 = (const float*)(p.ws + OFF_X1);
  for (int u = blockIdx.x; u < 1024; u += gridDim.x) {
#pragma unroll 2
    for (int rr = 0; rr < 4; ++rr) {
      const size_t row = (size_t)u * 16 + wave * 4 + rr;
      float4 fv[4];
      float ss = 0.f;
#pragma unroll
      for (int i = 0; i < 4; ++i) {
        fv[i] = ((const float4*)(p.out + row * DM))[lane + 64 * i];
        ss += fv[i].x * fv[i].x + fv[i].y * fv[i].y + fv[i].z * fv[i].z + fv[i].w * fv[i].w;
      }
      ss = wave_sum(ss);
      const float rs = rsqrtf(ss * (1.f / DM) + EPS);
#pragma unroll
      for (int i = 0; i < 4; ++i) {
        const float4 w = ((const float4*)p.norm_mlp_post)[lane + 64 * i];
        const float4 xv = ((const float4*)(x1 + row * DM))[lane + 64 * i];
        float4 o;
        o.x = xv.x + fv[i].x * rs * w.x; o.y = xv.y + fv[i].y * rs * w.y; o.z = xv.z + fv[i].z * rs * w.z; o.w = xv.w + fv[i].w * rs * w.w;
        ((float4*)(p.out + row * DM))[lane + 64 * i] = o;
      }
    }
  }
}

DI void run_phase(const Params& p, int ph, char* smem) {
  switch (ph) {
    case 0: phase0(p, smem); break;
    case 1: phase1(p, smem); break;
    case 2: phase_qk(p, smem); break;
    case 3:
#ifdef DBL_HYONLY
      for (int u = blockIdx.x; u < 512; u += gridDim.x) hyena_unit(p, u, smem);
#endif
#ifdef DBL_MLONLY
      for (int u = blockIdx.x; u < 1024; u += gridDim.x) mlstm_local_unit(p, u, smem);
#endif
      for (int u = blockIdx.x; u < 512 + 1024; u += gridDim.x) {
        if (u < 512) hyena_unit(p, u, smem);
        else mlstm_local_unit(p, u - 512, smem);
      }
      break;
    case 4:
      for (int u = blockIdx.x; u < 512; u += gridDim.x) scan_unit(p, u);
      break;
    case 5:
      for (int u = blockIdx.x; u < 512 + 2048; u += gridDim.x) {
#ifndef DBG_SKIP_MLSTM
        if (u < 512) mlstm_out_unit(p, u, smem);
#else
        if (u < 512) { u16* A2 = (u16*)(p.ws + OFF_A2); const int T0 = (u >> 5 >> 2) * 4096 + (u & 31) * 128, hq = (u >> 5) & 3;
          for (int i = threadIdx.x; i < 128 * 128; i += 256) A2[(size_t)(T0 + (i >> 7)) * 1024 + hq * 128 + (i & 127)] = 0; }
#endif
#ifndef DBG_SKIP_HYENA
        else hyena_norm_unit(p, u - 512, smem);
#else
        else { const int un = u - 512; const int tt = un & 63, g = (un >> 6) & 7, b = un >> 9; u16* A2 = (u16*)(p.ws + OFF_A2);
          for (int i = threadIdx.x; i < 64 * 64; i += 256) A2[((size_t)b * 4096 + tt * 64 + (i >> 6)) * 1024 + 512 + g * 64 + (i & 63)] = 0x3F80; }
#endif
      }
      break;
    case 6: gemm_phase<0>((const u16*)(p.ws + OFF_A2), (const u16*)(p.ws + OFF_WOUTT), 1024, 8, p.out, smem); break;
    case 7: phase_post_mix(p); break;
    case 8: gemm_phase<1>((const u16*)(p.ws + OFF_HM), (const u16*)(p.ws + OFF_W1T), 1024, 32, p.ws + OFF_H, smem); break;
    case 9: gemm_phase<0>((const u16*)(p.ws + OFF_H), (const u16*)(p.ws + OFF_W2T), 4096, 8, p.out, smem); break;
    case 10: phase_final(p); break;
  }
}
constexpr int NPHASE = 11;

#define XB_XCNT(j)  (256  + 64 * (j))
#define XB_XSUB(j)  (1280 + 64 * (j))
#define XB_XGEN(j)  (2304 + 64 * (j))
#define XB_TOP      3328
#define XB_TOPGEN   3392
#define XCD_BAR_WORDS 3456
DI unsigned xb_ld(unsigned* p) { return __hip_atomic_load(p, __ATOMIC_RELAXED, __HIP_MEMORY_SCOPE_AGENT); }
DI unsigned xb_add(unsigned* p, unsigned v) { return __hip_atomic_fetch_add(p, v, __ATOMIC_RELAXED, __HIP_MEMORY_SCOPE_AGENT); }
DI unsigned xb_xcc_id() { return (unsigned)__builtin_amdgcn_s_getreg((3 << 11) | 20) & 0xFu; }
struct XcdBar { unsigned* bar; unsigned x, nloc, nx; };
DI void xcd_barrier(XcdBar& b) {
  asm volatile("s_waitcnt vmcnt(0)" ::: "memory");
  __syncthreads();
  if (threadIdx.x == 0) {
    unsigned* bar = b.bar;
    __builtin_amdgcn_s_waitcnt(0);
    if (b.nloc == 0u) {
      const unsigned G = gridDim.x;
      unsigned sum, cnt, mine;
      for (;;) {
        sum = 0u; cnt = 0u; mine = 0u;
#pragma unroll
        for (unsigned j = 0; j < 16; ++j) { const unsigned c = xb_ld(&bar[XB_XCNT(j)]); sum += c; cnt += (c > 0u) ? 1u : 0u; mine = (j == b.x) ? c : mine; }
        if (sum == G) break;
        __builtin_amdgcn_s_sleep(1);
      }
      b.nloc = mine > 0u ? mine : 1u; b.nx = cnt > 0u ? cnt : 1u;
    }
    const unsigned nloc = b.nloc, nx = b.nx;
    const unsigned old = xb_add(&bar[XB_XSUB(b.x)], 1u);
    const unsigned gen = old / nloc;
    if (old + 1u == (gen + 1u) * nloc) {
      __builtin_amdgcn_fence(__ATOMIC_RELEASE, "agent");
      asm volatile("s_waitcnt vmcnt(0)" ::: "memory");
      const unsigned og = xb_add(&bar[XB_TOP], 1u);
      const unsigned tg = og / nx;
      if (og + 1u == (tg + 1u) * nx) xb_add(&bar[XB_TOPGEN], 1u);
      else while (xb_ld(&bar[XB_TOPGEN]) == tg) __builtin_amdgcn_s_sleep(1);
      __builtin_amdgcn_fence(__ATOMIC_ACQUIRE, "agent");
      xb_add(&bar[XB_XGEN(b.x)], 1u);
      asm volatile("s_waitcnt vmcnt(0)" ::: "memory");
    } else {
      while (xb_ld(&bar[XB_XGEN(b.x)]) == gen) __builtin_amdgcn_s_sleep(1);
      __builtin_amdgcn_fence(__ATOMIC_ACQUIRE, "agent");
      asm volatile("s_waitcnt vmcnt(0)" ::: "memory");
    }
  }
  __syncthreads();
}

#if MULTI_LAUNCH
template <int PH>
__global__ void __launch_bounds__(256, 2) phase_kernel(Params p) {
  __shared__ __attribute__((aligned(16))) char smem[65536];
  run_phase(p, PH, smem);
}
template <int PH>
static void launch_phase(const Params& p, hipStream_t stream) {
  hipLaunchKernelGGL(phase_kernel<PH>, dim3(512), dim3(256), 0, stream, p);
}
#else
__global__ void __launch_bounds__(256, 2) mega_kernel(Params p) {
  __shared__ __attribute__((aligned(16))) char smem[65536];
  cg::grid_group grid = cg::this_grid();
  XcdBar xb;
  xb.bar = (unsigned*)(p.ws + OFF_BAR); xb.x = xb_xcc_id(); xb.nloc = 0u; xb.nx = 0u;
  if (p.ws == nullptr) grid.sync();
  if (threadIdx.x == 0) (void)xb_add(&xb.bar[XB_XCNT(xb.x)], 1u);
#define GSYNC xcd_barrier(xb)
#ifdef DBL_P0
  run_phase(p, 0, smem);
#endif
  run_phase(p, 0, smem); GSYNC;
  run_phase(p, 1, smem); GSYNC;
#ifdef DBL_GEMM
  run_phase(p, 1, smem); grid.sync();
#endif
  run_phase(p, 2, smem); GSYNC;
#ifdef DBL_P2
  run_phase(p, 2, smem); GSYNC;
#endif
  run_phase(p, 3, smem); GSYNC;
#ifdef DBL_HY
  run_phase(p, 3, smem); GSYNC;
#endif
  run_phase(p, 4, smem); GSYNC;
  run_phase(p, 5, smem); GSYNC;
#ifdef DBL_P5
  run_phase(p, 5, smem); GSYNC;
#endif
  run_phase(p, 6, smem); GSYNC;
#ifdef DBL_GEMM
  run_phase(p, 6, smem); GSYNC;
#endif
  run_phase(p, 7, smem); GSYNC;
#ifdef DBL_P7
  run_phase(p, 7, smem); GSYNC;
#endif
  run_phase(p, 8, smem); GSYNC;
#ifdef DBL_GEMM
  run_phase(p, 8, smem); GSYNC;
#endif
  run_phase(p, 9, smem); GSYNC;
#ifdef DBL_GEMM
  run_phase(p, 9, smem); GSYNC;
#endif
#ifdef XSYNC
  for (int q = 0; q < 10; ++q) GSYNC;
#endif
  run_phase(p, 10, smem);
}
#endif

extern "C" void kernel_launch(void* const* d_in, const int* in_sizes, int n_in, void* d_out, int out_size, void* d_ws,
                              size_t ws_size, hipStream_t stream) {
  Params p{};
  const float** pp = (const float**)&p;
  for (int i = 0; i < 23; ++i) pp[i] = (const float*)d_in[i];
  p.out = (float*)d_out;
  p.ws = (char*)d_ws;
#if MULTI_LAUNCH
  launch_phase<0>(p, stream);
#ifdef DBL_P0
  launch_phase<0>(p, stream);
#endif
 launch_phase<1>(p, stream); launch_phase<2>(p, stream); launch_phase<3>(p, stream);
#ifdef DBL_HY
  launch_phase<3>(p, stream);
#endif

  launch_phase<4>(p, stream); launch_phase<5>(p, stream);
#ifdef DBL_P5
  launch_phase<5>(p, stream);
#endif
 launch_phase<6>(p, stream); launch_phase<7>(p, stream);
  launch_phase<8>(p, stream); launch_phase<9>(p, stream); launch_phase<10>(p, stream);
#else
  static int grid_blocks = 0;
  if (!grid_blocks) {
    int dev = 0, cus = 0, per_cu = 0;
    hipGetDevice(&dev);
    hipDeviceGetAttribute(&cus, hipDeviceAttributeMultiprocessorCount, dev);
    hipOccupancyMaxActiveBlocksPerMultiprocessor(&per_cu, mega_kernel, 256, 0);
    if (per_cu > 2) per_cu = 2;
    if (per_cu < 1) per_cu = 1;
#ifdef FORCE2
    per_cu = 2;
#endif
    grid_blocks = cus * per_cu;
  }
  hipMemsetAsync((char*)d_ws + OFF_BAR, 0, XCD_BAR_WORDS * 4, stream);
  void* args[] = {&p};
  hipError_t e = hipLaunchCooperativeKernel((void*)mega_kernel, dim3(grid_blocks), dim3(256), args, 0, stream);
  if (e != hipSuccess) fprintf(stderr, "cooperative launch failed: %s (grid %d)\n", hipGetErrorString(e), grid_blocks);
#endif
}
#if defined(__HIP_DEVICE_COMPILE__)
#pragma clang attribute pop
#endif
```

```cpp
#if defined(__HIP_DEVICE_COMPILE__)
#pragma clang attribute push(__attribute__((target("no-packed-fp32-ops"))), apply_to = function)
#endif
#include <hip/hip_runtime.h>
#include <hip/hip_cooperative_groups.h>
#include <cstdio>
namespace cg = cooperative_groups;

#ifndef MULTI_LAUNCH
#define MULTI_LAUNCH 0
#endif

typedef unsigned short u16;
using bf16x8 = __attribute__((ext_vector_type(8))) short;
using f32x16 = __attribute__((ext_vector_type(16))) float;
#define DI __device__ __forceinline__
#define MFMA(a, b, c) __builtin_amdgcn_mfma_f32_32x32x16_bf16((a), (b), (c), 0, 0, 0)

constexpr int SEQ = 4096, DM = 1024, NTOK = 16384, NIN = 3600, NINP = 3712, DFF = 4096;
constexpr float EPS = 1e-6f;
constexpr size_t MiB = 1u << 20;
constexpr size_t OFF_WINT = 0, OFF_WOUTT = 8 * MiB, OFF_W1T = 10 * MiB, OFF_W2T = 18 * MiB;
constexpr size_t OFF_XN = 26 * MiB, OFF_QA = 26 * MiB, OFF_KA = 42 * MiB;
constexpr size_t OFF_FILT = 58 * MiB, OFF_QKPRE = 90 * MiB, OFF_A2 = 90 * MiB;
constexpr size_t OFF_HYT = 122 * MiB, OFF_VT = 170 * MiB, OFF_OG = 186 * MiB, OFF_GATES = 202 * MiB;
constexpr size_t OFF_NL = 203 * MiB, OFF_MLOC = 203 * MiB + 512 * 1024, OFF_GSUM = OFF_MLOC + 4096, OFF_MS = OFF_GSUM + 4096;
constexpr size_t OFF_KAT = 205 * MiB, OFF_Z2T = 221 * MiB;
constexpr size_t OFF_TW = 204 * MiB, OFF_BAR = 254 * MiB;
constexpr size_t OFF_X1 = 26 * MiB, OFF_HM = 90 * MiB, OFF_H = 122 * MiB;

struct Params {
  const float *x, *norm_mix_pre, *norm_mix_post, *norm_mlp_pre, *norm_mlp_post, *w_in, *b_gates, *conv_w, *conv_b,
      *mlstm_norm_w, *hyena_norm_w, *filt_w1, *filt_b1, *filt_w2, *filt_b2, *filt_w3, *filt_b3, *filt_w4, *filt_freq,
      *filt_bias, *w_out, *w_mlp_in, *w_mlp_out;
  float* out;
  char* ws;
};

DI u16 f2bf(float x) { unsigned u = __float_as_uint(x); u += 0x7fffu + ((u >> 16) & 1u); return (u16)(u >> 16); }
DI float bf2f(u16 v) { return __uint_as_float(((unsigned)v) << 16); }
DI int opaque_tid() { int t = threadIdx.x; asm volatile("" : "+v"(t)); return t; }
DI int crow(int r, int hh) { return (r & 3) + 8 * (r >> 2) + 4 * hh; }
DI float log_sigmoid(float x) { return fminf(x, 0.f) - log1pf(expf(-fabsf(x))); }
DI float sigmoidf(float x) { return 1.f / (1.f + expf(-x)); }
DI float red2pi(float x) {
  const float k = rintf(x * 0.15915494309189535f);
  float r = fmaf(-k, 6.28125f, x);
  return fmaf(-k, 1.9353071795864769e-3f, r);
}
DI float fsin(float x) { return sinf(x); }
DI float fcos(float x) { return cosf(x); }
DI bf16x8 pack8(const float* v) {
  bf16x8 r;
#pragma unroll
  for (int i = 0; i < 8; ++i) r[i] = (short)f2bf(v[i]);
  return r;
}
DI bf16x8 scale8(bf16x8 a, float s) {
  bf16x8 r;
#pragma unroll
  for (int i = 0; i < 8; ++i) r[i] = (short)f2bf(bf2f((u16)a[i]) * s);
  return r;
}

template <bool SWAP>
DI void gemm_core(const u16* __restrict__ A, const u16* __restrict__ Bt, int K, int m0, int n0, char* smem, f32x16 (&acc)[4][2]) {
  const int tid = opaque_tid(), lane = tid & 63, wave = tid >> 6, wr = wave >> 1, wc = wave & 1;
  const int lr = lane & 31, hh = lane >> 5;
#pragma unroll
  for (int i = 0; i < 4; ++i)
#pragma unroll
    for (int j = 0; j < 2; ++j)
#pragma unroll
      for (int r = 0; r < 16; ++r) acc[i][j][r] = 0.f;
  const int c = tid & 7, r0 = tid >> 3;
  const u16* Ag = A + (size_t)(m0 + r0) * K + c * 8;
  const u16* Bg = Bt + (size_t)(n0 + r0) * K + c * 8;
  const int soff = r0 * 128 + ((c ^ ((r0 >> 1) & 7)) << 4);
  char* As = smem;
  char* Bs = smem + 32768;
  uint4 ra0, ra1, ra2, ra3, ra4, ra5, ra6, ra7, rb0, rb1, rb2, rb3;
#define GLOAD_ALL(k0)                                                                                             \
  ra0 = *(const uint4*)(Ag + (size_t)(0) * K + (k0));   ra1 = *(const uint4*)(Ag + (size_t)(32) * K + (k0));      \
  ra2 = *(const uint4*)(Ag + (size_t)(64) * K + (k0));  ra3 = *(const uint4*)(Ag + (size_t)(96) * K + (k0));      \
  ra4 = *(const uint4*)(Ag + (size_t)(128) * K + (k0)); ra5 = *(const uint4*)(Ag + (size_t)(160) * K + (k0));     \
  ra6 = *(const uint4*)(Ag + (size_t)(192) * K + (k0)); ra7 = *(const uint4*)(Ag + (size_t)(224) * K + (k0));     \
  rb0 = *(const uint4*)(Bg + (size_t)(0) * K + (k0));   rb1 = *(const uint4*)(Bg + (size_t)(32) * K + (k0));      \
  rb2 = *(const uint4*)(Bg + (size_t)(64) * K + (k0));  rb3 = *(const uint4*)(Bg + (size_t)(96) * K + (k0));
  GLOAD_ALL(0)
  const int nk = K >> 6;
#pragma unroll 1
  for (int kt = 0; kt < nk; ++kt) {
    __syncthreads();
    *(uint4*)(As + soff + 0 * 4096) = ra0; *(uint4*)(As + soff + 1 * 4096) = ra1; *(uint4*)(As + soff + 2 * 4096) = ra2; *(uint4*)(As + soff + 3 * 4096) = ra3;
    *(uint4*)(As + soff + 4 * 4096) = ra4; *(uint4*)(As + soff + 5 * 4096) = ra5; *(uint4*)(As + soff + 6 * 4096) = ra6; *(uint4*)(As + soff + 7 * 4096) = ra7;
    *(uint4*)(Bs + soff + 0 * 4096) = rb0; *(uint4*)(Bs + soff + 1 * 4096) = rb1; *(uint4*)(Bs + soff + 2 * 4096) = rb2; *(uint4*)(Bs + soff + 3 * 4096) = rb3;
    __syncthreads();
    if (kt + 1 < nk) {
      const int k0 = (kt + 1) << 6;
      GLOAD_ALL(k0)
    }
#pragma unroll
    for (int kk = 0; kk < 4; ++kk) {
      bf16x8 a[4], b[2];
      const int cc = kk * 2 + hh;
#pragma unroll
      for (int i = 0; i < 4; ++i) {
        const int r = wr * 128 + i * 32 + lr;
        a[i] = *(const bf16x8*)(As + r * 128 + ((cc ^ ((r >> 1) & 7)) << 4));
      }
#pragma unroll
      for (int j = 0; j < 2; ++j) {
        const int r = wc * 64 + j * 32 + lr;
        b[j] = *(const bf16x8*)(Bs + r * 128 + ((cc ^ ((r >> 1) & 7)) << 4));
      }
#pragma unroll
      for (int i = 0; i < 4; ++i)
#pragma unroll
        for (int j = 0; j < 2; ++j) acc[i][j] = SWAP ? MFMA(b[j], a[i], acc[i][j]) : MFMA(a[i], b[j], acc[i][j]);
    }
  }
  __syncthreads();
}

DI void tile_map(int id, int ntn, int& mt, int& nt) {
  const int per = 16 * ntn;
  const int g = id / per, rem = id - g * per;
  mt = g * 16 + (rem & 15);
  nt = rem >> 4;
}

DI void transpose_tile(const float* __restrict__ src, int R, int C, u16* __restrict__ dst, int kt, int nt, char* smem) {
  float* tile = (float*)smem;
  const int tid = threadIdx.x;
  const int k0 = kt * 64, n0 = nt * 64;
#pragma unroll 4
  for (int it = 0; it < 16; ++it) {
    const int kk = it * 4 + (tid >> 6), nn = tid & 63;
    const int n = n0 + nn;
    tile[kk * 65 + nn] = (n < C) ? src[(size_t)(k0 + kk) * C + n] : 0.f;
  }
  __syncthreads();
#pragma unroll 4
  for (int it = 0; it < 16; ++it) {
    const int nn = it * 4 + (tid >> 6), kk = tid & 63;
    dst[(size_t)(n0 + nn) * R + k0 + kk] = f2bf(tile[kk * 65 + nn]);
  }
  __syncthreads();
}

DI float wave_sum(float v) {
#pragma unroll
  for (int o = 32; o; o >>= 1) v += __shfl_xor(v, o, 64);
  return v;
}

DI void filter_unit(const Params& p, int unit, char* smem) {
  float* sz = (float*)smem;
  float* hA = sz + 8 * 33 + 8;
  float* hB = hA + 8 * 64;
  float* hT = hB + 8 * 64;
  const int tid = opaque_tid();
  const int l0 = unit * 8;
  for (int idx = tid; idx < 8 * 33; idx += 256) {
    const int pp = idx / 33, f = idx - pp * 33;
    const float l = (float)(l0 + pp);
    float v;
    if (f == 0) v = l / 4095.f;
    else {
      const int jb = (f - 1) & 15;
      const float fj = 1e-4f + (float)jb * ((15.f - 1e-4f) / 15.f);
      const float ang = 6.283185307179586f * l / 4096.f;
      v = (f <= 16) ? fcos(fj * ang) : -fsin(fj * ang);
    }
    sz[idx] = v;
  }
  const int o = tid & 63, pq = tid >> 6;
  {
    const float bb = p.filt_b1[o], fr = p.filt_freq[o];
    __syncthreads();
    float s0 = bb, s1 = bb;
#pragma unroll 1
    for (int f0 = 0; f0 < 33; f0 += 11) {
      float wc[11];
#pragma unroll
      for (int f = 0; f < 11; ++f) wc[f] = p.filt_w1[(f0 + f) * 64 + o];
#pragma unroll
      for (int f = 0; f < 11; ++f) { s0 += sz[pq * 33 + f0 + f] * wc[f]; s1 += sz[(pq + 4) * 33 + f0 + f] * wc[f]; }
    }
    hA[pq * 64 + o] = fsin(fr * s0);
    hA[(pq + 4) * 64 + o] = fsin(fr * s1);
  }
  {
    const float bb = p.filt_b2[o], fr = p.filt_freq[64 + o];
    __syncthreads();
    float s0 = bb, s1 = bb;
#pragma unroll 1
    for (int k0 = 0; k0 < 64; k0 += 16) {
      float wc[16];
#pragma unroll
      for (int k = 0; k < 16; ++k) wc[k] = p.filt_w2[(k0 + k) * 64 + o];
#pragma unroll
      for (int k = 0; k < 16; ++k) { s0 += hA[pq * 64 + k0 + k] * wc[k]; s1 += hA[(pq + 4) * 64 + k0 + k] * wc[k]; }
    }
    hB[pq * 64 + o] = fsin(fr * s0);
    hB[(pq + 4) * 64 + o] = fsin(fr * s1);
  }
  {
    const float bb = p.filt_b3[o], fr = p.filt_freq[128 + o];
    __syncthreads();
    float s0 = bb, s1 = bb;
#pragma unroll 1
    for (int k0 = 0; k0 < 64; k0 += 16) {
      float wc[16];
#pragma unroll
      for (int k = 0; k < 16; ++k) wc[k] = p.filt_w3[(k0 + k) * 64 + o];
#pragma unroll
      for (int k = 0; k < 16; ++k) { s0 += hB[pq * 64 + k0 + k] * wc[k]; s1 += hB[(pq + 4) * 64 + k0 + k] * wc[k]; }
    }
    hT[o * 8 + pq] = fsin(fr * s0);
    hT[o * 8 + pq + 4] = fsin(fr * s1);
  }
  __syncthreads();
  float* filt = (float*)(p.ws + OFF_FILT);
  const float min_decay = -3.0701134573253944f, max_decay = -15.350567286626973f;
#pragma unroll 1
  for (int cc = 0; cc < 8; ++cc) {
    const int col = tid + 256 * cc;
    float acc[8];
#pragma unroll
    for (int q = 0; q < 8; ++q) acc[q] = 0.f;
#pragma unroll 1
    for (int k0 = 0; k0 < 64; k0 += 16) {
      float wc[16];
#pragma unroll
      for (int k = 0; k < 16; ++k) wc[k] = p.filt_w4[(k0 + k) * 2048 + col];
#pragma unroll
      for (int k = 0; k < 16; ++k) {
        const float4 h0 = *(const float4*)(hT + (k0 + k) * 8);
        const float4 h1 = *(const float4*)(hT + (k0 + k) * 8 + 4);
        acc[0] += h0.x * wc[k]; acc[1] += h0.y * wc[k]; acc[2] += h0.z * wc[k]; acc[3] += h0.w * wc[k];
        acc[4] += h1.x * wc[k]; acc[5] += h1.y * wc[k]; acc[6] += h1.z * wc[k]; acc[7] += h1.w * wc[k];
      }
    }
    const int ch = col & 511;
    const float delta = fabsf(min_decay + (float)ch * ((max_decay - min_decay) / 511.f));
#pragma unroll
    for (int q = 0; q < 8; ++q) {
      const float t = (float)(l0 + q) / 4095.f;
      acc[q] *= expf(-t * delta);
    }
    float4* dst = (float4*)(filt + (size_t)col * 4096 + l0);
    dst[0] = make_float4(acc[0], acc[1], acc[2], acc[3]);
    dst[1] = make_float4(acc[4], acc[5], acc[6], acc[7]);
  }
  __syncthreads();
}

DI void phase0(const Params& p, char* smem) {
  const int tid = threadIdx.x, lane = tid & 63, wave = tid >> 6;
  const int U_W = 32, U_F = 512, U_X = 1024, U_T1 = 58 * 16, U_T2 = 256, U_T3 = 1024, U_T4 = 1024;
  const int total = U_W + U_F + U_X + U_T1 + U_T2 + U_T3 + U_T4;
  for (int u = blockIdx.x; u < total; u += gridDim.x) {
    int v = u;
    if (v < U_W) {
      const int idx = v * 256 + tid;
      if (idx < 8191) {
        const int lh = 31 - __clz(idx + 1);
        const int h = 1 << lh, jj = idx + 1 - h;
        float2* twp = (float2*)(p.ws + OFF_TW);
        const float ang = -3.14159265358979f * (float)jj / (float)h;
        twp[idx] = make_float2(cosf(ang), sinf(ang));
      }
      continue;
    }
    v -= U_W;
    if (v < U_F) { filter_unit(p, v, smem); continue; }
    v -= U_F;
    if (v < U_X) {
      u16* xn = (u16*)(p.ws + OFF_XN);
#pragma unroll 4
      for (int rr = 0; rr < 4; ++rr) {
        const int row = v * 16 + wave * 4 + rr;
        const float4* xr = (const float4*)(p.x + (size_t)row * DM);
        float4 xv[4];
        float ss = 0.f;
#pragma unroll
        for (int i = 0; i < 4; ++i) {
          xv[i] = xr[lane + 64 * i];
          ss += xv[i].x * xv[i].x + xv[i].y * xv[i].y + xv[i].z * xv[i].z + xv[i].w * xv[i].w;
        }
        ss = wave_sum(ss);
        const float rs = rsqrtf(ss * (1.f / DM) + EPS);
#pragma unroll
        for (int i = 0; i < 4; ++i) {
          const float4 w = ((const float4*)p.norm_mix_pre)[lane + 64 * i];
          ushort4 o;
          o.x = f2bf(xv[i].x * rs * w.x); o.y = f2bf(xv[i].y * rs * w.y); o.z = f2bf(xv[i].z * rs * w.z); o.w = f2bf(xv[i].w * rs * w.w);
          *(ushort4*)(xn + (size_t)row * DM + (lane + 64 * i) * 4) = o;
        }
      }
      continue;
    }
    v -= U_X;
    if (v < U_T1) { transpose_tile(p.w_in, DM, NIN, (u16*)(p.ws + OFF_WINT), v & 15, v >> 4, smem); continue; }
    v -= U_T1;
    if (v < U_T2) { transpose_tile(p.w_out, DM, DM, (u16*)(p.ws + OFF_WOUTT), v & 15, v >> 4, smem); continue; }
    v -= U_T2;
    if (v < U_T3) { transpose_tile(p.w_mlp_in, DM, DFF, (u16*)(p.ws + OFF_W1T), v & 15, v >> 4, smem); continue; }
    v -= U_T3;
    transpose_tile(p.w_mlp_out, DFF, DM, (u16*)(p.ws + OFF_W2T), v & 63, v >> 6, smem);
  }
}

DI void phase1(const Params& p, char* smem) {
  const int tid = threadIdx.x, lane = tid & 63, wave = tid >> 6, wr = wave >> 1, wc = wave & 1, lr = lane & 31, hh = lane >> 5;
  const u16* xn = (const u16*)(p.ws + OFF_XN);
  const u16* wt = (const u16*)(p.ws + OFF_WINT);
  u16* qkpre = (u16*)(p.ws + OFF_QKPRE);
  u16* hyT = (u16*)(p.ws + OFF_HYT);
  u16* vT = (u16*)(p.ws + OFF_VT);
  u16* og = (u16*)(p.ws + OFF_OG);
  float* gates = (float*)(p.ws + OFF_GATES);
  const int ntn = 29, ntiles = 64 * ntn;
  for (int id = blockIdx.x; id < ntiles; id += gridDim.x) {
    int mt, nt;
    tile_map(id, ntn, mt, nt);
    const int m0 = mt * 256, n0 = nt * 128;
    f32x16 acc[4][2];
    const bool swap = (nt >= 8 && nt < 24);
    if (swap) gemm_core<true>(xn, wt, DM, m0, n0, smem, acc);
    else gemm_core<false>(xn, wt, DM, m0, n0, smem, acc);
#pragma unroll
    for (int i = 0; i < 4; ++i)
#pragma unroll
      for (int j = 0; j < 2; ++j)
#pragma unroll
        for (int r = 0; r < 16; ++r) {
          const float val = acc[i][j][r];
          if (!swap) {
            const int row = m0 + wr * 128 + i * 32 + crow(r, hh);
            const int col = n0 + wc * 64 + j * 32 + lr;
            if (nt < 8) qkpre[(size_t)row * 1024 + col] = f2bf(val);
            else if (nt < 28) og[(size_t)row * 512 + (col - 3072)] = f2bf(sigmoidf(val));
            else if (col < 3600) gates[(size_t)row * 16 + (col - 3584)] = val;
          } else {
            const int n = n0 + wc * 64 + j * 32 + crow(r, hh);
            const int m = m0 + wr * 128 + i * 32 + lr;
            const int b = m >> 12, t = m & 4095;
            if (nt < 20) {
              const int cc = n - 1024, g = cc >> 9, ch = cc & 511;
              hyT[((size_t)((g * 4 + b) * 512 + ch)) * 4096 + t] = f2bf(val);
            } else {
              const int cc = n - 2560;
              vT[((size_t)(b * 512 + cc)) * 4096 + t] = f2bf(val);
            }
          }
        }
  }
}

DI void phase_qk(const Params& p, char* smem) {
  u16* tile = (u16*)smem;
  const int tid = threadIdx.x;
  const u16* qkpre = (const u16*)(p.ws + OFF_QKPRE);
  u16* qa = (u16*)(p.ws + OFF_QA);
  u16* ka = (u16*)(p.ws + OFF_KA);
  u16* kaT = (u16*)(p.ws + OFF_KAT);
  for (int u = blockIdx.x; u < 4096; u += gridDim.x) {
    const int ct = u & 15, tt = u >> 4;
    const int C = ct * 64 + (tid & 63);
    const float w0 = p.conv_w[C], w1 = p.conv_w[2560 + C], w2 = p.conv_w[5120 + C], cb = p.conv_b[C];
#pragma unroll 4
    for (int i = 0; i < 16; ++i) {
      const int row = (tid >> 6) + 4 * i;
      const int T = tt * 64 + row, t = T & 4095;
      const float pm = t > 0 ? bf2f(qkpre[(size_t)(T - 1) * 1024 + C]) : 0.f;
      const float p0 = bf2f(qkpre[(size_t)T * 1024 + C]);
      const float pp = t < 4095 ? bf2f(qkpre[(size_t)(T + 1) * 1024 + C]) : 0.f;
      const float val = w0 * pm + w1 * p0 + w2 * pp + cb;
      float s = val * sigmoidf(val);
      if (C < 512) qa[(size_t)T * 512 + C] = f2bf(s);
      else {
        s *= 0.08838834764831845f;
        const u16 sb = f2bf(s);
        ka[(size_t)T * 512 + (C - 512)] = sb;
        tile[(tid & 63) * 66 + row] = sb;
      }
    }
    if (ct >= 8) {
      __syncthreads();
      const int b = (tt * 64) >> 12, t0 = (tt * 64) & 4095;
      const int d0 = (ct - 8) * 64;
#pragma unroll 4
      for (int i = 0; i < 16; ++i) {
        const int dl = (tid >> 6) + 4 * i, tl = tid & 63;
        kaT[((size_t)(b * 512 + d0 + dl)) * 4096 + t0 + tl] = tile[dl * 66 + tl];
      }
      __syncthreads();
    }
  }
}

DI float lz(float v) { asm volatile("" : "+v"(v)); return v; }
DI float2 mk2(float a, float b) { return make_float2(a, b); }
DI float2 cmul(float2 a, float2 w) { return mk2(a.x * w.x - a.y * w.y, a.x * w.y + a.y * w.x); }
DI float2 cmulc(float2 a, float2 w) { return mk2(a.x * w.x + a.y * w.y, a.y * w.x - a.x * w.y); }
template <int NW, bool INV>
DI void r4_pass(float2* x, int tid, int q, const float2* __restrict__ t1, const float2* __restrict__ t2) {
  constexpr int NL = NW > 4 ? 4 : NW;
  constexpr int NB = NW > 4 ? 2 : 1;
  constexpr int CNT = 8 / NB;
#pragma unroll 1
  for (int bt = 0; bt < NB; ++bt) {
    float2 w1[NL], w2[NL];
#pragma unroll
    for (int n = 0; n < NL; ++n) { const int j = (tid + ((bt * CNT + n) << 8)) & (q - 1); w1[n] = t1[j]; w2[n] = t2[j]; }
    if (bt == 0) __syncthreads();
#pragma unroll(NL == 4 ? 4 : 2)
    for (int ii = 0; ii < CNT; ++ii) {
      const int k = tid + ((bt * CNT + ii) << 8);
      const int j = k & (q - 1);
      int base = ((k - j) << 2) + j;
      asm volatile("" : "+v"(base));
      const float2 ww1 = w1[ii % NL], ww2 = w2[ii % NL];
      const float2 x0 = x[base], x1 = x[base + q], x2 = x[base + 2 * q], x3 = x[base + 3 * q];
      if (!INV) {
        const float2 a0 = mk2(x0.x + x2.x, x0.y + x2.y);
        const float2 a1 = mk2(x1.x + x3.x, x1.y + x3.y);
        const float2 d02 = mk2(x0.x - x2.x, x0.y - x2.y);
        const float2 d13 = mk2(x1.y - x3.y, x3.x - x1.x);
        const float2 a2 = cmul(d02, ww1);
        const float2 a3 = cmul(d13, ww1);
        x[base] = mk2(a0.x + a1.x, a0.y + a1.y);
        x[base + q] = cmul(mk2(a0.x - a1.x, a0.y - a1.y), ww2);
        x[base + 2 * q] = mk2(a2.x + a3.x, a2.y + a3.y);
        x[base + 3 * q] = cmul(mk2(a2.x - a3.x, a2.y - a3.y), ww2);
      } else {
        const float2 b1 = cmulc(x1, ww2), b3 = cmulc(x3, ww2);
        const float2 a0 = mk2(x0.x + b1.x, x0.y + b1.y);
        const float2 a1 = mk2(x0.x - b1.x, x0.y - b1.y);
        const float2 a2 = mk2(x2.x + b3.x, x2.y + b3.y);
        const float2 a3 = mk2(x2.x - b3.x, x2.y - b3.y);
        const float2 c2 = cmulc(a2, ww1);
        const float2 c3t = cmulc(a3, ww1);
        const float2 c3 = mk2(-c3t.y, c3t.x);
        x[base] = mk2(a0.x + c2.x, a0.y + c2.y);
        x[base + 2 * q] = mk2(a0.x - c2.x, a0.y - c2.y);
        x[base + q] = mk2(a1.x + c3.x, a1.y + c3.y);
        x[base + 3 * q] = mk2(a1.x - c3.x, a1.y - c3.y);
      }
    }
  }
}
DI void r2_last(float2* x, int tid) {
#pragma unroll 4
  for (int i = 0; i < 16; ++i) {
    const int i0 = (tid + (i << 8)) << 1;
    const float2 a = x[i0], b = x[i0 + 1];
    x[i0] = mk2(a.x + b.x, a.y + b.y);
    x[i0 + 1] = mk2(a.x - b.x, a.y - b.y);
  }
}
DI void fft_fwd(float2* x, int tid, const float2* __restrict__ tw) {
  r4_pass<8, false>(x, tid, 2048, tw + 4095, tw + 2047);
  r4_pass<2, false>(x, tid, 512, tw + 1023, tw + 511);
  r4_pass<1, false>(x, tid, 128, tw + 255, tw + 127);
  r4_pass<1, false>(x, tid, 32, tw + 63, tw + 31);
  r4_pass<1, false>(x, tid, 8, tw + 15, tw + 7);
  r4_pass<1, false>(x, tid, 2, tw + 3, tw + 1);
  __syncthreads();
  r2_last(x, tid);
  __syncthreads();
}
DI void fft_inv(float2* x, int tid, const float2* __restrict__ tw) {
  __syncthreads();
  r2_last(x, tid);
  r4_pass<1, true>(x, tid, 2, tw + 3, tw + 1);
  r4_pass<1, true>(x, tid, 8, tw + 15, tw + 7);
  r4_pass<1, true>(x, tid, 32, tw + 63, tw + 31);
  r4_pass<1, true>(x, tid, 128, tw + 255, tw + 127);
  r4_pass<2, true>(x, tid, 512, tw + 1023, tw + 511);
  r4_pass<8, true>(x, tid, 2048, tw + 4095, tw + 2047);
  __syncthreads();
}

DI float hy_conv(const u16* __restrict__ pr, int t, float w0, float w1, float w2, float cb) {
  const float a = t > 0 ? bf2f(pr[t - 1]) : 0.f;
  const float b = bf2f(pr[t]);
  const float c = t < 4095 ? bf2f(pr[t + 1]) : 0.f;
  return w0 * a + w1 * b + w2 * c + cb;
}

DI void hy_conv4(const u16* __restrict__ pr, int t0, float w0, float w1, float w2, float cb, float (&o)[4]) {
  const ushort4 c = *(const ushort4*)(pr + t0);
  const float pm = t0 > 0 ? bf2f(pr[t0 - 1]) : 0.f;
  const float pn = t0 + 4 < 4096 ? bf2f(pr[t0 + 4]) : 0.f;
  const float x0 = bf2f(c.x), x1 = bf2f(c.y), x2 = bf2f(c.z), x3 = bf2f(c.w);
  o[0] = w0 * pm + w1 * x0 + w2 * x1 + cb;
  o[1] = w0 * x0 + w1 * x1 + w2 * x2 + cb;
  o[2] = w0 * x1 + w1 * x2 + w2 * x3 + cb;
  o[3] = w0 * x2 + w1 * x3 + w2 * pn + cb;
}

DI void hyena_unit(const Params& p, int ch, char* smem) {
  float2* buf = (float2*)smem;
  const int tid = opaque_tid();
  const u16* hyT = (const u16*)(p.ws + OFF_HYT);
  const float* filt = (const float*)(p.ws + OFF_FILT);
  float* z2T = (float*)(p.ws + OFF_Z2T);
  const float2* tw = (const float2*)(p.ws + OFF_TW);
  float2 Kr[32];
#pragma unroll 1
  for (int ord = 0; ord < 2; ++ord) {
    const float* kf = filt + (size_t)((0 * 2 + ord) * 512 + ch) * 4096;
    const float* kb = filt + (size_t)((1 * 2 + ord) * 512 + ch) * 4096;
    const float fb = p.filt_bias[ord * 512 + ch];
    __syncthreads();
#pragma unroll 4
    for (int n = tid; n < 8192; n += 256) {
      float v;
      if (n < 4096) v = kf[n];
      else if (n == 4096) v = 0.f;
      else v = kb[8192 - n];
      if (n == 0) v += fb;
      buf[n] = make_float2(v, 0.f);
    }
    fft_fwd(buf, tid, tw);
#pragma unroll
    for (int j = 0; j < 32; ++j) {
      const float2 v = buf[tid + 256 * j];
      Kr[j] = make_float2(v.x * (1.f / 8192.f), v.y * (1.f / 8192.f));
    }
    const int gcol = 1024 + (1 + ord) * 512 + ch;
    const float gw0 = p.conv_w[gcol], gw1 = p.conv_w[2560 + gcol], gw2 = p.conv_w[5120 + gcol], gcb = p.conv_b[gcol];
    const int vcol = 1024 + ch;
    const float vw0 = p.conv_w[vcol], vw1 = p.conv_w[2560 + vcol], vw2 = p.conv_w[5120 + vcol], vcb = p.conv_b[vcol];
#pragma unroll 1
    for (int pr = 0; pr < 2; ++pr) {
      const int b0 = 2 * pr, b1 = 2 * pr + 1;
      __syncthreads();
      if (ord == 0) {
        const u16* u0 = hyT + ((size_t)((0 * 4 + b0) * 512 + ch)) * 4096;
        const u16* u1 = hyT + ((size_t)((0 * 4 + b1) * 512 + ch)) * 4096;
#pragma unroll
        for (int g = 0; g < 4; ++g) {
          const int t0 = g * 1024 + tid * 4;
          float a[4], b[4];
          hy_conv4(u0, t0, vw0, vw1, vw2, vcb, a);
          hy_conv4(u1, t0, vw0, vw1, vw2, vcb, b);
          *(float4*)(buf + t0) = make_float4(a[0], b[0], a[1], b[1]);
          *(float4*)(buf + t0 + 2) = make_float4(a[2], b[2], a[3], b[3]);
          *(float4*)(buf + 4096 + t0) = make_float4(0.f, 0.f, 0.f, 0.f);
          *(float4*)(buf + 4096 + t0 + 2) = make_float4(0.f, 0.f, 0.f, 0.f);
        }
      } else {
        const float* u0 = z2T + ((size_t)(b0 * 512 + ch)) * 4096;
        const float* u1 = z2T + ((size_t)(b1 * 512 + ch)) * 4096;
#pragma unroll
        for (int g = 0; g < 4; ++g) {
          const int t0 = g * 1024 + tid * 4;
          const float4 a = *(const float4*)(u0 + t0);
          const float4 b = *(const float4*)(u1 + t0);
          *(float4*)(buf + t0) = make_float4(a.x, b.x, a.y, b.y);
          *(float4*)(buf + t0 + 2) = make_float4(a.z, b.z, a.w, b.w);
          *(float4*)(buf + 4096 + t0) = make_float4(0.f, 0.f, 0.f, 0.f);
          *(float4*)(buf + 4096 + t0 + 2) = make_float4(0.f, 0.f, 0.f, 0.f);
        }
      }
      fft_fwd(buf, tid, tw);
#pragma unroll
      for (int j = 0; j < 32; ++j) {
        const float2 v = buf[tid + 256 * j];
        buf[tid + 256 * j] = make_float2(v.x * Kr[j].x - v.y * Kr[j].y, v.x * Kr[j].y + v.y * Kr[j].x);
      }
      fft_inv(buf, tid, tw);
      const u16* g0 = hyT + ((size_t)(((1 + ord) * 4 + b0) * 512 + ch)) * 4096;
      const u16* g1 = hyT + ((size_t)(((1 + ord) * 4 + b1) * 512 + ch)) * 4096;
      float* o0 = z2T + ((size_t)(b0 * 512 + ch)) * 4096;
      float* o1 = z2T + ((size_t)(b1 * 512 + ch)) * 4096;
#pragma unroll
      for (int g = 0; g < 4; ++g) {
        const int t0 = g * 1024 + tid * 4;
        const float4 y01 = *(const float4*)(buf + t0);
        const float4 y23 = *(const float4*)(buf + t0 + 2);
        float ga[4], gb[4];
        hy_conv4(g0, t0, gw0, gw1, gw2, gcb, ga);
        hy_conv4(g1, t0, gw0, gw1, gw2, gcb, gb);
        *(float4*)(o0 + t0) = make_float4(ga[0] * y01.x, ga[1] * y01.z, ga[2] * y23.x, ga[3] * y23.z);
        *(float4*)(o1 + t0) = make_float4(gb[0] * y01.y, gb[1] * y01.w, gb[2] * y23.y, gb[3] * y23.w);
      }
    }
  }
  __syncthreads();
}

DI void mlstm_local_unit(const Params& p, int u, char* smem) {
  float* s_gi = (float*)smem;
  float* s_lf = s_gi + 128;
  float* s_a = s_lf + 128;
  float* s_w = s_a + 128;
  const int tid = opaque_tid(), lane = tid & 63, wave = tid >> 6, lr = lane & 31, hh = lane >> 5;
  const int j = u & 31, dir = (u >> 5) & 1, bh = u >> 6, h = bh & 3, b = bh >> 2;
  const int T0 = b * 4096 + j * 128;
  const float* gates = (const float*)(p.ws + OFF_GATES);
  const u16* vT = (const u16*)(p.ws + OFF_VT);
  const u16* kaT = (const u16*)(p.ws + OFF_KAT);
  float* CL = p.out;
  float* nl = (float*)(p.ws + OFF_NL);
  float* mloc = (float*)(p.ws + OFF_MLOC);
  float* gsum = (float*)(p.ws + OFF_GSUM);
  __syncthreads();
  if (tid < 128) {
    const int T = T0 + tid;
    s_gi[tid] = gates[(size_t)T * 16 + dir * 8 + h] + p.b_gates[dir * 8 + h];
    s_lf[tid] = log_sigmoid(gates[(size_t)T * 16 + dir * 8 + 4 + h] + p.b_gates[dir * 8 + 4 + h]);
  }
  __syncthreads();
  float gtot = 0.f;
  if (tid < 128) {
    float pre = 0.f;
#pragma unroll 4
    for (int m = 0; m < 128; ++m) {
      const float v = s_lf[m];
      if (m < tid) pre += v;
      gtot += v;
    }
    s_a[tid] = (dir == 0) ? (gtot - pre - s_lf[tid] + s_gi[tid]) : (pre + s_gi[tid]);
  }
  __syncthreads();
  if (tid < 128) {
    float mx = -3.0e38f;
#pragma unroll 4
    for (int m = 0; m < 128; ++m) mx = fmaxf(mx, s_a[m]);
    s_w[tid] = expf(s_a[tid] - mx);
    if (tid == 0) { mloc[u] = mx; gsum[u] = gtot; }
  }
  __syncthreads();
  f32x16 acc[4];
#pragma unroll
  for (int d = 0; d < 4; ++d)
#pragma unroll
    for (int r = 0; r < 16; ++r) acc[d][r] = 0.f;
  const u16* vrow = vT + ((size_t)(bh * 128 + wave * 32 + lr)) * 4096 + j * 128 + hh * 8;
  const u16* kbase = kaT + ((size_t)(bh * 128 + lr)) * 4096 + j * 128 + hh * 8;
#pragma unroll 4
  for (int ks = 0; ks < 8; ++ks) {
    const bf16x8 av = *(const bf16x8*)(vrow + ks * 16);
    bf16x8 a;
#pragma unroll
    for (int i = 0; i < 8; ++i) a[i] = (short)f2bf(bf2f((u16)av[i]) * s_w[ks * 16 + hh * 8 + i]);
#pragma unroll
    for (int dt = 0; dt < 4; ++dt) {
      const bf16x8 bk = *(const bf16x8*)(kbase + (size_t)(dt * 32) * 4096 + ks * 16);
      acc[dt] = MFMA(a, bk, acc[dt]);
    }
  }
  float* dst = CL + (size_t)u * 16384;
#pragma unroll
  for (int dt = 0; dt < 4; ++dt)
#pragma unroll
    for (int r = 0; r < 16; ++r) dst[(wave * 32 + crow(r, hh)) * 128 + dt * 32 + lr] = acc[dt][r];
  if (tid < 128) {
    const u16* kr = kaT + ((size_t)(bh * 128 + tid)) * 4096 + j * 128;
    float s = 0.f;
#pragma unroll 2
    for (int l = 0; l < 128; l += 8) {
      const bf16x8 kv = *(const bf16x8*)(kr + l);
#pragma unroll
      for (int i = 0; i < 8; ++i) s += s_w[l + i] * bf2f((u16)kv[i]);
    }
    nl[(size_t)u * 128 + tid] = s;
  }
}

DI void scan_unit(const Params& p, int unit) {
  const int tid = opaque_tid();
  const int sc = unit >> 4, part = unit & 15, dir = sc & 1;
  float* CL = p.out;
  float* nl = (float*)(p.ws + OFF_NL);
  const float* mloc = (const float*)(p.ws + OFF_MLOC);
  const float* gsum = (const float*)(p.ws + OFF_GSUM);
  float* ms = (float*)(p.ws + OFF_MS);
  const int idx = part * 1024 + tid * 4;
  float4 C = make_float4(0.f, 0.f, 0.f, 0.f);
  float nst = 0.f, m = 0.f;
  const bool do_n = (part == 0) && (tid < 128);
  float4 pf[4];
#pragma unroll
  for (int q = 0; q < 4; ++q) {
    const int jj = dir ? 31 - q : q;
    pf[q] = *(const float4*)(CL + (size_t)(sc * 32 + jj) * 16384 + idx);
  }
#pragma unroll 1
  for (int c0 = 0; c0 < 32; c0 += 4) {
#pragma unroll
    for (int q = 0; q < 4; ++q) {
      const int c = c0 + q;
      const int jj = dir ? 31 - c : c;
      const int u = sc * 32 + jj;
      const float4 cl = pf[q];
      *(float4*)(CL + (size_t)u * 16384 + idx) = C;
      if (c + 4 < 32) {
        const int j2 = dir ? 31 - (c + 4) : (c + 4);
        pf[q] = *(const float4*)(CL + (size_t)(sc * 32 + j2) * 16384 + idx);
      }
      const float g = gsum[u], ml = mloc[u];
      const float mn = fmaxf(g + m, ml);
      const float dec = expf(g + m - mn), scl = expf(ml - mn);
      C.x = dec * C.x + scl * cl.x; C.y = dec * C.y + scl * cl.y; C.z = dec * C.z + scl * cl.z; C.w = dec * C.w + scl * cl.w;
      if (do_n) {
        const float nv = nl[(size_t)u * 128 + tid];
        nl[(size_t)u * 128 + tid] = nst;
        nst = dec * nst + scl * nv;
      }
      if (part == 0 && tid == 0) ms[u] = m;
      m = mn;
    }
  }
}

template <int DIR>
DI void mlstm_dir(const Params& p, int bh, int j, char* smem, f32x16 (&hs)[4]) {
  float* s_gi = (float*)smem;
  float* s_lf = s_gi + 128;
  float* s_bc = s_lf + 128;
  float* s_r = s_bc + 128;
  float* s_al = s_r + 128;
  float* s_fl = s_al + 128;
  float* s_is = s_fl + 128;
  const int tid = opaque_tid(), lane = tid & 63, wave = tid >> 6, lr = lane & 31, hh = lane >> 5;
  u16* Pl = (u16*)(smem + 4096) + wave * (32 * 136);
  const int h = bh & 3, b = bh >> 2;
  const int T0 = b * 4096 + j * 128;
  const float* gates = (const float*)(p.ws + OFF_GATES);
  const u16* qa = (const u16*)(p.ws + OFF_QA);
  const u16* ka = (const u16*)(p.ws + OFF_KA);
  const u16* vT = (const u16*)(p.ws + OFF_VT);
  const float* CS = p.out;
  const float* ns = (const float*)(p.ws + OFF_NL);
  const float* ms = (const float*)(p.ws + OFF_MS);
  u16* A2 = (u16*)(p.ws + OFF_A2);
  bf16x8 ones;
#pragma unroll
  for (int i = 0; i < 8; ++i) ones[i] = (short)0x3F80;
  const u16* qrow = qa + (size_t)(T0 + wave * 32 + lr) * 512 + h * 128 + hh * 8;
  const int u = (bh * 2 + DIR) * 32 + j;
  const float msu = ms[u];
  __syncthreads();
  if (tid < 128) {
    const int T = T0 + tid;
    s_gi[tid] = gates[(size_t)T * 16 + DIR * 8 + h] + p.b_gates[DIR * 8 + h];
    s_lf[tid] = log_sigmoid(gates[(size_t)T * 16 + DIR * 8 + 4 + h] + p.b_gates[DIR * 8 + 4 + h]);
  }
  __syncthreads();
  if (tid < 128) {
    float a = 0.f;
#pragma unroll 4
    for (int m = 0; m < 128; ++m) {
      const bool in = (DIR == 0) ? (m <= tid) : (m >= tid);
      a += in ? s_lf[m] : 0.f;
    }
    s_bc[tid] = a;
    s_r[tid] = s_gi[tid] - a;
  }
  __syncthreads();
  if (tid < 128) {
    float cm = -3.0e38f;
#pragma unroll 4
    for (int m = 0; m < 128; ++m) {
      const bool in = (DIR == 0) ? (m <= tid) : (m >= tid);
      cm = in ? fmaxf(cm, s_r[m]) : cm;
    }
    const float bc = s_bc[tid];
    const float mt = bc + fmaxf(msu, cm);
    s_al[tid] = bc - mt;
    s_fl[tid] = expf(-mt);
    s_is[tid] = expf(bc + msu - mt);
  }
  __syncthreads();
  {
    f32x16 S[4];
#pragma unroll
    for (int st = 0; st < 4; ++st)
#pragma unroll
      for (int r = 0; r < 16; ++r) S[st][r] = 0.f;
    const u16* kbase = ka + (size_t)(T0 + lr) * 512 + h * 128 + hh * 8;
#pragma unroll 4
    for (int ks = 0; ks < 8; ++ks) {
      const bf16x8 a = *(const bf16x8*)(qrow + ks * 16);
#pragma unroll
      for (int st = 0; st < 4; ++st) {
        const bf16x8 bk = *(const bf16x8*)(kbase + (size_t)(st * 32) * 512 + ks * 16);
        S[st] = MFMA(a, bk, S[st]);
      }
    }
#pragma unroll
    for (int st = 0; st < 4; ++st) {
      const int sl = st * 32 + lr;
      const float rs = s_r[sl];
#pragma unroll
      for (int r = 0; r < 16; ++r) {
        const int tl = wave * 32 + crow(r, hh);
        const bool valid = (DIR == 0) ? (sl <= tl) : (sl >= tl);
        const float pv = valid ? S[st][r] * __expf(s_al[tl] + rs) : 0.f;
        Pl[crow(r, hh) * 136 + sl] = f2bf(pv);
      }
    }
  }
  __syncthreads();
#pragma unroll
  for (int eh = 0; eh < 2; ++eh) {
    f32x16 N[3];
#pragma unroll
    for (int e = 0; e < 3; ++e)
#pragma unroll
      for (int r = 0; r < 16; ++r) N[e][r] = 0.f;
    {
      const u16* vbase = vT + ((size_t)(bh * 128 + eh * 64 + lr)) * 4096 + j * 128 + hh * 8;
#pragma unroll 4
      for (int ks = 0; ks < 8; ++ks) {
        const bf16x8 a = *(const bf16x8*)(Pl + lr * 136 + ks * 16 + hh * 8);
#pragma unroll
        for (int e2 = 0; e2 < 2; ++e2) {
          const bf16x8 bv = *(const bf16x8*)(vbase + (size_t)(e2 * 32) * 4096 + ks * 16);
          N[e2] = MFMA(a, bv, N[e2]);
        }
        N[2] = MFMA(a, ones, N[2]);
      }
    }
    {
      const float isc = s_is[wave * 32 + lr];
      const float* cbase = CS + (size_t)u * 16384 + (size_t)(eh * 64 + lr) * 128 + hh * 8;
      const float* nbase = ns + (size_t)u * 128 + hh * 8;
#pragma unroll 4
      for (int ks = 0; ks < 8; ++ks) {
        const bf16x8 aq = *(const bf16x8*)(qrow + ks * 16);
        const bf16x8 a = scale8(aq, isc);
#pragma unroll
        for (int e2 = 0; e2 < 2; ++e2) {
          const float4 c0 = *(const float4*)(cbase + (size_t)(e2 * 32) * 128 + ks * 16);
          const float4 c1 = *(const float4*)(cbase + (size_t)(e2 * 32) * 128 + ks * 16 + 4);
          const float cv[8] = {c0.x, c0.y, c0.z, c0.w, c1.x, c1.y, c1.z, c1.w};
          N[e2] = MFMA(a, pack8(cv), N[e2]);
        }
        const float4 n0 = *(const float4*)(nbase + ks * 16);
        const float4 n1 = *(const float4*)(nbase + ks * 16 + 4);
        const float nv[8] = {n0.x, n0.y, n0.z, n0.w, n1.x, n1.y, n1.z, n1.w};
        N[2] = MFMA(a, pack8(nv), N[2]);
      }
    }
#pragma unroll
    for (int r = 0; r < 16; ++r) {
      const int tl = wave * 32 + crow(r, hh);
      const float den = fmaxf(fabsf(N[2][r]), s_fl[tl]);
      const float inv = 1.f / den;
#pragma unroll
      for (int e2 = 0; e2 < 2; ++e2) {
        const float hv = N[e2][r] * inv;
        u16* tp = A2 + (size_t)(T0 + tl) * 1024 + h * 128 + (eh * 2 + e2) * 32 + lr;
        if (DIR == 0) *tp = f2bf(hv);
        else hs[eh * 2 + e2][r] = hv + bf2f(*tp);
      }
    }
  }
}

DI void mlstm_out_unit(const Params& p, int unit, char* smem) {
  const int tid = opaque_tid(), lane = tid & 63, wave = tid >> 6, lr = lane & 31, hh = lane >> 5;
  const int j = unit & 31, bh = unit >> 5, h = bh & 3, b = bh >> 2;
  const int T0 = b * 4096 + j * 128;
  const u16* og = (const u16*)(p.ws + OFF_OG);
  u16* A2 = (u16*)(p.ws + OFF_A2);
  f32x16 hs[4];
  mlstm_dir<0>(p, bh, j, smem, hs);
  mlstm_dir<1>(p, bh, j, smem, hs);
#pragma unroll
  for (int r = 0; r < 16; ++r) {
    const int T = T0 + wave * 32 + crow(r, hh);
    float ss = 0.f;
#pragma unroll
    for (int et = 0; et < 4; ++et) {
      const float o = bf2f(og[(size_t)T * 512 + h * 128 + et * 32 + lr]);
      hs[et][r] *= o;
      ss += hs[et][r] * hs[et][r];
    }
#pragma unroll
    for (int o = 1; o < 32; o <<= 1) ss += __shfl_xor(ss, o, 64);
    const float rs = rsqrtf(ss * (1.f / 128.f) + EPS);
#pragma unroll
    for (int et = 0; et < 4; ++et) {
      const int e = h * 128 + et * 32 + lr;
      A2[(size_t)T * 1024 + e] = f2bf(hs[et][r] * rs * p.mlstm_norm_w[e]);
    }
  }
}

DI void hyena_norm_unit(const Params& p, int unit, char* smem) {
  float* tile = (float*)smem;
  const int tid = opaque_tid();
  const int tt = unit & 63, g = (unit >> 6) & 7, b = unit >> 9;
  const float* z2T = (const float*)(p.ws + OFF_Z2T);
  u16* A2 = (u16*)(p.ws + OFF_A2);
  __syncthreads();
#pragma unroll 4
  for (int i = 0; i < 16; ++i) {
    const int cl = (tid >> 6) + 4 * i, tl = tid & 63;
    tile[cl * 65 + tl] = z2T[((size_t)(b * 512 + g * 64 + cl)) * 4096 + tt * 64 + tl];
  }
  __syncthreads();
  const int tl = tid >> 2, qd = tid & 3;
  float v[16];
  float ss = 0.f;
#pragma unroll
  for (int i = 0; i < 16; ++i) {
    v[i] = tile[(qd * 16 + i) * 65 + tl];
    ss += v[i] * v[i];
  }
  ss += __shfl_xor(ss, 1, 64);
  ss += __shfl_xor(ss, 2, 64);
  const float rs = rsqrtf(ss * (1.f / 64.f) + EPS);
  const size_t T = (size_t)b * 4096 + tt * 64 + tl;
  u16* dst = A2 + T * 1024 + 512 + g * 64 + qd * 16;
  const float* w = p.hyena_norm_w + g * 64 + qd * 16;
  float o[16];
#pragma unroll
  for (int i = 0; i < 16; ++i) o[i] = v[i] * rs * w[i];
  *(bf16x8*)(dst) = pack8(o);
  *(bf16x8*)(dst + 8) = pack8(o + 8);
}

template <int EPI>
DI void gemm_phase(const u16* A, const u16* Bt, int K, int ntn, void* outp, char* smem) {
  const int tid = threadIdx.x, lane = tid & 63, wave = tid >> 6, wr = wave >> 1, wc = wave & 1, lr = lane & 31, hh = lane >> 5;
  const int ntiles = 64 * ntn;
  for (int id = blockIdx.x; id < ntiles; id += gridDim.x) {
    int mt, nt;
    tile_map(id, ntn, mt, nt);
    const int m0 = mt * 256, n0 = nt * 128;
    f32x16 acc[4][2];
    gemm_core<false>(A, Bt, K, m0, n0, smem, acc);
#pragma unroll
    for (int i = 0; i < 4; ++i)
#pragma unroll
      for (int j = 0; j < 2; ++j)
#pragma unroll
        for (int r = 0; r < 16; ++r) {
          const int row = m0 + wr * 128 + i * 32 + crow(r, hh);
          const int col = n0 + wc * 64 + j * 32 + lr;
          const float val = acc[i][j][r];
          if (EPI == 0) ((float*)outp)[(size_t)row * 1024 + col] = val;
          else {
            const float rl = fmaxf(val, 0.f);
            ((u16*)outp)[(size_t)row * 4096 + col] = f2bf(rl * rl);
          }
        }
  }
}

DI void phase_post_mix(const Params& p) {
  const int tid = threadIdx.x, lane = tid & 63, wave = tid >> 6;
  const float* mix = p.out;
  float* x1 = (float*)(p.ws + OFF_X1);
  u16* hm = (u16*)(p.ws + OFF_HM);
  for (int u = blockIdx.x; u < 1024; u += gridDim.x) {
#pragma unroll 2
    for (int rr = 0; rr < 4; ++rr) {
      const size_t row = (size_t)u * 16 + wave * 4 + rr;
      float4 mv[4], xv[4];
      float ss = 0.f;
#pragma unroll
      for (int i = 0; i < 4; ++i) {
        mv[i] = ((const float4*)(mix + row * DM))[lane + 64 * i];
        xv[i] = ((const float4*)(p.x + row * DM))[lane + 64 * i];
        ss += mv[i].x * mv[i].x + mv[i].y * mv[i].y + mv[i].z * mv[i].z + mv[i].w * mv[i].w;
      }
      ss = wave_sum(ss);
      const float rs = rsqrtf(ss * (1.f / DM) + EPS);
      float s2 = 0.f;
#pragma unroll
      for (int i = 0; i < 4; ++i) {
        const float4 w = ((const float4*)p.norm_mix_post)[lane + 64 * i];
        xv[i].x += mv[i].x * rs * w.x; xv[i].y += mv[i].y * rs * w.y; xv[i].z += mv[i].z * rs * w.z; xv[i].w += mv[i].w * rs * w.w;
        s2 += xv[i].x * xv[i].x + xv[i].y * xv[i].y + xv[i].z * xv[i].z + xv[i].w * xv[i].w;
        ((float4*)(x1 + row * DM))[lane + 64 * i] = xv[i];
      }
      s2 = wave_sum(s2);
      const float r2 = rsqrtf(s2 * (1.f / DM) + EPS);
#pragma unroll
      for (int i = 0; i < 4; ++i) {
        const float4 w = ((const float4*)p.norm_mlp_pre)[lane + 64 * i];
        ushort4 o;
        o.x = f2bf(xv[i].x * r2 * w.x); o.y = f2bf(xv[i].y * r2 * w.y); o.z = f2bf(xv[i].z * r2 * w.z); o.w = f2bf(xv[i].w * r2 * w.w);
        *(ushort4*)(hm + row * DM + (lane + 64 * i) * 4) = o;
      }
    }
  }
}

DI void phase_final(const Params& p) {
  const int tid = threadIdx.x, lane = tid & 63, wave = tid >> 6;
  const float* x1 = (const float*)(p.ws + OFF_X1);
  for (int u = blockIdx.x; u < 1024; u += gridDim.x) {
#pragma unroll 2
    for (int rr = 0; rr < 4; ++rr) {
      const size_t row = (size_t)u * 16 + wave * 4 + rr;
      float4 fv[4];
      float ss = 0.f;
#pragma unroll
      for (int i = 0; i < 4; ++i) {
        fv[i] = ((const float4*)(p.out + row * DM))[lane + 64 * i];
        ss += fv[i].x * fv[i].x + fv[i].y * fv[i].y + fv[i].z * fv[i].z + fv[i].w * fv[i].w;
      }
      ss = wave_sum(ss);
      const float rs = rsqrtf(ss * (1.f / DM) + EPS);
#pragma unroll
      for (int i = 0; i < 4; ++i) {
        const float4 w = ((const float4*)p.norm_mlp_post)[lane + 64 * i];
        const float4 xv = ((const float4*)(x1 + row * DM))[lane + 64 * i];
        float4 o;
        o.x = xv.x + fv[i].x * rs * w.x; o.y = xv.y + fv[i].y * rs * w.y; o.z = xv.z + fv[i].z * rs * w.z; o.w = xv.w + fv[i].w * rs * w.w;
        ((float4*)(p.out + row * DM))[lane + 64 * i] = o;
      }
    }
  }
}

DI void run_phase(const Params& p, int ph, char* smem) {
  switch (ph) {
    case 0: phase0(p, smem); break;
    case 1: phase1(p, smem); break;
    case 2: phase_qk(p, smem); break;
    case 3:
#ifdef DBL_HYONLY
      for (int u = blockIdx.x; u < 512; u += gridDim.x) hyena_unit(p, u, smem);
#endif
#ifdef DBL_MLONLY
      for (int u = blockIdx.x; u < 1024; u += gridDim.x) mlstm_local_unit(p, u, smem);
#endif
      for (int u = blockIdx.x; u < 512 + 1024; u += gridDim.x) {
        if (u < 512) hyena_unit(p, u, smem);
        else mlstm_local_unit(p, u - 512, smem);
      }
      break;
    case 4:
      for (int u = blockIdx.x; u < 512; u += gridDim.x) scan_unit(p, u);
      break;
    case 5:
      for (int u = blockIdx.x; u < 512 + 2048; u += gridDim.x) {
#ifndef DBG_SKIP_MLSTM
        if (u < 512) mlstm_out_unit(p, u, smem);
#else
        if (u < 512) { u16* A2 = (u16*)(p.ws + OFF_A2); const int T0 = (u >> 5 >> 2) * 4096 + (u & 31) * 128, hq = (u >> 5) & 3;
          for (int i = threadIdx.x; i < 128 * 128; i += 256) A2[(size_t)(T0 + (i >> 7)) * 1024 + hq * 128 + (i & 127)] = 0; }
#endif
#ifndef DBG_SKIP_HYENA
        else hyena_norm_unit(p, u - 512, smem);
#else
        else { const int un = u - 512; const int tt = un & 63, g = (un >> 6) & 7, b = un >> 9; u16* A2 = (u16*)(p.ws + OFF_A2);
          for (int i = threadIdx.x; i < 64 * 64; i += 256) A2[((size_t)b * 4096 + tt * 64 + (i >> 6)) * 1024 + 512 + g * 64 + (i & 63)] = 0x3F80; }
#endif
      }
      break;
    case 6: gemm_phase<0>((const u16*)(p.ws + OFF_A2), (const u16*)(p.ws + OFF_WOUTT), 1024, 8, p.out, smem); break;
    case 7: phase_post_mix(p); break;
    case 8: gemm_phase<1>((const u16*)(p.ws + OFF_HM), (const u16*)(p.ws + OFF_W1T), 1024, 32, p.ws + OFF_H, smem); break;
    case 9: gemm_phase<0>((const u16*)(p.ws + OFF_H), (const u16*)(p.ws + OFF_W2T), 4096, 8, p.out, smem); break;
    case 10: phase_final(p); break;
  }
}
constexpr int NPHASE = 11;

#define XB_XCNT(j)  (256  + 64 * (j))
#define XB_XSUB(j)  (1280 + 64 * (j))
#define XB_XGEN(j)  (2304 + 64 * (j))
#define XB_TOP      3328
#define XB_TOPGEN   3392
#define XCD_BAR_WORDS 3456
DI unsigned xb_ld(unsigned* p) { return __hip_atomic_load(p, __ATOMIC_RELAXED, __HIP_MEMORY_SCOPE_AGENT); }
DI unsigned xb_add(unsigned* p, unsigned v) { return __hip_atomic_fetch_add(p, v, __ATOMIC_RELAXED, __HIP_MEMORY_SCOPE_AGENT); }
DI unsigned xb_xcc_id() { return (unsigned)__builtin_amdgcn_s_getreg((3 << 11) | 20) & 0xFu; }
struct XcdBar { unsigned* bar; unsigned x, nloc, nx; };
DI void xcd_barrier(XcdBar& b) {
  asm volatile("s_waitcnt vmcnt(0)" ::: "memory");
  __syncthreads();
  if (threadIdx.x == 0) {
    unsigned* bar = b.bar;
    __builtin_amdgcn_s_waitcnt(0);
    if (b.nloc == 0u) {
      const unsigned G = gridDim.x;
      unsigned sum, cnt, mine;
      for (;;) {
        sum = 0u; cnt = 0u; mine = 0u;
#pragma unroll
        for (unsigned j = 0; j < 16; ++j) { const unsigned c = xb_ld(&bar[XB_XCNT(j)]); sum += c; cnt += (c > 0u) ? 1u : 0u; mine = (j == b.x) ? c : mine; }
        if (sum == G) break;
        __builtin_amdgcn_s_sleep(1);
      }
      b.nloc = mine > 0u ? mine : 1u; b.nx = cnt > 0u ? cnt : 1u;
    }
    const unsigned nloc = b.nloc, nx = b.nx;
    const unsigned old = xb_add(&bar[XB_XSUB(b.x)], 1u);
    const unsigned gen = old / nloc;
    if (old + 1u == (gen + 1u) * nloc) {
      __builtin_amdgcn_fence(__ATOMIC_RELEASE, "agent");
      asm volatile("s_waitcnt vmcnt(0)" ::: "memory");
      const unsigned og = xb_add(&bar[XB_TOP], 1u);
      const unsigned tg = og / nx;
      if (og + 1u == (tg + 1u) * nx) xb_add(&bar[XB_TOPGEN], 1u);
      else while (xb_ld(&bar[XB_TOPGEN]) == tg) __builtin_amdgcn_s_sleep(1);
      __builtin_amdgcn_fence(__ATOMIC_ACQUIRE, "agent");
      xb_add(&bar[XB_XGEN(b.x)], 1u);
      asm volatile("s_waitcnt vmcnt(0)" ::: "memory");
    } else {
      while (xb_ld(&bar[XB_XGEN(b.x)]) == gen) __builtin_amdgcn_s_sleep(1);
      __builtin_amdgcn_fence(__ATOMIC_ACQUIRE, "agent");
      asm volatile("s_waitcnt vmcnt(0)" ::: "memory");
    }
  }
  __syncthreads();
}

#if MULTI_LAUNCH
template <int PH>
__global__ void __launch_bounds__(256, 2) phase_kernel(Params p) {
  __shared__ __attribute__((aligned(16))) char smem[65536];
  run_phase(p, PH, smem);
}
template <int PH>
static void launch_phase(const Params& p, hipStream_t stream) {
  hipLaunchKernelGGL(phase_kernel<PH>, dim3(512), dim3(256), 0, stream, p);
}
#else
__global__ void __launch_bounds__(256, 2) mega_kernel(Params p) {
  __shared__ __attribute__((aligned(16))) char smem[65536];
  cg::grid_group grid = cg::this_grid();
  XcdBar xb;
  xb.bar = (unsigned*)(p.ws + OFF_BAR); xb.x = xb_xcc_id(); xb.nloc = 0u; xb.nx = 0u;
  if (p.ws == nullptr) grid.sync();
  if (threadIdx.x == 0) (void)xb_add(&xb.bar[XB_XCNT(xb.x)], 1u);
#define GSYNC xcd_barrier(xb)
#ifdef DBL_P0
  run_phase(p, 0, smem);
#endif
  run_phase(p, 0, smem); GSYNC;
  run_phase(p, 1, smem); GSYNC;
#ifdef DBL_GEMM
  run_phase(p, 1, smem); grid.sync();
#endif
  run_phase(p, 2, smem); GSYNC;
#ifdef DBL_P2
  run_phase(p, 2, smem); GSYNC;
#endif
  run_phase(p, 3, smem); GSYNC;
#ifdef DBL_HY
  run_phase(p, 3, smem); GSYNC;
#endif
  run_phase(p, 4, smem); GSYNC;
  run_phase(p, 5, smem); GSYNC;
#ifdef DBL_P5
  run_phase(p, 5, smem); GSYNC;
#endif
  run_phase(p, 6, smem); GSYNC;
#ifdef DBL_GEMM
  run_phase(p, 6, smem); GSYNC;
#endif
  run_phase(p, 7, smem); GSYNC;
#ifdef DBL_P7
  run_phase(p, 7, smem); GSYNC;
#endif
  run_phase(p, 8, smem); GSYNC;
#ifdef DBL_GEMM
  run_phase(p, 8, smem); GSYNC;
#endif
  run_phase(p, 9, smem); GSYNC;
#ifdef DBL_GEMM
  run_phase(p, 9, smem); GSYNC;
#endif
#ifdef XSYNC
  for (int q = 0; q < 10; ++q) GSYNC;
#endif
  run_phase(p, 10, smem);
}
#endif

extern "C" void kernel_launch(void* const* d_in, const int* in_sizes, int n_in, void* d_out, int out_size, void* d_ws,
                              size_t ws_size, hipStream_t stream) {
  Params p{};
  const float** pp = (const float**)&p;
  for (int i = 0; i < 23; ++i) pp[i] = (const float*)d_in[i];
  p.out = (float*)d_out;
  p.ws = (char*)d_ws;
#if MULTI_LAUNCH
  launch_phase<0>(p, stream);
#ifdef DBL_P0
  launch_phase<0>(p, stream);
#endif
 launch_phase<1>(p, stream); launch_phase<2>(p, stream); launch_phase<3>(p, stream);
#ifdef DBL_HY
  launch_phase<3>(p, stream);
#endif

  launch_phase<4>(p, stream); launch_phase<5>(p, stream);
#ifdef DBL_P5
  launch_phase<5>(p, stream);
#endif
 launch_phase<6>(p, stream); launch_phase<7>(p, stream);
  launch_phase<8>(p, stream); launch_phase<9>(p, stream); launch_phase<10>(p, stream);
#else
  static int grid_blocks = 0;
  if (!grid_blocks) {
    int dev = 0, cus = 0, per_cu = 0;
    hipGetDevice(&dev);
    hipDeviceGetAttribute(&cus, hipDeviceAttributeMultiprocessorCount, dev);
    hipOccupancyMaxActiveBlocksPerMultiprocessor(&per_cu, mega_kernel, 256, 0);
    if (per_cu > 2) per_cu = 2;
    if (per_cu < 1) per_cu = 1;
#ifdef FORCE2
    per_cu = 2;
#endif
    grid_blocks = cus * per_cu;
  }
  hipMemsetAsync((char*)d_ws + OFF_BAR, 0, XCD_BAR_WORDS * 4, stream);
  void* args[] = {&p};
  hipError_t e = hipLaunchCooperativeKernel((void*)mega_kernel, dim3(grid_blocks), dim3(256), args, 0, stream);
  if (e != hipSuccess) fprintf(stderr, "cooperative launch failed: %s (grid %d)\n", hipGetErrorString(e), grid_blocks);
#endif
}
#if defined(__HIP_DEVICE_COMPILE__)
#pragma clang attribute pop
#endif
```

```cpp
#if defined(__HIP_DEVICE_COMPILE__)
#pragma clang attribute push(__attribute__((target("no-packed-fp32-ops"))), apply_to = function)
#endif
#include <hip/hip_runtime.h>
#include <hip/hip_cooperative_groups.h>
#include <cstdio>
namespace cg = cooperative_groups;

#ifndef MULTI_LAUNCH
#define MULTI_LAUNCH 0
#endif

typedef unsigned short u16;
using bf16x8 = __attribute__((ext_vector_type(8))) short;
using f32x16 = __attribute__((ext_vector_type(16))) float;
#define DI __device__ __forceinline__
#define MFMA(a, b, c) __builtin_amdgcn_mfma_f32_32x32x16_bf16((a), (b), (c), 0, 0, 0)

constexpr int SEQ = 4096, DM = 1024, NTOK = 16384, NIN = 3600, NINP = 3712, DFF = 4096;
constexpr float EPS = 1e-6f;
constexpr size_t MiB = 1u << 20;
constexpr size_t OFF_WINT = 0, OFF_WOUTT = 8 * MiB, OFF_W1T = 10 * MiB, OFF_W2T = 18 * MiB;
constexpr size_t OFF_XN = 26 * MiB, OFF_QA = 26 * MiB, OFF_KA = 42 * MiB;
constexpr size_t OFF_FILT = 58 * MiB, OFF_QKPRE = 90 * MiB, OFF_A2 = 90 * MiB;
constexpr size_t OFF_HYT = 122 * MiB, OFF_VT = 170 * MiB, OFF_OG = 186 * MiB, OFF_GATES = 202 * MiB;
constexpr size_t OFF_NL = 203 * MiB, OFF_MLOC = 203 * MiB + 512 * 1024, OFF_GSUM = OFF_MLOC + 4096, OFF_MS = OFF_GSUM + 4096;
constexpr size_t OFF_KAT = 205 * MiB, OFF_Z2T = 221 * MiB;
constexpr size_t OFF_TW = 204 * MiB, OFF_BAR = 254 * MiB;
constexpr size_t OFF_X1 = 26 * MiB, OFF_HM = 90 * MiB, OFF_H = 122 * MiB;

struct Params {
  const float *x, *norm_mix_pre, *norm_mix_post, *norm_mlp_pre, *norm_mlp_post, *w_in, *b_gates, *conv_w, *conv_b,
      *mlstm_norm_w, *hyena_norm_w, *filt_w1, *filt_b1, *filt_w2, *filt_b2, *filt_w3, *filt_b3, *filt_w4, *filt_freq,
      *filt_bias, *w_out, *w_mlp_in, *w_mlp_out;
  float* out;
  char* ws;
};

DI u16 f2bf(float x) { unsigned u = __float_as_uint(x); u += 0x7fffu + ((u >> 16) & 1u); return (u16)(u >> 16); }
DI float bf2f(u16 v) { return __uint_as_float(((unsigned)v) << 16); }
DI int opaque_tid() { int t = threadIdx.x; asm volatile("" : "+v"(t)); return t; }
DI int crow(int r, int hh) { return (r & 3) + 8 * (r >> 2) + 4 * hh; }
DI float log_sigmoid(float x) { return fminf(x, 0.f) - log1pf(expf(-fabsf(x))); }
DI float sigmoidf(float x) { return 1.f / (1.f + expf(-x)); }
DI float red2pi(float x) {
  const float k = rintf(x * 0.15915494309189535f);
  float r = fmaf(-k, 6.28125f, x);
  return fmaf(-k, 1.9353071795864769e-3f, r);
}
DI float fsin(float x) { return sinf(x); }
DI float fcos(float x) { return cosf(x); }
DI bf16x8 pack8(const float* v) {
  bf16x8 r;
#pragma unroll
  for (int i = 0; i < 8; ++i) r[i] = (short)f2bf(v[i]);
  return r;
}
DI bf16x8 scale8(bf16x8 a, float s) {
  bf16x8 r;
#pragma unroll
  for (int i = 0; i < 8; ++i) r[i] = (short)f2bf(bf2f((u16)a[i]) * s);
  return r;
}

template <bool SWAP>
DI void gemm_core(const u16* __restrict__ A, const u16* __restrict__ Bt, int K, int m0, int n0, char* smem, f32x16 (&acc)[4][2]) {
  const int tid = opaque_tid(), lane = tid & 63, wave = tid >> 6, wr = wave >> 1, wc = wave & 1;
  const int lr = lane & 31, hh = lane >> 5;
#pragma unroll
  for (int i = 0; i < 4; ++i)
#pragma unroll
    for (int j = 0; j < 2; ++j)
#pragma unroll
      for (int r = 0; r < 16; ++r) acc[i][j][r] = 0.f;
  const int c = tid & 7, r0 = tid >> 3;
  const u16* Ag = A + (size_t)(m0 + r0) * K + c * 8;
  const u16* Bg = Bt + (size_t)(n0 + r0) * K + c * 8;
  const int soff = r0 * 128 + ((c ^ ((r0 >> 1) & 7)) << 4);
  char* As = smem;
  char* Bs = smem + 32768;
  uint4 ra0, ra1, ra2, ra3, ra4, ra5, ra6, ra7, rb0, rb1, rb2, rb3;
#define GLOAD_ALL(k0)                                                                                             \
  ra0 = *(const uint4*)(Ag + (size_t)(0) * K + (k0));   ra1 = *(const uint4*)(Ag + (size_t)(32) * K + (k0));      \
  ra2 = *(const uint4*)(Ag + (size_t)(64) * K + (k0));  ra3 = *(const uint4*)(Ag + (size_t)(96) * K + (k0));      \
  ra4 = *(const uint4*)(Ag + (size_t)(128) * K + (k0)); ra5 = *(const uint4*)(Ag + (size_t)(160) * K + (k0));     \
  ra6 = *(const uint4*)(Ag + (size_t)(192) * K + (k0)); ra7 = *(const uint4*)(Ag + (size_t)(224) * K + (k0));     \
  rb0 = *(const uint4*)(Bg + (size_t)(0) * K + (k0));   rb1 = *(const uint4*)(Bg + (size_t)(32) * K + (k0));      \
  rb2 = *(const uint4*)(Bg + (size_t)(64) * K + (k0));  rb3 = *(const uint4*)(Bg + (size_t)(96) * K + (k0));
  GLOAD_ALL(0)
  const int nk = K >> 6;
#pragma unroll 1
  for (int kt = 0; kt < nk; ++kt) {
    __syncthreads();
    *(uint4*)(As + soff + 0 * 4096) = ra0; *(uint4*)(As + soff + 1 * 4096) = ra1; *(uint4*)(As + soff + 2 * 4096) = ra2; *(uint4*)(As + soff + 3 * 4096) = ra3;
    *(uint4*)(As + soff + 4 * 4096) = ra4; *(uint4*)(As + soff + 5 * 4096) = ra5; *(uint4*)(As + soff + 6 * 4096) = ra6; *(uint4*)(As + soff + 7 * 4096) = ra7;
    *(uint4*)(Bs + soff + 0 * 4096) = rb0; *(uint4*)(Bs + soff + 1 * 4096) = rb1; *(uint4*)(Bs + soff + 2 * 4096) = rb2; *(uint4*)(Bs + soff + 3 * 4096) = rb3;
    __syncthreads();
    if (kt + 1 < nk) {
      const int k0 = (kt + 1) << 6;
      GLOAD_ALL(k0)
    }
#pragma unroll
    for (int kk = 0; kk < 4; ++kk) {
      bf16x8 a[4], b[2];
      const int cc = kk * 2 + hh;
#pragma unroll
      for (int i = 0; i < 4; ++i) {
        const int r = wr * 128 + i * 32 + lr;
        a[i] = *(const bf16x8*)(As + r * 128 + ((cc ^ ((r >> 1) & 7)) << 4));
      }
#pragma unroll
      for (int j = 0; j < 2; ++j) {
        const int r = wc * 64 + j * 32 + lr;
        b[j] = *(const bf16x8*)(Bs + r * 128 + ((cc ^ ((r >> 1) & 7)) << 4));
      }
#pragma unroll
      for (int i = 0; i < 4; ++i)
#pragma unroll
        for (int j = 0; j < 2; ++j) acc[i][j] = SWAP ? MFMA(b[j], a[i], acc[i][j]) : MFMA(a[i], b[j], acc[i][j]);
    }
  }
  __syncthreads();
}

DI void tile_map(int id, int ntn, int& mt, int& nt) {
  const int r = id >> 9, b = id & 511;
  const int x = b & 7, sidx = b >> 3;
  const int P = r * 8 + x;
  mt = (P & 7) * 8 + (sidx & 7);
  nt = (P >> 3) * 8 + (sidx >> 3);
}
DI int tile_count(int ntn) { return ((ntn + 7) >> 3) * 512; }

DI void transpose_tile(const float* __restrict__ src, int R, int C, u16* __restrict__ dst, int kt, int nt, char* smem) {
  float* tile = (float*)smem;
  const int tid = threadIdx.x;
  const int k0 = kt * 64, n0 = nt * 64;
#pragma unroll 4
  for (int it = 0; it < 16; ++it) {
    const int kk = it * 4 + (tid >> 6), nn = tid & 63;
    const int n = n0 + nn;
    tile[kk * 65 + nn] = (n < C) ? src[(size_t)(k0 + kk) * C + n] : 0.f;
  }
  __syncthreads();
#pragma unroll 4
  for (int it = 0; it < 16; ++it) {
    const int nn = it * 4 + (tid >> 6), kk = tid & 63;
    dst[(size_t)(n0 + nn) * R + k0 + kk] = f2bf(tile[kk * 65 + nn]);
  }
  __syncthreads();
}

DI float wave_sum(float v) {
#pragma unroll
  for (int o = 32; o; o >>= 1) v += __shfl_xor(v, o, 64);
  return v;
}

DI void filter_unit(const Params& p, int unit, char* smem) {
  float* sz = (float*)smem;
  float* hA = sz + 8 * 33 + 8;
  float* hB = hA + 8 * 64;
  float* hT = hB + 8 * 64;
  const int tid = opaque_tid();
  const int l0 = unit * 8;
  for (int idx = tid; idx < 8 * 33; idx += 256) {
    const int pp = idx / 33, f = idx - pp * 33;
    const float l = (float)(l0 + pp);
    float v;
    if (f == 0) v = l / 4095.f;
    else {
      const int jb = (f - 1) & 15;
      const float fj = 1e-4f + (float)jb * ((15.f - 1e-4f) / 15.f);
      const float ang = 6.283185307179586f * l / 4096.f;
      v = (f <= 16) ? fcos(fj * ang) : -fsin(fj * ang);
    }
    sz[idx] = v;
  }
  const int o = tid & 63, pq = tid >> 6;
  {
    const float bb = p.filt_b1[o], fr = p.filt_freq[o];
    __syncthreads();
    float s0 = bb, s1 = bb;
#pragma unroll 1
    for (int f0 = 0; f0 < 33; f0 += 11) {
      float wc[11];
#pragma unroll
      for (int f = 0; f < 11; ++f) wc[f] = p.filt_w1[(f0 + f) * 64 + o];
#pragma unroll
      for (int f = 0; f < 11; ++f) { s0 += sz[pq * 33 + f0 + f] * wc[f]; s1 += sz[(pq + 4) * 33 + f0 + f] * wc[f]; }
    }
    hA[pq * 64 + o] = fsin(fr * s0);
    hA[(pq + 4) * 64 + o] = fsin(fr * s1);
  }
  {
    const float bb = p.filt_b2[o], fr = p.filt_freq[64 + o];
    __syncthreads();
    float s0 = bb, s1 = bb;
#pragma unroll 1
    for (int k0 = 0; k0 < 64; k0 += 16) {
      float wc[16];
#pragma unroll
      for (int k = 0; k < 16; ++k) wc[k] = p.filt_w2[(k0 + k) * 64 + o];
#pragma unroll
      for (int k = 0; k < 16; ++k) { s0 += hA[pq * 64 + k0 + k] * wc[k]; s1 += hA[(pq + 4) * 64 + k0 + k] * wc[k]; }
    }
    hB[pq * 64 + o] = fsin(fr * s0);
    hB[(pq + 4) * 64 + o] = fsin(fr * s1);
  }
  {
    const float bb = p.filt_b3[o], fr = p.filt_freq[128 + o];
    __syncthreads();
    float s0 = bb, s1 = bb;
#pragma unroll 1
    for (int k0 = 0; k0 < 64; k0 += 16) {
      float wc[16];
#pragma unroll
      for (int k = 0; k < 16; ++k) wc[k] = p.filt_w3[(k0 + k) * 64 + o];
#pragma unroll
      for (int k = 0; k < 16; ++k) { s0 += hB[pq * 64 + k0 + k] * wc[k]; s1 += hB[(pq + 4) * 64 + k0 + k] * wc[k]; }
    }
    hT[o * 8 + pq] = fsin(fr * s0);
    hT[o * 8 + pq + 4] = fsin(fr * s1);
  }
  __syncthreads();
  float* filt = (float*)(p.ws + OFF_FILT);
  const float min_decay = -3.0701134573253944f, max_decay = -15.350567286626973f;
#pragma unroll 1
  for (int cc = 0; cc < 8; ++cc) {
    const int col = tid + 256 * cc;
    float acc[8];
#pragma unroll
    for (int q = 0; q < 8; ++q) acc[q] = 0.f;
#pragma unroll 1
    for (int k0 = 0; k0 < 64; k0 += 16) {
      float wc[16];
#pragma unroll
      for (int k = 0; k < 16; ++k) wc[k] = p.filt_w4[(k0 + k) * 2048 + col];
#pragma unroll
      for (int k = 0; k < 16; ++k) {
        const float4 h0 = *(const float4*)(hT + (k0 + k) * 8);
        const float4 h1 = *(const float4*)(hT + (k0 + k) * 8 + 4);
        acc[0] += h0.x * wc[k]; acc[1] += h0.y * wc[k]; acc[2] += h0.z * wc[k]; acc[3] += h0.w * wc[k];
        acc[4] += h1.x * wc[k]; acc[5] += h1.y * wc[k]; acc[6] += h1.z * wc[k]; acc[7] += h1.w * wc[k];
      }
    }
    const int ch = col & 511;
    const float delta = fabsf(min_decay + (float)ch * ((max_decay - min_decay) / 511.f));
#pragma unroll
    for (int q = 0; q < 8; ++q) {
      const float t = (float)(l0 + q) / 4095.f;
      acc[q] *= expf(-t * delta);
    }
    float4* dst = (float4*)(filt + (size_t)col * 4096 + l0);
    dst[0] = make_float4(acc[0], acc[1], acc[2], acc[3]);
    dst[1] = make_float4(acc[4], acc[5], acc[6], acc[7]);
  }
  __syncthreads();
}

DI void phase0(const Params& p, char* smem) {
  const int tid = threadIdx.x, lane = tid & 63, wave = tid >> 6;
  const int U_W = 32, U_F = 512, U_X = 1024, U_T1 = 58 * 16, U_T2 = 256, U_T3 = 1024, U_T4 = 1024;
  const int total = U_W + U_F + U_X + U_T1 + U_T2 + U_T3 + U_T4;
  for (int u = blockIdx.x; u < total; u += gridDim.x) {
    int v = u;
    if (v < U_W) {
      const int idx = v * 256 + tid;
      if (idx < 8191) {
        const int lh = 31 - __clz(idx + 1);
        const int h = 1 << lh, jj = idx + 1 - h;
        float2* twp = (float2*)(p.ws + OFF_TW);
        const float ang = -3.14159265358979f * (float)jj / (float)h;
        twp[idx] = make_float2(cosf(ang), sinf(ang));
      }
      continue;
    }
    v -= U_W;
    if (v < U_F) { filter_unit(p, v, smem); continue; }
    v -= U_F;
    if (v < U_X) {
      u16* xn = (u16*)(p.ws + OFF_XN);
#pragma unroll 4
      for (int rr = 0; rr < 4; ++rr) {
        const int row = v * 16 + wave * 4 + rr;
        const float4* xr = (const float4*)(p.x + (size_t)row * DM);
        float4 xv[4];
        float ss = 0.f;
#pragma unroll
        for (int i = 0; i < 4; ++i) {
          xv[i] = xr[lane + 64 * i];
          ss += xv[i].x * xv[i].x + xv[i].y * xv[i].y + xv[i].z * xv[i].z + xv[i].w * xv[i].w;
        }
        ss = wave_sum(ss);
        const float rs = rsqrtf(ss * (1.f / DM) + EPS);
#pragma unroll
        for (int i = 0; i < 4; ++i) {
          const float4 w = ((const float4*)p.norm_mix_pre)[lane + 64 * i];
          ushort4 o;
          o.x = f2bf(xv[i].x * rs * w.x); o.y = f2bf(xv[i].y * rs * w.y); o.z = f2bf(xv[i].z * rs * w.z); o.w = f2bf(xv[i].w * rs * w.w);
          *(ushort4*)(xn + (size_t)row * DM + (lane + 64 * i) * 4) = o;
        }
      }
      continue;
    }
    v -= U_X;
    if (v < U_T1) { transpose_tile(p.w_in, DM, NIN, (u16*)(p.ws + OFF_WINT), v & 15, v >> 4, smem); continue; }
    v -= U_T1;
    if (v < U_T2) { transpose_tile(p.w_out, DM, DM, (u16*)(p.ws + OFF_WOUTT), v & 15, v >> 4, smem); continue; }
    v -= U_T2;
    if (v < U_T3) { transpose_tile(p.w_mlp_in, DM, DFF, (u16*)(p.ws + OFF_W1T), v & 15, v >> 4, smem); continue; }
    v -= U_T3;
    transpose_tile(p.w_mlp_out, DFF, DM, (u16*)(p.ws + OFF_W2T), v & 63, v >> 6, smem);
  }
}

DI void phase1(const Params& p, char* smem) {
  const int tid = threadIdx.x, lane = tid & 63, wave = tid >> 6, wr = wave >> 1, wc = wave & 1, lr = lane & 31, hh = lane >> 5;
  const u16* xn = (const u16*)(p.ws + OFF_XN);
  const u16* wt = (const u16*)(p.ws + OFF_WINT);
  u16* qkpre = (u16*)(p.ws + OFF_QKPRE);
  u16* hyT = (u16*)(p.ws + OFF_HYT);
  u16* vT = (u16*)(p.ws + OFF_VT);
  u16* og = (u16*)(p.ws + OFF_OG);
  float* gates = (float*)(p.ws + OFF_GATES);
  const int ntn = 29, ntiles = tile_count(ntn);
  for (int id = blockIdx.x; id < ntiles; id += gridDim.x) {
    int mt, nt;
    tile_map(id, ntn, mt, nt);
    if (nt >= ntn) continue;
    const int m0 = mt * 256, n0 = nt * 128;
    f32x16 acc[4][2];
    const bool swap = (nt >= 8 && nt < 24);
    if (swap) gemm_core<true>(xn, wt, DM, m0, n0, smem, acc);
    else gemm_core<false>(xn, wt, DM, m0, n0, smem, acc);
#pragma unroll
    for (int i = 0; i < 4; ++i)
#pragma unroll
      for (int j = 0; j < 2; ++j)
#pragma unroll
        for (int r = 0; r < 16; ++r) {
          const float val = acc[i][j][r];
          if (!swap) {
            const int row = m0 + wr * 128 + i * 32 + crow(r, hh);
            const int col = n0 + wc * 64 + j * 32 + lr;
            if (nt < 8) qkpre[(size_t)row * 1024 + col] = f2bf(val);
            else if (nt < 28) og[(size_t)row * 512 + (col - 3072)] = f2bf(sigmoidf(val));
            else if (col < 3600) gates[(size_t)row * 16 + (col - 3584)] = val;
          } else {
            const int n = n0 + wc * 64 + j * 32 + crow(r, hh);
            const int m = m0 + wr * 128 + i * 32 + lr;
            const int b = m >> 12, t = m & 4095;
            if (nt < 20) {
              const int cc = n - 1024, g = cc >> 9, ch = cc & 511;
              hyT[((size_t)((g * 4 + b) * 512 + ch)) * 4096 + t] = f2bf(val);
            } else {
              const int cc = n - 2560;
              vT[((size_t)(b * 512 + cc)) * 4096 + t] = f2bf(val);
            }
          }
        }
  }
}

DI void phase_qk(const Params& p, char* smem) {
  const int tid = opaque_tid();
  const int cg = tid & 31, rg = tid >> 5;
  const u16* qkpre = (const u16*)(p.ws + OFF_QKPRE);
  u16* qa = (u16*)(p.ws + OFF_QA);
  u16* ka = (u16*)(p.ws + OFF_KA);
  u16* kaT = (u16*)(p.ws + OFF_KAT);
  for (int u = blockIdx.x; u < 1024; u += gridDim.x) {
    const int ct = u & 3, tt = u >> 2;
    const int C0 = ct * 256 + cg * 8;
    const int Tb = tt * 64 + rg * 8;
    const int tb = Tb & 4095;
    float w0[8], w1[8], w2[8], cb[8];
    {
      const float4 a0 = *(const float4*)(p.conv_w + C0), a1 = *(const float4*)(p.conv_w + C0 + 4);
      const float4 b0 = *(const float4*)(p.conv_w + 2560 + C0), b1 = *(const float4*)(p.conv_w + 2560 + C0 + 4);
      const float4 c0 = *(const float4*)(p.conv_w + 5120 + C0), c1 = *(const float4*)(p.conv_w + 5120 + C0 + 4);
      const float4 d0 = *(const float4*)(p.conv_b + C0), d1 = *(const float4*)(p.conv_b + C0 + 4);
      w0[0] = a0.x; w0[1] = a0.y; w0[2] = a0.z; w0[3] = a0.w; w0[4] = a1.x; w0[5] = a1.y; w0[6] = a1.z; w0[7] = a1.w;
      w1[0] = b0.x; w1[1] = b0.y; w1[2] = b0.z; w1[3] = b0.w; w1[4] = b1.x; w1[5] = b1.y; w1[6] = b1.z; w1[7] = b1.w;
      w2[0] = c0.x; w2[1] = c0.y; w2[2] = c0.z; w2[3] = c0.w; w2[4] = c1.x; w2[5] = c1.y; w2[6] = c1.z; w2[7] = c1.w;
      cb[0] = d0.x; cb[1] = d0.y; cb[2] = d0.z; cb[3] = d0.w; cb[4] = d1.x; cb[5] = d1.y; cb[6] = d1.z; cb[7] = d1.w;
    }
    bf16x8 rows[10];
    const u16* src = qkpre + (size_t)Tb * 1024 + C0;
#pragma unroll
    for (int r = 0; r < 10; ++r) {
      const int t = tb + r - 1;
      bf16x8 z;
#pragma unroll
      for (int i = 0; i < 8; ++i) z[i] = 0;
      rows[r] = (t >= 0 && t <= 4095) ? *(const bf16x8*)(src + (ptrdiff_t)(r - 1) * 1024) : z;
    }
    const bool isk = C0 >= 512;
    bf16x8 tr[8];
#pragma unroll
    for (int r = 0; r < 8; ++r) {
      bf16x8 o;
#pragma unroll
      for (int i = 0; i < 8; ++i) {
        const float val = w0[i] * bf2f((u16)rows[r][i]) + w1[i] * bf2f((u16)rows[r + 1][i]) + w2[i] * bf2f((u16)rows[r + 2][i]) + cb[i];
        float sv = val * sigmoidf(val);
        if (isk) sv *= 0.08838834764831845f;
        o[i] = (short)f2bf(sv);
        tr[i][r] = o[i];
      }
      if (!isk) *(bf16x8*)(qa + (size_t)(Tb + r) * 512 + C0) = o;
      else *(bf16x8*)(ka + (size_t)(Tb + r) * 512 + (C0 - 512)) = o;
    }
    if (isk) {
      const int b = Tb >> 12;
#pragma unroll
      for (int i = 0; i < 8; ++i) *(bf16x8*)(kaT + ((size_t)(b * 512 + (C0 - 512) + i)) * 4096 + tb) = tr[i];
    }
  }
}

DI float lz(float v) { asm volatile("" : "+v"(v)); return v; }
DI float2 mk2(float a, float b) { return make_float2(a, b); }
DI float2 cmul(float2 a, float2 w) { return mk2(a.x * w.x - a.y * w.y, a.x * w.y + a.y * w.x); }
DI float2 cmulc(float2 a, float2 w) { return mk2(a.x * w.x + a.y * w.y, a.y * w.x - a.x * w.y); }
template <int NW, bool INV>
DI void r4_pass(float2* x, int tid, int q, const float2* __restrict__ t1, const float2* __restrict__ t2) {
  constexpr int NL = NW > 4 ? 4 : NW;
  constexpr int NB = NW > 4 ? 2 : 1;
  constexpr int CNT = 8 / NB;
#pragma unroll 1
  for (int bt = 0; bt < NB; ++bt) {
    float2 w1[NL], w2[NL];
#pragma unroll
    for (int n = 0; n < NL; ++n) { const int j = (tid + ((bt * CNT + n) << 8)) & (q - 1); w1[n] = t1[j]; w2[n] = t2[j]; }
    if (bt == 0) __syncthreads();
#pragma unroll(NL == 4 ? 4 : 2)
    for (int ii = 0; ii < CNT; ++ii) {
      const int k = tid + ((bt * CNT + ii) << 8);
      const int j = k & (q - 1);
      int base = ((k - j) << 2) + j;
      asm volatile("" : "+v"(base));
      const float2 ww1 = w1[ii % NL], ww2 = w2[ii % NL];
      const float2 x0 = x[base], x1 = x[base + q], x2 = x[base + 2 * q], x3 = x[base + 3 * q];
      if (!INV) {
        const float2 a0 = mk2(x0.x + x2.x, x0.y + x2.y);
        const float2 a1 = mk2(x1.x + x3.x, x1.y + x3.y);
        const float2 d02 = mk2(x0.x - x2.x, x0.y - x2.y);
        const float2 d13 = mk2(x1.y - x3.y, x3.x - x1.x);
        const float2 a2 = cmul(d02, ww1);
        const float2 a3 = cmul(d13, ww1);
        x[base] = mk2(a0.x + a1.x, a0.y + a1.y);
        x[base + q] = cmul(mk2(a0.x - a1.x, a0.y - a1.y), ww2);
        x[base + 2 * q] = mk2(a2.x + a3.x, a2.y + a3.y);
        x[base + 3 * q] = cmul(mk2(a2.x - a3.x, a2.y - a3.y), ww2);
      } else {
        const float2 b1 = cmulc(x1, ww2), b3 = cmulc(x3, ww2);
        const float2 a0 = mk2(x0.x + b1.x, x0.y + b1.y);
        const float2 a1 = mk2(x0.x - b1.x, x0.y - b1.y);
        const float2 a2 = mk2(x2.x + b3.x, x2.y + b3.y);
        const float2 a3 = mk2(x2.x - b3.x, x2.y - b3.y);
        const float2 c2 = cmulc(a2, ww1);
        const float2 c3t = cmulc(a3, ww1);
        const float2 c3 = mk2(-c3t.y, c3t.x);
        x[base] = mk2(a0.x + c2.x, a0.y + c2.y);
        x[base + 2 * q] = mk2(a0.x - c2.x, a0.y - c2.y);
        x[base + q] = mk2(a1.x + c3.x, a1.y + c3.y);
        x[base + 3 * q] = mk2(a1.x - c3.x, a1.y - c3.y);
      }
    }
  }
}
DI void r2_last(float2* x, int tid) {
#pragma unroll 4
  for (int i = 0; i < 16; ++i) {
    const int i0 = (tid + (i << 8)) << 1;
    const float2 a = x[i0], b = x[i0 + 1];
    x[i0] = mk2(a.x + b.x, a.y + b.y);
    x[i0 + 1] = mk2(a.x - b.x, a.y - b.y);
  }
}
DI void fft_fwd(float2* x, int tid, const float2* __restrict__ tw) {
  r4_pass<8, false>(x, tid, 2048, tw + 4095, tw + 2047);
  r4_pass<2, false>(x, tid, 512, tw + 1023, tw + 511);
  r4_pass<1, false>(x, tid, 128, tw + 255, tw + 127);
  r4_pass<1, false>(x, tid, 32, tw + 63, tw + 31);
  r4_pass<1, false>(x, tid, 8, tw + 15, tw + 7);
  r4_pass<1, false>(x, tid, 2, tw + 3, tw + 1);
  __syncthreads();
  r2_last(x, tid);
  __syncthreads();
}
DI void fft_inv(float2* x, int tid, const float2* __restrict__ tw) {
  __syncthreads();
  r2_last(x, tid);
  r4_pass<1, true>(x, tid, 2, tw + 3, tw + 1);
  r4_pass<1, true>(x, tid, 8, tw + 15, tw + 7);
  r4_pass<1, true>(x, tid, 32, tw + 63, tw + 31);
  r4_pass<1, true>(x, tid, 128, tw + 255, tw + 127);
  r4_pass<2, true>(x, tid, 512, tw + 1023, tw + 511);
  r4_pass<8, true>(x, tid, 2048, tw + 4095, tw + 2047);
  __syncthreads();
}

DI float hy_conv(const u16* __restrict__ pr, int t, float w0, float w1, float w2, float cb) {
  const float a = t > 0 ? bf2f(pr[t - 1]) : 0.f;
  const float b = bf2f(pr[t]);
  const float c = t < 4095 ? bf2f(pr[t + 1]) : 0.f;
  return w0 * a + w1 * b + w2 * c + cb;
}

DI void hy_conv4(const u16* __restrict__ pr, int t0, float w0, float w1, float w2, float cb, float (&o)[4]) {
  const ushort4 c = *(const ushort4*)(pr + t0);
  const float pm = t0 > 0 ? bf2f(pr[t0 - 1]) : 0.f;
  const float pn = t0 + 4 < 4096 ? bf2f(pr[t0 + 4]) : 0.f;
  const float x0 = bf2f(c.x), x1 = bf2f(c.y), x2 = bf2f(c.z), x3 = bf2f(c.w);
  o[0] = w0 * pm + w1 * x0 + w2 * x1 + cb;
  o[1] = w0 * x0 + w1 * x1 + w2 * x2 + cb;
  o[2] = w0 * x1 + w1 * x2 + w2 * x3 + cb;
  o[3] = w0 * x2 + w1 * x3 + w2 * pn + cb;
}

DI void hyena_unit(const Params& p, int ch, char* smem) {
  float2* buf = (float2*)smem;
  const int tid = opaque_tid();
  const u16* hyT = (const u16*)(p.ws + OFF_HYT);
  const float* filt = (const float*)(p.ws + OFF_FILT);
  float* z2T = (float*)(p.ws + OFF_Z2T);
  const float2* tw = (const float2*)(p.ws + OFF_TW);
  float2 Kr[32];
#pragma unroll 1
  for (int ord = 0; ord < 2; ++ord) {
    const float* kf = filt + (size_t)((0 * 2 + ord) * 512 + ch) * 4096;
    const float* kb = filt + (size_t)((1 * 2 + ord) * 512 + ch) * 4096;
    const float fb = p.filt_bias[ord * 512 + ch];
    __syncthreads();
#pragma unroll
    for (int g = 0; g < 4; ++g) {
      const int n0 = g * 1024 + tid * 4;
      float4 v = *(const float4*)(kf + n0);
      if (n0 == 0) v.x += fb;
      *(float4*)(buf + n0) = make_float4(v.x, 0.f, v.y, 0.f);
      *(float4*)(buf + n0 + 2) = make_float4(v.z, 0.f, v.w, 0.f);
      const float4 r = *(const float4*)(kb + 4092 - n0);
      const float e0 = (n0 == 0) ? 0.f : kb[4096 - n0];
      *(float4*)(buf + 4096 + n0) = make_float4(e0, 0.f, r.w, 0.f);
      *(float4*)(buf + 4096 + n0 + 2) = make_float4(r.z, 0.f, r.y, 0.f);
    }
    fft_fwd(buf, tid, tw);
#pragma unroll
    for (int j = 0; j < 32; ++j) {
      const float2 v = buf[tid + 256 * j];
      Kr[j] = make_float2(v.x * (1.f / 8192.f), v.y * (1.f / 8192.f));
    }
    const int gcol = 1024 + (1 + ord) * 512 + ch;
    const float gw0 = p.conv_w[gcol], gw1 = p.conv_w[2560 + gcol], gw2 = p.conv_w[5120 + gcol], gcb = p.conv_b[gcol];
    const int vcol = 1024 + ch;
    const float vw0 = p.conv_w[vcol], vw1 = p.conv_w[2560 + vcol], vw2 = p.conv_w[5120 + vcol], vcb = p.conv_b[vcol];
#pragma unroll 1
    for (int pr = 0; pr < 2; ++pr) {
      const int b0 = 2 * pr, b1 = 2 * pr + 1;
      __syncthreads();
      if (ord == 0) {
        const u16* u0 = hyT + ((size_t)((0 * 4 + b0) * 512 + ch)) * 4096;
        const u16* u1 = hyT + ((size_t)((0 * 4 + b1) * 512 + ch)) * 4096;
#pragma unroll
        for (int g = 0; g < 4; ++g) {
          const int t0 = g * 1024 + tid * 4;
          float a[4], b[4];
          hy_conv4(u0, t0, vw0, vw1, vw2, vcb, a);
          hy_conv4(u1, t0, vw0, vw1, vw2, vcb, b);
          *(float4*)(buf + t0) = make_float4(a[0], b[0], a[1], b[1]);
          *(float4*)(buf + t0 + 2) = make_float4(a[2], b[2], a[3], b[3]);
          *(float4*)(buf + 4096 + t0) = make_float4(0.f, 0.f, 0.f, 0.f);
          *(float4*)(buf + 4096 + t0 + 2) = make_float4(0.f, 0.f, 0.f, 0.f);
        }
      } else {
        const float* u0 = z2T + ((size_t)(b0 * 512 + ch)) * 4096;
        const float* u1 = z2T + ((size_t)(b1 * 512 + ch)) * 4096;
#pragma unroll
        for (int g = 0; g < 4; ++g) {
          const int t0 = g * 1024 + tid * 4;
          const float4 a = *(const float4*)(u0 + t0);
          const float4 b = *(const float4*)(u1 + t0);
          *(float4*)(buf + t0) = make_float4(a.x, b.x, a.y, b.y);
          *(float4*)(buf + t0 + 2) = make_float4(a.z, b.z, a.w, b.w);
          *(float4*)(buf + 4096 + t0) = make_float4(0.f, 0.f, 0.f, 0.f);
          *(float4*)(buf + 4096 + t0 + 2) = make_float4(0.f, 0.f, 0.f, 0.f);
        }
      }
      fft_fwd(buf, tid, tw);
#pragma unroll
      for (int j = 0; j < 32; ++j) {
        const float2 v = buf[tid + 256 * j];
        buf[tid + 256 * j] = make_float2(v.x * Kr[j].x - v.y * Kr[j].y, v.x * Kr[j].y + v.y * Kr[j].x);
      }
      fft_inv(buf, tid, tw);
      const u16* g0 = hyT + ((size_t)(((1 + ord) * 4 + b0) * 512 + ch)) * 4096;
      const u16* g1 = hyT + ((size_t)(((1 + ord) * 4 + b1) * 512 + ch)) * 4096;
      float* o0 = z2T + ((size_t)(b0 * 512 + ch)) * 4096;
      float* o1 = z2T + ((size_t)(b1 * 512 + ch)) * 4096;
#pragma unroll
      for (int g = 0; g < 4; ++g) {
        const int t0 = g * 1024 + tid * 4;
        const float4 y01 = *(const float4*)(buf + t0);
        const float4 y23 = *(const float4*)(buf + t0 + 2);
        float ga[4], gb[4];
        hy_conv4(g0, t0, gw0, gw1, gw2, gcb, ga);
        hy_conv4(g1, t0, gw0, gw1, gw2, gcb, gb);
        *(float4*)(o0 + t0) = make_float4(ga[0] * y01.x, ga[1] * y01.z, ga[2] * y23.x, ga[3] * y23.z);
        *(float4*)(o1 + t0) = make_float4(gb[0] * y01.y, gb[1] * y01.w, gb[2] * y23.y, gb[3] * y23.w);
      }
    }
  }
  __syncthreads();
}

DI void mlstm_local_unit(const Params& p, int u, char* smem) {
  float* s_gi = (float*)smem;
  float* s_lf = s_gi + 128;
  float* s_a = s_lf + 128;
  float* s_w = s_a + 128;
  const int tid = opaque_tid(), lane = tid & 63, wave = tid >> 6, lr = lane & 31, hh = lane >> 5;
  const int j = u & 31, dir = (u >> 5) & 1, bh = u >> 6, h = bh & 3, b = bh >> 2;
  const int T0 = b * 4096 + j * 128;
  const float* gates = (const float*)(p.ws + OFF_GATES);
  const u16* vT = (const u16*)(p.ws + OFF_VT);
  const u16* kaT = (const u16*)(p.ws + OFF_KAT);
  float* CL = p.out;
  float* nl = (float*)(p.ws + OFF_NL);
  float* mloc = (float*)(p.ws + OFF_MLOC);
  float* gsum = (float*)(p.ws + OFF_GSUM);
  __syncthreads();
  if (tid < 128) {
    const int T = T0 + tid;
    s_gi[tid] = gates[(size_t)T * 16 + dir * 8 + h] + p.b_gates[dir * 8 + h];
    s_lf[tid] = log_sigmoid(gates[(size_t)T * 16 + dir * 8 + 4 + h] + p.b_gates[dir * 8 + 4 + h]);
  }
  __syncthreads();
  float gtot = 0.f;
  if (tid < 128) {
    float pre = 0.f;
#pragma unroll 4
    for (int m = 0; m < 128; ++m) {
      const float v = s_lf[m];
      if (m < tid) pre += v;
      gtot += v;
    }
    s_a[tid] = (dir == 0) ? (gtot - pre - s_lf[tid] + s_gi[tid]) : (pre + s_gi[tid]);
  }
  __syncthreads();
  if (tid < 128) {
    float mx = -3.0e38f;
#pragma unroll 4
    for (int m = 0; m < 128; ++m) mx = fmaxf(mx, s_a[m]);
    s_w[tid] = expf(s_a[tid] - mx);
    if (tid == 0) { mloc[u] = mx; gsum[u] = gtot; }
  }
  __syncthreads();
  f32x16 acc[4];
#pragma unroll
  for (int d = 0; d < 4; ++d)
#pragma unroll
    for (int r = 0; r < 16; ++r) acc[d][r] = 0.f;
  const u16* vrow = vT + ((size_t)(bh * 128 + wave * 32 + lr)) * 4096 + j * 128 + hh * 8;
  const u16* kbase = kaT + ((size_t)(bh * 128 + lr)) * 4096 + j * 128 + hh * 8;
#pragma unroll 4
  for (int ks = 0; ks < 8; ++ks) {
    const bf16x8 av = *(const bf16x8*)(vrow + ks * 16);
    bf16x8 a;
#pragma unroll
    for (int i = 0; i < 8; ++i) a[i] = (short)f2bf(bf2f((u16)av[i]) * s_w[ks * 16 + hh * 8 + i]);
#pragma unroll
    for (int dt = 0; dt < 4; ++dt) {
      const bf16x8 bk = *(const bf16x8*)(kbase + (size_t)(dt * 32) * 4096 + ks * 16);
      acc[dt] = MFMA(a, bk, acc[dt]);
    }
  }
  float* dst = CL + (size_t)u * 16384;
#pragma unroll
  for (int dt = 0; dt < 4; ++dt)
#pragma unroll
    for (int r = 0; r < 16; ++r) dst[(wave * 32 + crow(r, hh)) * 128 + dt * 32 + lr] = acc[dt][r];
  if (tid < 128) {
    const u16* kr = kaT + ((size_t)(bh * 128 + tid)) * 4096 + j * 128;
    float s = 0.f;
#pragma unroll 2
    for (int l = 0; l < 128; l += 8) {
      const bf16x8 kv = *(const bf16x8*)(kr + l);
#pragma unroll
      for (int i = 0; i < 8; ++i) s += s_w[l + i] * bf2f((u16)kv[i]);
    }
    nl[(size_t)u * 128 + tid] = s;
  }
}

DI void scan_unit(const Params& p, int unit) {
  const int tid = opaque_tid();
  const int sc = unit >> 4, part = unit & 15, dir = sc & 1;
  float* CL = p.out;
  float* nl = (float*)(p.ws + OFF_NL);
  const float* mloc = (const float*)(p.ws + OFF_MLOC);
  const float* gsum = (const float*)(p.ws + OFF_GSUM);
  float* ms = (float*)(p.ws + OFF_MS);
  const int idx = part * 1024 + tid * 4;
  float4 C = make_float4(0.f, 0.f, 0.f, 0.f);
  float nst = 0.f, m = 0.f;
  const bool do_n = (part == 0) && (tid < 128);
  float4 pf[4];
#pragma unroll
  for (int q = 0; q < 4; ++q) {
    const int jj = dir ? 31 - q : q;
    pf[q] = *(const float4*)(CL + (size_t)(sc * 32 + jj) * 16384 + idx);
  }
#pragma unroll 1
  for (int c0 = 0; c0 < 32; c0 += 4) {
#pragma unroll
    for (int q = 0; q < 4; ++q) {
      const int c = c0 + q;
      const int jj = dir ? 31 - c : c;
      const int u = sc * 32 + jj;
      const float4 cl = pf[q];
      *(float4*)(CL + (size_t)u * 16384 + idx) = C;
      if (c + 4 < 32) {
        const int j2 = dir ? 31 - (c + 4) : (c + 4);
        pf[q] = *(const float4*)(CL + (size_t)(sc * 32 + j2) * 16384 + idx);
      }
      const float g = gsum[u], ml = mloc[u];
      const float mn = fmaxf(g + m, ml);
      const float dec = expf(g + m - mn), scl = expf(ml - mn);
      C.x = dec * C.x + scl * cl.x; C.y = dec * C.y + scl * cl.y; C.z = dec * C.z + scl * cl.z; C.w = dec * C.w + scl * cl.w;
      if (do_n) {
        const float nv = nl[(size_t)u * 128 + tid];
        nl[(size_t)u * 128 + tid] = nst;
        nst = dec * nst + scl * nv;
      }
      if (part == 0 && tid == 0) ms[u] = m;
      m = mn;
    }
  }
}

template <int DIR>
DI void mlstm_dir(const Params& p, int bh, int j, char* smem, f32x16 (&hs)[4]) {
  float* s_gi = (float*)smem;
  float* s_lf = s_gi + 128;
  float* s_bc = s_lf + 128;
  float* s_r = s_bc + 128;
  float* s_al = s_r + 128;
  float* s_fl = s_al + 128;
  float* s_is = s_fl + 128;
  const int tid = opaque_tid(), lane = tid & 63, wave = tid >> 6, lr = lane & 31, hh = lane >> 5;
  u16* Pl = (u16*)(smem + 4096) + wave * (32 * 136);
  const int h = bh & 3, b = bh >> 2;
  const int T0 = b * 4096 + j * 128;
  const float* gates = (const float*)(p.ws + OFF_GATES);
  const u16* qa = (const u16*)(p.ws + OFF_QA);
  const u16* ka = (const u16*)(p.ws + OFF_KA);
  const u16* vT = (const u16*)(p.ws + OFF_VT);
  const float* CS = p.out;
  const float* ns = (const float*)(p.ws + OFF_NL);
  const float* ms = (const float*)(p.ws + OFF_MS);
  u16* A2 = (u16*)(p.ws + OFF_A2);
  bf16x8 ones;
#pragma unroll
  for (int i = 0; i < 8; ++i) ones[i] = (short)0x3F80;
  const u16* qrow = qa + (size_t)(T0 + wave * 32 + lr) * 512 + h * 128 + hh * 8;
  const int u = (bh * 2 + DIR) * 32 + j;
  const float msu = ms[u];
  __syncthreads();
  if (tid < 128) {
    const int T = T0 + tid;
    s_gi[tid] = gates[(size_t)T * 16 + DIR * 8 + h] + p.b_gates[DIR * 8 + h];
    s_lf[tid] = log_sigmoid(gates[(size_t)T * 16 + DIR * 8 + 4 + h] + p.b_gates[DIR * 8 + 4 + h]);
  }
  __syncthreads();
  if (tid < 128) {
    float a = 0.f;
#pragma unroll 4
    for (int m = 0; m < 128; ++m) {
      const bool in = (DIR == 0) ? (m <= tid) : (m >= tid);
      a += in ? s_lf[m] : 0.f;
    }
    s_bc[tid] = a;
    s_r[tid] = s_gi[tid] - a;
  }
  __syncthreads();
  if (tid < 128) {
    float cm = -3.0e38f;
#pragma unroll 4
    for (int m = 0; m < 128; ++m) {
      const bool in = (DIR == 0) ? (m <= tid) : (m >= tid);
      cm = in ? fmaxf(cm, s_r[m]) : cm;
    }
    const float bc = s_bc[tid];
    const float mt = bc + fmaxf(msu, cm);
    s_al[tid] = bc - mt;
    s_fl[tid] = expf(-mt);
    s_is[tid] = expf(bc + msu - mt);
  }
  __syncthreads();
  {
    f32x16 S[4];
#pragma unroll
    for (int st = 0; st < 4; ++st)
#pragma unroll
      for (int r = 0; r < 16; ++r) S[st][r] = 0.f;
    const u16* kbase = ka + (size_t)(T0 + lr) * 512 + h * 128 + hh * 8;
#pragma unroll 4
    for (int ks = 0; ks < 8; ++ks) {
      const bf16x8 a = *(const bf16x8*)(qrow + ks * 16);
#pragma unroll
      for (int st = 0; st < 4; ++st) {
        const bf16x8 bk = *(const bf16x8*)(kbase + (size_t)(st * 32) * 512 + ks * 16);
        S[st] = MFMA(a, bk, S[st]);
      }
    }
#pragma unroll
    for (int st = 0; st < 4; ++st) {
      const int sl = st * 32 + lr;
      const float rs = s_r[sl];
#pragma unroll
      for (int r = 0; r < 16; ++r) {
        const int tl = wave * 32 + crow(r, hh);
        const bool valid = (DIR == 0) ? (sl <= tl) : (sl >= tl);
        const float pv = valid ? S[st][r] * __expf(s_al[tl] + rs) : 0.f;
        Pl[crow(r, hh) * 136 + sl] = f2bf(pv);
      }
    }
  }
  __syncthreads();
#pragma unroll
  for (int eh = 0; eh < 2; ++eh) {
    f32x16 N[3];
#pragma unroll
    for (int e = 0; e < 3; ++e)
#pragma unroll
      for (int r = 0; r < 16; ++r) N[e][r] = 0.f;
    {
      const u16* vbase = vT + ((size_t)(bh * 128 + eh * 64 + lr)) * 4096 + j * 128 + hh * 8;
#pragma unroll 4
      for (int ks = 0; ks < 8; ++ks) {
        const bf16x8 a = *(const bf16x8*)(Pl + lr * 136 + ks * 16 + hh * 8);
#pragma unroll
        for (int e2 = 0; e2 < 2; ++e2) {
          const bf16x8 bv = *(const bf16x8*)(vbase + (size_t)(e2 * 32) * 4096 + ks * 16);
          N[e2] = MFMA(a, bv, N[e2]);
        }
        N[2] = MFMA(a, ones, N[2]);
      }
    }
    {
      const float isc = s_is[wave * 32 + lr];
      const float* cbase = CS + (size_t)u * 16384 + (size_t)(eh * 64 + lr) * 128 + hh * 8;
      const float* nbase = ns + (size_t)u * 128 + hh * 8;
#pragma unroll 4
      for (int ks = 0; ks < 8; ++ks) {
        const bf16x8 aq = *(const bf16x8*)(qrow + ks * 16);
        const bf16x8 a = scale8(aq, isc);
#pragma unroll
        for (int e2 = 0; e2 < 2; ++e2) {
          const float4 c0 = *(const float4*)(cbase + (size_t)(e2 * 32) * 128 + ks * 16);
          const float4 c1 = *(const float4*)(cbase + (size_t)(e2 * 32) * 128 + ks * 16 + 4);
          const float cv[8] = {c0.x, c0.y, c0.z, c0.w, c1.x, c1.y, c1.z, c1.w};
          N[e2] = MFMA(a, pack8(cv), N[e2]);
        }
        const float4 n0 = *(const float4*)(nbase + ks * 16);
        const float4 n1 = *(const float4*)(nbase + ks * 16 + 4);
        const float nv[8] = {n0.x, n0.y, n0.z, n0.w, n1.x, n1.y, n1.z, n1.w};
        N[2] = MFMA(a, pack8(nv), N[2]);
      }
    }
#pragma unroll
    for (int r = 0; r < 16; ++r) {
      const int tl = wave * 32 + crow(r, hh);
      const float den = fmaxf(fabsf(N[2][r]), s_fl[tl]);
      const float inv = 1.f / den;
#pragma unroll
      for (int e2 = 0; e2 < 2; ++e2) {
        const float hv = N[e2][r] * inv;
        u16* tp = A2 + (size_t)(T0 + tl) * 1024 + h * 128 + (eh * 2 + e2) * 32 + lr;
        if (DIR == 0) *tp = f2bf(hv);
        else hs[eh * 2 + e2][r] = hv + bf2f(*tp);
      }
    }
  }
}

DI void mlstm_out_unit(const Params& p, int unit, char* smem) {
  const int tid = opaque_tid(), lane = tid & 63, wave = tid >> 6, lr = lane & 31, hh = lane >> 5;
  const int j = unit & 31, bh = unit >> 5, h = bh & 3, b = bh >> 2;
  const int T0 = b * 4096 + j * 128;
  const u16* og = (const u16*)(p.ws + OFF_OG);
  u16* A2 = (u16*)(p.ws + OFF_A2);
  f32x16 hs[4];
  mlstm_dir<0>(p, bh, j, smem, hs);
  mlstm_dir<1>(p, bh, j, smem, hs);
#pragma unroll
  for (int r = 0; r < 16; ++r) {
    const int T = T0 + wave * 32 + crow(r, hh);
    float ss = 0.f;
#pragma unroll
    for (int et = 0; et < 4; ++et) {
      const float o = bf2f(og[(size_t)T * 512 + h * 128 + et * 32 + lr]);
      hs[et][r] *= o;
      ss += hs[et][r] * hs[et][r];
    }
#pragma unroll
    for (int o = 1; o < 32; o <<= 1) ss += __shfl_xor(ss, o, 64);
    const float rs = rsqrtf(ss * (1.f / 128.f) + EPS);
#pragma unroll
    for (int et = 0; et < 4; ++et) {
      const int e = h * 128 + et * 32 + lr;
      A2[(size_t)T * 1024 + e] = f2bf(hs[et][r] * rs * p.mlstm_norm_w[e]);
    }
  }
}

DI void hyena_norm_unit(const Params& p, int unit, char* smem) {
  float* tile = (float*)smem;
  const int tid = opaque_tid();
  const int tt = unit & 63, g = (unit >> 6) & 7, b = unit >> 9;
  const float* z2T = (const float*)(p.ws + OFF_Z2T);
  u16* A2 = (u16*)(p.ws + OFF_A2);
  __syncthreads();
#pragma unroll 4
  for (int i = 0; i < 16; ++i) {
    const int cl = (tid >> 6) + 4 * i, tl = tid & 63;
    tile[cl * 65 + tl] = z2T[((size_t)(b * 512 + g * 64 + cl)) * 4096 + tt * 64 + tl];
  }
  __syncthreads();
  const int tl = tid >> 2, qd = tid & 3;
  float v[16];
  float ss = 0.f;
#pragma unroll
  for (int i = 0; i < 16; ++i) {
    v[i] = tile[(qd * 16 + i) * 65 + tl];
    ss += v[i] * v[i];
  }
  ss += __shfl_xor(ss, 1, 64);
  ss += __shfl_xor(ss, 2, 64);
  const float rs = rsqrtf(ss * (1.f / 64.f) + EPS);
  const size_t T = (size_t)b * 4096 + tt * 64 + tl;
  u16* dst = A2 + T * 1024 + 512 + g * 64 + qd * 16;
  const float* w = p.hyena_norm_w + g * 64 + qd * 16;
  float o[16];
#pragma unroll
  for (int i = 0; i < 16; ++i) o[i] = v[i] * rs * w[i];
  *(bf16x8*)(dst) = pack8(o);
  *(bf16x8*)(dst + 8) = pack8(o + 8);
}

template <int EPI>
DI void gemm_phase(const u16* A, const u16* Bt, int K, int ntn, void* outp, char* smem) {
  const int tid = threadIdx.x, lane = tid & 63, wave = tid >> 6, wr = wave >> 1, wc = wave & 1, lr = lane & 31, hh = lane >> 5;
  const int ntiles = tile_count(ntn);
  for (int id = blockIdx.x; id < ntiles; id += gridDim.x) {
    int mt, nt;
    tile_map(id, ntn, mt, nt);
    if (nt >= ntn) continue;
    const int m0 = mt * 256, n0 = nt * 128;
    f32x16 acc[4][2];
    gemm_core<false>(A, Bt, K, m0, n0, smem, acc);
#pragma unroll
    for (int i = 0; i < 4; ++i)
#pragma unroll
      for (int j = 0; j < 2; ++j)
#pragma unroll
        for (int r = 0; r < 16; ++r) {
          const int row = m0 + wr * 128 + i * 32 + crow(r, hh);
          const int col = n0 + wc * 64 + j * 32 + lr;
          const float val = acc[i][j][r];
          if (EPI == 0) ((float*)outp)[(size_t)row * 1024 + col] = val;
          else {
            const float rl = fmaxf(val, 0.f);
            ((u16*)outp)[(size_t)row * 4096 + col] = f2bf(rl * rl);
          }
        }
  }
}

DI void phase_post_mix(const Params& p) {
  const int tid = threadIdx.x, lane = tid & 63, wave = tid >> 6;
  const float* mix = p.out;
  float* x1 = (float*)(p.ws + OFF_X1);
  u16* hm = (u16*)(p.ws + OFF_HM);
  for (int u = blockIdx.x; u < 1024; u += gridDim.x) {
#pragma unroll 2
    for (int rr = 0; rr < 4; ++rr) {
      const size_t row = (size_t)u * 16 + wave * 4 + rr;
      float4 mv[4], xv[4];
      float ss = 0.f;
#pragma unroll
      for (int i = 0; i < 4; ++i) {
        mv[i] = ((const float4*)(mix + row * DM))[lane + 64 * i];
        xv[i] = ((const float4*)(p.x + row * DM))[lane + 64 * i];
        ss += mv[i].x * mv[i].x + mv[i].y * mv[i].y + mv[i].z * mv[i].z + mv[i].w * mv[i].w;
      }
      ss = wave_sum(ss);
      const float rs = rsqrtf(ss * (1.f / DM) + EPS);
      float s2 = 0.f;
#pragma unroll
      for (int i = 0; i < 4; ++i) {
        const float4 w = ((const float4*)p.norm_mix_post)[lane + 64 * i];
        xv[i].x += mv[i].x * rs * w.x; xv[i].y += mv[i].y * rs * w.y; xv[i].z += mv[i].z * rs * w.z; xv[i].w += mv[i].w * rs * w.w;
        s2 += xv[i].x * xv[i].x + xv[i].y * xv[i].y + xv[i].z * xv[i].z + xv[i].w * xv[i].w;
        ((float4*)(x1 + row * DM))[lane + 64 * i] = xv[i];
      }
      s2 = wave_sum(s2);
      const float r2 = rsqrtf(s2 * (1.f / DM) + EPS);
#pragma unroll
      for (int i = 0; i < 4; ++i) {
        const float4 w = ((const float4*)p.norm_mlp_pre)[lane + 64 * i];
        ushort4 o;
        o.x = f2bf(xv[i].x * r2 * w.x); o.y = f2bf(xv[i].y * r2 * w.y); o.z = f2bf(xv[i].z * r2 * w.z); o.w = f2bf(xv[i].w * r2 * w.w);
        *(ushort4*)(hm + row * DM + (lane + 64 * i) * 4) = o;
      }
    }
  }
}

DI void phase_final(const Params& p) {
  const int tid = threadIdx.x, lane = tid & 63, wave = tid >> 6;
  const float* x1 = (const float*)(p.ws + OFF_X1);
  for (int u = blockIdx.x; u < 1024; u += gridDim.x) {
#pragma unroll 2
    for (int rr = 0; rr < 4; ++rr) {
      const size_t row = (size_t)u * 16 + wave * 4 + rr;
      float4 fv[4];
      float ss = 0.f;
#pragma unroll
      for (int i = 0; i < 4; ++i) {
        fv[i] = ((const float4*)(p.out + row * DM))[lane + 64 * i];
        ss += fv[i].x * fv[i].x + fv[i].y * fv[i].y + fv[i].z * fv[i].z + fv[i].w * fv[i].w;
      }
      ss = wave_sum(ss);
      const float rs = rsqrtf(ss * (1.f / DM) + EPS);
#pragma unroll
      for (int i = 0; i < 4; ++i) {
        const float4 w = ((const float4*)p.norm_mlp_post)[lane + 64 * i];
        const float4 xv = ((const float4*)(x1 + row * DM))[lane + 64 * i];
        float4 o;
        o.x = xv.x + fv[i].x * rs * w.x; o.y = xv.y + fv[i].y * rs * w.y; o.z = xv.z + fv[i].z * rs * w.z; o.w = xv.w + fv[i].w * rs * w.w;
        ((float4*)(p.out + row * DM))[lane + 64 * i] = o;
      }
    }
  }
}

DI void run_phase(const Params& p, int ph, char* smem) {
  switch (ph) {
    case 0: phase0(p, smem); break;
    case 1: phase1(p, smem); break;
    case 2: phase_qk(p, smem); break;
    case 3:
#ifdef DBL_HYONLY
      for (int u = blockIdx.x; u < 512; u += gridDim.x) hyena_unit(p, u, smem);
#endif
#ifdef DBL_MLONLY
      for (int u = blockIdx.x; u < 1024; u += gridDim.x) mlstm_local_unit(p, u, smem);
#endif
      for (int u = blockIdx.x; u < 512 + 1024; u += gridDim.x) {
        if (u < 512) hyena_unit(p, u, smem);
        else mlstm_local_unit(p, u - 512, smem);
      }
      break;
    case 4:
      for (int u = blockIdx.x; u < 512; u += gridDim.x) scan_unit(p, u);
      break;
    case 5:
      for (int u = blockIdx.x; u < 512 + 2048; u += gridDim.x) {
#ifndef DBG_SKIP_MLSTM
        if (u < 512) mlstm_out_unit(p, u, smem);
#else
        if (u < 512) { u16* A2 = (u16*)(p.ws + OFF_A2); const int T0 = (u >> 5 >> 2) * 4096 + (u & 31) * 128, hq = (u >> 5) & 3;
          for (int i = threadIdx.x; i < 128 * 128; i += 256) A2[(size_t)(T0 + (i >> 7)) * 1024 + hq * 128 + (i & 127)] = 0; }
#endif
#ifndef DBG_SKIP_HYENA
        else hyena_norm_unit(p, u - 512, smem);
#else
        else { const int un = u - 512; const int tt = un & 63, g = (un >> 6) & 7, b = un >> 9; u16* A2 = (u16*)(p.ws + OFF_A2);
          for (int i = threadIdx.x; i < 64 * 64; i += 256) A2[((size_t)b * 4096 + tt * 64 + (i >> 6)) * 1024 + 512 + g * 64 + (i & 63)] = 0x3F80; }
#endif
      }
      break;
    case 6: gemm_phase<0>((const u16*)(p.ws + OFF_A2), (const u16*)(p.ws + OFF_WOUTT), 1024, 8, p.out, smem); break;
    case 7: phase_post_mix(p); break;
    case 8: gemm_phase<1>((const u16*)(p.ws + OFF_HM), (const u16*)(p.ws + OFF_W1T), 1024, 32, p.ws + OFF_H, smem); break;
    case 9: gemm_phase<0>((const u16*)(p.ws + OFF_H), (const u16*)(p.ws + OFF_W2T), 4096, 8, p.out, smem); break;
    case 10: phase_final(p); break;
  }
}
constexpr int NPHASE = 11;

#define XB_XCNT(j)  (256  + 64 * (j))
#define XB_XSUB(j)  (1280 + 64 * (j))
#define XB_XGEN(j)  (2304 + 64 * (j))
#define XB_TOP      3328
#define XB_TOPGEN   3392
#define XCD_BAR_WORDS 3456
DI unsigned xb_ld(unsigned* p) { return __hip_atomic_load(p, __ATOMIC_RELAXED, __HIP_MEMORY_SCOPE_AGENT); }
DI unsigned xb_add(unsigned* p, unsigned v) { return __hip_atomic_fetch_add(p, v, __ATOMIC_RELAXED, __HIP_MEMORY_SCOPE_AGENT); }
DI unsigned xb_xcc_id() { return (unsigned)__builtin_amdgcn_s_getreg((3 << 11) | 20) & 0xFu; }
struct XcdBar { unsigned* bar; unsigned x, nloc, nx; };
DI void xcd_barrier(XcdBar& b) {
  asm volatile("s_waitcnt vmcnt(0)" ::: "memory");
  __syncthreads();
  if (threadIdx.x == 0) {
    unsigned* bar = b.bar;
    __builtin_amdgcn_s_waitcnt(0);
    if (b.nloc == 0u) {
      const unsigned G = gridDim.x;
      unsigned sum, cnt, mine;
      for (;;) {
        sum = 0u; cnt = 0u; mine = 0u;
#pragma unroll
        for (unsigned j = 0; j < 16; ++j) { const unsigned c = xb_ld(&bar[XB_XCNT(j)]); sum += c; cnt += (c > 0u) ? 1u : 0u; mine = (j == b.x) ? c : mine; }
        if (sum == G) break;
        __builtin_amdgcn_s_sleep(1);
      }
      b.nloc = mine > 0u ? mine : 1u; b.nx = cnt > 0u ? cnt : 1u;
    }
    const unsigned nloc = b.nloc, nx = b.nx;
    const unsigned old = xb_add(&bar[XB_XSUB(b.x)], 1u);
    const unsigned gen = old / nloc;
    if (old + 1u == (gen + 1u) * nloc) {
      __builtin_amdgcn_fence(__ATOMIC_RELEASE, "agent");
      asm volatile("s_waitcnt vmcnt(0)" ::: "memory");
      const unsigned og = xb_add(&bar[XB_TOP], 1u);
      const unsigned tg = og / nx;
      if (og + 1u == (tg + 1u) * nx) xb_add(&bar[XB_TOPGEN], 1u);
      else while (xb_ld(&bar[XB_TOPGEN]) == tg) __builtin_amdgcn_s_sleep(1);
      __builtin_amdgcn_fence(__ATOMIC_ACQUIRE, "agent");
      xb_add(&bar[XB_XGEN(b.x)], 1u);
      asm volatile("s_waitcnt vmcnt(0)" ::: "memory");
    } else {
      while (xb_ld(&bar[XB_XGEN(b.x)]) == gen) __builtin_amdgcn_s_sleep(1);
      __builtin_amdgcn_fence(__ATOMIC_ACQUIRE, "agent");
      asm volatile("s_waitcnt vmcnt(0)" ::: "memory");
    }
  }
  __syncthreads();
}

#if MULTI_LAUNCH
template <int PH>
__global__ void __launch_bounds__(256, 2) phase_kernel(Params p) {
  __shared__ __attribute__((aligned(16))) char smem[65536];
  run_phase(p, PH, smem);
}
template <int PH>
static void launch_phase(const Params& p, hipStream_t stream) {
  hipLaunchKernelGGL(phase_kernel<PH>, dim3(512), dim3(256), 0, stream, p);
}
#else
__global__ void __launch_bounds__(256, 2) mega_kernel(Params p) {
  __shared__ __attribute__((aligned(16))) char smem[65536];
  cg::grid_group grid = cg::this_grid();
  XcdBar xb;
  xb.bar = (unsigned*)(p.ws + OFF_BAR); xb.x = xb_xcc_id(); xb.nloc = 0u; xb.nx = 0u;
  if (p.ws == nullptr) grid.sync();
  if (threadIdx.x == 0) (void)xb_add(&xb.bar[XB_XCNT(xb.x)], 1u);
#define GSYNC xcd_barrier(xb)
#ifdef DBL_P0
  run_phase(p, 0, smem);
#endif
  run_phase(p, 0, smem); GSYNC;
  run_phase(p, 1, smem); GSYNC;
#ifdef DBL_GEMM
  run_phase(p, 1, smem); grid.sync();
#endif
  run_phase(p, 2, smem); GSYNC;
#ifdef DBL_P2
  run_phase(p, 2, smem); GSYNC;
#endif
  run_phase(p, 3, smem); GSYNC;
#ifdef DBL_HY
  run_phase(p, 3, smem); GSYNC;
#endif
  run_phase(p, 4, smem); GSYNC;
  run_phase(p, 5, smem); GSYNC;
#ifdef DBL_P5
  run_phase(p, 5, smem); GSYNC;
#endif
  run_phase(p, 6, smem); GSYNC;
#ifdef DBL_GEMM
  run_phase(p, 6, smem); GSYNC;
#endif
  run_phase(p, 7, smem); GSYNC;
#ifdef DBL_P7
  run_phase(p, 7, smem); GSYNC;
#endif
  run_phase(p, 8, smem); GSYNC;
#ifdef DBL_GEMM
  run_phase(p, 8, smem); GSYNC;
#endif
  run_phase(p, 9, smem); GSYNC;
#ifdef DBL_GEMM
  run_phase(p, 9, smem); GSYNC;
#endif
#ifdef XSYNC
  for (int q = 0; q < 10; ++q) GSYNC;
#endif
  run_phase(p, 10, smem);
}
#endif

extern "C" void kernel_launch(void* const* d_in, const int* in_sizes, int n_in, void* d_out, int out_size, void* d_ws,
                              size_t ws_size, hipStream_t stream) {
  Params p{};
  const float** pp = (const float**)&p;
  for (int i = 0; i < 23; ++i) pp[i] = (const float*)d_in[i];
  p.out = (float*)d_out;
  p.ws = (char*)d_ws;
#if MULTI_LAUNCH
  launch_phase<0>(p, stream);
#ifdef DBL_P0
  launch_phase<0>(p, stream);
#endif
 launch_phase<1>(p, stream); launch_phase<2>(p, stream); launch_phase<3>(p, stream);
#ifdef DBL_HY
  launch_phase<3>(p, stream);
#endif

  launch_phase<4>(p, stream); launch_phase<5>(p, stream);
#ifdef DBL_P5
  launch_phase<5>(p, stream);
#endif
 launch_phase<6>(p, stream); launch_phase<7>(p, stream);
  launch_phase<8>(p, stream); launch_phase<9>(p, stream); launch_phase<10>(p, stream);
#else
  static int grid_blocks = 0;
  if (!grid_blocks) {
    int dev = 0, cus = 0, per_cu = 0;
    hipGetDevice(&dev);
    hipDeviceGetAttribute(&cus, hipDeviceAttributeMultiprocessorCount, dev);
    hipOccupancyMaxActiveBlocksPerMultiprocessor(&per_cu, mega_kernel, 256, 0);
    if (per_cu > 2) per_cu = 2;
    if (per_cu < 1) per_cu = 1;
#ifdef FORCE2
    per_cu = 2;
#endif
    grid_blocks = cus * per_cu;
  }
  hipMemsetAsync((char*)d_ws + OFF_BAR, 0, XCD_BAR_WORDS * 4, stream);
  void* args[] = {&p};
  hipError_t e = hipLaunchCooperativeKernel((void*)mega_kernel, dim3(grid_blocks), dim3(256), args, 0, stream);
  if (e != hipSuccess) fprintf(stderr, "cooperative launch failed: %s (grid %d)\n", hipGetErrorString(e), grid_blocks);
#endif
}
#if defined(__HIP_DEVICE_COMPILE__)
#pragma clang attribute pop
#endif
```

```cpp
#if defined(__HIP_DEVICE_COMPILE__)
#pragma clang attribute push(__attribute__((target("no-packed-fp32-ops"))), apply_to = function)
#endif
#include <hip/hip_runtime.h>
#include <hip/hip_cooperative_groups.h>
#include <cstdio>
namespace cg = cooperative_groups;

#ifndef MULTI_LAUNCH
#define MULTI_LAUNCH 0
#endif

typedef unsigned short u16;
using bf16x8 = __attribute__((ext_vector_type(8))) short;
using f32x16 = __attribute__((ext_vector_type(16))) float;
#define DI __device__ __forceinline__
#define MFMA(a, b, c) __builtin_amdgcn_mfma_f32_32x32x16_bf16((a), (b), (c), 0, 0, 0)

constexpr int SEQ = 4096, DM = 1024, NTOK = 16384, NIN = 3600, NINP = 3712, DFF = 4096;
constexpr float EPS = 1e-6f;
constexpr size_t MiB = 1u << 20;
constexpr size_t OFF_WINT = 0, OFF_WOUTT = 8 * MiB, OFF_W1T = 10 * MiB, OFF_W2T = 18 * MiB;
constexpr size_t OFF_XN = 26 * MiB, OFF_QA = 26 * MiB, OFF_KA = 42 * MiB;
constexpr size_t OFF_FILT = 58 * MiB, OFF_QKPRE = 90 * MiB, OFF_A2 = 90 * MiB;
constexpr size_t OFF_HYT = 122 * MiB, OFF_VT = 170 * MiB, OFF_OG = 186 * MiB, OFF_GATES = 202 * MiB;
constexpr size_t OFF_NL = 203 * MiB, OFF_MLOC = 203 * MiB + 512 * 1024, OFF_GSUM = OFF_MLOC + 4096, OFF_MS = OFF_GSUM + 4096;
constexpr size_t OFF_KAT = 205 * MiB, OFF_Z2T = 221 * MiB;
constexpr size_t OFF_TW = 204 * MiB, OFF_BAR = 254 * MiB;
constexpr size_t OFF_X1 = 26 * MiB, OFF_HM = 90 * MiB, OFF_H = 122 * MiB;

struct Params {
  const float *x, *norm_mix_pre, *norm_mix_post, *norm_mlp_pre, *norm_mlp_post, *w_in, *b_gates, *conv_w, *conv_b,
      *mlstm_norm_w, *hyena_norm_w, *filt_w1, *filt_b1, *filt_w2, *filt_b2, *filt_w3, *filt_b3, *filt_w4, *filt_freq,
      *filt_bias, *w_out, *w_mlp_in, *w_mlp_out;
  float* out;
  char* ws;
};

DI u16 f2bf(float x) { unsigned u = __float_as_uint(x); u += 0x7fffu + ((u >> 16) & 1u); return (u16)(u >> 16); }
DI float bf2f(u16 v) { return __uint_as_float(((unsigned)v) << 16); }
DI int opaque_tid() { int t = threadIdx.x; asm volatile("" : "+v"(t)); return t; }
DI int crow(int r, int hh) { return (r & 3) + 8 * (r >> 2) + 4 * hh; }
DI float log_sigmoid(float x) { return fminf(x, 0.f) - log1pf(expf(-fabsf(x))); }
DI float sigmoidf(float x) { return 1.f / (1.f + expf(-x)); }
DI float red2pi(float x) {
  const float k = rintf(x * 0.15915494309189535f);
  float r = fmaf(-k, 6.28125f, x);
  return fmaf(-k, 1.9353071795864769e-3f, r);
}
DI float fsin(float x) { return sinf(x); }
DI float fcos(float x) { return cosf(x); }
DI bf16x8 pack8(const float* v) {
  bf16x8 r;
#pragma unroll
  for (int i = 0; i < 8; ++i) r[i] = (short)f2bf(v[i]);
  return r;
}
DI bf16x8 scale8(bf16x8 a, float s) {
  bf16x8 r;
#pragma unroll
  for (int i = 0; i < 8; ++i) r[i] = (short)f2bf(bf2f((u16)a[i]) * s);
  return r;
}

template <bool SWAP>
DI void gemm_core(const u16* __restrict__ A, const u16* __restrict__ Bt, int K, int m0, int n0, char* smem, f32x16 (&acc)[4][2]) {
  const int tid = opaque_tid(), lane = tid & 63, wave = tid >> 6, wr = wave >> 1, wc = wave & 1;
  const int lr = lane & 31, hh = lane >> 5;
#pragma unroll
  for (int i = 0; i < 4; ++i)
#pragma unroll
    for (int j = 0; j < 2; ++j)
#pragma unroll
      for (int r = 0; r < 16; ++r) acc[i][j][r] = 0.f;
  const int c = tid & 7, r0 = tid >> 3;
  const u16* Ag = A + (size_t)(m0 + r0) * K + c * 8;
  const u16* Bg = Bt + (size_t)(n0 + r0) * K + c * 8;
  const int soff = r0 * 128 + ((c ^ ((r0 >> 1) & 7)) << 4);
  char* As = smem;
  char* Bs = smem + 32768;
  uint4 ra0, ra1, ra2, ra3, ra4, ra5, ra6, ra7, rb0, rb1, rb2, rb3;
#define GLOAD_ALL(k0)                                                                                             \
  ra0 = *(const uint4*)(Ag + (size_t)(0) * K + (k0));   ra1 = *(const uint4*)(Ag + (size_t)(32) * K + (k0));      \
  ra2 = *(const uint4*)(Ag + (size_t)(64) * K + (k0));  ra3 = *(const uint4*)(Ag + (size_t)(96) * K + (k0));      \
  ra4 = *(const uint4*)(Ag + (size_t)(128) * K + (k0)); ra5 = *(const uint4*)(Ag + (size_t)(160) * K + (k0));     \
  ra6 = *(const uint4*)(Ag + (size_t)(192) * K + (k0)); ra7 = *(const uint4*)(Ag + (size_t)(224) * K + (k0));     \
  rb0 = *(const uint4*)(Bg + (size_t)(0) * K + (k0));   rb1 = *(const uint4*)(Bg + (size_t)(32) * K + (k0));      \
  rb2 = *(const uint4*)(Bg + (size_t)(64) * K + (k0));  rb3 = *(const uint4*)(Bg + (size_t)(96) * K + (k0));
  GLOAD_ALL(0)
  const int nk = K >> 6;
#pragma unroll 1
  for (int kt = 0; kt < nk; ++kt) {
    __syncthreads();
    *(uint4*)(As + soff + 0 * 4096) = ra0; *(uint4*)(As + soff + 1 * 4096) = ra1; *(uint4*)(As + soff + 2 * 4096) = ra2; *(uint4*)(As + soff + 3 * 4096) = ra3;
    *(uint4*)(As + soff + 4 * 4096) = ra4; *(uint4*)(As + soff + 5 * 4096) = ra5; *(uint4*)(As + soff + 6 * 4096) = ra6; *(uint4*)(As + soff + 7 * 4096) = ra7;
    *(uint4*)(Bs + soff + 0 * 4096) = rb0; *(uint4*)(Bs + soff + 1 * 4096) = rb1; *(uint4*)(Bs + soff + 2 * 4096) = rb2; *(uint4*)(Bs + soff + 3 * 4096) = rb3;
    __syncthreads();
    if (kt + 1 < nk) {
      const int k0 = (kt + 1) << 6;
      GLOAD_ALL(k0)
    }
#pragma unroll
    for (int kk = 0; kk < 4; ++kk) {
      bf16x8 a[4], b[2];
      const int cc = kk * 2 + hh;
#pragma unroll
      for (int i = 0; i < 4; ++i) {
        const int r = wr * 128 + i * 32 + lr;
        a[i] = *(const bf16x8*)(As + r * 128 + ((cc ^ ((r >> 1) & 7)) << 4));
      }
#pragma unroll
      for (int j = 0; j < 2; ++j) {
        const int r = wc * 64 + j * 32 + lr;
        b[j] = *(const bf16x8*)(Bs + r * 128 + ((cc ^ ((r >> 1) & 7)) << 4));
      }
#pragma unroll
      for (int i = 0; i < 4; ++i)
#pragma unroll
        for (int j = 0; j < 2; ++j) acc[i][j] = SWAP ? MFMA(b[j], a[i], acc[i][j]) : MFMA(a[i], b[j], acc[i][j]);
    }
  }
  __syncthreads();
}

DI void tile_map(int id, int ntn, int& mt, int& nt) {
  const int r = id >> 9, b = id & 511;
  const int x = b & 7, sidx = b >> 3;
  const int P = r * 8 + x;
  mt = (P & 7) * 8 + (sidx & 7);
  nt = (P >> 3) * 8 + (sidx >> 3);
}
DI int tile_count(int ntn) { return ((ntn + 7) >> 3) * 512; }

DI void transpose_tile(const float* __restrict__ src, int R, int C, u16* __restrict__ dst, int kt, int nt, char* smem) {
  float* tile = (float*)smem;
  const int tid = threadIdx.x;
  const int k0 = kt * 64, n0 = nt * 64;
#pragma unroll 4
  for (int it = 0; it < 16; ++it) {
    const int kk = it * 4 + (tid >> 6), nn = tid & 63;
    const int n = n0 + nn;
    tile[kk * 65 + nn] = (n < C) ? src[(size_t)(k0 + kk) * C + n] : 0.f;
  }
  __syncthreads();
#pragma unroll 4
  for (int it = 0; it < 16; ++it) {
    const int nn = it * 4 + (tid >> 6), kk = tid & 63;
    dst[(size_t)(n0 + nn) * R + k0 + kk] = f2bf(tile[kk * 65 + nn]);
  }
  __syncthreads();
}

DI float wave_sum(float v) {
#pragma unroll
  for (int o = 32; o; o >>= 1) v += __shfl_xor(v, o, 64);
  return v;
}

DI void filter_unit(const Params& p, int unit, char* smem) {
  float* sz = (float*)smem;
  float* hA = sz + 8 * 33 + 8;
  float* hB = hA + 8 * 64;
  float* hT = hB + 8 * 64;
  const int tid = opaque_tid();
  const int l0 = unit * 8;
  for (int idx = tid; idx < 8 * 33; idx += 256) {
    const int pp = idx / 33, f = idx - pp * 33;
    const float l = (float)(l0 + pp);
    float v;
    if (f == 0) v = l / 4095.f;
    else {
      const int jb = (f - 1) & 15;
      const float fj = 1e-4f + (float)jb * ((15.f - 1e-4f) / 15.f);
      const float ang = 6.283185307179586f * l / 4096.f;
      v = (f <= 16) ? fcos(fj * ang) : -fsin(fj * ang);
    }
    sz[idx] = v;
  }
  const int o = tid & 63, pq = tid >> 6;
  {
    const float bb = p.filt_b1[o], fr = p.filt_freq[o];
    __syncthreads();
    float s0 = bb, s1 = bb;
#pragma unroll 1
    for (int f0 = 0; f0 < 33; f0 += 11) {
      float wc[11];
#pragma unroll
      for (int f = 0; f < 11; ++f) wc[f] = p.filt_w1[(f0 + f) * 64 + o];
#pragma unroll
      for (int f = 0; f < 11; ++f) { s0 += sz[pq * 33 + f0 + f] * wc[f]; s1 += sz[(pq + 4) * 33 + f0 + f] * wc[f]; }
    }
    hA[pq * 64 + o] = fsin(fr * s0);
    hA[(pq + 4) * 64 + o] = fsin(fr * s1);
  }
  {
    const float bb = p.filt_b2[o], fr = p.filt_freq[64 + o];
    __syncthreads();
    float s0 = bb, s1 = bb;
#pragma unroll 1
    for (int k0 = 0; k0 < 64; k0 += 16) {
      float wc[16];
#pragma unroll
      for (int k = 0; k < 16; ++k) wc[k] = p.filt_w2[(k0 + k) * 64 + o];
#pragma unroll
      for (int k = 0; k < 16; ++k) { s0 += hA[pq * 64 + k0 + k] * wc[k]; s1 += hA[(pq + 4) * 64 + k0 + k] * wc[k]; }
    }
    hB[pq * 64 + o] = fsin(fr * s0);
    hB[(pq + 4) * 64 + o] = fsin(fr * s1);
  }
  {
    const float bb = p.filt_b3[o], fr = p.filt_freq[128 + o];
    __syncthreads();
    float s0 = bb, s1 = bb;
#pragma unroll 1
    for (int k0 = 0; k0 < 64; k0 += 16) {
      float wc[16];
#pragma unroll
      for (int k = 0; k < 16; ++k) wc[k] = p.filt_w3[(k0 + k) * 64 + o];
#pragma unroll
      for (int k = 0; k < 16; ++k) { s0 += hB[pq * 64 + k0 + k] * wc[k]; s1 += hB[(pq + 4) * 64 + k0 + k] * wc[k]; }
    }
    hT[o * 8 + pq] = fsin(fr * s0);
    hT[o * 8 + pq + 4] = fsin(fr * s1);
  }
  __syncthreads();
  float* filt = (float*)(p.ws + OFF_FILT);
  const float min_decay = -3.0701134573253944f, max_decay = -15.350567286626973f;
#pragma unroll 1
  for (int cc = 0; cc < 8; ++cc) {
    const int col = tid + 256 * cc;
    float acc[8];
#pragma unroll
    for (int q = 0; q < 8; ++q) acc[q] = 0.f;
#pragma unroll 1
    for (int k0 = 0; k0 < 64; k0 += 16) {
      float wc[16];
#pragma unroll
      for (int k = 0; k < 16; ++k) wc[k] = p.filt_w4[(k0 + k) * 2048 + col];
#pragma unroll
      for (int k = 0; k < 16; ++k) {
        const float4 h0 = *(const float4*)(hT + (k0 + k) * 8);
        const float4 h1 = *(const float4*)(hT + (k0 + k) * 8 + 4);
        acc[0] += h0.x * wc[k]; acc[1] += h0.y * wc[k]; acc[2] += h0.z * wc[k]; acc[3] += h0.w * wc[k];
        acc[4] += h1.x * wc[k]; acc[5] += h1.y * wc[k]; acc[6] += h1.z * wc[k]; acc[7] += h1.w * wc[k];
      }
    }
    const int ch = col & 511;
    const float delta = fabsf(min_decay + (float)ch * ((max_decay - min_decay) / 511.f));
#pragma unroll
    for (int q = 0; q < 8; ++q) {
      const float t = (float)(l0 + q) / 4095.f;
      acc[q] *= expf(-t * delta);
    }
    float4* dst = (float4*)(filt + (size_t)col * 4096 + l0);
    dst[0] = make_float4(acc[0], acc[1], acc[2], acc[3]);
    dst[1] = make_float4(acc[4], acc[5], acc[6], acc[7]);
  }
  __syncthreads();
}

DI void phase0(const Params& p, char* smem) {
  const int tid = threadIdx.x, lane = tid & 63, wave = tid >> 6;
  const int U_W = 32, U_F = 512, U_X = 1024, U_T1 = 58 * 16, U_T2 = 256, U_T3 = 1024, U_T4 = 1024;
  const int total = U_W + U_F + U_X + U_T1 + U_T2 + U_T3 + U_T4;
  for (int u = blockIdx.x; u < total; u += gridDim.x) {
    int v = u;
    if (v < U_W) {
      const int idx = v * 256 + tid;
      if (idx < 8191) {
        const int lh = 31 - __clz(idx + 1);
        const int h = 1 << lh, jj = idx + 1 - h;
        float2* twp = (float2*)(p.ws + OFF_TW);
        const float ang = -3.14159265358979f * (float)jj / (float)h;
        twp[idx] = make_float2(cosf(ang), sinf(ang));
      }
      continue;
    }
    v -= U_W;
    if (v < U_F) { filter_unit(p, v, smem); continue; }
    v -= U_F;
    if (v < U_X) {
      u16* xn = (u16*)(p.ws + OFF_XN);
#pragma unroll 4
      for (int rr = 0; rr < 4; ++rr) {
        const int row = v * 16 + wave * 4 + rr;
        const float4* xr = (const float4*)(p.x + (size_t)row * DM);
        float4 xv[4];
        float ss = 0.f;
#pragma unroll
        for (int i = 0; i < 4; ++i) {
          xv[i] = xr[lane + 64 * i];
          ss += xv[i].x * xv[i].x + xv[i].y * xv[i].y + xv[i].z * xv[i].z + xv[i].w * xv[i].w;
        }
        ss = wave_sum(ss);
        const float rs = rsqrtf(ss * (1.f / DM) + EPS);
#pragma unroll
        for (int i = 0; i < 4; ++i) {
          const float4 w = ((const float4*)p.norm_mix_pre)[lane + 64 * i];
          ushort4 o;
          o.x = f2bf(xv[i].x * rs * w.x); o.y = f2bf(xv[i].y * rs * w.y); o.z = f2bf(xv[i].z * rs * w.z); o.w = f2bf(xv[i].w * rs * w.w);
          *(ushort4*)(xn + (size_t)row * DM + (lane + 64 * i) * 4) = o;
        }
      }
      continue;
    }
    v -= U_X;
    if (v < U_T1) { transpose_tile(p.w_in, DM, NIN, (u16*)(p.ws + OFF_WINT), v & 15, v >> 4, smem); continue; }
    v -= U_T1;
    if (v < U_T2) { transpose_tile(p.w_out, DM, DM, (u16*)(p.ws + OFF_WOUTT), v & 15, v >> 4, smem); continue; }
    v -= U_T2;
    if (v < U_T3) { transpose_tile(p.w_mlp_in, DM, DFF, (u16*)(p.ws + OFF_W1T), v & 15, v >> 4, smem); continue; }
    v -= U_T3;
    transpose_tile(p.w_mlp_out, DFF, DM, (u16*)(p.ws + OFF_W2T), v & 63, v >> 6, smem);
  }
}

DI void wave_lds_sync() { asm volatile("s_waitcnt lgkmcnt(0)" ::: "memory"); __builtin_amdgcn_wave_barrier(); }
template <int MODE>
DI void stage_tile_ns(const f32x16 (&acc)[4][2], char* wl, int lr, int hh) {
#pragma unroll
  for (int i = 0; i < 4; ++i)
#pragma unroll
    for (int j = 0; j < 2; ++j)
#pragma unroll
      for (int r = 0; r < 16; ++r) {
        float v = acc[i][j][r];
        if (MODE == 1) v = sigmoidf(v);
        if (MODE == 2) { v = fmaxf(v, 0.f); v = v * v; }
        *(u16*)(wl + (i * 32 + crow(r, hh)) * 128 + (j * 32 + lr) * 2) = f2bf(v);
      }
}
DI void stage_tile_sw(const f32x16 (&acc)[4][2], char* wl, int lr, int hh) {
#pragma unroll
  for (int i = 0; i < 4; ++i)
#pragma unroll
    for (int j = 0; j < 2; ++j)
#pragma unroll
      for (int r = 0; r < 16; ++r) *(u16*)(wl + (j * 32 + crow(r, hh)) * 256 + (i * 32 + lr) * 2) = f2bf(acc[i][j][r]);
}
DI void flush_tile_ns(const char* wl, u16* dst, size_t pitch, int lane) {
#pragma unroll 4
  for (int it = 0; it < 16; ++it) {
    const int q = lane + 64 * it, row = q >> 3, c8 = q & 7;
    *(uint4*)(dst + (size_t)row * pitch + c8 * 8) = *(const uint4*)(wl + row * 128 + c8 * 16);
  }
}

DI void phase1(const Params& p, char* smem) {
  const int tid = threadIdx.x, lane = tid & 63, wave = tid >> 6, wr = wave >> 1, wc = wave & 1, lr = lane & 31, hh = lane >> 5;
  const u16* xn = (const u16*)(p.ws + OFF_XN);
  const u16* wt = (const u16*)(p.ws + OFF_WINT);
  u16* qkpre = (u16*)(p.ws + OFF_QKPRE);
  u16* hyT = (u16*)(p.ws + OFF_HYT);
  u16* vT = (u16*)(p.ws + OFF_VT);
  u16* og = (u16*)(p.ws + OFF_OG);
  float* gates = (float*)(p.ws + OFF_GATES);
  const int ntn = 29, ntiles = tile_count(ntn);
  for (int id = blockIdx.x; id < ntiles; id += gridDim.x) {
    int mt, nt;
    tile_map(id, ntn, mt, nt);
    if (nt >= ntn) continue;
    const int m0 = mt * 256, n0 = nt * 128;
    f32x16 acc[4][2];
    const bool swap = (nt >= 8 && nt < 24);
    if (swap) gemm_core<true>(xn, wt, DM, m0, n0, smem, acc);
    else gemm_core<false>(xn, wt, DM, m0, n0, smem, acc);
    char* wl = smem + wave * 16384;
    if (!swap) {
      if (nt < 28) {
        if (nt < 8) stage_tile_ns<0>(acc, wl, lr, hh); else stage_tile_ns<1>(acc, wl, lr, hh);
        wave_lds_sync();
        const size_t row0 = (size_t)(m0 + wr * 128);
        if (nt < 8) flush_tile_ns(wl, qkpre + row0 * 1024 + n0 + wc * 64, 1024, lane);
        else flush_tile_ns(wl, og + row0 * 512 + (n0 - 3072) + wc * 64, 512, lane);
      } else {
#pragma unroll
        for (int i = 0; i < 4; ++i)
#pragma unroll
          for (int r = 0; r < 16; ++r) {
            const int row = m0 + wr * 128 + i * 32 + crow(r, hh);
            if (wc == 0 && lr < 16) gates[(size_t)row * 16 + lr] = acc[i][0][r];
          }
      }
    } else {
      stage_tile_sw(acc, wl, lr, hh);
      wave_lds_sync();
      const int mrow = m0 + wr * 128, b = mrow >> 12, t0 = mrow & 4095;
#pragma unroll 4
      for (int it = 0; it < 16; ++it) {
        const int q = lane + 64 * it, chl = q >> 4, c16 = q & 15;
        const int n = n0 + wc * 64 + chl;
        u16* dst;
        if (nt < 20) { const int cc = n - 1024, g = cc >> 9, ch = cc & 511; dst = hyT + ((size_t)((g * 4 + b) * 512 + ch)) * 4096; }
        else dst = vT + ((size_t)(b * 512 + (n - 2560))) * 4096;
        *(uint4*)(dst + t0 + c16 * 8) = *(const uint4*)(wl + chl * 256 + c16 * 16);
      }
    }
  }
}

DI void phase_qk(const Params& p, char* smem) {
  const int tid = opaque_tid();
  const int cg = tid & 31, rg = tid >> 5;
  const u16* qkpre = (const u16*)(p.ws + OFF_QKPRE);
  u16* qa = (u16*)(p.ws + OFF_QA);
  u16* ka = (u16*)(p.ws + OFF_KA);
  u16* kaT = (u16*)(p.ws + OFF_KAT);
  for (int u = blockIdx.x; u < 1024; u += gridDim.x) {
    const int ct = u & 3, tt = u >> 2;
    const int C0 = ct * 256 + cg * 8;
    const int Tb = tt * 64 + rg * 8;
    const int tb = Tb & 4095;
    float w0[8], w1[8], w2[8], cb[8];
    {
      const float4 a0 = *(const float4*)(p.conv_w + C0), a1 = *(const float4*)(p.conv_w + C0 + 4);
      const float4 b0 = *(const float4*)(p.conv_w + 2560 + C0), b1 = *(const float4*)(p.conv_w + 2560 + C0 + 4);
      const float4 c0 = *(const float4*)(p.conv_w + 5120 + C0), c1 = *(const float4*)(p.conv_w + 5120 + C0 + 4);
      const float4 d0 = *(const float4*)(p.conv_b + C0), d1 = *(const float4*)(p.conv_b + C0 + 4);
      w0[0] = a0.x; w0[1] = a0.y; w0[2] = a0.z; w0[3] = a0.w; w0[4] = a1.x; w0[5] = a1.y; w0[6] = a1.z; w0[7] = a1.w;
      w1[0] = b0.x; w1[1] = b0.y; w1[2] = b0.z; w1[3] = b0.w; w1[4] = b1.x; w1[5] = b1.y; w1[6] = b1.z; w1[7] = b1.w;
      w2[0] = c0.x; w2[1] = c0.y; w2[2] = c0.z; w2[3] = c0.w; w2[4] = c1.x; w2[5] = c1.y; w2[6] = c1.z; w2[7] = c1.w;
      cb[0] = d0.x; cb[1] = d0.y; cb[2] = d0.z; cb[3] = d0.w; cb[4] = d1.x; cb[5] = d1.y; cb[6] = d1.z; cb[7] = d1.w;
    }
    bf16x8 rows[10];
    const u16* src = qkpre + (size_t)Tb * 1024 + C0;
#pragma unroll
    for (int r = 0; r < 10; ++r) {
      const int t = tb + r - 1;
      bf16x8 z;
#pragma unroll
      for (int i = 0; i < 8; ++i) z[i] = 0;
      rows[r] = (t >= 0 && t <= 4095) ? *(const bf16x8*)(src + (ptrdiff_t)(r - 1) * 1024) : z;
    }
    const bool isk = C0 >= 512;
    bf16x8 tr[8];
#pragma unroll
    for (int r = 0; r < 8; ++r) {
      bf16x8 o;
#pragma unroll
      for (int i = 0; i < 8; ++i) {
        const float val = w0[i] * bf2f((u16)rows[r][i]) + w1[i] * bf2f((u16)rows[r + 1][i]) + w2[i] * bf2f((u16)rows[r + 2][i]) + cb[i];
        float sv = val * sigmoidf(val);
        if (isk) sv *= 0.08838834764831845f;
        o[i] = (short)f2bf(sv);
        tr[i][r] = o[i];
      }
      if (!isk) *(bf16x8*)(qa + (size_t)(Tb + r) * 512 + C0) = o;
      else *(bf16x8*)(ka + (size_t)(Tb + r) * 512 + (C0 - 512)) = o;
    }
    if (isk) {
      const int b = Tb >> 12;
#pragma unroll
      for (int i = 0; i < 8; ++i) *(bf16x8*)(kaT + ((size_t)(b * 512 + (C0 - 512) + i)) * 4096 + tb) = tr[i];
    }
  }
}

DI float lz(float v) { asm volatile("" : "+v"(v)); return v; }
DI float2 mk2(float a, float b) { return make_float2(a, b); }
DI float2 cmul(float2 a, float2 w) { return mk2(a.x * w.x - a.y * w.y, a.x * w.y + a.y * w.x); }
DI float2 cmulc(float2 a, float2 w) { return mk2(a.x * w.x + a.y * w.y, a.y * w.x - a.x * w.y); }
template <int NW, bool INV>
DI void r4_pass(float2* x, int tid, int q, const float2* __restrict__ t1, const float2* __restrict__ t2) {
  constexpr int NL = NW > 4 ? 4 : NW;
  constexpr int NB = NW > 4 ? 2 : 1;
  constexpr int CNT = 8 / NB;
#pragma unroll 1
  for (int bt = 0; bt < NB; ++bt) {
    float2 w1[NL], w2[NL];
#pragma unroll
    for (int n = 0; n < NL; ++n) { const int j = (tid + ((bt * CNT + n) << 8)) & (q - 1); w1[n] = t1[j]; w2[n] = t2[j]; }
    if (bt == 0) __syncthreads();
#pragma unroll(NL == 4 ? 4 : 2)
    for (int ii = 0; ii < CNT; ++ii) {
      const int k = tid + ((bt * CNT + ii) << 8);
      const int j = k & (q - 1);
      int base = ((k - j) << 2) + j;
      asm volatile("" : "+v"(base));
      const float2 ww1 = w1[ii % NL], ww2 = w2[ii % NL];
      const float2 x0 = x[base], x1 = x[base + q], x2 = x[base + 2 * q], x3 = x[base + 3 * q];
      if (!INV) {
        const float2 a0 = mk2(x0.x + x2.x, x0.y + x2.y);
        const float2 a1 = mk2(x1.x + x3.x, x1.y + x3.y);
        const float2 d02 = mk2(x0.x - x2.x, x0.y - x2.y);
        const float2 d13 = mk2(x1.y - x3.y, x3.x - x1.x);
        const float2 a2 = cmul(d02, ww1);
        const float2 a3 = cmul(d13, ww1);
        x[base] = mk2(a0.x + a1.x, a0.y + a1.y);
        x[base + q] = cmul(mk2(a0.x - a1.x, a0.y - a1.y), ww2);
        x[base + 2 * q] = mk2(a2.x + a3.x, a2.y + a3.y);
        x[base + 3 * q] = cmul(mk2(a2.x - a3.x, a2.y - a3.y), ww2);
      } else {
        const float2 b1 = cmulc(x1, ww2), b3 = cmulc(x3, ww2);
        const float2 a0 = mk2(x0.x + b1.x, x0.y + b1.y);
        const float2 a1 = mk2(x0.x - b1.x, x0.y - b1.y);
        const float2 a2 = mk2(x2.x + b3.x, x2.y + b3.y);
        const float2 a3 = mk2(x2.x - b3.x, x2.y - b3.y);
        const float2 c2 = cmulc(a2, ww1);
        const float2 c3t = cmulc(a3, ww1);
        const float2 c3 = mk2(-c3t.y, c3t.x);
        x[base] = mk2(a0.x + c2.x, a0.y + c2.y);
        x[base + 2 * q] = mk2(a0.x - c2.x, a0.y - c2.y);
        x[base + q] = mk2(a1.x + c3.x, a1.y + c3.y);
        x[base + 3 * q] = mk2(a1.x - c3.x, a1.y - c3.y);
      }
    }
  }
}
DI void r2_last(float2* x, int tid) {
#pragma unroll 4
  for (int i = 0; i < 16; ++i) {
    const int i0 = (tid + (i << 8)) << 1;
    const float2 a = x[i0], b = x[i0 + 1];
    x[i0] = mk2(a.x + b.x, a.y + b.y);
    x[i0 + 1] = mk2(a.x - b.x, a.y - b.y);
  }
}
DI void fft_fwd(float2* x, int tid, const float2* __restrict__ tw) {
  r4_pass<8, false>(x, tid, 2048, tw + 4095, tw + 2047);
  r4_pass<2, false>(x, tid, 512, tw + 1023, tw + 511);
  r4_pass<1, false>(x, tid, 128, tw + 255, tw + 127);
  r4_pass<1, false>(x, tid, 32, tw + 63, tw + 31);
  r4_pass<1, false>(x, tid, 8, tw + 15, tw + 7);
  r4_pass<1, false>(x, tid, 2, tw + 3, tw + 1);
  __syncthreads();
  r2_last(x, tid);
  __syncthreads();
}
DI void fft_inv(float2* x, int tid, const float2* __restrict__ tw) {
  __syncthreads();
  r2_last(x, tid);
  r4_pass<1, true>(x, tid, 2, tw + 3, tw + 1);
  r4_pass<1, true>(x, tid, 8, tw + 15, tw + 7);
  r4_pass<1, true>(x, tid, 32, tw + 63, tw + 31);
  r4_pass<1, true>(x, tid, 128, tw + 255, tw + 127);
  r4_pass<2, true>(x, tid, 512, tw + 1023, tw + 511);
  r4_pass<8, true>(x, tid, 2048, tw + 4095, tw + 2047);
  __syncthreads();
}

DI float hy_conv(const u16* __restrict__ pr, int t, float w0, float w1, float w2, float cb) {
  const float a = t > 0 ? bf2f(pr[t - 1]) : 0.f;
  const float b = bf2f(pr[t]);
  const float c = t < 4095 ? bf2f(pr[t + 1]) : 0.f;
  return w0 * a + w1 * b + w2 * c + cb;
}

DI void hy_conv4(const u16* __restrict__ pr, int t0, float w0, float w1, float w2, float cb, float (&o)[4]) {
  const ushort4 c = *(const ushort4*)(pr + t0);
  const float pm = t0 > 0 ? bf2f(pr[t0 - 1]) : 0.f;
  const float pn = t0 + 4 < 4096 ? bf2f(pr[t0 + 4]) : 0.f;
  const float x0 = bf2f(c.x), x1 = bf2f(c.y), x2 = bf2f(c.z), x3 = bf2f(c.w);
  o[0] = w0 * pm + w1 * x0 + w2 * x1 + cb;
  o[1] = w0 * x0 + w1 * x1 + w2 * x2 + cb;
  o[2] = w0 * x1 + w1 * x2 + w2 * x3 + cb;
  o[3] = w0 * x2 + w1 * x3 + w2 * pn + cb;
}

DI void hyena_unit(const Params& p, int ch, char* smem) {
  float2* buf = (float2*)smem;
  const int tid = opaque_tid();
  const u16* hyT = (const u16*)(p.ws + OFF_HYT);
  const float* filt = (const float*)(p.ws + OFF_FILT);
  float* z2T = (float*)(p.ws + OFF_Z2T);
  const float2* tw = (const float2*)(p.ws + OFF_TW);
  float2 Kr[32];
#pragma unroll 1
  for (int ord = 0; ord < 2; ++ord) {
    const float* kf = filt + (size_t)((0 * 2 + ord) * 512 + ch) * 4096;
    const float* kb = filt + (size_t)((1 * 2 + ord) * 512 + ch) * 4096;
    const float fb = p.filt_bias[ord * 512 + ch];
    __syncthreads();
#pragma unroll
    for (int g = 0; g < 4; ++g) {
      const int n0 = g * 1024 + tid * 4;
      float4 v = *(const float4*)(kf + n0);
      if (n0 == 0) v.x += fb;
      *(float4*)(buf + n0) = make_float4(v.x, 0.f, v.y, 0.f);
      *(float4*)(buf + n0 + 2) = make_float4(v.z, 0.f, v.w, 0.f);
      const float4 r = *(const float4*)(kb + 4092 - n0);
      const float e0 = (n0 == 0) ? 0.f : kb[4096 - n0];
      *(float4*)(buf + 4096 + n0) = make_float4(e0, 0.f, r.w, 0.f);
      *(float4*)(buf + 4096 + n0 + 2) = make_float4(r.z, 0.f, r.y, 0.f);
    }
    fft_fwd(buf, tid, tw);
#pragma unroll
    for (int j = 0; j < 32; ++j) {
      const float2 v = buf[tid + 256 * j];
      Kr[j] = make_float2(v.x * (1.f / 8192.f), v.y * (1.f / 8192.f));
    }
    const int gcol = 1024 + (1 + ord) * 512 + ch;
    const float gw0 = p.conv_w[gcol], gw1 = p.conv_w[2560 + gcol], gw2 = p.conv_w[5120 + gcol], gcb = p.conv_b[gcol];
    const int vcol = 1024 + ch;
    const float vw0 = p.conv_w[vcol], vw1 = p.conv_w[2560 + vcol], vw2 = p.conv_w[5120 + vcol], vcb = p.conv_b[vcol];
#pragma unroll 1
    for (int pr = 0; pr < 2; ++pr) {
      const int b0 = 2 * pr, b1 = 2 * pr + 1;
      __syncthreads();
      if (ord == 0) {
        const u16* u0 = hyT + ((size_t)((0 * 4 + b0) * 512 + ch)) * 4096;
        const u16* u1 = hyT + ((size_t)((0 * 4 + b1) * 512 + ch)) * 4096;
#pragma unroll
        for (int g = 0; g < 4; ++g) {
          const int t0 = g * 1024 + tid * 4;
          float a[4], b[4];
          hy_conv4(u0, t0, vw0, vw1, vw2, vcb, a);
          hy_conv4(u1, t0, vw0, vw1, vw2, vcb, b);
          *(float4*)(buf + t0) = make_float4(a[0], b[0], a[1], b[1]);
          *(float4*)(buf + t0 + 2) = make_float4(a[2], b[2], a[3], b[3]);
          *(float4*)(buf + 4096 + t0) = make_float4(0.f, 0.f, 0.f, 0.f);
          *(float4*)(buf + 4096 + t0 + 2) = make_float4(0.f, 0.f, 0.f, 0.f);
        }
      } else {
        const float* u0 = z2T + ((size_t)(b0 * 512 + ch)) * 4096;
        const float* u1 = z2T + ((size_t)(b1 * 512 + ch)) * 4096;
#pragma unroll
        for (int g = 0; g < 4; ++g) {
          const int t0 = g * 1024 + tid * 4;
          const float4 a = *(const float4*)(u0 + t0);
          const float4 b = *(const float4*)(u1 + t0);
          *(float4*)(buf + t0) = make_float4(a.x, b.x, a.y, b.y);
          *(float4*)(buf + t0 + 2) = make_float4(a.z, b.z, a.w, b.w);
          *(float4*)(buf + 4096 + t0) = make_float4(0.f, 0.f, 0.f, 0.f);
          *(float4*)(buf + 4096 + t0 + 2) = make_float4(0.f, 0.f, 0.f, 0.f);
        }
      }
      fft_fwd(buf, tid, tw);
#pragma unroll
      for (int j = 0; j < 32; ++j) {
        const float2 v = buf[tid + 256 * j];
        buf[tid + 256 * j] = make_float2(v.x * Kr[j].x - v.y * Kr[j].y, v.x * Kr[j].y + v.y * Kr[j].x);
      }
      fft_inv(buf, tid, tw);
      const u16* g0 = hyT + ((size_t)(((1 + ord) * 4 + b0) * 512 + ch)) * 4096;
      const u16* g1 = hyT + ((size_t)(((1 + ord) * 4 + b1) * 512 + ch)) * 4096;
      float* o0 = z2T + ((size_t)(b0 * 512 + ch)) * 4096;
      float* o1 = z2T + ((size_t)(b1 * 512 + ch)) * 4096;
#pragma unroll
      for (int g = 0; g < 4; ++g) {
        const int t0 = g * 1024 + tid * 4;
        const float4 y01 = *(const float4*)(buf + t0);
        const float4 y23 = *(const float4*)(buf + t0 + 2);
        float ga[4], gb[4];
        hy_conv4(g0, t0, gw0, gw1, gw2, gcb, ga);
        hy_conv4(g1, t0, gw0, gw1, gw2, gcb, gb);
        *(float4*)(o0 + t0) = make_float4(ga[0] * y01.x, ga[1] * y01.z, ga[2] * y23.x, ga[3] * y23.z);
        *(float4*)(o1 + t0) = make_float4(gb[0] * y01.y, gb[1] * y01.w, gb[2] * y23.y, gb[3] * y23.w);
      }
    }
  }
  __syncthreads();
}

DI void mlstm_local_unit(const Params& p, int u, char* smem) {
  float* s_gi = (float*)smem;
  float* s_lf = s_gi + 128;
  float* s_a = s_lf + 128;
  float* s_w = s_a + 128;
  const int tid = opaque_tid(), lane = tid & 63, wave = tid >> 6, lr = lane & 31, hh = lane >> 5;
  const int j = u & 31, dir = (u >> 5) & 1, bh = u >> 6, h = bh & 3, b = bh >> 2;
  const int T0 = b * 4096 + j * 128;
  const float* gates = (const float*)(p.ws + OFF_GATES);
  const u16* vT = (const u16*)(p.ws + OFF_VT);
  const u16* kaT = (const u16*)(p.ws + OFF_KAT);
  float* CL = p.out;
  float* nl = (float*)(p.ws + OFF_NL);
  float* mloc = (float*)(p.ws + OFF_MLOC);
  float* gsum = (float*)(p.ws + OFF_GSUM);
  __syncthreads();
  if (tid < 128) {
    const int T = T0 + tid;
    s_gi[tid] = gates[(size_t)T * 16 + dir * 8 + h] + p.b_gates[dir * 8 + h];
    s_lf[tid] = log_sigmoid(gates[(size_t)T * 16 + dir * 8 + 4 + h] + p.b_gates[dir * 8 + 4 + h]);
  }
  __syncthreads();
  float gtot = 0.f;
  if (tid < 128) {
    float pre = 0.f;
#pragma unroll 4
    for (int m = 0; m < 128; ++m) {
      const float v = s_lf[m];
      if (m < tid) pre += v;
      gtot += v;
    }
    s_a[tid] = (dir == 0) ? (gtot - pre - s_lf[tid] + s_gi[tid]) : (pre + s_gi[tid]);
  }
  __syncthreads();
  if (tid < 128) {
    float mx = -3.0e38f;
#pragma unroll 4
    for (int m = 0; m < 128; ++m) mx = fmaxf(mx, s_a[m]);
    s_w[tid] = expf(s_a[tid] - mx);
    if (tid == 0) { mloc[u] = mx; gsum[u] = gtot; }
  }
  __syncthreads();
  f32x16 acc[4];
#pragma unroll
  for (int d = 0; d < 4; ++d)
#pragma unroll
    for (int r = 0; r < 16; ++r) acc[d][r] = 0.f;
  const u16* vrow = vT + ((size_t)(bh * 128 + wave * 32 + lr)) * 4096 + j * 128 + hh * 8;
  const u16* kbase = kaT + ((size_t)(bh * 128 + lr)) * 4096 + j * 128 + hh * 8;
#pragma unroll 4
  for (int ks = 0; ks < 8; ++ks) {
    const bf16x8 av = *(const bf16x8*)(vrow + ks * 16);
    bf16x8 a;
#pragma unroll
    for (int i = 0; i < 8; ++i) a[i] = (short)f2bf(bf2f((u16)av[i]) * s_w[ks * 16 + hh * 8 + i]);
#pragma unroll
    for (int dt = 0; dt < 4; ++dt) {
      const bf16x8 bk = *(const bf16x8*)(kbase + (size_t)(dt * 32) * 4096 + ks * 16);
      acc[dt] = MFMA(a, bk, acc[dt]);
    }
  }
  float* dst = CL + (size_t)u * 16384;
#pragma unroll
  for (int dt = 0; dt < 4; ++dt)
#pragma unroll
    for (int r = 0; r < 16; ++r) dst[(wave * 32 + crow(r, hh)) * 128 + dt * 32 + lr] = acc[dt][r];
  if (tid < 128) {
    const u16* kr = kaT + ((size_t)(bh * 128 + tid)) * 4096 + j * 128;
    float s = 0.f;
#pragma unroll 2
    for (int l = 0; l < 128; l += 8) {
      const bf16x8 kv = *(const bf16x8*)(kr + l);
#pragma unroll
      for (int i = 0; i < 8; ++i) s += s_w[l + i] * bf2f((u16)kv[i]);
    }
    nl[(size_t)u * 128 + tid] = s;
  }
}

DI void scan_unit(const Params& p, int unit) {
  const int tid = opaque_tid();
  const int sc = unit >> 4, part = unit & 15, dir = sc & 1;
  float* CL = p.out;
  float* nl = (float*)(p.ws + OFF_NL);
  const float* mloc = (const float*)(p.ws + OFF_MLOC);
  const float* gsum = (const float*)(p.ws + OFF_GSUM);
  float* ms = (float*)(p.ws + OFF_MS);
  const int idx = part * 1024 + tid * 4;
  float4 C = make_float4(0.f, 0.f, 0.f, 0.f);
  float nst = 0.f, m = 0.f;
  const bool do_n = (part == 0) && (tid < 128);
  float4 pf[4];
#pragma unroll
  for (int q = 0; q < 4; ++q) {
    const int jj = dir ? 31 - q : q;
    pf[q] = *(const float4*)(CL + (size_t)(sc * 32 + jj) * 16384 + idx);
  }
#pragma unroll 1
  for (int c0 = 0; c0 < 32; c0 += 4) {
#pragma unroll
    for (int q = 0; q < 4; ++q) {
      const int c = c0 + q;
      const int jj = dir ? 31 - c : c;
      const int u = sc * 32 + jj;
      const float4 cl = pf[q];
      *(float4*)(CL + (size_t)u * 16384 + idx) = C;
      if (c + 4 < 32) {
        const int j2 = dir ? 31 - (c + 4) : (c + 4);
        pf[q] = *(const float4*)(CL + (size_t)(sc * 32 + j2) * 16384 + idx);
      }
      const float g = gsum[u], ml = mloc[u];
      const float mn = fmaxf(g + m, ml);
      const float dec = expf(g + m - mn), scl = expf(ml - mn);
      C.x = dec * C.x + scl * cl.x; C.y = dec * C.y + scl * cl.y; C.z = dec * C.z + scl * cl.z; C.w = dec * C.w + scl * cl.w;
      if (do_n) {
        const float nv = nl[(size_t)u * 128 + tid];
        nl[(size_t)u * 128 + tid] = nst;
        nst = dec * nst + scl * nv;
      }
      if (part == 0 && tid == 0) ms[u] = m;
      m = mn;
    }
  }
}

template <int DIR>
DI void mlstm_dir(const Params& p, int bh, int j, char* smem, f32x16 (&hs)[4]) {
  float* s_gi = (float*)smem;
  float* s_lf = s_gi + 128;
  float* s_bc = s_lf + 128;
  float* s_r = s_bc + 128;
  float* s_al = s_r + 128;
  float* s_fl = s_al + 128;
  float* s_is = s_fl + 128;
  const int tid = opaque_tid(), lane = tid & 63, wave = tid >> 6, lr = lane & 31, hh = lane >> 5;
  u16* Pl = (u16*)(smem + 4096) + wave * (32 * 136);
  const int h = bh & 3, b = bh >> 2;
  const int T0 = b * 4096 + j * 128;
  const float* gates = (const float*)(p.ws + OFF_GATES);
  const u16* qa = (const u16*)(p.ws + OFF_QA);
  const u16* ka = (const u16*)(p.ws + OFF_KA);
  const u16* vT = (const u16*)(p.ws + OFF_VT);
  const float* CS = p.out;
  const float* ns = (const float*)(p.ws + OFF_NL);
  const float* ms = (const float*)(p.ws + OFF_MS);
  u16* A2 = (u16*)(p.ws + OFF_A2);
  bf16x8 ones;
#pragma unroll
  for (int i = 0; i < 8; ++i) ones[i] = (short)0x3F80;
  const u16* qrow = qa + (size_t)(T0 + wave * 32 + lr) * 512 + h * 128 + hh * 8;
  const int u = (bh * 2 + DIR) * 32 + j;
  const float msu = ms[u];
  __syncthreads();
  if (tid < 128) {
    const int T = T0 + tid;
    s_gi[tid] = gates[(size_t)T * 16 + DIR * 8 + h] + p.b_gates[DIR * 8 + h];
    s_lf[tid] = log_sigmoid(gates[(size_t)T * 16 + DIR * 8 + 4 + h] + p.b_gates[DIR * 8 + 4 + h]);
  }
  __syncthreads();
  if (tid < 128) {
    float a = 0.f;
#pragma unroll 4
    for (int m = 0; m < 128; ++m) {
      const bool in = (DIR == 0) ? (m <= tid) : (m >= tid);
      a += in ? s_lf[m] : 0.f;
    }
    s_bc[tid] = a;
    s_r[tid] = s_gi[tid] - a;
  }
  __syncthreads();
  if (tid < 128) {
    float cm = -3.0e38f;
#pragma unroll 4
    for (int m = 0; m < 128; ++m) {
      const bool in = (DIR == 0) ? (m <= tid) : (m >= tid);
      cm = in ? fmaxf(cm, s_r[m]) : cm;
    }
    const float bc = s_bc[tid];
    const float mt = bc + fmaxf(msu, cm);
    s_al[tid] = bc - mt;
    s_fl[tid] = expf(-mt);
    s_is[tid] = expf(bc + msu - mt);
  }
  __syncthreads();
  {
    f32x16 S[4];
#pragma unroll
    for (int st = 0; st < 4; ++st)
#pragma unroll
      for (int r = 0; r < 16; ++r) S[st][r] = 0.f;
    const u16* kbase = ka + (size_t)(T0 + lr) * 512 + h * 128 + hh * 8;
#pragma unroll 4
    for (int ks = 0; ks < 8; ++ks) {
      const bf16x8 a = *(const bf16x8*)(qrow + ks * 16);
#pragma unroll
      for (int st = 0; st < 4; ++st) {
        const bf16x8 bk = *(const bf16x8*)(kbase + (size_t)(st * 32) * 512 + ks * 16);
        S[st] = MFMA(a, bk, S[st]);
      }
    }
#pragma unroll
    for (int st = 0; st < 4; ++st) {
      const int sl = st * 32 + lr;
      const float rs = s_r[sl];
#pragma unroll
      for (int r = 0; r < 16; ++r) {
        const int tl = wave * 32 + crow(r, hh);
        const bool valid = (DIR == 0) ? (sl <= tl) : (sl >= tl);
        const float pv = valid ? S[st][r] * __expf(s_al[tl] + rs) : 0.f;
        Pl[crow(r, hh) * 136 + sl] = f2bf(pv);
      }
    }
  }
  __syncthreads();
#pragma unroll
  for (int eh = 0; eh < 2; ++eh) {
    f32x16 N[3];
#pragma unroll
    for (int e = 0; e < 3; ++e)
#pragma unroll
      for (int r = 0; r < 16; ++r) N[e][r] = 0.f;
    {
      const u16* vbase = vT + ((size_t)(bh * 128 + eh * 64 + lr)) * 4096 + j * 128 + hh * 8;
#pragma unroll 4
      for (int ks = 0; ks < 8; ++ks) {
        const bf16x8 a = *(const bf16x8*)(Pl + lr * 136 + ks * 16 + hh * 8);
#pragma unroll
        for (int e2 = 0; e2 < 2; ++e2) {
          const bf16x8 bv = *(const bf16x8*)(vbase + (size_t)(e2 * 32) * 4096 + ks * 16);
          N[e2] = MFMA(a, bv, N[e2]);
        }
        N[2] = MFMA(a, ones, N[2]);
      }
    }
    {
      const float isc = s_is[wave * 32 + lr];
      const float* cbase = CS + (size_t)u * 16384 + (size_t)(eh * 64 + lr) * 128 + hh * 8;
      const float* nbase = ns + (size_t)u * 128 + hh * 8;
#pragma unroll 4
      for (int ks = 0; ks < 8; ++ks) {
        const bf16x8 aq = *(const bf16x8*)(qrow + ks * 16);
        const bf16x8 a = scale8(aq, isc);
#pragma unroll
        for (int e2 = 0; e2 < 2; ++e2) {
          const float4 c0 = *(const float4*)(cbase + (size_t)(e2 * 32) * 128 + ks * 16);
          const float4 c1 = *(const float4*)(cbase + (size_t)(e2 * 32) * 128 + ks * 16 + 4);
          const float cv[8] = {c0.x, c0.y, c0.z, c0.w, c1.x, c1.y, c1.z, c1.w};
          N[e2] = MFMA(a, pack8(cv), N[e2]);
        }
        const float4 n0 = *(const float4*)(nbase + ks * 16);
        const float4 n1 = *(const float4*)(nbase + ks * 16 + 4);
        const float nv[8] = {n0.x, n0.y, n0.z, n0.w, n1.x, n1.y, n1.z, n1.w};
        N[2] = MFMA(a, pack8(nv), N[2]);
      }
    }
#pragma unroll
    for (int r = 0; r < 16; ++r) {
      const int tl = wave * 32 + crow(r, hh);
      const float den = fmaxf(fabsf(N[2][r]), s_fl[tl]);
      const float inv = 1.f / den;
#pragma unroll
      for (int e2 = 0; e2 < 2; ++e2) {
        const float hv = N[e2][r] * inv;
        u16* tp = A2 + (size_t)(T0 + tl) * 1024 + h * 128 + (eh * 2 + e2) * 32 + lr;
        if (DIR == 0) *tp = f2bf(hv);
        else hs[eh * 2 + e2][r] = hv + bf2f(*tp);
      }
    }
  }
}

DI void mlstm_out_unit(const Params& p, int unit, char* smem) {
  const int tid = opaque_tid(), lane = tid & 63, wave = tid >> 6, lr = lane & 31, hh = lane >> 5;
  const int j = unit & 31, bh = unit >> 5, h = bh & 3, b = bh >> 2;
  const int T0 = b * 4096 + j * 128;
  const u16* og = (const u16*)(p.ws + OFF_OG);
  u16* A2 = (u16*)(p.ws + OFF_A2);
  f32x16 hs[4];
  mlstm_dir<0>(p, bh, j, smem, hs);
  mlstm_dir<1>(p, bh, j, smem, hs);
#pragma unroll
  for (int r = 0; r < 16; ++r) {
    const int T = T0 + wave * 32 + crow(r, hh);
    float ss = 0.f;
#pragma unroll
    for (int et = 0; et < 4; ++et) {
      const float o = bf2f(og[(size_t)T * 512 + h * 128 + et * 32 + lr]);
      hs[et][r] *= o;
      ss += hs[et][r] * hs[et][r];
    }
#pragma unroll
    for (int o = 1; o < 32; o <<= 1) ss += __shfl_xor(ss, o, 64);
    const float rs = rsqrtf(ss * (1.f / 128.f) + EPS);
#pragma unroll
    for (int et = 0; et < 4; ++et) {
      const int e = h * 128 + et * 32 + lr;
      A2[(size_t)T * 1024 + e] = f2bf(hs[et][r] * rs * p.mlstm_norm_w[e]);
    }
  }
}

DI void hyena_norm_unit(const Params& p, int unit, char* smem) {
  float* tile = (float*)smem;
  const int tid = opaque_tid();
  const int tt = unit & 63, g = (unit >> 6) & 7, b = unit >> 9;
  const float* z2T = (const float*)(p.ws + OFF_Z2T);
  u16* A2 = (u16*)(p.ws + OFF_A2);
  __syncthreads();
#pragma unroll 4
  for (int i = 0; i < 16; ++i) {
    const int cl = (tid >> 6) + 4 * i, tl = tid & 63;
    tile[cl * 65 + tl] = z2T[((size_t)(b * 512 + g * 64 + cl)) * 4096 + tt * 64 + tl];
  }
  __syncthreads();
  const int tl = tid >> 2, qd = tid & 3;
  float v[16];
  float ss = 0.f;
#pragma unroll
  for (int i = 0; i < 16; ++i) {
    v[i] = tile[(qd * 16 + i) * 65 + tl];
    ss += v[i] * v[i];
  }
  ss += __shfl_xor(ss, 1, 64);
  ss += __shfl_xor(ss, 2, 64);
  const float rs = rsqrtf(ss * (1.f / 64.f) + EPS);
  const size_t T = (size_t)b * 4096 + tt * 64 + tl;
  u16* dst = A2 + T * 1024 + 512 + g * 64 + qd * 16;
  const float* w = p.hyena_norm_w + g * 64 + qd * 16;
  float o[16];
#pragma unroll
  for (int i = 0; i < 16; ++i) o[i] = v[i] * rs * w[i];
  *(bf16x8*)(dst) = pack8(o);
  *(bf16x8*)(dst + 8) = pack8(o + 8);
}

template <int EPI>
DI void gemm_phase(const u16* A, const u16* Bt, int K, int ntn, void* outp, char* smem) {
  const int tid = threadIdx.x, lane = tid & 63, wave = tid >> 6, wr = wave >> 1, wc = wave & 1, lr = lane & 31, hh = lane >> 5;
  const int ntiles = tile_count(ntn);
  for (int id = blockIdx.x; id < ntiles; id += gridDim.x) {
    int mt, nt;
    tile_map(id, ntn, mt, nt);
    if (nt >= ntn) continue;
    const int m0 = mt * 256, n0 = nt * 128;
    f32x16 acc[4][2];
    gemm_core<false>(A, Bt, K, m0, n0, smem, acc);
    if (EPI == 0) {
#pragma unroll
      for (int i = 0; i < 4; ++i)
#pragma unroll
        for (int j = 0; j < 2; ++j)
#pragma unroll
          for (int r = 0; r < 16; ++r) {
            const int row = m0 + wr * 128 + i * 32 + crow(r, hh);
            const int col = n0 + wc * 64 + j * 32 + lr;
            ((float*)outp)[(size_t)row * 1024 + col] = acc[i][j][r];
          }
    } else {
      char* wl = smem + wave * 16384;
      stage_tile_ns<2>(acc, wl, lr, hh);
      wave_lds_sync();
      flush_tile_ns(wl, (u16*)outp + (size_t)(m0 + wr * 128) * 4096 + n0 + wc * 64, 4096, lane);
    }
  }
}

DI void phase_post_mix(const Params& p) {
  const int tid = threadIdx.x, lane = tid & 63, wave = tid >> 6;
  const float* mix = p.out;
  float* x1 = (float*)(p.ws + OFF_X1);
  u16* hm = (u16*)(p.ws + OFF_HM);
  for (int u = blockIdx.x; u < 1024; u += gridDim.x) {
#pragma unroll 2
    for (int rr = 0; rr < 4; ++rr) {
      const size_t row = (size_t)u * 16 + wave * 4 + rr;
      float4 mv[4], xv[4];
      float ss = 0.f;
#pragma unroll
      for (int i = 0; i < 4; ++i) {
        mv[i] = ((const float4*)(mix + row * DM))[lane + 64 * i];
        xv[i] = ((const float4*)(p.x + row * DM))[lane + 64 * i];
        ss += mv[i].x * mv[i].x + mv[i].y * mv[i].y + mv[i].z * mv[i].z + mv[i].w * mv[i].w;
      }
      ss = wave_sum(ss);
      const float rs = rsqrtf(ss * (1.f / DM) + EPS);
      float s2 = 0.f;
#pragma unroll
      for (int i = 0; i < 4; ++i) {
        const float4 w = ((const float4*)p.norm_mix_post)[lane + 64 * i];
        xv[i].x += mv[i].x * rs * w.x; xv[i].y += mv[i].y * rs * w.y; xv[i].z += mv[i].z * rs * w.z; xv[i].w += mv[i].w * rs * w.w;
        s2 += xv[i].x * xv[i].x + xv[i].y * xv[i].y + xv[i].z * xv[i].z + xv[i].w * xv[i].w;
        ((float4*)(x1 + row * DM))[lane + 64 * i] = xv[i];
      }
      s2 = wave_sum(s2);
      const float r2 = rsqrtf(s2 * (1.f / DM) + EPS);
#pragma unroll
      for (int i = 0; i < 4; ++i) {
        const float4 w = ((const float4*)p.norm_mlp_pre)[lane + 64 * i];
        ushort4 o;
        o.x = f2bf(xv[i].x * r2 * w.x); o.y = f2bf(xv[i].y * r2 * w.y); o.z = f2bf(xv[i].z * r2 * w.z); o.w = f2bf(xv[i].w * r2 * w.w);
        *(ushort4*)(hm + row * DM + (lane + 64 * i) * 4) = o;
      }
    }
  }
}

DI void phase_final(const Params& p) {
  const int tid = threadIdx.x, lane = tid & 63, wave = tid >> 6;
  const float* x1 = (const float*)(p.ws + OFF_X1);
  for (int u = blockIdx.x; u < 1024; u += gridDim.x) {
#pragma unroll 2
    for (int rr = 0; rr < 4; ++rr) {
      const size_t row = (size_t)u * 16 + wave * 4 + rr;
      float4 fv[4];
      float ss = 0.f;
#pragma unroll
      for (int i = 0; i < 4; ++i) {
        fv[i] = ((const float4*)(p.out + row * DM))[lane + 64 * i];
        ss += fv[i].x * fv[i].x + fv[i].y * fv[i].y + fv[i].z * fv[i].z + fv[i].w * fv[i].w;
      }
      ss = wave_sum(ss);
      const float rs = rsqrtf(ss * (1.f / DM) + EPS);
#pragma unroll
      for (int i = 0; i < 4; ++i) {
        const float4 w = ((const float4*)p.norm_mlp_post)[lane + 64 * i];
        const float4 xv = ((const float4*)(x1 + row * DM))[lane + 64 * i];
        float4 o;
        o.x = xv.x + fv[i].x * rs * w.x; o.y = xv.y + fv[i].y * rs * w.y; o.z = xv.z + fv[i].z * rs * w.z; o.w = xv.w + fv[i].w * rs * w.w;
        ((float4*)(p.out + row * DM))[lane + 64 * i] = o;
      }
    }
  }
}

DI void run_phase(const Params& p, int ph, char* smem) {
  switch (ph) {
    case 0: phase0(p, smem); break;
    case 1: phase1(p, smem); break;
    case 2: phase_qk(p, smem); break;
    case 3:
#ifdef DBL_HYONLY
      for (int u = blockIdx.x; u < 512; u += gridDim.x) hyena_unit(p, u, smem);
#endif
#ifdef DBL_MLONLY
      for (int u = blockIdx.x; u < 1024; u += gridDim.x) mlstm_local_unit(p, u, smem);
#endif
      for (int u = blockIdx.x; u < 512 + 1024; u += gridDim.x) {
        if (u < 512) hyena_unit(p, u, smem);
        else mlstm_local_unit(p, u - 512, smem);
      }
      break;
    case 4:
      for (int u = blockIdx.x; u < 512; u += gridDim.x) scan_unit(p, u);
      break;
    case 5:
      for (int u = blockIdx.x; u < 512 + 2048; u += gridDim.x) {
#ifndef DBG_SKIP_MLSTM
        if (u < 512) mlstm_out_unit(p, u, smem);
#else
        if (u < 512) { u16* A2 = (u16*)(p.ws + OFF_A2); const int T0 = (u >> 5 >> 2) * 4096 + (u & 31) * 128, hq = (u >> 5) & 3;
          for (int i = threadIdx.x; i < 128 * 128; i += 256) A2[(size_t)(T0 + (i >> 7)) * 1024 + hq * 128 + (i & 127)] = 0; }
#endif
#ifndef DBG_SKIP_HYENA
        else hyena_norm_unit(p, u - 512, smem);
#else
        else { const int un = u - 512; const int tt = un & 63, g = (un >> 6) & 7, b = un >> 9; u16* A2 = (u16*)(p.ws + OFF_A2);
          for (int i = threadIdx.x; i < 64 * 64; i += 256) A2[((size_t)b * 4096 + tt * 64 + (i >> 6)) * 1024 + 512 + g * 64 + (i & 63)] = 0x3F80; }
#endif
      }
      break;
    case 6: gemm_phase<0>((const u16*)(p.ws + OFF_A2), (const u16*)(p.ws + OFF_WOUTT), 1024, 8, p.out, smem); break;
    case 7: phase_post_mix(p); break;
    case 8: gemm_phase<1>((const u16*)(p.ws + OFF_HM), (const u16*)(p.ws + OFF_W1T), 1024, 32, p.ws + OFF_H, smem); break;
    case 9: gemm_phase<0>((const u16*)(p.ws + OFF_H), (const u16*)(p.ws + OFF_W2T), 4096, 8, p.out, smem); break;
    case 10: phase_final(p); break;
  }
}
constexpr int NPHASE = 11;

#define XB_XCNT(j)  (256  + 64 * (j))
#define XB_XSUB(j)  (1280 + 64 * (j))
#define XB_XGEN(j)  (2304 + 64 * (j))
#define XB_TOP      3328
#define XB_TOPGEN   3392
#define XCD_BAR_WORDS 3456
DI unsigned xb_ld(unsigned* p) { return __hip_atomic_load(p, __ATOMIC_RELAXED, __HIP_MEMORY_SCOPE_AGENT); }
DI unsigned xb_add(unsigned* p, unsigned v) { return __hip_atomic_fetch_add(p, v, __ATOMIC_RELAXED, __HIP_MEMORY_SCOPE_AGENT); }
DI unsigned xb_xcc_id() { return (unsigned)__builtin_amdgcn_s_getreg((3 << 11) | 20) & 0xFu; }
struct XcdBar { unsigned* bar; unsigned x, nloc, nx; };
DI void xcd_barrier(XcdBar& b) {
  asm volatile("s_waitcnt vmcnt(0)" ::: "memory");
  __syncthreads();
  if (threadIdx.x == 0) {
    unsigned* bar = b.bar;
    __builtin_amdgcn_s_waitcnt(0);
    if (b.nloc == 0u) {
      const unsigned G = gridDim.x;
      unsigned sum, cnt, mine;
      for (;;) {
        sum = 0u; cnt = 0u; mine = 0u;
#pragma unroll
        for (unsigned j = 0; j < 16; ++j) { const unsigned c = xb_ld(&bar[XB_XCNT(j)]); sum += c; cnt += (c > 0u) ? 1u : 0u; mine = (j == b.x) ? c : mine; }
        if (sum == G) break;
        __builtin_amdgcn_s_sleep(1);
      }
      b.nloc = mine > 0u ? mine : 1u; b.nx = cnt > 0u ? cnt : 1u;
    }
    const unsigned nloc = b.nloc, nx = b.nx;
    const unsigned old = xb_add(&bar[XB_XSUB(b.x)], 1u);
    const unsigned gen = old / nloc;
    if (old + 1u == (gen + 1u) * nloc) {
      __builtin_amdgcn_fence(__ATOMIC_RELEASE, "agent");
      asm volatile("s_waitcnt vmcnt(0)" ::: "memory");
      const unsigned og = xb_add(&bar[XB_TOP], 1u);
      const unsigned tg = og / nx;
      if (og + 1u == (tg + 1u) * nx) xb_add(&bar[XB_TOPGEN], 1u);
      else while (xb_ld(&bar[XB_TOPGEN]) == tg) __builtin_amdgcn_s_sleep(1);
      __builtin_amdgcn_fence(__ATOMIC_ACQUIRE, "agent");
      xb_add(&bar[XB_XGEN(b.x)], 1u);
      asm volatile("s_waitcnt vmcnt(0)" ::: "memory");
    } else {
      while (xb_ld(&bar[XB_XGEN(b.x)]) == gen) __builtin_amdgcn_s_sleep(1);
      __builtin_amdgcn_fence(__ATOMIC_ACQUIRE, "agent");
      asm volatile("s_waitcnt vmcnt(0)" ::: "memory");
    }
  }
  __syncthreads();
}

#if MULTI_LAUNCH
template <int PH>
__global__ void __launch_bounds__(256, 2) phase_kernel(Params p) {
  __shared__ __attribute__((aligned(16))) char smem[65536];
  run_phase(p, PH, smem);
}
template <int PH>
static void launch_phase(const Params& p, hipStream_t stream) {
  hipLaunchKernelGGL(phase_kernel<PH>, dim3(512), dim3(256), 0, stream, p);
}
#else
__global__ void __launch_bounds__(256, 2) mega_kernel(Params p) {
  __shared__ __attribute__((aligned(16))) char smem[65536];
  cg::grid_group grid = cg::this_grid();
  XcdBar xb;
  xb.bar = (unsigned*)(p.ws + OFF_BAR); xb.x = xb_xcc_id(); xb.nloc = 0u; xb.nx = 0u;
  if (p.ws == nullptr) grid.sync();
  if (threadIdx.x == 0) (void)xb_add(&xb.bar[XB_XCNT(xb.x)], 1u);
#define GSYNC xcd_barrier(xb)
#ifdef DBL_P0
  run_phase(p, 0, smem);
#endif
  run_phase(p, 0, smem); GSYNC;
  run_phase(p, 1, smem); GSYNC;
#ifdef DBL_GEMM
  run_phase(p, 1, smem); grid.sync();
#endif
  run_phase(p, 2, smem); GSYNC;
#ifdef DBL_P2
  run_phase(p, 2, smem); GSYNC;
#endif
  run_phase(p, 3, smem); GSYNC;
#ifdef DBL_HY
  run_phase(p, 3, smem); GSYNC;
#endif
  run_phase(p, 4, smem); GSYNC;
  run_phase(p, 5, smem); GSYNC;
#ifdef DBL_P5
  run_phase(p, 5, smem); GSYNC;
#endif
  run_phase(p, 6, smem); GSYNC;
#ifdef DBL_GEMM
  run_phase(p, 6, smem); GSYNC;
#endif
  run_phase(p, 7, smem); GSYNC;
#ifdef DBL_P7
  run_phase(p, 7, smem); GSYNC;
#endif
  run_phase(p, 8, smem); GSYNC;
#ifdef DBL_GEMM
  run_phase(p, 8, smem); GSYNC;
#endif
  run_phase(p, 9, smem); GSYNC;
#ifdef DBL_GEMM
  run_phase(p, 9, smem); GSYNC;
#endif
#ifdef XSYNC
  for (int q = 0; q < 10; ++q) GSYNC;
#endif
  run_phase(p, 10, smem);
}
#endif

extern "C" void kernel_launch(void* const* d_in, const int* in_sizes, int n_in, void* d_out, int out_size, void* d_ws,
                              size_t ws_size, hipStream_t stream) {
  Params p{};
  const float** pp = (const float**)&p;
  for (int i = 0; i < 23; ++i) pp[i] = (const float*)d_in[i];
  p.out = (float*)d_out;
  p.ws = (char*)d_ws;
#if MULTI_LAUNCH
  launch_phase<0>(p, stream);
#ifdef DBL_P0
  launch_phase<0>(p, stream);
#endif
 launch_phase<1>(p, stream); launch_phase<2>(p, stream); launch_phase<3>(p, stream);
#ifdef DBL_HY
  launch_phase<3>(p, stream);
#endif

  launch_phase<4>(p, stream); launch_phase<5>(p, stream);
#ifdef DBL_P5
  launch_phase<5>(p, stream);
#endif
 launch_phase<6>(p, stream); launch_phase<7>(p, stream);
  launch_phase<8>(p, stream); launch_phase<9>(p, stream); launch_phase<10>(p, stream);
#else
  static int grid_blocks = 0;
  if (!grid_blocks) {
    int dev = 0, cus = 0, per_cu = 0;
    hipGetDevice(&dev);
    hipDeviceGetAttribute(&cus, hipDeviceAttributeMultiprocessorCount, dev);
    hipOccupancyMaxActiveBlocksPerMultiprocessor(&per_cu, mega_kernel, 256, 0);
    if (per_cu > 2) per_cu = 2;
    if (per_cu < 1) per_cu = 1;
#ifdef FORCE2
    per_cu = 2;
#endif
    grid_blocks = cus * per_cu;
  }
  hipMemsetAsync((char*)d_ws + OFF_BAR, 0, XCD_BAR_WORDS * 4, stream);
  void* args[] = {&p};
  hipError_t e = hipLaunchCooperativeKernel((void*)mega_kernel, dim3(grid_blocks), dim3(256), args, 0, stream);
  if (e != hipSuccess) fprintf(stderr, "cooperative launch failed: %s (grid %d)\n", hipGetErrorString(e), grid_blocks);
#endif
}
#if defined(__HIP_DEVICE_COMPILE__)
#pragma clang attribute pop
#endif
```

```cpp
#if defined(__HIP_DEVICE_COMPILE__)
#pragma clang attribute push(__attribute__((target("no-packed-fp32-ops"))), apply_to = function)
#endif
#include <hip/hip_runtime.h>
#include <hip/hip_cooperative_groups.h>
#include <cstdio>
namespace cg = cooperative_groups;

#ifndef MULTI_LAUNCH
#define MULTI_LAUNCH 0
#endif

typedef unsigned short u16;
using bf16x8 = __attribute__((ext_vector_type(8))) short;
using f32x16 = __attribute__((ext_vector_type(16))) float;
#define DI __device__ __forceinline__
#define MFMA(a, b, c) __builtin_amdgcn_mfma_f32_32x32x16_bf16((a), (b), (c), 0, 0, 0)

constexpr int SEQ = 4096, DM = 1024, NTOK = 16384, NIN = 3600, NINP = 3712, DFF = 4096;
constexpr float EPS = 1e-6f;
constexpr size_t MiB = 1u << 20;
constexpr size_t OFF_WINT = 0, OFF_WOUTT = 8 * MiB, OFF_W1T = 10 * MiB, OFF_W2T = 18 * MiB;
constexpr size_t OFF_XN = 26 * MiB, OFF_QA = 26 * MiB, OFF_KA = 42 * MiB;
constexpr size_t OFF_FILT = 58 * MiB, OFF_QKPRE = 90 * MiB, OFF_A2 = 90 * MiB;
constexpr size_t OFF_HYT = 122 * MiB, OFF_VT = 170 * MiB, OFF_OG = 186 * MiB, OFF_GATES = 202 * MiB;
constexpr size_t OFF_NL = 203 * MiB, OFF_MLOC = 203 * MiB + 512 * 1024, OFF_GSUM = OFF_MLOC + 4096, OFF_MS = OFF_GSUM + 4096;
constexpr size_t OFF_KAT = 205 * MiB, OFF_Z2T = 221 * MiB;
constexpr size_t OFF_TW = 204 * MiB, OFF_BAR = 254 * MiB;
constexpr size_t OFF_X1 = 26 * MiB, OFF_HM = 90 * MiB, OFF_H = 122 * MiB;

struct Params {
  const float *x, *norm_mix_pre, *norm_mix_post, *norm_mlp_pre, *norm_mlp_post, *w_in, *b_gates, *conv_w, *conv_b,
      *mlstm_norm_w, *hyena_norm_w, *filt_w1, *filt_b1, *filt_w2, *filt_b2, *filt_w3, *filt_b3, *filt_w4, *filt_freq,
      *filt_bias, *w_out, *w_mlp_in, *w_mlp_out;
  float* out;
  char* ws;
};

DI u16 f2bf(float x) { unsigned u = __float_as_uint(x); u += 0x7fffu + ((u >> 16) & 1u); return (u16)(u >> 16); }
DI float bf2f(u16 v) { return __uint_as_float(((unsigned)v) << 16); }
DI int opaque_tid() { int t = threadIdx.x; asm volatile("" : "+v"(t)); return t; }
DI int crow(int r, int hh) { return (r & 3) + 8 * (r >> 2) + 4 * hh; }
DI float log_sigmoid(float x) { return fminf(x, 0.f) - log1pf(expf(-fabsf(x))); }
DI float sigmoidf(float x) { return 1.f / (1.f + expf(-x)); }
DI float red2pi(float x) {
  const float k = rintf(x * 0.15915494309189535f);
  float r = fmaf(-k, 6.28125f, x);
  return fmaf(-k, 1.9353071795864769e-3f, r);
}
DI float fsin(float x) { return sinf(x); }
DI float fcos(float x) { return cosf(x); }
DI bf16x8 pack8(const float* v) {
  bf16x8 r;
#pragma unroll
  for (int i = 0; i < 8; ++i) r[i] = (short)f2bf(v[i]);
  return r;
}
DI bf16x8 scale8(bf16x8 a, float s) {
  bf16x8 r;
#pragma unroll
  for (int i = 0; i < 8; ++i) r[i] = (short)f2bf(bf2f((u16)a[i]) * s);
  return r;
}

template <bool SWAP>
DI void gemm_core(const u16* __restrict__ A, const u16* __restrict__ Bt, int K, int m0, int n0, char* smem, f32x16 (&acc)[4][2]) {
  const int tid = opaque_tid(), lane = tid & 63, wave = tid >> 6, wr = wave >> 1, wc = wave & 1;
  const int lr = lane & 31, hh = lane >> 5;
#pragma unroll
  for (int i = 0; i < 4; ++i)
#pragma unroll
    for (int j = 0; j < 2; ++j)
#pragma unroll
      for (int r = 0; r < 16; ++r) acc[i][j][r] = 0.f;
  const int c = tid & 7, r0 = tid >> 3;
  const u16* Ag = A + (size_t)(m0 + r0) * K + c * 8;
  const u16* Bg = Bt + (size_t)(n0 + r0) * K + c * 8;
  const int soff = r0 * 128 + ((c ^ ((r0 >> 1) & 7)) << 4);
  char* As = smem;
  char* Bs = smem + 32768;
  uint4 ra0, ra1, ra2, ra3, ra4, ra5, ra6, ra7, rb0, rb1, rb2, rb3;
#define GLOAD_ALL(k0)                                                                                             \
  ra0 = *(const uint4*)(Ag + (size_t)(0) * K + (k0));   ra1 = *(const uint4*)(Ag + (size_t)(32) * K + (k0));      \
  ra2 = *(const uint4*)(Ag + (size_t)(64) * K + (k0));  ra3 = *(const uint4*)(Ag + (size_t)(96) * K + (k0));      \
  ra4 = *(const uint4*)(Ag + (size_t)(128) * K + (k0)); ra5 = *(const uint4*)(Ag + (size_t)(160) * K + (k0));     \
  ra6 = *(const uint4*)(Ag + (size_t)(192) * K + (k0)); ra7 = *(const uint4*)(Ag + (size_t)(224) * K + (k0));     \
  rb0 = *(const uint4*)(Bg + (size_t)(0) * K + (k0));   rb1 = *(const uint4*)(Bg + (size_t)(32) * K + (k0));      \
  rb2 = *(const uint4*)(Bg + (size_t)(64) * K + (k0));  rb3 = *(const uint4*)(Bg + (size_t)(96) * K + (k0));
  GLOAD_ALL(0)
  const int nk = K >> 6;
#pragma unroll 1
  for (int kt = 0; kt < nk; ++kt) {
    __syncthreads();
    *(uint4*)(As + soff + 0 * 4096) = ra0; *(uint4*)(As + soff + 1 * 4096) = ra1; *(uint4*)(As + soff + 2 * 4096) = ra2; *(uint4*)(As + soff + 3 * 4096) = ra3;
    *(uint4*)(As + soff + 4 * 4096) = ra4; *(uint4*)(As + soff + 5 * 4096) = ra5; *(uint4*)(As + soff + 6 * 4096) = ra6; *(uint4*)(As + soff + 7 * 4096) = ra7;
    *(uint4*)(Bs + soff + 0 * 4096) = rb0; *(uint4*)(Bs + soff + 1 * 4096) = rb1; *(uint4*)(Bs + soff + 2 * 4096) = rb2; *(uint4*)(Bs + soff + 3 * 4096) = rb3;
    __syncthreads();
    if (kt + 1 < nk) {
      const int k0 = (kt + 1) << 6;
      GLOAD_ALL(k0)
    }
#pragma unroll
    for (int kk = 0; kk < 4; ++kk) {
      bf16x8 a[4], b[2];
      const int cc = kk * 2 + hh;
#pragma unroll
      for (int i = 0; i < 4; ++i) {
        const int r = wr * 128 + i * 32 + lr;
        a[i] = *(const bf16x8*)(As + r * 128 + ((cc ^ ((r >> 1) & 7)) << 4));
      }
#pragma unroll
      for (int j = 0; j < 2; ++j) {
        const int r = wc * 64 + j * 32 + lr;
        b[j] = *(const bf16x8*)(Bs + r * 128 + ((cc ^ ((r >> 1) & 7)) << 4));
      }
#pragma unroll
      for (int i = 0; i < 4; ++i)
#pragma unroll
        for (int j = 0; j < 2; ++j) acc[i][j] = SWAP ? MFMA(b[j], a[i], acc[i][j]) : MFMA(a[i], b[j], acc[i][j]);
    }
  }
  __syncthreads();
}

DI void tile_map(int id, int ntn, int& mt, int& nt) {
  const int r = id >> 9, b = id & 511;
  const int x = b & 7, sidx = b >> 3;
  const int P = r * 8 + x;
  mt = (P & 7) * 8 + (sidx & 7);
  nt = (P >> 3) * 8 + (sidx >> 3);
}
DI int tile_count(int ntn) { return ((ntn + 7) >> 3) * 512; }

DI void transpose_tile(const float* __restrict__ src, int R, int C, u16* __restrict__ dst, int kt, int nt, char* smem) {
  float* tile = (float*)smem;
  const int tid = threadIdx.x;
  const int k0 = kt * 64, n0 = nt * 64;
#pragma unroll 4
  for (int it = 0; it < 16; ++it) {
    const int kk = it * 4 + (tid >> 6), nn = tid & 63;
    const int n = n0 + nn;
    tile[kk * 65 + nn] = (n < C) ? src[(size_t)(k0 + kk) * C + n] : 0.f;
  }
  __syncthreads();
#pragma unroll
  for (int it = 0; it < 2; ++it) {
    const int q = tid + 256 * it, nn = q >> 3, kc = q & 7;
    float o[8];
#pragma unroll
    for (int i = 0; i < 8; ++i) o[i] = tile[(kc * 8 + i) * 65 + nn];
    *(bf16x8*)(dst + (size_t)(n0 + nn) * R + k0 + kc * 8) = pack8(o);
  }
  __syncthreads();
}

DI float wave_sum(float v) {
#pragma unroll
  for (int o = 32; o; o >>= 1) v += __shfl_xor(v, o, 64);
  return v;
}

DI void filter_unit(const Params& p, int unit, char* smem) {
  float* sz = (float*)smem;
  float* hA = sz + 8 * 33 + 8;
  float* hB = hA + 8 * 64;
  float* hT = hB + 8 * 64;
  const int tid = opaque_tid();
  const int l0 = unit * 8;
  for (int idx = tid; idx < 8 * 33; idx += 256) {
    const int pp = idx / 33, f = idx - pp * 33;
    const float l = (float)(l0 + pp);
    float v;
    if (f == 0) v = l / 4095.f;
    else {
      const int jb = (f - 1) & 15;
      const float fj = 1e-4f + (float)jb * ((15.f - 1e-4f) / 15.f);
      const float ang = 6.283185307179586f * l / 4096.f;
      v = (f <= 16) ? fcos(fj * ang) : -fsin(fj * ang);
    }
    sz[idx] = v;
  }
  const int o = tid & 63, pq = tid >> 6;
  {
    const float bb = p.filt_b1[o], fr = p.filt_freq[o];
    __syncthreads();
    float s0 = bb, s1 = bb;
#pragma unroll 1
    for (int f0 = 0; f0 < 33; f0 += 11) {
      float wc[11];
#pragma unroll
      for (int f = 0; f < 11; ++f) wc[f] = p.filt_w1[(f0 + f) * 64 + o];
#pragma unroll
      for (int f = 0; f < 11; ++f) { s0 += sz[pq * 33 + f0 + f] * wc[f]; s1 += sz[(pq + 4) * 33 + f0 + f] * wc[f]; }
    }
    hA[pq * 64 + o] = fsin(fr * s0);
    hA[(pq + 4) * 64 + o] = fsin(fr * s1);
  }
  {
    const float bb = p.filt_b2[o], fr = p.filt_freq[64 + o];
    __syncthreads();
    float s0 = bb, s1 = bb;
#pragma unroll 1
    for (int k0 = 0; k0 < 64; k0 += 16) {
      float wc[16];
#pragma unroll
      for (int k = 0; k < 16; ++k) wc[k] = p.filt_w2[(k0 + k) * 64 + o];
#pragma unroll
      for (int k = 0; k < 16; ++k) { s0 += hA[pq * 64 + k0 + k] * wc[k]; s1 += hA[(pq + 4) * 64 + k0 + k] * wc[k]; }
    }
    hB[pq * 64 + o] = fsin(fr * s0);
    hB[(pq + 4) * 64 + o] = fsin(fr * s1);
  }
  {
    const float bb = p.filt_b3[o], fr = p.filt_freq[128 + o];
    __syncthreads();
    float s0 = bb, s1 = bb;
#pragma unroll 1
    for (int k0 = 0; k0 < 64; k0 += 16) {
      float wc[16];
#pragma unroll
      for (int k = 0; k < 16; ++k) wc[k] = p.filt_w3[(k0 + k) * 64 + o];
#pragma unroll
      for (int k = 0; k < 16; ++k) { s0 += hB[pq * 64 + k0 + k] * wc[k]; s1 += hB[(pq + 4) * 64 + k0 + k] * wc[k]; }
    }
    hT[o * 8 + pq] = fsin(fr * s0);
    hT[o * 8 + pq + 4] = fsin(fr * s1);
  }
  __syncthreads();
  float* filt = (float*)(p.ws + OFF_FILT);
  const float min_decay = -3.0701134573253944f, max_decay = -15.350567286626973f;
#pragma unroll 1
  for (int cc = 0; cc < 8; ++cc) {
    const int col = tid + 256 * cc;
    float acc[8];
#pragma unroll
    for (int q = 0; q < 8; ++q) acc[q] = 0.f;
#pragma unroll 1
    for (int k0 = 0; k0 < 64; k0 += 16) {
      float wc[16];
#pragma unroll
      for (int k = 0; k < 16; ++k) wc[k] = p.filt_w4[(k0 + k) * 2048 + col];
#pragma unroll
      for (int k = 0; k < 16; ++k) {
        const float4 h0 = *(const float4*)(hT + (k0 + k) * 8);
        const float4 h1 = *(const float4*)(hT + (k0 + k) * 8 + 4);
        acc[0] += h0.x * wc[k]; acc[1] += h0.y * wc[k]; acc[2] += h0.z * wc[k]; acc[3] += h0.w * wc[k];
        acc[4] += h1.x * wc[k]; acc[5] += h1.y * wc[k]; acc[6] += h1.z * wc[k]; acc[7] += h1.w * wc[k];
      }
    }
    const int ch = col & 511;
    const float delta = fabsf(min_decay + (float)ch * ((max_decay - min_decay) / 511.f));
#pragma unroll
    for (int q = 0; q < 8; ++q) {
      const float t = (float)(l0 + q) / 4095.f;
      acc[q] *= expf(-t * delta);
    }
    float4* dst = (float4*)(filt + (size_t)col * 4096 + l0);
    dst[0] = make_float4(acc[0], acc[1], acc[2], acc[3]);
    dst[1] = make_float4(acc[4], acc[5], acc[6], acc[7]);
  }
  __syncthreads();
}

DI void phase0(const Params& p, char* smem) {
  const int tid = threadIdx.x, lane = tid & 63, wave = tid >> 6;
  const int U_W = 32, U_F = 512, U_X = 1024, U_T1 = 58 * 16, U_T2 = 256, U_T3 = 1024, U_T4 = 1024;
  const int total = U_W + U_F + U_X + U_T1 + U_T2 + U_T3 + U_T4;
  for (int u = blockIdx.x; u < total; u += gridDim.x) {
    int v = u;
    if (v < U_W) {
      const int idx = v * 256 + tid;
      if (idx < 8191) {
        const int lh = 31 - __clz(idx + 1);
        const int h = 1 << lh, jj = idx + 1 - h;
        float2* twp = (float2*)(p.ws + OFF_TW);
        const float ang = -3.14159265358979f * (float)jj / (float)h;
        twp[idx] = make_float2(cosf(ang), sinf(ang));
      }
      continue;
    }
    v -= U_W;
    if (v < U_F) { filter_unit(p, v, smem); continue; }
    v -= U_F;
    if (v < U_X) {
      u16* xn = (u16*)(p.ws + OFF_XN);
#pragma unroll 4
      for (int rr = 0; rr < 4; ++rr) {
        const int row = v * 16 + wave * 4 + rr;
        const float4* xr = (const float4*)(p.x + (size_t)row * DM);
        float4 xv[4];
        float ss = 0.f;
#pragma unroll
        for (int i = 0; i < 4; ++i) {
          xv[i] = xr[lane + 64 * i];
          ss += xv[i].x * xv[i].x + xv[i].y * xv[i].y + xv[i].z * xv[i].z + xv[i].w * xv[i].w;
        }
        ss = wave_sum(ss);
        const float rs = rsqrtf(ss * (1.f / DM) + EPS);
#pragma unroll
        for (int i = 0; i < 4; ++i) {
          const float4 w = ((const float4*)p.norm_mix_pre)[lane + 64 * i];
          ushort4 o;
          o.x = f2bf(xv[i].x * rs * w.x); o.y = f2bf(xv[i].y * rs * w.y); o.z = f2bf(xv[i].z * rs * w.z); o.w = f2bf(xv[i].w * rs * w.w);
          *(ushort4*)(xn + (size_t)row * DM + (lane + 64 * i) * 4) = o;
        }
      }
      continue;
    }
    v -= U_X;
    if (v < U_T1) { transpose_tile(p.w_in, DM, NIN, (u16*)(p.ws + OFF_WINT), v & 15, v >> 4, smem); continue; }
    v -= U_T1;
    if (v < U_T2) { transpose_tile(p.w_out, DM, DM, (u16*)(p.ws + OFF_WOUTT), v & 15, v >> 4, smem); continue; }
    v -= U_T2;
    if (v < U_T3) { transpose_tile(p.w_mlp_in, DM, DFF, (u16*)(p.ws + OFF_W1T), v & 15, v >> 4, smem); continue; }
    v -= U_T3;
    transpose_tile(p.w_mlp_out, DFF, DM, (u16*)(p.ws + OFF_W2T), v & 63, v >> 6, smem);
  }
}

DI void wave_lds_sync() { asm volatile("s_waitcnt lgkmcnt(0)" ::: "memory"); __builtin_amdgcn_wave_barrier(); }
template <int MODE>
DI void stage_tile_ns(const f32x16 (&acc)[4][2], char* wl, int lr, int hh) {
#pragma unroll
  for (int i = 0; i < 4; ++i)
#pragma unroll
    for (int j = 0; j < 2; ++j)
#pragma unroll
      for (int r = 0; r < 16; ++r) {
        float v = acc[i][j][r];
        if (MODE == 1) v = sigmoidf(v);
        if (MODE == 2) { v = fmaxf(v, 0.f); v = v * v; }
        *(u16*)(wl + (i * 32 + crow(r, hh)) * 128 + (j * 32 + lr) * 2) = f2bf(v);
      }
}
DI void stage_tile_sw(const f32x16 (&acc)[4][2], char* wl, int lr, int hh) {
#pragma unroll
  for (int i = 0; i < 4; ++i)
#pragma unroll
    for (int j = 0; j < 2; ++j)
#pragma unroll
      for (int r = 0; r < 16; ++r) *(u16*)(wl + (j * 32 + crow(r, hh)) * 256 + (i * 32 + lr) * 2) = f2bf(acc[i][j][r]);
}
DI void flush_tile_ns(const char* wl, u16* dst, size_t pitch, int lane) {
#pragma unroll 4
  for (int it = 0; it < 16; ++it) {
    const int q = lane + 64 * it, row = q >> 3, c8 = q & 7;
    *(uint4*)(dst + (size_t)row * pitch + c8 * 8) = *(const uint4*)(wl + row * 128 + c8 * 16);
  }
}

DI void phase1(const Params& p, char* smem) {
  const int tid = threadIdx.x, lane = tid & 63, wave = tid >> 6, wr = wave >> 1, wc = wave & 1, lr = lane & 31, hh = lane >> 5;
  const u16* xn = (const u16*)(p.ws + OFF_XN);
  const u16* wt = (const u16*)(p.ws + OFF_WINT);
  u16* qkpre = (u16*)(p.ws + OFF_QKPRE);
  u16* hyT = (u16*)(p.ws + OFF_HYT);
  u16* vT = (u16*)(p.ws + OFF_VT);
  u16* og = (u16*)(p.ws + OFF_OG);
  float* gates = (float*)(p.ws + OFF_GATES);
  const int ntn = 29, ntiles = tile_count(ntn);
  for (int id = blockIdx.x; id < ntiles; id += gridDim.x) {
    int mt, nt;
    tile_map(id, ntn, mt, nt);
    if (nt >= ntn) continue;
    const int m0 = mt * 256, n0 = nt * 128;
    f32x16 acc[4][2];
    const bool swap = (nt >= 8 && nt < 24);
    if (swap) gemm_core<true>(xn, wt, DM, m0, n0, smem, acc);
    else gemm_core<false>(xn, wt, DM, m0, n0, smem, acc);
    char* wl = smem + wave * 16384;
    if (!swap) {
      if (nt < 28) {
        if (nt < 8) stage_tile_ns<0>(acc, wl, lr, hh); else stage_tile_ns<1>(acc, wl, lr, hh);
        wave_lds_sync();
        const size_t row0 = (size_t)(m0 + wr * 128);
        if (nt < 8) flush_tile_ns(wl, qkpre + row0 * 1024 + n0 + wc * 64, 1024, lane);
        else flush_tile_ns(wl, og + row0 * 512 + (n0 - 3072) + wc * 64, 512, lane);
      } else {
#pragma unroll
        for (int i = 0; i < 4; ++i)
#pragma unroll
          for (int r = 0; r < 16; ++r) {
            const int row = m0 + wr * 128 + i * 32 + crow(r, hh);
            if (wc == 0 && lr < 16) gates[(size_t)row * 16 + lr] = acc[i][0][r];
          }
      }
    } else {
      stage_tile_sw(acc, wl, lr, hh);
      wave_lds_sync();
      const int mrow = m0 + wr * 128, b = mrow >> 12, t0 = mrow & 4095;
#pragma unroll 4
      for (int it = 0; it < 16; ++it) {
        const int q = lane + 64 * it, chl = q >> 4, c16 = q & 15;
        const int n = n0 + wc * 64 + chl;
        u16* dst;
        if (nt < 20) { const int cc = n - 1024, g = cc >> 9, ch = cc & 511; dst = hyT + ((size_t)((g * 4 + b) * 512 + ch)) * 4096; }
        else dst = vT + ((size_t)(b * 512 + (n - 2560))) * 4096;
        *(uint4*)(dst + t0 + c16 * 8) = *(const uint4*)(wl + chl * 256 + c16 * 16);
      }
    }
  }
}

DI void phase_qk(const Params& p, char* smem) {
  const int tid = opaque_tid();
  const int cg = tid & 31, rg = tid >> 5;
  const u16* qkpre = (const u16*)(p.ws + OFF_QKPRE);
  u16* qa = (u16*)(p.ws + OFF_QA);
  u16* ka = (u16*)(p.ws + OFF_KA);
  u16* kaT = (u16*)(p.ws + OFF_KAT);
  for (int u = blockIdx.x; u < 1024; u += gridDim.x) {
    const int ct = u & 3, tt = u >> 2;
    const int C0 = ct * 256 + cg * 8;
    const int Tb = tt * 64 + rg * 8;
    const int tb = Tb & 4095;
    float w0[8], w1[8], w2[8], cb[8];
    {
      const float4 a0 = *(const float4*)(p.conv_w + C0), a1 = *(const float4*)(p.conv_w + C0 + 4);
      const float4 b0 = *(const float4*)(p.conv_w + 2560 + C0), b1 = *(const float4*)(p.conv_w + 2560 + C0 + 4);
      const float4 c0 = *(const float4*)(p.conv_w + 5120 + C0), c1 = *(const float4*)(p.conv_w + 5120 + C0 + 4);
      const float4 d0 = *(const float4*)(p.conv_b + C0), d1 = *(const float4*)(p.conv_b + C0 + 4);
      w0[0] = a0.x; w0[1] = a0.y; w0[2] = a0.z; w0[3] = a0.w; w0[4] = a1.x; w0[5] = a1.y; w0[6] = a1.z; w0[7] = a1.w;
      w1[0] = b0.x; w1[1] = b0.y; w1[2] = b0.z; w1[3] = b0.w; w1[4] = b1.x; w1[5] = b1.y; w1[6] = b1.z; w1[7] = b1.w;
      w2[0] = c0.x; w2[1] = c0.y; w2[2] = c0.z; w2[3] = c0.w; w2[4] = c1.x; w2[5] = c1.y; w2[6] = c1.z; w2[7] = c1.w;
      cb[0] = d0.x; cb[1] = d0.y; cb[2] = d0.z; cb[3] = d0.w; cb[4] = d1.x; cb[5] = d1.y; cb[6] = d1.z; cb[7] = d1.w;
    }
    bf16x8 rows[10];
    const u16* src = qkpre + (size_t)Tb * 1024 + C0;
#pragma unroll
    for (int r = 0; r < 10; ++r) {
      const int t = tb + r - 1;
      bf16x8 z;
#pragma unroll
      for (int i = 0; i < 8; ++i) z[i] = 0;
      rows[r] = (t >= 0 && t <= 4095) ? *(const bf16x8*)(src + (ptrdiff_t)(r - 1) * 1024) : z;
    }
    const bool isk = C0 >= 512;
    bf16x8 tr[8];
#pragma unroll
    for (int r = 0; r < 8; ++r) {
      bf16x8 o;
#pragma unroll
      for (int i = 0; i < 8; ++i) {
        const float val = w0[i] * bf2f((u16)rows[r][i]) + w1[i] * bf2f((u16)rows[r + 1][i]) + w2[i] * bf2f((u16)rows[r + 2][i]) + cb[i];
        float sv = val * sigmoidf(val);
        if (isk) sv *= 0.08838834764831845f;
        o[i] = (short)f2bf(sv);
        tr[i][r] = o[i];
      }
      if (!isk) *(bf16x8*)(qa + (size_t)(Tb + r) * 512 + C0) = o;
      else *(bf16x8*)(ka + (size_t)(Tb + r) * 512 + (C0 - 512)) = o;
    }
    if (isk) {
      const int b = Tb >> 12;
#pragma unroll
      for (int i = 0; i < 8; ++i) *(bf16x8*)(kaT + ((size_t)(b * 512 + (C0 - 512) + i)) * 4096 + tb) = tr[i];
    }
  }
}

DI float lz(float v) { asm volatile("" : "+v"(v)); return v; }
DI float2 mk2(float a, float b) { return make_float2(a, b); }
DI float2 cmul(float2 a, float2 w) { return mk2(a.x * w.x - a.y * w.y, a.x * w.y + a.y * w.x); }
DI float2 cmulc(float2 a, float2 w) { return mk2(a.x * w.x + a.y * w.y, a.y * w.x - a.x * w.y); }
template <int NW, bool INV>
DI void r4_pass(float2* x, int tid, int q, const float2* __restrict__ t1, const float2* __restrict__ t2) {
  constexpr int NL = NW > 4 ? 4 : NW;
  constexpr int NB = NW > 4 ? 2 : 1;
  constexpr int CNT = 8 / NB;
#pragma unroll 1
  for (int bt = 0; bt < NB; ++bt) {
    float2 w1[NL], w2[NL];
#pragma unroll
    for (int n = 0; n < NL; ++n) { const int j = (tid + ((bt * CNT + n) << 8)) & (q - 1); w1[n] = t1[j]; w2[n] = t2[j]; }
    if (bt == 0) __syncthreads();
#pragma unroll(NL == 4 ? 4 : 2)
    for (int ii = 0; ii < CNT; ++ii) {
      const int k = tid + ((bt * CNT + ii) << 8);
      const int j = k & (q - 1);
      int base = ((k - j) << 2) + j;
      asm volatile("" : "+v"(base));
      const float2 ww1 = w1[ii % NL], ww2 = w2[ii % NL];
      const float2 x0 = x[base], x1 = x[base + q], x2 = x[base + 2 * q], x3 = x[base + 3 * q];
      if (!INV) {
        const float2 a0 = mk2(x0.x + x2.x, x0.y + x2.y);
        const float2 a1 = mk2(x1.x + x3.x, x1.y + x3.y);
        const float2 d02 = mk2(x0.x - x2.x, x0.y - x2.y);
        const float2 d13 = mk2(x1.y - x3.y, x3.x - x1.x);
        const float2 a2 = cmul(d02, ww1);
        const float2 a3 = cmul(d13, ww1);
        x[base] = mk2(a0.x + a1.x, a0.y + a1.y);
        x[base + q] = cmul(mk2(a0.x - a1.x, a0.y - a1.y), ww2);
        x[base + 2 * q] = mk2(a2.x + a3.x, a2.y + a3.y);
        x[base + 3 * q] = cmul(mk2(a2.x - a3.x, a2.y - a3.y), ww2);
      } else {
        const float2 b1 = cmulc(x1, ww2), b3 = cmulc(x3, ww2);
        const float2 a0 = mk2(x0.x + b1.x, x0.y + b1.y);
        const float2 a1 = mk2(x0.x - b1.x, x0.y - b1.y);
        const float2 a2 = mk2(x2.x + b3.x, x2.y + b3.y);
        const float2 a3 = mk2(x2.x - b3.x, x2.y - b3.y);
        const float2 c2 = cmulc(a2, ww1);
        const float2 c3t = cmulc(a3, ww1);
        const float2 c3 = mk2(-c3t.y, c3t.x);
        x[base] = mk2(a0.x + c2.x, a0.y + c2.y);
        x[base + 2 * q] = mk2(a0.x - c2.x, a0.y - c2.y);
        x[base + q] = mk2(a1.x + c3.x, a1.y + c3.y);
        x[base + 3 * q] = mk2(a1.x - c3.x, a1.y - c3.y);
      }
    }
  }
}
DI void r2_last(float2* x, int tid) {
#pragma unroll 4
  for (int i = 0; i < 16; ++i) {
    const int i0 = (tid + (i << 8)) << 1;
    const float2 a = x[i0], b = x[i0 + 1];
    x[i0] = mk2(a.x + b.x, a.y + b.y);
    x[i0 + 1] = mk2(a.x - b.x, a.y - b.y);
  }
}
DI void fft_fwd(float2* x, int tid, const float2* __restrict__ tw) {
  r4_pass<8, false>(x, tid, 2048, tw + 4095, tw + 2047);
  r4_pass<2, false>(x, tid, 512, tw + 1023, tw + 511);
  r4_pass<1, false>(x, tid, 128, tw + 255, tw + 127);
  r4_pass<1, false>(x, tid, 32, tw + 63, tw + 31);
  r4_pass<1, false>(x, tid, 8, tw + 15, tw + 7);
  r4_pass<1, false>(x, tid, 2, tw + 3, tw + 1);
  __syncthreads();
  r2_last(x, tid);
  __syncthreads();
}
DI void fft_inv(float2* x, int tid, const float2* __restrict__ tw) {
  __syncthreads();
  r2_last(x, tid);
  r4_pass<1, true>(x, tid, 2, tw + 3, tw + 1);
  r4_pass<1, true>(x, tid, 8, tw + 15, tw + 7);
  r4_pass<1, true>(x, tid, 32, tw + 63, tw + 31);
  r4_pass<1, true>(x, tid, 128, tw + 255, tw + 127);
  r4_pass<2, true>(x, tid, 512, tw + 1023, tw + 511);
  r4_pass<8, true>(x, tid, 2048, tw + 4095, tw + 2047);
  __syncthreads();
}

DI float hy_conv(const u16* __restrict__ pr, int t, float w0, float w1, float w2, float cb) {
  const float a = t > 0 ? bf2f(pr[t - 1]) : 0.f;
  const float b = bf2f(pr[t]);
  const float c = t < 4095 ? bf2f(pr[t + 1]) : 0.f;
  return w0 * a + w1 * b + w2 * c + cb;
}

DI void hy_conv4(const u16* __restrict__ pr, int t0, float w0, float w1, float w2, float cb, float (&o)[4]) {
  const ushort4 c = *(const ushort4*)(pr + t0);
  const float pm = t0 > 0 ? bf2f(pr[t0 - 1]) : 0.f;
  const float pn = t0 + 4 < 4096 ? bf2f(pr[t0 + 4]) : 0.f;
  const float x0 = bf2f(c.x), x1 = bf2f(c.y), x2 = bf2f(c.z), x3 = bf2f(c.w);
  o[0] = w0 * pm + w1 * x0 + w2 * x1 + cb;
  o[1] = w0 * x0 + w1 * x1 + w2 * x2 + cb;
  o[2] = w0 * x1 + w1 * x2 + w2 * x3 + cb;
  o[3] = w0 * x2 + w1 * x3 + w2 * pn + cb;
}

DI void hyena_unit(const Params& p, int ch, char* smem) {
  float2* buf = (float2*)smem;
  const int tid = opaque_tid();
  const u16* hyT = (const u16*)(p.ws + OFF_HYT);
  const float* filt = (const float*)(p.ws + OFF_FILT);
  float* z2T = (float*)(p.ws + OFF_Z2T);
  const float2* tw = (const float2*)(p.ws + OFF_TW);
  float2 Kr[32];
#pragma unroll 1
  for (int ord = 0; ord < 2; ++ord) {
    const float* kf = filt + (size_t)((0 * 2 + ord) * 512 + ch) * 4096;
    const float* kb = filt + (size_t)((1 * 2 + ord) * 512 + ch) * 4096;
    const float fb = p.filt_bias[ord * 512 + ch];
    __syncthreads();
#pragma unroll
    for (int g = 0; g < 4; ++g) {
      const int n0 = g * 1024 + tid * 4;
      float4 v = *(const float4*)(kf + n0);
      if (n0 == 0) v.x += fb;
      *(float4*)(buf + n0) = make_float4(v.x, 0.f, v.y, 0.f);
      *(float4*)(buf + n0 + 2) = make_float4(v.z, 0.f, v.w, 0.f);
      const float4 r = *(const float4*)(kb + 4092 - n0);
      const float e0 = (n0 == 0) ? 0.f : kb[4096 - n0];
      *(float4*)(buf + 4096 + n0) = make_float4(e0, 0.f, r.w, 0.f);
      *(float4*)(buf + 4096 + n0 + 2) = make_float4(r.z, 0.f, r.y, 0.f);
    }
    fft_fwd(buf, tid, tw);
#pragma unroll
    for (int j = 0; j < 32; ++j) {
      const float2 v = buf[tid + 256 * j];
      Kr[j] = make_float2(v.x * (1.f / 8192.f), v.y * (1.f / 8192.f));
    }
    const int gcol = 1024 + (1 + ord) * 512 + ch;
    const float gw0 = p.conv_w[gcol], gw1 = p.conv_w[2560 + gcol], gw2 = p.conv_w[5120 + gcol], gcb = p.conv_b[gcol];
    const int vcol = 1024 + ch;
    const float vw0 = p.conv_w[vcol], vw1 = p.conv_w[2560 + vcol], vw2 = p.conv_w[5120 + vcol], vcb = p.conv_b[vcol];
#pragma unroll 1
    for (int pr = 0; pr < 2; ++pr) {
      const int b0 = 2 * pr, b1 = 2 * pr + 1;
      __syncthreads();
      if (ord == 0) {
        const u16* u0 = hyT + ((size_t)((0 * 4 + b0) * 512 + ch)) * 4096;
        const u16* u1 = hyT + ((size_t)((0 * 4 + b1) * 512 + ch)) * 4096;
#pragma unroll
        for (int g = 0; g < 4; ++g) {
          const int t0 = g * 1024 + tid * 4;
          float a[4], b[4];
          hy_conv4(u0, t0, vw0, vw1, vw2, vcb, a);
          hy_conv4(u1, t0, vw0, vw1, vw2, vcb, b);
          *(float4*)(buf + t0) = make_float4(a[0], b[0], a[1], b[1]);
          *(float4*)(buf + t0 + 2) = make_float4(a[2], b[2], a[3], b[3]);
          *(float4*)(buf + 4096 + t0) = make_float4(0.f, 0.f, 0.f, 0.f);
          *(float4*)(buf + 4096 + t0 + 2) = make_float4(0.f, 0.f, 0.f, 0.f);
        }
      } else {
        const float* u0 = z2T + ((size_t)(b0 * 512 + ch)) * 4096;
        const float* u1 = z2T + ((size_t)(b1 * 512 + ch)) * 4096;
#pragma unroll
        for (int g = 0; g < 4; ++g) {
          const int t0 = g * 1024 + tid * 4;
          const float4 a = *(const float4*)(u0 + t0);
          const float4 b = *(const float4*)(u1 + t0);
          *(float4*)(buf + t0) = make_float4(a.x, b.x, a.y, b.y);
          *(float4*)(buf + t0 + 2) = make_float4(a.z, b.z, a.w, b.w);
          *(float4*)(buf + 4096 + t0) = make_float4(0.f, 0.f, 0.f, 0.f);
          *(float4*)(buf + 4096 + t0 + 2) = make_float4(0.f, 0.f, 0.f, 0.f);
        }
      }
      fft_fwd(buf, tid, tw);
#pragma unroll
      for (int j = 0; j < 32; ++j) {
        const float2 v = buf[tid + 256 * j];
        buf[tid + 256 * j] = make_float2(v.x * Kr[j].x - v.y * Kr[j].y, v.x * Kr[j].y + v.y * Kr[j].x);
      }
      fft_inv(buf, tid, tw);
      const u16* g0 = hyT + ((size_t)(((1 + ord) * 4 + b0) * 512 + ch)) * 4096;
      const u16* g1 = hyT + ((size_t)(((1 + ord) * 4 + b1) * 512 + ch)) * 4096;
      float* o0 = z2T + ((size_t)(b0 * 512 + ch)) * 4096;
      float* o1 = z2T + ((size_t)(b1 * 512 + ch)) * 4096;
#pragma unroll
      for (int g = 0; g < 4; ++g) {
        const int t0 = g * 1024 + tid * 4;
        const float4 y01 = *(const float4*)(buf + t0);
        const float4 y23 = *(const float4*)(buf + t0 + 2);
        float ga[4], gb[4];
        hy_conv4(g0, t0, gw0, gw1, gw2, gcb, ga);
        hy_conv4(g1, t0, gw0, gw1, gw2, gcb, gb);
        *(float4*)(o0 + t0) = make_float4(ga[0] * y01.x, ga[1] * y01.z, ga[2] * y23.x, ga[3] * y23.z);
        *(float4*)(o1 + t0) = make_float4(gb[0] * y01.y, gb[1] * y01.w, gb[2] * y23.y, gb[3] * y23.w);
      }
    }
  }
  __syncthreads();
}

DI void mlstm_local_unit(const Params& p, int u, char* smem) {
  float* s_gi = (float*)smem;
  float* s_lf = s_gi + 128;
  float* s_a = s_lf + 128;
  float* s_w = s_a + 128;
  const int tid = opaque_tid(), lane = tid & 63, wave = tid >> 6, lr = lane & 31, hh = lane >> 5;
  const int j = u & 31, dir = (u >> 5) & 1, bh = u >> 6, h = bh & 3, b = bh >> 2;
  const int T0 = b * 4096 + j * 128;
  const float* gates = (const float*)(p.ws + OFF_GATES);
  const u16* vT = (const u16*)(p.ws + OFF_VT);
  const u16* kaT = (const u16*)(p.ws + OFF_KAT);
  float* CL = p.out;
  float* nl = (float*)(p.ws + OFF_NL);
  float* mloc = (float*)(p.ws + OFF_MLOC);
  float* gsum = (float*)(p.ws + OFF_GSUM);
  __syncthreads();
  if (tid < 128) {
    const int T = T0 + tid;
    s_gi[tid] = gates[(size_t)T * 16 + dir * 8 + h] + p.b_gates[dir * 8 + h];
    s_lf[tid] = log_sigmoid(gates[(size_t)T * 16 + dir * 8 + 4 + h] + p.b_gates[dir * 8 + 4 + h]);
  }
  __syncthreads();
  float gtot = 0.f;
  if (tid < 128) {
    float pre = 0.f;
#pragma unroll 4
    for (int m = 0; m < 128; ++m) {
      const float v = s_lf[m];
      if (m < tid) pre += v;
      gtot += v;
    }
    s_a[tid] = (dir == 0) ? (gtot - pre - s_lf[tid] + s_gi[tid]) : (pre + s_gi[tid]);
  }
  __syncthreads();
  if (tid < 128) {
    float mx = -3.0e38f;
#pragma unroll 4
    for (int m = 0; m < 128; ++m) mx = fmaxf(mx, s_a[m]);
    s_w[tid] = expf(s_a[tid] - mx);
    if (tid == 0) { mloc[u] = mx; gsum[u] = gtot; }
  }
  __syncthreads();
  f32x16 acc[4];
#pragma unroll
  for (int d = 0; d < 4; ++d)
#pragma unroll
    for (int r = 0; r < 16; ++r) acc[d][r] = 0.f;
  const u16* vrow = vT + ((size_t)(bh * 128 + wave * 32 + lr)) * 4096 + j * 128 + hh * 8;
  const u16* kbase = kaT + ((size_t)(bh * 128 + lr)) * 4096 + j * 128 + hh * 8;
#pragma unroll 4
  for (int ks = 0; ks < 8; ++ks) {
    const bf16x8 av = *(const bf16x8*)(vrow + ks * 16);
    bf16x8 a;
#pragma unroll
    for (int i = 0; i < 8; ++i) a[i] = (short)f2bf(bf2f((u16)av[i]) * s_w[ks * 16 + hh * 8 + i]);
#pragma unroll
    for (int dt = 0; dt < 4; ++dt) {
      const bf16x8 bk = *(const bf16x8*)(kbase + (size_t)(dt * 32) * 4096 + ks * 16);
      acc[dt] = MFMA(a, bk, acc[dt]);
    }
  }
  float* dst = CL + (size_t)u * 16384;
#pragma unroll
  for (int dt = 0; dt < 4; ++dt)
#pragma unroll
    for (int r = 0; r < 16; ++r) dst[(wave * 32 + crow(r, hh)) * 128 + dt * 32 + lr] = acc[dt][r];
  if (tid < 128) {
    const u16* kr = kaT + ((size_t)(bh * 128 + tid)) * 4096 + j * 128;
    float s = 0.f;
#pragma unroll 2
    for (int l = 0; l < 128; l += 8) {
      const bf16x8 kv = *(const bf16x8*)(kr + l);
#pragma unroll
      for (int i = 0; i < 8; ++i) s += s_w[l + i] * bf2f((u16)kv[i]);
    }
    nl[(size_t)u * 128 + tid] = s;
  }
}

DI void scan_unit(const Params& p, int unit) {
  const int tid = opaque_tid();
  const int sc = unit >> 4, part = unit & 15, dir = sc & 1;
  float* CL = p.out;
  float* nl = (float*)(p.ws + OFF_NL);
  const float* mloc = (const float*)(p.ws + OFF_MLOC);
  const float* gsum = (const float*)(p.ws + OFF_GSUM);
  float* ms = (float*)(p.ws + OFF_MS);
  const int idx = part * 1024 + tid * 4;
  float4 C = make_float4(0.f, 0.f, 0.f, 0.f);
  float nst = 0.f, m = 0.f;
  const bool do_n = (part == 0) && (tid < 128);
  float4 pf[4];
#pragma unroll
  for (int q = 0; q < 4; ++q) {
    const int jj = dir ? 31 - q : q;
    pf[q] = *(const float4*)(CL + (size_t)(sc * 32 + jj) * 16384 + idx);
  }
#pragma unroll 1
  for (int c0 = 0; c0 < 32; c0 += 4) {
#pragma unroll
    for (int q = 0; q < 4; ++q) {
      const int c = c0 + q;
      const int jj = dir ? 31 - c : c;
      const int u = sc * 32 + jj;
      const float4 cl = pf[q];
      *(float4*)(CL + (size_t)u * 16384 + idx) = C;
      if (c + 4 < 32) {
        const int j2 = dir ? 31 - (c + 4) : (c + 4);
        pf[q] = *(const float4*)(CL + (size_t)(sc * 32 + j2) * 16384 + idx);
      }
      const float g = gsum[u], ml = mloc[u];
      const float mn = fmaxf(g + m, ml);
      const float dec = expf(g + m - mn), scl = expf(ml - mn);
      C.x = dec * C.x + scl * cl.x; C.y = dec * C.y + scl * cl.y; C.z = dec * C.z + scl * cl.z; C.w = dec * C.w + scl * cl.w;
      if (do_n) {
        const float nv = nl[(size_t)u * 128 + tid];
        nl[(size_t)u * 128 + tid] = nst;
        nst = dec * nst + scl * nv;
      }
      if (part == 0 && tid == 0) ms[u] = m;
      m = mn;
    }
  }
}

template <int DIR>
DI void mlstm_dir(const Params& p, int bh, int j, char* smem, f32x16 (&hs)[4]) {
  float* s_gi = (float*)smem;
  float* s_lf = s_gi + 128;
  float* s_bc = s_lf + 128;
  float* s_r = s_bc + 128;
  float* s_al = s_r + 128;
  float* s_fl = s_al + 128;
  float* s_is = s_fl + 128;
  const int tid = opaque_tid(), lane = tid & 63, wave = tid >> 6, lr = lane & 31, hh = lane >> 5;
  u16* Pl = (u16*)(smem + 4096) + wave * (32 * 136);
  const int h = bh & 3, b = bh >> 2;
  const int T0 = b * 4096 + j * 128;
  const float* gates = (const float*)(p.ws + OFF_GATES);
  const u16* qa = (const u16*)(p.ws + OFF_QA);
  const u16* ka = (const u16*)(p.ws + OFF_KA);
  const u16* vT = (const u16*)(p.ws + OFF_VT);
  const float* CS = p.out;
  const float* ns = (const float*)(p.ws + OFF_NL);
  const float* ms = (const float*)(p.ws + OFF_MS);
  u16* A2 = (u16*)(p.ws + OFF_A2);
  bf16x8 ones;
#pragma unroll
  for (int i = 0; i < 8; ++i) ones[i] = (short)0x3F80;
  const u16* qrow = qa + (size_t)(T0 + wave * 32 + lr) * 512 + h * 128 + hh * 8;
  const int u = (bh * 2 + DIR) * 32 + j;
  const float msu = ms[u];
  __syncthreads();
  if (tid < 128) {
    const int T = T0 + tid;
    s_gi[tid] = gates[(size_t)T * 16 + DIR * 8 + h] + p.b_gates[DIR * 8 + h];
    s_lf[tid] = log_sigmoid(gates[(size_t)T * 16 + DIR * 8 + 4 + h] + p.b_gates[DIR * 8 + 4 + h]);
  }
  __syncthreads();
  if (tid < 128) {
    float a = 0.f;
#pragma unroll 4
    for (int m = 0; m < 128; ++m) {
      const bool in = (DIR == 0) ? (m <= tid) : (m >= tid);
      a += in ? s_lf[m] : 0.f;
    }
    s_bc[tid] = a;
    s_r[tid] = s_gi[tid] - a;
  }
  __syncthreads();
  if (tid < 128) {
    float cm = -3.0e38f;
#pragma unroll 4
    for (int m = 0; m < 128; ++m) {
      const bool in = (DIR == 0) ? (m <= tid) : (m >= tid);
      cm = in ? fmaxf(cm, s_r[m]) : cm;
    }
    const float bc = s_bc[tid];
    const float mt = bc + fmaxf(msu, cm);
    s_al[tid] = bc - mt;
    s_fl[tid] = expf(-mt);
    s_is[tid] = expf(bc + msu - mt);
  }
  __syncthreads();
  {
    f32x16 S[4];
#pragma unroll
    for (int st = 0; st < 4; ++st)
#pragma unroll
      for (int r = 0; r < 16; ++r) S[st][r] = 0.f;
    const u16* kbase = ka + (size_t)(T0 + lr) * 512 + h * 128 + hh * 8;
#pragma unroll 4
    for (int ks = 0; ks < 8; ++ks) {
      const bf16x8 a = *(const bf16x8*)(qrow + ks * 16);
#pragma unroll
      for (int st = 0; st < 4; ++st) {
        const bf16x8 bk = *(const bf16x8*)(kbase + (size_t)(st * 32) * 512 + ks * 16);
        S[st] = MFMA(a, bk, S[st]);
      }
    }
#pragma unroll
    for (int st = 0; st < 4; ++st) {
      const int sl = st * 32 + lr;
      const float rs = s_r[sl];
#pragma unroll
      for (int r = 0; r < 16; ++r) {
        const int tl = wave * 32 + crow(r, hh);
        const bool valid = (DIR == 0) ? (sl <= tl) : (sl >= tl);
        const float pv = valid ? S[st][r] * __expf(s_al[tl] + rs) : 0.f;
        Pl[crow(r, hh) * 136 + sl] = f2bf(pv);
      }
    }
  }
  __syncthreads();
#pragma unroll
  for (int eh = 0; eh < 2; ++eh) {
    f32x16 N[3];
#pragma unroll
    for (int e = 0; e < 3; ++e)
#pragma unroll
      for (int r = 0; r < 16; ++r) N[e][r] = 0.f;
    {
      const u16* vbase = vT + ((size_t)(bh * 128 + eh * 64 + lr)) * 4096 + j * 128 + hh * 8;
#pragma unroll 4
      for (int ks = 0; ks < 8; ++ks) {
        const bf16x8 a = *(const bf16x8*)(Pl + lr * 136 + ks * 16 + hh * 8);
#pragma unroll
        for (int e2 = 0; e2 < 2; ++e2) {
          const bf16x8 bv = *(const bf16x8*)(vbase + (size_t)(e2 * 32) * 4096 + ks * 16);
          N[e2] = MFMA(a, bv, N[e2]);
        }
        N[2] = MFMA(a, ones, N[2]);
      }
    }
    {
      const float isc = s_is[wave * 32 + lr];
      const float* cbase = CS + (size_t)u * 16384 + (size_t)(eh * 64 + lr) * 128 + hh * 8;
      const float* nbase = ns + (size_t)u * 128 + hh * 8;
#pragma unroll 4
      for (int ks = 0; ks < 8; ++ks) {
        const bf16x8 aq = *(const bf16x8*)(qrow + ks * 16);
        const bf16x8 a = scale8(aq, isc);
#pragma unroll
        for (int e2 = 0; e2 < 2; ++e2) {
          const float4 c0 = *(const float4*)(cbase + (size_t)(e2 * 32) * 128 + ks * 16);
          const float4 c1 = *(const float4*)(cbase + (size_t)(e2 * 32) * 128 + ks * 16 + 4);
          const float cv[8] = {c0.x, c0.y, c0.z, c0.w, c1.x, c1.y, c1.z, c1.w};
          N[e2] = MFMA(a, pack8(cv), N[e2]);
        }
        const float4 n0 = *(const float4*)(nbase + ks * 16);
        const float4 n1 = *(const float4*)(nbase + ks * 16 + 4);
        const float nv[8] = {n0.x, n0.y, n0.z, n0.w, n1.x, n1.y, n1.z, n1.w};
        N[2] = MFMA(a, pack8(nv), N[2]);
      }
    }
    u16* park = (u16*)(p.ws + OFF_HYT) + ((size_t)(bh * 32 + j) * 256 + tid) * 64 + eh * 32;
    bf16x8 pk[4];
    if (DIR == 1) {
#pragma unroll
      for (int q = 0; q < 4; ++q) pk[q] = *(const bf16x8*)(park + q * 8);
    }
#pragma unroll
    for (int r = 0; r < 16; ++r) {
      const int tl = wave * 32 + crow(r, hh);
      const float den = fmaxf(fabsf(N[2][r]), s_fl[tl]);
      const float inv = 1.f / den;
#pragma unroll
      for (int e2 = 0; e2 < 2; ++e2) {
        const float hv = N[e2][r] * inv;
        const int v = e2 * 16 + r;
        if (DIR == 0) pk[v >> 3][v & 7] = (short)f2bf(hv);
        else hs[eh * 2 + e2][r] = hv + bf2f((u16)pk[v >> 3][v & 7]);
      }
    }
    if (DIR == 0) {
#pragma unroll
      for (int q = 0; q < 4; ++q) *(bf16x8*)(park + q * 8) = pk[q];
    }
  }
}

DI void mlstm_out_unit(const Params& p, int unit, char* smem) {
  const int tid = opaque_tid(), lane = tid & 63, wave = tid >> 6, lr = lane & 31, hh = lane >> 5;
  const int j = unit & 31, bh = unit >> 5, h = bh & 3, b = bh >> 2;
  const int T0 = b * 4096 + j * 128;
  const u16* og = (const u16*)(p.ws + OFF_OG);
  u16* A2 = (u16*)(p.ws + OFF_A2);
  f32x16 hs[4];
  mlstm_dir<0>(p, bh, j, smem, hs);
  mlstm_dir<1>(p, bh, j, smem, hs);
  __syncthreads();
  float* wl = (float*)(smem + wave * 16384);
#pragma unroll
  for (int et = 0; et < 4; ++et)
#pragma unroll
    for (int r = 0; r < 16; ++r) wl[crow(r, hh) * 128 + et * 32 + lr] = hs[et][r];
  wave_lds_sync();
  {
    const int row = lane >> 1, half = lane & 1;
    const size_t T = (size_t)(T0 + wave * 32 + row);
    const u16* ogp = og + T * 512 + h * 128 + half * 64;
    const float* src = wl + row * 128 + half * 64;
    float g[64];
    float ss = 0.f;
#pragma unroll
    for (int q = 0; q < 8; ++q) {
      const bf16x8 o8 = *(const bf16x8*)(ogp + q * 8);
      const float4 h0 = *(const float4*)(src + q * 8), h1 = *(const float4*)(src + q * 8 + 4);
      g[q * 8 + 0] = h0.x * bf2f((u16)o8[0]); g[q * 8 + 1] = h0.y * bf2f((u16)o8[1]); g[q * 8 + 2] = h0.z * bf2f((u16)o8[2]); g[q * 8 + 3] = h0.w * bf2f((u16)o8[3]);
      g[q * 8 + 4] = h1.x * bf2f((u16)o8[4]); g[q * 8 + 5] = h1.y * bf2f((u16)o8[5]); g[q * 8 + 6] = h1.z * bf2f((u16)o8[6]); g[q * 8 + 7] = h1.w * bf2f((u16)o8[7]);
#pragma unroll
      for (int i = 0; i < 8; ++i) ss += g[q * 8 + i] * g[q * 8 + i];
    }
    ss += __shfl_xor(ss, 1, 64);
    const float rs = rsqrtf(ss * (1.f / 128.f) + EPS);
    const float* mw = p.mlstm_norm_w + h * 128 + half * 64;
    u16* dst = A2 + T * 1024 + h * 128 + half * 64;
#pragma unroll
    for (int q = 0; q < 8; ++q) {
      const float4 w0 = *(const float4*)(mw + q * 8), w1 = *(const float4*)(mw + q * 8 + 4);
      float o[8];
      o[0] = g[q * 8 + 0] * rs * w0.x; o[1] = g[q * 8 + 1] * rs * w0.y; o[2] = g[q * 8 + 2] * rs * w0.z; o[3] = g[q * 8 + 3] * rs * w0.w;
      o[4] = g[q * 8 + 4] * rs * w1.x; o[5] = g[q * 8 + 5] * rs * w1.y; o[6] = g[q * 8 + 6] * rs * w1.z; o[7] = g[q * 8 + 7] * rs * w1.w;
      *(bf16x8*)(dst + q * 8) = pack8(o);
    }
  }
}

DI void hyena_norm_unit(const Params& p, int unit, char* smem) {
  float* tile = (float*)smem;
  const int tid = opaque_tid();
  const int tt = unit & 63, g = (unit >> 6) & 7, b = unit >> 9;
  const float* z2T = (const float*)(p.ws + OFF_Z2T);
  u16* A2 = (u16*)(p.ws + OFF_A2);
  __syncthreads();
#pragma unroll 4
  for (int i = 0; i < 16; ++i) {
    const int cl = (tid >> 6) + 4 * i, tl = tid & 63;
    tile[cl * 65 + tl] = z2T[((size_t)(b * 512 + g * 64 + cl)) * 4096 + tt * 64 + tl];
  }
  __syncthreads();
  const int tl = tid >> 2, qd = tid & 3;
  float v[16];
  float ss = 0.f;
#pragma unroll
  for (int i = 0; i < 16; ++i) {
    v[i] = tile[(qd * 16 + i) * 65 + tl];
    ss += v[i] * v[i];
  }
  ss += __shfl_xor(ss, 1, 64);
  ss += __shfl_xor(ss, 2, 64);
  const float rs = rsqrtf(ss * (1.f / 64.f) + EPS);
  const size_t T = (size_t)b * 4096 + tt * 64 + tl;
  u16* dst = A2 + T * 1024 + 512 + g * 64 + qd * 16;
  const float* w = p.hyena_norm_w + g * 64 + qd * 16;
  float o[16];
#pragma unroll
  for (int i = 0; i < 16; ++i) o[i] = v[i] * rs * w[i];
  *(bf16x8*)(dst) = pack8(o);
  *(bf16x8*)(dst + 8) = pack8(o + 8);
}

template <int EPI>
DI void gemm_phase(const u16* A, const u16* Bt, int K, int ntn, void* outp, char* smem) {
  const int tid = threadIdx.x, lane = tid & 63, wave = tid >> 6, wr = wave >> 1, wc = wave & 1, lr = lane & 31, hh = lane >> 5;
  const int ntiles = tile_count(ntn);
  for (int id = blockIdx.x; id < ntiles; id += gridDim.x) {
    int mt, nt;
    tile_map(id, ntn, mt, nt);
    if (nt >= ntn) continue;
    const int m0 = mt * 256, n0 = nt * 128;
    f32x16 acc[4][2];
    gemm_core<false>(A, Bt, K, m0, n0, smem, acc);
    if (EPI == 0) {
#pragma unroll
      for (int i = 0; i < 4; ++i)
#pragma unroll
        for (int j = 0; j < 2; ++j)
#pragma unroll
          for (int r = 0; r < 16; ++r) {
            const int row = m0 + wr * 128 + i * 32 + crow(r, hh);
            const int col = n0 + wc * 64 + j * 32 + lr;
            ((float*)outp)[(size_t)row * 1024 + col] = acc[i][j][r];
          }
    } else {
      char* wl = smem + wave * 16384;
      stage_tile_ns<2>(acc, wl, lr, hh);
      wave_lds_sync();
      flush_tile_ns(wl, (u16*)outp + (size_t)(m0 + wr * 128) * 4096 + n0 + wc * 64, 4096, lane);
    }
  }
}

DI void phase_post_mix(const Params& p) {
  const int tid = threadIdx.x, lane = tid & 63, wave = tid >> 6;
  const float* mix = p.out;
  float* x1 = (float*)(p.ws + OFF_X1);
  u16* hm = (u16*)(p.ws + OFF_HM);
  for (int u = blockIdx.x; u < 1024; u += gridDim.x) {
#pragma unroll 2
    for (int rr = 0; rr < 4; ++rr) {
      const size_t row = (size_t)u * 16 + wave * 4 + rr;
      float4 mv[4], xv[4];
      float ss = 0.f;
#pragma unroll
      for (int i = 0; i < 4; ++i) {
        mv[i] = ((const float4*)(mix + row * DM))[lane + 64 * i];
        xv[i] = ((const float4*)(p.x + row * DM))[lane + 64 * i];
        ss += mv[i].x * mv[i].x + mv[i].y * mv[i].y + mv[i].z * mv[i].z + mv[i].w * mv[i].w;
      }
      ss = wave_sum(ss);
      const float rs = rsqrtf(ss * (1.f / DM) + EPS);
      float s2 = 0.f;
#pragma unroll
      for (int i = 0; i < 4; ++i) {
        const float4 w = ((const float4*)p.norm_mix_post)[lane + 64 * i];
        xv[i].x += mv[i].x * rs * w.x; xv[i].y += mv[i].y * rs * w.y; xv[i].z += mv[i].z * rs * w.z; xv[i].w += mv[i].w * rs * w.w;
        s2 += xv[i].x * xv[i].x + xv[i].y * xv[i].y + xv[i].z * xv[i].z + xv[i].w * xv[i].w;
        ((float4*)(x1 + row * DM))[lane + 64 * i] = xv[i];
      }
      s2 = wave_sum(s2);
      const float r2 = rsqrtf(s2 * (1.f / DM) + EPS);
#pragma unroll
      for (int i = 0; i < 4; ++i) {
        const float4 w = ((const float4*)p.norm_mlp_pre)[lane + 64 * i];
        ushort4 o;
        o.x = f2bf(xv[i].x * r2 * w.x); o.y = f2bf(xv[i].y * r2 * w.y); o.z = f2bf(xv[i].z * r2 * w.z); o.w = f2bf(xv[i].w * r2 * w.w);
        *(ushort4*)(hm + row * DM + (lane + 64 * i) * 4) = o;
      }
    }
  }
}

DI void phase_final(const Params& p) {
  const int tid = threadIdx.x, lane = tid & 63, wave = tid >> 6;
  const float* x1 = (const float*)(p.ws + OFF_X1);
  for (int u = blockIdx.x; u < 1024; u += gridDim.x) {
#pragma unroll 2
    for (int rr = 0; rr < 4; ++rr) {
      const size_t row = (size_t)u * 16 + wave * 4 + rr;
      float4 fv[4];
      float ss = 0.f;
#pragma unroll
      for (int i = 0; i < 4; ++i) {
        fv[i] = ((const float4*)(p.out + row * DM))[lane + 64 * i];
        ss += fv[i].x * fv[i].x + fv[i].y * fv[i].y + fv[i].z * fv[i].z + fv[i].w * fv[i].w;
      }
      ss = wave_sum(ss);
      const float rs = rsqrtf(ss * (1.f / DM) + EPS);
#pragma unroll
      for (int i = 0; i < 4; ++i) {
        const float4 w = ((const float4*)p.norm_mlp_post)[lane + 64 * i];
        const float4 xv = ((const float4*)(x1 + row * DM))[lane + 64 * i];
        float4 o;
        o.x = xv.x + fv[i].x * rs * w.x; o.y = xv.y + fv[i].y * rs * w.y; o.z = xv.z + fv[i].z * rs * w.z; o.w = xv.w + fv[i].w * rs * w.w;
        ((float4*)(p.out + row * DM))[lane + 64 * i] = o;
      }
    }
  }
}

DI void run_phase(const Params& p, int ph, char* smem) {
  switch (ph) {
    case 0: phase0(p, smem); break;
    case 1: phase1(p, smem); break;
    case 2: phase_qk(p, smem); break;
    case 3:
#ifdef DBL_HYONLY
      for (int u = blockIdx.x; u < 512; u += gridDim.x) hyena_unit(p, u, smem);
#endif
#ifdef DBL_MLONLY
      for (int u = blockIdx.x; u < 1024; u += gridDim.x) mlstm_local_unit(p, u, smem);
#endif
      for (int u = blockIdx.x; u < 512 + 1024; u += gridDim.x) {
        if (u < 512) hyena_unit(p, u, smem);
        else mlstm_local_unit(p, u - 512, smem);
      }
      break;
    case 4:
      for (int u = blockIdx.x; u < 512; u += gridDim.x) scan_unit(p, u);
      break;
    case 5:
      for (int u = blockIdx.x; u < 512 + 2048; u += gridDim.x) {
#ifndef DBG_SKIP_MLSTM
        if (u < 512) mlstm_out_unit(p, u, smem);
#else
        if (u < 512) { u16* A2 = (u16*)(p.ws + OFF_A2); const int T0 = (u >> 5 >> 2) * 4096 + (u & 31) * 128, hq = (u >> 5) & 3;
          for (int i = threadIdx.x; i < 128 * 128; i += 256) A2[(size_t)(T0 + (i >> 7)) * 1024 + hq * 128 + (i & 127)] = 0; }
#endif
#ifndef DBG_SKIP_HYENA
        else hyena_norm_unit(p, u - 512, smem);
#else
        else { const int un = u - 512; const int tt = un & 63, g = (un >> 6) & 7, b = un >> 9; u16* A2 = (u16*)(p.ws + OFF_A2);
          for (int i = threadIdx.x; i < 64 * 64; i += 256) A2[((size_t)b * 4096 + tt * 64 + (i >> 6)) * 1024 + 512 + g * 64 + (i & 63)] = 0x3F80; }
#endif
      }
      break;
    case 6: gemm_phase<0>((const u16*)(p.ws + OFF_A2), (const u16*)(p.ws + OFF_WOUTT), 1024, 8, p.out, smem); break;
    case 7: phase_post_mix(p); break;
    case 8: gemm_phase<1>((const u16*)(p.ws + OFF_HM), (const u16*)(p.ws + OFF_W1T), 1024, 32, p.ws + OFF_H, smem); break;
    case 9: gemm_phase<0>((const u16*)(p.ws + OFF_H), (const u16*)(p.ws + OFF_W2T), 4096, 8, p.out, smem); break;
    case 10: phase_final(p); break;
  }
}
constexpr int NPHASE = 11;

#define XB_XCNT(j)  (256  + 64 * (j))
#define XB_XSUB(j)  (1280 + 64 * (j))
#define XB_XGEN(j)  (2304 + 64 * (j))
#define XB_TOP      3328
#define XB_TOPGEN   3392
#define XCD_BAR_WORDS 3456
DI unsigned xb_ld(unsigned* p) { return __hip_atomic_load(p, __ATOMIC_RELAXED, __HIP_MEMORY_SCOPE_AGENT); }
DI unsigned xb_add(unsigned* p, unsigned v) { return __hip_atomic_fetch_add(p, v, __ATOMIC_RELAXED, __HIP_MEMORY_SCOPE_AGENT); }
DI unsigned xb_xcc_id() { return (unsigned)__builtin_amdgcn_s_getreg((3 << 11) | 20) & 0xFu; }
struct XcdBar { unsigned* bar; unsigned x, nloc, nx; };
DI void xcd_barrier(XcdBar& b) {
  asm volatile("s_waitcnt vmcnt(0)" ::: "memory");
  __syncthreads();
  if (threadIdx.x == 0) {
    unsigned* bar = b.bar;
    __builtin_amdgcn_s_waitcnt(0);
    if (b.nloc == 0u) {
      const unsigned G = gridDim.x;
      unsigned sum, cnt, mine;
      for (;;) {
        sum = 0u; cnt = 0u; mine = 0u;
#pragma unroll
        for (unsigned j = 0; j < 16; ++j) { const unsigned c = xb_ld(&bar[XB_XCNT(j)]); sum += c; cnt += (c > 0u) ? 1u : 0u; mine = (j == b.x) ? c : mine; }
        if (sum == G) break;
        __builtin_amdgcn_s_sleep(1);
      }
      b.nloc = mine > 0u ? mine : 1u; b.nx = cnt > 0u ? cnt : 1u;
    }
    const unsigned nloc = b.nloc, nx = b.nx;
    const unsigned old = xb_add(&bar[XB_XSUB(b.x)], 1u);
    const unsigned gen = old / nloc;
    if (old + 1u == (gen + 1u) * nloc) {
      __builtin_amdgcn_fence(__ATOMIC_RELEASE, "agent");
      asm volatile("s_waitcnt vmcnt(0)" ::: "memory");
      const unsigned og = xb_add(&bar[XB_TOP], 1u);
      const unsigned tg = og / nx;
      if (og + 1u == (tg + 1u) * nx) xb_add(&bar[XB_TOPGEN], 1u);
      else while (xb_ld(&bar[XB_TOPGEN]) == tg) __builtin_amdgcn_s_sleep(1);
      __builtin_amdgcn_fence(__ATOMIC_ACQUIRE, "agent");
      xb_add(&bar[XB_XGEN(b.x)], 1u);
      asm volatile("s_waitcnt vmcnt(0)" ::: "memory");
    } else {
      while (xb_ld(&bar[XB_XGEN(b.x)]) == gen) __builtin_amdgcn_s_sleep(1);
      __builtin_amdgcn_fence(__ATOMIC_ACQUIRE, "agent");
      asm volatile("s_waitcnt vmcnt(0)" ::: "memory");
    }
  }
  __syncthreads();
}

#if MULTI_LAUNCH
template <int PH>
__global__ void __launch_bounds__(256, 2) phase_kernel(Params p) {
  __shared__ __attribute__((aligned(16))) char smem[65536];
  run_phase(p, PH, smem);
}
template <int PH>
static void launch_phase(const Params& p, hipStream_t stream) {
  hipLaunchKernelGGL(phase_kernel<PH>, dim3(512), dim3(256), 0, stream, p);
}
#else
__global__ void __launch_bounds__(256, 2) mega_kernel(Params p) {
  __shared__ __attribute__((aligned(16))) char smem[65536];
  cg::grid_group grid = cg::this_grid();
  XcdBar xb;
  xb.bar = (unsigned*)(p.ws + OFF_BAR); xb.x = xb_xcc_id(); xb.nloc = 0u; xb.nx = 0u;
  if (p.ws == nullptr) grid.sync();
  if (threadIdx.x == 0) (void)xb_add(&xb.bar[XB_XCNT(xb.x)], 1u);
#define GSYNC xcd_barrier(xb)
#ifdef DBL_P0
  run_phase(p, 0, smem);
#endif
  run_phase(p, 0, smem); GSYNC;
  run_phase(p, 1, smem); GSYNC;
#ifdef DBL_GEMM
  run_phase(p, 1, smem); grid.sync();
#endif
  run_phase(p, 2, smem); GSYNC;
#ifdef DBL_P2
  run_phase(p, 2, smem); GSYNC;
#endif
  run_phase(p, 3, smem); GSYNC;
#ifdef DBL_HY
  run_phase(p, 3, smem); GSYNC;
#endif
  run_phase(p, 4, smem); GSYNC;
  run_phase(p, 5, smem); GSYNC;
#ifdef DBL_P5
  run_phase(p, 5, smem); GSYNC;
#endif
  run_phase(p, 6, smem); GSYNC;
#ifdef DBL_GEMM
  run_phase(p, 6, smem); GSYNC;
#endif
  run_phase(p, 7, smem); GSYNC;
#ifdef DBL_P7
  run_phase(p, 7, smem); GSYNC;
#endif
  run_phase(p, 8, smem); GSYNC;
#ifdef DBL_GEMM
  run_phase(p, 8, smem); GSYNC;
#endif
  run_phase(p, 9, smem); GSYNC;
#ifdef DBL_GEMM
  run_phase(p, 9, smem); GSYNC;
#endif
#ifdef XSYNC
  for (int q = 0; q < 10; ++q) GSYNC;
#endif
  run_phase(p, 10, smem);
}
#endif

extern "C" void kernel_launch(void* const* d_in, const int* in_sizes, int n_in, void* d_out, int out_size, void* d_ws,
                              size_t ws_size, hipStream_t stream) {
  Params p{};
  const float** pp = (const float**)&p;
  for (int i = 0; i < 23; ++i) pp[i] = (const float*)d_in[i];
  p.out = (float*)d_out;
  p.ws = (char*)d_ws;
#if MULTI_LAUNCH
  launch_phase<0>(p, stream);
#ifdef DBL_P0
  launch_phase<0>(p, stream);
#endif
 launch_phase<1>(p, stream); launch_phase<2>(p, stream); launch_phase<3>(p, stream);
#ifdef DBL_HY
  launch_phase<3>(p, stream);
#endif

  launch_phase<4>(p, stream); launch_phase<5>(p, stream);
#ifdef DBL_P5
  launch_phase<5>(p, stream);
#endif
 launch_phase<6>(p, stream); launch_phase<7>(p, stream);
  launch_phase<8>(p, stream); launch_phase<9>(p, stream); launch_phase<10>(p, stream);
#else
  static int grid_blocks = 0;
  if (!grid_blocks) {
    int dev = 0, cus = 0, per_cu = 0;
    hipGetDevice(&dev);
    hipDeviceGetAttribute(&cus, hipDeviceAttributeMultiprocessorCount, dev);
    hipOccupancyMaxActiveBlocksPerMultiprocessor(&per_cu, mega_kernel, 256, 0);
    if (per_cu > 2) per_cu = 2;
    if (per_cu < 1) per_cu = 1;
#ifdef FORCE2
    per_cu = 2;
#endif
    grid_blocks = cus * per_cu;
  }
  hipMemsetAsync((char*)d_ws + OFF_BAR, 0, XCD_BAR_WORDS * 4, stream);
  void* args[] = {&p};
  hipError_t e = hipLaunchCooperativeKernel((void*)mega_kernel, dim3(grid_blocks), dim3(256), args, 0, stream);
  if (e != hipSuccess) fprintf(stderr, "cooperative launch failed: %s (grid %d)\n", hipGetErrorString(e), grid_blocks);
#endif
}
#if defined(__HIP_DEVICE_COMPILE__)
#pragma clang attribute pop
#endif
```

```cpp
#if defined(__HIP_DEVICE_COMPILE__)
#pragma clang attribute push(__attribute__((target("no-packed-fp32-ops"))), apply_to = function)
#endif
#include <hip/hip_runtime.h>
#include <hip/hip_cooperative_groups.h>
#include <cstdio>
namespace cg = cooperative_groups;

#ifndef MULTI_LAUNCH
#define MULTI_LAUNCH 0
#endif

typedef unsigned short u16;
using bf16x8 = __attribute__((ext_vector_type(8))) short;
using f32x16 = __attribute__((ext_vector_type(16))) float;
#define DI __device__ __forceinline__
#define MFMA(a, b, c) __builtin_amdgcn_mfma_f32_32x32x16_bf16((a), (b), (c), 0, 0, 0)

constexpr int SEQ = 4096, DM = 1024, NTOK = 16384, NIN = 3600, NINP = 3712, DFF = 4096;
constexpr float EPS = 1e-6f;
constexpr size_t MiB = 1u << 20;
constexpr size_t OFF_WINT = 0, OFF_WOUTT = 8 * MiB, OFF_W1T = 10 * MiB, OFF_W2T = 18 * MiB;
constexpr size_t OFF_XN = 26 * MiB, OFF_QA = 26 * MiB, OFF_KA = 42 * MiB;
constexpr size_t OFF_FILT = 58 * MiB, OFF_QKPRE = 90 * MiB, OFF_A2 = 90 * MiB;
constexpr size_t OFF_HYT = 122 * MiB, OFF_VT = 170 * MiB, OFF_OG = 186 * MiB, OFF_GATES = 202 * MiB;
constexpr size_t OFF_NL = 203 * MiB, OFF_MLOC = 203 * MiB + 512 * 1024, OFF_GSUM = OFF_MLOC + 4096, OFF_MS = OFF_GSUM + 4096;
constexpr size_t OFF_KAT = 205 * MiB, OFF_Z2T = 221 * MiB;
constexpr size_t OFF_TW = 204 * MiB, OFF_BAR = 254 * MiB;
constexpr size_t OFF_X1 = 26 * MiB, OFF_HM = 90 * MiB, OFF_H = 122 * MiB;

struct Params {
  const float *x, *norm_mix_pre, *norm_mix_post, *norm_mlp_pre, *norm_mlp_post, *w_in, *b_gates, *conv_w, *conv_b,
      *mlstm_norm_w, *hyena_norm_w, *filt_w1, *filt_b1, *filt_w2, *filt_b2, *filt_w3, *filt_b3, *filt_w4, *filt_freq,
      *filt_bias, *w_out, *w_mlp_in, *w_mlp_out;
  float* out;
  char* ws;
};

DI u16 f2bf(float x) { unsigned u = __float_as_uint(x); u += 0x7fffu + ((u >> 16) & 1u); return (u16)(u >> 16); }
DI float bf2f(u16 v) { return __uint_as_float(((unsigned)v) << 16); }
DI int opaque_tid() { int t = threadIdx.x; asm volatile("" : "+v"(t)); return t; }
DI int crow(int r, int hh) { return (r & 3) + 8 * (r >> 2) + 4 * hh; }
DI float log_sigmoid(float x) { return fminf(x, 0.f) - log1pf(expf(-fabsf(x))); }
DI float sigmoidf(float x) { return 1.f / (1.f + expf(-x)); }
DI float red2pi(float x) {
  const float k = rintf(x * 0.15915494309189535f);
  float r = fmaf(-k, 6.28125f, x);
  return fmaf(-k, 1.9353071795864769e-3f, r);
}
DI float fsin(float x) { return sinf(x); }
DI float fcos(float x) { return cosf(x); }
DI bf16x8 pack8(const float* v) {
  bf16x8 r;
#pragma unroll
  for (int i = 0; i < 8; ++i) r[i] = (short)f2bf(v[i]);
  return r;
}
DI bf16x8 scale8(bf16x8 a, float s) {
  bf16x8 r;
#pragma unroll
  for (int i = 0; i < 8; ++i) r[i] = (short)f2bf(bf2f((u16)a[i]) * s);
  return r;
}

template <bool SWAP>
DI void gemm_core(const u16* __restrict__ A, const u16* __restrict__ Bt, int K, int m0, int n0, char* smem, f32x16 (&acc)[4][2]) {
  const int tid = opaque_tid(), lane = tid & 63, wave = tid >> 6, wr = wave >> 1, wc = wave & 1;
  const int lr = lane & 31, hh = lane >> 5;
#pragma unroll
  for (int i = 0; i < 4; ++i)
#pragma unroll
    for (int j = 0; j < 2; ++j)
#pragma unroll
      for (int r = 0; r < 16; ++r) acc[i][j][r] = 0.f;
  const int c = tid & 7, r0 = tid >> 3;
  const u16* Ag = A + (size_t)(m0 + r0) * K + c * 8;
  const u16* Bg = Bt + (size_t)(n0 + r0) * K + c * 8;
  const int soff = r0 * 128 + ((c ^ ((r0 >> 1) & 7)) << 4);
  char* As = smem;
  char* Bs = smem + 32768;
  uint4 ra0, ra1, ra2, ra3, ra4, ra5, ra6, ra7, rb0, rb1, rb2, rb3;
#define GLOAD_ALL(k0)                                                                                             \
  ra0 = *(const uint4*)(Ag + (size_t)(0) * K + (k0));   ra1 = *(const uint4*)(Ag + (size_t)(32) * K + (k0));      \
  ra2 = *(const uint4*)(Ag + (size_t)(64) * K + (k0));  ra3 = *(const uint4*)(Ag + (size_t)(96) * K + (k0));      \
  ra4 = *(const uint4*)(Ag + (size_t)(128) * K + (k0)); ra5 = *(const uint4*)(Ag + (size_t)(160) * K + (k0));     \
  ra6 = *(const uint4*)(Ag + (size_t)(192) * K + (k0)); ra7 = *(const uint4*)(Ag + (size_t)(224) * K + (k0));     \
  rb0 = *(const uint4*)(Bg + (size_t)(0) * K + (k0));   rb1 = *(const uint4*)(Bg + (size_t)(32) * K + (k0));      \
  rb2 = *(const uint4*)(Bg + (size_t)(64) * K + (k0));  rb3 = *(const uint4*)(Bg + (size_t)(96) * K + (k0));
  GLOAD_ALL(0)
  const int nk = K >> 6;
#pragma unroll 1
  for (int kt = 0; kt < nk; ++kt) {
    __syncthreads();
    *(uint4*)(As + soff + 0 * 4096) = ra0; *(uint4*)(As + soff + 1 * 4096) = ra1; *(uint4*)(As + soff + 2 * 4096) = ra2; *(uint4*)(As + soff + 3 * 4096) = ra3;
    *(uint4*)(As + soff + 4 * 4096) = ra4; *(uint4*)(As + soff + 5 * 4096) = ra5; *(uint4*)(As + soff + 6 * 4096) = ra6; *(uint4*)(As + soff + 7 * 4096) = ra7;
    *(uint4*)(Bs + soff + 0 * 4096) = rb0; *(uint4*)(Bs + soff + 1 * 4096) = rb1; *(uint4*)(Bs + soff + 2 * 4096) = rb2; *(uint4*)(Bs + soff + 3 * 4096) = rb3;
    __syncthreads();
    if (kt + 1 < nk) {
      const int k0 = (kt + 1) << 6;
      GLOAD_ALL(k0)
    }
#pragma unroll
    for (int kk = 0; kk < 4; ++kk) {
      bf16x8 a[4], b[2];
      const int cc = kk * 2 + hh;
#pragma unroll
      for (int i = 0; i < 4; ++i) {
        const int r = wr * 128 + i * 32 + lr;
        a[i] = *(const bf16x8*)(As + r * 128 + ((cc ^ ((r >> 1) & 7)) << 4));
      }
#pragma unroll
      for (int j = 0; j < 2; ++j) {
        const int r = wc * 64 + j * 32 + lr;
        b[j] = *(const bf16x8*)(Bs + r * 128 + ((cc ^ ((r >> 1) & 7)) << 4));
      }
#pragma unroll
      for (int i = 0; i < 4; ++i)
#pragma unroll
        for (int j = 0; j < 2; ++j) acc[i][j] = SWAP ? MFMA(b[j], a[i], acc[i][j]) : MFMA(a[i], b[j], acc[i][j]);
    }
  }
  __syncthreads();
}

DI void tile_map(int id, int ntn, int& mt, int& nt) {
  const int r = id >> 9, b = id & 511;
  const int x = b & 7, sidx = b >> 3;
  const int P = r * 8 + x;
  mt = (P & 7) * 8 + (sidx & 7);
  nt = (P >> 3) * 8 + (sidx >> 3);
}
DI int tile_count(int ntn) { return ((ntn + 7) >> 3) * 512; }

DI void transpose_tile(const float* __restrict__ src, int R, int C, u16* __restrict__ dst, int kt, int nt, char* smem) {
  float* tile = (float*)smem;
  const int tid = threadIdx.x;
  const int k0 = kt * 64, n0 = nt * 64;
#pragma unroll 4
  for (int it = 0; it < 16; ++it) {
    const int kk = it * 4 + (tid >> 6), nn = tid & 63;
    const int n = n0 + nn;
    tile[kk * 65 + nn] = (n < C) ? src[(size_t)(k0 + kk) * C + n] : 0.f;
  }
  __syncthreads();
#pragma unroll
  for (int it = 0; it < 2; ++it) {
    const int q = tid + 256 * it, nn = q >> 3, kc = q & 7;
    float o[8];
#pragma unroll
    for (int i = 0; i < 8; ++i) o[i] = tile[(kc * 8 + i) * 65 + nn];
    *(bf16x8*)(dst + (size_t)(n0 + nn) * R + k0 + kc * 8) = pack8(o);
  }
  __syncthreads();
}

DI float wave_sum(float v) {
#pragma unroll
  for (int o = 32; o; o >>= 1) v += __shfl_xor(v, o, 64);
  return v;
}

DI void filter_unit(const Params& p, int unit, char* smem) {
  float* sz = (float*)smem;
  float* hA = sz + 8 * 33 + 8;
  float* hB = hA + 8 * 64;
  float* hT = hB + 8 * 64;
  const int tid = opaque_tid();
  const int l0 = unit * 8;
  for (int idx = tid; idx < 8 * 33; idx += 256) {
    const int pp = idx / 33, f = idx - pp * 33;
    const float l = (float)(l0 + pp);
    float v;
    if (f == 0) v = l / 4095.f;
    else {
      const int jb = (f - 1) & 15;
      const float fj = 1e-4f + (float)jb * ((15.f - 1e-4f) / 15.f);
      const float ang = 6.283185307179586f * l / 4096.f;
      v = (f <= 16) ? fcos(fj * ang) : -fsin(fj * ang);
    }
    sz[idx] = v;
  }
  const int o = tid & 63, pq = tid >> 6;
  {
    const float bb = p.filt_b1[o], fr = p.filt_freq[o];
    __syncthreads();
    float s0 = bb, s1 = bb;
#pragma unroll 1
    for (int f0 = 0; f0 < 33; f0 += 11) {
      float wc[11];
#pragma unroll
      for (int f = 0; f < 11; ++f) wc[f] = p.filt_w1[(f0 + f) * 64 + o];
#pragma unroll
      for (int f = 0; f < 11; ++f) { s0 += sz[pq * 33 + f0 + f] * wc[f]; s1 += sz[(pq + 4) * 33 + f0 + f] * wc[f]; }
    }
    hA[pq * 64 + o] = fsin(fr * s0);
    hA[(pq + 4) * 64 + o] = fsin(fr * s1);
  }
  {
    const float bb = p.filt_b2[o], fr = p.filt_freq[64 + o];
    __syncthreads();
    float s0 = bb, s1 = bb;
#pragma unroll 1
    for (int k0 = 0; k0 < 64; k0 += 16) {
      float wc[16];
#pragma unroll
      for (int k = 0; k < 16; ++k) wc[k] = p.filt_w2[(k0 + k) * 64 + o];
#pragma unroll
      for (int k = 0; k < 16; ++k) { s0 += hA[pq * 64 + k0 + k] * wc[k]; s1 += hA[(pq + 4) * 64 + k0 + k] * wc[k]; }
    }
    hB[pq * 64 + o] = fsin(fr * s0);
    hB[(pq + 4) * 64 + o] = fsin(fr * s1);
  }
  {
    const float bb = p.filt_b3[o], fr = p.filt_freq[128 + o];
    __syncthreads();
    float s0 = bb, s1 = bb;
#pragma unroll 1
    for (int k0 = 0; k0 < 64; k0 += 16) {
      float wc[16];
#pragma unroll
      for (int k = 0; k < 16; ++k) wc[k] = p.filt_w3[(k0 + k) * 64 + o];
#pragma unroll
      for (int k = 0; k < 16; ++k) { s0 += hB[pq * 64 + k0 + k] * wc[k]; s1 += hB[(pq + 4) * 64 + k0 + k] * wc[k]; }
    }
    hT[o * 8 + pq] = fsin(fr * s0);
    hT[o * 8 + pq + 4] = fsin(fr * s1);
  }
  __syncthreads();
  float* filt = (float*)(p.ws + OFF_FILT);
  const float min_decay = -3.0701134573253944f, max_decay = -15.350567286626973f;
#pragma unroll 1
  for (int cc = 0; cc < 8; ++cc) {
    const int col = tid + 256 * cc;
    float acc[8];
#pragma unroll
    for (int q = 0; q < 8; ++q) acc[q] = 0.f;
#pragma unroll 1
    for (int k0 = 0; k0 < 64; k0 += 16) {
      float wc[16];
#pragma unroll
      for (int k = 0; k < 16; ++k) wc[k] = p.filt_w4[(k0 + k) * 2048 + col];
#pragma unroll
      for (int k = 0; k < 16; ++k) {
        const float4 h0 = *(const float4*)(hT + (k0 + k) * 8);
        const float4 h1 = *(const float4*)(hT + (k0 + k) * 8 + 4);
        acc[0] += h0.x * wc[k]; acc[1] += h0.y * wc[k]; acc[2] += h0.z * wc[k]; acc[3] += h0.w * wc[k];
        acc[4] += h1.x * wc[k]; acc[5] += h1.y * wc[k]; acc[6] += h1.z * wc[k]; acc[7] += h1.w * wc[k];
      }
    }
    const int ch = col & 511;
    const float delta = fabsf(min_decay + (float)ch * ((max_decay - min_decay) / 511.f));
#pragma unroll
    for (int q = 0; q < 8; ++q) {
      const float t = (float)(l0 + q) / 4095.f;
      acc[q] *= expf(-t * delta);
    }
    float4* dst = (float4*)(filt + (size_t)col * 4096 + l0);
    dst[0] = make_float4(acc[0], acc[1], acc[2], acc[3]);
    dst[1] = make_float4(acc[4], acc[5], acc[6], acc[7]);
  }
  __syncthreads();
}

DI void phase0(const Params& p, char* smem) {
  const int tid = threadIdx.x, lane = tid & 63, wave = tid >> 6;
  const int U_W = 32, U_F = 512, U_X = 1024, U_T1 = 58 * 16, U_T2 = 256, U_T3 = 1024, U_T4 = 1024;
  const int total = U_W + U_F + U_X + U_T1 + U_T2 + U_T3 + U_T4;
  for (int u = blockIdx.x; u < total; u += gridDim.x) {
    int v = u;
    if (v < U_W) {
      const int idx = v * 256 + tid;
      if (idx < 8191) {
        const int lh = 31 - __clz(idx + 1);
        const int h = 1 << lh, jj = idx + 1 - h;
        float2* twp = (float2*)(p.ws + OFF_TW);
        const float ang = -3.14159265358979f * (float)jj / (float)h;
        twp[idx] = make_float2(cosf(ang), sinf(ang));
      }
      continue;
    }
    v -= U_W;
    if (v < U_F) { filter_unit(p, v, smem); continue; }
    v -= U_F;
    if (v < U_X) {
      u16* xn = (u16*)(p.ws + OFF_XN);
#pragma unroll 4
      for (int rr = 0; rr < 4; ++rr) {
        const int row = v * 16 + wave * 4 + rr;
        const float4* xr = (const float4*)(p.x + (size_t)row * DM);
        float4 xv[4];
        float ss = 0.f;
#pragma unroll
        for (int i = 0; i < 4; ++i) {
          xv[i] = xr[lane + 64 * i];
          ss += xv[i].x * xv[i].x + xv[i].y * xv[i].y + xv[i].z * xv[i].z + xv[i].w * xv[i].w;
        }
        ss = wave_sum(ss);
        const float rs = rsqrtf(ss * (1.f / DM) + EPS);
#pragma unroll
        for (int i = 0; i < 4; ++i) {
          const float4 w = ((const float4*)p.norm_mix_pre)[lane + 64 * i];
          ushort4 o;
          o.x = f2bf(xv[i].x * rs * w.x); o.y = f2bf(xv[i].y * rs * w.y); o.z = f2bf(xv[i].z * rs * w.z); o.w = f2bf(xv[i].w * rs * w.w);
          *(ushort4*)(xn + (size_t)row * DM + (lane + 64 * i) * 4) = o;
        }
      }
      continue;
    }
    v -= U_X;
    if (v < U_T1) { transpose_tile(p.w_in, DM, NIN, (u16*)(p.ws + OFF_WINT), v & 15, v >> 4, smem); continue; }
    v -= U_T1;
    if (v < U_T2) { transpose_tile(p.w_out, DM, DM, (u16*)(p.ws + OFF_WOUTT), v & 15, v >> 4, smem); continue; }
    v -= U_T2;
    if (v < U_T3) { transpose_tile(p.w_mlp_in, DM, DFF, (u16*)(p.ws + OFF_W1T), v & 15, v >> 4, smem); continue; }
    v -= U_T3;
    transpose_tile(p.w_mlp_out, DFF, DM, (u16*)(p.ws + OFF_W2T), v & 63, v >> 6, smem);
  }
}

DI void wave_lds_sync() { asm volatile("s_waitcnt lgkmcnt(0)" ::: "memory"); __builtin_amdgcn_wave_barrier(); }
template <int MODE>
DI void stage_tile_ns(const f32x16 (&acc)[4][2], char* wl, int lr, int hh) {
#pragma unroll
  for (int i = 0; i < 4; ++i)
#pragma unroll
    for (int j = 0; j < 2; ++j)
#pragma unroll
      for (int r = 0; r < 16; ++r) {
        float v = acc[i][j][r];
        if (MODE == 1) v = sigmoidf(v);
        if (MODE == 2) { v = fmaxf(v, 0.f); v = v * v; }
        *(u16*)(wl + (i * 32 + crow(r, hh)) * 128 + (j * 32 + lr) * 2) = f2bf(v);
      }
}
DI void stage_tile_sw(const f32x16 (&acc)[4][2], char* wl, int lr, int hh) {
#pragma unroll
  for (int i = 0; i < 4; ++i)
#pragma unroll
    for (int j = 0; j < 2; ++j)
#pragma unroll
      for (int r = 0; r < 16; ++r) *(u16*)(wl + (j * 32 + crow(r, hh)) * 256 + (i * 32 + lr) * 2) = f2bf(acc[i][j][r]);
}
DI void flush_tile_ns(const char* wl, u16* dst, size_t pitch, int lane) {
#pragma unroll 4
  for (int it = 0; it < 16; ++it) {
    const int q = lane + 64 * it, row = q >> 3, c8 = q & 7;
    *(uint4*)(dst + (size_t)row * pitch + c8 * 8) = *(const uint4*)(wl + row * 128 + c8 * 16);
  }
}

DI void phase1(const Params& p, char* smem) {
  const int tid = threadIdx.x, lane = tid & 63, wave = tid >> 6, wr = wave >> 1, wc = wave & 1, lr = lane & 31, hh = lane >> 5;
  const u16* xn = (const u16*)(p.ws + OFF_XN);
  const u16* wt = (const u16*)(p.ws + OFF_WINT);
  u16* qkpre = (u16*)(p.ws + OFF_QKPRE);
  u16* hyT = (u16*)(p.ws + OFF_HYT);
  u16* vT = (u16*)(p.ws + OFF_VT);
  u16* og = (u16*)(p.ws + OFF_OG);
  float* gates = (float*)(p.ws + OFF_GATES);
  const int ntn = 29, ntiles = tile_count(ntn);
  for (int id = blockIdx.x; id < ntiles; id += gridDim.x) {
    int mt, nt;
    tile_map(id, ntn, mt, nt);
    if (nt >= ntn) continue;
    const int m0 = mt * 256, n0 = nt * 128;
    f32x16 acc[4][2];
    const bool swap = (nt >= 8 && nt < 24);
    if (swap) gemm_core<true>(xn, wt, DM, m0, n0, smem, acc);
    else gemm_core<false>(xn, wt, DM, m0, n0, smem, acc);
    char* wl = smem + wave * 16384;
    if (!swap) {
      if (nt < 28) {
        if (nt < 8) stage_tile_ns<0>(acc, wl, lr, hh); else stage_tile_ns<1>(acc, wl, lr, hh);
        wave_lds_sync();
        const size_t row0 = (size_t)(m0 + wr * 128);
        if (nt < 8) flush_tile_ns(wl, qkpre + row0 * 1024 + n0 + wc * 64, 1024, lane);
        else flush_tile_ns(wl, og + row0 * 512 + (n0 - 3072) + wc * 64, 512, lane);
      } else {
#pragma unroll
        for (int i = 0; i < 4; ++i)
#pragma unroll
          for (int r = 0; r < 16; ++r) {
            const int row = m0 + wr * 128 + i * 32 + crow(r, hh);
            if (wc == 0 && lr < 16) gates[(size_t)row * 16 + lr] = acc[i][0][r];
          }
      }
    } else {
      stage_tile_sw(acc, wl, lr, hh);
      wave_lds_sync();
      const int mrow = m0 + wr * 128, b = mrow >> 12, t0 = mrow & 4095;
#pragma unroll 4
      for (int it = 0; it < 16; ++it) {
        const int q = lane + 64 * it, chl = q >> 4, c16 = q & 15;
        const int n = n0 + wc * 64 + chl;
        u16* dst;
        if (nt < 20) { const int cc = n - 1024, g = cc >> 9, ch = cc & 511; dst = hyT + ((size_t)((g * 4 + b) * 512 + ch)) * 4096; }
        else dst = vT + ((size_t)(b * 512 + (n - 2560))) * 4096;
        *(uint4*)(dst + t0 + c16 * 8) = *(const uint4*)(wl + chl * 256 + c16 * 16);
      }
    }
  }
}

DI void phase_qk(const Params& p, char* smem) {
  const int tid = opaque_tid();
  const int cg = tid & 31, rg = tid >> 5;
  const u16* qkpre = (const u16*)(p.ws + OFF_QKPRE);
  u16* qa = (u16*)(p.ws + OFF_QA);
  u16* ka = (u16*)(p.ws + OFF_KA);
  u16* kaT = (u16*)(p.ws + OFF_KAT);
  for (int u = blockIdx.x; u < 1024; u += gridDim.x) {
    const int ct = u & 3, tt = u >> 2;
    const int C0 = ct * 256 + cg * 8;
    const int Tb = tt * 64 + rg * 8;
    const int tb = Tb & 4095;
    float w0[8], w1[8], w2[8], cb[8];
    {
      const float4 a0 = *(const float4*)(p.conv_w + C0), a1 = *(const float4*)(p.conv_w + C0 + 4);
      const float4 b0 = *(const float4*)(p.conv_w + 2560 + C0), b1 = *(const float4*)(p.conv_w + 2560 + C0 + 4);
      const float4 c0 = *(const float4*)(p.conv_w + 5120 + C0), c1 = *(const float4*)(p.conv_w + 5120 + C0 + 4);
      const float4 d0 = *(const float4*)(p.conv_b + C0), d1 = *(const float4*)(p.conv_b + C0 + 4);
      w0[0] = a0.x; w0[1] = a0.y; w0[2] = a0.z; w0[3] = a0.w; w0[4] = a1.x; w0[5] = a1.y; w0[6] = a1.z; w0[7] = a1.w;
      w1[0] = b0.x; w1[1] = b0.y; w1[2] = b0.z; w1[3] = b0.w; w1[4] = b1.x; w1[5] = b1.y; w1[6] = b1.z; w1[7] = b1.w;
      w2[0] = c0.x; w2[1] = c0.y; w2[2] = c0.z; w2[3] = c0.w; w2[4] = c1.x; w2[5] = c1.y; w2[6] = c1.z; w2[7] = c1.w;
      cb[0] = d0.x; cb[1] = d0.y; cb[2] = d0.z; cb[3] = d0.w; cb[4] = d1.x; cb[5] = d1.y; cb[6] = d1.z; cb[7] = d1.w;
    }
    bf16x8 rows[10];
    const u16* src = qkpre + (size_t)Tb * 1024 + C0;
#pragma unroll
    for (int r = 0; r < 10; ++r) {
      const int t = tb + r - 1;
      bf16x8 z;
#pragma unroll
      for (int i = 0; i < 8; ++i) z[i] = 0;
      rows[r] = (t >= 0 && t <= 4095) ? *(const bf16x8*)(src + (ptrdiff_t)(r - 1) * 1024) : z;
    }
    const bool isk = C0 >= 512;
    bf16x8 tr[8];
#pragma unroll
    for (int r = 0; r < 8; ++r) {
      bf16x8 o;
#pragma unroll
      for (int i = 0; i < 8; ++i) {
        const float val = w0[i] * bf2f((u16)rows[r][i]) + w1[i] * bf2f((u16)rows[r + 1][i]) + w2[i] * bf2f((u16)rows[r + 2][i]) + cb[i];
        float sv = val * sigmoidf(val);
        if (isk) sv *= 0.08838834764831845f;
        o[i] = (short)f2bf(sv);
        tr[i][r] = o[i];
      }
      if (!isk) *(bf16x8*)(qa + (size_t)(Tb + r) * 512 + C0) = o;
      else *(bf16x8*)(ka + (size_t)(Tb + r) * 512 + (C0 - 512)) = o;
    }
    if (isk) {
      const int b = Tb >> 12;
#pragma unroll
      for (int i = 0; i < 8; ++i) *(bf16x8*)(kaT + ((size_t)(b * 512 + (C0 - 512) + i)) * 4096 + tb) = tr[i];
    }
  }
}

DI float lz(float v) { asm volatile("" : "+v"(v)); return v; }
DI float2 mk2(float a, float b) { return make_float2(a, b); }
DI float2 cmul(float2 a, float2 w) { return mk2(a.x * w.x - a.y * w.y, a.x * w.y + a.y * w.x); }
DI float2 cmulc(float2 a, float2 w) { return mk2(a.x * w.x + a.y * w.y, a.y * w.x - a.x * w.y); }
template <int NW, bool INV>
DI void r4_pass(float2* x, int tid, int q, const float2* __restrict__ t1, const float2* __restrict__ t2) {
  constexpr int NL = NW > 4 ? 4 : NW;
  constexpr int NB = NW > 4 ? 2 : 1;
  constexpr int CNT = 8 / NB;
#pragma unroll 1
  for (int bt = 0; bt < NB; ++bt) {
    float2 w1[NL], w2[NL];
#pragma unroll
    for (int n = 0; n < NL; ++n) { const int j = (tid + ((bt * CNT + n) << 8)) & (q - 1); w1[n] = t1[j]; w2[n] = t2[j]; }
    if (bt == 0) __syncthreads();
#pragma unroll(NL == 4 ? 4 : 2)
    for (int ii = 0; ii < CNT; ++ii) {
      const int k = tid + ((bt * CNT + ii) << 8);
      const int j = k & (q - 1);
      int base = ((k - j) << 2) + j;
      asm volatile("" : "+v"(base));
      const float2 ww1 = w1[ii % NL], ww2 = w2[ii % NL];
      const float2 x0 = x[base], x1 = x[base + q], x2 = x[base + 2 * q], x3 = x[base + 3 * q];
      if (!INV) {
        const float2 a0 = mk2(x0.x + x2.x, x0.y + x2.y);
        const float2 a1 = mk2(x1.x + x3.x, x1.y + x3.y);
        const float2 d02 = mk2(x0.x - x2.x, x0.y - x2.y);
        const float2 d13 = mk2(x1.y - x3.y, x3.x - x1.x);
        const float2 a2 = cmul(d02, ww1);
        const float2 a3 = cmul(d13, ww1);
        x[base] = mk2(a0.x + a1.x, a0.y + a1.y);
        x[base + q] = cmul(mk2(a0.x - a1.x, a0.y - a1.y), ww2);
        x[base + 2 * q] = mk2(a2.x + a3.x, a2.y + a3.y);
        x[base + 3 * q] = cmul(mk2(a2.x - a3.x, a2.y - a3.y), ww2);
      } else {
        const float2 b1 = cmulc(x1, ww2), b3 = cmulc(x3, ww2);
        const float2 a0 = mk2(x0.x + b1.x, x0.y + b1.y);
        const float2 a1 = mk2(x0.x - b1.x, x0.y - b1.y);
        const float2 a2 = mk2(x2.x + b3.x, x2.y + b3.y);
        const float2 a3 = mk2(x2.x - b3.x, x2.y - b3.y);
        const float2 c2 = cmulc(a2, ww1);
        const float2 c3t = cmulc(a3, ww1);
        const float2 c3 = mk2(-c3t.y, c3t.x);
        x[base] = mk2(a0.x + c2.x, a0.y + c2.y);
        x[base + 2 * q] = mk2(a0.x - c2.x, a0.y - c2.y);
        x[base + q] = mk2(a1.x + c3.x, a1.y + c3.y);
        x[base + 3 * q] = mk2(a1.x - c3.x, a1.y - c3.y);
      }
    }
  }
}
DI void r2_last(float2* x, int tid) {
#pragma unroll 4
  for (int i = 0; i < 16; ++i) {
    const int i0 = (tid + (i << 8)) << 1;
    const float2 a = x[i0], b = x[i0 + 1];
    x[i0] = mk2(a.x + b.x, a.y + b.y);
    x[i0 + 1] = mk2(a.x - b.x, a.y - b.y);
  }
}
DI void fft_fwd(float2* x, int tid, const float2* __restrict__ tw) {
  r4_pass<8, false>(x, tid, 2048, tw + 4095, tw + 2047);
  r4_pass<2, false>(x, tid, 512, tw + 1023, tw + 511);
  r4_pass<1, false>(x, tid, 128, tw + 255, tw + 127);
  r4_pass<1, false>(x, tid, 32, tw + 63, tw + 31);
  r4_pass<1, false>(x, tid, 8, tw + 15, tw + 7);
  r4_pass<1, false>(x, tid, 2, tw + 3, tw + 1);
  __syncthreads();
  r2_last(x, tid);
  __syncthreads();
}
DI void fft_inv(float2* x, int tid, const float2* __restrict__ tw) {
  __syncthreads();
  r2_last(x, tid);
  r4_pass<1, true>(x, tid, 2, tw + 3, tw + 1);
  r4_pass<1, true>(x, tid, 8, tw + 15, tw + 7);
  r4_pass<1, true>(x, tid, 32, tw + 63, tw + 31);
  r4_pass<1, true>(x, tid, 128, tw + 255, tw + 127);
  r4_pass<2, true>(x, tid, 512, tw + 1023, tw + 511);
  r4_pass<8, true>(x, tid, 2048, tw + 4095, tw + 2047);
  __syncthreads();
}

DI float hy_conv(const u16* __restrict__ pr, int t, float w0, float w1, float w2, float cb) {
  const float a = t > 0 ? bf2f(pr[t - 1]) : 0.f;
  const float b = bf2f(pr[t]);
  const float c = t < 4095 ? bf2f(pr[t + 1]) : 0.f;
  return w0 * a + w1 * b + w2 * c + cb;
}

DI void hy_conv4(const u16* __restrict__ pr, int t0, float w0, float w1, float w2, float cb, float (&o)[4]) {
  const ushort4 c = *(const ushort4*)(pr + t0);
  const float pm = t0 > 0 ? bf2f(pr[t0 - 1]) : 0.f;
  const float pn = t0 + 4 < 4096 ? bf2f(pr[t0 + 4]) : 0.f;
  const float x0 = bf2f(c.x), x1 = bf2f(c.y), x2 = bf2f(c.z), x3 = bf2f(c.w);
  o[0] = w0 * pm + w1 * x0 + w2 * x1 + cb;
  o[1] = w0 * x0 + w1 * x1 + w2 * x2 + cb;
  o[2] = w0 * x1 + w1 * x2 + w2 * x3 + cb;
  o[3] = w0 * x2 + w1 * x3 + w2 * pn + cb;
}

DI void hyena_unit(const Params& p, int ch, char* smem) {
  float2* buf = (float2*)smem;
  const int tid = opaque_tid();
  const u16* hyT = (const u16*)(p.ws + OFF_HYT);
  const float* filt = (const float*)(p.ws + OFF_FILT);
  float* z2T = (float*)(p.ws + OFF_Z2T);
  const float2* tw = (const float2*)(p.ws + OFF_TW);
  float2 Kr[32];
#pragma unroll 1
  for (int ord = 0; ord < 2; ++ord) {
    const float* kf = filt + (size_t)((0 * 2 + ord) * 512 + ch) * 4096;
    const float* kb = filt + (size_t)((1 * 2 + ord) * 512 + ch) * 4096;
    const float fb = p.filt_bias[ord * 512 + ch];
    __syncthreads();
#pragma unroll
    for (int g = 0; g < 4; ++g) {
      const int n0 = g * 1024 + tid * 4;
      float4 v = *(const float4*)(kf + n0);
      if (n0 == 0) v.x += fb;
      *(float4*)(buf + n0) = make_float4(v.x, 0.f, v.y, 0.f);
      *(float4*)(buf + n0 + 2) = make_float4(v.z, 0.f, v.w, 0.f);
      const float4 r = *(const float4*)(kb + 4092 - n0);
      const float e0 = (n0 == 0) ? 0.f : kb[4096 - n0];
      *(float4*)(buf + 4096 + n0) = make_float4(e0, 0.f, r.w, 0.f);
      *(float4*)(buf + 4096 + n0 + 2) = make_float4(r.z, 0.f, r.y, 0.f);
    }
    fft_fwd(buf, tid, tw);
#pragma unroll
    for (int j = 0; j < 32; ++j) {
      const float2 v = buf[tid + 256 * j];
      Kr[j] = make_float2(v.x * (1.f / 8192.f), v.y * (1.f / 8192.f));
    }
    const int gcol = 1024 + (1 + ord) * 512 + ch;
    const float gw0 = p.conv_w[gcol], gw1 = p.conv_w[2560 + gcol], gw2 = p.conv_w[5120 + gcol], gcb = p.conv_b[gcol];
    const int vcol = 1024 + ch;
    const float vw0 = p.conv_w[vcol], vw1 = p.conv_w[2560 + vcol], vw2 = p.conv_w[5120 + vcol], vcb = p.conv_b[vcol];
#pragma unroll 1
    for (int pr = 0; pr < 2; ++pr) {
      const int b0 = 2 * pr, b1 = 2 * pr + 1;
      __syncthreads();
      if (ord == 0) {
        const u16* u0 = hyT + ((size_t)((0 * 4 + b0) * 512 + ch)) * 4096;
        const u16* u1 = hyT + ((size_t)((0 * 4 + b1) * 512 + ch)) * 4096;
#pragma unroll
        for (int g = 0; g < 4; ++g) {
          const int t0 = g * 1024 + tid * 4;
          float a[4], b[4];
          hy_conv4(u0, t0, vw0, vw1, vw2, vcb, a);
          hy_conv4(u1, t0, vw0, vw1, vw2, vcb, b);
          *(float4*)(buf + t0) = make_float4(a[0], b[0], a[1], b[1]);
          *(float4*)(buf + t0 + 2) = make_float4(a[2], b[2], a[3], b[3]);
          *(float4*)(buf + 4096 + t0) = make_float4(0.f, 0.f, 0.f, 0.f);
          *(float4*)(buf + 4096 + t0 + 2) = make_float4(0.f, 0.f, 0.f, 0.f);
        }
      } else {
        const float* u0 = z2T + ((size_t)(b0 * 512 + ch)) * 4096;
        const float* u1 = z2T + ((size_t)(b1 * 512 + ch)) * 4096;
#pragma unroll
        for (int g = 0; g < 4; ++g) {
          const int t0 = g * 1024 + tid * 4;
          const float4 a = *(const float4*)(u0 + t0);
          const float4 b = *(const float4*)(u1 + t0);
          *(float4*)(buf + t0) = make_float4(a.x, b.x, a.y, b.y);
          *(float4*)(buf + t0 + 2) = make_float4(a.z, b.z, a.w, b.w);
          *(float4*)(buf + 4096 + t0) = make_float4(0.f, 0.f, 0.f, 0.f);
          *(float4*)(buf + 4096 + t0 + 2) = make_float4(0.f, 0.f, 0.f, 0.f);
        }
      }
      fft_fwd(buf, tid, tw);
#pragma unroll
      for (int j = 0; j < 32; ++j) {
        const float2 v = buf[tid + 256 * j];
        buf[tid + 256 * j] = make_float2(v.x * Kr[j].x - v.y * Kr[j].y, v.x * Kr[j].y + v.y * Kr[j].x);
      }
      fft_inv(buf, tid, tw);
      const u16* g0 = hyT + ((size_t)(((1 + ord) * 4 + b0) * 512 + ch)) * 4096;
      const u16* g1 = hyT + ((size_t)(((1 + ord) * 4 + b1) * 512 + ch)) * 4096;
      float* o0 = z2T + ((size_t)(b0 * 512 + ch)) * 4096;
      float* o1 = z2T + ((size_t)(b1 * 512 + ch)) * 4096;
#pragma unroll
      for (int g = 0; g < 4; ++g) {
        const int t0 = g * 1024 + tid * 4;
        const float4 y01 = *(const float4*)(buf + t0);
        const float4 y23 = *(const float4*)(buf + t0 + 2);
        float ga[4], gb[4];
        hy_conv4(g0, t0, gw0, gw1, gw2, gcb, ga);
        hy_conv4(g1, t0, gw0, gw1, gw2, gcb, gb);
        *(float4*)(o0 + t0) = make_float4(ga[0] * y01.x, ga[1] * y01.z, ga[2] * y23.x, ga[3] * y23.z);
        *(float4*)(o1 + t0) = make_float4(gb[0] * y01.y, gb[1] * y01.w, gb[2] * y23.y, gb[3] * y23.w);
      }
    }
  }
  __syncthreads();
}

DI void mlstm_local_unit(const Params& p, int u, char* smem) {
  float* s_gi = (float*)smem;
  float* s_lf = s_gi + 128;
  float* s_a = s_lf + 128;
  float* s_w = s_a + 128;
  const int tid = opaque_tid(), lane = tid & 63, wave = tid >> 6, lr = lane & 31, hh = lane >> 5;
  const int j = u & 31, dir = (u >> 5) & 1, bh = u >> 6, h = bh & 3, b = bh >> 2;
  const int T0 = b * 4096 + j * 128;
  const float* gates = (const float*)(p.ws + OFF_GATES);
  const u16* vT = (const u16*)(p.ws + OFF_VT);
  const u16* kaT = (const u16*)(p.ws + OFF_KAT);
  float* CL = p.out;
  float* nl = (float*)(p.ws + OFF_NL);
  float* mloc = (float*)(p.ws + OFF_MLOC);
  float* gsum = (float*)(p.ws + OFF_GSUM);
  __syncthreads();
  if (tid < 128) {
    const int T = T0 + tid;
    s_gi[tid] = gates[(size_t)T * 16 + dir * 8 + h] + p.b_gates[dir * 8 + h];
    s_lf[tid] = log_sigmoid(gates[(size_t)T * 16 + dir * 8 + 4 + h] + p.b_gates[dir * 8 + 4 + h]);
  }
  __syncthreads();
  float gtot = 0.f;
  if (tid < 128) {
    float pre = 0.f;
#pragma unroll 4
    for (int m = 0; m < 128; ++m) {
      const float v = s_lf[m];
      if (m < tid) pre += v;
      gtot += v;
    }
    s_a[tid] = (dir == 0) ? (gtot - pre - s_lf[tid] + s_gi[tid]) : (pre + s_gi[tid]);
  }
  __syncthreads();
  if (tid < 128) {
    float mx = -3.0e38f;
#pragma unroll 4
    for (int m = 0; m < 128; ++m) mx = fmaxf(mx, s_a[m]);
    s_w[tid] = expf(s_a[tid] - mx);
    if (tid == 0) { mloc[u] = mx; gsum[u] = gtot; }
  }
  __syncthreads();
  f32x16 acc[4];
#pragma unroll
  for (int d = 0; d < 4; ++d)
#pragma unroll
    for (int r = 0; r < 16; ++r) acc[d][r] = 0.f;
  const u16* vrow = vT + ((size_t)(bh * 128 + wave * 32 + lr)) * 4096 + j * 128 + hh * 8;
  const u16* kbase = kaT + ((size_t)(bh * 128 + lr)) * 4096 + j * 128 + hh * 8;
#pragma unroll 4
  for (int ks = 0; ks < 8; ++ks) {
    const bf16x8 av = *(const bf16x8*)(vrow + ks * 16);
    bf16x8 a;
#pragma unroll
    for (int i = 0; i < 8; ++i) a[i] = (short)f2bf(bf2f((u16)av[i]) * s_w[ks * 16 + hh * 8 + i]);
#pragma unroll
    for (int dt = 0; dt < 4; ++dt) {
      const bf16x8 bk = *(const bf16x8*)(kbase + (size_t)(dt * 32) * 4096 + ks * 16);
      acc[dt] = MFMA(a, bk, acc[dt]);
    }
  }
  float* dst = CL + (size_t)u * 16384;
#pragma unroll
  for (int dt = 0; dt < 4; ++dt)
#pragma unroll
    for (int r = 0; r < 16; ++r) dst[(wave * 32 + crow(r, hh)) * 128 + dt * 32 + lr] = acc[dt][r];
  if (tid < 128) {
    const u16* kr = kaT + ((size_t)(bh * 128 + tid)) * 4096 + j * 128;
    float s = 0.f;
#pragma unroll 2
    for (int l = 0; l < 128; l += 8) {
      const bf16x8 kv = *(const bf16x8*)(kr + l);
#pragma unroll
      for (int i = 0; i < 8; ++i) s += s_w[l + i] * bf2f((u16)kv[i]);
    }
    nl[(size_t)u * 128 + tid] = s;
  }
}

DI void scan_unit(const Params& p, int unit) {
  const int tid = opaque_tid();
  const int sc = unit >> 4, part = unit & 15, dir = sc & 1;
  float* CL = p.out;
  float* nl = (float*)(p.ws + OFF_NL);
  const float* mloc = (const float*)(p.ws + OFF_MLOC);
  const float* gsum = (const float*)(p.ws + OFF_GSUM);
  float* ms = (float*)(p.ws + OFF_MS);
  const int idx = part * 1024 + tid * 4;
  float4 C = make_float4(0.f, 0.f, 0.f, 0.f);
  float nst = 0.f, m = 0.f;
  const bool do_n = (part == 0) && (tid < 128);
  float4 pf[4];
#pragma unroll
  for (int q = 0; q < 4; ++q) {
    const int jj = dir ? 31 - q : q;
    pf[q] = *(const float4*)(CL + (size_t)(sc * 32 + jj) * 16384 + idx);
  }
#pragma unroll 1
  for (int c0 = 0; c0 < 32; c0 += 4) {
#pragma unroll
    for (int q = 0; q < 4; ++q) {
      const int c = c0 + q;
      const int jj = dir ? 31 - c : c;
      const int u = sc * 32 + jj;
      const float4 cl = pf[q];
      *(float4*)(CL + (size_t)u * 16384 + idx) = C;
      if (c + 4 < 32) {
        const int j2 = dir ? 31 - (c + 4) : (c + 4);
        pf[q] = *(const float4*)(CL + (size_t)(sc * 32 + j2) * 16384 + idx);
      }
      const float g = gsum[u], ml = mloc[u];
      const float mn = fmaxf(g + m, ml);
      const float dec = expf(g + m - mn), scl = expf(ml - mn);
      C.x = dec * C.x + scl * cl.x; C.y = dec * C.y + scl * cl.y; C.z = dec * C.z + scl * cl.z; C.w = dec * C.w + scl * cl.w;
      if (do_n) {
        const float nv = nl[(size_t)u * 128 + tid];
        nl[(size_t)u * 128 + tid] = nst;
        nst = dec * nst + scl * nv;
      }
      if (part == 0 && tid == 0) ms[u] = m;
      m = mn;
    }
  }
}

template <int DIR>
DI void mlstm_dir(const Params& p, int bh, int j, char* smem, f32x16 (&hs)[4]) {
  float* s_gi = (float*)smem;
  float* s_lf = s_gi + 128;
  float* s_bc = s_lf + 128;
  float* s_r = s_bc + 128;
  float* s_al = s_r + 128;
  float* s_fl = s_al + 128;
  float* s_is = s_fl + 128;
  const int tid = opaque_tid(), lane = tid & 63, wave = tid >> 6, lr = lane & 31, hh = lane >> 5;
  u16* Pl = (u16*)(smem + 4096) + wave * (32 * 136);
  const int h = bh & 3, b = bh >> 2;
  const int T0 = b * 4096 + j * 128;
  const float* gates = (const float*)(p.ws + OFF_GATES);
  const u16* qa = (const u16*)(p.ws + OFF_QA);
  const u16* ka = (const u16*)(p.ws + OFF_KA);
  const u16* vT = (const u16*)(p.ws + OFF_VT);
  const float* CS = p.out;
  const float* ns = (const float*)(p.ws + OFF_NL);
  const float* ms = (const float*)(p.ws + OFF_MS);
  u16* A2 = (u16*)(p.ws + OFF_A2);
  bf16x8 ones;
#pragma unroll
  for (int i = 0; i < 8; ++i) ones[i] = (short)0x3F80;
  const u16* qrow = qa + (size_t)(T0 + wave * 32 + lr) * 512 + h * 128 + hh * 8;
  const int u = (bh * 2 + DIR) * 32 + j;
  const float msu = ms[u];
  __syncthreads();
  if (tid < 128) {
    const int T = T0 + tid;
    s_gi[tid] = gates[(size_t)T * 16 + DIR * 8 + h] + p.b_gates[DIR * 8 + h];
    s_lf[tid] = log_sigmoid(gates[(size_t)T * 16 + DIR * 8 + 4 + h] + p.b_gates[DIR * 8 + 4 + h]);
  }
  __syncthreads();
  if (tid < 128) {
    float a = 0.f;
#pragma unroll 4
    for (int m = 0; m < 128; ++m) {
      const bool in = (DIR == 0) ? (m <= tid) : (m >= tid);
      a += in ? s_lf[m] : 0.f;
    }
    s_bc[tid] = a;
    s_r[tid] = s_gi[tid] - a;
  }
  __syncthreads();
  if (tid < 128) {
    float cm = -3.0e38f;
#pragma unroll 4
    for (int m = 0; m < 128; ++m) {
      const bool in = (DIR == 0) ? (m <= tid) : (m >= tid);
      cm = in ? fmaxf(cm, s_r[m]) : cm;
    }
    const float bc = s_bc[tid];
    const float mt = bc + fmaxf(msu, cm);
    s_al[tid] = bc - mt;
    s_fl[tid] = expf(-mt);
    s_is[tid] = expf(bc + msu - mt);
  }
  __syncthreads();
  char* Kt = smem + 4096;
  char* R2 = smem + 40960;
  {
#pragma unroll
    for (int bt = 0; bt < 2; ++bt) {
      uint4 kq[4];
#pragma unroll
      for (int i = 0; i < 4; ++i) {
        const int q = tid + 256 * (bt * 4 + i), row = q >> 4, ch = q & 15;
        kq[i] = *(const uint4*)(ka + (size_t)(T0 + row) * 512 + h * 128 + ch * 8);
      }
#pragma unroll
      for (int i = 0; i < 4; ++i) {
        const int q = tid + 256 * (bt * 4 + i), row = q >> 4, ch = q & 15;
        *(uint4*)(Kt + row * 256 + ((ch ^ (row & 15)) << 4)) = kq[i];
      }
    }
  }
  __syncthreads();
  {
    f32x16 S[4];
#pragma unroll
    for (int st = 0; st < 4; ++st)
#pragma unroll
      for (int r = 0; r < 16; ++r) S[st][r] = 0.f;
#pragma unroll 4
    for (int ks = 0; ks < 8; ++ks) {
      const bf16x8 a = *(const bf16x8*)(qrow + ks * 16);
#pragma unroll
      for (int st = 0; st < 4; ++st) {
        const int krow = st * 32 + lr;
        const bf16x8 bk = *(const bf16x8*)(Kt + krow * 256 + (((ks * 2 + hh) ^ (krow & 15)) << 4));
        S[st] = MFMA(a, bk, S[st]);
      }
    }
    __syncthreads();
#pragma unroll
    for (int st = 0; st < 4; ++st) {
      const int sl = st * 32 + lr;
      const float rs = s_r[sl];
#pragma unroll
      for (int r = 0; r < 16; ++r) {
        const int tl = wave * 32 + crow(r, hh);
        const bool valid = (DIR == 0) ? (sl <= tl) : (sl >= tl);
        const float pv = valid ? S[st][r] * __expf(s_al[tl] + rs) : 0.f;
        Pl[crow(r, hh) * 136 + sl] = f2bf(pv);
      }
    }
  }
#pragma unroll
  for (int eh = 0; eh < 2; ++eh) {
    f32x16 N[3];
#pragma unroll
    for (int e = 0; e < 3; ++e)
#pragma unroll
      for (int r = 0; r < 16; ++r) N[e][r] = 0.f;
    {
      uint4 vq[4];
#pragma unroll
      for (int i = 0; i < 4; ++i) {
        const int q = tid + 256 * i, row = q >> 4, ch = q & 15;
        vq[i] = *(const uint4*)(vT + ((size_t)(bh * 128 + eh * 64 + row)) * 4096 + j * 128 + ch * 8);
      }
#pragma unroll
      for (int i = 0; i < 4; ++i) {
        const int q = tid + 256 * i, row = q >> 4, ch = q & 15;
        *(uint4*)(R2 + row * 256 + ((ch ^ (row & 15)) << 4)) = vq[i];
      }
    }
    __syncthreads();
    {
#pragma unroll 4
      for (int ks = 0; ks < 8; ++ks) {
        const bf16x8 a = *(const bf16x8*)(Pl + lr * 136 + ks * 16 + hh * 8);
#pragma unroll
        for (int e2 = 0; e2 < 2; ++e2) {
          const int vrow = e2 * 32 + lr;
          const bf16x8 bv = *(const bf16x8*)(R2 + vrow * 256 + (((ks * 2 + hh) ^ (vrow & 15)) << 4));
          N[e2] = MFMA(a, bv, N[e2]);
        }
        N[2] = MFMA(a, ones, N[2]);
      }
    }
    {
      bf16x8 cq[4];
#pragma unroll
      for (int i = 0; i < 4; ++i) {
        const int q = tid + 256 * i, row = q >> 4, ch = q & 15;
        const float* src = CS + (size_t)u * 16384 + (size_t)(eh * 64 + row) * 128 + ch * 8;
        const float4 c0 = *(const float4*)(src), c1 = *(const float4*)(src + 4);
        const float cv[8] = {c0.x, c0.y, c0.z, c0.w, c1.x, c1.y, c1.z, c1.w};
        cq[i] = pack8(cv);
      }
      __syncthreads();
#pragma unroll
      for (int i = 0; i < 4; ++i) {
        const int q = tid + 256 * i, row = q >> 4, ch = q & 15;
        *(bf16x8*)(R2 + row * 256 + ((ch ^ (row & 15)) << 4)) = cq[i];
      }
    }
    __syncthreads();
    {
      const float isc = s_is[wave * 32 + lr];
      const float* nbase = ns + (size_t)u * 128 + hh * 8;
#pragma unroll 4
      for (int ks = 0; ks < 8; ++ks) {
        const bf16x8 aq = *(const bf16x8*)(qrow + ks * 16);
        const bf16x8 a = scale8(aq, isc);
#pragma unroll
        for (int e2 = 0; e2 < 2; ++e2) {
          const int crw = e2 * 32 + lr;
          const bf16x8 bc = *(const bf16x8*)(R2 + crw * 256 + (((ks * 2 + hh) ^ (crw & 15)) << 4));
          N[e2] = MFMA(a, bc, N[e2]);
        }
        const float4 n0 = *(const float4*)(nbase + ks * 16);
        const float4 n1 = *(const float4*)(nbase + ks * 16 + 4);
        const float nv[8] = {n0.x, n0.y, n0.z, n0.w, n1.x, n1.y, n1.z, n1.w};
        N[2] = MFMA(a, pack8(nv), N[2]);
      }
    }
    __syncthreads();
    u16* park = (u16*)(p.ws + OFF_HYT) + ((size_t)(bh * 32 + j) * 256 + tid) * 64 + eh * 32;
    bf16x8 pk[4];
    if (DIR == 1) {
#pragma unroll
      for (int q = 0; q < 4; ++q) pk[q] = *(const bf16x8*)(park + q * 8);
    }
#pragma unroll
    for (int r = 0; r < 16; ++r) {
      const int tl = wave * 32 + crow(r, hh);
      const float den = fmaxf(fabsf(N[2][r]), s_fl[tl]);
      const float inv = 1.f / den;
#pragma unroll
      for (int e2 = 0; e2 < 2; ++e2) {
        const float hv = N[e2][r] * inv;
        const int v = e2 * 16 + r;
        if (DIR == 0) pk[v >> 3][v & 7] = (short)f2bf(hv);
        else hs[eh * 2 + e2][r] = hv + bf2f((u16)pk[v >> 3][v & 7]);
      }
    }
    if (DIR == 0) {
#pragma unroll
      for (int q = 0; q < 4; ++q) *(bf16x8*)(park + q * 8) = pk[q];
    }
  }
}

DI void mlstm_out_unit(const Params& p, int unit, char* smem) {
  const int tid = opaque_tid(), lane = tid & 63, wave = tid >> 6, lr = lane & 31, hh = lane >> 5;
  const int j = unit & 31, bh = unit >> 5, h = bh & 3, b = bh >> 2;
  const int T0 = b * 4096 + j * 128;
  const u16* og = (const u16*)(p.ws + OFF_OG);
  u16* A2 = (u16*)(p.ws + OFF_A2);
  f32x16 hs[4];
  mlstm_dir<0>(p, bh, j, smem, hs);
  mlstm_dir<1>(p, bh, j, smem, hs);
  __syncthreads();
  float* wl = (float*)(smem + wave * 16384);
#pragma unroll
  for (int et = 0; et < 4; ++et)
#pragma unroll
    for (int r = 0; r < 16; ++r) wl[crow(r, hh) * 128 + et * 32 + lr] = hs[et][r];
  wave_lds_sync();
  {
    const int row = lane >> 1, half = lane & 1;
    const size_t T = (size_t)(T0 + wave * 32 + row);
    const u16* ogp = og + T * 512 + h * 128 + half * 64;
    const float* src = wl + row * 128 + half * 64;
    float g[64];
    float ss = 0.f;
#pragma unroll
    for (int q = 0; q < 8; ++q) {
      const bf16x8 o8 = *(const bf16x8*)(ogp + q * 8);
      const float4 h0 = *(const float4*)(src + q * 8), h1 = *(const float4*)(src + q * 8 + 4);
      g[q * 8 + 0] = h0.x * bf2f((u16)o8[0]); g[q * 8 + 1] = h0.y * bf2f((u16)o8[1]); g[q * 8 + 2] = h0.z * bf2f((u16)o8[2]); g[q * 8 + 3] = h0.w * bf2f((u16)o8[3]);
      g[q * 8 + 4] = h1.x * bf2f((u16)o8[4]); g[q * 8 + 5] = h1.y * bf2f((u16)o8[5]); g[q * 8 + 6] = h1.z * bf2f((u16)o8[6]); g[q * 8 + 7] = h1.w * bf2f((u16)o8[7]);
#pragma unroll
      for (int i = 0; i < 8; ++i) ss += g[q * 8 + i] * g[q * 8 + i];
    }
    ss += __shfl_xor(ss, 1, 64);
    const float rs = rsqrtf(ss * (1.f / 128.f) + EPS);
    const float* mw = p.mlstm_norm_w + h * 128 + half * 64;
    u16* dst = A2 + T * 1024 + h * 128 + half * 64;
#pragma unroll
    for (int q = 0; q < 8; ++q) {
      const float4 w0 = *(const float4*)(mw + q * 8), w1 = *(const float4*)(mw + q * 8 + 4);
      float o[8];
      o[0] = g[q * 8 + 0] * rs * w0.x; o[1] = g[q * 8 + 1] * rs * w0.y; o[2] = g[q * 8 + 2] * rs * w0.z; o[3] = g[q * 8 + 3] * rs * w0.w;
      o[4] = g[q * 8 + 4] * rs * w1.x; o[5] = g[q * 8 + 5] * rs * w1.y; o[6] = g[q * 8 + 6] * rs * w1.z; o[7] = g[q * 8 + 7] * rs * w1.w;
      *(bf16x8*)(dst + q * 8) = pack8(o);
    }
  }
}

DI void hyena_norm_unit(const Params& p, int unit, char* smem) {
  float* tile = (float*)smem;
  const int tid = opaque_tid();
  const int tt = unit & 63, g = (unit >> 6) & 7, b = unit >> 9;
  const float* z2T = (const float*)(p.ws + OFF_Z2T);
  u16* A2 = (u16*)(p.ws + OFF_A2);
  __syncthreads();
#pragma unroll 4
  for (int i = 0; i < 16; ++i) {
    const int cl = (tid >> 6) + 4 * i, tl = tid & 63;
    tile[cl * 65 + tl] = z2T[((size_t)(b * 512 + g * 64 + cl)) * 4096 + tt * 64 + tl];
  }
  __syncthreads();
  const int tl = tid >> 2, qd = tid & 3;
  float v[16];
  float ss = 0.f;
#pragma unroll
  for (int i = 0; i < 16; ++i) {
    v[i] = tile[(qd * 16 + i) * 65 + tl];
    ss += v[i] * v[i];
  }
  ss += __shfl_xor(ss, 1, 64);
  ss += __shfl_xor(ss, 2, 64);
  const float rs = rsqrtf(ss * (1.f / 64.f) + EPS);
  const size_t T = (size_t)b * 4096 + tt * 64 + tl;
  u16* dst = A2 + T * 1024 + 512 + g * 64 + qd * 16;
  const float* w = p.hyena_norm_w + g * 64 + qd * 16;
  float o[16];
#pragma unroll
  for (int i = 0; i < 16; ++i) o[i] = v[i] * rs * w[i];
  *(bf16x8*)(dst) = pack8(o);
  *(bf16x8*)(dst + 8) = pack8(o + 8);
}

template <int EPI>
DI void gemm_phase(const u16* A, const u16* Bt, int K, int ntn, void* outp, char* smem) {
  const int tid = threadIdx.x, lane = tid & 63, wave = tid >> 6, wr = wave >> 1, wc = wave & 1, lr = lane & 31, hh = lane >> 5;
  const int ntiles = tile_count(ntn);
  for (int id = blockIdx.x; id < ntiles; id += gridDim.x) {
    int mt, nt;
    tile_map(id, ntn, mt, nt);
    if (nt >= ntn) continue;
    const int m0 = mt * 256, n0 = nt * 128;
    f32x16 acc[4][2];
    gemm_core<false>(A, Bt, K, m0, n0, smem, acc);
    if (EPI == 0) {
#pragma unroll
      for (int i = 0; i < 4; ++i)
#pragma unroll
        for (int j = 0; j < 2; ++j)
#pragma unroll
          for (int r = 0; r < 16; ++r) {
            const int row = m0 + wr * 128 + i * 32 + crow(r, hh);
            const int col = n0 + wc * 64 + j * 32 + lr;
            ((float*)outp)[(size_t)row * 1024 + col] = acc[i][j][r];
          }
    } else {
      char* wl = smem + wave * 16384;
      stage_tile_ns<2>(acc, wl, lr, hh);
      wave_lds_sync();
      flush_tile_ns(wl, (u16*)outp + (size_t)(m0 + wr * 128) * 4096 + n0 + wc * 64, 4096, lane);
    }
  }
}

DI void phase_post_mix(const Params& p) {
  const int tid = threadIdx.x, lane = tid & 63, wave = tid >> 6;
  const float* mix = p.out;
  float* x1 = (float*)(p.ws + OFF_X1);
  u16* hm = (u16*)(p.ws + OFF_HM);
  for (int u = blockIdx.x; u < 1024; u += gridDim.x) {
#pragma unroll 2
    for (int rr = 0; rr < 4; ++rr) {
      const size_t row = (size_t)u * 16 + wave * 4 + rr;
      float4 mv[4], xv[4];
      float ss = 0.f;
#pragma unroll
      for (int i = 0; i < 4; ++i) {
        mv[i] = ((const float4*)(mix + row * DM))[lane + 64 * i];
        xv[i] = ((const float4*)(p.x + row * DM))[lane + 64 * i];
        ss += mv[i].x * mv[i].x + mv[i].y * mv[i].y + mv[i].z * mv[i].z + mv[i].w * mv[i].w;
      }
      ss = wave_sum(ss);
      const float rs = rsqrtf(ss * (1.f / DM) + EPS);
      float s2 = 0.f;
#pragma unroll
      for (int i = 0; i < 4; ++i) {
        const float4 w = ((const float4*)p.norm_mix_post)[lane + 64 * i];
        xv[i].x += mv[i].x * rs * w.x; xv[i].y += mv[i].y * rs * w.y; xv[i].z += mv[i].z * rs * w.z; xv[i].w += mv[i].w * rs * w.w;
        s2 += xv[i].x * xv[i].x + xv[i].y * xv[i].y + xv[i].z * xv[i].z + xv[i].w * xv[i].w;
        ((float4*)(x1 + row * DM))[lane + 64 * i] = xv[i];
      }
      s2 = wave_sum(s2);
      const float r2 = rsqrtf(s2 * (1.f / DM) + EPS);
#pragma unroll
      for (int i = 0; i < 4; ++i) {
        const float4 w = ((const float4*)p.norm_mlp_pre)[lane + 64 * i];
        ushort4 o;
        o.x = f2bf(xv[i].x * r2 * w.x); o.y = f2bf(xv[i].y * r2 * w.y); o.z = f2bf(xv[i].z * r2 * w.z); o.w = f2bf(xv[i].w * r2 * w.w);
        *(ushort4*)(hm + row * DM + (lane + 64 * i) * 4) = o;
      }
    }
  }
}

DI void phase_final(const Params& p) {
  const int tid = threadIdx.x, lane = tid & 63, wave = tid >> 6;
  const float* x1 = (const float*)(p.ws + OFF_X1);
  for (int u = blockIdx.x; u < 1024; u += gridDim.x) {
#pragma unroll 2
    for (int rr = 0; rr < 4; ++rr) {
      const size_t row = (size_t)u * 16 + wave * 4 + rr;
      float4 fv[4];
      float ss = 0.f;
#pragma unroll
      for (int i = 0; i < 4; ++i) {
        fv[i] = ((const float4*)(p.out + row * DM))[lane + 64 * i];
        ss += fv[i].x * fv[i].x + fv[i].y * fv[i].y + fv[i].z * fv[i].z + fv[i].w * fv[i].w;
      }
      ss = wave_sum(ss);
      const float rs = rsqrtf(ss * (1.f / DM) + EPS);
#pragma unroll
      for (int i = 0; i < 4; ++i) {
        const float4 w = ((const float4*)p.norm_mlp_post)[lane + 64 * i];
        const float4 xv = ((const float4*)(x1 + row * DM))[lane + 64 * i];
        float4 o;
        o.x = xv.x + fv[i].x * rs * w.x; o.y = xv.y + fv[i].y * rs * w.y; o.z = xv.z + fv[i].z * rs * w.z; o.w = xv.w + fv[i].w * rs * w.w;
        ((float4*)(p.out + row * DM))[lane + 64 * i] = o;
      }
    }
  }
}

DI void run_phase(const Params& p, int ph, char* smem) {
  switch (ph) {
    case 0: phase0(p, smem); break;
    case 1: phase1(p, smem); break;
    case 2: phase_qk(p, smem); break;
    case 3:
#ifdef DBL_HYONLY
      for (int u = blockIdx.x; u < 512; u += gridDim.x) hyena_unit(p, u, smem);
#endif
#ifdef DBL_MLONLY
      for (int u = blockIdx.x; u < 1024; u += gridDim.x) mlstm_local_unit(p, u, smem);
#endif
      for (int u = blockIdx.x; u < 512 + 1024; u += gridDim.x) {
        if (u < 512) hyena_unit(p, u, smem);
        else mlstm_local_unit(p, u - 512, smem);
      }
      break;
    case 4:
      for (int u = blockIdx.x; u < 512; u += gridDim.x) scan_unit(p, u);
      break;
    case 5:
      for (int u = blockIdx.x; u < 512 + 2048; u += gridDim.x) {
#ifndef DBG_SKIP_MLSTM
        if (u < 512) mlstm_out_unit(p, u, smem);
#else
        if (u < 512) { u16* A2 = (u16*)(p.ws + OFF_A2); const int T0 = (u >> 5 >> 2) * 4096 + (u & 31) * 128, hq = (u >> 5) & 3;
          for (int i = threadIdx.x; i < 128 * 128; i += 256) A2[(size_t)(T0 + (i >> 7)) * 1024 + hq * 128 + (i & 127)] = 0; }
#endif
#ifndef DBG_SKIP_HYENA
        else hyena_norm_unit(p, u - 512, smem);
#else
        else { const int un = u - 512; const int tt = un & 63, g = (un >> 6) & 7, b = un >> 9; u16* A2 = (u16*)(p.ws + OFF_A2);
          for (int i = threadIdx.x; i < 64 * 64; i += 256) A2[((size_t)b * 4096 + tt * 64 + (i >> 6)) * 1024 + 512 + g * 64 + (i & 63)] = 0x3F80; }
#endif
      }
      break;
    case 6: gemm_phase<0>((const u16*)(p.ws + OFF_A2), (const u16*)(p.ws + OFF_WOUTT), 1024, 8, p.out, smem); break;
    case 7: phase_post_mix(p); break;
    case 8: gemm_phase<1>((const u16*)(p.ws + OFF_HM), (const u16*)(p.ws + OFF_W1T), 1024, 32, p.ws + OFF_H, smem); break;
    case 9: gemm_phase<0>((const u16*)(p.ws + OFF_H), (const u16*)(p.ws + OFF_W2T), 4096, 8, p.out, smem); break;
    case 10: phase_final(p); break;
  }
}
constexpr int NPHASE = 11;

#define XB_XCNT(j)  (256  + 64 * (j))
#define XB_XSUB(j)  (1280 + 64 * (j))
#define XB_XGEN(j)  (2304 + 64 * (j))
#define XB_TOP      3328
#define XB_TOPGEN   3392
#define XCD_BAR_WORDS 3456
DI unsigned xb_ld(unsigned* p) { return __hip_atomic_load(p, __ATOMIC_RELAXED, __HIP_MEMORY_SCOPE_AGENT); }
DI unsigned xb_add(unsigned* p, unsigned v) { return __hip_atomic_fetch_add(p, v, __ATOMIC_RELAXED, __HIP_MEMORY_SCOPE_AGENT); }
DI unsigned xb_xcc_id() { return (unsigned)__builtin_amdgcn_s_getreg((3 << 11) | 20) & 0xFu; }
struct XcdBar { unsigned* bar; unsigned x, nloc, nx; };
DI void xcd_barrier(XcdBar& b) {
  asm volatile("s_waitcnt vmcnt(0)" ::: "memory");
  __syncthreads();
  if (threadIdx.x == 0) {
    unsigned* bar = b.bar;
    __builtin_amdgcn_s_waitcnt(0);
    if (b.nloc == 0u) {
      const unsigned G = gridDim.x;
      unsigned sum, cnt, mine;
      for (;;) {
        sum = 0u; cnt = 0u; mine = 0u;
#pragma unroll
        for (unsigned j = 0; j < 16; ++j) { const unsigned c = xb_ld(&bar[XB_XCNT(j)]); sum += c; cnt += (c > 0u) ? 1u : 0u; mine = (j == b.x) ? c : mine; }
        if (sum == G) break;
        __builtin_amdgcn_s_sleep(1);
      }
      b.nloc = mine > 0u ? mine : 1u; b.nx = cnt > 0u ? cnt : 1u;
    }
    const unsigned nloc = b.nloc, nx = b.nx;
    const unsigned old = xb_add(&bar[XB_XSUB(b.x)], 1u);
    const unsigned gen = old / nloc;
    if (old + 1u == (gen + 1u) * nloc) {
      __builtin_amdgcn_fence(__ATOMIC_RELEASE, "agent");
      asm volatile("s_waitcnt vmcnt(0)" ::: "memory");
      const unsigned og = xb_add(&bar[XB_TOP], 1u);
      const unsigned tg = og / nx;
      if (og + 1u == (tg + 1u) * nx) xb_add(&bar[XB_TOPGEN], 1u);
      else while (xb_ld(&bar[XB_TOPGEN]) == tg) __builtin_amdgcn_s_sleep(1);
      __builtin_amdgcn_fence(__ATOMIC_ACQUIRE, "agent");
      xb_add(&bar[XB_XGEN(b.x)], 1u);
      asm volatile("s_waitcnt vmcnt(0)" ::: "memory");
    } else {
      while (xb_ld(&bar[XB_XGEN(b.x)]) == gen) __builtin_amdgcn_s_sleep(1);
      __builtin_amdgcn_fence(__ATOMIC_ACQUIRE, "agent");
      asm volatile("s_waitcnt vmcnt(0)" ::: "memory");
    }
  }
  __syncthreads();
}

#if MULTI_LAUNCH
template <int PH>
__global__ void __launch_bounds__(256, 2) phase_kernel(Params p) {
  __shared__ __attribute__((aligned(16))) char smem[65536];
  run_phase(p, PH, smem);
}
template <int PH>
static void launch_phase(const Params& p, hipStream_t stream) {
  hipLaunchKernelGGL(phase_kernel<PH>, dim3(512), dim3(256), 0, stream, p);
}
#else
__global__ void __launch_bounds__(256, 2) mega_kernel(Params p) {
  __shared__ __attribute__((aligned(16))) char smem[65536];
  cg::grid_group grid = cg::this_grid();
  XcdBar xb;
  xb.bar = (unsigned*)(p.ws + OFF_BAR); xb.x = xb_xcc_id(); xb.nloc = 0u; xb.nx = 0u;
  if (p.ws == nullptr) grid.sync();
  if (threadIdx.x == 0) (void)xb_add(&xb.bar[XB_XCNT(xb.x)], 1u);
#define GSYNC xcd_barrier(xb)
#ifdef DBL_P0
  run_phase(p, 0, smem);
#endif
  run_phase(p, 0, smem); GSYNC;
  run_phase(p, 1, smem); GSYNC;
#ifdef DBL_GEMM
  run_phase(p, 1, smem); grid.sync();
#endif
  run_phase(p, 2, smem); GSYNC;
#ifdef DBL_P2
  run_phase(p, 2, smem); GSYNC;
#endif
  run_phase(p, 3, smem); GSYNC;
#ifdef DBL_HY
  run_phase(p, 3, smem); GSYNC;
#endif
  run_phase(p, 4, smem); GSYNC;
  run_phase(p, 5, smem); GSYNC;
#ifdef DBL_P5
  run_phase(p, 5, smem); GSYNC;
#endif
  run_phase(p, 6, smem); GSYNC;
#ifdef DBL_GEMM
  run_phase(p, 6, smem); GSYNC;
#endif
  run_phase(p, 7, smem); GSYNC;
#ifdef DBL_P7
  run_phase(p, 7, smem); GSYNC;
#endif
  run_phase(p, 8, smem); GSYNC;
#ifdef DBL_GEMM
  run_phase(p, 8, smem); GSYNC;
#endif
  run_phase(p, 9, smem); GSYNC;
#ifdef DBL_GEMM
  run_phase(p, 9, smem); GSYNC;
#endif
#ifdef XSYNC
  for (int q = 0; q < 10; ++q) GSYNC;
#endif
  run_phase(p, 10, smem);
}
#endif

extern "C" void kernel_launch(void* const* d_in, const int* in_sizes, int n_in, void* d_out, int out_size, void* d_ws,
                              size_t ws_size, hipStream_t stream) {
  Params p{};
  const float** pp = (const float**)&p;
  for (int i = 0; i < 23; ++i) pp[i] = (const float*)d_in[i];
  p.out = (float*)d_out;
  p.ws = (char*)d_ws;
#if MULTI_LAUNCH
  launch_phase<0>(p, stream);
#ifdef DBL_P0
  launch_phase<0>(p, stream);
#endif
 launch_phase<1>(p, stream); launch_phase<2>(p, stream); launch_phase<3>(p, stream);
#ifdef DBL_HY
  launch_phase<3>(p, stream);
#endif

  launch_phase<4>(p, stream); launch_phase<5>(p, stream);
#ifdef DBL_P5
  launch_phase<5>(p, stream);
#endif
 launch_phase<6>(p, stream); launch_phase<7>(p, stream);
  launch_phase<8>(p, stream); launch_phase<9>(p, stream); launch_phase<10>(p, stream);
#else
  static int grid_blocks = 0;
  if (!grid_blocks) {
    int dev = 0, cus = 0, per_cu = 0;
    hipGetDevice(&dev);
    hipDeviceGetAttribute(&cus, hipDeviceAttributeMultiprocessorCount, dev);
    hipOccupancyMaxActiveBlocksPerMultiprocessor(&per_cu, mega_kernel, 256, 0);
    if (per_cu > 2) per_cu = 2;
    if (per_cu < 1) per_cu = 1;
#ifdef FORCE2
    per_cu = 2;
#endif
    grid_blocks = cus * per_cu;
  }
  hipMemsetAsync((char*)d_ws + OFF_BAR, 0, XCD_BAR_WORDS * 4, stream);
  void* args[] = {&p};
  hipError_t e = hipLaunchCooperativeKernel((void*)mega_kernel, dim3(grid_blocks), dim3(256), args, 0, stream);
  if (e != hipSuccess) fprintf(stderr, "cooperative launch failed: %s (grid %d)\n", hipGetErrorString(e), grid_blocks);
#endif
}
#if defined(__HIP_DEVICE_COMPILE__)
#pragma clang attribute pop
#endif
```

```cpp
#if defined(__HIP_DEVICE_COMPILE__)
#pragma clang attribute push(__attribute__((target("no-packed-fp32-ops"))), apply_to = function)
#endif
#include <hip/hip_runtime.h>
#include <hip/hip_cooperative_groups.h>
#include <cstdio>
namespace cg = cooperative_groups;

#ifndef MULTI_LAUNCH
#define MULTI_LAUNCH 0
#endif

typedef unsigned short u16;
using bf16x8 = __attribute__((ext_vector_type(8))) short;
using f32x16 = __attribute__((ext_vector_type(16))) float;
#define DI __device__ __forceinline__
#define MFMA(a, b, c) __builtin_amdgcn_mfma_f32_32x32x16_bf16((a), (b), (c), 0, 0, 0)

constexpr int SEQ = 4096, DM = 1024, NTOK = 16384, NIN = 3600, NINP = 3712, DFF = 4096;
constexpr float EPS = 1e-6f;
constexpr size_t MiB = 1u << 20;
constexpr size_t OFF_WINT = 0, OFF_WOUTT = 8 * MiB, OFF_W1T = 10 * MiB, OFF_W2T = 18 * MiB;
constexpr size_t OFF_XN = 26 * MiB, OFF_QA = 26 * MiB, OFF_KA = 42 * MiB;
constexpr size_t OFF_FILT = 58 * MiB, OFF_QKPRE = 90 * MiB, OFF_A2 = 90 * MiB;
constexpr size_t OFF_HYT = 122 * MiB, OFF_VT = 170 * MiB, OFF_OG = 186 * MiB, OFF_GATES = 202 * MiB;
constexpr size_t OFF_NL = 203 * MiB, OFF_MLOC = 203 * MiB + 512 * 1024, OFF_GSUM = OFF_MLOC + 4096, OFF_MS = OFF_GSUM + 4096;
constexpr size_t OFF_KAT = 205 * MiB, OFF_Z2T = 221 * MiB;
constexpr size_t OFF_TW = 204 * MiB, OFF_BAR = 254 * MiB;
constexpr size_t OFF_X1 = 26 * MiB, OFF_HM = 90 * MiB, OFF_H = 122 * MiB;

struct Params {
  const float *x, *norm_mix_pre, *norm_mix_post, *norm_mlp_pre, *norm_mlp_post, *w_in, *b_gates, *conv_w, *conv_b,
      *mlstm_norm_w, *hyena_norm_w, *filt_w1, *filt_b1, *filt_w2, *filt_b2, *filt_w3, *filt_b3, *filt_w4, *filt_freq,
      *filt_bias, *w_out, *w_mlp_in, *w_mlp_out;
  float* out;
  char* ws;
};

DI u16 f2bf(float x) { unsigned u = __float_as_uint(x); u += 0x7fffu + ((u >> 16) & 1u); return (u16)(u >> 16); }
DI float bf2f(u16 v) { return __uint_as_float(((unsigned)v) << 16); }
DI int opaque_tid() { int t = threadIdx.x; asm volatile("" : "+v"(t)); return t; }
DI int crow(int r, int hh) { return (r & 3) + 8 * (r >> 2) + 4 * hh; }
DI float log_sigmoid(float x) { return fminf(x, 0.f) - log1pf(expf(-fabsf(x))); }
DI float sigmoidf(float x) { return 1.f / (1.f + expf(-x)); }
DI float red2pi(float x) {
  const float k = rintf(x * 0.15915494309189535f);
  float r = fmaf(-k, 6.28125f, x);
  return fmaf(-k, 1.9353071795864769e-3f, r);
}
DI float fsin(float x) { return sinf(x); }
DI float fcos(float x) { return cosf(x); }
DI bf16x8 pack8(const float* v) {
  bf16x8 r;
#pragma unroll
  for (int i = 0; i < 8; ++i) r[i] = (short)f2bf(v[i]);
  return r;
}
DI bf16x8 scale8(bf16x8 a, float s) {
  bf16x8 r;
#pragma unroll
  for (int i = 0; i < 8; ++i) r[i] = (short)f2bf(bf2f((u16)a[i]) * s);
  return r;
}

template <bool SWAP>
DI void gemm_core(const u16* __restrict__ A, const u16* __restrict__ Bt, int K, int m0, int n0, char* smem, f32x16 (&acc)[4][2]) {
  const int tid = opaque_tid(), lane = tid & 63, wave = tid >> 6, wr = wave >> 1, wc = wave & 1;
  const int lr = lane & 31, hh = lane >> 5;
#pragma unroll
  for (int i = 0; i < 4; ++i)
#pragma unroll
    for (int j = 0; j < 2; ++j)
#pragma unroll
      for (int r = 0; r < 16; ++r) acc[i][j][r] = 0.f;
  const int c = tid & 7, r0 = tid >> 3;
  const u16* Ag = A + (size_t)(m0 + r0) * K + c * 8;
  const u16* Bg = Bt + (size_t)(n0 + r0) * K + c * 8;
  const int soff = r0 * 128 + ((c ^ ((r0 >> 1) & 7)) << 4);
  char* As = smem;
  char* Bs = smem + 32768;
  uint4 ra0, ra1, ra2, ra3, ra4, ra5, ra6, ra7, rb0, rb1, rb2, rb3;
#define GLOAD_ALL(k0)                                                                                             \
  ra0 = *(const uint4*)(Ag + (size_t)(0) * K + (k0));   ra1 = *(const uint4*)(Ag + (size_t)(32) * K + (k0));      \
  ra2 = *(const uint4*)(Ag + (size_t)(64) * K + (k0));  ra3 = *(const uint4*)(Ag + (size_t)(96) * K + (k0));      \
  ra4 = *(const uint4*)(Ag + (size_t)(128) * K + (k0)); ra5 = *(const uint4*)(Ag + (size_t)(160) * K + (k0));     \
  ra6 = *(const uint4*)(Ag + (size_t)(192) * K + (k0)); ra7 = *(const uint4*)(Ag + (size_t)(224) * K + (k0));     \
  rb0 = *(const uint4*)(Bg + (size_t)(0) * K + (k0));   rb1 = *(const uint4*)(Bg + (size_t)(32) * K + (k0));      \
  rb2 = *(const uint4*)(Bg + (size_t)(64) * K + (k0));  rb3 = *(const uint4*)(Bg + (size_t)(96) * K + (k0));
  GLOAD_ALL(0)
  const int nk = K >> 6;
#pragma unroll 1
  for (int kt = 0; kt < nk; ++kt) {
    __syncthreads();
    *(uint4*)(As + soff + 0 * 4096) = ra0; *(uint4*)(As + soff + 1 * 4096) = ra1; *(uint4*)(As + soff + 2 * 4096) = ra2; *(uint4*)(As + soff + 3 * 4096) = ra3;
    *(uint4*)(As + soff + 4 * 4096) = ra4; *(uint4*)(As + soff + 5 * 4096) = ra5; *(uint4*)(As + soff + 6 * 4096) = ra6; *(uint4*)(As + soff + 7 * 4096) = ra7;
    *(uint4*)(Bs + soff + 0 * 4096) = rb0; *(uint4*)(Bs + soff + 1 * 4096) = rb1; *(uint4*)(Bs + soff + 2 * 4096) = rb2; *(uint4*)(Bs + soff + 3 * 4096) = rb3;
    __syncthreads();
    if (kt + 1 < nk) {
      const int k0 = (kt + 1) << 6;
      GLOAD_ALL(k0)
    }
#pragma unroll
    for (int kk = 0; kk < 4; ++kk) {
      bf16x8 a[4], b[2];
      const int cc = kk * 2 + hh;
#pragma unroll
      for (int i = 0; i < 4; ++i) {
        const int r = wr * 128 + i * 32 + lr;
        a[i] = *(const bf16x8*)(As + r * 128 + ((cc ^ ((r >> 1) & 7)) << 4));
      }
#pragma unroll
      for (int j = 0; j < 2; ++j) {
        const int r = wc * 64 + j * 32 + lr;
        b[j] = *(const bf16x8*)(Bs + r * 128 + ((cc ^ ((r >> 1) & 7)) << 4));
      }
#pragma unroll
      for (int i = 0; i < 4; ++i)
#pragma unroll
        for (int j = 0; j < 2; ++j) acc[i][j] = SWAP ? MFMA(b[j], a[i], acc[i][j]) : MFMA(a[i], b[j], acc[i][j]);
    }
  }
  __syncthreads();
}

DI void tile_map(int id, int ntn, int& mt, int& nt) {
  const int r = id >> 9, b = id & 511;
  const int x = b & 7, sidx = b >> 3;
  const int P = r * 8 + x;
  mt = (P & 7) * 8 + (sidx & 7);
  nt = (P >> 3) * 8 + (sidx >> 3);
}
DI int tile_count(int ntn) { return ((ntn + 7) >> 3) * 512; }

DI void transpose_tile(const float* __restrict__ src, int R, int C, u16* __restrict__ dst, int kt, int nt, char* smem) {
  float* tile = (float*)smem;
  const int tid = threadIdx.x;
  const int k0 = kt * 64, n0 = nt * 64;
#pragma unroll 4
  for (int it = 0; it < 16; ++it) {
    const int kk = it * 4 + (tid >> 6), nn = tid & 63;
    const int n = n0 + nn;
    tile[kk * 65 + nn] = (n < C) ? src[(size_t)(k0 + kk) * C + n] : 0.f;
  }
  __syncthreads();
#pragma unroll
  for (int it = 0; it < 2; ++it) {
    const int q = tid + 256 * it, nn = q >> 3, kc = q & 7;
    float o[8];
#pragma unroll
    for (int i = 0; i < 8; ++i) o[i] = tile[(kc * 8 + i) * 65 + nn];
    *(bf16x8*)(dst + (size_t)(n0 + nn) * R + k0 + kc * 8) = pack8(o);
  }
  __syncthreads();
}

DI float wave_sum(float v) {
#pragma unroll
  for (int o = 32; o; o >>= 1) v += __shfl_xor(v, o, 64);
  return v;
}

DI void filter_unit(const Params& p, int unit, char* smem) {
  float* sz = (float*)smem;
  float* hA = sz + 8 * 33 + 8;
  float* hB = hA + 8 * 64;
  float* hT = hB + 8 * 64;
  const int tid = opaque_tid();
  const int l0 = unit * 8;
  for (int idx = tid; idx < 8 * 33; idx += 256) {
    const int pp = idx / 33, f = idx - pp * 33;
    const float l = (float)(l0 + pp);
    float v;
    if (f == 0) v = l / 4095.f;
    else {
      const int jb = (f - 1) & 15;
      const float fj = 1e-4f + (float)jb * ((15.f - 1e-4f) / 15.f);
      const float ang = 6.283185307179586f * l / 4096.f;
      v = (f <= 16) ? fcos(fj * ang) : -fsin(fj * ang);
    }
    sz[idx] = v;
  }
  const int o = tid & 63, pq = tid >> 6;
  {
    const float bb = p.filt_b1[o], fr = p.filt_freq[o];
    __syncthreads();
    float s0 = bb, s1 = bb;
#pragma unroll 1
    for (int f0 = 0; f0 < 33; f0 += 11) {
      float wc[11];
#pragma unroll
      for (int f = 0; f < 11; ++f) wc[f] = p.filt_w1[(f0 + f) * 64 + o];
#pragma unroll
      for (int f = 0; f < 11; ++f) { s0 += sz[pq * 33 + f0 + f] * wc[f]; s1 += sz[(pq + 4) * 33 + f0 + f] * wc[f]; }
    }
    hA[pq * 64 + o] = fsin(fr * s0);
    hA[(pq + 4) * 64 + o] = fsin(fr * s1);
  }
  {
    const float bb = p.filt_b2[o], fr = p.filt_freq[64 + o];
    __syncthreads();
    float s0 = bb, s1 = bb;
#pragma unroll 1
    for (int k0 = 0; k0 < 64; k0 += 16) {
      float wc[16];
#pragma unroll
      for (int k = 0; k < 16; ++k) wc[k] = p.filt_w2[(k0 + k) * 64 + o];
#pragma unroll
      for (int k = 0; k < 16; ++k) { s0 += hA[pq * 64 + k0 + k] * wc[k]; s1 += hA[(pq + 4) * 64 + k0 + k] * wc[k]; }
    }
    hB[pq * 64 + o] = fsin(fr * s0);
    hB[(pq + 4) * 64 + o] = fsin(fr * s1);
  }
  {
    const float bb = p.filt_b3[o], fr = p.filt_freq[128 + o];
    __syncthreads();
    float s0 = bb, s1 = bb;
#pragma unroll 1
    for (int k0 = 0; k0 < 64; k0 += 16) {
      float wc[16];
#pragma unroll
      for (int k = 0; k < 16; ++k) wc[k] = p.filt_w3[(k0 + k) * 64 + o];
#pragma unroll
      for (int k = 0; k < 16; ++k) { s0 += hB[pq * 64 + k0 + k] * wc[k]; s1 += hB[(pq + 4) * 64 + k0 + k] * wc[k]; }
    }
    hT[o * 8 + pq] = fsin(fr * s0);
    hT[o * 8 + pq + 4] = fsin(fr * s1);
  }
  __syncthreads();
  float* filt = (float*)(p.ws + OFF_FILT);
  const float min_decay = -3.0701134573253944f, max_decay = -15.350567286626973f;
#pragma unroll 1
  for (int cc = 0; cc < 8; ++cc) {
    const int col = tid + 256 * cc;
    float acc[8];
#pragma unroll
    for (int q = 0; q < 8; ++q) acc[q] = 0.f;
#pragma unroll 1
    for (int k0 = 0; k0 < 64; k0 += 16) {
      float wc[16];
#pragma unroll
      for (int k = 0; k < 16; ++k) wc[k] = p.filt_w4[(k0 + k) * 2048 + col];
#pragma unroll
      for (int k = 0; k < 16; ++k) {
        const float4 h0 = *(const float4*)(hT + (k0 + k) * 8);
        const float4 h1 = *(const float4*)(hT + (k0 + k) * 8 + 4);
        acc[0] += h0.x * wc[k]; acc[1] += h0.y * wc[k]; acc[2] += h0.z * wc[k]; acc[3] += h0.w * wc[k];
        acc[4] += h1.x * wc[k]; acc[5] += h1.y * wc[k]; acc[6] += h1.z * wc[k]; acc[7] += h1.w * wc[k];
      }
    }
    const int ch = col & 511;
    const float delta = fabsf(min_decay + (float)ch * ((max_decay - min_decay) / 511.f));
#pragma unroll
    for (int q = 0; q < 8; ++q) {
      const float t = (float)(l0 + q) / 4095.f;
      acc[q] *= expf(-t * delta);
    }
    float4* dst = (float4*)(filt + (size_t)col * 4096 + l0);
    dst[0] = make_float4(acc[0], acc[1], acc[2], acc[3]);
    dst[1] = make_float4(acc[4], acc[5], acc[6], acc[7]);
  }
  __syncthreads();
}

DI void phase0(const Params& p, char* smem) {
  const int tid = threadIdx.x, lane = tid & 63, wave = tid >> 6;
  const int U_W = 32, U_F = 512, U_X = 1024, U_T1 = 58 * 16, U_T2 = 256, U_T3 = 1024, U_T4 = 1024;
  const int total = U_W + U_F + U_X + U_T1 + U_T2 + U_T3 + U_T4;
  for (int u = blockIdx.x; u < total; u += gridDim.x) {
    int v = u;
    if (v < U_W) {
      const int idx = v * 256 + tid;
      if (idx < 8191) {
        const int lh = 31 - __clz(idx + 1);
        const int h = 1 << lh, jj = idx + 1 - h;
        float2* twp = (float2*)(p.ws + OFF_TW);
        const float ang = -3.14159265358979f * (float)jj / (float)h;
        twp[idx] = make_float2(cosf(ang), sinf(ang));
      }
      continue;
    }
    v -= U_W;
    if (v < U_F) { filter_unit(p, v, smem); continue; }
    v -= U_F;
    if (v < U_X) {
      u16* xn = (u16*)(p.ws + OFF_XN);
#pragma unroll 4
      for (int rr = 0; rr < 4; ++rr) {
        const int row = v * 16 + wave * 4 + rr;
        const float4* xr = (const float4*)(p.x + (size_t)row * DM);
        float4 xv[4];
        float ss = 0.f;
#pragma unroll
        for (int i = 0; i < 4; ++i) {
          xv[i] = xr[lane + 64 * i];
          ss += xv[i].x * xv[i].x + xv[i].y * xv[i].y + xv[i].z * xv[i].z + xv[i].w * xv[i].w;
        }
        ss = wave_sum(ss);
        const float rs = rsqrtf(ss * (1.f / DM) + EPS);
#pragma unroll
        for (int i = 0; i < 4; ++i) {
          const float4 w = ((const float4*)p.norm_mix_pre)[lane + 64 * i];
          ushort4 o;
          o.x = f2bf(xv[i].x * rs * w.x); o.y = f2bf(xv[i].y * rs * w.y); o.z = f2bf(xv[i].z * rs * w.z); o.w = f2bf(xv[i].w * rs * w.w);
          *(ushort4*)(xn + (size_t)row * DM + (lane + 64 * i) * 4) = o;
        }
      }
      continue;
    }
    v -= U_X;
    if (v < U_T1) { transpose_tile(p.w_in, DM, NIN, (u16*)(p.ws + OFF_WINT), v & 15, v >> 4, smem); continue; }
    v -= U_T1;
    if (v < U_T2) { transpose_tile(p.w_out, DM, DM, (u16*)(p.ws + OFF_WOUTT), v & 15, v >> 4, smem); continue; }
    v -= U_T2;
    if (v < U_T3) { transpose_tile(p.w_mlp_in, DM, DFF, (u16*)(p.ws + OFF_W1T), v & 15, v >> 4, smem); continue; }
    v -= U_T3;
    transpose_tile(p.w_mlp_out, DFF, DM, (u16*)(p.ws + OFF_W2T), v & 63, v >> 6, smem);
  }
}

DI void wave_lds_sync() { asm volatile("s_waitcnt lgkmcnt(0)" ::: "memory"); __builtin_amdgcn_wave_barrier(); }
template <int MODE>
DI void stage_tile_ns(const f32x16 (&acc)[4][2], char* wl, int lr, int hh) {
#pragma unroll
  for (int i = 0; i < 4; ++i)
#pragma unroll
    for (int j = 0; j < 2; ++j)
#pragma unroll
      for (int r = 0; r < 16; ++r) {
        float v = acc[i][j][r];
        if (MODE == 1) v = sigmoidf(v);
        if (MODE == 2) { v = fmaxf(v, 0.f); v = v * v; }
        *(u16*)(wl + (i * 32 + crow(r, hh)) * 128 + (j * 32 + lr) * 2) = f2bf(v);
      }
}
DI void stage_tile_sw(const f32x16 (&acc)[4][2], char* wl, int lr, int hh) {
#pragma unroll
  for (int i = 0; i < 4; ++i)
#pragma unroll
    for (int j = 0; j < 2; ++j)
#pragma unroll
      for (int r = 0; r < 16; ++r) *(u16*)(wl + (j * 32 + crow(r, hh)) * 256 + (i * 32 + lr) * 2) = f2bf(acc[i][j][r]);
}
DI void flush_tile_ns(const char* wl, u16* dst, size_t pitch, int lane) {
#pragma unroll 4
  for (int it = 0; it < 16; ++it) {
    const int q = lane + 64 * it, row = q >> 3, c8 = q & 7;
    *(uint4*)(dst + (size_t)row * pitch + c8 * 8) = *(const uint4*)(wl + row * 128 + c8 * 16);
  }
}

DI void phase1(const Params& p, char* smem) {
  const int tid = threadIdx.x, lane = tid & 63, wave = tid >> 6, wr = wave >> 1, wc = wave & 1, lr = lane & 31, hh = lane >> 5;
  const u16* xn = (const u16*)(p.ws + OFF_XN);
  const u16* wt = (const u16*)(p.ws + OFF_WINT);
  u16* qkpre = (u16*)(p.ws + OFF_QKPRE);
  u16* hyT = (u16*)(p.ws + OFF_HYT);
  u16* vT = (u16*)(p.ws + OFF_VT);
  u16* og = (u16*)(p.ws + OFF_OG);
  float* gates = (float*)(p.ws + OFF_GATES);
  const int ntn = 29, ntiles = tile_count(ntn);
  for (int id = blockIdx.x; id < ntiles; id += gridDim.x) {
    int mt, nt;
    tile_map(id, ntn, mt, nt);
    if (nt >= ntn) continue;
    const int m0 = mt * 256, n0 = nt * 128;
    f32x16 acc[4][2];
    const bool swap = (nt >= 8 && nt < 24);
    if (swap) gemm_core<true>(xn, wt, DM, m0, n0, smem, acc);
    else gemm_core<false>(xn, wt, DM, m0, n0, smem, acc);
    char* wl = smem + wave * 16384;
    if (!swap) {
      if (nt < 28) {
        if (nt < 8) stage_tile_ns<0>(acc, wl, lr, hh); else stage_tile_ns<1>(acc, wl, lr, hh);
        wave_lds_sync();
        const size_t row0 = (size_t)(m0 + wr * 128);
        if (nt < 8) flush_tile_ns(wl, qkpre + row0 * 1024 + n0 + wc * 64, 1024, lane);
        else flush_tile_ns(wl, og + row0 * 512 + (n0 - 3072) + wc * 64, 512, lane);
      } else {
#pragma unroll
        for (int i = 0; i < 4; ++i)
#pragma unroll
          for (int r = 0; r < 16; ++r) {
            const int row = m0 + wr * 128 + i * 32 + crow(r, hh);
            if (wc == 0 && lr < 16) gates[(size_t)row * 16 + lr] = acc[i][0][r];
          }
      }
    } else {
      stage_tile_sw(acc, wl, lr, hh);
      wave_lds_sync();
      const int mrow = m0 + wr * 128, b = mrow >> 12, t0 = mrow & 4095;
#pragma unroll 4
      for (int it = 0; it < 16; ++it) {
        const int q = lane + 64 * it, chl = q >> 4, c16 = q & 15;
        const int n = n0 + wc * 64 + chl;
        u16* dst;
        if (nt < 20) { const int cc = n - 1024, g = cc >> 9, ch = cc & 511; dst = hyT + ((size_t)((g * 4 + b) * 512 + ch)) * 4096; }
        else dst = vT + ((size_t)(b * 512 + (n - 2560))) * 4096;
        *(uint4*)(dst + t0 + c16 * 8) = *(const uint4*)(wl + chl * 256 + c16 * 16);
      }
    }
  }
}

DI void phase_qk(const Params& p, char* smem) {
  const int tid = opaque_tid();
  const int cg = tid & 31, rg = tid >> 5;
  const u16* qkpre = (const u16*)(p.ws + OFF_QKPRE);
  u16* qa = (u16*)(p.ws + OFF_QA);
  u16* ka = (u16*)(p.ws + OFF_KA);
  u16* kaT = (u16*)(p.ws + OFF_KAT);
  for (int u = blockIdx.x; u < 1024; u += gridDim.x) {
    const int ct = u & 3, tt = u >> 2;
    const int C0 = ct * 256 + cg * 8;
    const int Tb = tt * 64 + rg * 8;
    const int tb = Tb & 4095;
    float w0[8], w1[8], w2[8], cb[8];
    {
      const float4 a0 = *(const float4*)(p.conv_w + C0), a1 = *(const float4*)(p.conv_w + C0 + 4);
      const float4 b0 = *(const float4*)(p.conv_w + 2560 + C0), b1 = *(const float4*)(p.conv_w + 2560 + C0 + 4);
      const float4 c0 = *(const float4*)(p.conv_w + 5120 + C0), c1 = *(const float4*)(p.conv_w + 5120 + C0 + 4);
      const float4 d0 = *(const float4*)(p.conv_b + C0), d1 = *(const float4*)(p.conv_b + C0 + 4);
      w0[0] = a0.x; w0[1] = a0.y; w0[2] = a0.z; w0[3] = a0.w; w0[4] = a1.x; w0[5] = a1.y; w0[6] = a1.z; w0[7] = a1.w;
      w1[0] = b0.x; w1[1] = b0.y; w1[2] = b0.z; w1[3] = b0.w; w1[4] = b1.x; w1[5] = b1.y; w1[6] = b1.z; w1[7] = b1.w;
      w2[0] = c0.x; w2[1] = c0.y; w2[2] = c0.z; w2[3] = c0.w; w2[4] = c1.x; w2[5] = c1.y; w2[6] = c1.z; w2[7] = c1.w;
      cb[0] = d0.x; cb[1] = d0.y; cb[2] = d0.z; cb[3] = d0.w; cb[4] = d1.x; cb[5] = d1.y; cb[6] = d1.z; cb[7] = d1.w;
    }
    bf16x8 rows[10];
    const u16* src = qkpre + (size_t)Tb * 1024 + C0;
#pragma unroll
    for (int r = 0; r < 10; ++r) {
      const int t = tb + r - 1;
      bf16x8 z;
#pragma unroll
      for (int i = 0; i < 8; ++i) z[i] = 0;
      rows[r] = (t >= 0 && t <= 4095) ? *(const bf16x8*)(src + (ptrdiff_t)(r - 1) * 1024) : z;
    }
    const bool isk = C0 >= 512;
    bf16x8 tr[8];
#pragma unroll
    for (int r = 0; r < 8; ++r) {
      bf16x8 o;
#pragma unroll
      for (int i = 0; i < 8; ++i) {
        const float val = w0[i] * bf2f((u16)rows[r][i]) + w1[i] * bf2f((u16)rows[r + 1][i]) + w2[i] * bf2f((u16)rows[r + 2][i]) + cb[i];
        float sv = val * sigmoidf(val);
        if (isk) sv *= 0.08838834764831845f;
        o[i] = (short)f2bf(sv);
        tr[i][r] = o[i];
      }
      if (!isk) *(bf16x8*)(qa + (size_t)(Tb + r) * 512 + C0) = o;
      else *(bf16x8*)(ka + (size_t)(Tb + r) * 512 + (C0 - 512)) = o;
    }
    if (isk) {
      const int b = Tb >> 12;
#pragma unroll
      for (int i = 0; i < 8; ++i) *(bf16x8*)(kaT + ((size_t)(b * 512 + (C0 - 512) + i)) * 4096 + tb) = tr[i];
    }
  }
}

DI float lz(float v) { asm volatile("" : "+v"(v)); return v; }
DI float2 mk2(float a, float b) { return make_float2(a, b); }
DI float2 cmul(float2 a, float2 w) { return mk2(a.x * w.x - a.y * w.y, a.x * w.y + a.y * w.x); }
DI float2 cmulc(float2 a, float2 w) { return mk2(a.x * w.x + a.y * w.y, a.y * w.x - a.x * w.y); }
DI int lx(int idx) { const int sw = (idx >> 5) & 3; return idx ^ (sw << 3) ^ (sw << 1); }
template <int NW, bool INV, bool INLX = false, bool OUTLX = false>
DI void r4_pass(float2* x, int tid, int q, const float2* __restrict__ t1, const float2* __restrict__ t2) {
  constexpr int NL = NW > 4 ? 4 : NW;
  constexpr int NB = NW > 4 ? 2 : 1;
  constexpr int CNT = 8 / NB;
#pragma unroll 1
  for (int bt = 0; bt < NB; ++bt) {
    float2 w1[NL], w2[NL];
#pragma unroll
    for (int n = 0; n < NL; ++n) { const int j = (tid + ((bt * CNT + n) << 8)) & (q - 1); w1[n] = t1[j]; w2[n] = t2[j]; }
    if (bt == 0) __syncthreads();
#pragma unroll(NL == 4 ? 4 : 2)
    for (int ii = 0; ii < CNT; ++ii) {
      const int k = tid + ((bt * CNT + ii) << 8);
      const int j = k & (q - 1);
      int base = ((k - j) << 2) + j;
      asm volatile("" : "+v"(base));
      const float2 ww1 = w1[ii % NL], ww2 = w2[ii % NL];
      const int i0_ = INLX ? lx(base) : base, i1_ = INLX ? lx(base + q) : base + q, i2_ = INLX ? lx(base + 2 * q) : base + 2 * q, i3_ = INLX ? lx(base + 3 * q) : base + 3 * q;
      const int o0_ = OUTLX ? lx(base) : base, o1_ = OUTLX ? lx(base + q) : base + q, o2_ = OUTLX ? lx(base + 2 * q) : base + 2 * q, o3_ = OUTLX ? lx(base + 3 * q) : base + 3 * q;
      const float2 x0 = x[i0_], x1 = x[i1_], x2 = x[i2_], x3 = x[i3_];
      if (!INV) {
        const float2 a0 = mk2(x0.x + x2.x, x0.y + x2.y);
        const float2 a1 = mk2(x1.x + x3.x, x1.y + x3.y);
        const float2 d02 = mk2(x0.x - x2.x, x0.y - x2.y);
        const float2 d13 = mk2(x1.y - x3.y, x3.x - x1.x);
        const float2 a2 = cmul(d02, ww1);
        const float2 a3 = cmul(d13, ww1);
        x[o0_] = mk2(a0.x + a1.x, a0.y + a1.y);
        x[o1_] = cmul(mk2(a0.x - a1.x, a0.y - a1.y), ww2);
        x[o2_] = mk2(a2.x + a3.x, a2.y + a3.y);
        x[o3_] = cmul(mk2(a2.x - a3.x, a2.y - a3.y), ww2);
      } else {
        const float2 b1 = cmulc(x1, ww2), b3 = cmulc(x3, ww2);
        const float2 a0 = mk2(x0.x + b1.x, x0.y + b1.y);
        const float2 a1 = mk2(x0.x - b1.x, x0.y - b1.y);
        const float2 a2 = mk2(x2.x + b3.x, x2.y + b3.y);
        const float2 a3 = mk2(x2.x - b3.x, x2.y - b3.y);
        const float2 c2 = cmulc(a2, ww1);
        const float2 c3t = cmulc(a3, ww1);
        const float2 c3 = mk2(-c3t.y, c3t.x);
        x[o0_] = mk2(a0.x + c2.x, a0.y + c2.y);
        x[o2_] = mk2(a0.x - c2.x, a0.y - c2.y);
        x[o1_] = mk2(a1.x + c3.x, a1.y + c3.y);
        x[o3_] = mk2(a1.x - c3.x, a1.y - c3.y);
      }
    }
  }
}
template <bool INV>
DI void r8_tail(float2* x, int tid) {
  const float R = 0.70710678118654752f;
#pragma unroll 2
  for (int i = 0; i < 4; ++i) {
    const int G = tid + (i << 8);
    const int sw = (G >> 2) & 3;
    const int blk = (G << 3) ^ (sw << 3);
    float4* p0 = (float4*)(x + blk + ((0 ^ sw) << 1));
    float4* p1 = (float4*)(x + blk + ((1 ^ sw) << 1));
    float4* p2 = (float4*)(x + blk + ((2 ^ sw) << 1));
    float4* p3 = (float4*)(x + blk + ((3 ^ sw) << 1));
    const float4 v0 = *p0, v1 = *p1, v2 = *p2, v3 = *p3;
    float2 e0 = make_float2(v0.x, v0.y), e1 = make_float2(v0.z, v0.w), e2 = make_float2(v1.x, v1.y), e3 = make_float2(v1.z, v1.w);
    float2 e4 = make_float2(v2.x, v2.y), e5 = make_float2(v2.z, v2.w), e6 = make_float2(v3.x, v3.y), e7 = make_float2(v3.z, v3.w);
    if (!INV) {
      const float2 s0 = mk2(e0.x + e4.x, e0.y + e4.y), d0 = mk2(e0.x - e4.x, e0.y - e4.y);
      const float2 s1 = mk2(e1.x + e5.x, e1.y + e5.y), t1 = mk2(e1.x - e5.x, e1.y - e5.y);
      const float2 s2 = mk2(e2.x + e6.x, e2.y + e6.y), t2 = mk2(e2.x - e6.x, e2.y - e6.y);
      const float2 s3 = mk2(e3.x + e7.x, e3.y + e7.y), t3 = mk2(e3.x - e7.x, e3.y - e7.y);
      const float2 d1 = mk2((t1.x + t1.y) * R, (t1.y - t1.x) * R);
      const float2 d2 = mk2(t2.y, -t2.x);
      const float2 d3 = mk2((t3.y - t3.x) * R, -(t3.x + t3.y) * R);
      const float2 a0 = mk2(s0.x + s2.x, s0.y + s2.y), a2 = mk2(s0.x - s2.x, s0.y - s2.y);
      const float2 a1 = mk2(s1.x + s3.x, s1.y + s3.y), u3 = mk2(s1.x - s3.x, s1.y - s3.y);
      const float2 a3 = mk2(u3.y, -u3.x);
      const float2 a4 = mk2(d0.x + d2.x, d0.y + d2.y), a6 = mk2(d0.x - d2.x, d0.y - d2.y);
      const float2 a5 = mk2(d1.x + d3.x, d1.y + d3.y), u7 = mk2(d1.x - d3.x, d1.y - d3.y);
      const float2 a7 = mk2(u7.y, -u7.x);
      *p0 = make_float4(a0.x + a1.x, a0.y + a1.y, a0.x - a1.x, a0.y - a1.y);
      *p1 = make_float4(a2.x + a3.x, a2.y + a3.y, a2.x - a3.x, a2.y - a3.y);
      *p2 = make_float4(a4.x + a5.x, a4.y + a5.y, a4.x - a5.x, a4.y - a5.y);
      *p3 = make_float4(a6.x + a7.x, a6.y + a7.y, a6.x - a7.x, a6.y - a7.y);
    } else {
      const float2 z0 = mk2(e0.x + e1.x, e0.y + e1.y), z1 = mk2(e0.x - e1.x, e0.y - e1.y);
      const float2 z2 = mk2(e2.x + e3.x, e2.y + e3.y), z3 = mk2(e2.x - e3.x, e2.y - e3.y);
      const float2 z4 = mk2(e4.x + e5.x, e4.y + e5.y), z5 = mk2(e4.x - e5.x, e4.y - e5.y);
      const float2 z6 = mk2(e6.x + e7.x, e6.y + e7.y), z7 = mk2(e6.x - e7.x, e6.y - e7.y);
      const float2 b3 = mk2(-z3.y, z3.x), b7 = mk2(-z7.y, z7.x);
      const float2 y0 = mk2(z0.x + z2.x, z0.y + z2.y), y2 = mk2(z0.x - z2.x, z0.y - z2.y);
      const float2 y1 = mk2(z1.x + b3.x, z1.y + b3.y), y3 = mk2(z1.x - b3.x, z1.y - b3.y);
      const float2 y4 = mk2(z4.x + z6.x, z4.y + z6.y), y6 = mk2(z4.x - z6.x, z4.y - z6.y);
      const float2 y5 = mk2(z5.x + b7.x, z5.y + b7.y), y7 = mk2(z5.x - b7.x, z5.y - b7.y);
      const float2 c4 = y4;
      const float2 c5 = mk2((y5.x - y5.y) * R, (y5.x + y5.y) * R);
      const float2 c6 = mk2(-y6.y, y6.x);
      const float2 c7 = mk2(-(y7.x + y7.y) * R, (y7.x - y7.y) * R);
      *p0 = make_float4(y0.x + c4.x, y0.y + c4.y, y1.x + c5.x, y1.y + c5.y);
      *p1 = make_float4(y2.x + c6.x, y2.y + c6.y, y3.x + c7.x, y3.y + c7.y);
      *p2 = make_float4(y0.x - c4.x, y0.y - c4.y, y1.x - c5.x, y1.y - c5.y);
      *p3 = make_float4(y2.x - c6.x, y2.y - c6.y, y3.x - c7.x, y3.y - c7.y);
    }
  }
}
DI void fft_fwd(float2* x, int tid, const float2* __restrict__ tw) {
  r4_pass<8, false>(x, tid, 2048, tw + 4095, tw + 2047);
  r4_pass<2, false>(x, tid, 512, tw + 1023, tw + 511);
  r4_pass<1, false>(x, tid, 128, tw + 255, tw + 127);
  r4_pass<1, false, false, true>(x, tid, 32, tw + 63, tw + 31);
  r4_pass<1, false, true, true>(x, tid, 8, tw + 15, tw + 7);
  __syncthreads();
  r8_tail<false>(x, tid);
  __syncthreads();
}
DI void fft_inv(float2* x, int tid, const float2* __restrict__ tw) {
  __syncthreads();
  r8_tail<true>(x, tid);
  r4_pass<1, true, true, true>(x, tid, 8, tw + 15, tw + 7);
  r4_pass<1, true, true, false>(x, tid, 32, tw + 63, tw + 31);
  r4_pass<1, true>(x, tid, 128, tw + 255, tw + 127);
  r4_pass<2, true>(x, tid, 512, tw + 1023, tw + 511);
  r4_pass<8, true>(x, tid, 2048, tw + 4095, tw + 2047);
  __syncthreads();
}

DI float hy_conv(const u16* __restrict__ pr, int t, float w0, float w1, float w2, float cb) {
  const float a = t > 0 ? bf2f(pr[t - 1]) : 0.f;
  const float b = bf2f(pr[t]);
  const float c = t < 4095 ? bf2f(pr[t + 1]) : 0.f;
  return w0 * a + w1 * b + w2 * c + cb;
}

DI void hy_conv4(const u16* __restrict__ pr, int t0, float w0, float w1, float w2, float cb, float (&o)[4]) {
  const ushort4 c = *(const ushort4*)(pr + t0);
  const float pm = t0 > 0 ? bf2f(pr[t0 - 1]) : 0.f;
  const float pn = t0 + 4 < 4096 ? bf2f(pr[t0 + 4]) : 0.f;
  const float x0 = bf2f(c.x), x1 = bf2f(c.y), x2 = bf2f(c.z), x3 = bf2f(c.w);
  o[0] = w0 * pm + w1 * x0 + w2 * x1 + cb;
  o[1] = w0 * x0 + w1 * x1 + w2 * x2 + cb;
  o[2] = w0 * x1 + w1 * x2 + w2 * x3 + cb;
  o[3] = w0 * x2 + w1 * x3 + w2 * pn + cb;
}

DI void hyena_unit(const Params& p, int ch, char* smem) {
  float2* buf = (float2*)smem;
  const int tid = opaque_tid();
  const u16* hyT = (const u16*)(p.ws + OFF_HYT);
  const float* filt = (const float*)(p.ws + OFF_FILT);
  float* z2T = (float*)(p.ws + OFF_Z2T);
  const float2* tw = (const float2*)(p.ws + OFF_TW);
  float2 Kr[32];
#pragma unroll 1
  for (int ord = 0; ord < 2; ++ord) {
    const float* kf = filt + (size_t)((0 * 2 + ord) * 512 + ch) * 4096;
    const float* kb = filt + (size_t)((1 * 2 + ord) * 512 + ch) * 4096;
    const float fb = p.filt_bias[ord * 512 + ch];
    __syncthreads();
#pragma unroll
    for (int g = 0; g < 4; ++g) {
      const int n0 = g * 1024 + tid * 4;
      float4 v = *(const float4*)(kf + n0);
      if (n0 == 0) v.x += fb;
      *(float4*)(buf + n0) = make_float4(v.x, 0.f, v.y, 0.f);
      *(float4*)(buf + n0 + 2) = make_float4(v.z, 0.f, v.w, 0.f);
      const float4 r = *(const float4*)(kb + 4092 - n0);
      const float e0 = (n0 == 0) ? 0.f : kb[4096 - n0];
      *(float4*)(buf + 4096 + n0) = make_float4(e0, 0.f, r.w, 0.f);
      *(float4*)(buf + 4096 + n0 + 2) = make_float4(r.z, 0.f, r.y, 0.f);
    }
    fft_fwd(buf, tid, tw);
#pragma unroll
    for (int j = 0; j < 32; ++j) {
      const float2 v = buf[tid + 256 * j];
      Kr[j] = make_float2(v.x * (1.f / 8192.f), v.y * (1.f / 8192.f));
    }
    const int gcol = 1024 + (1 + ord) * 512 + ch;
    const float gw0 = p.conv_w[gcol], gw1 = p.conv_w[2560 + gcol], gw2 = p.conv_w[5120 + gcol], gcb = p.conv_b[gcol];
    const int vcol = 1024 + ch;
    const float vw0 = p.conv_w[vcol], vw1 = p.conv_w[2560 + vcol], vw2 = p.conv_w[5120 + vcol], vcb = p.conv_b[vcol];
#pragma unroll 1
    for (int pr = 0; pr < 2; ++pr) {
      const int b0 = 2 * pr, b1 = 2 * pr + 1;
      __syncthreads();
      if (ord == 0) {
        const u16* u0 = hyT + ((size_t)((0 * 4 + b0) * 512 + ch)) * 4096;
        const u16* u1 = hyT + ((size_t)((0 * 4 + b1) * 512 + ch)) * 4096;
#pragma unroll
        for (int g = 0; g < 4; ++g) {
          const int t0 = g * 1024 + tid * 4;
          float a[4], b[4];
          hy_conv4(u0, t0, vw0, vw1, vw2, vcb, a);
          hy_conv4(u1, t0, vw0, vw1, vw2, vcb, b);
          *(float4*)(buf + t0) = make_float4(a[0], b[0], a[1], b[1]);
          *(float4*)(buf + t0 + 2) = make_float4(a[2], b[2], a[3], b[3]);
          *(float4*)(buf + 4096 + t0) = make_float4(0.f, 0.f, 0.f, 0.f);
          *(float4*)(buf + 4096 + t0 + 2) = make_float4(0.f, 0.f, 0.f, 0.f);
        }
      } else {
        const float* u0 = z2T + ((size_t)(b0 * 512 + ch)) * 4096;
        const float* u1 = z2T + ((size_t)(b1 * 512 + ch)) * 4096;
#pragma unroll
        for (int g = 0; g < 4; ++g) {
          const int t0 = g * 1024 + tid * 4;
          const float4 a = *(const float4*)(u0 + t0);
          const float4 b = *(const float4*)(u1 + t0);
          *(float4*)(buf + t0) = make_float4(a.x, b.x, a.y, b.y);
          *(float4*)(buf + t0 + 2) = make_float4(a.z, b.z, a.w, b.w);
          *(float4*)(buf + 4096 + t0) = make_float4(0.f, 0.f, 0.f, 0.f);
          *(float4*)(buf + 4096 + t0 + 2) = make_float4(0.f, 0.f, 0.f, 0.f);
        }
      }
      fft_fwd(buf, tid, tw);
#pragma unroll
      for (int j = 0; j < 32; ++j) {
        const float2 v = buf[tid + 256 * j];
        buf[tid + 256 * j] = make_float2(v.x * Kr[j].x - v.y * Kr[j].y, v.x * Kr[j].y + v.y * Kr[j].x);
      }
      fft_inv(buf, tid, tw);
      const u16* g0 = hyT + ((size_t)(((1 + ord) * 4 + b0) * 512 + ch)) * 4096;
      const u16* g1 = hyT + ((size_t)(((1 + ord) * 4 + b1) * 512 + ch)) * 4096;
      float* o0 = z2T + ((size_t)(b0 * 512 + ch)) * 4096;
      float* o1 = z2T + ((size_t)(b1 * 512 + ch)) * 4096;
#pragma unroll
      for (int g = 0; g < 4; ++g) {
        const int t0 = g * 1024 + tid * 4;
        const float4 y01 = *(const float4*)(buf + t0);
        const float4 y23 = *(const float4*)(buf + t0 + 2);
        float ga[4], gb[4];
        hy_conv4(g0, t0, gw0, gw1, gw2, gcb, ga);
        hy_conv4(g1, t0, gw0, gw1, gw2, gcb, gb);
        *(float4*)(o0 + t0) = make_float4(ga[0] * y01.x, ga[1] * y01.z, ga[2] * y23.x, ga[3] * y23.z);
        *(float4*)(o1 + t0) = make_float4(gb[0] * y01.y, gb[1] * y01.w, gb[2] * y23.y, gb[3] * y23.w);
      }
    }
  }
  __syncthreads();
}

DI void mlstm_local_unit(const Params& p, int u, char* smem) {
  float* s_gi = (float*)smem;
  float* s_lf = s_gi + 128;
  float* s_a = s_lf + 128;
  float* s_w = s_a + 128;
  const int tid = opaque_tid(), lane = tid & 63, wave = tid >> 6, lr = lane & 31, hh = lane >> 5;
  const int j = u & 31, dir = (u >> 5) & 1, bh = u >> 6, h = bh & 3, b = bh >> 2;
  const int T0 = b * 4096 + j * 128;
  const float* gates = (const float*)(p.ws + OFF_GATES);
  const u16* vT = (const u16*)(p.ws + OFF_VT);
  const u16* kaT = (const u16*)(p.ws + OFF_KAT);
  float* CL = p.out;
  float* nl = (float*)(p.ws + OFF_NL);
  float* mloc = (float*)(p.ws + OFF_MLOC);
  float* gsum = (float*)(p.ws + OFF_GSUM);
  __syncthreads();
  if (tid < 128) {
    const int T = T0 + tid;
    s_gi[tid] = gates[(size_t)T * 16 + dir * 8 + h] + p.b_gates[dir * 8 + h];
    s_lf[tid] = log_sigmoid(gates[(size_t)T * 16 + dir * 8 + 4 + h] + p.b_gates[dir * 8 + 4 + h]);
  }
  __syncthreads();
  float gtot = 0.f;
  if (tid < 128) {
    float pre = 0.f;
#pragma unroll 4
    for (int m = 0; m < 128; ++m) {
      const float v = s_lf[m];
      if (m < tid) pre += v;
      gtot += v;
    }
    s_a[tid] = (dir == 0) ? (gtot - pre - s_lf[tid] + s_gi[tid]) : (pre + s_gi[tid]);
  }
  __syncthreads();
  if (tid < 128) {
    float mx = -3.0e38f;
#pragma unroll 4
    for (int m = 0; m < 128; ++m) mx = fmaxf(mx, s_a[m]);
    s_w[tid] = expf(s_a[tid] - mx);
    if (tid == 0) { mloc[u] = mx; gsum[u] = gtot; }
  }
  __syncthreads();
  f32x16 acc[4];
#pragma unroll
  for (int d = 0; d < 4; ++d)
#pragma unroll
    for (int r = 0; r < 16; ++r) acc[d][r] = 0.f;
  const u16* vrow = vT + ((size_t)(bh * 128 + wave * 32 + lr)) * 4096 + j * 128 + hh * 8;
  const u16* kbase = kaT + ((size_t)(bh * 128 + lr)) * 4096 + j * 128 + hh * 8;
#pragma unroll 4
  for (int ks = 0; ks < 8; ++ks) {
    const bf16x8 av = *(const bf16x8*)(vrow + ks * 16);
    bf16x8 a;
#pragma unroll
    for (int i = 0; i < 8; ++i) a[i] = (short)f2bf(bf2f((u16)av[i]) * s_w[ks * 16 + hh * 8 + i]);
#pragma unroll
    for (int dt = 0; dt < 4; ++dt) {
      const bf16x8 bk = *(const bf16x8*)(kbase + (size_t)(dt * 32) * 4096 + ks * 16);
      acc[dt] = MFMA(a, bk, acc[dt]);
    }
  }
  float* dst = CL + (size_t)u * 16384;
#pragma unroll
  for (int dt = 0; dt < 4; ++dt)
#pragma unroll
    for (int r = 0; r < 16; ++r) dst[(wave * 32 + crow(r, hh)) * 128 + dt * 32 + lr] = acc[dt][r];
  if (tid < 128) {
    const u16* kr = kaT + ((size_t)(bh * 128 + tid)) * 4096 + j * 128;
    float s = 0.f;
#pragma unroll 2
    for (int l = 0; l < 128; l += 8) {
      const bf16x8 kv = *(const bf16x8*)(kr + l);
#pragma unroll
      for (int i = 0; i < 8; ++i) s += s_w[l + i] * bf2f((u16)kv[i]);
    }
    nl[(size_t)u * 128 + tid] = s;
  }
}

DI void scan_unit(const Params& p, int unit) {
  const int tid = opaque_tid();
  const int sc = unit >> 4, part = unit & 15, dir = sc & 1;
  float* CL = p.out;
  float* nl = (float*)(p.ws + OFF_NL);
  const float* mloc = (const float*)(p.ws + OFF_MLOC);
  const float* gsum = (const float*)(p.ws + OFF_GSUM);
  float* ms = (float*)(p.ws + OFF_MS);
  const int idx = part * 1024 + tid * 4;
  float4 C = make_float4(0.f, 0.f, 0.f, 0.f);
  float nst = 0.f, m = 0.f;
  const bool do_n = (part == 0) && (tid < 128);
  float4 pf[4];
#pragma unroll
  for (int q = 0; q < 4; ++q) {
    const int jj = dir ? 31 - q : q;
    pf[q] = *(const float4*)(CL + (size_t)(sc * 32 + jj) * 16384 + idx);
  }
#pragma unroll 1
  for (int c0 = 0; c0 < 32; c0 += 4) {
#pragma unroll
    for (int q = 0; q < 4; ++q) {
      const int c = c0 + q;
      const int jj = dir ? 31 - c : c;
      const int u = sc * 32 + jj;
      const float4 cl = pf[q];
      *(float4*)(CL + (size_t)u * 16384 + idx) = C;
      if (c + 4 < 32) {
        const int j2 = dir ? 31 - (c + 4) : (c + 4);
        pf[q] = *(const float4*)(CL + (size_t)(sc * 32 + j2) * 16384 + idx);
      }
      const float g = gsum[u], ml = mloc[u];
      const float mn = fmaxf(g + m, ml);
      const float dec = expf(g + m - mn), scl = expf(ml - mn);
      C.x = dec * C.x + scl * cl.x; C.y = dec * C.y + scl * cl.y; C.z = dec * C.z + scl * cl.z; C.w = dec * C.w + scl * cl.w;
      if (do_n) {
        const float nv = nl[(size_t)u * 128 + tid];
        nl[(size_t)u * 128 + tid] = nst;
        nst = dec * nst + scl * nv;
      }
      if (part == 0 && tid == 0) ms[u] = m;
      m = mn;
    }
  }
}

template <int DIR>
DI void mlstm_dir(const Params& p, int bh, int j, char* smem, f32x16 (&hs)[4]) {
  float* s_gi = (float*)smem;
  float* s_lf = s_gi + 128;
  float* s_bc = s_lf + 128;
  float* s_r = s_bc + 128;
  float* s_al = s_r + 128;
  float* s_fl = s_al + 128;
  float* s_is = s_fl + 128;
  const int tid = opaque_tid(), lane = tid & 63, wave = tid >> 6, lr = lane & 31, hh = lane >> 5;
  u16* Pl = (u16*)(smem + 4096) + wave * (32 * 136);
  const int h = bh & 3, b = bh >> 2;
  const int T0 = b * 4096 + j * 128;
  const float* gates = (const float*)(p.ws + OFF_GATES);
  const u16* qa = (const u16*)(p.ws + OFF_QA);
  const u16* ka = (const u16*)(p.ws + OFF_KA);
  const u16* vT = (const u16*)(p.ws + OFF_VT);
  const float* CS = p.out;
  const float* ns = (const float*)(p.ws + OFF_NL);
  const float* ms = (const float*)(p.ws + OFF_MS);
  u16* A2 = (u16*)(p.ws + OFF_A2);
  bf16x8 ones;
#pragma unroll
  for (int i = 0; i < 8; ++i) ones[i] = (short)0x3F80;
  const u16* qrow = qa + (size_t)(T0 + wave * 32 + lr) * 512 + h * 128 + hh * 8;
  const int u = (bh * 2 + DIR) * 32 + j;
  const float msu = ms[u];
  __syncthreads();
  if (tid < 128) {
    const int T = T0 + tid;
    s_gi[tid] = gates[(size_t)T * 16 + DIR * 8 + h] + p.b_gates[DIR * 8 + h];
    s_lf[tid] = log_sigmoid(gates[(size_t)T * 16 + DIR * 8 + 4 + h] + p.b_gates[DIR * 8 + 4 + h]);
  }
  __syncthreads();
  if (tid < 128) {
    float a = 0.f;
#pragma unroll 4
    for (int m = 0; m < 128; ++m) {
      const bool in = (DIR == 0) ? (m <= tid) : (m >= tid);
      a += in ? s_lf[m] : 0.f;
    }
    s_bc[tid] = a;
    s_r[tid] = s_gi[tid] - a;
  }
  __syncthreads();
  if (tid < 128) {
    float cm = -3.0e38f;
#pragma unroll 4
    for (int m = 0; m < 128; ++m) {
      const bool in = (DIR == 0) ? (m <= tid) : (m >= tid);
      cm = in ? fmaxf(cm, s_r[m]) : cm;
    }
    const float bc = s_bc[tid];
    const float mt = bc + fmaxf(msu, cm);
    s_al[tid] = bc - mt;
    s_fl[tid] = expf(-mt);
    s_is[tid] = expf(bc + msu - mt);
  }
  __syncthreads();
  char* Kt = smem + 4096;
  char* R2 = smem + 40960;
  {
#pragma unroll
    for (int bt = 0; bt < 2; ++bt) {
      uint4 kq[4];
#pragma unroll
      for (int i = 0; i < 4; ++i) {
        const int q = tid + 256 * (bt * 4 + i), row = q >> 4, ch = q & 15;
        kq[i] = *(const uint4*)(ka + (size_t)(T0 + row) * 512 + h * 128 + ch * 8);
      }
#pragma unroll
      for (int i = 0; i < 4; ++i) {
        const int q = tid + 256 * (bt * 4 + i), row = q >> 4, ch = q & 15;
        *(uint4*)(Kt + row * 256 + ((ch ^ (row & 15)) << 4)) = kq[i];
      }
    }
  }
  __syncthreads();
  {
    f32x16 S[4];
#pragma unroll
    for (int st = 0; st < 4; ++st)
#pragma unroll
      for (int r = 0; r < 16; ++r) S[st][r] = 0.f;
#pragma unroll 4
    for (int ks = 0; ks < 8; ++ks) {
      const bf16x8 a = *(const bf16x8*)(qrow + ks * 16);
#pragma unroll
      for (int st = 0; st < 4; ++st) {
        const int krow = st * 32 + lr;
        const bf16x8 bk = *(const bf16x8*)(Kt + krow * 256 + (((ks * 2 + hh) ^ (krow & 15)) << 4));
        S[st] = MFMA(a, bk, S[st]);
      }
    }
    __syncthreads();
#pragma unroll
    for (int st = 0; st < 4; ++st) {
      const int sl = st * 32 + lr;
      const float rs = s_r[sl];
#pragma unroll
      for (int r = 0; r < 16; ++r) {
        const int tl = wave * 32 + crow(r, hh);
        const bool valid = (DIR == 0) ? (sl <= tl) : (sl >= tl);
        const float pv = valid ? S[st][r] * __expf(s_al[tl] + rs) : 0.f;
        Pl[crow(r, hh) * 136 + sl] = f2bf(pv);
      }
    }
  }
#pragma unroll
  for (int eh = 0; eh < 2; ++eh) {
    f32x16 N[3];
#pragma unroll
    for (int e = 0; e < 3; ++e)
#pragma unroll
      for (int r = 0; r < 16; ++r) N[e][r] = 0.f;
    {
      uint4 vq[4];
#pragma unroll
      for (int i = 0; i < 4; ++i) {
        const int q = tid + 256 * i, row = q >> 4, ch = q & 15;
        vq[i] = *(const uint4*)(vT + ((size_t)(bh * 128 + eh * 64 + row)) * 4096 + j * 128 + ch * 8);
      }
#pragma unroll
      for (int i = 0; i < 4; ++i) {
        const int q = tid + 256 * i, row = q >> 4, ch = q & 15;
        *(uint4*)(R2 + row * 256 + ((ch ^ (row & 15)) << 4)) = vq[i];
      }
    }
    __syncthreads();
    {
#pragma unroll 4
      for (int ks = 0; ks < 8; ++ks) {
        const bf16x8 a = *(const bf16x8*)(Pl + lr * 136 + ks * 16 + hh * 8);
#pragma unroll
        for (int e2 = 0; e2 < 2; ++e2) {
          const int vrow = e2 * 32 + lr;
          const bf16x8 bv = *(const bf16x8*)(R2 + vrow * 256 + (((ks * 2 + hh) ^ (vrow & 15)) << 4));
          N[e2] = MFMA(a, bv, N[e2]);
        }
        N[2] = MFMA(a, ones, N[2]);
      }
    }
    {
      bf16x8 cq[4];
#pragma unroll
      for (int i = 0; i < 4; ++i) {
        const int q = tid + 256 * i, row = q >> 4, ch = q & 15;
        const float* src = CS + (size_t)u * 16384 + (size_t)(eh * 64 + row) * 128 + ch * 8;
        const float4 c0 = *(const float4*)(src), c1 = *(const float4*)(src + 4);
        const float cv[8] = {c0.x, c0.y, c0.z, c0.w, c1.x, c1.y, c1.z, c1.w};
        cq[i] = pack8(cv);
      }
      __syncthreads();
#pragma unroll
      for (int i = 0; i < 4; ++i) {
        const int q = tid + 256 * i, row = q >> 4, ch = q & 15;
        *(bf16x8*)(R2 + row * 256 + ((ch ^ (row & 15)) << 4)) = cq[i];
      }
    }
    __syncthreads();
    {
      const float isc = s_is[wave * 32 + lr];
      const float* nbase = ns + (size_t)u * 128 + hh * 8;
#pragma unroll 4
      for (int ks = 0; ks < 8; ++ks) {
        const bf16x8 aq = *(const bf16x8*)(qrow + ks * 16);
        const bf16x8 a = scale8(aq, isc);
#pragma unroll
        for (int e2 = 0; e2 < 2; ++e2) {
          const int crw = e2 * 32 + lr;
          const bf16x8 bc = *(const bf16x8*)(R2 + crw * 256 + (((ks * 2 + hh) ^ (crw & 15)) << 4));
          N[e2] = MFMA(a, bc, N[e2]);
        }
        const float4 n0 = *(const float4*)(nbase + ks * 16);
        const float4 n1 = *(const float4*)(nbase + ks * 16 + 4);
        const float nv[8] = {n0.x, n0.y, n0.z, n0.w, n1.x, n1.y, n1.z, n1.w};
        N[2] = MFMA(a, pack8(nv), N[2]);
      }
    }
    __syncthreads();
    u16* park = (u16*)(p.ws + OFF_HYT) + ((size_t)(bh * 32 + j) * 256 + tid) * 64 + eh * 32;
    bf16x8 pk[4];
    if (DIR == 1) {
#pragma unroll
      for (int q = 0; q < 4; ++q) pk[q] = *(const bf16x8*)(park + q * 8);
    }
#pragma unroll
    for (int r = 0; r < 16; ++r) {
      const int tl = wave * 32 + crow(r, hh);
      const float den = fmaxf(fabsf(N[2][r]), s_fl[tl]);
      const float inv = 1.f / den;
#pragma unroll
      for (int e2 = 0; e2 < 2; ++e2) {
        const float hv = N[e2][r] * inv;
        const int v = e2 * 16 + r;
        if (DIR == 0) pk[v >> 3][v & 7] = (short)f2bf(hv);
        else hs[eh * 2 + e2][r] = hv + bf2f((u16)pk[v >> 3][v & 7]);
      }
    }
    if (DIR == 0) {
#pragma unroll
      for (int q = 0; q < 4; ++q) *(bf16x8*)(park + q * 8) = pk[q];
    }
  }
}

DI void mlstm_out_unit(const Params& p, int unit, char* smem) {
  const int tid = opaque_tid(), lane = tid & 63, wave = tid >> 6, lr = lane & 31, hh = lane >> 5;
  const int j = unit & 31, bh = unit >> 5, h = bh & 3, b = bh >> 2;
  const int T0 = b * 4096 + j * 128;
  const u16* og = (const u16*)(p.ws + OFF_OG);
  u16* A2 = (u16*)(p.ws + OFF_A2);
  f32x16 hs[4];
  mlstm_dir<0>(p, bh, j, smem, hs);
  mlstm_dir<1>(p, bh, j, smem, hs);
  __syncthreads();
  float* wl = (float*)(smem + wave * 16384);
#pragma unroll
  for (int et = 0; et < 4; ++et)
#pragma unroll
    for (int r = 0; r < 16; ++r) wl[crow(r, hh) * 128 + et * 32 + lr] = hs[et][r];
  wave_lds_sync();
  {
    const int row = lane >> 1, half = lane & 1;
    const size_t T = (size_t)(T0 + wave * 32 + row);
    const u16* ogp = og + T * 512 + h * 128 + half * 64;
    const float* src = wl + row * 128 + half * 64;
    float g[64];
    float ss = 0.f;
#pragma unroll
    for (int q = 0; q < 8; ++q) {
      const bf16x8 o8 = *(const bf16x8*)(ogp + q * 8);
      const float4 h0 = *(const float4*)(src + q * 8), h1 = *(const float4*)(src + q * 8 + 4);
      g[q * 8 + 0] = h0.x * bf2f((u16)o8[0]); g[q * 8 + 1] = h0.y * bf2f((u16)o8[1]); g[q * 8 + 2] = h0.z * bf2f((u16)o8[2]); g[q * 8 + 3] = h0.w * bf2f((u16)o8[3]);
      g[q * 8 + 4] = h1.x * bf2f((u16)o8[4]); g[q * 8 + 5] = h1.y * bf2f((u16)o8[5]); g[q * 8 + 6] = h1.z * bf2f((u16)o8[6]); g[q * 8 + 7] = h1.w * bf2f((u16)o8[7]);
#pragma unroll
      for (int i = 0; i < 8; ++i) ss += g[q * 8 + i] * g[q * 8 + i];
    }
    ss += __shfl_xor(ss, 1, 64);
    const float rs = rsqrtf(ss * (1.f / 128.f) + EPS);
    const float* mw = p.mlstm_norm_w + h * 128 + half * 64;
    u16* dst = A2 + T * 1024 + h * 128 + half * 64;
#pragma unroll
    for (int q = 0; q < 8; ++q) {
      const float4 w0 = *(const float4*)(mw + q * 8), w1 = *(const float4*)(mw + q * 8 + 4);
      float o[8];
      o[0] = g[q * 8 + 0] * rs * w0.x; o[1] = g[q * 8 + 1] * rs * w0.y; o[2] = g[q * 8 + 2] * rs * w0.z; o[3] = g[q * 8 + 3] * rs * w0.w;
      o[4] = g[q * 8 + 4] * rs * w1.x; o[5] = g[q * 8 + 5] * rs * w1.y; o[6] = g[q * 8 + 6] * rs * w1.z; o[7] = g[q * 8 + 7] * rs * w1.w;
      *(bf16x8*)(dst + q * 8) = pack8(o);
    }
  }
}

DI void hyena_norm_unit(const Params& p, int unit, char* smem) {
  float* tile = (float*)smem;
  const int tid = opaque_tid();
  const int tt = unit & 63, g = (unit >> 6) & 7, b = unit >> 9;
  const float* z2T = (const float*)(p.ws + OFF_Z2T);
  u16* A2 = (u16*)(p.ws + OFF_A2);
  __syncthreads();
#pragma unroll 4
  for (int i = 0; i < 16; ++i) {
    const int cl = (tid >> 6) + 4 * i, tl = tid & 63;
    tile[cl * 65 + tl] = z2T[((size_t)(b * 512 + g * 64 + cl)) * 4096 + tt * 64 + tl];
  }
  __syncthreads();
  const int tl = tid >> 2, qd = tid & 3;
  float v[16];
  float ss = 0.f;
#pragma unroll
  for (int i = 0; i < 16; ++i) {
    v[i] = tile[(qd * 16 + i) * 65 + tl];
    ss += v[i] * v[i];
  }
  ss += __shfl_xor(ss, 1, 64);
  ss += __shfl_xor(ss, 2, 64);
  const float rs = rsqrtf(ss * (1.f / 64.f) + EPS);
  const size_t T = (size_t)b * 4096 + tt * 64 + tl;
  u16* dst = A2 + T * 1024 + 512 + g * 64 + qd * 16;
  const float* w = p.hyena_norm_w + g * 64 + qd * 16;
  float o[16];
#pragma unroll
  for (int i = 0; i < 16; ++i) o[i] = v[i] * rs * w[i];
  *(bf16x8*)(dst) = pack8(o);
  *(bf16x8*)(dst + 8) = pack8(o + 8);
}

template <int EPI>
DI void gemm_phase(const u16* A, const u16* Bt, int K, int ntn, void* outp, char* smem) {
  const int tid = threadIdx.x, lane = tid & 63, wave = tid >> 6, wr = wave >> 1, wc = wave & 1, lr = lane & 31, hh = lane >> 5;
  const int ntiles = tile_count(ntn);
  for (int id = blockIdx.x; id < ntiles; id += gridDim.x) {
    int mt, nt;
    tile_map(id, ntn, mt, nt);
    if (nt >= ntn) continue;
    const int m0 = mt * 256, n0 = nt * 128;
    f32x16 acc[4][2];
    gemm_core<false>(A, Bt, K, m0, n0, smem, acc);
    if (EPI == 0) {
#pragma unroll
      for (int i = 0; i < 4; ++i)
#pragma unroll
        for (int j = 0; j < 2; ++j)
#pragma unroll
          for (int r = 0; r < 16; ++r) {
            const int row = m0 + wr * 128 + i * 32 + crow(r, hh);
            const int col = n0 + wc * 64 + j * 32 + lr;
            ((float*)outp)[(size_t)row * 1024 + col] = acc[i][j][r];
          }
    } else {
      char* wl = smem + wave * 16384;
      stage_tile_ns<2>(acc, wl, lr, hh);
      wave_lds_sync();
      flush_tile_ns(wl, (u16*)outp + (size_t)(m0 + wr * 128) * 4096 + n0 + wc * 64, 4096, lane);
    }
  }
}

DI void phase_post_mix(const Params& p) {
  const int tid = threadIdx.x, lane = tid & 63, wave = tid >> 6;
  const float* mix = p.out;
  float* x1 = (float*)(p.ws + OFF_X1);
  u16* hm = (u16*)(p.ws + OFF_HM);
  for (int u = blockIdx.x; u < 1024; u += gridDim.x) {
#pragma unroll 2
    for (int rr = 0; rr < 4; ++rr) {
      const size_t row = (size_t)u * 16 + wave * 4 + rr;
      float4 mv[4], xv[4];
      float ss = 0.f;
#pragma unroll
      for (int i = 0; i < 4; ++i) {
        mv[i] = ((const float4*)(mix + row * DM))[lane + 64 * i];
        xv[i] = ((const float4*)(p.x + row * DM))[lane + 64 * i];
        ss += mv[i].x * mv[i].x + mv[i].y * mv[i].y + mv[i].z * mv[i].z + mv[i].w * mv[i].w;
      }
      ss = wave_sum(ss);
      const float rs = rsqrtf(ss * (1.f / DM) + EPS);
      float s2 = 0.f;
#pragma unroll
      for (int i = 0; i < 4; ++i) {
        const float4 w = ((const float4*)p.norm_mix_post)[lane + 64 * i];
        xv[i].x += mv[i].x * rs * w.x; xv[i].y += mv[i].y * rs * w.y; xv[i].z += mv[i].z * rs * w.z; xv[i].w += mv[i].w * rs * w.w;
        s2 += xv[i].x * xv[i].x + xv[i].y * xv[i].y + xv[i].z * xv[i].z + xv[i].w * xv[i].w;
        ((float4*)(x1 + row * DM))[lane + 64 * i] = xv[i];
      }
      s2 = wave_sum(s2);
      const float r2 = rsqrtf(s2 * (1.f / DM) + EPS);
#pragma unroll
      for (int i = 0; i < 4; ++i) {
        const float4 w = ((const float4*)p.norm_mlp_pre)[lane + 64 * i];
        ushort4 o;
        o.x = f2bf(xv[i].x * r2 * w.x); o.y = f2bf(xv[i].y * r2 * w.y); o.z = f2bf(xv[i].z * r2 * w.z); o.w = f2bf(xv[i].w * r2 * w.w);
        *(ushort4*)(hm + row * DM + (lane + 64 * i) * 4) = o;
      }
    }
  }
}

DI void phase_final(const Params& p) {
  const int tid = threadIdx.x, lane = tid & 63, wave = tid >> 6;
  const float* x1 = (const float*)(p.ws + OFF_X1);
  for (int u = blockIdx.x; u < 1024; u += gridDim.x) {
#pragma unroll 2
    for (int rr = 0; rr < 4; ++rr) {
      const size_t row = (size_t)u * 16 + wave * 4 + rr;
      float4 fv[4];
      float ss = 0.f;
#pragma unroll
      for (int i = 0; i < 4; ++i) {
        fv[i] = ((const float4*)(p.out + row * DM))[lane + 64 * i];
        ss += fv[i].x * fv[i].x + fv[i].y * fv[i].y + fv[i].z * fv[i].z + fv[i].w * fv[i].w;
      }
      ss = wave_sum(ss);
      const float rs = rsqrtf(ss * (1.f / DM) + EPS);
#pragma unroll
      for (int i = 0; i < 4; ++i) {
        const float4 w = ((const float4*)p.norm_mlp_post)[lane + 64 * i];
        const float4 xv = ((const float4*)(x1 + row * DM))[lane + 64 * i];
        float4 o;
        o.x = xv.x + fv[i].x * rs * w.x; o.y = xv.y + fv[i].y * rs * w.y; o.z = xv.z + fv[i].z * rs * w.z; o.w = xv.w + fv[i].w * rs * w.w;
        ((float4*)(p.out + row * DM))[lane + 64 * i] = o;
      }
    }
  }
}

DI void run_phase(const Params& p, int ph, char* smem) {
  switch (ph) {
    case 0: phase0(p, smem); break;
    case 1: phase1(p, smem); break;
    case 2: phase_qk(p, smem); break;
    case 3:
#ifdef DBL_HYONLY
      for (int u = blockIdx.x; u < 512; u += gridDim.x) hyena_unit(p, u, smem);
#endif
#ifdef DBL_MLONLY
      for (int u = blockIdx.x; u < 1024; u += gridDim.x) mlstm_local_unit(p, u, smem);
#endif
      for (int u = blockIdx.x; u < 512 + 1024; u += gridDim.x) {
        if (u < 512) hyena_unit(p, u, smem);
        else mlstm_local_unit(p, u - 512, smem);
      }
      break;
    case 4:
      for (int u = blockIdx.x; u < 512; u += gridDim.x) scan_unit(p, u);
      break;
    case 5:
      for (int u = blockIdx.x; u < 512 + 2048; u += gridDim.x) {
#ifndef DBG_SKIP_MLSTM
        if (u < 512) mlstm_out_unit(p, u, smem);
#else
        if (u < 512) { u16* A2 = (u16*)(p.ws + OFF_A2); const int T0 = (u >> 5 >> 2) * 4096 + (u & 31) * 128, hq = (u >> 5) & 3;
          for (int i = threadIdx.x; i < 128 * 128; i += 256) A2[(size_t)(T0 + (i >> 7)) * 1024 + hq * 128 + (i & 127)] = 0; }
#endif
#ifndef DBG_SKIP_HYENA
        else hyena_norm_unit(p, u - 512, smem);
#else
        else { const int un = u - 512; const int tt = un & 63, g = (un >> 6) & 7, b = un >> 9; u16* A2 = (u16*)(p.ws + OFF_A2);
          for (int i = threadIdx.x; i < 64 * 64; i += 256) A2[((size_t)b * 4096 + tt * 64 + (i >> 6)) * 1024 + 512 + g * 64 + (i & 63)] = 0x3F80; }
#endif
      }
      break;
    case 6: gemm_phase<0>((const u16*)(p.ws + OFF_A2), (const u16*)(p.ws + OFF_WOUTT), 1024, 8, p.out, smem); break;
    case 7: phase_post_mix(p); break;
    case 8: gemm_phase<1>((const u16*)(p.ws + OFF_HM), (const u16*)(p.ws + OFF_W1T), 1024, 32, p.ws + OFF_H, smem); break;
    case 9: gemm_phase<0>((const u16*)(p.ws + OFF_H), (const u16*)(p.ws + OFF_W2T), 4096, 8, p.out, smem); break;
    case 10: phase_final(p); break;
  }
}
constexpr int NPHASE = 11;

#define XB_XCNT(j)  (256  + 64 * (j))
#define XB_XSUB(j)  (1280 + 64 * (j))
#define XB_XGEN(j)  (2304 + 64 * (j))
#define XB_TOP      3328
#define XB_TOPGEN   3392
#define XCD_BAR_WORDS 3456
DI unsigned xb_ld(unsigned* p) { return __hip_atomic_load(p, __ATOMIC_RELAXED, __HIP_MEMORY_SCOPE_AGENT); }
DI unsigned xb_add(unsigned* p, unsigned v) { return __hip_atomic_fetch_add(p, v, __ATOMIC_RELAXED, __HIP_MEMORY_SCOPE_AGENT); }
DI unsigned xb_xcc_id() { return (unsigned)__builtin_amdgcn_s_getreg((3 << 11) | 20) & 0xFu; }
struct XcdBar { unsigned* bar; unsigned x, nloc, nx; };
DI void xcd_barrier(XcdBar& b) {
  asm volatile("s_waitcnt vmcnt(0)" ::: "memory");
  __syncthreads();
  if (threadIdx.x == 0) {
    unsigned* bar = b.bar;
    __builtin_amdgcn_s_waitcnt(0);
    if (b.nloc == 0u) {
      const unsigned G = gridDim.x;
      unsigned sum, cnt, mine;
      for (;;) {
        sum = 0u; cnt = 0u; mine = 0u;
#pragma unroll
        for (unsigned j = 0; j < 16; ++j) { const unsigned c = xb_ld(&bar[XB_XCNT(j)]); sum += c; cnt += (c > 0u) ? 1u : 0u; mine = (j == b.x) ? c : mine; }
        if (sum == G) break;
        __builtin_amdgcn_s_sleep(1);
      }
      b.nloc = mine > 0u ? mine : 1u; b.nx = cnt > 0u ? cnt : 1u;
    }
    const unsigned nloc = b.nloc, nx = b.nx;
    const unsigned old = xb_add(&bar[XB_XSUB(b.x)], 1u);
    const unsigned gen = old / nloc;
    if (old + 1u == (gen + 1u) * nloc) {
      __builtin_amdgcn_fence(__ATOMIC_RELEASE, "agent");
      asm volatile("s_waitcnt vmcnt(0)" ::: "memory");
      const unsigned og = xb_add(&bar[XB_TOP], 1u);
      const unsigned tg = og / nx;
      if (og + 1u == (tg + 1u) * nx) xb_add(&bar[XB_TOPGEN], 1u);
      else while (xb_ld(&bar[XB_TOPGEN]) == tg) __builtin_amdgcn_s_sleep(1);
      __builtin_amdgcn_fence(__ATOMIC_ACQUIRE, "agent");
      xb_add(&bar[XB_XGEN(b.x)], 1u);
      asm volatile("s_waitcnt vmcnt(0)" ::: "memory");
    } else {
      while (xb_ld(&bar[XB_XGEN(b.x)]) == gen) __builtin_amdgcn_s_sleep(1);
      __builtin_amdgcn_fence(__ATOMIC_ACQUIRE, "agent");
      asm volatile("s_waitcnt vmcnt(0)" ::: "memory");
    }
  }
  __syncthreads();
}

#if MULTI_LAUNCH
template <int PH>
__global__ void __launch_bounds__(256, 2) phase_kernel(Params p) {
  __shared__ __attribute__((aligned(16))) char smem[65536];
  run_phase(p, PH, smem);
}
template <int PH>
static void launch_phase(const Params& p, hipStream_t stream) {
  hipLaunchKernelGGL(phase_kernel<PH>, dim3(512), dim3(256), 0, stream, p);
}
#else
__global__ void __launch_bounds__(256, 2) mega_kernel(Params p) {
  __shared__ __attribute__((aligned(16))) char smem[65536];
  cg::grid_group grid = cg::this_grid();
  XcdBar xb;
  xb.bar = (unsigned*)(p.ws + OFF_BAR); xb.x = xb_xcc_id(); xb.nloc = 0u; xb.nx = 0u;
  if (p.ws == nullptr) grid.sync();
  if (threadIdx.x == 0) (void)xb_add(&xb.bar[XB_XCNT(xb.x)], 1u);
#define GSYNC xcd_barrier(xb)
#ifdef DBL_P0
  run_phase(p, 0, smem);
#endif
  run_phase(p, 0, smem); GSYNC;
  run_phase(p, 1, smem); GSYNC;
#ifdef DBL_GEMM
  run_phase(p, 1, smem); grid.sync();
#endif
  run_phase(p, 2, smem); GSYNC;
#ifdef DBL_P2
  run_phase(p, 2, smem); GSYNC;
#endif
  run_phase(p, 3, smem); GSYNC;
#ifdef DBL_HY
  run_phase(p, 3, smem); GSYNC;
#endif
  run_phase(p, 4, smem); GSYNC;
  run_phase(p, 5, smem); GSYNC;
#ifdef DBL_P5
  run_phase(p, 5, smem); GSYNC;
#endif
  run_phase(p, 6, smem); GSYNC;
#ifdef DBL_GEMM
  run_phase(p, 6, smem); GSYNC;
#endif
  run_phase(p, 7, smem); GSYNC;
#ifdef DBL_P7
  run_phase(p, 7, smem); GSYNC;
#endif
  run_phase(p, 8, smem); GSYNC;
#ifdef DBL_GEMM
  run_phase(p, 8, smem); GSYNC;
#endif
  run_phase(p, 9, smem); GSYNC;
#ifdef DBL_GEMM
  run_phase(p, 9, smem); GSYNC;
#endif
#ifdef XSYNC
  for (int q = 0; q < 10; ++q) GSYNC;
#endif
  run_phase(p, 10, smem);
}
#endif

extern "C" void kernel_launch(void* const* d_in, const int* in_sizes, int n_in, void* d_out, int out_size, void* d_ws,
                              size_t ws_size, hipStream_t stream) {
  Params p{};
  const float** pp = (const float**)&p;
  for (int i = 0; i < 23; ++i) pp[i] = (const float*)d_in[i];
  p.out = (float*)d_out;
  p.ws = (char*)d_ws;
#if MULTI_LAUNCH
  launch_phase<0>(p, stream);
#ifdef DBL_P0
  launch_phase<0>(p, stream);
#endif
 launch_phase<1>(p, stream); launch_phase<2>(p, stream); launch_phase<3>(p, stream);
#ifdef DBL_HY
  launch_phase<3>(p, stream);
#endif

  launch_phase<4>(p, stream); launch_phase<5>(p, stream);
#ifdef DBL_P5
  launch_phase<5>(p, stream);
#endif
 launch_phase<6>(p, stream); launch_phase<7>(p, stream);
  launch_phase<8>(p, stream); launch_phase<9>(p, stream); launch_phase<10>(p, stream);
#else
  static int grid_blocks = 0;
  if (!grid_blocks) {
    int dev = 0, cus = 0, per_cu = 0;
    hipGetDevice(&dev);
    hipDeviceGetAttribute(&cus, hipDeviceAttributeMultiprocessorCount, dev);
    hipOccupancyMaxActiveBlocksPerMultiprocessor(&per_cu, mega_kernel, 256, 0);
    if (per_cu > 2) per_cu = 2;
    if (per_cu < 1) per_cu = 1;
#ifdef FORCE2
    per_cu = 2;
#endif
    grid_blocks = cus * per_cu;
  }
  hipMemsetAsync((char*)d_ws + OFF_BAR, 0, XCD_BAR_WORDS * 4, stream);
  void* args[] = {&p};
  hipError_t e = hipLaunchCooperativeKernel((void*)mega_kernel, dim3(grid_blocks), dim3(256), args, 0, stream);
  if (e != hipSuccess) fprintf(stderr, "cooperative launch failed: %s (grid %d)\n", hipGetErrorString(e), grid_blocks);
#endif
}
#if defined(__HIP_DEVICE_COMPILE__)
#pragma clang attribute pop
#endif
```

```cpp
#if defined(__HIP_DEVICE_COMPILE__)
#pragma clang attribute push(__attribute__((target("no-packed-fp32-ops"))), apply_to = function)
#endif
#include <hip/hip_runtime.h>
#include <hip/hip_cooperative_groups.h>
#include <cstdio>
namespace cg = cooperative_groups;

#ifndef MULTI_LAUNCH
#define MULTI_LAUNCH 0
#endif

typedef unsigned short u16;
using bf16x8 = __attribute__((ext_vector_type(8))) short;
using f32x16 = __attribute__((ext_vector_type(16))) float;
#define DI __device__ __forceinline__
#define MFMA(a, b, c) __builtin_amdgcn_mfma_f32_32x32x16_bf16((a), (b), (c), 0, 0, 0)

constexpr int SEQ = 4096, DM = 1024, NTOK = 16384, NIN = 3600, NINP = 3712, DFF = 4096;
constexpr float EPS = 1e-6f;
constexpr size_t MiB = 1u << 20;
constexpr size_t OFF_WINT = 0, OFF_WOUTT = 8 * MiB, OFF_W1T = 10 * MiB, OFF_W2T = 18 * MiB;
constexpr size_t OFF_XN = 26 * MiB, OFF_QA = 26 * MiB, OFF_KA = 42 * MiB;
constexpr size_t OFF_FILT = 58 * MiB, OFF_QKPRE = 90 * MiB, OFF_A2 = 90 * MiB;
constexpr size_t OFF_HYT = 122 * MiB, OFF_VT = 170 * MiB, OFF_OG = 186 * MiB, OFF_GATES = 202 * MiB;
constexpr size_t OFF_NL = 203 * MiB, OFF_MLOC = 203 * MiB + 512 * 1024, OFF_GSUM = OFF_MLOC + 4096, OFF_MS = OFF_GSUM + 4096;
constexpr size_t OFF_KAT = 205 * MiB, OFF_Z2T = 221 * MiB;
constexpr size_t OFF_TW = 204 * MiB, OFF_BAR = 254 * MiB;
constexpr size_t OFF_X1 = 26 * MiB, OFF_HM = 90 * MiB, OFF_H = 122 * MiB;

struct Params {
  const float *x, *norm_mix_pre, *norm_mix_post, *norm_mlp_pre, *norm_mlp_post, *w_in, *b_gates, *conv_w, *conv_b,
      *mlstm_norm_w, *hyena_norm_w, *filt_w1, *filt_b1, *filt_w2, *filt_b2, *filt_w3, *filt_b3, *filt_w4, *filt_freq,
      *filt_bias, *w_out, *w_mlp_in, *w_mlp_out;
  float* out;
  char* ws;
};

DI u16 f2bf(float x) { unsigned u = __float_as_uint(x); u += 0x7fffu + ((u >> 16) & 1u); return (u16)(u >> 16); }
DI float bf2f(u16 v) { return __uint_as_float(((unsigned)v) << 16); }
DI int opaque_tid() { int t = threadIdx.x; asm volatile("" : "+v"(t)); return t; }
DI int crow(int r, int hh) { return (r & 3) + 8 * (r >> 2) + 4 * hh; }
DI float log_sigmoid(float x) { return fminf(x, 0.f) - log1pf(expf(-fabsf(x))); }
DI float sigmoidf(float x) { return 1.f / (1.f + expf(-x)); }
DI float red2pi(float x) {
  const float k = rintf(x * 0.15915494309189535f);
  float r = fmaf(-k, 6.28125f, x);
  return fmaf(-k, 1.9353071795864769e-3f, r);
}
DI float fsin(float x) { return sinf(x); }
DI float fcos(float x) { return cosf(x); }
DI bf16x8 pack8(const float* v) {
  bf16x8 r;
#pragma unroll
  for (int i = 0; i < 8; ++i) r[i] = (short)f2bf(v[i]);
  return r;
}
DI bf16x8 scale8(bf16x8 a, float s) {
  bf16x8 r;
#pragma unroll
  for (int i = 0; i < 8; ++i) r[i] = (short)f2bf(bf2f((u16)a[i]) * s);
  return r;
}

template <bool SWAP>
DI void gemm_core(const u16* __restrict__ A, const u16* __restrict__ Bt, int K, int m0, int n0, char* smem, f32x16 (&acc)[4][2]) {
  const int tid = opaque_tid(), lane = tid & 63, wave = tid >> 6, wr = wave >> 1, wc = wave & 1;
  const int lr = lane & 31, hh = lane >> 5;
#pragma unroll
  for (int i = 0; i < 4; ++i)
#pragma unroll
    for (int j = 0; j < 2; ++j)
#pragma unroll
      for (int r = 0; r < 16; ++r) acc[i][j][r] = 0.f;
  const int c = tid & 7, r0 = tid >> 3;
  const u16* Ag = A + (size_t)(m0 + r0) * K + c * 8;
  const u16* Bg = Bt + (size_t)(n0 + r0) * K + c * 8;
  const int soff = r0 * 128 + ((c ^ ((r0 >> 1) & 7)) << 4);
  char* As = smem;
  char* Bs = smem + 32768;
  uint4 ra0, ra1, ra2, ra3, ra4, ra5, ra6, ra7, rb0, rb1, rb2, rb3;
#define GLOAD_ALL(k0)                                                                                             \
  ra0 = *(const uint4*)(Ag + (size_t)(0) * K + (k0));   ra1 = *(const uint4*)(Ag + (size_t)(32) * K + (k0));      \
  ra2 = *(const uint4*)(Ag + (size_t)(64) * K + (k0));  ra3 = *(const uint4*)(Ag + (size_t)(96) * K + (k0));      \
  ra4 = *(const uint4*)(Ag + (size_t)(128) * K + (k0)); ra5 = *(const uint4*)(Ag + (size_t)(160) * K + (k0));     \
  ra6 = *(const uint4*)(Ag + (size_t)(192) * K + (k0)); ra7 = *(const uint4*)(Ag + (size_t)(224) * K + (k0));     \
  rb0 = *(const uint4*)(Bg + (size_t)(0) * K + (k0));   rb1 = *(const uint4*)(Bg + (size_t)(32) * K + (k0));      \
  rb2 = *(const uint4*)(Bg + (size_t)(64) * K + (k0));  rb3 = *(const uint4*)(Bg + (size_t)(96) * K + (k0));
  GLOAD_ALL(0)
  const int nk = K >> 6;
#pragma unroll 1
  for (int kt = 0; kt < nk; ++kt) {
    __syncthreads();
    *(uint4*)(As + soff + 0 * 4096) = ra0; *(uint4*)(As + soff + 1 * 4096) = ra1; *(uint4*)(As + soff + 2 * 4096) = ra2; *(uint4*)(As + soff + 3 * 4096) = ra3;
    *(uint4*)(As + soff + 4 * 4096) = ra4; *(uint4*)(As + soff + 5 * 4096) = ra5; *(uint4*)(As + soff + 6 * 4096) = ra6; *(uint4*)(As + soff + 7 * 4096) = ra7;
    *(uint4*)(Bs + soff + 0 * 4096) = rb0; *(uint4*)(Bs + soff + 1 * 4096) = rb1; *(uint4*)(Bs + soff + 2 * 4096) = rb2; *(uint4*)(Bs + soff + 3 * 4096) = rb3;
    __syncthreads();
    if (kt + 1 < nk) {
      const int k0 = (kt + 1) << 6;
      GLOAD_ALL(k0)
    }
#pragma unroll
    for (int kk = 0; kk < 4; ++kk) {
      bf16x8 a[4], b[2];
      const int cc = kk * 2 + hh;
#pragma unroll
      for (int i = 0; i < 4; ++i) {
        const int r = wr * 128 + i * 32 + lr;
        a[i] = *(const bf16x8*)(As + r * 128 + ((cc ^ ((r >> 1) & 7)) << 4));
      }
#pragma unroll
      for (int j = 0; j < 2; ++j) {
        const int r = wc * 64 + j * 32 + lr;
        b[j] = *(const bf16x8*)(Bs + r * 128 + ((cc ^ ((r >> 1) & 7)) << 4));
      }
#pragma unroll
      for (int i = 0; i < 4; ++i)
#pragma unroll
        for (int j = 0; j < 2; ++j) acc[i][j] = SWAP ? MFMA(b[j], a[i], acc[i][j]) : MFMA(a[i], b[j], acc[i][j]);
    }
  }
  __syncthreads();
}

DI void tile_map(int id, int ntn, int& mt, int& nt) {
  const int r = id >> 9, b = id & 511;
  const int x = b & 7, sidx = b >> 3;
  const int P = r * 8 + x;
  mt = (P & 7) * 8 + (sidx & 7);
  nt = (P >> 3) * 8 + (sidx >> 3);
}
DI int tile_count(int ntn) { return ((ntn + 7) >> 3) * 512; }

DI void transpose_tile(const float* __restrict__ src, int R, int C, u16* __restrict__ dst, int kt, int nt, char* smem) {
  float* tile = (float*)smem;
  const int tid = threadIdx.x;
  const int k0 = kt * 64, n0 = nt * 64;
#pragma unroll 4
  for (int it = 0; it < 16; ++it) {
    const int kk = it * 4 + (tid >> 6), nn = tid & 63;
    const int n = n0 + nn;
    tile[kk * 65 + nn] = (n < C) ? src[(size_t)(k0 + kk) * C + n] : 0.f;
  }
  __syncthreads();
#pragma unroll
  for (int it = 0; it < 2; ++it) {
    const int q = tid + 256 * it, nn = q >> 3, kc = q & 7;
    float o[8];
#pragma unroll
    for (int i = 0; i < 8; ++i) o[i] = tile[(kc * 8 + i) * 65 + nn];
    *(bf16x8*)(dst + (size_t)(n0 + nn) * R + k0 + kc * 8) = pack8(o);
  }
  __syncthreads();
}

DI float wave_sum(float v) {
#pragma unroll
  for (int o = 32; o; o >>= 1) v += __shfl_xor(v, o, 64);
  return v;
}

DI void filter_unit(const Params& p, int unit, char* smem) {
  float* sz = (float*)smem;
  float* hA = sz + 8 * 33 + 8;
  float* hB = hA + 8 * 64;
  float* hT = hB + 8 * 64;
  const int tid = opaque_tid();
  const int l0 = unit * 8;
  for (int idx = tid; idx < 8 * 33; idx += 256) {
    const int pp = idx / 33, f = idx - pp * 33;
    const float l = (float)(l0 + pp);
    float v;
    if (f == 0) v = l / 4095.f;
    else {
      const int jb = (f - 1) & 15;
      const float fj = 1e-4f + (float)jb * ((15.f - 1e-4f) / 15.f);
      const float ang = 6.283185307179586f * l / 4096.f;
      v = (f <= 16) ? fcos(fj * ang) : -fsin(fj * ang);
    }
    sz[idx] = v;
  }
  const int o = tid & 63, pq = tid >> 6;
  {
    const float bb = p.filt_b1[o], fr = p.filt_freq[o];
    __syncthreads();
    float s0 = bb, s1 = bb;
#pragma unroll 1
    for (int f0 = 0; f0 < 33; f0 += 11) {
      float wc[11];
#pragma unroll
      for (int f = 0; f < 11; ++f) wc[f] = p.filt_w1[(f0 + f) * 64 + o];
#pragma unroll
      for (int f = 0; f < 11; ++f) { s0 += sz[pq * 33 + f0 + f] * wc[f]; s1 += sz[(pq + 4) * 33 + f0 + f] * wc[f]; }
    }
    hA[pq * 64 + o] = fsin(fr * s0);
    hA[(pq + 4) * 64 + o] = fsin(fr * s1);
  }
  {
    const float bb = p.filt_b2[o], fr = p.filt_freq[64 + o];
    __syncthreads();
    float s0 = bb, s1 = bb;
#pragma unroll 1
    for (int k0 = 0; k0 < 64; k0 += 16) {
      float wc[16];
#pragma unroll
      for (int k = 0; k < 16; ++k) wc[k] = p.filt_w2[(k0 + k) * 64 + o];
#pragma unroll
      for (int k = 0; k < 16; ++k) { s0 += hA[pq * 64 + k0 + k] * wc[k]; s1 += hA[(pq + 4) * 64 + k0 + k] * wc[k]; }
    }
    hB[pq * 64 + o] = fsin(fr * s0);
    hB[(pq + 4) * 64 + o] = fsin(fr * s1);
  }
  {
    const float bb = p.filt_b3[o], fr = p.filt_freq[128 + o];
    __syncthreads();
    float s0 = bb, s1 = bb;
#pragma unroll 1
    for (int k0 = 0; k0 < 64; k0 += 16) {
      float wc[16];
#pragma unroll
      for (int k = 0; k < 16; ++k) wc[k] = p.filt_w3[(k0 + k) * 64 + o];
#pragma unroll
      for (int k = 0; k < 16; ++k) { s0 += hB[pq * 64 + k0 + k] * wc[k]; s1 += hB[(pq + 4) * 64 + k0 + k] * wc[k]; }
    }
    hT[o * 8 + pq] = fsin(fr * s0);
    hT[o * 8 + pq + 4] = fsin(fr * s1);
  }
  __syncthreads();
  float* filt = (float*)(p.ws + OFF_FILT);
  const float min_decay = -3.0701134573253944f, max_decay = -15.350567286626973f;
#pragma unroll 1
  for (int cc = 0; cc < 8; ++cc) {
    const int col = tid + 256 * cc;
    float acc[8];
#pragma unroll
    for (int q = 0; q < 8; ++q) acc[q] = 0.f;
#pragma unroll 1
    for (int k0 = 0; k0 < 64; k0 += 16) {
      float wc[16];
#pragma unroll
      for (int k = 0; k < 16; ++k) wc[k] = p.filt_w4[(k0 + k) * 2048 + col];
#pragma unroll
      for (int k = 0; k < 16; ++k) {
        const float4 h0 = *(const float4*)(hT + (k0 + k) * 8);
        const float4 h1 = *(const float4*)(hT + (k0 + k) * 8 + 4);
        acc[0] += h0.x * wc[k]; acc[1] += h0.y * wc[k]; acc[2] += h0.z * wc[k]; acc[3] += h0.w * wc[k];
        acc[4] += h1.x * wc[k]; acc[5] += h1.y * wc[k]; acc[6] += h1.z * wc[k]; acc[7] += h1.w * wc[k];
      }
    }
    const int ch = col & 511;
    const float delta = fabsf(min_decay + (float)ch * ((max_decay - min_decay) / 511.f));
#pragma unroll
    for (int q = 0; q < 8; ++q) {
      const float t = (float)(l0 + q) / 4095.f;
      acc[q] *= expf(-t * delta);
    }
    float4* dst = (float4*)(filt + (size_t)col * 4096 + l0);
    dst[0] = make_float4(acc[0], acc[1], acc[2], acc[3]);
    dst[1] = make_float4(acc[4], acc[5], acc[6], acc[7]);
  }
  __syncthreads();
}

DI void phase0(const Params& p, char* smem) {
  const int tid = threadIdx.x, lane = tid & 63, wave = tid >> 6;
  const int U_W = 32, U_F = 512, U_X = 1024, U_T1 = 58 * 16, U_T2 = 256, U_T3 = 1024, U_T4 = 1024;
  const int total = U_W + U_F + U_X + U_T1 + U_T2 + U_T3 + U_T4;
  for (int u = blockIdx.x; u < total; u += gridDim.x) {
    int v = u;
    if (v < U_W) {
      const int idx = v * 256 + tid;
      if (idx < 8191) {
        const int lh = 31 - __clz(idx + 1);
        const int h = 1 << lh, jj = idx + 1 - h;
        float2* twp = (float2*)(p.ws + OFF_TW);
        const float ang = -3.14159265358979f * (float)jj / (float)h;
        twp[idx] = make_float2(cosf(ang), sinf(ang));
      }
      continue;
    }
    v -= U_W;
    if (v < U_F) { filter_unit(p, v, smem); continue; }
    v -= U_F;
    if (v < U_X) {
      u16* xn = (u16*)(p.ws + OFF_XN);
#pragma unroll 4
      for (int rr = 0; rr < 4; ++rr) {
        const int row = v * 16 + wave * 4 + rr;
        const float4* xr = (const float4*)(p.x + (size_t)row * DM);
        float4 xv[4];
        float ss = 0.f;
#pragma unroll
        for (int i = 0; i < 4; ++i) {
          xv[i] = xr[lane + 64 * i];
          ss += xv[i].x * xv[i].x + xv[i].y * xv[i].y + xv[i].z * xv[i].z + xv[i].w * xv[i].w;
        }
        ss = wave_sum(ss);
        const float rs = rsqrtf(ss * (1.f / DM) + EPS);
#pragma unroll
        for (int i = 0; i < 4; ++i) {
          const float4 w = ((const float4*)p.norm_mix_pre)[lane + 64 * i];
          ushort4 o;
          o.x = f2bf(xv[i].x * rs * w.x); o.y = f2bf(xv[i].y * rs * w.y); o.z = f2bf(xv[i].z * rs * w.z); o.w = f2bf(xv[i].w * rs * w.w);
          *(ushort4*)(xn + (size_t)row * DM + (lane + 64 * i) * 4) = o;
        }
      }
      continue;
    }
    v -= U_X;
    if (v < U_T1) { transpose_tile(p.w_in, DM, NIN, (u16*)(p.ws + OFF_WINT), v & 15, v >> 4, smem); continue; }
    v -= U_T1;
    if (v < U_T2) { transpose_tile(p.w_out, DM, DM, (u16*)(p.ws + OFF_WOUTT), v & 15, v >> 4, smem); continue; }
    v -= U_T2;
    if (v < U_T3) { transpose_tile(p.w_mlp_in, DM, DFF, (u16*)(p.ws + OFF_W1T), v & 15, v >> 4, smem); continue; }
    v -= U_T3;
    transpose_tile(p.w_mlp_out, DFF, DM, (u16*)(p.ws + OFF_W2T), v & 63, v >> 6, smem);
  }
}

DI void wave_lds_sync() { asm volatile("s_waitcnt lgkmcnt(0)" ::: "memory"); __builtin_amdgcn_wave_barrier(); }
template <int MODE>
DI void stage_tile_ns(const f32x16 (&acc)[4][2], char* wl, int lr, int hh) {
#pragma unroll
  for (int i = 0; i < 4; ++i)
#pragma unroll
    for (int j = 0; j < 2; ++j)
#pragma unroll
      for (int r = 0; r < 16; ++r) {
        float v = acc[i][j][r];
        if (MODE == 1) v = sigmoidf(v);
        if (MODE == 2) { v = fmaxf(v, 0.f); v = v * v; }
        *(u16*)(wl + (i * 32 + crow(r, hh)) * 128 + (j * 32 + lr) * 2) = f2bf(v);
      }
}
DI void stage_tile_sw(const f32x16 (&acc)[4][2], char* wl, int lr, int hh) {
#pragma unroll
  for (int i = 0; i < 4; ++i)
#pragma unroll
    for (int j = 0; j < 2; ++j)
#pragma unroll
      for (int r = 0; r < 16; ++r) *(u16*)(wl + (j * 32 + crow(r, hh)) * 256 + (i * 32 + lr) * 2) = f2bf(acc[i][j][r]);
}
DI void flush_tile_ns(const char* wl, u16* dst, size_t pitch, int lane) {
#pragma unroll 4
  for (int it = 0; it < 16; ++it) {
    const int q = lane + 64 * it, row = q >> 3, c8 = q & 7;
    *(uint4*)(dst + (size_t)row * pitch + c8 * 8) = *(const uint4*)(wl + row * 128 + c8 * 16);
  }
}

DI void phase1(const Params& p, char* smem) {
  const int tid = threadIdx.x, lane = tid & 63, wave = tid >> 6, wr = wave >> 1, wc = wave & 1, lr = lane & 31, hh = lane >> 5;
  const u16* xn = (const u16*)(p.ws + OFF_XN);
  const u16* wt = (const u16*)(p.ws + OFF_WINT);
  u16* qkpre = (u16*)(p.ws + OFF_QKPRE);
  u16* hyT = (u16*)(p.ws + OFF_HYT);
  u16* vT = (u16*)(p.ws + OFF_VT);
  u16* og = (u16*)(p.ws + OFF_OG);
  float* gates = (float*)(p.ws + OFF_GATES);
  const int ntn = 29, ntiles = tile_count(ntn);
  for (int id = blockIdx.x; id < ntiles; id += gridDim.x) {
    int mt, nt;
    tile_map(id, ntn, mt, nt);
    if (nt >= ntn) continue;
    const int m0 = mt * 256, n0 = nt * 128;
    f32x16 acc[4][2];
    const bool swap = (nt >= 8 && nt < 24);
    if (swap) gemm_core<true>(xn, wt, DM, m0, n0, smem, acc);
    else gemm_core<false>(xn, wt, DM, m0, n0, smem, acc);
    char* wl = smem + wave * 16384;
    if (!swap) {
      if (nt < 28) {
        if (nt < 8) stage_tile_ns<0>(acc, wl, lr, hh); else stage_tile_ns<1>(acc, wl, lr, hh);
        wave_lds_sync();
        const size_t row0 = (size_t)(m0 + wr * 128);
        if (nt < 8) flush_tile_ns(wl, qkpre + row0 * 1024 + n0 + wc * 64, 1024, lane);
        else flush_tile_ns(wl, og + row0 * 512 + (n0 - 3072) + wc * 64, 512, lane);
      } else {
#pragma unroll
        for (int i = 0; i < 4; ++i)
#pragma unroll
          for (int r = 0; r < 16; ++r) {
            const int row = m0 + wr * 128 + i * 32 + crow(r, hh);
            if (wc == 0 && lr < 16) gates[(size_t)row * 16 + lr] = acc[i][0][r];
          }
      }
    } else {
      stage_tile_sw(acc, wl, lr, hh);
      wave_lds_sync();
      const int mrow = m0 + wr * 128, b = mrow >> 12, t0 = mrow & 4095;
#pragma unroll 4
      for (int it = 0; it < 16; ++it) {
        const int q = lane + 64 * it, chl = q >> 4, c16 = q & 15;
        const int n = n0 + wc * 64 + chl;
        u16* dst;
        if (nt < 20) { const int cc = n - 1024, g = cc >> 9, ch = cc & 511; dst = hyT + ((size_t)((g * 4 + b) * 512 + ch)) * 4096; }
        else dst = vT + ((size_t)(b * 512 + (n - 2560))) * 4096;
        *(uint4*)(dst + t0 + c16 * 8) = *(const uint4*)(wl + chl * 256 + c16 * 16);
      }
    }
  }
}

DI void phase_qk(const Params& p, char* smem) {
  const int tid = opaque_tid();
  const int cg = tid & 31, rg = tid >> 5;
  const u16* qkpre = (const u16*)(p.ws + OFF_QKPRE);
  u16* qa = (u16*)(p.ws + OFF_QA);
  u16* ka = (u16*)(p.ws + OFF_KA);
  u16* kaT = (u16*)(p.ws + OFF_KAT);
  for (int u = blockIdx.x; u < 1024; u += gridDim.x) {
    const int ct = u & 3, tt = u >> 2;
    const int C0 = ct * 256 + cg * 8;
    const int Tb = tt * 64 + rg * 8;
    const int tb = Tb & 4095;
    float w0[8], w1[8], w2[8], cb[8];
    {
      const float4 a0 = *(const float4*)(p.conv_w + C0), a1 = *(const float4*)(p.conv_w + C0 + 4);
      const float4 b0 = *(const float4*)(p.conv_w + 2560 + C0), b1 = *(const float4*)(p.conv_w + 2560 + C0 + 4);
      const float4 c0 = *(const float4*)(p.conv_w + 5120 + C0), c1 = *(const float4*)(p.conv_w + 5120 + C0 + 4);
      const float4 d0 = *(const float4*)(p.conv_b + C0), d1 = *(const float4*)(p.conv_b + C0 + 4);
      w0[0] = a0.x; w0[1] = a0.y; w0[2] = a0.z; w0[3] = a0.w; w0[4] = a1.x; w0[5] = a1.y; w0[6] = a1.z; w0[7] = a1.w;
      w1[0] = b0.x; w1[1] = b0.y; w1[2] = b0.z; w1[3] = b0.w; w1[4] = b1.x; w1[5] = b1.y; w1[6] = b1.z; w1[7] = b1.w;
      w2[0] = c0.x; w2[1] = c0.y; w2[2] = c0.z; w2[3] = c0.w; w2[4] = c1.x; w2[5] = c1.y; w2[6] = c1.z; w2[7] = c1.w;
      cb[0] = d0.x; cb[1] = d0.y; cb[2] = d0.z; cb[3] = d0.w; cb[4] = d1.x; cb[5] = d1.y; cb[6] = d1.z; cb[7] = d1.w;
    }
    bf16x8 rows[10];
    const u16* src = qkpre + (size_t)Tb * 1024 + C0;
#pragma unroll
    for (int r = 0; r < 10; ++r) {
      const int t = tb + r - 1;
      bf16x8 z;
#pragma unroll
      for (int i = 0; i < 8; ++i) z[i] = 0;
      rows[r] = (t >= 0 && t <= 4095) ? *(const bf16x8*)(src + (ptrdiff_t)(r - 1) * 1024) : z;
    }
    const bool isk = C0 >= 512;
    bf16x8 tr[8];
#pragma unroll
    for (int r = 0; r < 8; ++r) {
      bf16x8 o;
#pragma unroll
      for (int i = 0; i < 8; ++i) {
        const float val = w0[i] * bf2f((u16)rows[r][i]) + w1[i] * bf2f((u16)rows[r + 1][i]) + w2[i] * bf2f((u16)rows[r + 2][i]) + cb[i];
        float sv = val * sigmoidf(val);
        if (isk) sv *= 0.08838834764831845f;
        o[i] = (short)f2bf(sv);
        tr[i][r] = o[i];
      }
      if (!isk) *(bf16x8*)(qa + (size_t)(Tb + r) * 512 + C0) = o;
      else *(bf16x8*)(ka + (size_t)(Tb + r) * 512 + (C0 - 512)) = o;
    }
    if (isk) {
      const int b = Tb >> 12;
#pragma unroll
      for (int i = 0; i < 8; ++i) *(bf16x8*)(kaT + ((size_t)(b * 512 + (C0 - 512) + i)) * 4096 + tb) = tr[i];
    }
  }
}

DI float lz(float v) { asm volatile("" : "+v"(v)); return v; }
DI float2 mk2(float a, float b) { return make_float2(a, b); }
DI float2 cmul(float2 a, float2 w) { return mk2(a.x * w.x - a.y * w.y, a.x * w.y + a.y * w.x); }
DI float2 cmulc(float2 a, float2 w) { return mk2(a.x * w.x + a.y * w.y, a.y * w.x - a.x * w.y); }
DI int lx(int idx) { const int sw = (idx >> 5) & 3; return idx ^ (sw << 3) ^ (sw << 1); }
template <bool LX>
DI void addr4(int base, int q, int k, int& a0, int& a1, int& a2, int& a3) {
  if (!LX) { a0 = base; a1 = base + q; a2 = base + 2 * q; a3 = base + 3 * q; }
  else if (q == 8) {
    const int sw = (k >> 3) & 3, b2 = base ^ (sw << 1);
    a0 = b2 + (sw << 3); a1 = b2 + ((1 ^ sw) << 3); a2 = b2 + ((2 ^ sw) << 3); a3 = b2 + ((3 ^ sw) << 3);
  } else {
    a0 = base; a1 = (base ^ 10) + 32; a2 = (base ^ 20) + 64; a3 = (base ^ 30) + 96;
  }
}
template <int NW, bool INV, bool INLX = false, bool OUTLX = false>
DI void r4_pass(float2* x, int tid, int q, const float2* __restrict__ t1, const float2* __restrict__ t2) {
  constexpr int NL = NW > 4 ? 4 : NW;
  constexpr int NB = NW > 4 ? 2 : 1;
  constexpr int CNT = 8 / NB;
#pragma unroll 1
  for (int bt = 0; bt < NB; ++bt) {
    float2 w1[NL], w2[NL];
#pragma unroll
    for (int n = 0; n < NL; ++n) { const int j = (tid + ((bt * CNT + n) << 8)) & (q - 1); w1[n] = t1[j]; w2[n] = t2[j]; }
    if (bt == 0) __syncthreads();
#pragma unroll(NL == 4 ? 4 : 2)
    for (int ii = 0; ii < CNT; ++ii) {
      const int k = tid + ((bt * CNT + ii) << 8);
      const int j = k & (q - 1);
      int base = ((k - j) << 2) + j;
      asm volatile("" : "+v"(base));
      const float2 ww1 = w1[ii % NL], ww2 = w2[ii % NL];
      int i0_, i1_, i2_, i3_, o0_, o1_, o2_, o3_;
      addr4<INLX>(base, q, k, i0_, i1_, i2_, i3_);
      addr4<OUTLX>(base, q, k, o0_, o1_, o2_, o3_);
      const float2 x0 = x[i0_], x1 = x[i1_], x2 = x[i2_], x3 = x[i3_];
      if (!INV) {
        const float2 a0 = mk2(x0.x + x2.x, x0.y + x2.y);
        const float2 a1 = mk2(x1.x + x3.x, x1.y + x3.y);
        const float2 d02 = mk2(x0.x - x2.x, x0.y - x2.y);
        const float2 d13 = mk2(x1.y - x3.y, x3.x - x1.x);
        const float2 a2 = cmul(d02, ww1);
        const float2 a3 = cmul(d13, ww1);
        x[o0_] = mk2(a0.x + a1.x, a0.y + a1.y);
        x[o1_] = cmul(mk2(a0.x - a1.x, a0.y - a1.y), ww2);
        x[o2_] = mk2(a2.x + a3.x, a2.y + a3.y);
        x[o3_] = cmul(mk2(a2.x - a3.x, a2.y - a3.y), ww2);
      } else {
        const float2 b1 = cmulc(x1, ww2), b3 = cmulc(x3, ww2);
        const float2 a0 = mk2(x0.x + b1.x, x0.y + b1.y);
        const float2 a1 = mk2(x0.x - b1.x, x0.y - b1.y);
        const float2 a2 = mk2(x2.x + b3.x, x2.y + b3.y);
        const float2 a3 = mk2(x2.x - b3.x, x2.y - b3.y);
        const float2 c2 = cmulc(a2, ww1);
        const float2 c3t = cmulc(a3, ww1);
        const float2 c3 = mk2(-c3t.y, c3t.x);
        x[o0_] = mk2(a0.x + c2.x, a0.y + c2.y);
        x[o2_] = mk2(a0.x - c2.x, a0.y - c2.y);
        x[o1_] = mk2(a1.x + c3.x, a1.y + c3.y);
        x[o3_] = mk2(a1.x - c3.x, a1.y - c3.y);
      }
    }
  }
}
template <bool INV>
DI void r8_tail(float2* x, int tid) {
  const float R = 0.70710678118654752f;
#pragma unroll 2
  for (int i = 0; i < 4; ++i) {
    const int G = tid + (i << 8);
    const int sw = (G >> 2) & 3;
    const int blk = (G << 3) ^ (sw << 3);
    float4* p0 = (float4*)(x + blk + ((0 ^ sw) << 1));
    float4* p1 = (float4*)(x + blk + ((1 ^ sw) << 1));
    float4* p2 = (float4*)(x + blk + ((2 ^ sw) << 1));
    float4* p3 = (float4*)(x + blk + ((3 ^ sw) << 1));
    const float4 v0 = *p0, v1 = *p1, v2 = *p2, v3 = *p3;
    float2 e0 = make_float2(v0.x, v0.y), e1 = make_float2(v0.z, v0.w), e2 = make_float2(v1.x, v1.y), e3 = make_float2(v1.z, v1.w);
    float2 e4 = make_float2(v2.x, v2.y), e5 = make_float2(v2.z, v2.w), e6 = make_float2(v3.x, v3.y), e7 = make_float2(v3.z, v3.w);
    if (!INV) {
      const float2 s0 = mk2(e0.x + e4.x, e0.y + e4.y), d0 = mk2(e0.x - e4.x, e0.y - e4.y);
      const float2 s1 = mk2(e1.x + e5.x, e1.y + e5.y), t1 = mk2(e1.x - e5.x, e1.y - e5.y);
      const float2 s2 = mk2(e2.x + e6.x, e2.y + e6.y), t2 = mk2(e2.x - e6.x, e2.y - e6.y);
      const float2 s3 = mk2(e3.x + e7.x, e3.y + e7.y), t3 = mk2(e3.x - e7.x, e3.y - e7.y);
      const float2 d1 = mk2((t1.x + t1.y) * R, (t1.y - t1.x) * R);
      const float2 d2 = mk2(t2.y, -t2.x);
      const float2 d3 = mk2((t3.y - t3.x) * R, -(t3.x + t3.y) * R);
      const float2 a0 = mk2(s0.x + s2.x, s0.y + s2.y), a2 = mk2(s0.x - s2.x, s0.y - s2.y);
      const float2 a1 = mk2(s1.x + s3.x, s1.y + s3.y), u3 = mk2(s1.x - s3.x, s1.y - s3.y);
      const float2 a3 = mk2(u3.y, -u3.x);
      const float2 a4 = mk2(d0.x + d2.x, d0.y + d2.y), a6 = mk2(d0.x - d2.x, d0.y - d2.y);
      const float2 a5 = mk2(d1.x + d3.x, d1.y + d3.y), u7 = mk2(d1.x - d3.x, d1.y - d3.y);
      const float2 a7 = mk2(u7.y, -u7.x);
      *p0 = make_float4(a0.x + a1.x, a0.y + a1.y, a0.x - a1.x, a0.y - a1.y);
      *p1 = make_float4(a2.x + a3.x, a2.y + a3.y, a2.x - a3.x, a2.y - a3.y);
      *p2 = make_float4(a4.x + a5.x, a4.y + a5.y, a4.x - a5.x, a4.y - a5.y);
      *p3 = make_float4(a6.x + a7.x, a6.y + a7.y, a6.x - a7.x, a6.y - a7.y);
    } else {
      const float2 z0 = mk2(e0.x + e1.x, e0.y + e1.y), z1 = mk2(e0.x - e1.x, e0.y - e1.y);
      const float2 z2 = mk2(e2.x + e3.x, e2.y + e3.y), z3 = mk2(e2.x - e3.x, e2.y - e3.y);
      const float2 z4 = mk2(e4.x + e5.x, e4.y + e5.y), z5 = mk2(e4.x - e5.x, e4.y - e5.y);
      const float2 z6 = mk2(e6.x + e7.x, e6.y + e7.y), z7 = mk2(e6.x - e7.x, e6.y - e7.y);
      const float2 b3 = mk2(-z3.y, z3.x), b7 = mk2(-z7.y, z7.x);
      const float2 y0 = mk2(z0.x + z2.x, z0.y + z2.y), y2 = mk2(z0.x - z2.x, z0.y - z2.y);
      const float2 y1 = mk2(z1.x + b3.x, z1.y + b3.y), y3 = mk2(z1.x - b3.x, z1.y - b3.y);
      const float2 y4 = mk2(z4.x + z6.x, z4.y + z6.y), y6 = mk2(z4.x - z6.x, z4.y - z6.y);
      const float2 y5 = mk2(z5.x + b7.x, z5.y + b7.y), y7 = mk2(z5.x - b7.x, z5.y - b7.y);
      const float2 c4 = y4;
      const float2 c5 = mk2((y5.x - y5.y) * R, (y5.x + y5.y) * R);
      const float2 c6 = mk2(-y6.y, y6.x);
      const float2 c7 = mk2(-(y7.x + y7.y) * R, (y7.x - y7.y) * R);
      *p0 = make_float4(y0.x + c4.x, y0.y + c4.y, y1.x + c5.x, y1.y + c5.y);
      *p1 = make_float4(y2.x + c6.x, y2.y + c6.y, y3.x + c7.x, y3.y + c7.y);
      *p2 = make_float4(y0.x - c4.x, y0.y - c4.y, y1.x - c5.x, y1.y - c5.y);
      *p3 = make_float4(y2.x - c6.x, y2.y - c6.y, y3.x - c7.x, y3.y - c7.y);
    }
  }
}
DI void fft_fwd(float2* x, int tid, const float2* __restrict__ tw) {
  r4_pass<8, false>(x, tid, 2048, tw + 4095, tw + 2047);
  r4_pass<2, false>(x, tid, 512, tw + 1023, tw + 511);
  r4_pass<1, false>(x, tid, 128, tw + 255, tw + 127);
  r4_pass<1, false, false, true>(x, tid, 32, tw + 63, tw + 31);
  r4_pass<1, false, true, true>(x, tid, 8, tw + 15, tw + 7);
  __syncthreads();
  r8_tail<false>(x, tid);
  __syncthreads();
}
DI void fft_inv(float2* x, int tid, const float2* __restrict__ tw) {
  __syncthreads();
  r8_tail<true>(x, tid);
  r4_pass<1, true, true, true>(x, tid, 8, tw + 15, tw + 7);
  r4_pass<1, true, true, false>(x, tid, 32, tw + 63, tw + 31);
  r4_pass<1, true>(x, tid, 128, tw + 255, tw + 127);
  r4_pass<2, true>(x, tid, 512, tw + 1023, tw + 511);
  r4_pass<8, true>(x, tid, 2048, tw + 4095, tw + 2047);
  __syncthreads();
}

DI float hy_conv(const u16* __restrict__ pr, int t, float w0, float w1, float w2, float cb) {
  const float a = t > 0 ? bf2f(pr[t - 1]) : 0.f;
  const float b = bf2f(pr[t]);
  const float c = t < 4095 ? bf2f(pr[t + 1]) : 0.f;
  return w0 * a + w1 * b + w2 * c + cb;
}

DI void hy_conv4(const u16* __restrict__ pr, int t0, float w0, float w1, float w2, float cb, float (&o)[4]) {
  const ushort4 c = *(const ushort4*)(pr + t0);
  const float pm = t0 > 0 ? bf2f(pr[t0 - 1]) : 0.f;
  const float pn = t0 + 4 < 4096 ? bf2f(pr[t0 + 4]) : 0.f;
  const float x0 = bf2f(c.x), x1 = bf2f(c.y), x2 = bf2f(c.z), x3 = bf2f(c.w);
  o[0] = w0 * pm + w1 * x0 + w2 * x1 + cb;
  o[1] = w0 * x0 + w1 * x1 + w2 * x2 + cb;
  o[2] = w0 * x1 + w1 * x2 + w2 * x3 + cb;
  o[3] = w0 * x2 + w1 * x3 + w2 * pn + cb;
}

DI void hyena_unit(const Params& p, int ch, char* smem) {
  float2* buf = (float2*)smem;
  const int tid = opaque_tid();
  const u16* hyT = (const u16*)(p.ws + OFF_HYT);
  const float* filt = (const float*)(p.ws + OFF_FILT);
  float* z2T = (float*)(p.ws + OFF_Z2T);
  const float2* tw = (const float2*)(p.ws + OFF_TW);
  float2 Kr[32];
#pragma unroll 1
  for (int ord = 0; ord < 2; ++ord) {
    const float* kf = filt + (size_t)((0 * 2 + ord) * 512 + ch) * 4096;
    const float* kb = filt + (size_t)((1 * 2 + ord) * 512 + ch) * 4096;
    const float fb = p.filt_bias[ord * 512 + ch];
    __syncthreads();
#pragma unroll
    for (int g = 0; g < 4; ++g) {
      const int n0 = g * 1024 + tid * 4;
      float4 v = *(const float4*)(kf + n0);
      if (n0 == 0) v.x += fb;
      *(float4*)(buf + n0) = make_float4(v.x, 0.f, v.y, 0.f);
      *(float4*)(buf + n0 + 2) = make_float4(v.z, 0.f, v.w, 0.f);
      const float4 r = *(const float4*)(kb + 4092 - n0);
      const float e0 = (n0 == 0) ? 0.f : kb[4096 - n0];
      *(float4*)(buf + 4096 + n0) = make_float4(e0, 0.f, r.w, 0.f);
      *(float4*)(buf + 4096 + n0 + 2) = make_float4(r.z, 0.f, r.y, 0.f);
    }
    fft_fwd(buf, tid, tw);
#pragma unroll
    for (int j = 0; j < 32; ++j) {
      const float2 v = buf[tid + 256 * j];
      Kr[j] = make_float2(v.x * (1.f / 8192.f), v.y * (1.f / 8192.f));
    }
    const int gcol = 1024 + (1 + ord) * 512 + ch;
    const float gw0 = p.conv_w[gcol], gw1 = p.conv_w[2560 + gcol], gw2 = p.conv_w[5120 + gcol], gcb = p.conv_b[gcol];
    const int vcol = 1024 + ch;
    const float vw0 = p.conv_w[vcol], vw1 = p.conv_w[2560 + vcol], vw2 = p.conv_w[5120 + vcol], vcb = p.conv_b[vcol];
#pragma unroll 1
    for (int pr = 0; pr < 2; ++pr) {
      const int b0 = 2 * pr, b1 = 2 * pr + 1;
      __syncthreads();
      if (ord == 0) {
        const u16* u0 = hyT + ((size_t)((0 * 4 + b0) * 512 + ch)) * 4096;
        const u16* u1 = hyT + ((size_t)((0 * 4 + b1) * 512 + ch)) * 4096;
#pragma unroll
        for (int g = 0; g < 4; ++g) {
          const int t0 = g * 1024 + tid * 4;
          float a[4], b[4];
          hy_conv4(u0, t0, vw0, vw1, vw2, vcb, a);
          hy_conv4(u1, t0, vw0, vw1, vw2, vcb, b);
          *(float4*)(buf + t0) = make_float4(a[0], b[0], a[1], b[1]);
          *(float4*)(buf + t0 + 2) = make_float4(a[2], b[2], a[3], b[3]);
          *(float4*)(buf + 4096 + t0) = make_float4(0.f, 0.f, 0.f, 0.f);
          *(float4*)(buf + 4096 + t0 + 2) = make_float4(0.f, 0.f, 0.f, 0.f);
        }
      } else {
        const float* u0 = z2T + ((size_t)(b0 * 512 + ch)) * 4096;
        const float* u1 = z2T + ((size_t)(b1 * 512 + ch)) * 4096;
#pragma unroll
        for (int g = 0; g < 4; ++g) {
          const int t0 = g * 1024 + tid * 4;
          const float4 a = *(const float4*)(u0 + t0);
          const float4 b = *(const float4*)(u1 + t0);
          *(float4*)(buf + t0) = make_float4(a.x, b.x, a.y, b.y);
          *(float4*)(buf + t0 + 2) = make_float4(a.z, b.z, a.w, b.w);
          *(float4*)(buf + 4096 + t0) = make_float4(0.f, 0.f, 0.f, 0.f);
          *(float4*)(buf + 4096 + t0 + 2) = make_float4(0.f, 0.f, 0.f, 0.f);
        }
      }
      fft_fwd(buf, tid, tw);
#pragma unroll
      for (int j = 0; j < 32; ++j) {
        const float2 v = buf[tid + 256 * j];
        buf[tid + 256 * j] = make_float2(v.x * Kr[j].x - v.y * Kr[j].y, v.x * Kr[j].y + v.y * Kr[j].x);
      }
      fft_inv(buf, tid, tw);
      const u16* g0 = hyT + ((size_t)(((1 + ord) * 4 + b0) * 512 + ch)) * 4096;
      const u16* g1 = hyT + ((size_t)(((1 + ord) * 4 + b1) * 512 + ch)) * 4096;
      float* o0 = z2T + ((size_t)(b0 * 512 + ch)) * 4096;
      float* o1 = z2T + ((size_t)(b1 * 512 + ch)) * 4096;
#pragma unroll
      for (int g = 0; g < 4; ++g) {
        const int t0 = g * 1024 + tid * 4;
        const float4 y01 = *(const float4*)(buf + t0);
        const float4 y23 = *(const float4*)(buf + t0 + 2);
        float ga[4], gb[4];
        hy_conv4(g0, t0, gw0, gw1, gw2, gcb, ga);
        hy_conv4(g1, t0, gw0, gw1, gw2, gcb, gb);
        *(float4*)(o0 + t0) = make_float4(ga[0] * y01.x, ga[1] * y01.z, ga[2] * y23.x, ga[3] * y23.z);
        *(float4*)(o1 + t0) = make_float4(gb[0] * y01.y, gb[1] * y01.w, gb[2] * y23.y, gb[3] * y23.w);
      }
    }
  }
  __syncthreads();
}

DI void mlstm_local_unit(const Params& p, int u, char* smem) {
  float* s_gi = (float*)smem;
  float* s_lf = s_gi + 128;
  float* s_a = s_lf + 128;
  float* s_w = s_a + 128;
  const int tid = opaque_tid(), lane = tid & 63, wave = tid >> 6, lr = lane & 31, hh = lane >> 5;
  const int j = u & 31, dir = (u >> 5) & 1, bh = u >> 6, h = bh & 3, b = bh >> 2;
  const int T0 = b * 4096 + j * 128;
  const float* gates = (const float*)(p.ws + OFF_GATES);
  const u16* vT = (const u16*)(p.ws + OFF_VT);
  const u16* kaT = (const u16*)(p.ws + OFF_KAT);
  float* CL = p.out;
  float* nl = (float*)(p.ws + OFF_NL);
  float* mloc = (float*)(p.ws + OFF_MLOC);
  float* gsum = (float*)(p.ws + OFF_GSUM);
  __syncthreads();
  if (tid < 128) {
    const int T = T0 + tid;
    s_gi[tid] = gates[(size_t)T * 16 + dir * 8 + h] + p.b_gates[dir * 8 + h];
    s_lf[tid] = log_sigmoid(gates[(size_t)T * 16 + dir * 8 + 4 + h] + p.b_gates[dir * 8 + 4 + h]);
  }
  __syncthreads();
  float gtot = 0.f;
  if (tid < 128) {
    float pre = 0.f;
#pragma unroll 4
    for (int m = 0; m < 128; ++m) {
      const float v = s_lf[m];
      if (m < tid) pre += v;
      gtot += v;
    }
    s_a[tid] = (dir == 0) ? (gtot - pre - s_lf[tid] + s_gi[tid]) : (pre + s_gi[tid]);
  }
  __syncthreads();
  if (tid < 128) {
    float mx = -3.0e38f;
#pragma unroll 4
    for (int m = 0; m < 128; ++m) mx = fmaxf(mx, s_a[m]);
    s_w[tid] = expf(s_a[tid] - mx);
    if (tid == 0) { mloc[u] = mx; gsum[u] = gtot; }
  }
  __syncthreads();
  f32x16 acc[4];
#pragma unroll
  for (int d = 0; d < 4; ++d)
#pragma unroll
    for (int r = 0; r < 16; ++r) acc[d][r] = 0.f;
  const u16* vrow = vT + ((size_t)(bh * 128 + wave * 32 + lr)) * 4096 + j * 128 + hh * 8;
  const u16* kbase = kaT + ((size_t)(bh * 128 + lr)) * 4096 + j * 128 + hh * 8;
#pragma unroll 4
  for (int ks = 0; ks < 8; ++ks) {
    const bf16x8 av = *(const bf16x8*)(vrow + ks * 16);
    bf16x8 a;
#pragma unroll
    for (int i = 0; i < 8; ++i) a[i] = (short)f2bf(bf2f((u16)av[i]) * s_w[ks * 16 + hh * 8 + i]);
#pragma unroll
    for (int dt = 0; dt < 4; ++dt) {
      const bf16x8 bk = *(const bf16x8*)(kbase + (size_t)(dt * 32) * 4096 + ks * 16);
      acc[dt] = MFMA(a, bk, acc[dt]);
    }
  }
  float* dst = CL + (size_t)u * 16384;
#pragma unroll
  for (int dt = 0; dt < 4; ++dt)
#pragma unroll
    for (int r = 0; r < 16; ++r) dst[(wave * 32 + crow(r, hh)) * 128 + dt * 32 + lr] = acc[dt][r];
  if (tid < 128) {
    const u16* kr = kaT + ((size_t)(bh * 128 + tid)) * 4096 + j * 128;
    float s = 0.f;
#pragma unroll 2
    for (int l = 0; l < 128; l += 8) {
      const bf16x8 kv = *(const bf16x8*)(kr + l);
#pragma unroll
      for (int i = 0; i < 8; ++i) s += s_w[l + i] * bf2f((u16)kv[i]);
    }
    nl[(size_t)u * 128 + tid] = s;
  }
}

DI void scan_unit(const Params& p, int unit) {
  const int tid = opaque_tid();
  const int sc = unit >> 4, part = unit & 15, dir = sc & 1;
  float* CL = p.out;
  float* nl = (float*)(p.ws + OFF_NL);
  const float* mloc = (const float*)(p.ws + OFF_MLOC);
  const float* gsum = (const float*)(p.ws + OFF_GSUM);
  float* ms = (float*)(p.ws + OFF_MS);
  const int idx = part * 1024 + tid * 4;
  float4 C = make_float4(0.f, 0.f, 0.f, 0.f);
  float nst = 0.f, m = 0.f;
  const bool do_n = (part == 0) && (tid < 128);
  float4 pf[4];
#pragma unroll
  for (int q = 0; q < 4; ++q) {
    const int jj = dir ? 31 - q : q;
    pf[q] = *(const float4*)(CL + (size_t)(sc * 32 + jj) * 16384 + idx);
  }
#pragma unroll 1
  for (int c0 = 0; c0 < 32; c0 += 4) {
#pragma unroll
    for (int q = 0; q < 4; ++q) {
      const int c = c0 + q;
      const int jj = dir ? 31 - c : c;
      const int u = sc * 32 + jj;
      const float4 cl = pf[q];
      *(float4*)(CL + (size_t)u * 16384 + idx) = C;
      if (c + 4 < 32) {
        const int j2 = dir ? 31 - (c + 4) : (c + 4);
        pf[q] = *(const float4*)(CL + (size_t)(sc * 32 + j2) * 16384 + idx);
      }
      const float g = gsum[u], ml = mloc[u];
      const float mn = fmaxf(g + m, ml);
      const float dec = expf(g + m - mn), scl = expf(ml - mn);
      C.x = dec * C.x + scl * cl.x; C.y = dec * C.y + scl * cl.y; C.z = dec * C.z + scl * cl.z; C.w = dec * C.w + scl * cl.w;
      if (do_n) {
        const float nv = nl[(size_t)u * 128 + tid];
        nl[(size_t)u * 128 + tid] = nst;
        nst = dec * nst + scl * nv;
      }
      if (part == 0 && tid == 0) ms[u] = m;
      m = mn;
    }
  }
}

template <int DIR>
DI void mlstm_dir(const Params& p, int bh, int j, char* smem, f32x16 (&hs)[4]) {
  float* s_gi = (float*)smem;
  float* s_lf = s_gi + 128;
  float* s_bc = s_lf + 128;
  float* s_r = s_bc + 128;
  float* s_al = s_r + 128;
  float* s_fl = s_al + 128;
  float* s_is = s_fl + 128;
  const int tid = opaque_tid(), lane = tid & 63, wave = tid >> 6, lr = lane & 31, hh = lane >> 5;
  u16* Pl = (u16*)(smem + 4096) + wave * (32 * 136);
  const int h = bh & 3, b = bh >> 2;
  const int T0 = b * 4096 + j * 128;
  const float* gates = (const float*)(p.ws + OFF_GATES);
  const u16* qa = (const u16*)(p.ws + OFF_QA);
  const u16* ka = (const u16*)(p.ws + OFF_KA);
  const u16* vT = (const u16*)(p.ws + OFF_VT);
  const float* CS = p.out;
  const float* ns = (const float*)(p.ws + OFF_NL);
  const float* ms = (const float*)(p.ws + OFF_MS);
  u16* A2 = (u16*)(p.ws + OFF_A2);
  bf16x8 ones;
#pragma unroll
  for (int i = 0; i < 8; ++i) ones[i] = (short)0x3F80;
  const u16* qrow = qa + (size_t)(T0 + wave * 32 + lr) * 512 + h * 128 + hh * 8;
  const int u = (bh * 2 + DIR) * 32 + j;
  const float msu = ms[u];
  __syncthreads();
  if (tid < 128) {
    const int T = T0 + tid;
    s_gi[tid] = gates[(size_t)T * 16 + DIR * 8 + h] + p.b_gates[DIR * 8 + h];
    s_lf[tid] = log_sigmoid(gates[(size_t)T * 16 + DIR * 8 + 4 + h] + p.b_gates[DIR * 8 + 4 + h]);
  }
  __syncthreads();
  if (tid < 128) {
    float a = 0.f;
#pragma unroll 4
    for (int m = 0; m < 128; ++m) {
      const bool in = (DIR == 0) ? (m <= tid) : (m >= tid);
      a += in ? s_lf[m] : 0.f;
    }
    s_bc[tid] = a;
    s_r[tid] = s_gi[tid] - a;
  }
  __syncthreads();
  if (tid < 128) {
    float cm = -3.0e38f;
#pragma unroll 4
    for (int m = 0; m < 128; ++m) {
      const bool in = (DIR == 0) ? (m <= tid) : (m >= tid);
      cm = in ? fmaxf(cm, s_r[m]) : cm;
    }
    const float bc = s_bc[tid];
    const float mt = bc + fmaxf(msu, cm);
    s_al[tid] = bc - mt;
    s_fl[tid] = expf(-mt);
    s_is[tid] = expf(bc + msu - mt);
  }
  __syncthreads();
  char* Kt = smem + 4096;
  char* R2 = smem + 40960;
  {
#pragma unroll
    for (int bt = 0; bt < 2; ++bt) {
      uint4 kq[4];
#pragma unroll
      for (int i = 0; i < 4; ++i) {
        const int q = tid + 256 * (bt * 4 + i), row = q >> 4, ch = q & 15;
        kq[i] = *(const uint4*)(ka + (size_t)(T0 + row) * 512 + h * 128 + ch * 8);
      }
#pragma unroll
      for (int i = 0; i < 4; ++i) {
        const int q = tid + 256 * (bt * 4 + i), row = q >> 4, ch = q & 15;
        *(uint4*)(Kt + row * 256 + ((ch ^ (row & 15)) << 4)) = kq[i];
      }
    }
  }
  __syncthreads();
  {
    f32x16 S[4];
#pragma unroll
    for (int st = 0; st < 4; ++st)
#pragma unroll
      for (int r = 0; r < 16; ++r) S[st][r] = 0.f;
#pragma unroll 4
    for (int ks = 0; ks < 8; ++ks) {
      const bf16x8 a = *(const bf16x8*)(qrow + ks * 16);
#pragma unroll
      for (int st = 0; st < 4; ++st) {
        const int krow = st * 32 + lr;
        const bf16x8 bk = *(const bf16x8*)(Kt + krow * 256 + (((ks * 2 + hh) ^ (krow & 15)) << 4));
        S[st] = MFMA(a, bk, S[st]);
      }
    }
    __syncthreads();
#pragma unroll
    for (int st = 0; st < 4; ++st) {
      const int sl = st * 32 + lr;
      const float rs = s_r[sl];
#pragma unroll
      for (int r = 0; r < 16; ++r) {
        const int tl = wave * 32 + crow(r, hh);
        const bool valid = (DIR == 0) ? (sl <= tl) : (sl >= tl);
        const float pv = valid ? S[st][r] * __expf(s_al[tl] + rs) : 0.f;
        Pl[crow(r, hh) * 136 + sl] = f2bf(pv);
      }
    }
  }
#pragma unroll
  for (int eh = 0; eh < 2; ++eh) {
    f32x16 N[3];
#pragma unroll
    for (int e = 0; e < 3; ++e)
#pragma unroll
      for (int r = 0; r < 16; ++r) N[e][r] = 0.f;
    {
      uint4 vq[4];
#pragma unroll
      for (int i = 0; i < 4; ++i) {
        const int q = tid + 256 * i, row = q >> 4, ch = q & 15;
        vq[i] = *(const uint4*)(vT + ((size_t)(bh * 128 + eh * 64 + row)) * 4096 + j * 128 + ch * 8);
      }
#pragma unroll
      for (int i = 0; i < 4; ++i) {
        const int q = tid + 256 * i, row = q >> 4, ch = q & 15;
        *(uint4*)(R2 + row * 256 + ((ch ^ (row & 15)) << 4)) = vq[i];
      }
    }
    __syncthreads();
    {
#pragma unroll 4
      for (int ks = 0; ks < 8; ++ks) {
        const bf16x8 a = *(const bf16x8*)(Pl + lr * 136 + ks * 16 + hh * 8);
#pragma unroll
        for (int e2 = 0; e2 < 2; ++e2) {
          const int vrow = e2 * 32 + lr;
          const bf16x8 bv = *(const bf16x8*)(R2 + vrow * 256 + (((ks * 2 + hh) ^ (vrow & 15)) << 4));
          N[e2] = MFMA(a, bv, N[e2]);
        }
        N[2] = MFMA(a, ones, N[2]);
      }
    }
    {
      bf16x8 cq[4];
#pragma unroll
      for (int i = 0; i < 4; ++i) {
        const int q = tid + 256 * i, row = q >> 4, ch = q & 15;
        const float* src = CS + (size_t)u * 16384 + (size_t)(eh * 64 + row) * 128 + ch * 8;
        const float4 c0 = *(const float4*)(src), c1 = *(const float4*)(src + 4);
        const float cv[8] = {c0.x, c0.y, c0.z, c0.w, c1.x, c1.y, c1.z, c1.w};
        cq[i] = pack8(cv);
      }
      __syncthreads();
#pragma unroll
      for (int i = 0; i < 4; ++i) {
        const int q = tid + 256 * i, row = q >> 4, ch = q & 15;
        *(bf16x8*)(R2 + row * 256 + ((ch ^ (row & 15)) << 4)) = cq[i];
      }
    }
    __syncthreads();
    {
      const float isc = s_is[wave * 32 + lr];
      const float* nbase = ns + (size_t)u * 128 + hh * 8;
#pragma unroll 4
      for (int ks = 0; ks < 8; ++ks) {
        const bf16x8 aq = *(const bf16x8*)(qrow + ks * 16);
        const bf16x8 a = scale8(aq, isc);
#pragma unroll
        for (int e2 = 0; e2 < 2; ++e2) {
          const int crw = e2 * 32 + lr;
          const bf16x8 bc = *(const bf16x8*)(R2 + crw * 256 + (((ks * 2 + hh) ^ (crw & 15)) << 4));
          N[e2] = MFMA(a, bc, N[e2]);
        }
        const float4 n0 = *(const float4*)(nbase + ks * 16);
        const float4 n1 = *(const float4*)(nbase + ks * 16 + 4);
        const float nv[8] = {n0.x, n0.y, n0.z, n0.w, n1.x, n1.y, n1.z, n1.w};
        N[2] = MFMA(a, pack8(nv), N[2]);
      }
    }
    __syncthreads();
    u16* park = (u16*)(p.ws + OFF_HYT) + ((size_t)(bh * 32 + j) * 256 + tid) * 64 + eh * 32;
    bf16x8 pk[4];
    if (DIR == 1) {
#pragma unroll
      for (int q = 0; q < 4; ++q) pk[q] = *(const bf16x8*)(park + q * 8);
    }
#pragma unroll
    for (int r = 0; r < 16; ++r) {
      const int tl = wave * 32 + crow(r, hh);
      const float den = fmaxf(fabsf(N[2][r]), s_fl[tl]);
      const float inv = 1.f / den;
#pragma unroll
      for (int e2 = 0; e2 < 2; ++e2) {
        const float hv = N[e2][r] * inv;
        const int v = e2 * 16 + r;
        if (DIR == 0) pk[v >> 3][v & 7] = (short)f2bf(hv);
        else hs[eh * 2 + e2][r] = hv + bf2f((u16)pk[v >> 3][v & 7]);
      }
    }
    if (DIR == 0) {
#pragma unroll
      for (int q = 0; q < 4; ++q) *(bf16x8*)(park + q * 8) = pk[q];
    }
  }
}

DI void mlstm_out_unit(const Params& p, int unit, char* smem) {
  const int tid = opaque_tid(), lane = tid & 63, wave = tid >> 6, lr = lane & 31, hh = lane >> 5;
  const int j = unit & 31, bh = unit >> 5, h = bh & 3, b = bh >> 2;
  const int T0 = b * 4096 + j * 128;
  const u16* og = (const u16*)(p.ws + OFF_OG);
  u16* A2 = (u16*)(p.ws + OFF_A2);
  f32x16 hs[4];
  mlstm_dir<0>(p, bh, j, smem, hs);
  mlstm_dir<1>(p, bh, j, smem, hs);
  __syncthreads();
  float* wl = (float*)(smem + wave * 16384);
#pragma unroll
  for (int et = 0; et < 4; ++et)
#pragma unroll
    for (int r = 0; r < 16; ++r) wl[crow(r, hh) * 128 + et * 32 + lr] = hs[et][r];
  wave_lds_sync();
  {
    const int row = lane >> 1, half = lane & 1;
    const size_t T = (size_t)(T0 + wave * 32 + row);
    const u16* ogp = og + T * 512 + h * 128 + half * 64;
    const float* src = wl + row * 128 + half * 64;
    float g[64];
    float ss = 0.f;
#pragma unroll
    for (int q = 0; q < 8; ++q) {
      const bf16x8 o8 = *(const bf16x8*)(ogp + q * 8);
      const float4 h0 = *(const float4*)(src + q * 8), h1 = *(const float4*)(src + q * 8 + 4);
      g[q * 8 + 0] = h0.x * bf2f((u16)o8[0]); g[q * 8 + 1] = h0.y * bf2f((u16)o8[1]); g[q * 8 + 2] = h0.z * bf2f((u16)o8[2]); g[q * 8 + 3] = h0.w * bf2f((u16)o8[3]);
      g[q * 8 + 4] = h1.x * bf2f((u16)o8[4]); g[q * 8 + 5] = h1.y * bf2f((u16)o8[5]); g[q * 8 + 6] = h1.z * bf2f((u16)o8[6]); g[q * 8 + 7] = h1.w * bf2f((u16)o8[7]);
#pragma unroll
      for (int i = 0; i < 8; ++i) ss += g[q * 8 + i] * g[q * 8 + i];
    }
    ss += __shfl_xor(ss, 1, 64);
    const float rs = rsqrtf(ss * (1.f / 128.f) + EPS);
    const float* mw = p.mlstm_norm_w + h * 128 + half * 64;
    u16* dst = A2 + T * 1024 + h * 128 + half * 64;
#pragma unroll
    for (int q = 0; q < 8; ++q) {
      const float4 w0 = *(const float4*)(mw + q * 8), w1 = *(const float4*)(mw + q * 8 + 4);
      float o[8];
      o[0] = g[q * 8 + 0] * rs * w0.x; o[1] = g[q * 8 + 1] * rs * w0.y; o[2] = g[q * 8 + 2] * rs * w0.z; o[3] = g[q * 8 + 3] * rs * w0.w;
      o[4] = g[q * 8 + 4] * rs * w1.x; o[5] = g[q * 8 + 5] * rs * w1.y; o[6] = g[q * 8 + 6] * rs * w1.z; o[7] = g[q * 8 + 7] * rs * w1.w;
      *(bf16x8*)(dst + q * 8) = pack8(o);
    }
  }
}

DI void hyena_norm_unit(const Params& p, int unit, char* smem) {
  float* tile = (float*)smem;
  const int tid = opaque_tid();
  const int tt = unit & 63, g = (unit >> 6) & 7, b = unit >> 9;
  const float* z2T = (const float*)(p.ws + OFF_Z2T);
  u16* A2 = (u16*)(p.ws + OFF_A2);
  __syncthreads();
#pragma unroll 4
  for (int i = 0; i < 16; ++i) {
    const int cl = (tid >> 6) + 4 * i, tl = tid & 63;
    tile[cl * 65 + tl] = z2T[((size_t)(b * 512 + g * 64 + cl)) * 4096 + tt * 64 + tl];
  }
  __syncthreads();
  const int tl = tid >> 2, qd = tid & 3;
  float v[16];
  float ss = 0.f;
#pragma unroll
  for (int i = 0; i < 16; ++i) {
    v[i] = tile[(qd * 16 + i) * 65 + tl];
    ss += v[i] * v[i];
  }
  ss += __shfl_xor(ss, 1, 64);
  ss += __shfl_xor(ss, 2, 64);
  const float rs = rsqrtf(ss * (1.f / 64.f) + EPS);
  const size_t T = (size_t)b * 4096 + tt * 64 + tl;
  u16* dst = A2 + T * 1024 + 512 + g * 64 + qd * 16;
  const float* w = p.hyena_norm_w + g * 64 + qd * 16;
  float o[16];
#pragma unroll
  for (int i = 0; i < 16; ++i) o[i] = v[i] * rs * w[i];
  *(bf16x8*)(dst) = pack8(o);
  *(bf16x8*)(dst + 8) = pack8(o + 8);
}

template <int EPI>
DI void gemm_phase(const u16* A, const u16* Bt, int K, int ntn, void* outp, char* smem) {
  const int tid = threadIdx.x, lane = tid & 63, wave = tid >> 6, wr = wave >> 1, wc = wave & 1, lr = lane & 31, hh = lane >> 5;
  const int ntiles = tile_count(ntn);
  for (int id = blockIdx.x; id < ntiles; id += gridDim.x) {
    int mt, nt;
    tile_map(id, ntn, mt, nt);
    if (nt >= ntn) continue;
    const int m0 = mt * 256, n0 = nt * 128;
    f32x16 acc[4][2];
    gemm_core<false>(A, Bt, K, m0, n0, smem, acc);
    if (EPI == 0) {
#pragma unroll
      for (int i = 0; i < 4; ++i)
#pragma unroll
        for (int j = 0; j < 2; ++j)
#pragma unroll
          for (int r = 0; r < 16; ++r) {
            const int row = m0 + wr * 128 + i * 32 + crow(r, hh);
            const int col = n0 + wc * 64 + j * 32 + lr;
            ((float*)outp)[(size_t)row * 1024 + col] = acc[i][j][r];
          }
    } else {
      char* wl = smem + wave * 16384;
      stage_tile_ns<2>(acc, wl, lr, hh);
      wave_lds_sync();
      flush_tile_ns(wl, (u16*)outp + (size_t)(m0 + wr * 128) * 4096 + n0 + wc * 64, 4096, lane);
    }
  }
}

DI void phase_post_mix(const Params& p) {
  const int tid = threadIdx.x, lane = tid & 63, wave = tid >> 6;
  const float* mix = p.out;
  float* x1 = (float*)(p.ws + OFF_X1);
  u16* hm = (u16*)(p.ws + OFF_HM);
  for (int u = blockIdx.x; u < 1024; u += gridDim.x) {
#pragma unroll 2
    for (int rr = 0; rr < 4; ++rr) {
      const size_t row = (size_t)u * 16 + wave * 4 + rr;
      float4 mv[4], xv[4];
      float ss = 0.f;
#pragma unroll
      for (int i = 0; i < 4; ++i) {
        mv[i] = ((const float4*)(mix + row * DM))[lane + 64 * i];
        xv[i] = ((const float4*)(p.x + row * DM))[lane + 64 * i];
        ss += mv[i].x * mv[i].x + mv[i].y * mv[i].y + mv[i].z * mv[i].z + mv[i].w * mv[i].w;
      }
      ss = wave_sum(ss);
      const float rs = rsqrtf(ss * (1.f / DM) + EPS);
      float s2 = 0.f;
#pragma unroll
      for (int i = 0; i < 4; ++i) {
        const float4 w = ((const float4*)p.norm_mix_post)[lane + 64 * i];
        xv[i].x += mv[i].x * rs * w.x; xv[i].y += mv[i].y * rs * w.y; xv[i].z += mv[i].z * rs * w.z; xv[i].w += mv[i].w * rs * w.w;
        s2 += xv[i].x * xv[i].x + xv[i].y * xv[i].y + xv[i].z * xv[i].z + xv[i].w * xv[i].w;
        ((float4*)(x1 + row * DM))[lane + 64 * i] = xv[i];
      }
      s2 = wave_sum(s2);
      const float r2 = rsqrtf(s2 * (1.f / DM) + EPS);
#pragma unroll
      for (int i = 0; i < 4; ++i) {
        const float4 w = ((const float4*)p.norm_mlp_pre)[lane + 64 * i];
        ushort4 o;
        o.x = f2bf(xv[i].x * r2 * w.x); o.y = f2bf(xv[i].y * r2 * w.y); o.z = f2bf(xv[i].z * r2 * w.z); o.w = f2bf(xv[i].w * r2 * w.w);
        *(ushort4*)(hm + row * DM + (lane + 64 * i) * 4) = o;
      }
    }
  }
}

DI void phase_final(const Params& p) {
  const int tid = threadIdx.x, lane = tid & 63, wave = tid >> 6;
  const float* x1 = (const float*)(p.ws + OFF_X1);
  for (int u = blockIdx.x; u < 1024; u += gridDim.x) {
#pragma unroll 2
    for (int rr = 0; rr < 4; ++rr) {
      const size_t row = (size_t)u * 16 + wave * 4 + rr;
      float4 fv[4];
      float ss = 0.f;
#pragma unroll
      for (int i = 0; i < 4; ++i) {
        fv[i] = ((const float4*)(p.out + row * DM))[lane + 64 * i];
        ss += fv[i].x * fv[i].x + fv[i].y * fv[i].y + fv[i].z * fv[i].z + fv[i].w * fv[i].w;
      }
      ss = wave_sum(ss);
      const float rs = rsqrtf(ss * (1.f / DM) + EPS);
#pragma unroll
      for (int i = 0; i < 4; ++i) {
        const float4 w = ((const float4*)p.norm_mlp_post)[lane + 64 * i];
        const float4 xv = ((const float4*)(x1 + row * DM))[lane + 64 * i];
        float4 o;
        o.x = xv.x + fv[i].x * rs * w.x; o.y = xv.y + fv[i].y * rs * w.y; o.z = xv.z + fv[i].z * rs * w.z; o.w = xv.w + fv[i].w * rs * w.w;
        ((float4*)(p.out + row * DM))[lane + 64 * i] = o;
      }
    }
  }
}

DI void run_phase(const Params& p, int ph, char* smem) {
  switch (ph) {
    case 0: phase0(p, smem); break;
    case 1: phase1(p, smem); break;
    case 2: phase_qk(p, smem); break;
    case 3:
#ifdef DBL_HYONLY
      for (int u = blockIdx.x; u < 512; u += gridDim.x) hyena_unit(p, u, smem);
#endif
#ifdef DBL_MLONLY
      for (int u = blockIdx.x; u < 1024; u += gridDim.x) mlstm_local_unit(p, u, smem);
#endif
      for (int u = blockIdx.x; u < 512 + 1024; u += gridDim.x) {
        if (u < 512) hyena_unit(p, u, smem);
        else mlstm_local_unit(p, u - 512, smem);
      }
      break;
    case 4:
      for (int u = blockIdx.x; u < 512; u += gridDim.x) scan_unit(p, u);
      break;
    case 5:
      for (int u = blockIdx.x; u < 512 + 2048; u += gridDim.x) {
#ifndef DBG_SKIP_MLSTM
        if (u < 512) mlstm_out_unit(p, u, smem);
#else
        if (u < 512) { u16* A2 = (u16*)(p.ws + OFF_A2); const int T0 = (u >> 5 >> 2) * 4096 + (u & 31) * 128, hq = (u >> 5) & 3;
          for (int i = threadIdx.x; i < 128 * 128; i += 256) A2[(size_t)(T0 + (i >> 7)) * 1024 + hq * 128 + (i & 127)] = 0; }
#endif
#ifndef DBG_SKIP_HYENA
        else hyena_norm_unit(p, u - 512, smem);
#else
        else { const int un = u - 512; const int tt = un & 63, g = (un >> 6) & 7, b = un >> 9; u16* A2 = (u16*)(p.ws + OFF_A2);
          for (int i = threadIdx.x; i < 64 * 64; i += 256) A2[((size_t)b * 4096 + tt * 64 + (i >> 6)) * 1024 + 512 + g * 64 + (i & 63)] = 0x3F80; }
#endif
      }
      break;
    case 6: gemm_phase<0>((const u16*)(p.ws + OFF_A2), (const u16*)(p.ws + OFF_WOUTT), 1024, 8, p.out, smem); break;
    case 7: phase_post_mix(p); break;
    case 8: gemm_phase<1>((const u16*)(p.ws + OFF_HM), (const u16*)(p.ws + OFF_W1T), 1024, 32, p.ws + OFF_H, smem); break;
    case 9: gemm_phase<0>((const u16*)(p.ws + OFF_H), (const u16*)(p.ws + OFF_W2T), 4096, 8, p.out, smem); break;
    case 10: phase_final(p); break;
  }
}
constexpr int NPHASE = 11;

#define XB_XCNT(j)  (256  + 64 * (j))
#define XB_XSUB(j)  (1280 + 64 * (j))
#define XB_XGEN(j)  (2304 + 64 * (j))
#define XB_TOP      3328
#define XB_TOPGEN   3392
#define XCD_BAR_WORDS 3456
DI unsigned xb_ld(unsigned* p) { return __hip_atomic_load(p, __ATOMIC_RELAXED, __HIP_MEMORY_SCOPE_AGENT); }
DI unsigned xb_add(unsigned* p, unsigned v) { return __hip_atomic_fetch_add(p, v, __ATOMIC_RELAXED, __HIP_MEMORY_SCOPE_AGENT); }
DI unsigned xb_xcc_id() { return (unsigned)__builtin_amdgcn_s_getreg((3 << 11) | 20) & 0xFu; }
struct XcdBar { unsigned* bar; unsigned x, nloc, nx; };
DI void xcd_barrier(XcdBar& b) {
  asm volatile("s_waitcnt vmcnt(0)" ::: "memory");
  __syncthreads();
  if (threadIdx.x == 0) {
    unsigned* bar = b.bar;
    __builtin_amdgcn_s_waitcnt(0);
    if (b.nloc == 0u) {
      const unsigned G = gridDim.x;
      unsigned sum, cnt, mine;
      for (;;) {
        sum = 0u; cnt = 0u; mine = 0u;
#pragma unroll
        for (unsigned j = 0; j < 16; ++j) { const unsigned c = xb_ld(&bar[XB_XCNT(j)]); sum += c; cnt += (c > 0u) ? 1u : 0u; mine = (j == b.x) ? c : mine; }
        if (sum == G) break;
        __builtin_amdgcn_s_sleep(1);
      }
      b.nloc = mine > 0u ? mine : 1u; b.nx = cnt > 0u ? cnt : 1u;
    }
    const unsigned nloc = b.nloc, nx = b.nx;
    const unsigned old = xb_add(&bar[XB_XSUB(b.x)], 1u);
    const unsigned gen = old / nloc;
    if (old + 1u == (gen + 1u) * nloc) {
      __builtin_amdgcn_fence(__ATOMIC_RELEASE, "agent");
      asm volatile("s_waitcnt vmcnt(0)" ::: "memory");
      const unsigned og = xb_add(&bar[XB_TOP], 1u);
      const unsigned tg = og / nx;
      if (og + 1u == (tg + 1u) * nx) xb_add(&bar[XB_TOPGEN], 1u);
      else while (xb_ld(&bar[XB_TOPGEN]) == tg) __builtin_amdgcn_s_sleep(1);
      __builtin_amdgcn_fence(__ATOMIC_ACQUIRE, "agent");
      xb_add(&bar[XB_XGEN(b.x)], 1u);
      asm volatile("s_waitcnt vmcnt(0)" ::: "memory");
    } else {
      while (xb_ld(&bar[XB_XGEN(b.x)]) == gen) __builtin_amdgcn_s_sleep(1);
      __builtin_amdgcn_fence(__ATOMIC_ACQUIRE, "agent");
      asm volatile("s_waitcnt vmcnt(0)" ::: "memory");
    }
  }
  __syncthreads();
}

#if MULTI_LAUNCH
template <int PH>
__global__ void __launch_bounds__(256, 2) phase_kernel(Params p) {
  __shared__ __attribute__((aligned(16))) char smem[65536];
  run_phase(p, PH, smem);
}
template <int PH>
static void launch_phase(const Params& p, hipStream_t stream) {
  hipLaunchKernelGGL(phase_kernel<PH>, dim3(512), dim3(256), 0, stream, p);
}
#else
__global__ void __launch_bounds__(256, 2) mega_kernel(Params p) {
  __shared__ __attribute__((aligned(16))) char smem[65536];
  cg::grid_group grid = cg::this_grid();
  XcdBar xb;
  xb.bar = (unsigned*)(p.ws + OFF_BAR); xb.x = xb_xcc_id(); xb.nloc = 0u; xb.nx = 0u;
  if (p.ws == nullptr) grid.sync();
  if (threadIdx.x == 0) (void)xb_add(&xb.bar[XB_XCNT(xb.x)], 1u);
#define GSYNC xcd_barrier(xb)
#ifdef DBL_P0
  run_phase(p, 0, smem);
#endif
  run_phase(p, 0, smem); GSYNC;
  run_phase(p, 1, smem); GSYNC;
#ifdef DBL_GEMM
  run_phase(p, 1, smem); grid.sync();
#endif
  run_phase(p, 2, smem); GSYNC;
#ifdef DBL_P2
  run_phase(p, 2, smem); GSYNC;
#endif
  run_phase(p, 3, smem); GSYNC;
#ifdef DBL_HY
  run_phase(p, 3, smem); GSYNC;
#endif
  run_phase(p, 4, smem); GSYNC;
  run_phase(p, 5, smem); GSYNC;
#ifdef DBL_P5
  run_phase(p, 5, smem); GSYNC;
#endif
  run_phase(p, 6, smem); GSYNC;
#ifdef DBL_GEMM
  run_phase(p, 6, smem); GSYNC;
#endif
  run_phase(p, 7, smem); GSYNC;
#ifdef DBL_P7
  run_phase(p, 7, smem); GSYNC;
#endif
  run_phase(p, 8, smem); GSYNC;
#ifdef DBL_GEMM
  run_phase(p, 8, smem); GSYNC;
#endif
  run_phase(p, 9, smem); GSYNC;
#ifdef DBL_GEMM
  run_phase(p, 9, smem); GSYNC;
#endif
#ifdef XSYNC
  for (int q = 0; q < 10; ++q) GSYNC;
#endif
  run_phase(p, 10, smem);
}
#endif

extern "C" void kernel_launch(void* const* d_in, const int* in_sizes, int n_in, void* d_out, int out_size, void* d_ws,
                              size_t ws_size, hipStream_t stream) {
  Params p{};
  const float** pp = (const float**)&p;
  for (int i = 0; i < 23; ++i) pp[i] = (const float*)d_in[i];
  p.out = (float*)d_out;
  p.ws = (char*)d_ws;
#if MULTI_LAUNCH
  launch_phase<0>(p, stream);
#ifdef DBL_P0
  launch_phase<0>(p, stream);
#endif
 launch_phase<1>(p, stream); launch_phase<2>(p, stream); launch_phase<3>(p, stream);
#ifdef DBL_HY
  launch_phase<3>(p, stream);
#endif

  launch_phase<4>(p, stream); launch_phase<5>(p, stream);
#ifdef DBL_P5
  launch_phase<5>(p, stream);
#endif
 launch_phase<6>(p, stream); launch_phase<7>(p, stream);
  launch_phase<8>(p, stream); launch_phase<9>(p, stream); launch_phase<10>(p, stream);
#else
  static int grid_blocks = 0;
  if (!grid_blocks) {
    int dev = 0, cus = 0, per_cu = 0;
    hipGetDevice(&dev);
    hipDeviceGetAttribute(&cus, hipDeviceAttributeMultiprocessorCount, dev);
    hipOccupancyMaxActiveBlocksPerMultiprocessor(&per_cu, mega_kernel, 256, 0);
    if (per_cu > 2) per_cu = 2;
    if (per_cu < 1) per_cu = 1;
#ifdef FORCE2
    per_cu = 2;
#endif
    grid_blocks = cus * per_cu;
  }
  hipMemsetAsync((char*)d_ws + OFF_BAR, 0, XCD_BAR_WORDS * 4, stream);
  void* args[] = {&p};
  hipError_t e = hipLaunchCooperativeKernel((void*)mega_kernel, dim3(grid_blocks), dim3(256), args, 0, stream);
  if (e != hipSuccess) fprintf(stderr, "cooperative launch failed: %s (grid %d)\n", hipGetErrorString(e), grid_blocks);
#endif
}
#if defined(__HIP_DEVICE_COMPILE__)
#pragma clang attribute pop
#endif
```

```cpp
#if defined(__HIP_DEVICE_COMPILE__)
#pragma clang attribute push(__attribute__((target("no-packed-fp32-ops"))), apply_to = function)
#endif
#include <hip/hip_runtime.h>
#include <hip/hip_cooperative_groups.h>
#include <cstdio>
namespace cg = cooperative_groups;

#ifndef MULTI_LAUNCH
#define MULTI_LAUNCH 0
#endif

typedef unsigned short u16;
using bf16x8 = __attribute__((ext_vector_type(8))) short;
using f32x16 = __attribute__((ext_vector_type(16))) float;
#define DI __device__ __forceinline__
#define MFMA(a, b, c) __builtin_amdgcn_mfma_f32_32x32x16_bf16((a), (b), (c), 0, 0, 0)

constexpr int SEQ = 4096, DM = 1024, NTOK = 16384, NIN = 3600, NINP = 3712, DFF = 4096;
constexpr float EPS = 1e-6f;
constexpr size_t MiB = 1u << 20;
constexpr size_t OFF_WINT = 0, OFF_WOUTT = 8 * MiB, OFF_W1T = 10 * MiB, OFF_W2T = 18 * MiB;
constexpr size_t OFF_XN = 26 * MiB, OFF_QA = 26 * MiB, OFF_KA = 42 * MiB;
constexpr size_t OFF_FILT = 58 * MiB, OFF_QKPRE = 90 * MiB, OFF_A2 = 90 * MiB;
constexpr size_t OFF_HYT = 122 * MiB, OFF_VT = 170 * MiB, OFF_OG = 186 * MiB, OFF_GATES = 202 * MiB;
constexpr size_t OFF_NL = 203 * MiB, OFF_MLOC = 203 * MiB + 512 * 1024, OFF_GSUM = OFF_MLOC + 4096, OFF_MS = OFF_GSUM + 4096;
constexpr size_t OFF_KAT = 205 * MiB, OFF_Z2T = 221 * MiB;
constexpr size_t OFF_TW = 204 * MiB, OFF_BAR = 254 * MiB;
constexpr size_t OFF_X1 = 26 * MiB, OFF_HM = 90 * MiB, OFF_H = 122 * MiB;

struct Params {
  const float *x, *norm_mix_pre, *norm_mix_post, *norm_mlp_pre, *norm_mlp_post, *w_in, *b_gates, *conv_w, *conv_b,
      *mlstm_norm_w, *hyena_norm_w, *filt_w1, *filt_b1, *filt_w2, *filt_b2, *filt_w3, *filt_b3, *filt_w4, *filt_freq,
      *filt_bias, *w_out, *w_mlp_in, *w_mlp_out;
  float* out;
  char* ws;
};

DI u16 f2bf(float x) { const __bf16 b = (__bf16)x; return __builtin_bit_cast(u16, b); }
DI float bf2f(u16 v) { return __uint_as_float(((unsigned)v) << 16); }
DI int opaque_tid() { int t = threadIdx.x; asm volatile("" : "+v"(t)); return t; }
DI int crow(int r, int hh) { return (r & 3) + 8 * (r >> 2) + 4 * hh; }
DI float log_sigmoid(float x) { return fminf(x, 0.f) - log1pf(expf(-fabsf(x))); }
DI float sigmoidf(float x) { return 1.f / (1.f + expf(-x)); }
DI float red2pi(float x) {
  const float k = rintf(x * 0.15915494309189535f);
  float r = fmaf(-k, 6.28125f, x);
  return fmaf(-k, 1.9353071795864769e-3f, r);
}
DI float fsin(float x) { return sinf(x); }
DI float fcos(float x) { return cosf(x); }
DI bf16x8 pack8(const float* v) {
  bf16x8 r;
#pragma unroll
  for (int i = 0; i < 8; ++i) r[i] = (short)f2bf(v[i]);
  return r;
}
DI bf16x8 scale8(bf16x8 a, float s) {
  bf16x8 r;
#pragma unroll
  for (int i = 0; i < 8; ++i) r[i] = (short)f2bf(bf2f((u16)a[i]) * s);
  return r;
}

template <bool SWAP>
DI void gemm_core(const u16* __restrict__ A, const u16* __restrict__ Bt, int K, int m0, int n0, char* smem, f32x16 (&acc)[4][2]) {
  const int tid = opaque_tid(), lane = tid & 63, wave = tid >> 6, wr = wave >> 1, wc = wave & 1;
  const int lr = lane & 31, hh = lane >> 5;
#pragma unroll
  for (int i = 0; i < 4; ++i)
#pragma unroll
    for (int j = 0; j < 2; ++j)
#pragma unroll
      for (int r = 0; r < 16; ++r) acc[i][j][r] = 0.f;
  const int c = tid & 7, r0 = tid >> 3;
  const u16* Ag = A + (size_t)(m0 + r0) * K + c * 8;
  const u16* Bg = Bt + (size_t)(n0 + r0) * K + c * 8;
  const int soff = r0 * 128 + ((c ^ ((r0 >> 1) & 7)) << 4);
  char* As = smem;
  char* Bs = smem + 32768;
  uint4 ra0, ra1, ra2, ra3, ra4, ra5, ra6, ra7, rb0, rb1, rb2, rb3;
#define GLOAD_ALL(k0)                                                                                             \
  ra0 = *(const uint4*)(Ag + (size_t)(0) * K + (k0));   ra1 = *(const uint4*)(Ag + (size_t)(32) * K + (k0));      \
  ra2 = *(const uint4*)(Ag + (size_t)(64) * K + (k0));  ra3 = *(const uint4*)(Ag + (size_t)(96) * K + (k0));      \
  ra4 = *(const uint4*)(Ag + (size_t)(128) * K + (k0)); ra5 = *(const uint4*)(Ag + (size_t)(160) * K + (k0));     \
  ra6 = *(const uint4*)(Ag + (size_t)(192) * K + (k0)); ra7 = *(const uint4*)(Ag + (size_t)(224) * K + (k0));     \
  rb0 = *(const uint4*)(Bg + (size_t)(0) * K + (k0));   rb1 = *(const uint4*)(Bg + (size_t)(32) * K + (k0));      \
  rb2 = *(const uint4*)(Bg + (size_t)(64) * K + (k0));  rb3 = *(const uint4*)(Bg + (size_t)(96) * K + (k0));
  GLOAD_ALL(0)
  const int nk = K >> 6;
#pragma unroll 1
  for (int kt = 0; kt < nk; ++kt) {
    __syncthreads();
    *(uint4*)(As + soff + 0 * 4096) = ra0; *(uint4*)(As + soff + 1 * 4096) = ra1; *(uint4*)(As + soff + 2 * 4096) = ra2; *(uint4*)(As + soff + 3 * 4096) = ra3;
    *(uint4*)(As + soff + 4 * 4096) = ra4; *(uint4*)(As + soff + 5 * 4096) = ra5; *(uint4*)(As + soff + 6 * 4096) = ra6; *(uint4*)(As + soff + 7 * 4096) = ra7;
    *(uint4*)(Bs + soff + 0 * 4096) = rb0; *(uint4*)(Bs + soff + 1 * 4096) = rb1; *(uint4*)(Bs + soff + 2 * 4096) = rb2; *(uint4*)(Bs + soff + 3 * 4096) = rb3;
    __syncthreads();
    if (kt + 1 < nk) {
      const int k0 = (kt + 1) << 6;
      GLOAD_ALL(k0)
    }
#pragma unroll
    for (int kk = 0; kk < 4; ++kk) {
      bf16x8 a[4], b[2];
      const int cc = kk * 2 + hh;
#pragma unroll
      for (int i = 0; i < 4; ++i) {
        const int r = wr * 128 + i * 32 + lr;
        a[i] = *(const bf16x8*)(As + r * 128 + ((cc ^ ((r >> 1) & 7)) << 4));
      }
#pragma unroll
      for (int j = 0; j < 2; ++j) {
        const int r = wc * 64 + j * 32 + lr;
        b[j] = *(const bf16x8*)(Bs + r * 128 + ((cc ^ ((r >> 1) & 7)) << 4));
      }
#pragma unroll
      for (int i = 0; i < 4; ++i)
#pragma unroll
        for (int j = 0; j < 2; ++j) acc[i][j] = SWAP ? MFMA(b[j], a[i], acc[i][j]) : MFMA(a[i], b[j], acc[i][j]);
    }
  }
  __syncthreads();
}

DI void tile_map(int id, int ntn, int& mt, int& nt) {
  const int r = id >> 9, b = id & 511;
  const int x = b & 7, sidx = b >> 3;
  const int P = r * 8 + x;
  mt = (P & 7) * 8 + (sidx & 7);
  nt = (P >> 3) * 8 + (sidx >> 3);
}
DI int tile_count(int ntn) { return ((ntn + 7) >> 3) * 512; }

DI void transpose_tile(const float* __restrict__ src, int R, int C, u16* __restrict__ dst, int kt, int nt, char* smem) {
  float* tile = (float*)smem;
  const int tid = threadIdx.x;
  const int k0 = kt * 64, n0 = nt * 64;
#pragma unroll 4
  for (int it = 0; it < 16; ++it) {
    const int kk = it * 4 + (tid >> 6), nn = tid & 63;
    const int n = n0 + nn;
    tile[kk * 65 + nn] = (n < C) ? src[(size_t)(k0 + kk) * C + n] : 0.f;
  }
  __syncthreads();
#pragma unroll
  for (int it = 0; it < 2; ++it) {
    const int q = tid + 256 * it, nn = q >> 3, kc = q & 7;
    float o[8];
#pragma unroll
    for (int i = 0; i < 8; ++i) o[i] = tile[(kc * 8 + i) * 65 + nn];
    *(bf16x8*)(dst + (size_t)(n0 + nn) * R + k0 + kc * 8) = pack8(o);
  }
  __syncthreads();
}

DI float wave_sum(float v) {
#pragma unroll
  for (int o = 32; o; o >>= 1) v += __shfl_xor(v, o, 64);
  return v;
}

DI void filter_unit(const Params& p, int unit, char* smem) {
  float* sz = (float*)smem;
  float* hA = sz + 8 * 33 + 8;
  float* hB = hA + 8 * 64;
  float* hT = hB + 8 * 64;
  const int tid = opaque_tid();
  const int l0 = unit * 8;
  for (int idx = tid; idx < 8 * 33; idx += 256) {
    const int pp = idx / 33, f = idx - pp * 33;
    const float l = (float)(l0 + pp);
    float v;
    if (f == 0) v = l / 4095.f;
    else {
      const int jb = (f - 1) & 15;
      const float fj = 1e-4f + (float)jb * ((15.f - 1e-4f) / 15.f);
      const float ang = 6.283185307179586f * l / 4096.f;
      v = (f <= 16) ? fcos(fj * ang) : -fsin(fj * ang);
    }
    sz[idx] = v;
  }
  const int o = tid & 63, pq = tid >> 6;
  {
    const float bb = p.filt_b1[o], fr = p.filt_freq[o];
    __syncthreads();
    float s0 = bb, s1 = bb;
#pragma unroll 1
    for (int f0 = 0; f0 < 33; f0 += 11) {
      float wc[11];
#pragma unroll
      for (int f = 0; f < 11; ++f) wc[f] = p.filt_w1[(f0 + f) * 64 + o];
#pragma unroll
      for (int f = 0; f < 11; ++f) { s0 += sz[pq * 33 + f0 + f] * wc[f]; s1 += sz[(pq + 4) * 33 + f0 + f] * wc[f]; }
    }
    hA[pq * 64 + o] = fsin(fr * s0);
    hA[(pq + 4) * 64 + o] = fsin(fr * s1);
  }
  {
    const float bb = p.filt_b2[o], fr = p.filt_freq[64 + o];
    __syncthreads();
    float s0 = bb, s1 = bb;
#pragma unroll 1
    for (int k0 = 0; k0 < 64; k0 += 16) {
      float wc[16];
#pragma unroll
      for (int k = 0; k < 16; ++k) wc[k] = p.filt_w2[(k0 + k) * 64 + o];
#pragma unroll
      for (int k = 0; k < 16; ++k) { s0 += hA[pq * 64 + k0 + k] * wc[k]; s1 += hA[(pq + 4) * 64 + k0 + k] * wc[k]; }
    }
    hB[pq * 64 + o] = fsin(fr * s0);
    hB[(pq + 4) * 64 + o] = fsin(fr * s1);
  }
  {
    const float bb = p.filt_b3[o], fr = p.filt_freq[128 + o];
    __syncthreads();
    float s0 = bb, s1 = bb;
#pragma unroll 1
    for (int k0 = 0; k0 < 64; k0 += 16) {
      float wc[16];
#pragma unroll
      for (int k = 0; k < 16; ++k) wc[k] = p.filt_w3[(k0 + k) * 64 + o];
#pragma unroll
      for (int k = 0; k < 16; ++k) { s0 += hB[pq * 64 + k0 + k] * wc[k]; s1 += hB[(pq + 4) * 64 + k0 + k] * wc[k]; }
    }
    hT[o * 8 + pq] = fsin(fr * s0);
    hT[o * 8 + pq + 4] = fsin(fr * s1);
  }
  __syncthreads();
  float* filt = (float*)(p.ws + OFF_FILT);
  const float min_decay = -3.0701134573253944f, max_decay = -15.350567286626973f;
#pragma unroll 1
  for (int cc = 0; cc < 8; ++cc) {
    const int col = tid + 256 * cc;
    float acc[8];
#pragma unroll
    for (int q = 0; q < 8; ++q) acc[q] = 0.f;
#pragma unroll 1
    for (int k0 = 0; k0 < 64; k0 += 16) {
      float wc[16];
#pragma unroll
      for (int k = 0; k < 16; ++k) wc[k] = p.filt_w4[(k0 + k) * 2048 + col];
#pragma unroll
      for (int k = 0; k < 16; ++k) {
        const float4 h0 = *(const float4*)(hT + (k0 + k) * 8);
        const float4 h1 = *(const float4*)(hT + (k0 + k) * 8 + 4);
        acc[0] += h0.x * wc[k]; acc[1] += h0.y * wc[k]; acc[2] += h0.z * wc[k]; acc[3] += h0.w * wc[k];
        acc[4] += h1.x * wc[k]; acc[5] += h1.y * wc[k]; acc[6] += h1.z * wc[k]; acc[7] += h1.w * wc[k];
      }
    }
    const int ch = col & 511;
    const float delta = fabsf(min_decay + (float)ch * ((max_decay - min_decay) / 511.f));
#pragma unroll
    for (int q = 0; q < 8; ++q) {
      const float t = (float)(l0 + q) / 4095.f;
      acc[q] *= expf(-t * delta);
    }
    float4* dst = (float4*)(filt + (size_t)col * 4096 + l0);
    dst[0] = make_float4(acc[0], acc[1], acc[2], acc[3]);
    dst[1] = make_float4(acc[4], acc[5], acc[6], acc[7]);
  }
  __syncthreads();
}

DI void phase0(const Params& p, char* smem) {
  const int tid = threadIdx.x, lane = tid & 63, wave = tid >> 6;
  const int U_W = 32, U_F = 512, U_X = 1024, U_T1 = 58 * 16, U_T2 = 256, U_T3 = 1024, U_T4 = 1024;
  const int total = U_W + U_F + U_X + U_T1 + U_T2 + U_T3 + U_T4;
  for (int u = blockIdx.x; u < total; u += gridDim.x) {
    int v = u;
    if (v < U_W) {
      const int idx = v * 256 + tid;
      if (idx < 8191) {
        const int lh = 31 - __clz(idx + 1);
        const int h = 1 << lh, jj = idx + 1 - h;
        float2* twp = (float2*)(p.ws + OFF_TW);
        const float ang = -3.14159265358979f * (float)jj / (float)h;
        twp[idx] = make_float2(cosf(ang), sinf(ang));
      }
      continue;
    }
    v -= U_W;
    if (v < U_F) { filter_unit(p, v, smem); continue; }
    v -= U_F;
    if (v < U_X) {
      u16* xn = (u16*)(p.ws + OFF_XN);
#pragma unroll 4
      for (int rr = 0; rr < 4; ++rr) {
        const int row = v * 16 + wave * 4 + rr;
        const float4* xr = (const float4*)(p.x + (size_t)row * DM);
        float4 xv[4];
        float ss = 0.f;
#pragma unroll
        for (int i = 0; i < 4; ++i) {
          xv[i] = xr[lane + 64 * i];
          ss += xv[i].x * xv[i].x + xv[i].y * xv[i].y + xv[i].z * xv[i].z + xv[i].w * xv[i].w;
        }
        ss = wave_sum(ss);
        const float rs = rsqrtf(ss * (1.f / DM) + EPS);
#pragma unroll
        for (int i = 0; i < 4; ++i) {
          const float4 w = ((const float4*)p.norm_mix_pre)[lane + 64 * i];
          ushort4 o;
          o.x = f2bf(xv[i].x * rs * w.x); o.y = f2bf(xv[i].y * rs * w.y); o.z = f2bf(xv[i].z * rs * w.z); o.w = f2bf(xv[i].w * rs * w.w);
          *(ushort4*)(xn + (size_t)row * DM + (lane + 64 * i) * 4) = o;
        }
      }
      continue;
    }
    v -= U_X;
    if (v < U_T1) { transpose_tile(p.w_in, DM, NIN, (u16*)(p.ws + OFF_WINT), v & 15, v >> 4, smem); continue; }
    v -= U_T1;
    if (v < U_T2) { transpose_tile(p.w_out, DM, DM, (u16*)(p.ws + OFF_WOUTT), v & 15, v >> 4, smem); continue; }
    v -= U_T2;
    if (v < U_T3) { transpose_tile(p.w_mlp_in, DM, DFF, (u16*)(p.ws + OFF_W1T), v & 15, v >> 4, smem); continue; }
    v -= U_T3;
    transpose_tile(p.w_mlp_out, DFF, DM, (u16*)(p.ws + OFF_W2T), v & 63, v >> 6, smem);
  }
}

DI void wave_lds_sync() { asm volatile("s_waitcnt lgkmcnt(0)" ::: "memory"); __builtin_amdgcn_wave_barrier(); }
template <int MODE>
DI void stage_tile_ns(const f32x16 (&acc)[4][2], char* wl, int lr, int hh) {
#pragma unroll
  for (int i = 0; i < 4; ++i)
#pragma unroll
    for (int j = 0; j < 2; ++j)
#pragma unroll
      for (int r = 0; r < 16; ++r) {
        float v = acc[i][j][r];
        if (MODE == 1) v = sigmoidf(v);
        if (MODE == 2) { v = fmaxf(v, 0.f); v = v * v; }
        *(u16*)(wl + (i * 32 + crow(r, hh)) * 128 + (j * 32 + lr) * 2) = f2bf(v);
      }
}
DI void stage_tile_sw(const f32x16 (&acc)[4][2], char* wl, int lr, int hh) {
#pragma unroll
  for (int i = 0; i < 4; ++i)
#pragma unroll
    for (int j = 0; j < 2; ++j)
#pragma unroll
      for (int r = 0; r < 16; ++r) *(u16*)(wl + (j * 32 + crow(r, hh)) * 256 + (i * 32 + lr) * 2) = f2bf(acc[i][j][r]);
}
DI void flush_tile_ns(const char* wl, u16* dst, size_t pitch, int lane) {
#pragma unroll 4
  for (int it = 0; it < 16; ++it) {
    const int q = lane + 64 * it, row = q >> 3, c8 = q & 7;
    *(uint4*)(dst + (size_t)row * pitch + c8 * 8) = *(const uint4*)(wl + row * 128 + c8 * 16);
  }
}

DI void phase1(const Params& p, char* smem) {
  const int tid = threadIdx.x, lane = tid & 63, wave = tid >> 6, wr = wave >> 1, wc = wave & 1, lr = lane & 31, hh = lane >> 5;
  const u16* xn = (const u16*)(p.ws + OFF_XN);
  const u16* wt = (const u16*)(p.ws + OFF_WINT);
  u16* qkpre = (u16*)(p.ws + OFF_QKPRE);
  u16* hyT = (u16*)(p.ws + OFF_HYT);
  u16* vT = (u16*)(p.ws + OFF_VT);
  u16* og = (u16*)(p.ws + OFF_OG);
  float* gates = (float*)(p.ws + OFF_GATES);
  const int ntn = 29, ntiles = tile_count(ntn);
  for (int id = blockIdx.x; id < ntiles; id += gridDim.x) {
    int mt, nt;
    tile_map(id, ntn, mt, nt);
    if (nt >= ntn) continue;
    const int m0 = mt * 256, n0 = nt * 128;
    f32x16 acc[4][2];
    const bool swap = (nt >= 8 && nt < 24);
    if (swap) gemm_core<true>(xn, wt, DM, m0, n0, smem, acc);
    else gemm_core<false>(xn, wt, DM, m0, n0, smem, acc);
    char* wl = smem + wave * 16384;
    if (!swap) {
      if (nt < 28) {
        if (nt < 8) stage_tile_ns<0>(acc, wl, lr, hh); else stage_tile_ns<1>(acc, wl, lr, hh);
        wave_lds_sync();
        const size_t row0 = (size_t)(m0 + wr * 128);
        if (nt < 8) flush_tile_ns(wl, qkpre + row0 * 1024 + n0 + wc * 64, 1024, lane);
        else flush_tile_ns(wl, og + row0 * 512 + (n0 - 3072) + wc * 64, 512, lane);
      } else {
#pragma unroll
        for (int i = 0; i < 4; ++i)
#pragma unroll
          for (int r = 0; r < 16; ++r) {
            const int row = m0 + wr * 128 + i * 32 + crow(r, hh);
            if (wc == 0 && lr < 16) gates[(size_t)row * 16 + lr] = acc[i][0][r];
          }
      }
    } else {
      stage_tile_sw(acc, wl, lr, hh);
      wave_lds_sync();
      const int mrow = m0 + wr * 128, b = mrow >> 12, t0 = mrow & 4095;
#pragma unroll 4
      for (int it = 0; it < 16; ++it) {
        const int q = lane + 64 * it, chl = q >> 4, c16 = q & 15;
        const int n = n0 + wc * 64 + chl;
        u16* dst;
        if (nt < 20) { const int cc = n - 1024, g = cc >> 9, ch = cc & 511; dst = hyT + ((size_t)((g * 4 + b) * 512 + ch)) * 4096; }
        else dst = vT + ((size_t)(b * 512 + (n - 2560))) * 4096;
        *(uint4*)(dst + t0 + c16 * 8) = *(const uint4*)(wl + chl * 256 + c16 * 16);
      }
    }
  }
}

DI void phase_qk(const Params& p, char* smem) {
  const int tid = opaque_tid();
  const int cg = tid & 31, rg = tid >> 5;
  const u16* qkpre = (const u16*)(p.ws + OFF_QKPRE);
  u16* qa = (u16*)(p.ws + OFF_QA);
  u16* ka = (u16*)(p.ws + OFF_KA);
  u16* kaT = (u16*)(p.ws + OFF_KAT);
  for (int u = blockIdx.x; u < 1024; u += gridDim.x) {
    const int ct = u & 3, tt = u >> 2;
    const int C0 = ct * 256 + cg * 8;
    const int Tb = tt * 64 + rg * 8;
    const int tb = Tb & 4095;
    float w0[8], w1[8], w2[8], cb[8];
    {
      const float4 a0 = *(const float4*)(p.conv_w + C0), a1 = *(const float4*)(p.conv_w + C0 + 4);
      const float4 b0 = *(const float4*)(p.conv_w + 2560 + C0), b1 = *(const float4*)(p.conv_w + 2560 + C0 + 4);
      const float4 c0 = *(const float4*)(p.conv_w + 5120 + C0), c1 = *(const float4*)(p.conv_w + 5120 + C0 + 4);
      const float4 d0 = *(const float4*)(p.conv_b + C0), d1 = *(const float4*)(p.conv_b + C0 + 4);
      w0[0] = a0.x; w0[1] = a0.y; w0[2] = a0.z; w0[3] = a0.w; w0[4] = a1.x; w0[5] = a1.y; w0[6] = a1.z; w0[7] = a1.w;
      w1[0] = b0.x; w1[1] = b0.y; w1[2] = b0.z; w1[3] = b0.w; w1[4] = b1.x; w1[5] = b1.y; w1[6] = b1.z; w1[7] = b1.w;
      w2[0] = c0.x; w2[1] = c0.y; w2[2] = c0.z; w2[3] = c0.w; w2[4] = c1.x; w2[5] = c1.y; w2[6] = c1.z; w2[7] = c1.w;
      cb[0] = d0.x; cb[1] = d0.y; cb[2] = d0.z; cb[3] = d0.w; cb[4] = d1.x; cb[5] = d1.y; cb[6] = d1.z; cb[7] = d1.w;
    }
    bf16x8 rows[10];
    const u16* src = qkpre + (size_t)Tb * 1024 + C0;
#pragma unroll
    for (int r = 0; r < 10; ++r) {
      const int t = tb + r - 1;
      bf16x8 z;
#pragma unroll
      for (int i = 0; i < 8; ++i) z[i] = 0;
      rows[r] = (t >= 0 && t <= 4095) ? *(const bf16x8*)(src + (ptrdiff_t)(r - 1) * 1024) : z;
    }
    const bool isk = C0 >= 512;
    bf16x8 tr[8];
#pragma unroll
    for (int r = 0; r < 8; ++r) {
      bf16x8 o;
#pragma unroll
      for (int i = 0; i < 8; ++i) {
        const float val = w0[i] * bf2f((u16)rows[r][i]) + w1[i] * bf2f((u16)rows[r + 1][i]) + w2[i] * bf2f((u16)rows[r + 2][i]) + cb[i];
        float sv = val * sigmoidf(val);
        if (isk) sv *= 0.08838834764831845f;
        o[i] = (short)f2bf(sv);
        tr[i][r] = o[i];
      }
      if (!isk) *(bf16x8*)(qa + (size_t)(Tb + r) * 512 + C0) = o;
      else *(bf16x8*)(ka + (size_t)(Tb + r) * 512 + (C0 - 512)) = o;
    }
    if (isk) {
      const int b = Tb >> 12;
#pragma unroll
      for (int i = 0; i < 8; ++i) *(bf16x8*)(kaT + ((size_t)(b * 512 + (C0 - 512) + i)) * 4096 + tb) = tr[i];
    }
  }
}

DI float lz(float v) { asm volatile("" : "+v"(v)); return v; }
DI float2 mk2(float a, float b) { return make_float2(a, b); }
DI float2 cmul(float2 a, float2 w) { return mk2(a.x * w.x - a.y * w.y, a.x * w.y + a.y * w.x); }
DI float2 cmulc(float2 a, float2 w) { return mk2(a.x * w.x + a.y * w.y, a.y * w.x - a.x * w.y); }
DI int lx(int idx) { const int sw = (idx >> 5) & 3; return idx ^ (sw << 3) ^ (sw << 1); }
template <bool LX>
DI void addr4(int base, int q, int k, int& a0, int& a1, int& a2, int& a3) {
  if (!LX) { a0 = base; a1 = base + q; a2 = base + 2 * q; a3 = base + 3 * q; }
  else if (q == 8) {
    const int sw = (k >> 3) & 3, b2 = base ^ (sw << 1);
    a0 = b2 + (sw << 3); a1 = b2 + ((1 ^ sw) << 3); a2 = b2 + ((2 ^ sw) << 3); a3 = b2 + ((3 ^ sw) << 3);
  } else {
    a0 = base; a1 = (base ^ 10) + 32; a2 = (base ^ 20) + 64; a3 = (base ^ 30) + 96;
  }
}
template <int NW, bool INV, bool INLX = false, bool OUTLX = false>
DI void r4_pass(float2* x, int tid, int q, const float2* __restrict__ t1, const float2* __restrict__ t2) {
  constexpr int NL = NW > 4 ? 4 : NW;
  constexpr int NB = NW > 4 ? 2 : 1;
  constexpr int CNT = 8 / NB;
#pragma unroll 1
  for (int bt = 0; bt < NB; ++bt) {
    float2 w1[NL], w2[NL];
#pragma unroll
    for (int n = 0; n < NL; ++n) { const int j = (tid + ((bt * CNT + n) << 8)) & (q - 1); w1[n] = t1[j]; w2[n] = t2[j]; }
    if (bt == 0) __syncthreads();
#pragma unroll(NL == 4 ? 4 : 2)
    for (int ii = 0; ii < CNT; ++ii) {
      const int k = tid + ((bt * CNT + ii) << 8);
      const int j = k & (q - 1);
      int base = ((k - j) << 2) + j;
      asm volatile("" : "+v"(base));
      const float2 ww1 = w1[ii % NL], ww2 = w2[ii % NL];
      int i0_, i1_, i2_, i3_, o0_, o1_, o2_, o3_;
      addr4<INLX>(base, q, k, i0_, i1_, i2_, i3_);
      addr4<OUTLX>(base, q, k, o0_, o1_, o2_, o3_);
      const float2 x0 = x[i0_], x1 = x[i1_], x2 = x[i2_], x3 = x[i3_];
      if (!INV) {
        const float2 a0 = mk2(x0.x + x2.x, x0.y + x2.y);
        const float2 a1 = mk2(x1.x + x3.x, x1.y + x3.y);
        const float2 d02 = mk2(x0.x - x2.x, x0.y - x2.y);
        const float2 d13 = mk2(x1.y - x3.y, x3.x - x1.x);
        const float2 a2 = cmul(d02, ww1);
        const float2 a3 = cmul(d13, ww1);
        x[o0_] = mk2(a0.x + a1.x, a0.y + a1.y);
        x[o1_] = cmul(mk2(a0.x - a1.x, a0.y - a1.y), ww2);
        x[o2_] = mk2(a2.x + a3.x, a2.y + a3.y);
        x[o3_] = cmul(mk2(a2.x - a3.x, a2.y - a3.y), ww2);
      } else {
        const float2 b1 = cmulc(x1, ww2), b3 = cmulc(x3, ww2);
        const float2 a0 = mk2(x0.x + b1.x, x0.y + b1.y);
        const float2 a1 = mk2(x0.x - b1.x, x0.y - b1.y);
        const float2 a2 = mk2(x2.x + b3.x, x2.y + b3.y);
        const float2 a3 = mk2(x2.x - b3.x, x2.y - b3.y);
        const float2 c2 = cmulc(a2, ww1);
        const float2 c3t = cmulc(a3, ww1);
        const float2 c3 = mk2(-c3t.y, c3t.x);
        x[o0_] = mk2(a0.x + c2.x, a0.y + c2.y);
        x[o2_] = mk2(a0.x - c2.x, a0.y - c2.y);
        x[o1_] = mk2(a1.x + c3.x, a1.y + c3.y);
        x[o3_] = mk2(a1.x - c3.x, a1.y - c3.y);
      }
    }
  }
}
template <bool INV>
DI void r8_tail(float2* x, int tid) {
  const float R = 0.70710678118654752f;
#pragma unroll 2
  for (int i = 0; i < 4; ++i) {
    const int G = tid + (i << 8);
    const int sw = (G >> 2) & 3;
    const int blk = (G << 3) ^ (sw << 3);
    float4* p0 = (float4*)(x + blk + ((0 ^ sw) << 1));
    float4* p1 = (float4*)(x + blk + ((1 ^ sw) << 1));
    float4* p2 = (float4*)(x + blk + ((2 ^ sw) << 1));
    float4* p3 = (float4*)(x + blk + ((3 ^ sw) << 1));
    const float4 v0 = *p0, v1 = *p1, v2 = *p2, v3 = *p3;
    float2 e0 = make_float2(v0.x, v0.y), e1 = make_float2(v0.z, v0.w), e2 = make_float2(v1.x, v1.y), e3 = make_float2(v1.z, v1.w);
    float2 e4 = make_float2(v2.x, v2.y), e5 = make_float2(v2.z, v2.w), e6 = make_float2(v3.x, v3.y), e7 = make_float2(v3.z, v3.w);
    if (!INV) {
      const float2 s0 = mk2(e0.x + e4.x, e0.y + e4.y), d0 = mk2(e0.x - e4.x, e0.y - e4.y);
      const float2 s1 = mk2(e1.x + e5.x, e1.y + e5.y), t1 = mk2(e1.x - e5.x, e1.y - e5.y);
      const float2 s2 = mk2(e2.x + e6.x, e2.y + e6.y), t2 = mk2(e2.x - e6.x, e2.y - e6.y);
      const float2 s3 = mk2(e3.x + e7.x, e3.y + e7.y), t3 = mk2(e3.x - e7.x, e3.y - e7.y);
      const float2 d1 = mk2((t1.x + t1.y) * R, (t1.y - t1.x) * R);
      const float2 d2 = mk2(t2.y, -t2.x);
      const float2 d3 = mk2((t3.y - t3.x) * R, -(t3.x + t3.y) * R);
      const float2 a0 = mk2(s0.x + s2.x, s0.y + s2.y), a2 = mk2(s0.x - s2.x, s0.y - s2.y);
      const float2 a1 = mk2(s1.x + s3.x, s1.y + s3.y), u3 = mk2(s1.x - s3.x, s1.y - s3.y);
      const float2 a3 = mk2(u3.y, -u3.x);
      const float2 a4 = mk2(d0.x + d2.x, d0.y + d2.y), a6 = mk2(d0.x - d2.x, d0.y - d2.y);
      const float2 a5 = mk2(d1.x + d3.x, d1.y + d3.y), u7 = mk2(d1.x - d3.x, d1.y - d3.y);
      const float2 a7 = mk2(u7.y, -u7.x);
      *p0 = make_float4(a0.x + a1.x, a0.y + a1.y, a0.x - a1.x, a0.y - a1.y);
      *p1 = make_float4(a2.x + a3.x, a2.y + a3.y, a2.x - a3.x, a2.y - a3.y);
      *p2 = make_float4(a4.x + a5.x, a4.y + a5.y, a4.x - a5.x, a4.y - a5.y);
      *p3 = make_float4(a6.x + a7.x, a6.y + a7.y, a6.x - a7.x, a6.y - a7.y);
    } else {
      const float2 z0 = mk2(e0.x + e1.x, e0.y + e1.y), z1 = mk2(e0.x - e1.x, e0.y - e1.y);
      const float2 z2 = mk2(e2.x + e3.x, e2.y + e3.y), z3 = mk2(e2.x - e3.x, e2.y - e3.y);
      const float2 z4 = mk2(e4.x + e5.x, e4.y + e5.y), z5 = mk2(e4.x - e5.x, e4.y - e5.y);
      const float2 z6 = mk2(e6.x + e7.x, e6.y + e7.y), z7 = mk2(e6.x - e7.x, e6.y - e7.y);
      const float2 b3 = mk2(-z3.y, z3.x), b7 = mk2(-z7.y, z7.x);
      const float2 y0 = mk2(z0.x + z2.x, z0.y + z2.y), y2 = mk2(z0.x - z2.x, z0.y - z2.y);
      const float2 y1 = mk2(z1.x + b3.x, z1.y + b3.y), y3 = mk2(z1.x - b3.x, z1.y - b3.y);
      const float2 y4 = mk2(z4.x + z6.x, z4.y + z6.y), y6 = mk2(z4.x - z6.x, z4.y - z6.y);
      const float2 y5 = mk2(z5.x + b7.x, z5.y + b7.y), y7 = mk2(z5.x - b7.x, z5.y - b7.y);
      const float2 c4 = y4;
      const float2 c5 = mk2((y5.x - y5.y) * R, (y5.x + y5.y) * R);
      const float2 c6 = mk2(-y6.y, y6.x);
      const float2 c7 = mk2(-(y7.x + y7.y) * R, (y7.x - y7.y) * R);
      *p0 = make_float4(y0.x + c4.x, y0.y + c4.y, y1.x + c5.x, y1.y + c5.y);
      *p1 = make_float4(y2.x + c6.x, y2.y + c6.y, y3.x + c7.x, y3.y + c7.y);
      *p2 = make_float4(y0.x - c4.x, y0.y - c4.y, y1.x - c5.x, y1.y - c5.y);
      *p3 = make_float4(y2.x - c6.x, y2.y - c6.y, y3.x - c7.x, y3.y - c7.y);
    }
  }
}
DI void fft_fwd(float2* x, int tid, const float2* __restrict__ tw) {
  r4_pass<8, false>(x, tid, 2048, tw + 4095, tw + 2047);
  r4_pass<2, false>(x, tid, 512, tw + 1023, tw + 511);
  r4_pass<1, false>(x, tid, 128, tw + 255, tw + 127);
  r4_pass<1, false, false, true>(x, tid, 32, tw + 63, tw + 31);
  r4_pass<1, false, true, true>(x, tid, 8, tw + 15, tw + 7);
  __syncthreads();
  r8_tail<false>(x, tid);
  __syncthreads();
}
DI void fft_inv(float2* x, int tid, const float2* __restrict__ tw) {
  __syncthreads();
  r8_tail<true>(x, tid);
  r4_pass<1, true, true, true>(x, tid, 8, tw + 15, tw + 7);
  r4_pass<1, true, true, false>(x, tid, 32, tw + 63, tw + 31);
  r4_pass<1, true>(x, tid, 128, tw + 255, tw + 127);
  r4_pass<2, true>(x, tid, 512, tw + 1023, tw + 511);
  r4_pass<8, true>(x, tid, 2048, tw + 4095, tw + 2047);
  __syncthreads();
}

DI float hy_conv(const u16* __restrict__ pr, int t, float w0, float w1, float w2, float cb) {
  const float a = t > 0 ? bf2f(pr[t - 1]) : 0.f;
  const float b = bf2f(pr[t]);
  const float c = t < 4095 ? bf2f(pr[t + 1]) : 0.f;
  return w0 * a + w1 * b + w2 * c + cb;
}

DI void hy_conv4(const u16* __restrict__ pr, int t0, float w0, float w1, float w2, float cb, float (&o)[4]) {
  const ushort4 c = *(const ushort4*)(pr + t0);
  const float pm = t0 > 0 ? bf2f(pr[t0 - 1]) : 0.f;
  const float pn = t0 + 4 < 4096 ? bf2f(pr[t0 + 4]) : 0.f;
  const float x0 = bf2f(c.x), x1 = bf2f(c.y), x2 = bf2f(c.z), x3 = bf2f(c.w);
  o[0] = w0 * pm + w1 * x0 + w2 * x1 + cb;
  o[1] = w0 * x0 + w1 * x1 + w2 * x2 + cb;
  o[2] = w0 * x1 + w1 * x2 + w2 * x3 + cb;
  o[3] = w0 * x2 + w1 * x3 + w2 * pn + cb;
}

DI void hyena_unit(const Params& p, int ch, char* smem) {
  float2* buf = (float2*)smem;
  const int tid = opaque_tid();
  const u16* hyT = (const u16*)(p.ws + OFF_HYT);
  const float* filt = (const float*)(p.ws + OFF_FILT);
  float* z2T = (float*)(p.ws + OFF_Z2T);
  const float2* tw = (const float2*)(p.ws + OFF_TW);
  float2 Kr[32];
#pragma unroll 1
  for (int ord = 0; ord < 2; ++ord) {
    const float* kf = filt + (size_t)((0 * 2 + ord) * 512 + ch) * 4096;
    const float* kb = filt + (size_t)((1 * 2 + ord) * 512 + ch) * 4096;
    const float fb = p.filt_bias[ord * 512 + ch];
    __syncthreads();
#pragma unroll
    for (int g = 0; g < 4; ++g) {
      const int n0 = g * 1024 + tid * 4;
      float4 v = *(const float4*)(kf + n0);
      if (n0 == 0) v.x += fb;
      *(float4*)(buf + n0) = make_float4(v.x, 0.f, v.y, 0.f);
      *(float4*)(buf + n0 + 2) = make_float4(v.z, 0.f, v.w, 0.f);
      const float4 r = *(const float4*)(kb + 4092 - n0);
      const float e0 = (n0 == 0) ? 0.f : kb[4096 - n0];
      *(float4*)(buf + 4096 + n0) = make_float4(e0, 0.f, r.w, 0.f);
      *(float4*)(buf + 4096 + n0 + 2) = make_float4(r.z, 0.f, r.y, 0.f);
    }
    fft_fwd(buf, tid, tw);
#pragma unroll
    for (int j = 0; j < 32; ++j) {
      const float2 v = buf[tid + 256 * j];
      Kr[j] = make_float2(v.x * (1.f / 8192.f), v.y * (1.f / 8192.f));
    }
    const int gcol = 1024 + (1 + ord) * 512 + ch;
    const float gw0 = p.conv_w[gcol], gw1 = p.conv_w[2560 + gcol], gw2 = p.conv_w[5120 + gcol], gcb = p.conv_b[gcol];
    const int vcol = 1024 + ch;
    const float vw0 = p.conv_w[vcol], vw1 = p.conv_w[2560 + vcol], vw2 = p.conv_w[5120 + vcol], vcb = p.conv_b[vcol];
#pragma unroll 1
    for (int pr = 0; pr < 2; ++pr) {
      const int b0 = 2 * pr, b1 = 2 * pr + 1;
      __syncthreads();
      if (ord == 0) {
        const u16* u0 = hyT + ((size_t)((0 * 4 + b0) * 512 + ch)) * 4096;
        const u16* u1 = hyT + ((size_t)((0 * 4 + b1) * 512 + ch)) * 4096;
#pragma unroll
        for (int g = 0; g < 4; ++g) {
          const int t0 = g * 1024 + tid * 4;
          float a[4], b[4];
          hy_conv4(u0, t0, vw0, vw1, vw2, vcb, a);
          hy_conv4(u1, t0, vw0, vw1, vw2, vcb, b);
          *(float4*)(buf + t0) = make_float4(a[0], b[0], a[1], b[1]);
          *(float4*)(buf + t0 + 2) = make_float4(a[2], b[2], a[3], b[3]);
          *(float4*)(buf + 4096 + t0) = make_float4(0.f, 0.f, 0.f, 0.f);
          *(float4*)(buf + 4096 + t0 + 2) = make_float4(0.f, 0.f, 0.f, 0.f);
        }
      } else {
        const float* u0 = z2T + ((size_t)(b0 * 512 + ch)) * 4096;
        const float* u1 = z2T + ((size_t)(b1 * 512 + ch)) * 4096;
#pragma unroll
        for (int g = 0; g < 4; ++g) {
          const int t0 = g * 1024 + tid * 4;
          const float4 a = *(const float4*)(u0 + t0);
          const float4 b = *(const float4*)(u1 + t0);
          *(float4*)(buf + t0) = make_float4(a.x, b.x, a.y, b.y);
          *(float4*)(buf + t0 + 2) = make_float4(a.z, b.z, a.w, b.w);
          *(float4*)(buf + 4096 + t0) = make_float4(0.f, 0.f, 0.f, 0.f);
          *(float4*)(buf + 4096 + t0 + 2) = make_float4(0.f, 0.f, 0.f, 0.f);
        }
      }
      fft_fwd(buf, tid, tw);
#pragma unroll
      for (int j = 0; j < 32; ++j) {
        const float2 v = buf[tid + 256 * j];
        buf[tid + 256 * j] = make_float2(v.x * Kr[j].x - v.y * Kr[j].y, v.x * Kr[j].y + v.y * Kr[j].x);
      }
      fft_inv(buf, tid, tw);
      const u16* g0 = hyT + ((size_t)(((1 + ord) * 4 + b0) * 512 + ch)) * 4096;
      const u16* g1 = hyT + ((size_t)(((1 + ord) * 4 + b1) * 512 + ch)) * 4096;
      float* o0 = z2T + ((size_t)(b0 * 512 + ch)) * 4096;
      float* o1 = z2T + ((size_t)(b1 * 512 + ch)) * 4096;
#pragma unroll
      for (int g = 0; g < 4; ++g) {
        const int t0 = g * 1024 + tid * 4;
        const float4 y01 = *(const float4*)(buf + t0);
        const float4 y23 = *(const float4*)(buf + t0 + 2);
        float ga[4], gb[4];
        hy_conv4(g0, t0, gw0, gw1, gw2, gcb, ga);
        hy_conv4(g1, t0, gw0, gw1, gw2, gcb, gb);
        *(float4*)(o0 + t0) = make_float4(ga[0] * y01.x, ga[1] * y01.z, ga[2] * y23.x, ga[3] * y23.z);
        *(float4*)(o1 + t0) = make_float4(gb[0] * y01.y, gb[1] * y01.w, gb[2] * y23.y, gb[3] * y23.w);
      }
    }
  }
  __syncthreads();
}

DI void mlstm_local_unit(const Params& p, int u, char* smem) {
  float* s_gi = (float*)smem;
  float* s_lf = s_gi + 128;
  float* s_a = s_lf + 128;
  float* s_w = s_a + 128;
  const int tid = opaque_tid(), lane = tid & 63, wave = tid >> 6, lr = lane & 31, hh = lane >> 5;
  const int j = u & 31, dir = (u >> 5) & 1, bh = u >> 6, h = bh & 3, b = bh >> 2;
  const int T0 = b * 4096 + j * 128;
  const float* gates = (const float*)(p.ws + OFF_GATES);
  const u16* vT = (const u16*)(p.ws + OFF_VT);
  const u16* kaT = (const u16*)(p.ws + OFF_KAT);
  float* CL = p.out;
  float* nl = (float*)(p.ws + OFF_NL);
  float* mloc = (float*)(p.ws + OFF_MLOC);
  float* gsum = (float*)(p.ws + OFF_GSUM);
  __syncthreads();
  if (tid < 128) {
    const int T = T0 + tid;
    s_gi[tid] = gates[(size_t)T * 16 + dir * 8 + h] + p.b_gates[dir * 8 + h];
    s_lf[tid] = log_sigmoid(gates[(size_t)T * 16 + dir * 8 + 4 + h] + p.b_gates[dir * 8 + 4 + h]);
  }
  __syncthreads();
  float gtot = 0.f;
  if (tid < 128) {
    float pre = 0.f;
#pragma unroll 4
    for (int m = 0; m < 128; ++m) {
      const float v = s_lf[m];
      if (m < tid) pre += v;
      gtot += v;
    }
    s_a[tid] = (dir == 0) ? (gtot - pre - s_lf[tid] + s_gi[tid]) : (pre + s_gi[tid]);
  }
  __syncthreads();
  if (tid < 128) {
    float mx = -3.0e38f;
#pragma unroll 4
    for (int m = 0; m < 128; ++m) mx = fmaxf(mx, s_a[m]);
    s_w[tid] = expf(s_a[tid] - mx);
    if (tid == 0) { mloc[u] = mx; gsum[u] = gtot; }
  }
  __syncthreads();
  f32x16 acc[4];
#pragma unroll
  for (int d = 0; d < 4; ++d)
#pragma unroll
    for (int r = 0; r < 16; ++r) acc[d][r] = 0.f;
  const u16* vrow = vT + ((size_t)(bh * 128 + wave * 32 + lr)) * 4096 + j * 128 + hh * 8;
  const u16* kbase = kaT + ((size_t)(bh * 128 + lr)) * 4096 + j * 128 + hh * 8;
#pragma unroll 4
  for (int ks = 0; ks < 8; ++ks) {
    const bf16x8 av = *(const bf16x8*)(vrow + ks * 16);
    bf16x8 a;
#pragma unroll
    for (int i = 0; i < 8; ++i) a[i] = (short)f2bf(bf2f((u16)av[i]) * s_w[ks * 16 + hh * 8 + i]);
#pragma unroll
    for (int dt = 0; dt < 4; ++dt) {
      const bf16x8 bk = *(const bf16x8*)(kbase + (size_t)(dt * 32) * 4096 + ks * 16);
      acc[dt] = MFMA(a, bk, acc[dt]);
    }
  }
  float* dst = CL + (size_t)u * 16384;
#pragma unroll
  for (int dt = 0; dt < 4; ++dt)
#pragma unroll
    for (int r = 0; r < 16; ++r) dst[(wave * 32 + crow(r, hh)) * 128 + dt * 32 + lr] = acc[dt][r];
  if (tid < 128) {
    const u16* kr = kaT + ((size_t)(bh * 128 + tid)) * 4096 + j * 128;
    float s = 0.f;
#pragma unroll 2
    for (int l = 0; l < 128; l += 8) {
      const bf16x8 kv = *(const bf16x8*)(kr + l);
#pragma unroll
      for (int i = 0; i < 8; ++i) s += s_w[l + i] * bf2f((u16)kv[i]);
    }
    nl[(size_t)u * 128 + tid] = s;
  }
}

DI void scan_unit(const Params& p, int unit) {
  const int tid = opaque_tid();
  const int sc = unit >> 4, part = unit & 15, dir = sc & 1;
  float* CL = p.out;
  float* nl = (float*)(p.ws + OFF_NL);
  const float* mloc = (const float*)(p.ws + OFF_MLOC);
  const float* gsum = (const float*)(p.ws + OFF_GSUM);
  float* ms = (float*)(p.ws + OFF_MS);
  const int idx = part * 1024 + tid * 4;
  float4 C = make_float4(0.f, 0.f, 0.f, 0.f);
  float nst = 0.f, m = 0.f;
  const bool do_n = (part == 0) && (tid < 128);
  float4 pf[4];
#pragma unroll
  for (int q = 0; q < 4; ++q) {
    const int jj = dir ? 31 - q : q;
    pf[q] = *(const float4*)(CL + (size_t)(sc * 32 + jj) * 16384 + idx);
  }
#pragma unroll 1
  for (int c0 = 0; c0 < 32; c0 += 4) {
#pragma unroll
    for (int q = 0; q < 4; ++q) {
      const int c = c0 + q;
      const int jj = dir ? 31 - c : c;
      const int u = sc * 32 + jj;
      const float4 cl = pf[q];
      *(float4*)(CL + (size_t)u * 16384 + idx) = C;
      if (c + 4 < 32) {
        const int j2 = dir ? 31 - (c + 4) : (c + 4);
        pf[q] = *(const float4*)(CL + (size_t)(sc * 32 + j2) * 16384 + idx);
      }
      const float g = gsum[u], ml = mloc[u];
      const float mn = fmaxf(g + m, ml);
      const float dec = expf(g + m - mn), scl = expf(ml - mn);
      C.x = dec * C.x + scl * cl.x; C.y = dec * C.y + scl * cl.y; C.z = dec * C.z + scl * cl.z; C.w = dec * C.w + scl * cl.w;
      if (do_n) {
        const float nv = nl[(size_t)u * 128 + tid];
        nl[(size_t)u * 128 + tid] = nst;
        nst = dec * nst + scl * nv;
      }
      if (part == 0 && tid == 0) ms[u] = m;
      m = mn;
    }
  }
}

template <int DIR>
DI void mlstm_dir(const Params& p, int bh, int j, char* smem, f32x16 (&hs)[4]) {
  float* s_gi = (float*)smem;
  float* s_lf = s_gi + 128;
  float* s_bc = s_lf + 128;
  float* s_r = s_bc + 128;
  float* s_al = s_r + 128;
  float* s_fl = s_al + 128;
  float* s_is = s_fl + 128;
  const int tid = opaque_tid(), lane = tid & 63, wave = tid >> 6, lr = lane & 31, hh = lane >> 5;
  u16* Pl = (u16*)(smem + 4096) + wave * (32 * 136);
  const int h = bh & 3, b = bh >> 2;
  const int T0 = b * 4096 + j * 128;
  const float* gates = (const float*)(p.ws + OFF_GATES);
  const u16* qa = (const u16*)(p.ws + OFF_QA);
  const u16* ka = (const u16*)(p.ws + OFF_KA);
  const u16* vT = (const u16*)(p.ws + OFF_VT);
  const float* CS = p.out;
  const float* ns = (const float*)(p.ws + OFF_NL);
  const float* ms = (const float*)(p.ws + OFF_MS);
  u16* A2 = (u16*)(p.ws + OFF_A2);
  bf16x8 ones;
#pragma unroll
  for (int i = 0; i < 8; ++i) ones[i] = (short)0x3F80;
  const u16* qrow = qa + (size_t)(T0 + wave * 32 + lr) * 512 + h * 128 + hh * 8;
  const int u = (bh * 2 + DIR) * 32 + j;
  const float msu = ms[u];
  __syncthreads();
  if (tid < 128) {
    const int T = T0 + tid;
    s_gi[tid] = gates[(size_t)T * 16 + DIR * 8 + h] + p.b_gates[DIR * 8 + h];
    s_lf[tid] = log_sigmoid(gates[(size_t)T * 16 + DIR * 8 + 4 + h] + p.b_gates[DIR * 8 + 4 + h]);
  }
  __syncthreads();
  if (tid < 128) {
    float a = 0.f;
#pragma unroll 4
    for (int m = 0; m < 128; ++m) {
      const bool in = (DIR == 0) ? (m <= tid) : (m >= tid);
      a += in ? s_lf[m] : 0.f;
    }
    s_bc[tid] = a;
    s_r[tid] = s_gi[tid] - a;
  }
  __syncthreads();
  if (tid < 128) {
    float cm = -3.0e38f;
#pragma unroll 4
    for (int m = 0; m < 128; ++m) {
      const bool in = (DIR == 0) ? (m <= tid) : (m >= tid);
      cm = in ? fmaxf(cm, s_r[m]) : cm;
    }
    const float bc = s_bc[tid];
    const float mt = bc + fmaxf(msu, cm);
    s_al[tid] = bc - mt;
    s_fl[tid] = expf(-mt);
    s_is[tid] = expf(bc + msu - mt);
  }
  __syncthreads();
  char* Kt = smem + 4096;
  char* R2 = smem + 40960;
  {
#pragma unroll
    for (int bt = 0; bt < 2; ++bt) {
      uint4 kq[4];
#pragma unroll
      for (int i = 0; i < 4; ++i) {
        const int q = tid + 256 * (bt * 4 + i), row = q >> 4, ch = q & 15;
        kq[i] = *(const uint4*)(ka + (size_t)(T0 + row) * 512 + h * 128 + ch * 8);
      }
#pragma unroll
      for (int i = 0; i < 4; ++i) {
        const int q = tid + 256 * (bt * 4 + i), row = q >> 4, ch = q & 15;
        *(uint4*)(Kt + row * 256 + ((ch ^ (row & 15)) << 4)) = kq[i];
      }
    }
  }
  __syncthreads();
  {
    f32x16 S[4];
#pragma unroll
    for (int st = 0; st < 4; ++st)
#pragma unroll
      for (int r = 0; r < 16; ++r) S[st][r] = 0.f;
#pragma unroll 4
    for (int ks = 0; ks < 8; ++ks) {
      const bf16x8 a = *(const bf16x8*)(qrow + ks * 16);
#pragma unroll
      for (int st = 0; st < 4; ++st) {
        const int krow = st * 32 + lr;
        const bf16x8 bk = *(const bf16x8*)(Kt + krow * 256 + (((ks * 2 + hh) ^ (krow & 15)) << 4));
        S[st] = MFMA(a, bk, S[st]);
      }
    }
    __syncthreads();
#pragma unroll
    for (int st = 0; st < 4; ++st) {
      const int sl = st * 32 + lr;
      const float rs = s_r[sl];
#pragma unroll
      for (int r = 0; r < 16; ++r) {
        const int tl = wave * 32 + crow(r, hh);
        const bool valid = (DIR == 0) ? (sl <= tl) : (sl >= tl);
        const float pv = valid ? S[st][r] * __expf(s_al[tl] + rs) : 0.f;
        Pl[crow(r, hh) * 136 + sl] = f2bf(pv);
      }
    }
  }
#pragma unroll
  for (int eh = 0; eh < 2; ++eh) {
    f32x16 N[3];
#pragma unroll
    for (int e = 0; e < 3; ++e)
#pragma unroll
      for (int r = 0; r < 16; ++r) N[e][r] = 0.f;
    {
      uint4 vq[4];
#pragma unroll
      for (int i = 0; i < 4; ++i) {
        const int q = tid + 256 * i, row = q >> 4, ch = q & 15;
        vq[i] = *(const uint4*)(vT + ((size_t)(bh * 128 + eh * 64 + row)) * 4096 + j * 128 + ch * 8);
      }
#pragma unroll
      for (int i = 0; i < 4; ++i) {
        const int q = tid + 256 * i, row = q >> 4, ch = q & 15;
        *(uint4*)(R2 + row * 256 + ((ch ^ (row & 15)) << 4)) = vq[i];
      }
    }
    __syncthreads();
    {
#pragma unroll 4
      for (int ks = 0; ks < 8; ++ks) {
        const bf16x8 a = *(const bf16x8*)(Pl + lr * 136 + ks * 16 + hh * 8);
#pragma unroll
        for (int e2 = 0; e2 < 2; ++e2) {
          const int vrow = e2 * 32 + lr;
          const bf16x8 bv = *(const bf16x8*)(R2 + vrow * 256 + (((ks * 2 + hh) ^ (vrow & 15)) << 4));
          N[e2] = MFMA(a, bv, N[e2]);
        }
        N[2] = MFMA(a, ones, N[2]);
      }
    }
    {
      bf16x8 cq[4];
#pragma unroll
      for (int i = 0; i < 4; ++i) {
        const int q = tid + 256 * i, row = q >> 4, ch = q & 15;
        const float* src = CS + (size_t)u * 16384 + (size_t)(eh * 64 + row) * 128 + ch * 8;
        const float4 c0 = *(const float4*)(src), c1 = *(const float4*)(src + 4);
        const float cv[8] = {c0.x, c0.y, c0.z, c0.w, c1.x, c1.y, c1.z, c1.w};
        cq[i] = pack8(cv);
      }
      __syncthreads();
#pragma unroll
      for (int i = 0; i < 4; ++i) {
        const int q = tid + 256 * i, row = q >> 4, ch = q & 15;
        *(bf16x8*)(R2 + row * 256 + ((ch ^ (row & 15)) << 4)) = cq[i];
      }
    }
    __syncthreads();
    {
      const float isc = s_is[wave * 32 + lr];
      const float* nbase = ns + (size_t)u * 128 + hh * 8;
#pragma unroll 4
      for (int ks = 0; ks < 8; ++ks) {
        const bf16x8 aq = *(const bf16x8*)(qrow + ks * 16);
        const bf16x8 a = scale8(aq, isc);
#pragma unroll
        for (int e2 = 0; e2 < 2; ++e2) {
          const int crw = e2 * 32 + lr;
          const bf16x8 bc = *(const bf16x8*)(R2 + crw * 256 + (((ks * 2 + hh) ^ (crw & 15)) << 4));
          N[e2] = MFMA(a, bc, N[e2]);
        }
        const float4 n0 = *(const float4*)(nbase + ks * 16);
        const float4 n1 = *(const float4*)(nbase + ks * 16 + 4);
        const float nv[8] = {n0.x, n0.y, n0.z, n0.w, n1.x, n1.y, n1.z, n1.w};
        N[2] = MFMA(a, pack8(nv), N[2]);
      }
    }
    __syncthreads();
    u16* park = (u16*)(p.ws + OFF_HYT) + ((size_t)(bh * 32 + j) * 256 + tid) * 64 + eh * 32;
    bf16x8 pk[4];
    if (DIR == 1) {
#pragma unroll
      for (int q = 0; q < 4; ++q) pk[q] = *(const bf16x8*)(park + q * 8);
    }
#pragma unroll
    for (int r = 0; r < 16; ++r) {
      const int tl = wave * 32 + crow(r, hh);
      const float den = fmaxf(fabsf(N[2][r]), s_fl[tl]);
      const float inv = 1.f / den;
#pragma unroll
      for (int e2 = 0; e2 < 2; ++e2) {
        const float hv = N[e2][r] * inv;
        const int v = e2 * 16 + r;
        if (DIR == 0) pk[v >> 3][v & 7] = (short)f2bf(hv);
        else hs[eh * 2 + e2][r] = hv + bf2f((u16)pk[v >> 3][v & 7]);
      }
    }
    if (DIR == 0) {
#pragma unroll
      for (int q = 0; q < 4; ++q) *(bf16x8*)(park + q * 8) = pk[q];
    }
  }
}

DI void mlstm_out_unit(const Params& p, int unit, char* smem) {
  const int tid = opaque_tid(), lane = tid & 63, wave = tid >> 6, lr = lane & 31, hh = lane >> 5;
  const int j = unit & 31, bh = unit >> 5, h = bh & 3, b = bh >> 2;
  const int T0 = b * 4096 + j * 128;
  const u16* og = (const u16*)(p.ws + OFF_OG);
  u16* A2 = (u16*)(p.ws + OFF_A2);
  f32x16 hs[4];
  mlstm_dir<0>(p, bh, j, smem, hs);
  mlstm_dir<1>(p, bh, j, smem, hs);
  __syncthreads();
  float* wl = (float*)(smem + wave * 16384);
#pragma unroll
  for (int et = 0; et < 4; ++et)
#pragma unroll
    for (int r = 0; r < 16; ++r) wl[crow(r, hh) * 128 + et * 32 + lr] = hs[et][r];
  wave_lds_sync();
  {
    const int row = lane >> 1, half = lane & 1;
    const size_t T = (size_t)(T0 + wave * 32 + row);
    const u16* ogp = og + T * 512 + h * 128 + half * 64;
    const float* src = wl + row * 128 + half * 64;
    float g[64];
    float ss = 0.f;
#pragma unroll
    for (int q = 0; q < 8; ++q) {
      const bf16x8 o8 = *(const bf16x8*)(ogp + q * 8);
      const float4 h0 = *(const float4*)(src + q * 8), h1 = *(const float4*)(src + q * 8 + 4);
      g[q * 8 + 0] = h0.x * bf2f((u16)o8[0]); g[q * 8 + 1] = h0.y * bf2f((u16)o8[1]); g[q * 8 + 2] = h0.z * bf2f((u16)o8[2]); g[q * 8 + 3] = h0.w * bf2f((u16)o8[3]);
      g[q * 8 + 4] = h1.x * bf2f((u16)o8[4]); g[q * 8 + 5] = h1.y * bf2f((u16)o8[5]); g[q * 8 + 6] = h1.z * bf2f((u16)o8[6]); g[q * 8 + 7] = h1.w * bf2f((u16)o8[7]);
#pragma unroll
      for (int i = 0; i < 8; ++i) ss += g[q * 8 + i] * g[q * 8 + i];
    }
    ss += __shfl_xor(ss, 1, 64);
    const float rs = rsqrtf(ss * (1.f / 128.f) + EPS);
    const float* mw = p.mlstm_norm_w + h * 128 + half * 64;
    u16* dst = A2 + T * 1024 + h * 128 + half * 64;
#pragma unroll
    for (int q = 0; q < 8; ++q) {
      const float4 w0 = *(const float4*)(mw + q * 8), w1 = *(const float4*)(mw + q * 8 + 4);
      float o[8];
      o[0] = g[q * 8 + 0] * rs * w0.x; o[1] = g[q * 8 + 1] * rs * w0.y; o[2] = g[q * 8 + 2] * rs * w0.z; o[3] = g[q * 8 + 3] * rs * w0.w;
      o[4] = g[q * 8 + 4] * rs * w1.x; o[5] = g[q * 8 + 5] * rs * w1.y; o[6] = g[q * 8 + 6] * rs * w1.z; o[7] = g[q * 8 + 7] * rs * w1.w;
      *(bf16x8*)(dst + q * 8) = pack8(o);
    }
  }
}

DI void hyena_norm_unit(const Params& p, int unit, char* smem) {
  float* tile = (float*)smem;
  const int tid = opaque_tid();
  const int tt = unit & 63, g = (unit >> 6) & 7, b = unit >> 9;
  const float* z2T = (const float*)(p.ws + OFF_Z2T);
  u16* A2 = (u16*)(p.ws + OFF_A2);
  __syncthreads();
#pragma unroll 4
  for (int i = 0; i < 16; ++i) {
    const int cl = (tid >> 6) + 4 * i, tl = tid & 63;
    tile[cl * 65 + tl] = z2T[((size_t)(b * 512 + g * 64 + cl)) * 4096 + tt * 64 + tl];
  }
  __syncthreads();
  const int tl = tid >> 2, qd = tid & 3;
  float v[16];
  float ss = 0.f;
#pragma unroll
  for (int i = 0; i < 16; ++i) {
    v[i] = tile[(qd * 16 + i) * 65 + tl];
    ss += v[i] * v[i];
  }
  ss += __shfl_xor(ss, 1, 64);
  ss += __shfl_xor(ss, 2, 64);
  const float rs = rsqrtf(ss * (1.f / 64.f) + EPS);
  const size_t T = (size_t)b * 4096 + tt * 64 + tl;
  u16* dst = A2 + T * 1024 + 512 + g * 64 + qd * 16;
  const float* w = p.hyena_norm_w + g * 64 + qd * 16;
  float o[16];
#pragma unroll
  for (int i = 0; i < 16; ++i) o[i] = v[i] * rs * w[i];
  *(bf16x8*)(dst) = pack8(o);
  *(bf16x8*)(dst + 8) = pack8(o + 8);
}

template <int EPI>
DI void gemm_phase(const u16* A, const u16* Bt, int K, int ntn, void* outp, char* smem) {
  const int tid = threadIdx.x, lane = tid & 63, wave = tid >> 6, wr = wave >> 1, wc = wave & 1, lr = lane & 31, hh = lane >> 5;
  const int ntiles = tile_count(ntn);
  for (int id = blockIdx.x; id < ntiles; id += gridDim.x) {
    int mt, nt;
    tile_map(id, ntn, mt, nt);
    if (nt >= ntn) continue;
    const int m0 = mt * 256, n0 = nt * 128;
    f32x16 acc[4][2];
    gemm_core<false>(A, Bt, K, m0, n0, smem, acc);
    if (EPI == 0) {
#pragma unroll
      for (int i = 0; i < 4; ++i)
#pragma unroll
        for (int j = 0; j < 2; ++j)
#pragma unroll
          for (int r = 0; r < 16; ++r) {
            const int row = m0 + wr * 128 + i * 32 + crow(r, hh);
            const int col = n0 + wc * 64 + j * 32 + lr;
            ((float*)outp)[(size_t)row * 1024 + col] = acc[i][j][r];
          }
    } else {
      char* wl = smem + wave * 16384;
      stage_tile_ns<2>(acc, wl, lr, hh);
      wave_lds_sync();
      flush_tile_ns(wl, (u16*)outp + (size_t)(m0 + wr * 128) * 4096 + n0 + wc * 64, 4096, lane);
    }
  }
}

DI void phase_post_mix(const Params& p) {
  const int tid = threadIdx.x, lane = tid & 63, wave = tid >> 6;
  const float* mix = p.out;
  float* x1 = (float*)(p.ws + OFF_X1);
  u16* hm = (u16*)(p.ws + OFF_HM);
  for (int u = blockIdx.x; u < 1024; u += gridDim.x) {
#pragma unroll 2
    for (int rr = 0; rr < 4; ++rr) {
      const size_t row = (size_t)u * 16 + wave * 4 + rr;
      float4 mv[4], xv[4];
      float ss = 0.f;
#pragma unroll
      for (int i = 0; i < 4; ++i) {
        mv[i] = ((const float4*)(mix + row * DM))[lane + 64 * i];
        xv[i] = ((const float4*)(p.x + row * DM))[lane + 64 * i];
        ss += mv[i].x * mv[i].x + mv[i].y * mv[i].y + mv[i].z * mv[i].z + mv[i].w * mv[i].w;
      }
      ss = wave_sum(ss);
      const float rs = rsqrtf(ss * (1.f / DM) + EPS);
      float s2 = 0.f;
#pragma unroll
      for (int i = 0; i < 4; ++i) {
        const float4 w = ((const float4*)p.norm_mix_post)[lane + 64 * i];
        xv[i].x += mv[i].x * rs * w.x; xv[i].y += mv[i].y * rs * w.y; xv[i].z += mv[i].z * rs * w.z; xv[i].w += mv[i].w * rs * w.w;
        s2 += xv[i].x * xv[i].x + xv[i].y * xv[i].y + xv[i].z * xv[i].z + xv[i].w * xv[i].w;
        ((float4*)(x1 + row * DM))[lane + 64 * i] = xv[i];
      }
      s2 = wave_sum(s2);
      const float r2 = rsqrtf(s2 * (1.f / DM) + EPS);
#pragma unroll
      for (int i = 0; i < 4; ++i) {
        const float4 w = ((const float4*)p.norm_mlp_pre)[lane + 64 * i];
        ushort4 o;
        o.x = f2bf(xv[i].x * r2 * w.x); o.y = f2bf(xv[i].y * r2 * w.y); o.z = f2bf(xv[i].z * r2 * w.z); o.w = f2bf(xv[i].w * r2 * w.w);
        *(ushort4*)(hm + row * DM + (lane + 64 * i) * 4) = o;
      }
    }
  }
}

DI void phase_final(const Params& p) {
  const int tid = threadIdx.x, lane = tid & 63, wave = tid >> 6;
  const float* x1 = (const float*)(p.ws + OFF_X1);
  for (int u = blockIdx.x; u < 1024; u += gridDim.x) {
#pragma unroll 2
    for (int rr = 0; rr < 4; ++rr) {
      const size_t row = (size_t)u * 16 + wave * 4 + rr;
      float4 fv[4];
      float ss = 0.f;
#pragma unroll
      for (int i = 0; i < 4; ++i) {
        fv[i] = ((const float4*)(p.out + row * DM))[lane + 64 * i];
        ss += fv[i].x * fv[i].x + fv[i].y * fv[i].y + fv[i].z * fv[i].z + fv[i].w * fv[i].w;
      }
      ss = wave_sum(ss);
      const float rs = rsqrtf(ss * (1.f / DM) + EPS);
#pragma unroll
      for (int i = 0; i < 4; ++i) {
        const float4 w = ((const float4*)p.norm_mlp_post)[lane + 64 * i];
        const float4 xv = ((const float4*)(x1 + row * DM))[lane + 64 * i];
        float4 o;
        o.x = xv.x + fv[i].x * rs * w.x; o.y = xv.y + fv[i].y * rs * w.y; o.z = xv.z + fv[i].z * rs * w.z; o.w = xv.w + fv[i].w * rs * w.w;
        ((float4*)(p.out + row * DM))[lane + 64 * i] = o;
      }
    }
  }
}

DI void run_phase(const Params& p, int ph, char* smem) {
  switch (ph) {
    case 0: phase0(p, smem); break;
    case 1: phase1(p, smem); break;
    case 2: phase_qk(p, smem); break;
    case 3:
#ifdef DBL_HYONLY
      for (int u = blockIdx.x; u < 512; u += gridDim.x) hyena_unit(p, u, smem);
#endif
#ifdef DBL_MLONLY
      for (int u = blockIdx.x; u < 1024; u += gridDim.x) mlstm_local_unit(p, u, smem);
#endif
      for (int u = blockIdx.x; u < 512 + 1024; u += gridDim.x) {
        if (u < 512) hyena_unit(p, u, smem);
        else mlstm_local_unit(p, u - 512, smem);
      }
      break;
    case 4:
      for (int u = blockIdx.x; u < 512; u += gridDim.x) scan_unit(p, u);
      break;
    case 5:
      for (int u = blockIdx.x; u < 512 + 2048; u += gridDim.x) {
#ifndef DBG_SKIP_MLSTM
        if (u < 512) mlstm_out_unit(p, u, smem);
#else
        if (u < 512) { u16* A2 = (u16*)(p.ws + OFF_A2); const int T0 = (u >> 5 >> 2) * 4096 + (u & 31) * 128, hq = (u >> 5) & 3;
          for (int i = threadIdx.x; i < 128 * 128; i += 256) A2[(size_t)(T0 + (i >> 7)) * 1024 + hq * 128 + (i & 127)] = 0; }
#endif
#ifndef DBG_SKIP_HYENA
        else hyena_norm_unit(p, u - 512, smem);
#else
        else { const int un = u - 512; const int tt = un & 63, g = (un >> 6) & 7, b = un >> 9; u16* A2 = (u16*)(p.ws + OFF_A2);
          for (int i = threadIdx.x; i < 64 * 64; i += 256) A2[((size_t)b * 4096 + tt * 64 + (i >> 6)) * 1024 + 512 + g * 64 + (i & 63)] = 0x3F80; }
#endif
      }
      break;
    case 6: gemm_phase<0>((const u16*)(p.ws + OFF_A2), (const u16*)(p.ws + OFF_WOUTT), 1024, 8, p.out, smem); break;
    case 7: phase_post_mix(p); break;
    case 8: gemm_phase<1>((const u16*)(p.ws + OFF_HM), (const u16*)(p.ws + OFF_W1T), 1024, 32, p.ws + OFF_H, smem); break;
    case 9: gemm_phase<0>((const u16*)(p.ws + OFF_H), (const u16*)(p.ws + OFF_W2T), 4096, 8, p.out, smem); break;
    case 10: phase_final(p); break;
  }
}
constexpr int NPHASE = 11;

#define XB_XCNT(j)  (256  + 64 * (j))
#define XB_XSUB(j)  (1280 + 64 * (j))
#define XB_XGEN(j)  (2304 + 64 * (j))
#define XB_TOP      3328
#define XB_TOPGEN   3392
#define XCD_BAR_WORDS 3456
DI unsigned xb_ld(unsigned* p) { return __hip_atomic_load(p, __ATOMIC_RELAXED, __HIP_MEMORY_SCOPE_AGENT); }
DI unsigned xb_add(unsigned* p, unsigned v) { return __hip_atomic_fetch_add(p, v, __ATOMIC_RELAXED, __HIP_MEMORY_SCOPE_AGENT); }
DI unsigned xb_xcc_id() { return (unsigned)__builtin_amdgcn_s_getreg((3 << 11) | 20) & 0xFu; }
struct XcdBar { unsigned* bar; unsigned x, nloc, nx; };
DI void xcd_barrier(XcdBar& b) {
  asm volatile("s_waitcnt vmcnt(0)" ::: "memory");
  __syncthreads();
  if (threadIdx.x == 0) {
    unsigned* bar = b.bar;
    __builtin_amdgcn_s_waitcnt(0);
    if (b.nloc == 0u) {
      const unsigned G = gridDim.x;
      unsigned sum, cnt, mine;
      for (;;) {
        sum = 0u; cnt = 0u; mine = 0u;
#pragma unroll
        for (unsigned j = 0; j < 16; ++j) { const unsigned c = xb_ld(&bar[XB_XCNT(j)]); sum += c; cnt += (c > 0u) ? 1u : 0u; mine = (j == b.x) ? c : mine; }
        if (sum == G) break;
        __builtin_amdgcn_s_sleep(1);
      }
      b.nloc = mine > 0u ? mine : 1u; b.nx = cnt > 0u ? cnt : 1u;
    }
    const unsigned nloc = b.nloc, nx = b.nx;
    const unsigned old = xb_add(&bar[XB_XSUB(b.x)], 1u);
    const unsigned gen = old / nloc;
    if (old + 1u == (gen + 1u) * nloc) {
      __builtin_amdgcn_fence(__ATOMIC_RELEASE, "agent");
      asm volatile("s_waitcnt vmcnt(0)" ::: "memory");
      const unsigned og = xb_add(&bar[XB_TOP], 1u);
      const unsigned tg = og / nx;
      if (og + 1u == (tg + 1u) * nx) xb_add(&bar[XB_TOPGEN], 1u);
      else while (xb_ld(&bar[XB_TOPGEN]) == tg) __builtin_amdgcn_s_sleep(1);
      __builtin_amdgcn_fence(__ATOMIC_ACQUIRE, "agent");
      xb_add(&bar[XB_XGEN(b.x)], 1u);
      asm volatile("s_waitcnt vmcnt(0)" ::: "memory");
    } else {
      while (xb_ld(&bar[XB_XGEN(b.x)]) == gen) __builtin_amdgcn_s_sleep(1);
      __builtin_amdgcn_fence(__ATOMIC_ACQUIRE, "agent");
      asm volatile("s_waitcnt vmcnt(0)" ::: "memory");
    }
  }
  __syncthreads();
}

#if MULTI_LAUNCH
template <int PH>
__global__ void __launch_bounds__(256, 2) phase_kernel(Params p) {
  __shared__ __attribute__((aligned(16))) char smem[65536];
  run_phase(p, PH, smem);
}
template <int PH>
static void launch_phase(const Params& p, hipStream_t stream) {
  hipLaunchKernelGGL(phase_kernel<PH>, dim3(512), dim3(256), 0, stream, p);
}
#else
__global__ void __launch_bounds__(256, 2) mega_kernel(Params p) {
  __shared__ __attribute__((aligned(16))) char smem[65536];
  cg::grid_group grid = cg::this_grid();
  XcdBar xb;
  xb.bar = (unsigned*)(p.ws + OFF_BAR); xb.x = xb_xcc_id(); xb.nloc = 0u; xb.nx = 0u;
  if (p.ws == nullptr) grid.sync();
  if (threadIdx.x == 0) (void)xb_add(&xb.bar[XB_XCNT(xb.x)], 1u);
#define GSYNC xcd_barrier(xb)
#ifdef DBL_P0
  run_phase(p, 0, smem);
#endif
  run_phase(p, 0, smem); GSYNC;
  run_phase(p, 1, smem); GSYNC;
#ifdef DBL_GEMM
  run_phase(p, 1, smem); grid.sync();
#endif
  run_phase(p, 2, smem); GSYNC;
#ifdef DBL_P2
  run_phase(p, 2, smem); GSYNC;
#endif
  run_phase(p, 3, smem); GSYNC;
#ifdef DBL_HY
  run_phase(p, 3, smem); GSYNC;
#endif
  run_phase(p, 4, smem); GSYNC;
  run_phase(p, 5, smem); GSYNC;
#ifdef DBL_P5
  run_phase(p, 5, smem); GSYNC;
#endif
  run_phase(p, 6, smem); GSYNC;
#ifdef DBL_GEMM
  run_phase(p, 6, smem); GSYNC;
#endif
  run_phase(p, 7, smem); GSYNC;
#ifdef DBL_P7
  run_phase(p, 7, smem); GSYNC;
#endif
  run_phase(p, 8, smem); GSYNC;
#ifdef DBL_GEMM
  run_phase(p, 8, smem); GSYNC;
#endif
  run_phase(p, 9, smem); GSYNC;
#ifdef DBL_GEMM
  run_phase(p, 9, smem); GSYNC;
#endif
#ifdef XSYNC
  for (int q = 0; q < 10; ++q) GSYNC;
#endif
  run_phase(p, 10, smem);
}
#endif

extern "C" void kernel_launch(void* const* d_in, const int* in_sizes, int n_in, void* d_out, int out_size, void* d_ws,
                              size_t ws_size, hipStream_t stream) {
  Params p{};
  const float** pp = (const float**)&p;
  for (int i = 0; i < 23; ++i) pp[i] = (const float*)d_in[i];
  p.out = (float*)d_out;
  p.ws = (char*)d_ws;
#if MULTI_LAUNCH
  launch_phase<0>(p, stream);
#ifdef DBL_P0
  launch_phase<0>(p, stream);
#endif
 launch_phase<1>(p, stream); launch_phase<2>(p, stream); launch_phase<3>(p, stream);
#ifdef DBL_HY
  launch_phase<3>(p, stream);
#endif

  launch_phase<4>(p, stream); launch_phase<5>(p, stream);
#ifdef DBL_P5
  launch_phase<5>(p, stream);
#endif
 launch_phase<6>(p, stream); launch_phase<7>(p, stream);
  launch_phase<8>(p, stream); launch_phase<9>(p, stream); launch_phase<10>(p, stream);
#else
  static int grid_blocks = 0;
  if (!grid_blocks) {
    int dev = 0, cus = 0, per_cu = 0;
    hipGetDevice(&dev);
    hipDeviceGetAttribute(&cus, hipDeviceAttributeMultiprocessorCount, dev);
    hipOccupancyMaxActiveBlocksPerMultiprocessor(&per_cu, mega_kernel, 256, 0);
    if (per_cu > 2) per_cu = 2;
    if (per_cu < 1) per_cu = 1;
#ifdef FORCE2
    per_cu = 2;
#endif
    grid_blocks = cus * per_cu;
  }
  hipMemsetAsync((char*)d_ws + OFF_BAR, 0, XCD_BAR_WORDS * 4, stream);
  void* args[] = {&p};
  hipError_t e = hipLaunchCooperativeKernel((void*)mega_kernel, dim3(grid_blocks), dim3(256), args, 0, stream);
  if (e != hipSuccess) fprintf(stderr, "cooperative launch failed: %s (grid %d)\n", hipGetErrorString(e), grid_blocks);
#endif
}
#if defined(__HIP_DEVICE_COMPILE__)
#pragma clang attribute pop
#endif
```

```cpp
#if defined(__HIP_DEVICE_COMPILE__)
#pragma clang attribute push(__attribute__((target("no-packed-fp32-ops"))), apply_to = function)
#endif
#include <hip/hip_runtime.h>
#include <hip/hip_cooperative_groups.h>
#include <cstdio>
namespace cg = cooperative_groups;

#ifndef MULTI_LAUNCH
#define MULTI_LAUNCH 0
#endif

typedef unsigned short u16;
using bf16x8 = __attribute__((ext_vector_type(8))) short;
using f32x16 = __attribute__((ext_vector_type(16))) float;
#define DI __device__ __forceinline__
#define MFMA(a, b, c) __builtin_amdgcn_mfma_f32_32x32x16_bf16((a), (b), (c), 0, 0, 0)

constexpr int SEQ = 4096, DM = 1024, NTOK = 16384, NIN = 3600, NINP = 3712, DFF = 4096;
constexpr float EPS = 1e-6f;
constexpr size_t MiB = 1u << 20;
constexpr size_t OFF_WINT = 0, OFF_WOUTT = 8 * MiB, OFF_W1T = 10 * MiB, OFF_W2T = 18 * MiB;
constexpr size_t OFF_XN = 26 * MiB, OFF_QA = 26 * MiB, OFF_KA = 42 * MiB;
constexpr size_t OFF_FILT = 58 * MiB, OFF_QKPRE = 90 * MiB, OFF_A2 = 90 * MiB;
constexpr size_t OFF_HYT = 122 * MiB, OFF_VT = 170 * MiB, OFF_OG = 186 * MiB, OFF_GATES = 202 * MiB;
constexpr size_t OFF_NL = 203 * MiB, OFF_MLOC = 203 * MiB + 512 * 1024, OFF_GSUM = OFF_MLOC + 4096, OFF_MS = OFF_GSUM + 4096;
constexpr size_t OFF_KAT = 205 * MiB, OFF_Z2T = 221 * MiB;
constexpr size_t OFF_TW = 204 * MiB, OFF_BAR = 254 * MiB;
constexpr size_t OFF_X1 = 26 * MiB, OFF_HM = 90 * MiB, OFF_H = 122 * MiB;

struct Params {
  const float *x, *norm_mix_pre, *norm_mix_post, *norm_mlp_pre, *norm_mlp_post, *w_in, *b_gates, *conv_w, *conv_b,
      *mlstm_norm_w, *hyena_norm_w, *filt_w1, *filt_b1, *filt_w2, *filt_b2, *filt_w3, *filt_b3, *filt_w4, *filt_freq,
      *filt_bias, *w_out, *w_mlp_in, *w_mlp_out;
  float* out;
  char* ws;
};

DI u16 f2bf(float x) { const __bf16 b = (__bf16)x; return __builtin_bit_cast(u16, b); }
DI float bf2f(u16 v) { return __uint_as_float(((unsigned)v) << 16); }
DI int opaque_tid() { int t = threadIdx.x; asm volatile("" : "+v"(t)); return t; }
DI int crow(int r, int hh) { return (r & 3) + 8 * (r >> 2) + 4 * hh; }
DI float log_sigmoid(float x) { return fminf(x, 0.f) - log1pf(expf(-fabsf(x))); }
DI float sigmoidf(float x) { return 1.f / (1.f + expf(-x)); }
DI float red2pi(float x) {
  const float k = rintf(x * 0.15915494309189535f);
  float r = fmaf(-k, 6.28125f, x);
  return fmaf(-k, 1.9353071795864769e-3f, r);
}
DI float fsin(float x) { return sinf(x); }
DI float fcos(float x) { return cosf(x); }
DI bf16x8 pack8(const float* v) {
  bf16x8 r;
#pragma unroll
  for (int i = 0; i < 8; ++i) r[i] = (short)f2bf(v[i]);
  return r;
}
DI bf16x8 scale8(bf16x8 a, float s) {
  bf16x8 r;
#pragma unroll
  for (int i = 0; i < 8; ++i) r[i] = (short)f2bf(bf2f((u16)a[i]) * s);
  return r;
}

template <bool SWAP>
DI void gemm_core(const u16* __restrict__ A, const u16* __restrict__ Bt, int K, int m0, int n0, char* smem, f32x16 (&acc)[4][2]) {
  const int tid = opaque_tid(), lane = tid & 63, wave = tid >> 6, wr = wave >> 1, wc = wave & 1;
  const int lr = lane & 31, hh = lane >> 5;
#pragma unroll
  for (int i = 0; i < 4; ++i)
#pragma unroll
    for (int j = 0; j < 2; ++j)
#pragma unroll
      for (int r = 0; r < 16; ++r) acc[i][j][r] = 0.f;
  const int c = tid & 7, r0 = tid >> 3;
  const u16* Ag = A + (size_t)(m0 + r0) * K + c * 8;
  const u16* Bg = Bt + (size_t)(n0 + r0) * K + c * 8;
  const int soff = r0 * 128 + ((c ^ ((r0 >> 1) & 7)) << 4);
  char* As = smem;
  char* Bs = smem + 32768;
  uint4 ra0, ra1, ra2, ra3, ra4, ra5, ra6, ra7, rb0, rb1, rb2, rb3;
#define GLOAD_ALL(k0)                                                                                             \
  ra0 = *(const uint4*)(Ag + (size_t)(0) * K + (k0));   ra1 = *(const uint4*)(Ag + (size_t)(32) * K + (k0));      \
  ra2 = *(const uint4*)(Ag + (size_t)(64) * K + (k0));  ra3 = *(const uint4*)(Ag + (size_t)(96) * K + (k0));      \
  ra4 = *(const uint4*)(Ag + (size_t)(128) * K + (k0)); ra5 = *(const uint4*)(Ag + (size_t)(160) * K + (k0));     \
  ra6 = *(const uint4*)(Ag + (size_t)(192) * K + (k0)); ra7 = *(const uint4*)(Ag + (size_t)(224) * K + (k0));     \
  rb0 = *(const uint4*)(Bg + (size_t)(0) * K + (k0));   rb1 = *(const uint4*)(Bg + (size_t)(32) * K + (k0));      \
  rb2 = *(const uint4*)(Bg + (size_t)(64) * K + (k0));  rb3 = *(const uint4*)(Bg + (size_t)(96) * K + (k0));
  GLOAD_ALL(0)
  const int nk = K >> 6;
#pragma unroll 1
  for (int kt = 0; kt < nk; ++kt) {
    __syncthreads();
    *(uint4*)(As + soff + 0 * 4096) = ra0; *(uint4*)(As + soff + 1 * 4096) = ra1; *(uint4*)(As + soff + 2 * 4096) = ra2; *(uint4*)(As + soff + 3 * 4096) = ra3;
    *(uint4*)(As + soff + 4 * 4096) = ra4; *(uint4*)(As + soff + 5 * 4096) = ra5; *(uint4*)(As + soff + 6 * 4096) = ra6; *(uint4*)(As + soff + 7 * 4096) = ra7;
    *(uint4*)(Bs + soff + 0 * 4096) = rb0; *(uint4*)(Bs + soff + 1 * 4096) = rb1; *(uint4*)(Bs + soff + 2 * 4096) = rb2; *(uint4*)(Bs + soff + 3 * 4096) = rb3;
    __syncthreads();
    if (kt + 1 < nk) {
      const int k0 = (kt + 1) << 6;
      GLOAD_ALL(k0)
    }
#pragma unroll
    for (int kk = 0; kk < 4; ++kk) {
      bf16x8 a[4], b[2];
      const int cc = kk * 2 + hh;
#pragma unroll
      for (int i = 0; i < 4; ++i) {
        const int r = wr * 128 + i * 32 + lr;
        a[i] = *(const bf16x8*)(As + r * 128 + ((cc ^ ((r >> 1) & 7)) << 4));
      }
#pragma unroll
      for (int j = 0; j < 2; ++j) {
        const int r = wc * 64 + j * 32 + lr;
        b[j] = *(const bf16x8*)(Bs + r * 128 + ((cc ^ ((r >> 1) & 7)) << 4));
      }
#pragma unroll
      for (int i = 0; i < 4; ++i)
#pragma unroll
        for (int j = 0; j < 2; ++j) acc[i][j] = SWAP ? MFMA(b[j], a[i], acc[i][j]) : MFMA(a[i], b[j], acc[i][j]);
    }
  }
  __syncthreads();
}

DI void tile_map(int id, int ntn, int& mt, int& nt) {
  const int r = id >> 9, b = id & 511;
  const int x = b & 7, sidx = b >> 3;
  const int P = r * 8 + x;
  mt = (P & 7) * 8 + (sidx & 7);
  nt = (P >> 3) * 8 + (sidx >> 3);
}
DI int tile_count(int ntn) { return ((ntn + 7) >> 3) * 512; }

DI void transpose_tile(const float* __restrict__ src, int R, int C, u16* __restrict__ dst, int kt, int nt, char* smem) {
  float* tile = (float*)smem;
  const int tid = threadIdx.x;
  const int k0 = kt * 64, n0 = nt * 64;
#pragma unroll 4
  for (int it = 0; it < 16; ++it) {
    const int kk = it * 4 + (tid >> 6), nn = tid & 63;
    const int n = n0 + nn;
    tile[kk * 65 + nn] = (n < C) ? src[(size_t)(k0 + kk) * C + n] : 0.f;
  }
  __syncthreads();
#pragma unroll
  for (int it = 0; it < 2; ++it) {
    const int q = tid + 256 * it, nn = q >> 3, kc = q & 7;
    float o[8];
#pragma unroll
    for (int i = 0; i < 8; ++i) o[i] = tile[(kc * 8 + i) * 65 + nn];
    *(bf16x8*)(dst + (size_t)(n0 + nn) * R + k0 + kc * 8) = pack8(o);
  }
  __syncthreads();
}

DI float wave_sum(float v) {
#pragma unroll
  for (int o = 32; o; o >>= 1) v += __shfl_xor(v, o, 64);
  return v;
}

DI void filter_unit(const Params& p, int unit, char* smem) {
  float* sz = (float*)smem;
  float* hA = sz + 8 * 33 + 8;
  float* hB = hA + 8 * 64;
  float* hT = hB + 8 * 64;
  const int tid = opaque_tid();
  const int l0 = unit * 8;
  for (int idx = tid; idx < 8 * 33; idx += 256) {
    const int pp = idx / 33, f = idx - pp * 33;
    const float l = (float)(l0 + pp);
    float v;
    if (f == 0) v = l / 4095.f;
    else {
      const int jb = (f - 1) & 15;
      const float fj = 1e-4f + (float)jb * ((15.f - 1e-4f) / 15.f);
      const float ang = 6.283185307179586f * l / 4096.f;
      v = (f <= 16) ? fcos(fj * ang) : -fsin(fj * ang);
    }
    sz[idx] = v;
  }
  const int o = tid & 63, pq = tid >> 6;
  {
    const float bb = p.filt_b1[o], fr = p.filt_freq[o];
    __syncthreads();
    float s0 = bb, s1 = bb;
#pragma unroll 1
    for (int f0 = 0; f0 < 33; f0 += 11) {
      float wc[11];
#pragma unroll
      for (int f = 0; f < 11; ++f) wc[f] = p.filt_w1[(f0 + f) * 64 + o];
#pragma unroll
      for (int f = 0; f < 11; ++f) { s0 += sz[pq * 33 + f0 + f] * wc[f]; s1 += sz[(pq + 4) * 33 + f0 + f] * wc[f]; }
    }
    hA[pq * 64 + o] = fsin(fr * s0);
    hA[(pq + 4) * 64 + o] = fsin(fr * s1);
  }
  {
    const float bb = p.filt_b2[o], fr = p.filt_freq[64 + o];
    __syncthreads();
    float s0 = bb, s1 = bb;
#pragma unroll 1
    for (int k0 = 0; k0 < 64; k0 += 16) {
      float wc[16];
#pragma unroll
      for (int k = 0; k < 16; ++k) wc[k] = p.filt_w2[(k0 + k) * 64 + o];
#pragma unroll
      for (int k = 0; k < 16; ++k) { s0 += hA[pq * 64 + k0 + k] * wc[k]; s1 += hA[(pq + 4) * 64 + k0 + k] * wc[k]; }
    }
    hB[pq * 64 + o] = fsin(fr * s0);
    hB[(pq + 4) * 64 + o] = fsin(fr * s1);
  }
  {
    const float bb = p.filt_b3[o], fr = p.filt_freq[128 + o];
    __syncthreads();
    float s0 = bb, s1 = bb;
#pragma unroll 1
    for (int k0 = 0; k0 < 64; k0 += 16) {
      float wc[16];
#pragma unroll
      for (int k = 0; k < 16; ++k) wc[k] = p.filt_w3[(k0 + k) * 64 + o];
#pragma unroll
      for (int k = 0; k < 16; ++k) { s0 += hB[pq * 64 + k0 + k] * wc[k]; s1 += hB[(pq + 4) * 64 + k0 + k] * wc[k]; }
    }
    hT[o * 8 + pq] = fsin(fr * s0);
    hT[o * 8 + pq + 4] = fsin(fr * s1);
  }
  __syncthreads();
  float* filt = (float*)(p.ws + OFF_FILT);
  const float min_decay = -3.0701134573253944f, max_decay = -15.350567286626973f;
#pragma unroll 1
  for (int cc = 0; cc < 8; ++cc) {
    const int col = tid + 256 * cc;
    float acc[8];
#pragma unroll
    for (int q = 0; q < 8; ++q) acc[q] = 0.f;
#pragma unroll 1
    for (int k0 = 0; k0 < 64; k0 += 16) {
      float wc[16];
#pragma unroll
      for (int k = 0; k < 16; ++k) wc[k] = p.filt_w4[(k0 + k) * 2048 + col];
#pragma unroll
      for (int k = 0; k < 16; ++k) {
        const float4 h0 = *(const float4*)(hT + (k0 + k) * 8);
        const float4 h1 = *(const float4*)(hT + (k0 + k) * 8 + 4);
        acc[0] += h0.x * wc[k]; acc[1] += h0.y * wc[k]; acc[2] += h0.z * wc[k]; acc[3] += h0.w * wc[k];
        acc[4] += h1.x * wc[k]; acc[5] += h1.y * wc[k]; acc[6] += h1.z * wc[k]; acc[7] += h1.w * wc[k];
      }
    }
    const int ch = col & 511;
    const float delta = fabsf(min_decay + (float)ch * ((max_decay - min_decay) / 511.f));
#pragma unroll
    for (int q = 0; q < 8; ++q) {
      const float t = (float)(l0 + q) / 4095.f;
      acc[q] *= expf(-t * delta);
    }
    float4* dst = (float4*)(filt + (size_t)col * 4096 + l0);
    dst[0] = make_float4(acc[0], acc[1], acc[2], acc[3]);
    dst[1] = make_float4(acc[4], acc[5], acc[6], acc[7]);
  }
  __syncthreads();
}

DI void phase0(const Params& p, char* smem) {
  const int tid = threadIdx.x, lane = tid & 63, wave = tid >> 6;
  const int U_W = 32, U_F = 512, U_X = 1024, U_T1 = 58 * 16, U_T2 = 256, U_T3 = 1024, U_T4 = 1024;
  const int total = U_W + U_F + U_X + U_T1 + U_T2 + U_T3 + U_T4;
  for (int u = blockIdx.x; u < total; u += gridDim.x) {
    int v = u;
    if (v < U_W) {
      const int idx = v * 256 + tid;
      if (idx < 8191) {
        const int lh = 31 - __clz(idx + 1);
        const int h = 1 << lh, jj = idx + 1 - h;
        float2* twp = (float2*)(p.ws + OFF_TW);
        const float ang = -3.14159265358979f * (float)jj / (float)h;
        twp[idx] = make_float2(cosf(ang), sinf(ang));
      }
      continue;
    }
    v -= U_W;
    if (v < U_F) { filter_unit(p, v, smem); continue; }
    v -= U_F;
    if (v < U_X) {
      u16* xn = (u16*)(p.ws + OFF_XN);
#pragma unroll 4
      for (int rr = 0; rr < 4; ++rr) {
        const int row = v * 16 + wave * 4 + rr;
        const float4* xr = (const float4*)(p.x + (size_t)row * DM);
        float4 xv[4];
        float ss = 0.f;
#pragma unroll
        for (int i = 0; i < 4; ++i) {
          xv[i] = xr[lane + 64 * i];
          ss += xv[i].x * xv[i].x + xv[i].y * xv[i].y + xv[i].z * xv[i].z + xv[i].w * xv[i].w;
        }
        ss = wave_sum(ss);
        const float rs = rsqrtf(ss * (1.f / DM) + EPS);
#pragma unroll
        for (int i = 0; i < 4; ++i) {
          const float4 w = ((const float4*)p.norm_mix_pre)[lane + 64 * i];
          ushort4 o;
          o.x = f2bf(xv[i].x * rs * w.x); o.y = f2bf(xv[i].y * rs * w.y); o.z = f2bf(xv[i].z * rs * w.z); o.w = f2bf(xv[i].w * rs * w.w);
          *(ushort4*)(xn + (size_t)row * DM + (lane + 64 * i) * 4) = o;
        }
      }
      continue;
    }
    v -= U_X;
    if (v < U_T1) { transpose_tile(p.w_in, DM, NIN, (u16*)(p.ws + OFF_WINT), v & 15, v >> 4, smem); continue; }
    v -= U_T1;
    if (v < U_T2) { transpose_tile(p.w_out, DM, DM, (u16*)(p.ws + OFF_WOUTT), v & 15, v >> 4, smem); continue; }
    v -= U_T2;
    if (v < U_T3) { transpose_tile(p.w_mlp_in, DM, DFF, (u16*)(p.ws + OFF_W1T), v & 15, v >> 4, smem); continue; }
    v -= U_T3;
    transpose_tile(p.w_mlp_out, DFF, DM, (u16*)(p.ws + OFF_W2T), v & 63, v >> 6, smem);
  }
}

DI void wave_lds_sync() { asm volatile("s_waitcnt lgkmcnt(0)" ::: "memory"); __builtin_amdgcn_wave_barrier(); }
template <int MODE>
DI void stage_tile_ns(const f32x16 (&acc)[4][2], char* wl, int lr, int hh) {
#pragma unroll
  for (int i = 0; i < 4; ++i)
#pragma unroll
    for (int j = 0; j < 2; ++j)
#pragma unroll
      for (int r = 0; r < 16; ++r) {
        float v = acc[i][j][r];
        if (MODE == 1) v = sigmoidf(v);
        if (MODE == 2) { v = fmaxf(v, 0.f); v = v * v; }
        *(u16*)(wl + (i * 32 + crow(r, hh)) * 128 + (j * 32 + lr) * 2) = f2bf(v);
      }
}
DI void stage_tile_sw(const f32x16 (&acc)[4][2], char* wl, int lr, int hh) {
#pragma unroll
  for (int i = 0; i < 4; ++i)
#pragma unroll
    for (int j = 0; j < 2; ++j)
#pragma unroll
      for (int r = 0; r < 16; ++r) *(u16*)(wl + (j * 32 + crow(r, hh)) * 256 + (i * 32 + lr) * 2) = f2bf(acc[i][j][r]);
}
DI void flush_tile_ns(const char* wl, u16* dst, size_t pitch, int lane) {
#pragma unroll 4
  for (int it = 0; it < 16; ++it) {
    const int q = lane + 64 * it, row = q >> 3, c8 = q & 7;
    *(uint4*)(dst + (size_t)row * pitch + c8 * 8) = *(const uint4*)(wl + row * 128 + c8 * 16);
  }
}

DI void phase1(const Params& p, char* smem) {
  const int tid = threadIdx.x, lane = tid & 63, wave = tid >> 6, wr = wave >> 1, wc = wave & 1, lr = lane & 31, hh = lane >> 5;
  const u16* xn = (const u16*)(p.ws + OFF_XN);
  const u16* wt = (const u16*)(p.ws + OFF_WINT);
  u16* qkpre = (u16*)(p.ws + OFF_QKPRE);
  u16* hyT = (u16*)(p.ws + OFF_HYT);
  u16* vT = (u16*)(p.ws + OFF_VT);
  u16* og = (u16*)(p.ws + OFF_OG);
  float* gates = (float*)(p.ws + OFF_GATES);
  const int ntn = 29, ntiles = tile_count(ntn);
  for (int id = blockIdx.x; id < ntiles; id += gridDim.x) {
    int mt, nt;
    tile_map(id, ntn, mt, nt);
    if (nt >= ntn) continue;
    const int m0 = mt * 256, n0 = nt * 128;
    f32x16 acc[4][2];
    const bool swap = (nt >= 8 && nt < 24);
    if (swap) gemm_core<true>(xn, wt, DM, m0, n0, smem, acc);
    else gemm_core<false>(xn, wt, DM, m0, n0, smem, acc);
    char* wl = smem + wave * 16384;
    if (!swap) {
      if (nt < 28) {
        if (nt < 8) stage_tile_ns<0>(acc, wl, lr, hh); else stage_tile_ns<1>(acc, wl, lr, hh);
        wave_lds_sync();
        const size_t row0 = (size_t)(m0 + wr * 128);
        if (nt < 8) flush_tile_ns(wl, qkpre + row0 * 1024 + n0 + wc * 64, 1024, lane);
        else flush_tile_ns(wl, og + row0 * 512 + (n0 - 3072) + wc * 64, 512, lane);
      } else {
#pragma unroll
        for (int i = 0; i < 4; ++i)
#pragma unroll
          for (int r = 0; r < 16; ++r) {
            const int row = m0 + wr * 128 + i * 32 + crow(r, hh);
            if (wc == 0 && lr < 16) gates[(size_t)row * 16 + lr] = acc[i][0][r];
          }
      }
    } else {
      stage_tile_sw(acc, wl, lr, hh);
      wave_lds_sync();
      const int mrow = m0 + wr * 128, b = mrow >> 12, t0 = mrow & 4095;
#pragma unroll 4
      for (int it = 0; it < 16; ++it) {
        const int q = lane + 64 * it, chl = q >> 4, c16 = q & 15;
        const int n = n0 + wc * 64 + chl;
        u16* dst;
        if (nt < 20) { const int cc = n - 1024, g = cc >> 9, ch = cc & 511; dst = hyT + ((size_t)((g * 4 + b) * 512 + ch)) * 4096; }
        else dst = vT + ((size_t)(b * 512 + (n - 2560))) * 4096;
        *(uint4*)(dst + t0 + c16 * 8) = *(const uint4*)(wl + chl * 256 + c16 * 16);
      }
    }
  }
}

DI void phase_qk(const Params& p, char* smem) {
  const int tid = opaque_tid();
  const int cg = tid & 31, rg = tid >> 5;
  const u16* qkpre = (const u16*)(p.ws + OFF_QKPRE);
  u16* qa = (u16*)(p.ws + OFF_QA);
  u16* ka = (u16*)(p.ws + OFF_KA);
  u16* kaT = (u16*)(p.ws + OFF_KAT);
  for (int u = blockIdx.x; u < 1024; u += gridDim.x) {
    const int ct = u & 3, tt = u >> 2;
    const int C0 = ct * 256 + cg * 8;
    const int Tb = tt * 64 + rg * 8;
    const int tb = Tb & 4095;
    float w0[8], w1[8], w2[8], cb[8];
    {
      const float4 a0 = *(const float4*)(p.conv_w + C0), a1 = *(const float4*)(p.conv_w + C0 + 4);
      const float4 b0 = *(const float4*)(p.conv_w + 2560 + C0), b1 = *(const float4*)(p.conv_w + 2560 + C0 + 4);
      const float4 c0 = *(const float4*)(p.conv_w + 5120 + C0), c1 = *(const float4*)(p.conv_w + 5120 + C0 + 4);
      const float4 d0 = *(const float4*)(p.conv_b + C0), d1 = *(const float4*)(p.conv_b + C0 + 4);
      w0[0] = a0.x; w0[1] = a0.y; w0[2] = a0.z; w0[3] = a0.w; w0[4] = a1.x; w0[5] = a1.y; w0[6] = a1.z; w0[7] = a1.w;
      w1[0] = b0.x; w1[1] = b0.y; w1[2] = b0.z; w1[3] = b0.w; w1[4] = b1.x; w1[5] = b1.y; w1[6] = b1.z; w1[7] = b1.w;
      w2[0] = c0.x; w2[1] = c0.y; w2[2] = c0.z; w2[3] = c0.w; w2[4] = c1.x; w2[5] = c1.y; w2[6] = c1.z; w2[7] = c1.w;
      cb[0] = d0.x; cb[1] = d0.y; cb[2] = d0.z; cb[3] = d0.w; cb[4] = d1.x; cb[5] = d1.y; cb[6] = d1.z; cb[7] = d1.w;
    }
    bf16x8 rows[10];
    const u16* src = qkpre + (size_t)Tb * 1024 + C0;
#pragma unroll
    for (int r = 0; r < 10; ++r) {
      const int t = tb + r - 1;
      bf16x8 z;
#pragma unroll
      for (int i = 0; i < 8; ++i) z[i] = 0;
      rows[r] = (t >= 0 && t <= 4095) ? *(const bf16x8*)(src + (ptrdiff_t)(r - 1) * 1024) : z;
    }
    const bool isk = C0 >= 512;
    bf16x8 tr[8];
#pragma unroll
    for (int r = 0; r < 8; ++r) {
      bf16x8 o;
#pragma unroll
      for (int i = 0; i < 8; ++i) {
        const float val = w0[i] * bf2f((u16)rows[r][i]) + w1[i] * bf2f((u16)rows[r + 1][i]) + w2[i] * bf2f((u16)rows[r + 2][i]) + cb[i];
        float sv = val * sigmoidf(val);
        if (isk) sv *= 0.08838834764831845f;
        o[i] = (short)f2bf(sv);
        tr[i][r] = o[i];
      }
      if (!isk) *(bf16x8*)(qa + (size_t)(Tb + r) * 512 + C0) = o;
      else *(bf16x8*)(ka + (size_t)(Tb + r) * 512 + (C0 - 512)) = o;
    }
    if (isk) {
      const int b = Tb >> 12;
#pragma unroll
      for (int i = 0; i < 8; ++i) *(bf16x8*)(kaT + ((size_t)(b * 512 + (C0 - 512) + i)) * 4096 + tb) = tr[i];
    }
  }
}

DI float lz(float v) { asm volatile("" : "+v"(v)); return v; }
DI float2 mk2(float a, float b) { return make_float2(a, b); }
DI float2 cmul(float2 a, float2 w) { return mk2(a.x * w.x - a.y * w.y, a.x * w.y + a.y * w.x); }
DI float2 cmulc(float2 a, float2 w) { return mk2(a.x * w.x + a.y * w.y, a.y * w.x - a.x * w.y); }
DI int lx(int idx) { const int sw = (idx >> 5) & 3; return idx ^ (sw << 3) ^ (sw << 1); }
template <bool LX>
DI void addr4(int base, int q, int k, int& a0, int& a1, int& a2, int& a3) {
  if (!LX) { a0 = base; a1 = base + q; a2 = base + 2 * q; a3 = base + 3 * q; }
  else if (q == 8) {
    const int sw = (k >> 3) & 3, b2 = base ^ (sw << 1);
    a0 = b2 + (sw << 3); a1 = b2 + ((1 ^ sw) << 3); a2 = b2 + ((2 ^ sw) << 3); a3 = b2 + ((3 ^ sw) << 3);
  } else {
    a0 = base; a1 = (base ^ 10) + 32; a2 = (base ^ 20) + 64; a3 = (base ^ 30) + 96;
  }
}
template <int NW, bool INV, bool INLX = false, bool OUTLX = false>
DI void r4_pass(float2* x, int tid, int q, const float2* __restrict__ t1, const float2* __restrict__ t2) {
  constexpr int NL = NW > 4 ? 4 : NW;
  constexpr int NB = NW > 4 ? 2 : 1;
  constexpr int CNT = 8 / NB;
#pragma unroll 1
  for (int bt = 0; bt < NB; ++bt) {
    float2 w1[NL], w2[NL];
#pragma unroll
    for (int n = 0; n < NL; ++n) { const int j = (tid + ((bt * CNT + n) << 8)) & (q - 1); w1[n] = t1[j]; w2[n] = t2[j]; }
    if (bt == 0) __syncthreads();
#pragma unroll(NL == 4 ? 4 : 2)
    for (int ii = 0; ii < CNT; ++ii) {
      const int k = tid + ((bt * CNT + ii) << 8);
      const int j = k & (q - 1);
      int base = ((k - j) << 2) + j;
      asm volatile("" : "+v"(base));
      const float2 ww1 = w1[ii % NL], ww2 = w2[ii % NL];
      int i0_, i1_, i2_, i3_, o0_, o1_, o2_, o3_;
      addr4<INLX>(base, q, k, i0_, i1_, i2_, i3_);
      addr4<OUTLX>(base, q, k, o0_, o1_, o2_, o3_);
      const float2 x0 = x[i0_], x1 = x[i1_], x2 = x[i2_], x3 = x[i3_];
      if (!INV) {
        const float2 a0 = mk2(x0.x + x2.x, x0.y + x2.y);
        const float2 a1 = mk2(x1.x + x3.x, x1.y + x3.y);
        const float2 d02 = mk2(x0.x - x2.x, x0.y - x2.y);
        const float2 d13 = mk2(x1.y - x3.y, x3.x - x1.x);
        const float2 a2 = cmul(d02, ww1);
        const float2 a3 = cmul(d13, ww1);
        x[o0_] = mk2(a0.x + a1.x, a0.y + a1.y);
        x[o1_] = cmul(mk2(a0.x - a1.x, a0.y - a1.y), ww2);
        x[o2_] = mk2(a2.x + a3.x, a2.y + a3.y);
        x[o3_] = cmul(mk2(a2.x - a3.x, a2.y - a3.y), ww2);
      } else {
        const float2 b1 = cmulc(x1, ww2), b3 = cmulc(x3, ww2);
        const float2 a0 = mk2(x0.x + b1.x, x0.y + b1.y);
        const float2 a1 = mk2(x0.x - b1.x, x0.y - b1.y);
        const float2 a2 = mk2(x2.x + b3.x, x2.y + b3.y);
        const float2 a3 = mk2(x2.x - b3.x, x2.y - b3.y);
        const float2 c2 = cmulc(a2, ww1);
        const float2 c3t = cmulc(a3, ww1);
        const float2 c3 = mk2(-c3t.y, c3t.x);
        x[o0_] = mk2(a0.x + c2.x, a0.y + c2.y);
        x[o2_] = mk2(a0.x - c2.x, a0.y - c2.y);
        x[o1_] = mk2(a1.x + c3.x, a1.y + c3.y);
        x[o3_] = mk2(a1.x - c3.x, a1.y - c3.y);
      }
    }
  }
}
template <bool INV>
DI void r8_tail(float2* x, int tid) {
  const float R = 0.70710678118654752f;
#pragma unroll 2
  for (int i = 0; i < 4; ++i) {
    const int G = tid + (i << 8);
    const int sw = (G >> 2) & 3;
    const int blk = (G << 3) ^ (sw << 3);
    float4* p0 = (float4*)(x + blk + ((0 ^ sw) << 1));
    float4* p1 = (float4*)(x + blk + ((1 ^ sw) << 1));
    float4* p2 = (float4*)(x + blk + ((2 ^ sw) << 1));
    float4* p3 = (float4*)(x + blk + ((3 ^ sw) << 1));
    const float4 v0 = *p0, v1 = *p1, v2 = *p2, v3 = *p3;
    float2 e0 = make_float2(v0.x, v0.y), e1 = make_float2(v0.z, v0.w), e2 = make_float2(v1.x, v1.y), e3 = make_float2(v1.z, v1.w);
    float2 e4 = make_float2(v2.x, v2.y), e5 = make_float2(v2.z, v2.w), e6 = make_float2(v3.x, v3.y), e7 = make_float2(v3.z, v3.w);
    if (!INV) {
      const float2 s0 = mk2(e0.x + e4.x, e0.y + e4.y), d0 = mk2(e0.x - e4.x, e0.y - e4.y);
      const float2 s1 = mk2(e1.x + e5.x, e1.y + e5.y), t1 = mk2(e1.x - e5.x, e1.y - e5.y);
      const float2 s2 = mk2(e2.x + e6.x, e2.y + e6.y), t2 = mk2(e2.x - e6.x, e2.y - e6.y);
      const float2 s3 = mk2(e3.x + e7.x, e3.y + e7.y), t3 = mk2(e3.x - e7.x, e3.y - e7.y);
      const float2 d1 = mk2((t1.x + t1.y) * R, (t1.y - t1.x) * R);
      const float2 d2 = mk2(t2.y, -t2.x);
      const float2 d3 = mk2((t3.y - t3.x) * R, -(t3.x + t3.y) * R);
      const float2 a0 = mk2(s0.x + s2.x, s0.y + s2.y), a2 = mk2(s0.x - s2.x, s0.y - s2.y);
      const float2 a1 = mk2(s1.x + s3.x, s1.y + s3.y), u3 = mk2(s1.x - s3.x, s1.y - s3.y);
      const float2 a3 = mk2(u3.y, -u3.x);
      const float2 a4 = mk2(d0.x + d2.x, d0.y + d2.y), a6 = mk2(d0.x - d2.x, d0.y - d2.y);
      const float2 a5 = mk2(d1.x + d3.x, d1.y + d3.y), u7 = mk2(d1.x - d3.x, d1.y - d3.y);
      const float2 a7 = mk2(u7.y, -u7.x);
      *p0 = make_float4(a0.x + a1.x, a0.y + a1.y, a0.x - a1.x, a0.y - a1.y);
      *p1 = make_float4(a2.x + a3.x, a2.y + a3.y, a2.x - a3.x, a2.y - a3.y);
      *p2 = make_float4(a4.x + a5.x, a4.y + a5.y, a4.x - a5.x, a4.y - a5.y);
      *p3 = make_float4(a6.x + a7.x, a6.y + a7.y, a6.x - a7.x, a6.y - a7.y);
    } else {
      const float2 z0 = mk2(e0.x + e1.x, e0.y + e1.y), z1 = mk2(e0.x - e1.x, e0.y - e1.y);
      const float2 z2 = mk2(e2.x + e3.x, e2.y + e3.y), z3 = mk2(e2.x - e3.x, e2.y - e3.y);
      const float2 z4 = mk2(e4.x + e5.x, e4.y + e5.y), z5 = mk2(e4.x - e5.x, e4.y - e5.y);
      const float2 z6 = mk2(e6.x + e7.x, e6.y + e7.y), z7 = mk2(e6.x - e7.x, e6.y - e7.y);
      const float2 b3 = mk2(-z3.y, z3.x), b7 = mk2(-z7.y, z7.x);
      const float2 y0 = mk2(z0.x + z2.x, z0.y + z2.y), y2 = mk2(z0.x - z2.x, z0.y - z2.y);
      const float2 y1 = mk2(z1.x + b3.x, z1.y + b3.y), y3 = mk2(z1.x - b3.x, z1.y - b3.y);
      const float2 y4 = mk2(z4.x + z6.x, z4.y + z6.y), y6 = mk2(z4.x - z6.x, z4.y - z6.y);
      const float2 y5 = mk2(z5.x + b7.x, z5.y + b7.y), y7 = mk2(z5.x - b7.x, z5.y - b7.y);
      const float2 c4 = y4;
      const float2 c5 = mk2((y5.x - y5.y) * R, (y5.x + y5.y) * R);
      const float2 c6 = mk2(-y6.y, y6.x);
      const float2 c7 = mk2(-(y7.x + y7.y) * R, (y7.x - y7.y) * R);
      *p0 = make_float4(y0.x + c4.x, y0.y + c4.y, y1.x + c5.x, y1.y + c5.y);
      *p1 = make_float4(y2.x + c6.x, y2.y + c6.y, y3.x + c7.x, y3.y + c7.y);
      *p2 = make_float4(y0.x - c4.x, y0.y - c4.y, y1.x - c5.x, y1.y - c5.y);
      *p3 = make_float4(y2.x - c6.x, y2.y - c6.y, y3.x - c7.x, y3.y - c7.y);
    }
  }
}
DI void fft_fwd(float2* x, int tid, const float2* __restrict__ tw) {
  r4_pass<8, false>(x, tid, 2048, tw + 4095, tw + 2047);
  r4_pass<2, false>(x, tid, 512, tw + 1023, tw + 511);
  r4_pass<1, false>(x, tid, 128, tw + 255, tw + 127);
  r4_pass<1, false, false, true>(x, tid, 32, tw + 63, tw + 31);
  r4_pass<1, false, true, true>(x, tid, 8, tw + 15, tw + 7);
  __syncthreads();
  r8_tail<false>(x, tid);
  __syncthreads();
}
DI void fft_inv(float2* x, int tid, const float2* __restrict__ tw) {
  __syncthreads();
  r8_tail<true>(x, tid);
  r4_pass<1, true, true, true>(x, tid, 8, tw + 15, tw + 7);
  r4_pass<1, true, true, false>(x, tid, 32, tw + 63, tw + 31);
  r4_pass<1, true>(x, tid, 128, tw + 255, tw + 127);
  r4_pass<2, true>(x, tid, 512, tw + 1023, tw + 511);
  r4_pass<8, true>(x, tid, 2048, tw + 4095, tw + 2047);
  __syncthreads();
}

DI float hy_conv(const u16* __restrict__ pr, int t, float w0, float w1, float w2, float cb) {
  const float a = t > 0 ? bf2f(pr[t - 1]) : 0.f;
  const float b = bf2f(pr[t]);
  const float c = t < 4095 ? bf2f(pr[t + 1]) : 0.f;
  return w0 * a + w1 * b + w2 * c + cb;
}

DI void hy_conv4(const u16* __restrict__ pr, int t0, float w0, float w1, float w2, float cb, float (&o)[4]) {
  const ushort4 c = *(const ushort4*)(pr + t0);
  const float pm = t0 > 0 ? bf2f(pr[t0 - 1]) : 0.f;
  const float pn = t0 + 4 < 4096 ? bf2f(pr[t0 + 4]) : 0.f;
  const float x0 = bf2f(c.x), x1 = bf2f(c.y), x2 = bf2f(c.z), x3 = bf2f(c.w);
  o[0] = w0 * pm + w1 * x0 + w2 * x1 + cb;
  o[1] = w0 * x0 + w1 * x1 + w2 * x2 + cb;
  o[2] = w0 * x1 + w1 * x2 + w2 * x3 + cb;
  o[3] = w0 * x2 + w1 * x3 + w2 * pn + cb;
}

DI void hyena_unit(const Params& p, int ch, char* smem) {
  float2* buf = (float2*)smem;
  const int tid = opaque_tid();
  const u16* hyT = (const u16*)(p.ws + OFF_HYT);
  const float* filt = (const float*)(p.ws + OFF_FILT);
  float* z2T = (float*)(p.ws + OFF_Z2T);
  const float2* tw = (const float2*)(p.ws + OFF_TW);
  float2 Kr[32];
  float* k1buf_base = (float*)(p.ws + OFF_FILT);
  {
    const float* kf0 = filt + (size_t)(0 * 512 + ch) * 4096;
    const float* kf1 = filt + (size_t)(1 * 512 + ch) * 4096;
    const float* kb0 = filt + (size_t)(2 * 512 + ch) * 4096;
    const float* kb1 = filt + (size_t)(3 * 512 + ch) * 4096;
    const float fb0 = p.filt_bias[ch], fb1 = p.filt_bias[512 + ch];
    __syncthreads();
#pragma unroll
    for (int g = 0; g < 4; ++g) {
      const int n0 = g * 1024 + tid * 4;
      float4 v0 = *(const float4*)(kf0 + n0), v1 = *(const float4*)(kf1 + n0);
      if (n0 == 0) { v0.x += fb0; v1.x += fb1; }
      const float4 r0 = *(const float4*)(kb0 + 4092 - n0), r1 = *(const float4*)(kb1 + 4092 - n0);
      const float e00 = (n0 == 0) ? 0.f : kb0[4096 - n0], e01 = (n0 == 0) ? 0.f : kb1[4096 - n0];
      *(float4*)(buf + n0) = make_float4(v0.x, v1.x, v0.y, v1.y);
      *(float4*)(buf + n0 + 2) = make_float4(v0.z, v1.z, v0.w, v1.w);
      *(float4*)(buf + 4096 + n0) = make_float4(e00, e01, r0.w, r1.w);
      *(float4*)(buf + 4096 + n0 + 2) = make_float4(r0.z, r1.z, r0.y, r1.y);
    }
    fft_fwd(buf, tid, tw);
    const float sc = 0.5f / 8192.f;
#pragma unroll
    for (int j = 0; j < 32; ++j) {
      const int P = tid + 256 * j;
      const int f = (int)(__brev((unsigned)lx(P)) >> 19);
      const int Pq = lx((int)(__brev((unsigned)((8192 - f) & 8191)) >> 19));
      const float2 zp = buf[P], zq = buf[Pq];
      Kr[j] = make_float2(sc * (zp.x + zq.x), sc * (zp.y - zq.y));
      const float2 k1 = make_float2(sc * (zp.y + zq.y), sc * (zq.x - zp.x));
      *(float2*)(k1buf_base + ((size_t)((P >> 11) * 512 + ch)) * 4096 + (P & 2047) * 2) = k1;
    }
  }
#pragma unroll 1
  for (int ord = 0; ord < 2; ++ord) {
    if (ord == 1) {
#pragma unroll
      for (int j = 0; j < 32; ++j) {
        const int P = tid + 256 * j;
        Kr[j] = *(const float2*)(k1buf_base + ((size_t)((P >> 11) * 512 + ch)) * 4096 + (P & 2047) * 2);
      }
    }
    const int gcol = 1024 + (1 + ord) * 512 + ch;
    const float gw0 = p.conv_w[gcol], gw1 = p.conv_w[2560 + gcol], gw2 = p.conv_w[5120 + gcol], gcb = p.conv_b[gcol];
    const int vcol = 1024 + ch;
    const float vw0 = p.conv_w[vcol], vw1 = p.conv_w[2560 + vcol], vw2 = p.conv_w[5120 + vcol], vcb = p.conv_b[vcol];
#pragma unroll 1
    for (int pr = 0; pr < 2; ++pr) {
      const int b0 = 2 * pr, b1 = 2 * pr + 1;
      __syncthreads();
      if (ord == 0) {
        const u16* u0 = hyT + ((size_t)((0 * 4 + b0) * 512 + ch)) * 4096;
        const u16* u1 = hyT + ((size_t)((0 * 4 + b1) * 512 + ch)) * 4096;
#pragma unroll
        for (int g = 0; g < 4; ++g) {
          const int t0 = g * 1024 + tid * 4;
          float a[4], b[4];
          hy_conv4(u0, t0, vw0, vw1, vw2, vcb, a);
          hy_conv4(u1, t0, vw0, vw1, vw2, vcb, b);
          *(float4*)(buf + t0) = make_float4(a[0], b[0], a[1], b[1]);
          *(float4*)(buf + t0 + 2) = make_float4(a[2], b[2], a[3], b[3]);
          *(float4*)(buf + 4096 + t0) = make_float4(0.f, 0.f, 0.f, 0.f);
          *(float4*)(buf + 4096 + t0 + 2) = make_float4(0.f, 0.f, 0.f, 0.f);
        }
      } else {
        const float* u0 = z2T + ((size_t)(b0 * 512 + ch)) * 4096;
        const float* u1 = z2T + ((size_t)(b1 * 512 + ch)) * 4096;
#pragma unroll
        for (int g = 0; g < 4; ++g) {
          const int t0 = g * 1024 + tid * 4;
          const float4 a = *(const float4*)(u0 + t0);
          const float4 b = *(const float4*)(u1 + t0);
          *(float4*)(buf + t0) = make_float4(a.x, b.x, a.y, b.y);
          *(float4*)(buf + t0 + 2) = make_float4(a.z, b.z, a.w, b.w);
          *(float4*)(buf + 4096 + t0) = make_float4(0.f, 0.f, 0.f, 0.f);
          *(float4*)(buf + 4096 + t0 + 2) = make_float4(0.f, 0.f, 0.f, 0.f);
        }
      }
      fft_fwd(buf, tid, tw);
#pragma unroll
      for (int j = 0; j < 32; ++j) {
        const float2 v = buf[tid + 256 * j];
        buf[tid + 256 * j] = make_float2(v.x * Kr[j].x - v.y * Kr[j].y, v.x * Kr[j].y + v.y * Kr[j].x);
      }
      fft_inv(buf, tid, tw);
      const u16* g0 = hyT + ((size_t)(((1 + ord) * 4 + b0) * 512 + ch)) * 4096;
      const u16* g1 = hyT + ((size_t)(((1 + ord) * 4 + b1) * 512 + ch)) * 4096;
      float* o0 = z2T + ((size_t)(b0 * 512 + ch)) * 4096;
      float* o1 = z2T + ((size_t)(b1 * 512 + ch)) * 4096;
#pragma unroll
      for (int g = 0; g < 4; ++g) {
        const int t0 = g * 1024 + tid * 4;
        const float4 y01 = *(const float4*)(buf + t0);
        const float4 y23 = *(const float4*)(buf + t0 + 2);
        float ga[4], gb[4];
        hy_conv4(g0, t0, gw0, gw1, gw2, gcb, ga);
        hy_conv4(g1, t0, gw0, gw1, gw2, gcb, gb);
        *(float4*)(o0 + t0) = make_float4(ga[0] * y01.x, ga[1] * y01.z, ga[2] * y23.x, ga[3] * y23.z);
        *(float4*)(o1 + t0) = make_float4(gb[0] * y01.y, gb[1] * y01.w, gb[2] * y23.y, gb[3] * y23.w);
      }
    }
  }
  __syncthreads();
}

DI void mlstm_local_unit(const Params& p, int u, char* smem) {
  float* s_gi = (float*)smem;
  float* s_lf = s_gi + 128;
  float* s_a = s_lf + 128;
  float* s_w = s_a + 128;
  const int tid = opaque_tid(), lane = tid & 63, wave = tid >> 6, lr = lane & 31, hh = lane >> 5;
  const int j = u & 31, dir = (u >> 5) & 1, bh = u >> 6, h = bh & 3, b = bh >> 2;
  const int T0 = b * 4096 + j * 128;
  const float* gates = (const float*)(p.ws + OFF_GATES);
  const u16* vT = (const u16*)(p.ws + OFF_VT);
  const u16* kaT = (const u16*)(p.ws + OFF_KAT);
  float* CL = p.out;
  float* nl = (float*)(p.ws + OFF_NL);
  float* mloc = (float*)(p.ws + OFF_MLOC);
  float* gsum = (float*)(p.ws + OFF_GSUM);
  __syncthreads();
  if (tid < 128) {
    const int T = T0 + tid;
    s_gi[tid] = gates[(size_t)T * 16 + dir * 8 + h] + p.b_gates[dir * 8 + h];
    s_lf[tid] = log_sigmoid(gates[(size_t)T * 16 + dir * 8 + 4 + h] + p.b_gates[dir * 8 + 4 + h]);
  }
  __syncthreads();
  float gtot = 0.f;
  if (tid < 128) {
    float pre = 0.f;
#pragma unroll 4
    for (int m = 0; m < 128; ++m) {
      const float v = s_lf[m];
      if (m < tid) pre += v;
      gtot += v;
    }
    s_a[tid] = (dir == 0) ? (gtot - pre - s_lf[tid] + s_gi[tid]) : (pre + s_gi[tid]);
  }
  __syncthreads();
  if (tid < 128) {
    float mx = -3.0e38f;
#pragma unroll 4
    for (int m = 0; m < 128; ++m) mx = fmaxf(mx, s_a[m]);
    s_w[tid] = expf(s_a[tid] - mx);
    if (tid == 0) { mloc[u] = mx; gsum[u] = gtot; }
  }
  __syncthreads();
  f32x16 acc[4];
#pragma unroll
  for (int d = 0; d < 4; ++d)
#pragma unroll
    for (int r = 0; r < 16; ++r) acc[d][r] = 0.f;
  const u16* vrow = vT + ((size_t)(bh * 128 + wave * 32 + lr)) * 4096 + j * 128 + hh * 8;
  const u16* kbase = kaT + ((size_t)(bh * 128 + lr)) * 4096 + j * 128 + hh * 8;
#pragma unroll 4
  for (int ks = 0; ks < 8; ++ks) {
    const bf16x8 av = *(const bf16x8*)(vrow + ks * 16);
    bf16x8 a;
#pragma unroll
    for (int i = 0; i < 8; ++i) a[i] = (short)f2bf(bf2f((u16)av[i]) * s_w[ks * 16 + hh * 8 + i]);
#pragma unroll
    for (int dt = 0; dt < 4; ++dt) {
      const bf16x8 bk = *(const bf16x8*)(kbase + (size_t)(dt * 32) * 4096 + ks * 16);
      acc[dt] = MFMA(a, bk, acc[dt]);
    }
  }
  float* dst = CL + (size_t)u * 16384;
#pragma unroll
  for (int dt = 0; dt < 4; ++dt)
#pragma unroll
    for (int r = 0; r < 16; ++r) dst[(wave * 32 + crow(r, hh)) * 128 + dt * 32 + lr] = acc[dt][r];
  if (tid < 128) {
    const u16* kr = kaT + ((size_t)(bh * 128 + tid)) * 4096 + j * 128;
    float s = 0.f;
#pragma unroll 2
    for (int l = 0; l < 128; l += 8) {
      const bf16x8 kv = *(const bf16x8*)(kr + l);
#pragma unroll
      for (int i = 0; i < 8; ++i) s += s_w[l + i] * bf2f((u16)kv[i]);
    }
    nl[(size_t)u * 128 + tid] = s;
  }
}

DI void scan_unit(const Params& p, int unit) {
  const int tid = opaque_tid();
  const int sc = unit >> 4, part = unit & 15, dir = sc & 1;
  float* CL = p.out;
  float* nl = (float*)(p.ws + OFF_NL);
  const float* mloc = (const float*)(p.ws + OFF_MLOC);
  const float* gsum = (const float*)(p.ws + OFF_GSUM);
  float* ms = (float*)(p.ws + OFF_MS);
  const int idx = part * 1024 + tid * 4;
  float4 C = make_float4(0.f, 0.f, 0.f, 0.f);
  float nst = 0.f, m = 0.f;
  const bool do_n = (part == 0) && (tid < 128);
  float4 pf[4];
#pragma unroll
  for (int q = 0; q < 4; ++q) {
    const int jj = dir ? 31 - q : q;
    pf[q] = *(const float4*)(CL + (size_t)(sc * 32 + jj) * 16384 + idx);
  }
#pragma unroll 1
  for (int c0 = 0; c0 < 32; c0 += 4) {
#pragma unroll
    for (int q = 0; q < 4; ++q) {
      const int c = c0 + q;
      const int jj = dir ? 31 - c : c;
      const int u = sc * 32 + jj;
      const float4 cl = pf[q];
      *(float4*)(CL + (size_t)u * 16384 + idx) = C;
      if (c + 4 < 32) {
        const int j2 = dir ? 31 - (c + 4) : (c + 4);
        pf[q] = *(const float4*)(CL + (size_t)(sc * 32 + j2) * 16384 + idx);
      }
      const float g = gsum[u], ml = mloc[u];
      const float mn = fmaxf(g + m, ml);
      const float dec = expf(g + m - mn), scl = expf(ml - mn);
      C.x = dec * C.x + scl * cl.x; C.y = dec * C.y + scl * cl.y; C.z = dec * C.z + scl * cl.z; C.w = dec * C.w + scl * cl.w;
      if (do_n) {
        const float nv = nl[(size_t)u * 128 + tid];
        nl[(size_t)u * 128 + tid] = nst;
        nst = dec * nst + scl * nv;
      }
      if (part == 0 && tid == 0) ms[u] = m;
      m = mn;
    }
  }
}

template <int DIR>
DI void mlstm_dir(const Params& p, int bh, int j, char* smem, f32x16 (&hs)[4]) {
  float* s_gi = (float*)smem;
  float* s_lf = s_gi + 128;
  float* s_bc = s_lf + 128;
  float* s_r = s_bc + 128;
  float* s_al = s_r + 128;
  float* s_fl = s_al + 128;
  float* s_is = s_fl + 128;
  const int tid = opaque_tid(), lane = tid & 63, wave = tid >> 6, lr = lane & 31, hh = lane >> 5;
  u16* Pl = (u16*)(smem + 4096) + wave * (32 * 136);
  const int h = bh & 3, b = bh >> 2;
  const int T0 = b * 4096 + j * 128;
  const float* gates = (const float*)(p.ws + OFF_GATES);
  const u16* qa = (const u16*)(p.ws + OFF_QA);
  const u16* ka = (const u16*)(p.ws + OFF_KA);
  const u16* vT = (const u16*)(p.ws + OFF_VT);
  const float* CS = p.out;
  const float* ns = (const float*)(p.ws + OFF_NL);
  const float* ms = (const float*)(p.ws + OFF_MS);
  u16* A2 = (u16*)(p.ws + OFF_A2);
  bf16x8 ones;
#pragma unroll
  for (int i = 0; i < 8; ++i) ones[i] = (short)0x3F80;
  const u16* qrow = qa + (size_t)(T0 + wave * 32 + lr) * 512 + h * 128 + hh * 8;
  const int u = (bh * 2 + DIR) * 32 + j;
  const float msu = ms[u];
  __syncthreads();
  if (tid < 128) {
    const int T = T0 + tid;
    s_gi[tid] = gates[(size_t)T * 16 + DIR * 8 + h] + p.b_gates[DIR * 8 + h];
    s_lf[tid] = log_sigmoid(gates[(size_t)T * 16 + DIR * 8 + 4 + h] + p.b_gates[DIR * 8 + 4 + h]);
  }
  __syncthreads();
  if (tid < 128) {
    float a = 0.f;
#pragma unroll 4
    for (int m = 0; m < 128; ++m) {
      const bool in = (DIR == 0) ? (m <= tid) : (m >= tid);
      a += in ? s_lf[m] : 0.f;
    }
    s_bc[tid] = a;
    s_r[tid] = s_gi[tid] - a;
  }
  __syncthreads();
  if (tid < 128) {
    float cm = -3.0e38f;
#pragma unroll 4
    for (int m = 0; m < 128; ++m) {
      const bool in = (DIR == 0) ? (m <= tid) : (m >= tid);
      cm = in ? fmaxf(cm, s_r[m]) : cm;
    }
    const float bc = s_bc[tid];
    const float mt = bc + fmaxf(msu, cm);
    s_al[tid] = bc - mt;
    s_fl[tid] = expf(-mt);
    s_is[tid] = expf(bc + msu - mt);
  }
  __syncthreads();
  char* Kt = smem + 4096;
  char* R2 = smem + 40960;
  {
#pragma unroll
    for (int bt = 0; bt < 2; ++bt) {
      uint4 kq[4];
#pragma unroll
      for (int i = 0; i < 4; ++i) {
        const int q = tid + 256 * (bt * 4 + i), row = q >> 4, ch = q & 15;
        kq[i] = *(const uint4*)(ka + (size_t)(T0 + row) * 512 + h * 128 + ch * 8);
      }
#pragma unroll
      for (int i = 0; i < 4; ++i) {
        const int q = tid + 256 * (bt * 4 + i), row = q >> 4, ch = q & 15;
        *(uint4*)(Kt + row * 256 + ((ch ^ (row & 15)) << 4)) = kq[i];
      }
    }
  }
  __syncthreads();
  {
    f32x16 S[4];
#pragma unroll
    for (int st = 0; st < 4; ++st)
#pragma unroll
      for (int r = 0; r < 16; ++r) S[st][r] = 0.f;
#pragma unroll 4
    for (int ks = 0; ks < 8; ++ks) {
      const bf16x8 a = *(const bf16x8*)(qrow + ks * 16);
#pragma unroll
      for (int st = 0; st < 4; ++st) {
        const int krow = st * 32 + lr;
        const bf16x8 bk = *(const bf16x8*)(Kt + krow * 256 + (((ks * 2 + hh) ^ (krow & 15)) << 4));
        S[st] = MFMA(a, bk, S[st]);
      }
    }
    __syncthreads();
#pragma unroll
    for (int st = 0; st < 4; ++st) {
      const int sl = st * 32 + lr;
      const float rs = s_r[sl];
#pragma unroll
      for (int r = 0; r < 16; ++r) {
        const int tl = wave * 32 + crow(r, hh);
        const bool valid = (DIR == 0) ? (sl <= tl) : (sl >= tl);
        const float pv = valid ? S[st][r] * __expf(s_al[tl] + rs) : 0.f;
        Pl[crow(r, hh) * 136 + sl] = f2bf(pv);
      }
    }
  }
#pragma unroll
  for (int eh = 0; eh < 2; ++eh) {
    f32x16 N[3];
#pragma unroll
    for (int e = 0; e < 3; ++e)
#pragma unroll
      for (int r = 0; r < 16; ++r) N[e][r] = 0.f;
    {
      uint4 vq[4];
#pragma unroll
      for (int i = 0; i < 4; ++i) {
        const int q = tid + 256 * i, row = q >> 4, ch = q & 15;
        vq[i] = *(const uint4*)(vT + ((size_t)(bh * 128 + eh * 64 + row)) * 4096 + j * 128 + ch * 8);
      }
#pragma unroll
      for (int i = 0; i < 4; ++i) {
        const int q = tid + 256 * i, row = q >> 4, ch = q & 15;
        *(uint4*)(R2 + row * 256 + ((ch ^ (row & 15)) << 4)) = vq[i];
      }
    }
    __syncthreads();
    {
#pragma unroll 4
      for (int ks = 0; ks < 8; ++ks) {
        const bf16x8 a = *(const bf16x8*)(Pl + lr * 136 + ks * 16 + hh * 8);
#pragma unroll
        for (int e2 = 0; e2 < 2; ++e2) {
          const int vrow = e2 * 32 + lr;
          const bf16x8 bv = *(const bf16x8*)(R2 + vrow * 256 + (((ks * 2 + hh) ^ (vrow & 15)) << 4));
          N[e2] = MFMA(a, bv, N[e2]);
        }
        N[2] = MFMA(a, ones, N[2]);
      }
    }
    {
      bf16x8 cq[4];
#pragma unroll
      for (int i = 0; i < 4; ++i) {
        const int q = tid + 256 * i, row = q >> 4, ch = q & 15;
        const float* src = CS + (size_t)u * 16384 + (size_t)(eh * 64 + row) * 128 + ch * 8;
        const float4 c0 = *(const float4*)(src), c1 = *(const float4*)(src + 4);
        const float cv[8] = {c0.x, c0.y, c0.z, c0.w, c1.x, c1.y, c1.z, c1.w};
        cq[i] = pack8(cv);
      }
      __syncthreads();
#pragma unroll
      for (int i = 0; i < 4; ++i) {
        const int q = tid + 256 * i, row = q >> 4, ch = q & 15;
        *(bf16x8*)(R2 + row * 256 + ((ch ^ (row & 15)) << 4)) = cq[i];
      }
    }
    __syncthreads();
    {
      const float isc = s_is[wave * 32 + lr];
      const float* nbase = ns + (size_t)u * 128 + hh * 8;
#pragma unroll 4
      for (int ks = 0; ks < 8; ++ks) {
        const bf16x8 aq = *(const bf16x8*)(qrow + ks * 16);
        const bf16x8 a = scale8(aq, isc);
#pragma unroll
        for (int e2 = 0; e2 < 2; ++e2) {
          const int crw = e2 * 32 + lr;
          const bf16x8 bc = *(const bf16x8*)(R2 + crw * 256 + (((ks * 2 + hh) ^ (crw & 15)) << 4));
          N[e2] = MFMA(a, bc, N[e2]);
        }
        const float4 n0 = *(const float4*)(nbase + ks * 16);
        const float4 n1 = *(const float4*)(nbase + ks * 16 + 4);
        const float nv[8] = {n0.x, n0.y, n0.z, n0.w, n1.x, n1.y, n1.z, n1.w};
        N[2] = MFMA(a, pack8(nv), N[2]);
      }
    }
    __syncthreads();
    u16* park = (u16*)(p.ws + OFF_HYT) + ((size_t)(bh * 32 + j) * 256 + tid) * 64 + eh * 32;
    bf16x8 pk[4];
    if (DIR == 1) {
#pragma unroll
      for (int q = 0; q < 4; ++q) pk[q] = *(const bf16x8*)(park + q * 8);
    }
#pragma unroll
    for (int r = 0; r < 16; ++r) {
      const int tl = wave * 32 + crow(r, hh);
      const float den = fmaxf(fabsf(N[2][r]), s_fl[tl]);
      const float inv = 1.f / den;
#pragma unroll
      for (int e2 = 0; e2 < 2; ++e2) {
        const float hv = N[e2][r] * inv;
        const int v = e2 * 16 + r;
        if (DIR == 0) pk[v >> 3][v & 7] = (short)f2bf(hv);
        else hs[eh * 2 + e2][r] = hv + bf2f((u16)pk[v >> 3][v & 7]);
      }
    }
    if (DIR == 0) {
#pragma unroll
      for (int q = 0; q < 4; ++q) *(bf16x8*)(park + q * 8) = pk[q];
    }
  }
}

DI void mlstm_out_unit(const Params& p, int unit, char* smem) {
  const int tid = opaque_tid(), lane = tid & 63, wave = tid >> 6, lr = lane & 31, hh = lane >> 5;
  const int j = unit & 31, bh = unit >> 5, h = bh & 3, b = bh >> 2;
  const int T0 = b * 4096 + j * 128;
  const u16* og = (const u16*)(p.ws + OFF_OG);
  u16* A2 = (u16*)(p.ws + OFF_A2);
  f32x16 hs[4];
  mlstm_dir<0>(p, bh, j, smem, hs);
  mlstm_dir<1>(p, bh, j, smem, hs);
  __syncthreads();
  float* wl = (float*)(smem + wave * 16384);
#pragma unroll
  for (int et = 0; et < 4; ++et)
#pragma unroll
    for (int r = 0; r < 16; ++r) wl[crow(r, hh) * 128 + et * 32 + lr] = hs[et][r];
  wave_lds_sync();
  {
    const int row = lane >> 1, half = lane & 1;
    const size_t T = (size_t)(T0 + wave * 32 + row);
    const u16* ogp = og + T * 512 + h * 128 + half * 64;
    const float* src = wl + row * 128 + half * 64;
    float g[64];
    float ss = 0.f;
#pragma unroll
    for (int q = 0; q < 8; ++q) {
      const bf16x8 o8 = *(const bf16x8*)(ogp + q * 8);
      const float4 h0 = *(const float4*)(src + q * 8), h1 = *(const float4*)(src + q * 8 + 4);
      g[q * 8 + 0] = h0.x * bf2f((u16)o8[0]); g[q * 8 + 1] = h0.y * bf2f((u16)o8[1]); g[q * 8 + 2] = h0.z * bf2f((u16)o8[2]); g[q * 8 + 3] = h0.w * bf2f((u16)o8[3]);
      g[q * 8 + 4] = h1.x * bf2f((u16)o8[4]); g[q * 8 + 5] = h1.y * bf2f((u16)o8[5]); g[q * 8 + 6] = h1.z * bf2f((u16)o8[6]); g[q * 8 + 7] = h1.w * bf2f((u16)o8[7]);
#pragma unroll
      for (int i = 0; i < 8; ++i) ss += g[q * 8 + i] * g[q * 8 + i];
    }
    ss += __shfl_xor(ss, 1, 64);
    const float rs = rsqrtf(ss * (1.f / 128.f) + EPS);
    const float* mw = p.mlstm_norm_w + h * 128 + half * 64;
    u16* dst = A2 + T * 1024 + h * 128 + half * 64;
#pragma unroll
    for (int q = 0; q < 8; ++q) {
      const float4 w0 = *(const float4*)(mw + q * 8), w1 = *(const float4*)(mw + q * 8 + 4);
      float o[8];
      o[0] = g[q * 8 + 0] * rs * w0.x; o[1] = g[q * 8 + 1] * rs * w0.y; o[2] = g[q * 8 + 2] * rs * w0.z; o[3] = g[q * 8 + 3] * rs * w0.w;
      o[4] = g[q * 8 + 4] * rs * w1.x; o[5] = g[q * 8 + 5] * rs * w1.y; o[6] = g[q * 8 + 6] * rs * w1.z; o[7] = g[q * 8 + 7] * rs * w1.w;
      *(bf16x8*)(dst + q * 8) = pack8(o);
    }
  }
}

DI void hyena_norm_unit(const Params& p, int unit, char* smem) {
  float* tile = (float*)smem;
  const int tid = opaque_tid();
  const int tt = unit & 63, g = (unit >> 6) & 7, b = unit >> 9;
  const float* z2T = (const float*)(p.ws + OFF_Z2T);
  u16* A2 = (u16*)(p.ws + OFF_A2);
  __syncthreads();
#pragma unroll 4
  for (int i = 0; i < 16; ++i) {
    const int cl = (tid >> 6) + 4 * i, tl = tid & 63;
    tile[cl * 65 + tl] = z2T[((size_t)(b * 512 + g * 64 + cl)) * 4096 + tt * 64 + tl];
  }
  __syncthreads();
  const int tl = tid >> 2, qd = tid & 3;
  float v[16];
  float ss = 0.f;
#pragma unroll
  for (int i = 0; i < 16; ++i) {
    v[i] = tile[(qd * 16 + i) * 65 + tl];
    ss += v[i] * v[i];
  }
  ss += __shfl_xor(ss, 1, 64);
  ss += __shfl_xor(ss, 2, 64);
  const float rs = rsqrtf(ss * (1.f / 64.f) + EPS);
  const size_t T = (size_t)b * 4096 + tt * 64 + tl;
  u16* dst = A2 + T * 1024 + 512 + g * 64 + qd * 16;
  const float* w = p.hyena_norm_w + g * 64 + qd * 16;
  float o[16];
#pragma unroll
  for (int i = 0; i < 16; ++i) o[i] = v[i] * rs * w[i];
  *(bf16x8*)(dst) = pack8(o);
  *(bf16x8*)(dst + 8) = pack8(o + 8);
}

template <int EPI>
DI void gemm_phase(const u16* A, const u16* Bt, int K, int ntn, void* outp, char* smem) {
  const int tid = threadIdx.x, lane = tid & 63, wave = tid >> 6, wr = wave >> 1, wc = wave & 1, lr = lane & 31, hh = lane >> 5;
  const int ntiles = tile_count(ntn);
  for (int id = blockIdx.x; id < ntiles; id += gridDim.x) {
    int mt, nt;
    tile_map(id, ntn, mt, nt);
    if (nt >= ntn) continue;
    const int m0 = mt * 256, n0 = nt * 128;
    f32x16 acc[4][2];
    gemm_core<false>(A, Bt, K, m0, n0, smem, acc);
    if (EPI == 0) {
#pragma unroll
      for (int i = 0; i < 4; ++i)
#pragma unroll
        for (int j = 0; j < 2; ++j)
#pragma unroll
          for (int r = 0; r < 16; ++r) {
            const int row = m0 + wr * 128 + i * 32 + crow(r, hh);
            const int col = n0 + wc * 64 + j * 32 + lr;
            ((float*)outp)[(size_t)row * 1024 + col] = acc[i][j][r];
          }
    } else {
      char* wl = smem + wave * 16384;
      stage_tile_ns<2>(acc, wl, lr, hh);
      wave_lds_sync();
      flush_tile_ns(wl, (u16*)outp + (size_t)(m0 + wr * 128) * 4096 + n0 + wc * 64, 4096, lane);
    }
  }
}

DI void phase_post_mix(const Params& p) {
  const int tid = threadIdx.x, lane = tid & 63, wave = tid >> 6;
  const float* mix = p.out;
  float* x1 = (float*)(p.ws + OFF_X1);
  u16* hm = (u16*)(p.ws + OFF_HM);
  for (int u = blockIdx.x; u < 1024; u += gridDim.x) {
#pragma unroll 2
    for (int rr = 0; rr < 4; ++rr) {
      const size_t row = (size_t)u * 16 + wave * 4 + rr;
      float4 mv[4], xv[4];
      float ss = 0.f;
#pragma unroll
      for (int i = 0; i < 4; ++i) {
        mv[i] = ((const float4*)(mix + row * DM))[lane + 64 * i];
        xv[i] = ((const float4*)(p.x + row * DM))[lane + 64 * i];
        ss += mv[i].x * mv[i].x + mv[i].y * mv[i].y + mv[i].z * mv[i].z + mv[i].w * mv[i].w;
      }
      ss = wave_sum(ss);
      const float rs = rsqrtf(ss * (1.f / DM) + EPS);
      float s2 = 0.f;
#pragma unroll
      for (int i = 0; i < 4; ++i) {
        const float4 w = ((const float4*)p.norm_mix_post)[lane + 64 * i];
        xv[i].x += mv[i].x * rs * w.x; xv[i].y += mv[i].y * rs * w.y; xv[i].z += mv[i].z * rs * w.z; xv[i].w += mv[i].w * rs * w.w;
        s2 += xv[i].x * xv[i].x + xv[i].y * xv[i].y + xv[i].z * xv[i].z + xv[i].w * xv[i].w;
        ((float4*)(x1 + row * DM))[lane + 64 * i] = xv[i];
      }
      s2 = wave_sum(s2);
      const float r2 = rsqrtf(s2 * (1.f / DM) + EPS);
#pragma unroll
      for (int i = 0; i < 4; ++i) {
        const float4 w = ((const float4*)p.norm_mlp_pre)[lane + 64 * i];
        ushort4 o;
        o.x = f2bf(xv[i].x * r2 * w.x); o.y = f2bf(xv[i].y * r2 * w.y); o.z = f2bf(xv[i].z * r2 * w.z); o.w = f2bf(xv[i].w * r2 * w.w);
        *(ushort4*)(hm + row * DM + (lane + 64 * i) * 4) = o;
      }
    }
  }
}

DI void phase_final(const Params& p) {
  const int tid = threadIdx.x, lane = tid & 63, wave = tid >> 6;
  const float* x1 = (const float*)(p.ws + OFF_X1);
  for (int u = blockIdx.x; u < 1024; u += gridDim.x) {
#pragma unroll 2
    for (int rr = 0; rr < 4; ++rr) {
      const size_t row = (size_t)u * 16 + wave * 4 + rr;
      float4 fv[4];
      float ss = 0.f;
#pragma unroll
      for (int i = 0; i < 4; ++i) {
        fv[i] = ((const float4*)(p.out + row * DM))[lane + 64 * i];
        ss += fv[i].x * fv[i].x + fv[i].y * fv[i].y + fv[i].z * fv[i].z + fv[i].w * fv[i].w;
      }
      ss = wave_sum(ss);
      const float rs = rsqrtf(ss * (1.f / DM) + EPS);
#pragma unroll
      for (int i = 0; i < 4; ++i) {
        const float4 w = ((const float4*)p.norm_mlp_post)[lane + 64 * i];
        const float4 xv = ((const float4*)(x1 + row * DM))[lane + 64 * i];
        float4 o;
        o.x = xv.x + fv[i].x * rs * w.x; o.y = xv.y + fv[i].y * rs * w.y; o.z = xv.z + fv[i].z * rs * w.z; o.w = xv.w + fv[i].w * rs * w.w;
        ((float4*)(p.out + row * DM))[lane + 64 * i] = o;
      }
    }
  }
}

DI void run_phase(const Params& p, int ph, char* smem) {
  switch (ph) {
    case 0: phase0(p, smem); break;
    case 1: phase1(p, smem); break;
    case 2: phase_qk(p, smem); break;
    case 3:
#ifdef DBL_HYONLY
      for (int u = blockIdx.x; u < 512; u += gridDim.x) hyena_unit(p, u, smem);
#endif
#ifdef DBL_MLONLY
      for (int u = blockIdx.x; u < 1024; u += gridDim.x) mlstm_local_unit(p, u, smem);
#endif
      for (int u = blockIdx.x; u < 512 + 1024; u += gridDim.x) {
        if (u < 512) hyena_unit(p, u, smem);
        else mlstm_local_unit(p, u - 512, smem);
      }
      break;
    case 4:
      for (int u = blockIdx.x; u < 512; u += gridDim.x) scan_unit(p, u);
      break;
    case 5:
      for (int u = blockIdx.x; u < 512 + 2048; u += gridDim.x) {
#ifndef DBG_SKIP_MLSTM
        if (u < 512) mlstm_out_unit(p, u, smem);
#else
        if (u < 512) { u16* A2 = (u16*)(p.ws + OFF_A2); const int T0 = (u >> 5 >> 2) * 4096 + (u & 31) * 128, hq = (u >> 5) & 3;
          for (int i = threadIdx.x; i < 128 * 128; i += 256) A2[(size_t)(T0 + (i >> 7)) * 1024 + hq * 128 + (i & 127)] = 0; }
#endif
#ifndef DBG_SKIP_HYENA
        else hyena_norm_unit(p, u - 512, smem);
#else
        else { const int un = u - 512; const int tt = un & 63, g = (un >> 6) & 7, b = un >> 9; u16* A2 = (u16*)(p.ws + OFF_A2);
          for (int i = threadIdx.x; i < 64 * 64; i += 256) A2[((size_t)b * 4096 + tt * 64 + (i >> 6)) * 1024 + 512 + g * 64 + (i & 63)] = 0x3F80; }
#endif
      }
      break;
    case 6: gemm_phase<0>((const u16*)(p.ws + OFF_A2), (const u16*)(p.ws + OFF_WOUTT), 1024, 8, p.out, smem); break;
    case 7: phase_post_mix(p); break;
    case 8: gemm_phase<1>((const u16*)(p.ws + OFF_HM), (const u16*)(p.ws + OFF_W1T), 1024, 32, p.ws + OFF_H, smem); break;
    case 9: gemm_phase<0>((const u16*)(p.ws + OFF_H), (const u16*)(p.ws + OFF_W2T), 4096, 8, p.out, smem); break;
    case 10: phase_final(p); break;
  }
}
constexpr int NPHASE = 11;

#define XB_XCNT(j)  (256  + 64 * (j))
#define XB_XSUB(j)  (1280 + 64 * (j))
#define XB_XGEN(j)  (2304 + 64 * (j))
#define XB_TOP      3328
#define XB_TOPGEN   3392
#define XCD_BAR_WORDS 3456
DI unsigned xb_ld(unsigned* p) { return __hip_atomic_load(p, __ATOMIC_RELAXED, __HIP_MEMORY_SCOPE_AGENT); }
DI unsigned xb_add(unsigned* p, unsigned v) { return __hip_atomic_fetch_add(p, v, __ATOMIC_RELAXED, __HIP_MEMORY_SCOPE_AGENT); }
DI unsigned xb_xcc_id() { return (unsigned)__builtin_amdgcn_s_getreg((3 << 11) | 20) & 0xFu; }
struct XcdBar { unsigned* bar; unsigned x, nloc, nx; };
DI void xcd_barrier(XcdBar& b) {
  asm volatile("s_waitcnt vmcnt(0)" ::: "memory");
  __syncthreads();
  if (threadIdx.x == 0) {
    unsigned* bar = b.bar;
    __builtin_amdgcn_s_waitcnt(0);
    if (b.nloc == 0u) {
      const unsigned G = gridDim.x;
      unsigned sum, cnt, mine;
      for (;;) {
        sum = 0u; cnt = 0u; mine = 0u;
#pragma unroll
        for (unsigned j = 0; j < 16; ++j) { const unsigned c = xb_ld(&bar[XB_XCNT(j)]); sum += c; cnt += (c > 0u) ? 1u : 0u; mine = (j == b.x) ? c : mine; }
        if (sum == G) break;
        __builtin_amdgcn_s_sleep(1);
      }
      b.nloc = mine > 0u ? mine : 1u; b.nx = cnt > 0u ? cnt : 1u;
    }
    const unsigned nloc = b.nloc, nx = b.nx;
    const unsigned old = xb_add(&bar[XB_XSUB(b.x)], 1u);
    const unsigned gen = old / nloc;
    if (old + 1u == (gen + 1u) * nloc) {
      __builtin_amdgcn_fence(__ATOMIC_RELEASE, "agent");
      asm volatile("s_waitcnt vmcnt(0)" ::: "memory");
      const unsigned og = xb_add(&bar[XB_TOP], 1u);
      const unsigned tg = og / nx;
      if (og + 1u == (tg + 1u) * nx) xb_add(&bar[XB_TOPGEN], 1u);
      else while (xb_ld(&bar[XB_TOPGEN]) == tg) __builtin_amdgcn_s_sleep(1);
      __builtin_amdgcn_fence(__ATOMIC_ACQUIRE, "agent");
      xb_add(&bar[XB_XGEN(b.x)], 1u);
      asm volatile("s_waitcnt vmcnt(0)" ::: "memory");
    } else {
      while (xb_ld(&bar[XB_XGEN(b.x)]) == gen) __builtin_amdgcn_s_sleep(1);
      __builtin_amdgcn_fence(__ATOMIC_ACQUIRE, "agent");
      asm volatile("s_waitcnt vmcnt(0)" ::: "memory");
    }
  }
  __syncthreads();
}

#if MULTI_LAUNCH
template <int PH>
__global__ void __launch_bounds__(256, 2) phase_kernel(Params p) {
  __shared__ __attribute__((aligned(16))) char smem[65536];
  run_phase(p, PH, smem);
}
template <int PH>
static void launch_phase(const Params& p, hipStream_t stream) {
  hipLaunchKernelGGL(phase_kernel<PH>, dim3(512), dim3(256), 0, stream, p);
}
#else
__global__ void __launch_bounds__(256, 2) mega_kernel(Params p) {
  __shared__ __attribute__((aligned(16))) char smem[65536];
  cg::grid_group grid = cg::this_grid();
  XcdBar xb;
  xb.bar = (unsigned*)(p.ws + OFF_BAR); xb.x = xb_xcc_id(); xb.nloc = 0u; xb.nx = 0u;
  if (p.ws == nullptr) grid.sync();
  if (threadIdx.x == 0) (void)xb_add(&xb.bar[XB_XCNT(xb.x)], 1u);
#define GSYNC xcd_barrier(xb)
#ifdef DBL_P0
  run_phase(p, 0, smem);
#endif
  run_phase(p, 0, smem); GSYNC;
  run_phase(p, 1, smem); GSYNC;
#ifdef DBL_GEMM
  run_phase(p, 1, smem); grid.sync();
#endif
  run_phase(p, 2, smem); GSYNC;
#ifdef DBL_P2
  run_phase(p, 2, smem); GSYNC;
#endif
  run_phase(p, 3, smem); GSYNC;
#ifdef DBL_HY
  run_phase(p, 3, smem); GSYNC;
#endif
  run_phase(p, 4, smem); GSYNC;
  run_phase(p, 5, smem); GSYNC;
#ifdef DBL_P5
  run_phase(p, 5, smem); GSYNC;
#endif
  run_phase(p, 6, smem); GSYNC;
#ifdef DBL_GEMM
  run_phase(p, 6, smem); GSYNC;
#endif
  run_phase(p, 7, smem); GSYNC;
#ifdef DBL_P7
  run_phase(p, 7, smem); GSYNC;
#endif
  run_phase(p, 8, smem); GSYNC;
#ifdef DBL_GEMM
  run_phase(p, 8, smem); GSYNC;
#endif
  run_phase(p, 9, smem); GSYNC;
#ifdef DBL_GEMM
  run_phase(p, 9, smem); GSYNC;
#endif
#ifdef XSYNC
  for (int q = 0; q < 10; ++q) GSYNC;
#endif
  run_phase(p, 10, smem);
}
#endif

extern "C" void kernel_launch(void* const* d_in, const int* in_sizes, int n_in, void* d_out, int out_size, void* d_ws,
                              size_t ws_size, hipStream_t stream) {
  Params p{};
  const float** pp = (const float**)&p;
  for (int i = 0; i < 23; ++i) pp[i] = (const float*)d_in[i];
  p.out = (float*)d_out;
  p.ws = (char*)d_ws;
#if MULTI_LAUNCH
  launch_phase<0>(p, stream);
#ifdef DBL_P0
  launch_phase<0>(p, stream);
#endif
 launch_phase<1>(p, stream); launch_phase<2>(p, stream); launch_phase<3>(p, stream);
#ifdef DBL_HY
  launch_phase<3>(p, stream);
#endif

  launch_phase<4>(p, stream); launch_phase<5>(p, stream);
#ifdef DBL_P5
  launch_phase<5>(p, stream);
#endif
 launch_phase<6>(p, stream); launch_phase<7>(p, stream);
  launch_phase<8>(p, stream); launch_phase<9>(p, stream); launch_phase<10>(p, stream);
#else
  static int grid_blocks = 0;
  if (!grid_blocks) {
    int dev = 0, cus = 0, per_cu = 0;
    hipGetDevice(&dev);
    hipDeviceGetAttribute(&cus, hipDeviceAttributeMultiprocessorCount, dev);
    hipOccupancyMaxActiveBlocksPerMultiprocessor(&per_cu, mega_kernel, 256, 0);
    if (per_cu > 2) per_cu = 2;
    if (per_cu < 1) per_cu = 1;
#ifdef FORCE2
    per_cu = 2;
#endif
    grid_blocks = cus * per_cu;
  }
  hipMemsetAsync((char*)d_ws + OFF_BAR, 0, XCD_BAR_WORDS * 4, stream);
  void* args[] = {&p};
  hipError_t e = hipLaunchCooperativeKernel((void*)mega_kernel, dim3(grid_blocks), dim3(256), args, 0, stream);
  if (e != hipSuccess) fprintf(stderr, "cooperative launch failed: %s (grid %d)\n", hipGetErrorString(e), grid_blocks);
#endif
}
#if defined(__HIP_DEVICE_COMPILE__)
#pragma clang attribute pop
#endif
```

```cpp
#if defined(__HIP_DEVICE_COMPILE__)
#pragma clang attribute push(__attribute__((target("no-packed-fp32-ops"))), apply_to = function)
#endif
#include <hip/hip_runtime.h>
#include <hip/hip_cooperative_groups.h>
#include <cstdio>
namespace cg = cooperative_groups;

#ifndef MULTI_LAUNCH
#define MULTI_LAUNCH 0
#endif

typedef unsigned short u16;
using bf16x8 = __attribute__((ext_vector_type(8))) short;
using f32x16 = __attribute__((ext_vector_type(16))) float;
#define DI __device__ __forceinline__
#define MFMA(a, b, c) __builtin_amdgcn_mfma_f32_32x32x16_bf16((a), (b), (c), 0, 0, 0)

constexpr int SEQ = 4096, DM = 1024, NTOK = 16384, NIN = 3600, NINP = 3712, DFF = 4096;
constexpr float EPS = 1e-6f;
constexpr size_t MiB = 1u << 20;
constexpr size_t OFF_WINT = 0, OFF_WOUTT = 8 * MiB, OFF_W1T = 10 * MiB, OFF_W2T = 18 * MiB;
constexpr size_t OFF_XN = 26 * MiB, OFF_QA = 26 * MiB, OFF_KA = 42 * MiB;
constexpr size_t OFF_FILT = 58 * MiB, OFF_QKPRE = 90 * MiB, OFF_A2 = 90 * MiB;
constexpr size_t OFF_HYT = 122 * MiB, OFF_VT = 170 * MiB, OFF_OG = 186 * MiB, OFF_GATES = 202 * MiB;
constexpr size_t OFF_NL = 203 * MiB, OFF_MLOC = 203 * MiB + 512 * 1024, OFF_GSUM = OFF_MLOC + 4096, OFF_MS = OFF_GSUM + 4096;
constexpr size_t OFF_KAT = 205 * MiB, OFF_Z2T = 221 * MiB;
constexpr size_t OFF_TW = 204 * MiB, OFF_BAR = 254 * MiB;
constexpr size_t OFF_X1 = 26 * MiB, OFF_HM = 90 * MiB, OFF_H = 122 * MiB;

struct Params {
  const float *x, *norm_mix_pre, *norm_mix_post, *norm_mlp_pre, *norm_mlp_post, *w_in, *b_gates, *conv_w, *conv_b,
      *mlstm_norm_w, *hyena_norm_w, *filt_w1, *filt_b1, *filt_w2, *filt_b2, *filt_w3, *filt_b3, *filt_w4, *filt_freq,
      *filt_bias, *w_out, *w_mlp_in, *w_mlp_out;
  float* out;
  char* ws;
};

DI u16 f2bf(float x) { const __bf16 b = (__bf16)x; return __builtin_bit_cast(u16, b); }
DI float bf2f(u16 v) { return __uint_as_float(((unsigned)v) << 16); }
DI int opaque_tid() { int t = threadIdx.x; asm volatile("" : "+v"(t)); return t; }
DI int crow(int r, int hh) { return (r & 3) + 8 * (r >> 2) + 4 * hh; }
DI float log_sigmoid(float x) { return fminf(x, 0.f) - log1pf(expf(-fabsf(x))); }
DI float sigmoidf(float x) { return 1.f / (1.f + __expf(-x)); }
DI float red2pi(float x) {
  const float k = rintf(x * 0.15915494309189535f);
  float r = fmaf(-k, 6.28125f, x);
  return fmaf(-k, 1.9353071795864769e-3f, r);
}
DI float fsin(float x) { return sinf(x); }
DI float fcos(float x) { return cosf(x); }
DI bf16x8 pack8(const float* v) {
  bf16x8 r;
#pragma unroll
  for (int i = 0; i < 8; ++i) r[i] = (short)f2bf(v[i]);
  return r;
}
DI bf16x8 scale8(bf16x8 a, float s) {
  bf16x8 r;
#pragma unroll
  for (int i = 0; i < 8; ++i) r[i] = (short)f2bf(bf2f((u16)a[i]) * s);
  return r;
}

template <bool SWAP>
DI void gemm_core(const u16* __restrict__ A, const u16* __restrict__ Bt, int K, int m0, int n0, char* smem, f32x16 (&acc)[4][2]) {
  const int tid = opaque_tid(), lane = tid & 63, wave = tid >> 6, wr = wave >> 1, wc = wave & 1;
  const int lr = lane & 31, hh = lane >> 5;
#pragma unroll
  for (int i = 0; i < 4; ++i)
#pragma unroll
    for (int j = 0; j < 2; ++j)
#pragma unroll
      for (int r = 0; r < 16; ++r) acc[i][j][r] = 0.f;
  const int c = tid & 7, r0 = tid >> 3;
  const u16* Ag = A + (size_t)(m0 + r0) * K + c * 8;
  const u16* Bg = Bt + (size_t)(n0 + r0) * K + c * 8;
  const int soff = r0 * 128 + ((c ^ ((r0 >> 1) & 7)) << 4);
  char* As = smem;
  char* Bs = smem + 32768;
  uint4 ra0, ra1, ra2, ra3, ra4, ra5, ra6, ra7, rb0, rb1, rb2, rb3;
#define GLOAD_ALL(k0)                                                                                             \
  ra0 = *(const uint4*)(Ag + (size_t)(0) * K + (k0));   ra1 = *(const uint4*)(Ag + (size_t)(32) * K + (k0));      \
  ra2 = *(const uint4*)(Ag + (size_t)(64) * K + (k0));  ra3 = *(const uint4*)(Ag + (size_t)(96) * K + (k0));      \
  ra4 = *(const uint4*)(Ag + (size_t)(128) * K + (k0)); ra5 = *(const uint4*)(Ag + (size_t)(160) * K + (k0));     \
  ra6 = *(const uint4*)(Ag + (size_t)(192) * K + (k0)); ra7 = *(const uint4*)(Ag + (size_t)(224) * K + (k0));     \
  rb0 = *(const uint4*)(Bg + (size_t)(0) * K + (k0));   rb1 = *(const uint4*)(Bg + (size_t)(32) * K + (k0));      \
  rb2 = *(const uint4*)(Bg + (size_t)(64) * K + (k0));  rb3 = *(const uint4*)(Bg + (size_t)(96) * K + (k0));
  GLOAD_ALL(0)
  const int nk = K >> 6;
#pragma unroll 1
  for (int kt = 0; kt < nk; ++kt) {
    __syncthreads();
    *(uint4*)(As + soff + 0 * 4096) = ra0; *(uint4*)(As + soff + 1 * 4096) = ra1; *(uint4*)(As + soff + 2 * 4096) = ra2; *(uint4*)(As + soff + 3 * 4096) = ra3;
    *(uint4*)(As + soff + 4 * 4096) = ra4; *(uint4*)(As + soff + 5 * 4096) = ra5; *(uint4*)(As + soff + 6 * 4096) = ra6; *(uint4*)(As + soff + 7 * 4096) = ra7;
    *(uint4*)(Bs + soff + 0 * 4096) = rb0; *(uint4*)(Bs + soff + 1 * 4096) = rb1; *(uint4*)(Bs + soff + 2 * 4096) = rb2; *(uint4*)(Bs + soff + 3 * 4096) = rb3;
    __syncthreads();
    if (kt + 1 < nk) {
      const int k0 = (kt + 1) << 6;
      GLOAD_ALL(k0)
    }
#pragma unroll
    for (int kk = 0; kk < 4; ++kk) {
      bf16x8 a[4], b[2];
      const int cc = kk * 2 + hh;
#pragma unroll
      for (int i = 0; i < 4; ++i) {
        const int r = wr * 128 + i * 32 + lr;
        a[i] = *(const bf16x8*)(As + r * 128 + ((cc ^ ((r >> 1) & 7)) << 4));
      }
#pragma unroll
      for (int j = 0; j < 2; ++j) {
        const int r = wc * 64 + j * 32 + lr;
        b[j] = *(const bf16x8*)(Bs + r * 128 + ((cc ^ ((r >> 1) & 7)) << 4));
      }
#pragma unroll
      for (int i = 0; i < 4; ++i)
#pragma unroll
        for (int j = 0; j < 2; ++j) acc[i][j] = SWAP ? MFMA(b[j], a[i], acc[i][j]) : MFMA(a[i], b[j], acc[i][j]);
    }
  }
  __syncthreads();
}

DI void tile_map(int id, int ntn, int& mt, int& nt) {
  const int r = id >> 9, b = id & 511;
  const int x = b & 7, sidx = b >> 3;
  const int P = r * 8 + x;
  mt = (P & 7) * 8 + (sidx & 7);
  nt = (P >> 3) * 8 + (sidx >> 3);
}
DI int tile_count(int ntn) { return ((ntn + 7) >> 3) * 512; }

DI void transpose_tile(const float* __restrict__ src, int R, int C, u16* __restrict__ dst, int kt, int nt, char* smem) {
  float* tile = (float*)smem;
  const int tid = threadIdx.x;
  const int k0 = kt * 64, n0 = nt * 64;
#pragma unroll 4
  for (int it = 0; it < 16; ++it) {
    const int kk = it * 4 + (tid >> 6), nn = tid & 63;
    const int n = n0 + nn;
    tile[kk * 65 + nn] = (n < C) ? src[(size_t)(k0 + kk) * C + n] : 0.f;
  }
  __syncthreads();
#pragma unroll
  for (int it = 0; it < 2; ++it) {
    const int q = tid + 256 * it, nn = q >> 3, kc = q & 7;
    float o[8];
#pragma unroll
    for (int i = 0; i < 8; ++i) o[i] = tile[(kc * 8 + i) * 65 + nn];
    *(bf16x8*)(dst + (size_t)(n0 + nn) * R + k0 + kc * 8) = pack8(o);
  }
  __syncthreads();
}

DI float wave_sum(float v) {
#pragma unroll
  for (int o = 32; o; o >>= 1) v += __shfl_xor(v, o, 64);
  return v;
}

DI void filter_unit(const Params& p, int unit, char* smem) {
  float* sz = (float*)smem;
  float* hA = sz + 8 * 33 + 8;
  float* hB = hA + 8 * 64;
  float* hT = hB + 8 * 64;
  const int tid = opaque_tid();
  const int l0 = unit * 8;
  for (int idx = tid; idx < 8 * 33; idx += 256) {
    const int pp = idx / 33, f = idx - pp * 33;
    const float l = (float)(l0 + pp);
    float v;
    if (f == 0) v = l / 4095.f;
    else {
      const int jb = (f - 1) & 15;
      const float fj = 1e-4f + (float)jb * ((15.f - 1e-4f) / 15.f);
      const float ang = 6.283185307179586f * l / 4096.f;
      v = (f <= 16) ? fcos(fj * ang) : -fsin(fj * ang);
    }
    sz[idx] = v;
  }
  const int o = tid & 63, pq = tid >> 6;
  {
    const float bb = p.filt_b1[o], fr = p.filt_freq[o];
    __syncthreads();
    float s0 = bb, s1 = bb;
#pragma unroll 1
    for (int f0 = 0; f0 < 33; f0 += 11) {
      float wc[11];
#pragma unroll
      for (int f = 0; f < 11; ++f) wc[f] = p.filt_w1[(f0 + f) * 64 + o];
#pragma unroll
      for (int f = 0; f < 11; ++f) { s0 += sz[pq * 33 + f0 + f] * wc[f]; s1 += sz[(pq + 4) * 33 + f0 + f] * wc[f]; }
    }
    hA[pq * 64 + o] = fsin(fr * s0);
    hA[(pq + 4) * 64 + o] = fsin(fr * s1);
  }
  {
    const float bb = p.filt_b2[o], fr = p.filt_freq[64 + o];
    __syncthreads();
    float s0 = bb, s1 = bb;
#pragma unroll 1
    for (int k0 = 0; k0 < 64; k0 += 16) {
      float wc[16];
#pragma unroll
      for (int k = 0; k < 16; ++k) wc[k] = p.filt_w2[(k0 + k) * 64 + o];
#pragma unroll
      for (int k = 0; k < 16; ++k) { s0 += hA[pq * 64 + k0 + k] * wc[k]; s1 += hA[(pq + 4) * 64 + k0 + k] * wc[k]; }
    }
    hB[pq * 64 + o] = fsin(fr * s0);
    hB[(pq + 4) * 64 + o] = fsin(fr * s1);
  }
  {
    const float bb = p.filt_b3[o], fr = p.filt_freq[128 + o];
    __syncthreads();
    float s0 = bb, s1 = bb;
#pragma unroll 1
    for (int k0 = 0; k0 < 64; k0 += 16) {
      float wc[16];
#pragma unroll
      for (int k = 0; k < 16; ++k) wc[k] = p.filt_w3[(k0 + k) * 64 + o];
#pragma unroll
      for (int k = 0; k < 16; ++k) { s0 += hB[pq * 64 + k0 + k] * wc[k]; s1 += hB[(pq + 4) * 64 + k0 + k] * wc[k]; }
    }
    hT[o * 8 + pq] = fsin(fr * s0);
    hT[o * 8 + pq + 4] = fsin(fr * s1);
  }
  __syncthreads();
  float* filt = (float*)(p.ws + OFF_FILT);
  const float min_decay = -3.0701134573253944f, max_decay = -15.350567286626973f;
#pragma unroll 1
  for (int cc = 0; cc < 8; ++cc) {
    const int col = tid + 256 * cc;
    float acc[8];
#pragma unroll
    for (int q = 0; q < 8; ++q) acc[q] = 0.f;
#pragma unroll 1
    for (int k0 = 0; k0 < 64; k0 += 16) {
      float wc[16];
#pragma unroll
      for (int k = 0; k < 16; ++k) wc[k] = p.filt_w4[(k0 + k) * 2048 + col];
#pragma unroll
      for (int k = 0; k < 16; ++k) {
        const float4 h0 = *(const float4*)(hT + (k0 + k) * 8);
        const float4 h1 = *(const float4*)(hT + (k0 + k) * 8 + 4);
        acc[0] += h0.x * wc[k]; acc[1] += h0.y * wc[k]; acc[2] += h0.z * wc[k]; acc[3] += h0.w * wc[k];
        acc[4] += h1.x * wc[k]; acc[5] += h1.y * wc[k]; acc[6] += h1.z * wc[k]; acc[7] += h1.w * wc[k];
      }
    }
    const int ch = col & 511;
    const float delta = fabsf(min_decay + (float)ch * ((max_decay - min_decay) / 511.f));
#pragma unroll
    for (int q = 0; q < 8; ++q) {
      const float t = (float)(l0 + q) / 4095.f;
      acc[q] *= expf(-t * delta);
    }
    float4* dst = (float4*)(filt + (size_t)col * 4096 + l0);
    dst[0] = make_float4(acc[0], acc[1], acc[2], acc[3]);
    dst[1] = make_float4(acc[4], acc[5], acc[6], acc[7]);
  }
  __syncthreads();
}

DI void phase0(const Params& p, char* smem) {
  const int tid = threadIdx.x, lane = tid & 63, wave = tid >> 6;
  const int U_W = 32, U_F = 512, U_X = 1024, U_T1 = 58 * 16, U_T2 = 256, U_T3 = 1024, U_T4 = 1024;
  const int total = U_W + U_F + U_X + U_T1 + U_T2 + U_T3 + U_T4;
  for (int u = blockIdx.x; u < total; u += gridDim.x) {
    int v = u;
    if (v < U_W) {
      const int idx = v * 256 + tid;
      if (idx < 8191) {
        const int lh = 31 - __clz(idx + 1);
        const int h = 1 << lh, jj = idx + 1 - h;
        float2* twp = (float2*)(p.ws + OFF_TW);
        const float ang = -3.14159265358979f * (float)jj / (float)h;
        twp[idx] = make_float2(cosf(ang), sinf(ang));
      }
      continue;
    }
    v -= U_W;
    if (v < U_F) { filter_unit(p, v, smem); continue; }
    v -= U_F;
    if (v < U_X) {
      u16* xn = (u16*)(p.ws + OFF_XN);
#pragma unroll 4
      for (int rr = 0; rr < 4; ++rr) {
        const int row = v * 16 + wave * 4 + rr;
        const float4* xr = (const float4*)(p.x + (size_t)row * DM);
        float4 xv[4];
        float ss = 0.f;
#pragma unroll
        for (int i = 0; i < 4; ++i) {
          xv[i] = xr[lane + 64 * i];
          ss += xv[i].x * xv[i].x + xv[i].y * xv[i].y + xv[i].z * xv[i].z + xv[i].w * xv[i].w;
        }
        ss = wave_sum(ss);
        const float rs = rsqrtf(ss * (1.f / DM) + EPS);
#pragma unroll
        for (int i = 0; i < 4; ++i) {
          const float4 w = ((const float4*)p.norm_mix_pre)[lane + 64 * i];
          ushort4 o;
          o.x = f2bf(xv[i].x * rs * w.x); o.y = f2bf(xv[i].y * rs * w.y); o.z = f2bf(xv[i].z * rs * w.z); o.w = f2bf(xv[i].w * rs * w.w);
          *(ushort4*)(xn + (size_t)row * DM + (lane + 64 * i) * 4) = o;
        }
      }
      continue;
    }
    v -= U_X;
    if (v < U_T1) { transpose_tile(p.w_in, DM, NIN, (u16*)(p.ws + OFF_WINT), v & 15, v >> 4, smem); continue; }
    v -= U_T1;
    if (v < U_T2) { transpose_tile(p.w_out, DM, DM, (u16*)(p.ws + OFF_WOUTT), v & 15, v >> 4, smem); continue; }
    v -= U_T2;
    if (v < U_T3) { transpose_tile(p.w_mlp_in, DM, DFF, (u16*)(p.ws + OFF_W1T), v & 15, v >> 4, smem); continue; }
    v -= U_T3;
    transpose_tile(p.w_mlp_out, DFF, DM, (u16*)(p.ws + OFF_W2T), v & 63, v >> 6, smem);
  }
}

DI void wave_lds_sync() { asm volatile("s_waitcnt lgkmcnt(0)" ::: "memory"); __builtin_amdgcn_wave_barrier(); }
template <int MODE>
DI void stage_tile_ns(const f32x16 (&acc)[4][2], char* wl, int lr, int hh) {
#pragma unroll
  for (int i = 0; i < 4; ++i)
#pragma unroll
    for (int j = 0; j < 2; ++j)
#pragma unroll
      for (int r = 0; r < 16; ++r) {
        float v = acc[i][j][r];
        if (MODE == 1) v = sigmoidf(v);
        if (MODE == 2) { v = fmaxf(v, 0.f); v = v * v; }
        *(u16*)(wl + (i * 32 + crow(r, hh)) * 128 + (j * 32 + lr) * 2) = f2bf(v);
      }
}
DI void stage_tile_sw(const f32x16 (&acc)[4][2], char* wl, int lr, int hh) {
#pragma unroll
  for (int i = 0; i < 4; ++i)
#pragma unroll
    for (int j = 0; j < 2; ++j)
#pragma unroll
      for (int r = 0; r < 16; ++r) *(u16*)(wl + (j * 32 + crow(r, hh)) * 256 + (i * 32 + lr) * 2) = f2bf(acc[i][j][r]);
}
DI void flush_tile_ns(const char* wl, u16* dst, size_t pitch, int lane) {
#pragma unroll 4
  for (int it = 0; it < 16; ++it) {
    const int q = lane + 64 * it, row = q >> 3, c8 = q & 7;
    *(uint4*)(dst + (size_t)row * pitch + c8 * 8) = *(const uint4*)(wl + row * 128 + c8 * 16);
  }
}

DI void phase1(const Params& p, char* smem) {
  const int tid = threadIdx.x, lane = tid & 63, wave = tid >> 6, wr = wave >> 1, wc = wave & 1, lr = lane & 31, hh = lane >> 5;
  const u16* xn = (const u16*)(p.ws + OFF_XN);
  const u16* wt = (const u16*)(p.ws + OFF_WINT);
  u16* qkpre = (u16*)(p.ws + OFF_QKPRE);
  u16* hyT = (u16*)(p.ws + OFF_HYT);
  u16* vT = (u16*)(p.ws + OFF_VT);
  u16* og = (u16*)(p.ws + OFF_OG);
  float* gates = (float*)(p.ws + OFF_GATES);
  const int ntn = 29, ntiles = tile_count(ntn);
  for (int id = blockIdx.x; id < ntiles; id += gridDim.x) {
    int mt, nt;
    tile_map(id, ntn, mt, nt);
    if (nt >= ntn) continue;
    const int m0 = mt * 256, n0 = nt * 128;
    f32x16 acc[4][2];
    const bool swap = (nt >= 8 && nt < 24);
    if (swap) gemm_core<true>(xn, wt, DM, m0, n0, smem, acc);
    else gemm_core<false>(xn, wt, DM, m0, n0, smem, acc);
    char* wl = smem + wave * 16384;
    if (!swap) {
      if (nt < 28) {
        if (nt < 8) stage_tile_ns<0>(acc, wl, lr, hh); else stage_tile_ns<1>(acc, wl, lr, hh);
        wave_lds_sync();
        const size_t row0 = (size_t)(m0 + wr * 128);
        if (nt < 8) flush_tile_ns(wl, qkpre + row0 * 1024 + n0 + wc * 64, 1024, lane);
        else flush_tile_ns(wl, og + row0 * 512 + (n0 - 3072) + wc * 64, 512, lane);
      } else {
#pragma unroll
        for (int i = 0; i < 4; ++i)
#pragma unroll
          for (int r = 0; r < 16; ++r) {
            const int row = m0 + wr * 128 + i * 32 + crow(r, hh);
            if (wc == 0 && lr < 16) gates[(size_t)row * 16 + lr] = acc[i][0][r];
          }
      }
    } else {
      stage_tile_sw(acc, wl, lr, hh);
      wave_lds_sync();
      const int mrow = m0 + wr * 128, b = mrow >> 12, t0 = mrow & 4095;
#pragma unroll 4
      for (int it = 0; it < 16; ++it) {
        const int q = lane + 64 * it, chl = q >> 4, c16 = q & 15;
        const int n = n0 + wc * 64 + chl;
        u16* dst;
        if (nt < 20) { const int cc = n - 1024, g = cc >> 9, ch = cc & 511; dst = hyT + ((size_t)((g * 4 + b) * 512 + ch)) * 4096; }
        else dst = vT + ((size_t)(b * 512 + (n - 2560))) * 4096;
        *(uint4*)(dst + t0 + c16 * 8) = *(const uint4*)(wl + chl * 256 + c16 * 16);
      }
    }
  }
}

DI void phase_qk(const Params& p, char* smem) {
  const int tid = opaque_tid();
  const int cg = tid & 31, rg = tid >> 5;
  const u16* qkpre = (const u16*)(p.ws + OFF_QKPRE);
  u16* qa = (u16*)(p.ws + OFF_QA);
  u16* ka = (u16*)(p.ws + OFF_KA);
  u16* kaT = (u16*)(p.ws + OFF_KAT);
  for (int u = blockIdx.x; u < 1024; u += gridDim.x) {
    const int ct = u & 3, tt = u >> 2;
    const int C0 = ct * 256 + cg * 8;
    const int Tb = tt * 64 + rg * 8;
    const int tb = Tb & 4095;
    float w0[8], w1[8], w2[8], cb[8];
    {
      const float4 a0 = *(const float4*)(p.conv_w + C0), a1 = *(const float4*)(p.conv_w + C0 + 4);
      const float4 b0 = *(const float4*)(p.conv_w + 2560 + C0), b1 = *(const float4*)(p.conv_w + 2560 + C0 + 4);
      const float4 c0 = *(const float4*)(p.conv_w + 5120 + C0), c1 = *(const float4*)(p.conv_w + 5120 + C0 + 4);
      const float4 d0 = *(const float4*)(p.conv_b + C0), d1 = *(const float4*)(p.conv_b + C0 + 4);
      w0[0] = a0.x; w0[1] = a0.y; w0[2] = a0.z; w0[3] = a0.w; w0[4] = a1.x; w0[5] = a1.y; w0[6] = a1.z; w0[7] = a1.w;
      w1[0] = b0.x; w1[1] = b0.y; w1[2] = b0.z; w1[3] = b0.w; w1[4] = b1.x; w1[5] = b1.y; w1[6] = b1.z; w1[7] = b1.w;
      w2[0] = c0.x; w2[1] = c0.y; w2[2] = c0.z; w2[3] = c0.w; w2[4] = c1.x; w2[5] = c1.y; w2[6] = c1.z; w2[7] = c1.w;
      cb[0] = d0.x; cb[1] = d0.y; cb[2] = d0.z; cb[3] = d0.w; cb[4] = d1.x; cb[5] = d1.y; cb[6] = d1.z; cb[7] = d1.w;
    }
    bf16x8 rows[10];
    const u16* src = qkpre + (size_t)Tb * 1024 + C0;
#pragma unroll
    for (int r = 0; r < 10; ++r) {
      const int t = tb + r - 1;
      bf16x8 z;
#pragma unroll
      for (int i = 0; i < 8; ++i) z[i] = 0;
      rows[r] = (t >= 0 && t <= 4095) ? *(const bf16x8*)(src + (ptrdiff_t)(r - 1) * 1024) : z;
    }
    const bool isk = C0 >= 512;
    bf16x8 tr[8];
#pragma unroll
    for (int r = 0; r < 8; ++r) {
      bf16x8 o;
#pragma unroll
      for (int i = 0; i < 8; ++i) {
        const float val = w0[i] * bf2f((u16)rows[r][i]) + w1[i] * bf2f((u16)rows[r + 1][i]) + w2[i] * bf2f((u16)rows[r + 2][i]) + cb[i];
        float sv = val * sigmoidf(val);
        if (isk) sv *= 0.08838834764831845f;
        o[i] = (short)f2bf(sv);
        tr[i][r] = o[i];
      }
      if (!isk) *(bf16x8*)(qa + (size_t)(Tb + r) * 512 + C0) = o;
      else *(bf16x8*)(ka + (size_t)(Tb + r) * 512 + (C0 - 512)) = o;
    }
    if (isk) {
      const int b = Tb >> 12;
#pragma unroll
      for (int i = 0; i < 8; ++i) *(bf16x8*)(kaT + ((size_t)(b * 512 + (C0 - 512) + i)) * 4096 + tb) = tr[i];
    }
  }
}

DI float lz(float v) { asm volatile("" : "+v"(v)); return v; }
DI float2 mk2(float a, float b) { return make_float2(a, b); }
DI float2 cmul(float2 a, float2 w) { return mk2(a.x * w.x - a.y * w.y, a.x * w.y + a.y * w.x); }
DI float2 cmulc(float2 a, float2 w) { return mk2(a.x * w.x + a.y * w.y, a.y * w.x - a.x * w.y); }
DI int lx(int idx) { const int sw = (idx >> 5) & 3; return idx ^ (sw << 3) ^ (sw << 1); }
template <bool LX>
DI void addr4(int base, int q, int k, int& a0, int& a1, int& a2, int& a3) {
  if (!LX) { a0 = base; a1 = base + q; a2 = base + 2 * q; a3 = base + 3 * q; }
  else if (q == 8) {
    const int sw = (k >> 3) & 3, b2 = base ^ (sw << 1);
    a0 = b2 + (sw << 3); a1 = b2 + ((1 ^ sw) << 3); a2 = b2 + ((2 ^ sw) << 3); a3 = b2 + ((3 ^ sw) << 3);
  } else {
    a0 = base; a1 = (base ^ 10) + 32; a2 = (base ^ 20) + 64; a3 = (base ^ 30) + 96;
  }
}
template <int NW, bool INV, bool INLX = false, bool OUTLX = false, bool PRUNE = false>
DI void r4_pass(float2* x, int tid, int q, const float2* __restrict__ t1, const float2* __restrict__ t2) {
  constexpr int NL = NW > 4 ? 4 : NW;
  constexpr int NB = NW > 4 ? 2 : 1;
  constexpr int CNT = 8 / NB;
#pragma unroll 1
  for (int bt = 0; bt < NB; ++bt) {
    float2 w1[NL], w2[NL];
#pragma unroll
    for (int n = 0; n < NL; ++n) { const int j = (tid + ((bt * CNT + n) << 8)) & (q - 1); w1[n] = t1[j]; w2[n] = t2[j]; }
    if (bt == 0) __syncthreads();
#pragma unroll(NL == 4 ? 4 : 2)
    for (int ii = 0; ii < CNT; ++ii) {
      const int k = tid + ((bt * CNT + ii) << 8);
      const int j = k & (q - 1);
      int base = ((k - j) << 2) + j;
      asm volatile("" : "+v"(base));
      const float2 ww1 = w1[ii % NL], ww2 = w2[ii % NL];
      int i0_, i1_, i2_, i3_, o0_, o1_, o2_, o3_;
      addr4<INLX>(base, q, k, i0_, i1_, i2_, i3_);
      addr4<OUTLX>(base, q, k, o0_, o1_, o2_, o3_);
      const float2 zz = make_float2(0.f, 0.f);
      const float2 x0 = x[i0_], x1 = x[i1_];
      const float2 x2 = (PRUNE && !INV) ? zz : x[i2_], x3 = (PRUNE && !INV) ? zz : x[i3_];
      if (!INV) {
        const float2 a0 = mk2(x0.x + x2.x, x0.y + x2.y);
        const float2 a1 = mk2(x1.x + x3.x, x1.y + x3.y);
        const float2 d02 = mk2(x0.x - x2.x, x0.y - x2.y);
        const float2 d13 = mk2(x1.y - x3.y, x3.x - x1.x);
        const float2 a2 = cmul(d02, ww1);
        const float2 a3 = cmul(d13, ww1);
        x[o0_] = mk2(a0.x + a1.x, a0.y + a1.y);
        x[o1_] = cmul(mk2(a0.x - a1.x, a0.y - a1.y), ww2);
        x[o2_] = mk2(a2.x + a3.x, a2.y + a3.y);
        x[o3_] = cmul(mk2(a2.x - a3.x, a2.y - a3.y), ww2);
      } else {
        const float2 b1 = cmulc(x1, ww2), b3 = cmulc(x3, ww2);
        const float2 a0 = mk2(x0.x + b1.x, x0.y + b1.y);
        const float2 a1 = mk2(x0.x - b1.x, x0.y - b1.y);
        const float2 a2 = mk2(x2.x + b3.x, x2.y + b3.y);
        const float2 a3 = mk2(x2.x - b3.x, x2.y - b3.y);
        const float2 c2 = cmulc(a2, ww1);
        const float2 c3t = cmulc(a3, ww1);
        const float2 c3 = mk2(-c3t.y, c3t.x);
        x[o0_] = mk2(a0.x + c2.x, a0.y + c2.y);
        if (!PRUNE) x[o2_] = mk2(a0.x - c2.x, a0.y - c2.y);
        x[o1_] = mk2(a1.x + c3.x, a1.y + c3.y);
        if (!PRUNE) x[o3_] = mk2(a1.x - c3.x, a1.y - c3.y);
      }
    }
  }
}
template <bool INV>
DI void r8_tail(float2* x, int tid) {
  const float R = 0.70710678118654752f;
#pragma unroll 2
  for (int i = 0; i < 4; ++i) {
    const int G = tid + (i << 8);
    const int sw = (G >> 2) & 3;
    const int blk = (G << 3) ^ (sw << 3);
    float4* p0 = (float4*)(x + blk + ((0 ^ sw) << 1));
    float4* p1 = (float4*)(x + blk + ((1 ^ sw) << 1));
    float4* p2 = (float4*)(x + blk + ((2 ^ sw) << 1));
    float4* p3 = (float4*)(x + blk + ((3 ^ sw) << 1));
    const float4 v0 = *p0, v1 = *p1, v2 = *p2, v3 = *p3;
    float2 e0 = make_float2(v0.x, v0.y), e1 = make_float2(v0.z, v0.w), e2 = make_float2(v1.x, v1.y), e3 = make_float2(v1.z, v1.w);
    float2 e4 = make_float2(v2.x, v2.y), e5 = make_float2(v2.z, v2.w), e6 = make_float2(v3.x, v3.y), e7 = make_float2(v3.z, v3.w);
    if (!INV) {
      const float2 s0 = mk2(e0.x + e4.x, e0.y + e4.y), d0 = mk2(e0.x - e4.x, e0.y - e4.y);
      const float2 s1 = mk2(e1.x + e5.x, e1.y + e5.y), t1 = mk2(e1.x - e5.x, e1.y - e5.y);
      const float2 s2 = mk2(e2.x + e6.x, e2.y + e6.y), t2 = mk2(e2.x - e6.x, e2.y - e6.y);
      const float2 s3 = mk2(e3.x + e7.x, e3.y + e7.y), t3 = mk2(e3.x - e7.x, e3.y - e7.y);
      const float2 d1 = mk2((t1.x + t1.y) * R, (t1.y - t1.x) * R);
      const float2 d2 = mk2(t2.y, -t2.x);
      const float2 d3 = mk2((t3.y - t3.x) * R, -(t3.x + t3.y) * R);
      const float2 a0 = mk2(s0.x + s2.x, s0.y + s2.y), a2 = mk2(s0.x - s2.x, s0.y - s2.y);
      const float2 a1 = mk2(s1.x + s3.x, s1.y + s3.y), u3 = mk2(s1.x - s3.x, s1.y - s3.y);
      const float2 a3 = mk2(u3.y, -u3.x);
      const float2 a4 = mk2(d0.x + d2.x, d0.y + d2.y), a6 = mk2(d0.x - d2.x, d0.y - d2.y);
      const float2 a5 = mk2(d1.x + d3.x, d1.y + d3.y), u7 = mk2(d1.x - d3.x, d1.y - d3.y);
      const float2 a7 = mk2(u7.y, -u7.x);
      *p0 = make_float4(a0.x + a1.x, a0.y + a1.y, a0.x - a1.x, a0.y - a1.y);
      *p1 = make_float4(a2.x + a3.x, a2.y + a3.y, a2.x - a3.x, a2.y - a3.y);
      *p2 = make_float4(a4.x + a5.x, a4.y + a5.y, a4.x - a5.x, a4.y - a5.y);
      *p3 = make_float4(a6.x + a7.x, a6.y + a7.y, a6.x - a7.x, a6.y - a7.y);
    } else {
      const float2 z0 = mk2(e0.x + e1.x, e0.y + e1.y), z1 = mk2(e0.x - e1.x, e0.y - e1.y);
      const float2 z2 = mk2(e2.x + e3.x, e2.y + e3.y), z3 = mk2(e2.x - e3.x, e2.y - e3.y);
      const float2 z4 = mk2(e4.x + e5.x, e4.y + e5.y), z5 = mk2(e4.x - e5.x, e4.y - e5.y);
      const float2 z6 = mk2(e6.x + e7.x, e6.y + e7.y), z7 = mk2(e6.x - e7.x, e6.y - e7.y);
      const float2 b3 = mk2(-z3.y, z3.x), b7 = mk2(-z7.y, z7.x);
      const float2 y0 = mk2(z0.x + z2.x, z0.y + z2.y), y2 = mk2(z0.x - z2.x, z0.y - z2.y);
      const float2 y1 = mk2(z1.x + b3.x, z1.y + b3.y), y3 = mk2(z1.x - b3.x, z1.y - b3.y);
      const float2 y4 = mk2(z4.x + z6.x, z4.y + z6.y), y6 = mk2(z4.x - z6.x, z4.y - z6.y);
      const float2 y5 = mk2(z5.x + b7.x, z5.y + b7.y), y7 = mk2(z5.x - b7.x, z5.y - b7.y);
      const float2 c4 = y4;
      const float2 c5 = mk2((y5.x - y5.y) * R, (y5.x + y5.y) * R);
      const float2 c6 = mk2(-y6.y, y6.x);
      const float2 c7 = mk2(-(y7.x + y7.y) * R, (y7.x - y7.y) * R);
      *p0 = make_float4(y0.x + c4.x, y0.y + c4.y, y1.x + c5.x, y1.y + c5.y);
      *p1 = make_float4(y2.x + c6.x, y2.y + c6.y, y3.x + c7.x, y3.y + c7.y);
      *p2 = make_float4(y0.x - c4.x, y0.y - c4.y, y1.x - c5.x, y1.y - c5.y);
      *p3 = make_float4(y2.x - c6.x, y2.y - c6.y, y3.x - c7.x, y3.y - c7.y);
    }
  }
}
template <bool DATA = false>
DI void fft_fwd(float2* x, int tid, const float2* __restrict__ tw) {
  r4_pass<8, false, false, false, DATA>(x, tid, 2048, tw + 4095, tw + 2047);
  r4_pass<2, false>(x, tid, 512, tw + 1023, tw + 511);
  r4_pass<1, false>(x, tid, 128, tw + 255, tw + 127);
  r4_pass<1, false, false, true>(x, tid, 32, tw + 63, tw + 31);
  r4_pass<1, false, true, true>(x, tid, 8, tw + 15, tw + 7);
  __syncthreads();
  r8_tail<false>(x, tid);
  __syncthreads();
}
template <bool DATA = false>
DI void fft_inv(float2* x, int tid, const float2* __restrict__ tw) {
  __syncthreads();
  r8_tail<true>(x, tid);
  r4_pass<1, true, true, true>(x, tid, 8, tw + 15, tw + 7);
  r4_pass<1, true, true, false>(x, tid, 32, tw + 63, tw + 31);
  r4_pass<1, true>(x, tid, 128, tw + 255, tw + 127);
  r4_pass<2, true>(x, tid, 512, tw + 1023, tw + 511);
  r4_pass<8, true, false, false, DATA>(x, tid, 2048, tw + 4095, tw + 2047);
  __syncthreads();
}

DI float hy_conv(const u16* __restrict__ pr, int t, float w0, float w1, float w2, float cb) {
  const float a = t > 0 ? bf2f(pr[t - 1]) : 0.f;
  const float b = bf2f(pr[t]);
  const float c = t < 4095 ? bf2f(pr[t + 1]) : 0.f;
  return w0 * a + w1 * b + w2 * c + cb;
}

DI void hy_conv4(const u16* __restrict__ pr, int t0, float w0, float w1, float w2, float cb, float (&o)[4]) {
  const ushort4 c = *(const ushort4*)(pr + t0);
  const float pm = t0 > 0 ? bf2f(pr[t0 - 1]) : 0.f;
  const float pn = t0 + 4 < 4096 ? bf2f(pr[t0 + 4]) : 0.f;
  const float x0 = bf2f(c.x), x1 = bf2f(c.y), x2 = bf2f(c.z), x3 = bf2f(c.w);
  o[0] = w0 * pm + w1 * x0 + w2 * x1 + cb;
  o[1] = w0 * x0 + w1 * x1 + w2 * x2 + cb;
  o[2] = w0 * x1 + w1 * x2 + w2 * x3 + cb;
  o[3] = w0 * x2 + w1 * x3 + w2 * pn + cb;
}

DI void hyena_unit(const Params& p, int ch, char* smem) {
  float2* buf = (float2*)smem;
  const int tid = opaque_tid();
  const u16* hyT = (const u16*)(p.ws + OFF_HYT);
  const float* filt = (const float*)(p.ws + OFF_FILT);
  float* z2T = (float*)(p.ws + OFF_Z2T);
  const float2* tw = (const float2*)(p.ws + OFF_TW);
  float2 Kr[32];
  float* k1buf_base = (float*)(p.ws + OFF_FILT);
  {
    const float* kf0 = filt + (size_t)(0 * 512 + ch) * 4096;
    const float* kf1 = filt + (size_t)(1 * 512 + ch) * 4096;
    const float* kb0 = filt + (size_t)(2 * 512 + ch) * 4096;
    const float* kb1 = filt + (size_t)(3 * 512 + ch) * 4096;
    const float fb0 = p.filt_bias[ch], fb1 = p.filt_bias[512 + ch];
    __syncthreads();
#pragma unroll
    for (int g = 0; g < 4; ++g) {
      const int n0 = g * 1024 + tid * 4;
      float4 v0 = *(const float4*)(kf0 + n0), v1 = *(const float4*)(kf1 + n0);
      if (n0 == 0) { v0.x += fb0; v1.x += fb1; }
      const float4 r0 = *(const float4*)(kb0 + 4092 - n0), r1 = *(const float4*)(kb1 + 4092 - n0);
      const float e00 = (n0 == 0) ? 0.f : kb0[4096 - n0], e01 = (n0 == 0) ? 0.f : kb1[4096 - n0];
      *(float4*)(buf + n0) = make_float4(v0.x, v1.x, v0.y, v1.y);
      *(float4*)(buf + n0 + 2) = make_float4(v0.z, v1.z, v0.w, v1.w);
      *(float4*)(buf + 4096 + n0) = make_float4(e00, e01, r0.w, r1.w);
      *(float4*)(buf + 4096 + n0 + 2) = make_float4(r0.z, r1.z, r0.y, r1.y);
    }
    fft_fwd(buf, tid, tw);
    const float sc = 0.5f / 8192.f;
#pragma unroll
    for (int j = 0; j < 32; ++j) {
      const int P = tid + 256 * j;
      const int f = (int)(__brev((unsigned)lx(P)) >> 19);
      const int Pq = lx((int)(__brev((unsigned)((8192 - f) & 8191)) >> 19));
      const float2 zp = buf[P], zq = buf[Pq];
      Kr[j] = make_float2(sc * (zp.x + zq.x), sc * (zp.y - zq.y));
      const float2 k1 = make_float2(sc * (zp.y + zq.y), sc * (zq.x - zp.x));
      *(float2*)(k1buf_base + ((size_t)((P >> 11) * 512 + ch)) * 4096 + (P & 2047) * 2) = k1;
    }
  }
#pragma unroll 1
  for (int ord = 0; ord < 2; ++ord) {
    if (ord == 1) {
#pragma unroll
      for (int j = 0; j < 32; ++j) {
        const int P = tid + 256 * j;
        Kr[j] = *(const float2*)(k1buf_base + ((size_t)((P >> 11) * 512 + ch)) * 4096 + (P & 2047) * 2);
      }
    }
    const int gcol = 1024 + (1 + ord) * 512 + ch;
    const float gw0 = p.conv_w[gcol], gw1 = p.conv_w[2560 + gcol], gw2 = p.conv_w[5120 + gcol], gcb = p.conv_b[gcol];
    const int vcol = 1024 + ch;
    const float vw0 = p.conv_w[vcol], vw1 = p.conv_w[2560 + vcol], vw2 = p.conv_w[5120 + vcol], vcb = p.conv_b[vcol];
#pragma unroll 1
    for (int pr = 0; pr < 2; ++pr) {
      const int b0 = 2 * pr, b1 = 2 * pr + 1;
      __syncthreads();
      if (ord == 0) {
        const u16* u0 = hyT + ((size_t)((0 * 4 + b0) * 512 + ch)) * 4096;
        const u16* u1 = hyT + ((size_t)((0 * 4 + b1) * 512 + ch)) * 4096;
#pragma unroll
        for (int g = 0; g < 4; ++g) {
          const int t0 = g * 1024 + tid * 4;
          float a[4], b[4];
          hy_conv4(u0, t0, vw0, vw1, vw2, vcb, a);
          hy_conv4(u1, t0, vw0, vw1, vw2, vcb, b);
          *(float4*)(buf + t0) = make_float4(a[0], b[0], a[1], b[1]);
          *(float4*)(buf + t0 + 2) = make_float4(a[2], b[2], a[3], b[3]);
        }
      } else {
        const float* u0 = z2T + ((size_t)(b0 * 512 + ch)) * 4096;
        const float* u1 = z2T + ((size_t)(b1 * 512 + ch)) * 4096;
#pragma unroll
        for (int g = 0; g < 4; ++g) {
          const int t0 = g * 1024 + tid * 4;
          const float4 a = *(const float4*)(u0 + t0);
          const float4 b = *(const float4*)(u1 + t0);
          *(float4*)(buf + t0) = make_float4(a.x, b.x, a.y, b.y);
          *(float4*)(buf + t0 + 2) = make_float4(a.z, b.z, a.w, b.w);
        }
      }
      fft_fwd<true>(buf, tid, tw);
#pragma unroll
      for (int j = 0; j < 32; ++j) {
        const float2 v = buf[tid + 256 * j];
        buf[tid + 256 * j] = make_float2(v.x * Kr[j].x - v.y * Kr[j].y, v.x * Kr[j].y + v.y * Kr[j].x);
      }
      fft_inv<true>(buf, tid, tw);
      const u16* g0 = hyT + ((size_t)(((1 + ord) * 4 + b0) * 512 + ch)) * 4096;
      const u16* g1 = hyT + ((size_t)(((1 + ord) * 4 + b1) * 512 + ch)) * 4096;
      float* o0 = z2T + ((size_t)(b0 * 512 + ch)) * 4096;
      float* o1 = z2T + ((size_t)(b1 * 512 + ch)) * 4096;
#pragma unroll
      for (int g = 0; g < 4; ++g) {
        const int t0 = g * 1024 + tid * 4;
        const float4 y01 = *(const float4*)(buf + t0);
        const float4 y23 = *(const float4*)(buf + t0 + 2);
        float ga[4], gb[4];
        hy_conv4(g0, t0, gw0, gw1, gw2, gcb, ga);
        hy_conv4(g1, t0, gw0, gw1, gw2, gcb, gb);
        *(float4*)(o0 + t0) = make_float4(ga[0] * y01.x, ga[1] * y01.z, ga[2] * y23.x, ga[3] * y23.z);
        *(float4*)(o1 + t0) = make_float4(gb[0] * y01.y, gb[1] * y01.w, gb[2] * y23.y, gb[3] * y23.w);
      }
    }
  }
  __syncthreads();
}

DI void mlstm_local_unit(const Params& p, int u, char* smem) {
  float* s_gi = (float*)smem;
  float* s_lf = s_gi + 128;
  float* s_a = s_lf + 128;
  float* s_w = s_a + 128;
  const int tid = opaque_tid(), lane = tid & 63, wave = tid >> 6, lr = lane & 31, hh = lane >> 5;
  const int j = u & 31, dir = (u >> 5) & 1, bh = u >> 6, h = bh & 3, b = bh >> 2;
  const int T0 = b * 4096 + j * 128;
  const float* gates = (const float*)(p.ws + OFF_GATES);
  const u16* vT = (const u16*)(p.ws + OFF_VT);
  const u16* kaT = (const u16*)(p.ws + OFF_KAT);
  float* CL = p.out;
  float* nl = (float*)(p.ws + OFF_NL);
  float* mloc = (float*)(p.ws + OFF_MLOC);
  float* gsum = (float*)(p.ws + OFF_GSUM);
  __syncthreads();
  if (tid < 128) {
    const int T = T0 + tid;
    s_gi[tid] = gates[(size_t)T * 16 + dir * 8 + h] + p.b_gates[dir * 8 + h];
    s_lf[tid] = log_sigmoid(gates[(size_t)T * 16 + dir * 8 + 4 + h] + p.b_gates[dir * 8 + 4 + h]);
  }
  __syncthreads();
  float gtot = 0.f;
  if (tid < 128) {
    float pre = 0.f;
#pragma unroll 4
    for (int m = 0; m < 128; ++m) {
      const float v = s_lf[m];
      if (m < tid) pre += v;
      gtot += v;
    }
    s_a[tid] = (dir == 0) ? (gtot - pre - s_lf[tid] + s_gi[tid]) : (pre + s_gi[tid]);
  }
  __syncthreads();
  if (tid < 128) {
    float mx = -3.0e38f;
#pragma unroll 4
    for (int m = 0; m < 128; ++m) mx = fmaxf(mx, s_a[m]);
    s_w[tid] = expf(s_a[tid] - mx);
    if (tid == 0) { mloc[u] = mx; gsum[u] = gtot; }
  }
  __syncthreads();
  f32x16 acc[4];
#pragma unroll
  for (int d = 0; d < 4; ++d)
#pragma unroll
    for (int r = 0; r < 16; ++r) acc[d][r] = 0.f;
  const u16* vrow = vT + ((size_t)(bh * 128 + wave * 32 + lr)) * 4096 + j * 128 + hh * 8;
  const u16* kbase = kaT + ((size_t)(bh * 128 + lr)) * 4096 + j * 128 + hh * 8;
#pragma unroll 4
  for (int ks = 0; ks < 8; ++ks) {
    const bf16x8 av = *(const bf16x8*)(vrow + ks * 16);
    bf16x8 a;
#pragma unroll
    for (int i = 0; i < 8; ++i) a[i] = (short)f2bf(bf2f((u16)av[i]) * s_w[ks * 16 + hh * 8 + i]);
#pragma unroll
    for (int dt = 0; dt < 4; ++dt) {
      const bf16x8 bk = *(const bf16x8*)(kbase + (size_t)(dt * 32) * 4096 + ks * 16);
      acc[dt] = MFMA(a, bk, acc[dt]);
    }
  }
  float* dst = CL + (size_t)u * 16384;
#pragma unroll
  for (int dt = 0; dt < 4; ++dt)
#pragma unroll
    for (int r = 0; r < 16; ++r) dst[(wave * 32 + crow(r, hh)) * 128 + dt * 32 + lr] = acc[dt][r];
  if (tid < 128) {
    const u16* kr = kaT + ((size_t)(bh * 128 + tid)) * 4096 + j * 128;
    float s = 0.f;
#pragma unroll 2
    for (int l = 0; l < 128; l += 8) {
      const bf16x8 kv = *(const bf16x8*)(kr + l);
#pragma unroll
      for (int i = 0; i < 8; ++i) s += s_w[l + i] * bf2f((u16)kv[i]);
    }
    nl[(size_t)u * 128 + tid] = s;
  }
}

DI void scan_unit(const Params& p, int unit) {
  const int tid = opaque_tid();
  const int sc = unit >> 4, part = unit & 15, dir = sc & 1;
  float* CL = p.out;
  float* nl = (float*)(p.ws + OFF_NL);
  const float* mloc = (const float*)(p.ws + OFF_MLOC);
  const float* gsum = (const float*)(p.ws + OFF_GSUM);
  float* ms = (float*)(p.ws + OFF_MS);
  const int idx = part * 1024 + tid * 4;
  float4 C = make_float4(0.f, 0.f, 0.f, 0.f);
  float nst = 0.f, m = 0.f;
  const bool do_n = (part == 0) && (tid < 128);
  float4 pf[4];
#pragma unroll
  for (int q = 0; q < 4; ++q) {
    const int jj = dir ? 31 - q : q;
    pf[q] = *(const float4*)(CL + (size_t)(sc * 32 + jj) * 16384 + idx);
  }
#pragma unroll 1
  for (int c0 = 0; c0 < 32; c0 += 4) {
#pragma unroll
    for (int q = 0; q < 4; ++q) {
      const int c = c0 + q;
      const int jj = dir ? 31 - c : c;
      const int u = sc * 32 + jj;
      const float4 cl = pf[q];
      *(float4*)(CL + (size_t)u * 16384 + idx) = C;
      if (c + 4 < 32) {
        const int j2 = dir ? 31 - (c + 4) : (c + 4);
        pf[q] = *(const float4*)(CL + (size_t)(sc * 32 + j2) * 16384 + idx);
      }
      const float g = gsum[u], ml = mloc[u];
      const float mn = fmaxf(g + m, ml);
      const float dec = expf(g + m - mn), scl = expf(ml - mn);
      C.x = dec * C.x + scl * cl.x; C.y = dec * C.y + scl * cl.y; C.z = dec * C.z + scl * cl.z; C.w = dec * C.w + scl * cl.w;
      if (do_n) {
        const float nv = nl[(size_t)u * 128 + tid];
        nl[(size_t)u * 128 + tid] = nst;
        nst = dec * nst + scl * nv;
      }
      if (part == 0 && tid == 0) ms[u] = m;
      m = mn;
    }
  }
}

template <int DIR>
DI void mlstm_dir(const Params& p, int bh, int j, char* smem, f32x16 (&hs)[4]) {
  float* s_gi = (float*)smem;
  float* s_lf = s_gi + 128;
  float* s_bc = s_lf + 128;
  float* s_r = s_bc + 128;
  float* s_al = s_r + 128;
  float* s_fl = s_al + 128;
  float* s_is = s_fl + 128;
  const int tid = opaque_tid(), lane = tid & 63, wave = tid >> 6, lr = lane & 31, hh = lane >> 5;
  u16* Pl = (u16*)(smem + 4096) + wave * (32 * 136);
  const int h = bh & 3, b = bh >> 2;
  const int T0 = b * 4096 + j * 128;
  const float* gates = (const float*)(p.ws + OFF_GATES);
  const u16* qa = (const u16*)(p.ws + OFF_QA);
  const u16* ka = (const u16*)(p.ws + OFF_KA);
  const u16* vT = (const u16*)(p.ws + OFF_VT);
  const float* CS = p.out;
  const float* ns = (const float*)(p.ws + OFF_NL);
  const float* ms = (const float*)(p.ws + OFF_MS);
  u16* A2 = (u16*)(p.ws + OFF_A2);
  bf16x8 ones;
#pragma unroll
  for (int i = 0; i < 8; ++i) ones[i] = (short)0x3F80;
  const u16* qrow = qa + (size_t)(T0 + wave * 32 + lr) * 512 + h * 128 + hh * 8;
  const int u = (bh * 2 + DIR) * 32 + j;
  const float msu = ms[u];
  __syncthreads();
  if (tid < 128) {
    const int T = T0 + tid;
    s_gi[tid] = gates[(size_t)T * 16 + DIR * 8 + h] + p.b_gates[DIR * 8 + h];
    s_lf[tid] = log_sigmoid(gates[(size_t)T * 16 + DIR * 8 + 4 + h] + p.b_gates[DIR * 8 + 4 + h]);
  }
  __syncthreads();
  if (tid < 128) {
    float a = 0.f;
#pragma unroll 4
    for (int m = 0; m < 128; ++m) {
      const bool in = (DIR == 0) ? (m <= tid) : (m >= tid);
      a += in ? s_lf[m] : 0.f;
    }
    s_bc[tid] = a;
    s_r[tid] = s_gi[tid] - a;
  }
  __syncthreads();
  if (tid < 128) {
    float cm = -3.0e38f;
#pragma unroll 4
    for (int m = 0; m < 128; ++m) {
      const bool in = (DIR == 0) ? (m <= tid) : (m >= tid);
      cm = in ? fmaxf(cm, s_r[m]) : cm;
    }
    const float bc = s_bc[tid];
    const float mt = bc + fmaxf(msu, cm);
    s_al[tid] = bc - mt;
    s_fl[tid] = expf(-mt);
    s_is[tid] = expf(bc + msu - mt);
  }
  __syncthreads();
  char* Kt = smem + 4096;
  char* R2 = smem + 40960;
  {
#pragma unroll
    for (int bt = 0; bt < 2; ++bt) {
      uint4 kq[4];
#pragma unroll
      for (int i = 0; i < 4; ++i) {
        const int q = tid + 256 * (bt * 4 + i), row = q >> 4, ch = q & 15;
        kq[i] = *(const uint4*)(ka + (size_t)(T0 + row) * 512 + h * 128 + ch * 8);
      }
#pragma unroll
      for (int i = 0; i < 4; ++i) {
        const int q = tid + 256 * (bt * 4 + i), row = q >> 4, ch = q & 15;
        *(uint4*)(Kt + row * 256 + ((ch ^ (row & 15)) << 4)) = kq[i];
      }
    }
  }
  __syncthreads();
  {
    f32x16 S[4];
#pragma unroll
    for (int st = 0; st < 4; ++st)
#pragma unroll
      for (int r = 0; r < 16; ++r) S[st][r] = 0.f;
#pragma unroll 4
    for (int ks = 0; ks < 8; ++ks) {
      const bf16x8 a = *(const bf16x8*)(qrow + ks * 16);
#pragma unroll
      for (int st = 0; st < 4; ++st) {
        const int krow = st * 32 + lr;
        const bf16x8 bk = *(const bf16x8*)(Kt + krow * 256 + (((ks * 2 + hh) ^ (krow & 15)) << 4));
        S[st] = MFMA(a, bk, S[st]);
      }
    }
    __syncthreads();
#pragma unroll
    for (int st = 0; st < 4; ++st) {
      const int sl = st * 32 + lr;
      const float rs = s_r[sl];
#pragma unroll
      for (int r = 0; r < 16; ++r) {
        const int tl = wave * 32 + crow(r, hh);
        const bool valid = (DIR == 0) ? (sl <= tl) : (sl >= tl);
        const float pv = valid ? S[st][r] * __expf(s_al[tl] + rs) : 0.f;
        Pl[crow(r, hh) * 136 + sl] = f2bf(pv);
      }
    }
  }
#pragma unroll
  for (int eh = 0; eh < 2; ++eh) {
    f32x16 N[3];
#pragma unroll
    for (int e = 0; e < 3; ++e)
#pragma unroll
      for (int r = 0; r < 16; ++r) N[e][r] = 0.f;
    {
      uint4 vq[4];
#pragma unroll
      for (int i = 0; i < 4; ++i) {
        const int q = tid + 256 * i, row = q >> 4, ch = q & 15;
        vq[i] = *(const uint4*)(vT + ((size_t)(bh * 128 + eh * 64 + row)) * 4096 + j * 128 + ch * 8);
      }
#pragma unroll
      for (int i = 0; i < 4; ++i) {
        const int q = tid + 256 * i, row = q >> 4, ch = q & 15;
        *(uint4*)(R2 + row * 256 + ((ch ^ (row & 15)) << 4)) = vq[i];
      }
    }
    __syncthreads();
    {
#pragma unroll 4
      for (int ks = 0; ks < 8; ++ks) {
        const bf16x8 a = *(const bf16x8*)(Pl + lr * 136 + ks * 16 + hh * 8);
#pragma unroll
        for (int e2 = 0; e2 < 2; ++e2) {
          const int vrow = e2 * 32 + lr;
          const bf16x8 bv = *(const bf16x8*)(R2 + vrow * 256 + (((ks * 2 + hh) ^ (vrow & 15)) << 4));
          N[e2] = MFMA(a, bv, N[e2]);
        }
        N[2] = MFMA(a, ones, N[2]);
      }
    }
    {
      bf16x8 cq[4];
#pragma unroll
      for (int i = 0; i < 4; ++i) {
        const int q = tid + 256 * i, row = q >> 4, ch = q & 15;
        const float* src = CS + (size_t)u * 16384 + (size_t)(eh * 64 + row) * 128 + ch * 8;
        const float4 c0 = *(const float4*)(src), c1 = *(const float4*)(src + 4);
        const float cv[8] = {c0.x, c0.y, c0.z, c0.w, c1.x, c1.y, c1.z, c1.w};
        cq[i] = pack8(cv);
      }
      __syncthreads();
#pragma unroll
      for (int i = 0; i < 4; ++i) {
        const int q = tid + 256 * i, row = q >> 4, ch = q & 15;
        *(bf16x8*)(R2 + row * 256 + ((ch ^ (row & 15)) << 4)) = cq[i];
      }
    }
    __syncthreads();
    {
      const float isc = s_is[wave * 32 + lr];
      const float* nbase = ns + (size_t)u * 128 + hh * 8;
#pragma unroll 4
      for (int ks = 0; ks < 8; ++ks) {
        const bf16x8 aq = *(const bf16x8*)(qrow + ks * 16);
        const bf16x8 a = scale8(aq, isc);
#pragma unroll
        for (int e2 = 0; e2 < 2; ++e2) {
          const int crw = e2 * 32 + lr;
          const bf16x8 bc = *(const bf16x8*)(R2 + crw * 256 + (((ks * 2 + hh) ^ (crw & 15)) << 4));
          N[e2] = MFMA(a, bc, N[e2]);
        }
        const float4 n0 = *(const float4*)(nbase + ks * 16);
        const float4 n1 = *(const float4*)(nbase + ks * 16 + 4);
        const float nv[8] = {n0.x, n0.y, n0.z, n0.w, n1.x, n1.y, n1.z, n1.w};
        N[2] = MFMA(a, pack8(nv), N[2]);
      }
    }
    __syncthreads();
    u16* park = (u16*)(p.ws + OFF_HYT) + ((size_t)(bh * 32 + j) * 256 + tid) * 64 + eh * 32;
    bf16x8 pk[4];
    if (DIR == 1) {
#pragma unroll
      for (int q = 0; q < 4; ++q) pk[q] = *(const bf16x8*)(park + q * 8);
    }
#pragma unroll
    for (int r = 0; r < 16; ++r) {
      const int tl = wave * 32 + crow(r, hh);
      const float den = fmaxf(fabsf(N[2][r]), s_fl[tl]);
      const float inv = 1.f / den;
#pragma unroll
      for (int e2 = 0; e2 < 2; ++e2) {
        const float hv = N[e2][r] * inv;
        const int v = e2 * 16 + r;
        if (DIR == 0) pk[v >> 3][v & 7] = (short)f2bf(hv);
        else hs[eh * 2 + e2][r] = hv + bf2f((u16)pk[v >> 3][v & 7]);
      }
    }
    if (DIR == 0) {
#pragma unroll
      for (int q = 0; q < 4; ++q) *(bf16x8*)(park + q * 8) = pk[q];
    }
  }
}

DI void mlstm_out_unit(const Params& p, int unit, char* smem) {
  const int tid = opaque_tid(), lane = tid & 63, wave = tid >> 6, lr = lane & 31, hh = lane >> 5;
  const int j = unit & 31, bh = unit >> 5, h = bh & 3, b = bh >> 2;
  const int T0 = b * 4096 + j * 128;
  const u16* og = (const u16*)(p.ws + OFF_OG);
  u16* A2 = (u16*)(p.ws + OFF_A2);
  f32x16 hs[4];
  mlstm_dir<0>(p, bh, j, smem, hs);
  mlstm_dir<1>(p, bh, j, smem, hs);
  __syncthreads();
  float* wl = (float*)(smem + wave * 16384);
#pragma unroll
  for (int et = 0; et < 4; ++et)
#pragma unroll
    for (int r = 0; r < 16; ++r) wl[crow(r, hh) * 128 + et * 32 + lr] = hs[et][r];
  wave_lds_sync();
  {
    const int row = lane >> 1, half = lane & 1;
    const size_t T = (size_t)(T0 + wave * 32 + row);
    const u16* ogp = og + T * 512 + h * 128 + half * 64;
    const float* src = wl + row * 128 + half * 64;
    float g[64];
    float ss = 0.f;
#pragma unroll
    for (int q = 0; q < 8; ++q) {
      const bf16x8 o8 = *(const bf16x8*)(ogp + q * 8);
      const float4 h0 = *(const float4*)(src + q * 8), h1 = *(const float4*)(src + q * 8 + 4);
      g[q * 8 + 0] = h0.x * bf2f((u16)o8[0]); g[q * 8 + 1] = h0.y * bf2f((u16)o8[1]); g[q * 8 + 2] = h0.z * bf2f((u16)o8[2]); g[q * 8 + 3] = h0.w * bf2f((u16)o8[3]);
      g[q * 8 + 4] = h1.x * bf2f((u16)o8[4]); g[q * 8 + 5] = h1.y * bf2f((u16)o8[5]); g[q * 8 + 6] = h1.z * bf2f((u16)o8[6]); g[q * 8 + 7] = h1.w * bf2f((u16)o8[7]);
#pragma unroll
      for (int i = 0; i < 8; ++i) ss += g[q * 8 + i] * g[q * 8 + i];
    }
    ss += __shfl_xor(ss, 1, 64);
    const float rs = rsqrtf(ss * (1.f / 128.f) + EPS);
    const float* mw = p.mlstm_norm_w + h * 128 + half * 64;
    u16* dst = A2 + T * 1024 + h * 128 + half * 64;
#pragma unroll
    for (int q = 0; q < 8; ++q) {
      const float4 w0 = *(const float4*)(mw + q * 8), w1 = *(const float4*)(mw + q * 8 + 4);
      float o[8];
      o[0] = g[q * 8 + 0] * rs * w0.x; o[1] = g[q * 8 + 1] * rs * w0.y; o[2] = g[q * 8 + 2] * rs * w0.z; o[3] = g[q * 8 + 3] * rs * w0.w;
      o[4] = g[q * 8 + 4] * rs * w1.x; o[5] = g[q * 8 + 5] * rs * w1.y; o[6] = g[q * 8 + 6] * rs * w1.z; o[7] = g[q * 8 + 7] * rs * w1.w;
      *(bf16x8*)(dst + q * 8) = pack8(o);
    }
  }
}

DI void hyena_norm_unit(const Params& p, int unit, char* smem) {
  float* tile = (float*)smem;
  const int tid = opaque_tid();
  const int tt = unit & 63, g = (unit >> 6) & 7, b = unit >> 9;
  const float* z2T = (const float*)(p.ws + OFF_Z2T);
  u16* A2 = (u16*)(p.ws + OFF_A2);
  __syncthreads();
#pragma unroll 4
  for (int i = 0; i < 16; ++i) {
    const int cl = (tid >> 6) + 4 * i, tl = tid & 63;
    tile[cl * 65 + tl] = z2T[((size_t)(b * 512 + g * 64 + cl)) * 4096 + tt * 64 + tl];
  }
  __syncthreads();
  const int tl = tid >> 2, qd = tid & 3;
  float v[16];
  float ss = 0.f;
#pragma unroll
  for (int i = 0; i < 16; ++i) {
    v[i] = tile[(qd * 16 + i) * 65 + tl];
    ss += v[i] * v[i];
  }
  ss += __shfl_xor(ss, 1, 64);
  ss += __shfl_xor(ss, 2, 64);
  const float rs = rsqrtf(ss * (1.f / 64.f) + EPS);
  const size_t T = (size_t)b * 4096 + tt * 64 + tl;
  u16* dst = A2 + T * 1024 + 512 + g * 64 + qd * 16;
  const float* w = p.hyena_norm_w + g * 64 + qd * 16;
  float o[16];
#pragma unroll
  for (int i = 0; i < 16; ++i) o[i] = v[i] * rs * w[i];
  *(bf16x8*)(dst) = pack8(o);
  *(bf16x8*)(dst + 8) = pack8(o + 8);
}

template <int EPI>
DI void gemm_phase(const u16* A, const u16* Bt, int K, int ntn, void* outp, char* smem) {
  const int tid = threadIdx.x, lane = tid & 63, wave = tid >> 6, wr = wave >> 1, wc = wave & 1, lr = lane & 31, hh = lane >> 5;
  const int ntiles = tile_count(ntn);
  for (int id = blockIdx.x; id < ntiles; id += gridDim.x) {
    int mt, nt;
    tile_map(id, ntn, mt, nt);
    if (nt >= ntn) continue;
    const int m0 = mt * 256, n0 = nt * 128;
    f32x16 acc[4][2];
    gemm_core<false>(A, Bt, K, m0, n0, smem, acc);
    if (EPI == 0) {
#pragma unroll
      for (int i = 0; i < 4; ++i)
#pragma unroll
        for (int j = 0; j < 2; ++j)
#pragma unroll
          for (int r = 0; r < 16; ++r) {
            const int row = m0 + wr * 128 + i * 32 + crow(r, hh);
            const int col = n0 + wc * 64 + j * 32 + lr;
            ((float*)outp)[(size_t)row * 1024 + col] = acc[i][j][r];
          }
    } else {
      char* wl = smem + wave * 16384;
      stage_tile_ns<2>(acc, wl, lr, hh);
      wave_lds_sync();
      flush_tile_ns(wl, (u16*)outp + (size_t)(m0 + wr * 128) * 4096 + n0 + wc * 64, 4096, lane);
    }
  }
}

DI void phase_post_mix(const Params& p) {
  const int tid = threadIdx.x, lane = tid & 63, wave = tid >> 6;
  const float* mix = p.out;
  float* x1 = (float*)(p.ws + OFF_X1);
  u16* hm = (u16*)(p.ws + OFF_HM);
  for (int u = blockIdx.x; u < 1024; u += gridDim.x) {
#pragma unroll 2
    for (int rr = 0; rr < 4; ++rr) {
      const size_t row = (size_t)u * 16 + wave * 4 + rr;
      float4 mv[4], xv[4];
      float ss = 0.f;
#pragma unroll
      for (int i = 0; i < 4; ++i) {
        mv[i] = ((const float4*)(mix + row * DM))[lane + 64 * i];
        xv[i] = ((const float4*)(p.x + row * DM))[lane + 64 * i];
        ss += mv[i].x * mv[i].x + mv[i].y * mv[i].y + mv[i].z * mv[i].z + mv[i].w * mv[i].w;
      }
      ss = wave_sum(ss);
      const float rs = rsqrtf(ss * (1.f / DM) + EPS);
      float s2 = 0.f;
#pragma unroll
      for (int i = 0; i < 4; ++i) {
        const float4 w = ((const float4*)p.norm_mix_post)[lane + 64 * i];
        xv[i].x += mv[i].x * rs * w.x; xv[i].y += mv[i].y * rs * w.y; xv[i].z += mv[i].z * rs * w.z; xv[i].w += mv[i].w * rs * w.w;
        s2 += xv[i].x * xv[i].x + xv[i].y * xv[i].y + xv[i].z * xv[i].z + xv[i].w * xv[i].w;
        ((float4*)(x1 + row * DM))[lane + 64 * i] = xv[i];
      }
      s2 = wave_sum(s2);
      const float r2 = rsqrtf(s2 * (1.f / DM) + EPS);
#pragma unroll
      for (int i = 0; i < 4; ++i) {
        const float4 w = ((const float4*)p.norm_mlp_pre)[lane + 64 * i];
        ushort4 o;
        o.x = f2bf(xv[i].x * r2 * w.x); o.y = f2bf(xv[i].y * r2 * w.y); o.z = f2bf(xv[i].z * r2 * w.z); o.w = f2bf(xv[i].w * r2 * w.w);
        *(ushort4*)(hm + row * DM + (lane + 64 * i) * 4) = o;
      }
    }
  }
}

DI void phase_final(const Params& p) {
  const int tid = threadIdx.x, lane = tid & 63, wave = tid >> 6;
  const float* x1 = (const float*)(p.ws + OFF_X1);
  for (int u = blockIdx.x; u < 1024; u += gridDim.x) {
#pragma unroll 2
    for (int rr = 0; rr < 4; ++rr) {
      const size_t row = (size_t)u * 16 + wave * 4 + rr;
      float4 fv[4];
      float ss = 0.f;
#pragma unroll
      for (int i = 0; i < 4; ++i) {
        fv[i] = ((const float4*)(p.out + row * DM))[lane + 64 * i];
        ss += fv[i].x * fv[i].x + fv[i].y * fv[i].y + fv[i].z * fv[i].z + fv[i].w * fv[i].w;
      }
      ss = wave_sum(ss);
      const float rs = rsqrtf(ss * (1.f / DM) + EPS);
#pragma unroll
      for (int i = 0; i < 4; ++i) {
        const float4 w = ((const float4*)p.norm_mlp_post)[lane + 64 * i];
        const float4 xv = ((const float4*)(x1 + row * DM))[lane + 64 * i];
        float4 o;
        o.x = xv.x + fv[i].x * rs * w.x; o.y = xv.y + fv[i].y * rs * w.y; o.z = xv.z + fv[i].z * rs * w.z; o.w = xv.w + fv[i].w * rs * w.w;
        ((float4*)(p.out + row * DM))[lane + 64 * i] = o;
      }
    }
  }
}

DI void run_phase(const Params& p, int ph, char* smem) {
  switch (ph) {
    case 0: phase0(p, smem); break;
    case 1: phase1(p, smem); break;
    case 2: phase_qk(p, smem); break;
    case 3:
#ifdef DBL_HYONLY
      for (int u = blockIdx.x; u < 512; u += gridDim.x) hyena_unit(p, u, smem);
#endif
#ifdef DBL_MLONLY
      for (int u = blockIdx.x; u < 1024; u += gridDim.x) mlstm_local_unit(p, u, smem);
#endif
      for (int u = blockIdx.x; u < 512 + 1024; u += gridDim.x) {
        if (u < 512) hyena_unit(p, u, smem);
        else mlstm_local_unit(p, u - 512, smem);
      }
      break;
    case 4:
      for (int u = blockIdx.x; u < 512; u += gridDim.x) scan_unit(p, u);
      break;
    case 5:
      for (int u = blockIdx.x; u < 512 + 2048; u += gridDim.x) {
#ifndef DBG_SKIP_MLSTM
        if (u < 512) mlstm_out_unit(p, u, smem);
#else
        if (u < 512) { u16* A2 = (u16*)(p.ws + OFF_A2); const int T0 = (u >> 5 >> 2) * 4096 + (u & 31) * 128, hq = (u >> 5) & 3;
          for (int i = threadIdx.x; i < 128 * 128; i += 256) A2[(size_t)(T0 + (i >> 7)) * 1024 + hq * 128 + (i & 127)] = 0; }
#endif
#ifndef DBG_SKIP_HYENA
        else hyena_norm_unit(p, u - 512, smem);
#else
        else { const int un = u - 512; const int tt = un & 63, g = (un >> 6) & 7, b = un >> 9; u16* A2 = (u16*)(p.ws + OFF_A2);
          for (int i = threadIdx.x; i < 64 * 64; i += 256) A2[((size_t)b * 4096 + tt * 64 + (i >> 6)) * 1024 + 512 + g * 64 + (i & 63)] = 0x3F80; }
#endif
      }
      break;
    case 6: gemm_phase<0>((const u16*)(p.ws + OFF_A2), (const u16*)(p.ws + OFF_WOUTT), 1024, 8, p.out, smem); break;
    case 7: phase_post_mix(p); break;
    case 8: gemm_phase<1>((const u16*)(p.ws + OFF_HM), (const u16*)(p.ws + OFF_W1T), 1024, 32, p.ws + OFF_H, smem); break;
    case 9: gemm_phase<0>((const u16*)(p.ws + OFF_H), (const u16*)(p.ws + OFF_W2T), 4096, 8, p.out, smem); break;
    case 10: phase_final(p); break;
  }
}
constexpr int NPHASE = 11;

#define XB_XCNT(j)  (256  + 64 * (j))
#define XB_XSUB(j)  (1280 + 64 * (j))
#define XB_XGEN(j)  (2304 + 64 * (j))
#define XB_TOP      3328
#define XB_TOPGEN   3392
#define XCD_BAR_WORDS 3456
DI unsigned xb_ld(unsigned* p) { return __hip_atomic_load(p, __ATOMIC_RELAXED, __HIP_MEMORY_SCOPE_AGENT); }
DI unsigned xb_add(unsigned* p, unsigned v) { return __hip_atomic_fetch_add(p, v, __ATOMIC_RELAXED, __HIP_MEMORY_SCOPE_AGENT); }
DI unsigned xb_xcc_id() { return (unsigned)__builtin_amdgcn_s_getreg((3 << 11) | 20) & 0xFu; }
struct XcdBar { unsigned* bar; unsigned x, nloc, nx; };
DI void xcd_barrier(XcdBar& b) {
  asm volatile("s_waitcnt vmcnt(0)" ::: "memory");
  __syncthreads();
  if (threadIdx.x == 0) {
    unsigned* bar = b.bar;
    __builtin_amdgcn_s_waitcnt(0);
    if (b.nloc == 0u) {
      const unsigned G = gridDim.x;
      unsigned sum, cnt, mine;
      for (;;) {
        sum = 0u; cnt = 0u; mine = 0u;
#pragma unroll
        for (unsigned j = 0; j < 16; ++j) { const unsigned c = xb_ld(&bar[XB_XCNT(j)]); sum += c; cnt += (c > 0u) ? 1u : 0u; mine = (j == b.x) ? c : mine; }
        if (sum == G) break;
        __builtin_amdgcn_s_sleep(1);
      }
      b.nloc = mine > 0u ? mine : 1u; b.nx = cnt > 0u ? cnt : 1u;
    }
    const unsigned nloc = b.nloc, nx = b.nx;
    const unsigned old = xb_add(&bar[XB_XSUB(b.x)], 1u);
    const unsigned gen = old / nloc;
    if (old + 1u == (gen + 1u) * nloc) {
      __builtin_amdgcn_fence(__ATOMIC_RELEASE, "agent");
      asm volatile("s_waitcnt vmcnt(0)" ::: "memory");
      const unsigned og = xb_add(&bar[XB_TOP], 1u);
      const unsigned tg = og / nx;
      if (og + 1u == (tg + 1u) * nx) xb_add(&bar[XB_TOPGEN], 1u);
      else while (xb_ld(&bar[XB_TOPGEN]) == tg) __builtin_amdgcn_s_sleep(1);
      __builtin_amdgcn_fence(__ATOMIC_ACQUIRE, "agent");
      xb_add(&bar[XB_XGEN(b.x)], 1u);
      asm volatile("s_waitcnt vmcnt(0)" ::: "memory");
    } else {
      while (xb_ld(&bar[XB_XGEN(b.x)]) == gen) __builtin_amdgcn_s_sleep(1);
      __builtin_amdgcn_fence(__ATOMIC_ACQUIRE, "agent");
      asm volatile("s_waitcnt vmcnt(0)" ::: "memory");
    }
  }
  __syncthreads();
}

#if MULTI_LAUNCH
template <int PH>
__global__ void __launch_bounds__(256, 2) phase_kernel(Params p) {
  __shared__ __attribute__((aligned(16))) char smem[65536];
  run_phase(p, PH, smem);
}
template <int PH>
static void launch_phase(const Params& p, hipStream_t stream) {
  hipLaunchKernelGGL(phase_kernel<PH>, dim3(512), dim3(256), 0, stream, p);
}
#else
__global__ void __launch_bounds__(256, 2) mega_kernel(Params p) {
  __shared__ __attribute__((aligned(16))) char smem[65536];
  cg::grid_group grid = cg::this_grid();
  XcdBar xb;
  xb.bar = (unsigned*)(p.ws + OFF_BAR); xb.x = xb_xcc_id(); xb.nloc = 0u; xb.nx = 0u;
  if (p.ws == nullptr) grid.sync();
  if (threadIdx.x == 0) (void)xb_add(&xb.bar[XB_XCNT(xb.x)], 1u);
#define GSYNC xcd_barrier(xb)
#ifdef DBL_P0
  run_phase(p, 0, smem);
#endif
  run_phase(p, 0, smem); GSYNC;
  run_phase(p, 1, smem); GSYNC;
#ifdef DBL_GEMM
  run_phase(p, 1, smem); grid.sync();
#endif
  run_phase(p, 2, smem); GSYNC;
#ifdef DBL_P2
  run_phase(p, 2, smem); GSYNC;
#endif
  run_phase(p, 3, smem); GSYNC;
#ifdef DBL_HY
  run_phase(p, 3, smem); GSYNC;
#endif
  run_phase(p, 4, smem); GSYNC;
  run_phase(p, 5, smem); GSYNC;
#ifdef DBL_P5
  run_phase(p, 5, smem); GSYNC;
#endif
  run_phase(p, 6, smem); GSYNC;
#ifdef DBL_GEMM
  run_phase(p, 6, smem); GSYNC;
#endif
  run_phase(p, 7, smem); GSYNC;
#ifdef DBL_P7
  run_phase(p, 7, smem); GSYNC;
#endif
  run_phase(p, 8, smem); GSYNC;
#ifdef DBL_GEMM
  run_phase(p, 8, smem); GSYNC;
#endif
  run_phase(p, 9, smem); GSYNC;
#ifdef DBL_GEMM
  run_phase(p, 9, smem); GSYNC;
#endif
#ifdef XSYNC
  for (int q = 0; q < 10; ++q) GSYNC;
#endif
  run_phase(p, 10, smem);
}
#endif

extern "C" void kernel_launch(void* const* d_in, const int* in_sizes, int n_in, void* d_out, int out_size, void* d_ws,
                              size_t ws_size, hipStream_t stream) {
  Params p{};
  const float** pp = (const float**)&p;
  for (int i = 0; i < 23; ++i) pp[i] = (const float*)d_in[i];
  p.out = (float*)d_out;
  p.ws = (char*)d_ws;
#if MULTI_LAUNCH
  launch_phase<0>(p, stream);
#ifdef DBL_P0
  launch_phase<0>(p, stream);
#endif
 launch_phase<1>(p, stream); launch_phase<2>(p, stream); launch_phase<3>(p, stream);
#ifdef DBL_HY
  launch_phase<3>(p, stream);
#endif

  launch_phase<4>(p, stream); launch_phase<5>(p, stream);
#ifdef DBL_P5
  launch_phase<5>(p, stream);
#endif
 launch_phase<6>(p, stream); launch_phase<7>(p, stream);
  launch_phase<8>(p, stream); launch_phase<9>(p, stream); launch_phase<10>(p, stream);
#else
  static int grid_blocks = 0;
  if (!grid_blocks) {
    int dev = 0, cus = 0, per_cu = 0;
    hipGetDevice(&dev);
    hipDeviceGetAttribute(&cus, hipDeviceAttributeMultiprocessorCount, dev);
    hipOccupancyMaxActiveBlocksPerMultiprocessor(&per_cu, mega_kernel, 256, 0);
    if (per_cu > 2) per_cu = 2;
    if (per_cu < 1) per_cu = 1;
#ifdef FORCE2
    per_cu = 2;
#endif
    grid_blocks = cus * per_cu;
  }
  hipMemsetAsync((char*)d_ws + OFF_BAR, 0, XCD_BAR_WORDS * 4, stream);
  void* args[] = {&p};
  hipError_t e = hipLaunchCooperativeKernel((void*)mega_kernel, dim3(grid_blocks), dim3(256), args, 0, stream);
  if (e != hipSuccess) fprintf(stderr, "cooperative launch failed: %s (grid %d)\n", hipGetErrorString(e), grid_blocks);
#endif
}
#if defined(__HIP_DEVICE_COMPILE__)
#pragma clang attribute pop
#endif
```

```cpp
#if defined(__HIP_DEVICE_COMPILE__)
#pragma clang attribute push(__attribute__((target("no-packed-fp32-ops"))), apply_to = function)
#endif
#include <hip/hip_runtime.h>
#include <hip/hip_cooperative_groups.h>
#include <cstdio>
namespace cg = cooperative_groups;

#ifndef MULTI_LAUNCH
#define MULTI_LAUNCH 0
#endif

typedef unsigned short u16;
using bf16x8 = __attribute__((ext_vector_type(8))) short;
using f32x16 = __attribute__((ext_vector_type(16))) float;
#define DI __device__ __forceinline__
#define MFMA(a, b, c) __builtin_amdgcn_mfma_f32_32x32x16_bf16((a), (b), (c), 0, 0, 0)

constexpr int SEQ = 4096, DM = 1024, NTOK = 16384, NIN = 3600, NINP = 3712, DFF = 4096;
constexpr float EPS = 1e-6f;
constexpr size_t MiB = 1u << 20;
constexpr size_t OFF_WINT = 0, OFF_WOUTT = 8 * MiB, OFF_W1T = 10 * MiB, OFF_W2T = 18 * MiB;
constexpr size_t OFF_XN = 26 * MiB, OFF_QA = 26 * MiB, OFF_KA = 42 * MiB;
constexpr size_t OFF_FILT = 58 * MiB, OFF_QKPRE = 90 * MiB, OFF_A2 = 90 * MiB;
constexpr size_t OFF_HYT = 122 * MiB, OFF_VT = 170 * MiB, OFF_OG = 186 * MiB, OFF_GATES = 202 * MiB;
constexpr size_t OFF_NL = 203 * MiB, OFF_MLOC = 203 * MiB + 512 * 1024, OFF_GSUM = OFF_MLOC + 4096, OFF_MS = OFF_GSUM + 4096;
constexpr size_t OFF_KAT = 205 * MiB, OFF_Z2T = 221 * MiB;
constexpr size_t OFF_TW = 204 * MiB, OFF_BAR = 254 * MiB;
constexpr size_t OFF_X1 = 26 * MiB, OFF_HM = 90 * MiB, OFF_H = 122 * MiB;

struct Params {
  const float *x, *norm_mix_pre, *norm_mix_post, *norm_mlp_pre, *norm_mlp_post, *w_in, *b_gates, *conv_w, *conv_b,
      *mlstm_norm_w, *hyena_norm_w, *filt_w1, *filt_b1, *filt_w2, *filt_b2, *filt_w3, *filt_b3, *filt_w4, *filt_freq,
      *filt_bias, *w_out, *w_mlp_in, *w_mlp_out;
  float* out;
  char* ws;
};

DI u16 f2bf(float x) { const __bf16 b = (__bf16)x; return __builtin_bit_cast(u16, b); }
DI float bf2f(u16 v) { return __uint_as_float(((unsigned)v) << 16); }
DI int opaque_tid() { int t = threadIdx.x; asm volatile("" : "+v"(t)); return t; }
DI int crow(int r, int hh) { return (r & 3) + 8 * (r >> 2) + 4 * hh; }
DI float log_sigmoid(float x) { return fminf(x, 0.f) - log1pf(expf(-fabsf(x))); }
DI float sigmoidf(float x) { return 1.f / (1.f + __expf(-x)); }
DI float red2pi(float x) {
  const float k = rintf(x * 0.15915494309189535f);
  float r = fmaf(-k, 6.28125f, x);
  return fmaf(-k, 1.9353071795864769e-3f, r);
}
DI float fsin(float x) { return sinf(x); }
DI float fcos(float x) { return cosf(x); }
DI bf16x8 pack8(const float* v) {
  bf16x8 r;
#pragma unroll
  for (int i = 0; i < 8; ++i) r[i] = (short)f2bf(v[i]);
  return r;
}
DI bf16x8 scale8(bf16x8 a, float s) {
  bf16x8 r;
#pragma unroll
  for (int i = 0; i < 8; ++i) r[i] = (short)f2bf(bf2f((u16)a[i]) * s);
  return r;
}

template <bool SWAP>
DI void gemm_core(const u16* __restrict__ A, const u16* __restrict__ Bt, int K, int m0, int n0, char* smem, f32x16 (&acc)[4][2]) {
  const int tid = opaque_tid(), lane = tid & 63, wave = tid >> 6, wr = wave >> 1, wc = wave & 1;
  const int lr = lane & 31, hh = lane >> 5;
#pragma unroll
  for (int i = 0; i < 4; ++i)
#pragma unroll
    for (int j = 0; j < 2; ++j)
#pragma unroll
      for (int r = 0; r < 16; ++r) acc[i][j][r] = 0.f;
  const int c = tid & 7, r0 = tid >> 3;
  const u16* Ag = A + (size_t)(m0 + r0) * K + c * 8;
  const u16* Bg = Bt + (size_t)(n0 + r0) * K + c * 8;
  const int soff = r0 * 128 + ((c ^ ((r0 >> 1) & 7)) << 4);
  char* As = smem;
  char* Bs = smem + 32768;
  uint4 ra0, ra1, ra2, ra3, ra4, ra5, ra6, ra7, rb0, rb1, rb2, rb3;
#define GLOAD_ALL(k0)                                                                                             \
  ra0 = *(const uint4*)(Ag + (size_t)(0) * K + (k0));   ra1 = *(const uint4*)(Ag + (size_t)(32) * K + (k0));      \
  ra2 = *(const uint4*)(Ag + (size_t)(64) * K + (k0));  ra3 = *(const uint4*)(Ag + (size_t)(96) * K + (k0));      \
  ra4 = *(const uint4*)(Ag + (size_t)(128) * K + (k0)); ra5 = *(const uint4*)(Ag + (size_t)(160) * K + (k0));     \
  ra6 = *(const uint4*)(Ag + (size_t)(192) * K + (k0)); ra7 = *(const uint4*)(Ag + (size_t)(224) * K + (k0));     \
  rb0 = *(const uint4*)(Bg + (size_t)(0) * K + (k0));   rb1 = *(const uint4*)(Bg + (size_t)(32) * K + (k0));      \
  rb2 = *(const uint4*)(Bg + (size_t)(64) * K + (k0));  rb3 = *(const uint4*)(Bg + (size_t)(96) * K + (k0));
  GLOAD_ALL(0)
  const int nk = K >> 6;
#pragma unroll 1
  for (int kt = 0; kt < nk; ++kt) {
    __syncthreads();
    *(uint4*)(As + soff + 0 * 4096) = ra0; *(uint4*)(As + soff + 1 * 4096) = ra1; *(uint4*)(As + soff + 2 * 4096) = ra2; *(uint4*)(As + soff + 3 * 4096) = ra3;
    *(uint4*)(As + soff + 4 * 4096) = ra4; *(uint4*)(As + soff + 5 * 4096) = ra5; *(uint4*)(As + soff + 6 * 4096) = ra6; *(uint4*)(As + soff + 7 * 4096) = ra7;
    *(uint4*)(Bs + soff + 0 * 4096) = rb0; *(uint4*)(Bs + soff + 1 * 4096) = rb1; *(uint4*)(Bs + soff + 2 * 4096) = rb2; *(uint4*)(Bs + soff + 3 * 4096) = rb3;
    __syncthreads();
    if (kt + 1 < nk) {
      const int k0 = (kt + 1) << 6;
      GLOAD_ALL(k0)
    }
#pragma unroll
    for (int kk = 0; kk < 4; ++kk) {
      bf16x8 a[4], b[2];
      const int cc = kk * 2 + hh;
#pragma unroll
      for (int i = 0; i < 4; ++i) {
        const int r = wr * 128 + i * 32 + lr;
        a[i] = *(const bf16x8*)(As + r * 128 + ((cc ^ ((r >> 1) & 7)) << 4));
      }
#pragma unroll
      for (int j = 0; j < 2; ++j) {
        const int r = wc * 64 + j * 32 + lr;
        b[j] = *(const bf16x8*)(Bs + r * 128 + ((cc ^ ((r >> 1) & 7)) << 4));
      }
#pragma unroll
      for (int i = 0; i < 4; ++i)
#pragma unroll
        for (int j = 0; j < 2; ++j) acc[i][j] = SWAP ? MFMA(b[j], a[i], acc[i][j]) : MFMA(a[i], b[j], acc[i][j]);
    }
  }
  __syncthreads();
}

DI void tile_map(int id, int ntn, int& mt, int& nt) {
  const int r = id >> 9, b = id & 511;
  const int x = b & 7, sidx = b >> 3;
  const int P = r * 8 + x;
  mt = (P & 7) * 8 + (sidx & 7);
  nt = (P >> 3) * 8 + (sidx >> 3);
}
DI int tile_count(int ntn) { return ((ntn + 7) >> 3) * 512; }

DI void transpose_tile(const float* __restrict__ src, int R, int C, u16* __restrict__ dst, int kt, int nt, char* smem) {
  float* tile = (float*)smem;
  const int tid = threadIdx.x;
  const int k0 = kt * 64, n0 = nt * 64;
#pragma unroll 4
  for (int it = 0; it < 16; ++it) {
    const int kk = it * 4 + (tid >> 6), nn = tid & 63;
    const int n = n0 + nn;
    tile[kk * 65 + nn] = (n < C) ? src[(size_t)(k0 + kk) * C + n] : 0.f;
  }
  __syncthreads();
#pragma unroll
  for (int it = 0; it < 2; ++it) {
    const int q = tid + 256 * it, nn = q >> 3, kc = q & 7;
    float o[8];
#pragma unroll
    for (int i = 0; i < 8; ++i) o[i] = tile[(kc * 8 + i) * 65 + nn];
    *(bf16x8*)(dst + (size_t)(n0 + nn) * R + k0 + kc * 8) = pack8(o);
  }
  __syncthreads();
}

DI float wave_sum(float v) {
#pragma unroll
  for (int o = 32; o; o >>= 1) v += __shfl_xor(v, o, 64);
  return v;
}

DI void filter_unit(const Params& p, int unit, char* smem) {
  float* sz = (float*)smem;
  float* hA = sz + 8 * 33 + 8;
  float* hB = hA + 8 * 64;
  float* hT = hB + 8 * 64;
  const int tid = opaque_tid();
  const int l0 = unit * 8;
  for (int idx = tid; idx < 8 * 33; idx += 256) {
    const int pp = idx / 33, f = idx - pp * 33;
    const float l = (float)(l0 + pp);
    float v;
    if (f == 0) v = l / 4095.f;
    else {
      const int jb = (f - 1) & 15;
      const float fj = 1e-4f + (float)jb * ((15.f - 1e-4f) / 15.f);
      const float ang = 6.283185307179586f * l / 4096.f;
      v = (f <= 16) ? fcos(fj * ang) : -fsin(fj * ang);
    }
    sz[idx] = v;
  }
  const int o = tid & 63, pq = tid >> 6;
  {
    const float bb = p.filt_b1[o], fr = p.filt_freq[o];
    __syncthreads();
    float s0 = bb, s1 = bb;
#pragma unroll 1
    for (int f0 = 0; f0 < 33; f0 += 11) {
      float wc[11];
#pragma unroll
      for (int f = 0; f < 11; ++f) wc[f] = p.filt_w1[(f0 + f) * 64 + o];
#pragma unroll
      for (int f = 0; f < 11; ++f) { s0 += sz[pq * 33 + f0 + f] * wc[f]; s1 += sz[(pq + 4) * 33 + f0 + f] * wc[f]; }
    }
    hA[pq * 64 + o] = fsin(fr * s0);
    hA[(pq + 4) * 64 + o] = fsin(fr * s1);
  }
  {
    const float bb = p.filt_b2[o], fr = p.filt_freq[64 + o];
    __syncthreads();
    float s0 = bb, s1 = bb;
#pragma unroll 1
    for (int k0 = 0; k0 < 64; k0 += 16) {
      float wc[16];
#pragma unroll
      for (int k = 0; k < 16; ++k) wc[k] = p.filt_w2[(k0 + k) * 64 + o];
#pragma unroll
      for (int k = 0; k < 16; ++k) { s0 += hA[pq * 64 + k0 + k] * wc[k]; s1 += hA[(pq + 4) * 64 + k0 + k] * wc[k]; }
    }
    hB[pq * 64 + o] = fsin(fr * s0);
    hB[(pq + 4) * 64 + o] = fsin(fr * s1);
  }
  {
    const float bb = p.filt_b3[o], fr = p.filt_freq[128 + o];
    __syncthreads();
    float s0 = bb, s1 = bb;
#pragma unroll 1
    for (int k0 = 0; k0 < 64; k0 += 16) {
      float wc[16];
#pragma unroll
      for (int k = 0; k < 16; ++k) wc[k] = p.filt_w3[(k0 + k) * 64 + o];
#pragma unroll
      for (int k = 0; k < 16; ++k) { s0 += hB[pq * 64 + k0 + k] * wc[k]; s1 += hB[(pq + 4) * 64 + k0 + k] * wc[k]; }
    }
    hT[o * 8 + pq] = fsin(fr * s0);
    hT[o * 8 + pq + 4] = fsin(fr * s1);
  }
  __syncthreads();
  float* filt = (float*)(p.ws + OFF_FILT);
  const float min_decay = -3.0701134573253944f, max_decay = -15.350567286626973f;
#pragma unroll 1
  for (int cc = 0; cc < 8; ++cc) {
    const int col = tid + 256 * cc;
    float acc[8];
#pragma unroll
    for (int q = 0; q < 8; ++q) acc[q] = 0.f;
#pragma unroll 1
    for (int k0 = 0; k0 < 64; k0 += 16) {
      float wc[16];
#pragma unroll
      for (int k = 0; k < 16; ++k) wc[k] = p.filt_w4[(k0 + k) * 2048 + col];
#pragma unroll
      for (int k = 0; k < 16; ++k) {
        const float4 h0 = *(const float4*)(hT + (k0 + k) * 8);
        const float4 h1 = *(const float4*)(hT + (k0 + k) * 8 + 4);
        acc[0] += h0.x * wc[k]; acc[1] += h0.y * wc[k]; acc[2] += h0.z * wc[k]; acc[3] += h0.w * wc[k];
        acc[4] += h1.x * wc[k]; acc[5] += h1.y * wc[k]; acc[6] += h1.z * wc[k]; acc[7] += h1.w * wc[k];
      }
    }
    const int ch = col & 511;
    const float delta = fabsf(min_decay + (float)ch * ((max_decay - min_decay) / 511.f));
#pragma unroll
    for (int q = 0; q < 8; ++q) {
      const float t = (float)(l0 + q) / 4095.f;
      acc[q] *= expf(-t * delta);
    }
    float4* dst = (float4*)(filt + (size_t)col * 4096 + l0);
    dst[0] = make_float4(acc[0], acc[1], acc[2], acc[3]);
    dst[1] = make_float4(acc[4], acc[5], acc[6], acc[7]);
  }
  __syncthreads();
}

DI void phase0(const Params& p, char* smem) {
  const int tid = threadIdx.x, lane = tid & 63, wave = tid >> 6;
  const int U_W = 32, U_F = 512, U_X = 1024, U_T1 = 58 * 16, U_T2 = 256, U_T3 = 1024, U_T4 = 1024;
  const int total = U_W + U_F + U_X + U_T1 + U_T2 + U_T3 + U_T4;
  for (int u = blockIdx.x; u < total; u += gridDim.x) {
    int v = u;
    if (v < U_W) {
      const int idx = v * 256 + tid;
      if (idx < 8191) {
        const int lh = 31 - __clz(idx + 1);
        const int h = 1 << lh, jj = idx + 1 - h;
        float2* twp = (float2*)(p.ws + OFF_TW);
        const float ang = -3.14159265358979f * (float)jj / (float)h;
        twp[idx] = make_float2(cosf(ang), sinf(ang));
      }
      continue;
    }
    v -= U_W;
    if (v < U_F) { filter_unit(p, v, smem); continue; }
    v -= U_F;
    if (v < U_X) {
      u16* xn = (u16*)(p.ws + OFF_XN);
#pragma unroll 4
      for (int rr = 0; rr < 4; ++rr) {
        const int row = v * 16 + wave * 4 + rr;
        const float4* xr = (const float4*)(p.x + (size_t)row * DM);
        float4 xv[4];
        float ss = 0.f;
#pragma unroll
        for (int i = 0; i < 4; ++i) {
          xv[i] = xr[lane + 64 * i];
          ss += xv[i].x * xv[i].x + xv[i].y * xv[i].y + xv[i].z * xv[i].z + xv[i].w * xv[i].w;
        }
        ss = wave_sum(ss);
        const float rs = rsqrtf(ss * (1.f / DM) + EPS);
#pragma unroll
        for (int i = 0; i < 4; ++i) {
          const float4 w = ((const float4*)p.norm_mix_pre)[lane + 64 * i];
          ushort4 o;
          o.x = f2bf(xv[i].x * rs * w.x); o.y = f2bf(xv[i].y * rs * w.y); o.z = f2bf(xv[i].z * rs * w.z); o.w = f2bf(xv[i].w * rs * w.w);
          *(ushort4*)(xn + (size_t)row * DM + (lane + 64 * i) * 4) = o;
        }
      }
      continue;
    }
    v -= U_X;
    if (v < U_T1) { transpose_tile(p.w_in, DM, NIN, (u16*)(p.ws + OFF_WINT), v & 15, v >> 4, smem); continue; }
    v -= U_T1;
    if (v < U_T2) { transpose_tile(p.w_out, DM, DM, (u16*)(p.ws + OFF_WOUTT), v & 15, v >> 4, smem); continue; }
    v -= U_T2;
    if (v < U_T3) { transpose_tile(p.w_mlp_in, DM, DFF, (u16*)(p.ws + OFF_W1T), v & 15, v >> 4, smem); continue; }
    v -= U_T3;
    transpose_tile(p.w_mlp_out, DFF, DM, (u16*)(p.ws + OFF_W2T), v & 63, v >> 6, smem);
  }
}

DI void wave_lds_sync() { asm volatile("s_waitcnt lgkmcnt(0)" ::: "memory"); __builtin_amdgcn_wave_barrier(); }
template <int MODE>
DI void stage_tile_ns(const f32x16 (&acc)[4][2], char* wl, int lr, int hh) {
#pragma unroll
  for (int i = 0; i < 4; ++i)
#pragma unroll
    for (int j = 0; j < 2; ++j)
#pragma unroll
      for (int r = 0; r < 16; ++r) {
        float v = acc[i][j][r];
        if (MODE == 1) v = sigmoidf(v);
        if (MODE == 2) { v = fmaxf(v, 0.f); v = v * v; }
        *(u16*)(wl + (i * 32 + crow(r, hh)) * 128 + (j * 32 + lr) * 2) = f2bf(v);
      }
}
DI void stage_tile_sw(const f32x16 (&acc)[4][2], char* wl, int lr, int hh) {
#pragma unroll
  for (int i = 0; i < 4; ++i)
#pragma unroll
    for (int j = 0; j < 2; ++j)
#pragma unroll
      for (int r = 0; r < 16; ++r) *(u16*)(wl + (j * 32 + crow(r, hh)) * 256 + (i * 32 + lr) * 2) = f2bf(acc[i][j][r]);
}
DI void flush_tile_ns(const char* wl, u16* dst, size_t pitch, int lane) {
#pragma unroll 4
  for (int it = 0; it < 16; ++it) {
    const int q = lane + 64 * it, row = q >> 3, c8 = q & 7;
    *(uint4*)(dst + (size_t)row * pitch + c8 * 8) = *(const uint4*)(wl + row * 128 + c8 * 16);
  }
}

DI void phase1(const Params& p, char* smem) {
  const int tid = threadIdx.x, lane = tid & 63, wave = tid >> 6, wr = wave >> 1, wc = wave & 1, lr = lane & 31, hh = lane >> 5;
  const u16* xn = (const u16*)(p.ws + OFF_XN);
  const u16* wt = (const u16*)(p.ws + OFF_WINT);
  u16* qkpre = (u16*)(p.ws + OFF_QKPRE);
  u16* hyT = (u16*)(p.ws + OFF_HYT);
  u16* vT = (u16*)(p.ws + OFF_VT);
  u16* og = (u16*)(p.ws + OFF_OG);
  float* gates = (float*)(p.ws + OFF_GATES);
  const int ntn = 29, ntiles = tile_count(ntn);
  for (int id = blockIdx.x; id < ntiles; id += gridDim.x) {
    int mt, nt;
    tile_map(id, ntn, mt, nt);
    if (nt >= ntn) continue;
    const int m0 = mt * 256, n0 = nt * 128;
    f32x16 acc[4][2];
    const bool swap = (nt >= 8 && nt < 24);
    if (swap) gemm_core<true>(xn, wt, DM, m0, n0, smem, acc);
    else gemm_core<false>(xn, wt, DM, m0, n0, smem, acc);
    char* wl = smem + wave * 16384;
    if (!swap) {
      if (nt < 28) {
        if (nt < 8) stage_tile_ns<0>(acc, wl, lr, hh); else stage_tile_ns<1>(acc, wl, lr, hh);
        wave_lds_sync();
        const size_t row0 = (size_t)(m0 + wr * 128);
        if (nt < 8) flush_tile_ns(wl, qkpre + row0 * 1024 + n0 + wc * 64, 1024, lane);
        else flush_tile_ns(wl, og + row0 * 512 + (n0 - 3072) + wc * 64, 512, lane);
      } else {
#pragma unroll
        for (int i = 0; i < 4; ++i)
#pragma unroll
          for (int r = 0; r < 16; ++r) {
            const int row = m0 + wr * 128 + i * 32 + crow(r, hh);
            if (wc == 0 && lr < 16) gates[(size_t)row * 16 + lr] = acc[i][0][r];
          }
      }
    } else {
      stage_tile_sw(acc, wl, lr, hh);
      wave_lds_sync();
      const int mrow = m0 + wr * 128, b = mrow >> 12, t0 = mrow & 4095;
#pragma unroll 4
      for (int it = 0; it < 16; ++it) {
        const int q = lane + 64 * it, chl = q >> 4, c16 = q & 15;
        const int n = n0 + wc * 64 + chl;
        u16* dst;
        if (nt < 20) { const int cc = n - 1024, g = cc >> 9, ch = cc & 511; dst = hyT + ((size_t)((g * 4 + b) * 512 + ch)) * 4096; }
        else dst = vT + ((size_t)(b * 512 + (n - 2560))) * 4096;
        *(uint4*)(dst + t0 + c16 * 8) = *(const uint4*)(wl + chl * 256 + c16 * 16);
      }
    }
  }
}

DI void phase_qk(const Params& p, char* smem) {
  const int tid = opaque_tid();
  const int cg = tid & 31, rg = tid >> 5;
  const u16* qkpre = (const u16*)(p.ws + OFF_QKPRE);
  u16* qa = (u16*)(p.ws + OFF_QA);
  u16* ka = (u16*)(p.ws + OFF_KA);
  u16* kaT = (u16*)(p.ws + OFF_KAT);
  for (int u = blockIdx.x; u < 1024; u += gridDim.x) {
    const int ct = u & 3, tt = u >> 2;
    const int C0 = ct * 256 + cg * 8;
    const int Tb = tt * 64 + rg * 8;
    const int tb = Tb & 4095;
    float w0[8], w1[8], w2[8], cb[8];
    {
      const float4 a0 = *(const float4*)(p.conv_w + C0), a1 = *(const float4*)(p.conv_w + C0 + 4);
      const float4 b0 = *(const float4*)(p.conv_w + 2560 + C0), b1 = *(const float4*)(p.conv_w + 2560 + C0 + 4);
      const float4 c0 = *(const float4*)(p.conv_w + 5120 + C0), c1 = *(const float4*)(p.conv_w + 5120 + C0 + 4);
      const float4 d0 = *(const float4*)(p.conv_b + C0), d1 = *(const float4*)(p.conv_b + C0 + 4);
      w0[0] = a0.x; w0[1] = a0.y; w0[2] = a0.z; w0[3] = a0.w; w0[4] = a1.x; w0[5] = a1.y; w0[6] = a1.z; w0[7] = a1.w;
      w1[0] = b0.x; w1[1] = b0.y; w1[2] = b0.z; w1[3] = b0.w; w1[4] = b1.x; w1[5] = b1.y; w1[6] = b1.z; w1[7] = b1.w;
      w2[0] = c0.x; w2[1] = c0.y; w2[2] = c0.z; w2[3] = c0.w; w2[4] = c1.x; w2[5] = c1.y; w2[6] = c1.z; w2[7] = c1.w;
      cb[0] = d0.x; cb[1] = d0.y; cb[2] = d0.z; cb[3] = d0.w; cb[4] = d1.x; cb[5] = d1.y; cb[6] = d1.z; cb[7] = d1.w;
    }
    bf16x8 rows[10];
    const u16* src = qkpre + (size_t)Tb * 1024 + C0;
#pragma unroll
    for (int r = 0; r < 10; ++r) {
      const int t = tb + r - 1;
      bf16x8 z;
#pragma unroll
      for (int i = 0; i < 8; ++i) z[i] = 0;
      rows[r] = (t >= 0 && t <= 4095) ? *(const bf16x8*)(src + (ptrdiff_t)(r - 1) * 1024) : z;
    }
    const bool isk = C0 >= 512;
    bf16x8 tr[8];
#pragma unroll
    for (int r = 0; r < 8; ++r) {
      bf16x8 o;
#pragma unroll
      for (int i = 0; i < 8; ++i) {
        const float val = w0[i] * bf2f((u16)rows[r][i]) + w1[i] * bf2f((u16)rows[r + 1][i]) + w2[i] * bf2f((u16)rows[r + 2][i]) + cb[i];
        float sv = val * sigmoidf(val);
        if (isk) sv *= 0.08838834764831845f;
        o[i] = (short)f2bf(sv);
        tr[i][r] = o[i];
      }
      if (!isk) *(bf16x8*)(qa + (size_t)(Tb + r) * 512 + C0) = o;
      else *(bf16x8*)(ka + (size_t)(Tb + r) * 512 + (C0 - 512)) = o;
    }
    if (isk) {
      const int b = Tb >> 12;
#pragma unroll
      for (int i = 0; i < 8; ++i) *(bf16x8*)(kaT + ((size_t)(b * 512 + (C0 - 512) + i)) * 4096 + tb) = tr[i];
    }
  }
}

DI float lz(float v) { asm volatile("" : "+v"(v)); return v; }
DI float2 mk2(float a, float b) { return make_float2(a, b); }
DI float2 cmul(float2 a, float2 w) { return mk2(a.x * w.x - a.y * w.y, a.x * w.y + a.y * w.x); }
DI float2 cmulc(float2 a, float2 w) { return mk2(a.x * w.x + a.y * w.y, a.y * w.x - a.x * w.y); }
DI int lx(int idx) { const int sw = (idx >> 5) & 3; return idx ^ (sw << 3) ^ (sw << 1); }
template <bool LX>
DI void addr4(int base, int q, int k, int& a0, int& a1, int& a2, int& a3) {
  if (!LX) { a0 = base; a1 = base + q; a2 = base + 2 * q; a3 = base + 3 * q; }
  else if (q == 8) {
    const int sw = (k >> 3) & 3, b2 = base ^ (sw << 1);
    a0 = b2 + (sw << 3); a1 = b2 + ((1 ^ sw) << 3); a2 = b2 + ((2 ^ sw) << 3); a3 = b2 + ((3 ^ sw) << 3);
  } else {
    a0 = base; a1 = (base ^ 10) + 32; a2 = (base ^ 20) + 64; a3 = (base ^ 30) + 96;
  }
}
template <int NW, bool INV, bool INLX = false, bool OUTLX = false, bool PRUNE = false>
DI void r4_pass(float2* x, int tid, int q, const float2* __restrict__ t1, const float2* __restrict__ t2) {
  constexpr int NL = NW > 4 ? 4 : NW;
  constexpr int NB = NW > 4 ? 2 : 1;
  constexpr int CNT = 8 / NB;
#pragma unroll 1
  for (int bt = 0; bt < NB; ++bt) {
    float2 w1[NL], w2[NL];
#pragma unroll
    for (int n = 0; n < NL; ++n) { const int j = (tid + ((bt * CNT + n) << 8)) & (q - 1); w1[n] = t1[j]; w2[n] = t2[j]; }
    if (bt == 0) __syncthreads();
#pragma unroll(NL == 4 ? 4 : 2)
    for (int ii = 0; ii < CNT; ++ii) {
      const int k = tid + ((bt * CNT + ii) << 8);
      const int j = k & (q - 1);
      int base = ((k - j) << 2) + j;
      asm volatile("" : "+v"(base));
      const float2 ww1 = w1[ii % NL], ww2 = w2[ii % NL];
      int i0_, i1_, i2_, i3_, o0_, o1_, o2_, o3_;
      addr4<INLX>(base, q, k, i0_, i1_, i2_, i3_);
      addr4<OUTLX>(base, q, k, o0_, o1_, o2_, o3_);
      const float2 zz = make_float2(0.f, 0.f);
      const float2 x0 = x[i0_], x1 = x[i1_];
      const float2 x2 = (PRUNE && !INV) ? zz : x[i2_], x3 = (PRUNE && !INV) ? zz : x[i3_];
      if (!INV) {
        const float2 a0 = mk2(x0.x + x2.x, x0.y + x2.y);
        const float2 a1 = mk2(x1.x + x3.x, x1.y + x3.y);
        const float2 d02 = mk2(x0.x - x2.x, x0.y - x2.y);
        const float2 d13 = mk2(x1.y - x3.y, x3.x - x1.x);
        const float2 a2 = cmul(d02, ww1);
        const float2 a3 = cmul(d13, ww1);
        x[o0_] = mk2(a0.x + a1.x, a0.y + a1.y);
        x[o1_] = cmul(mk2(a0.x - a1.x, a0.y - a1.y), ww2);
        x[o2_] = mk2(a2.x + a3.x, a2.y + a3.y);
        x[o3_] = cmul(mk2(a2.x - a3.x, a2.y - a3.y), ww2);
      } else {
        const float2 b1 = cmulc(x1, ww2), b3 = cmulc(x3, ww2);
        const float2 a0 = mk2(x0.x + b1.x, x0.y + b1.y);
        const float2 a1 = mk2(x0.x - b1.x, x0.y - b1.y);
        const float2 a2 = mk2(x2.x + b3.x, x2.y + b3.y);
        const float2 a3 = mk2(x2.x - b3.x, x2.y - b3.y);
        const float2 c2 = cmulc(a2, ww1);
        const float2 c3t = cmulc(a3, ww1);
        const float2 c3 = mk2(-c3t.y, c3t.x);
        x[o0_] = mk2(a0.x + c2.x, a0.y + c2.y);
        if (!PRUNE) x[o2_] = mk2(a0.x - c2.x, a0.y - c2.y);
        x[o1_] = mk2(a1.x + c3.x, a1.y + c3.y);
        if (!PRUNE) x[o3_] = mk2(a1.x - c3.x, a1.y - c3.y);
      }
    }
  }
}
template <bool INV>
DI void r8_tail(float2* x, int tid) {
  const float R = 0.70710678118654752f;
#pragma unroll 2
  for (int i = 0; i < 4; ++i) {
    const int G = tid + (i << 8);
    const int sw = (G >> 2) & 3;
    const int blk = (G << 3) ^ (sw << 3);
    float4* p0 = (float4*)(x + blk + ((0 ^ sw) << 1));
    float4* p1 = (float4*)(x + blk + ((1 ^ sw) << 1));
    float4* p2 = (float4*)(x + blk + ((2 ^ sw) << 1));
    float4* p3 = (float4*)(x + blk + ((3 ^ sw) << 1));
    const float4 v0 = *p0, v1 = *p1, v2 = *p2, v3 = *p3;
    float2 e0 = make_float2(v0.x, v0.y), e1 = make_float2(v0.z, v0.w), e2 = make_float2(v1.x, v1.y), e3 = make_float2(v1.z, v1.w);
    float2 e4 = make_float2(v2.x, v2.y), e5 = make_float2(v2.z, v2.w), e6 = make_float2(v3.x, v3.y), e7 = make_float2(v3.z, v3.w);
    if (!INV) {
      const float2 s0 = mk2(e0.x + e4.x, e0.y + e4.y), d0 = mk2(e0.x - e4.x, e0.y - e4.y);
      const float2 s1 = mk2(e1.x + e5.x, e1.y + e5.y), t1 = mk2(e1.x - e5.x, e1.y - e5.y);
      const float2 s2 = mk2(e2.x + e6.x, e2.y + e6.y), t2 = mk2(e2.x - e6.x, e2.y - e6.y);
      const float2 s3 = mk2(e3.x + e7.x, e3.y + e7.y), t3 = mk2(e3.x - e7.x, e3.y - e7.y);
      const float2 d1 = mk2((t1.x + t1.y) * R, (t1.y - t1.x) * R);
      const float2 d2 = mk2(t2.y, -t2.x);
      const float2 d3 = mk2((t3.y - t3.x) * R, -(t3.x + t3.y) * R);
      const float2 a0 = mk2(s0.x + s2.x, s0.y + s2.y), a2 = mk2(s0.x - s2.x, s0.y - s2.y);
      const float2 a1 = mk2(s1.x + s3.x, s1.y + s3.y), u3 = mk2(s1.x - s3.x, s1.y - s3.y);
      const float2 a3 = mk2(u3.y, -u3.x);
      const float2 a4 = mk2(d0.x + d2.x, d0.y + d2.y), a6 = mk2(d0.x - d2.x, d0.y - d2.y);
      const float2 a5 = mk2(d1.x + d3.x, d1.y + d3.y), u7 = mk2(d1.x - d3.x, d1.y - d3.y);
      const float2 a7 = mk2(u7.y, -u7.x);
      *p0 = make_float4(a0.x + a1.x, a0.y + a1.y, a0.x - a1.x, a0.y - a1.y);
      *p1 = make_float4(a2.x + a3.x, a2.y + a3.y, a2.x - a3.x, a2.y - a3.y);
      *p2 = make_float4(a4.x + a5.x, a4.y + a5.y, a4.x - a5.x, a4.y - a5.y);
      *p3 = make_float4(a6.x + a7.x, a6.y + a7.y, a6.x - a7.x, a6.y - a7.y);
    } else {
      const float2 z0 = mk2(e0.x + e1.x, e0.y + e1.y), z1 = mk2(e0.x - e1.x, e0.y - e1.y);
      const float2 z2 = mk2(e2.x + e3.x, e2.y + e3.y), z3 = mk2(e2.x - e3.x, e2.y - e3.y);
      const float2 z4 = mk2(e4.x + e5.x, e4.y + e5.y), z5 = mk2(e4.x - e5.x, e4.y - e5.y);
      const float2 z6 = mk2(e6.x + e7.x, e6.y + e7.y), z7 = mk2(e6.x - e7.x, e6.y - e7.y);
      const float2 b3 = mk2(-z3.y, z3.x), b7 = mk2(-z7.y, z7.x);
      const float2 y0 = mk2(z0.x + z2.x, z0.y + z2.y), y2 = mk2(z0.x - z2.x, z0.y - z2.y);
      const float2 y1 = mk2(z1.x + b3.x, z1.y + b3.y), y3 = mk2(z1.x - b3.x, z1.y - b3.y);
      const float2 y4 = mk2(z4.x + z6.x, z4.y + z6.y), y6 = mk2(z4.x - z6.x, z4.y - z6.y);
      const float2 y5 = mk2(z5.x + b7.x, z5.y + b7.y), y7 = mk2(z5.x - b7.x, z5.y - b7.y);
      const float2 c4 = y4;
      const float2 c5 = mk2((y5.x - y5.y) * R, (y5.x + y5.y) * R);
      const float2 c6 = mk2(-y6.y, y6.x);
      const float2 c7 = mk2(-(y7.x + y7.y) * R, (y7.x - y7.y) * R);
      *p0 = make_float4(y0.x + c4.x, y0.y + c4.y, y1.x + c5.x, y1.y + c5.y);
      *p1 = make_float4(y2.x + c6.x, y2.y + c6.y, y3.x + c7.x, y3.y + c7.y);
      *p2 = make_float4(y0.x - c4.x, y0.y - c4.y, y1.x - c5.x, y1.y - c5.y);
      *p3 = make_float4(y2.x - c6.x, y2.y - c6.y, y3.x - c7.x, y3.y - c7.y);
    }
  }
}
template <bool DATA = false>
DI void fft_fwd(float2* x, int tid, const float2* __restrict__ tw) {
  r4_pass<8, false, false, false, DATA>(x, tid, 2048, tw + 4095, tw + 2047);
  r4_pass<2, false>(x, tid, 512, tw + 1023, tw + 511);
  r4_pass<1, false>(x, tid, 128, tw + 255, tw + 127);
  r4_pass<1, false, false, true>(x, tid, 32, tw + 63, tw + 31);
  r4_pass<1, false, true, true>(x, tid, 8, tw + 15, tw + 7);
  __syncthreads();
  r8_tail<false>(x, tid);
  __syncthreads();
}
template <bool DATA = false>
DI void fft_inv(float2* x, int tid, const float2* __restrict__ tw) {
  __syncthreads();
  r8_tail<true>(x, tid);
  r4_pass<1, true, true, true>(x, tid, 8, tw + 15, tw + 7);
  r4_pass<1, true, true, false>(x, tid, 32, tw + 63, tw + 31);
  r4_pass<1, true>(x, tid, 128, tw + 255, tw + 127);
  r4_pass<2, true>(x, tid, 512, tw + 1023, tw + 511);
  r4_pass<8, true, false, false, DATA>(x, tid, 2048, tw + 4095, tw + 2047);
  __syncthreads();
}

DI float hy_conv(const u16* __restrict__ pr, int t, float w0, float w1, float w2, float cb) {
  const float a = t > 0 ? bf2f(pr[t - 1]) : 0.f;
  const float b = bf2f(pr[t]);
  const float c = t < 4095 ? bf2f(pr[t + 1]) : 0.f;
  return w0 * a + w1 * b + w2 * c + cb;
}

DI void hy_conv4(const u16* __restrict__ pr, int t0, float w0, float w1, float w2, float cb, float (&o)[4]) {
  const ushort4 c = *(const ushort4*)(pr + t0);
  const float pm = t0 > 0 ? bf2f(pr[t0 - 1]) : 0.f;
  const float pn = t0 + 4 < 4096 ? bf2f(pr[t0 + 4]) : 0.f;
  const float x0 = bf2f(c.x), x1 = bf2f(c.y), x2 = bf2f(c.z), x3 = bf2f(c.w);
  o[0] = w0 * pm + w1 * x0 + w2 * x1 + cb;
  o[1] = w0 * x0 + w1 * x1 + w2 * x2 + cb;
  o[2] = w0 * x1 + w1 * x2 + w2 * x3 + cb;
  o[3] = w0 * x2 + w1 * x3 + w2 * pn + cb;
}

DI void hyena_unit(const Params& p, int ch, char* smem) {
  float2* buf = (float2*)smem;
  const int tid = opaque_tid();
  const u16* hyT = (const u16*)(p.ws + OFF_HYT);
  const float* filt = (const float*)(p.ws + OFF_FILT);
  float* z2T = (float*)(p.ws + OFF_Z2T);
  const float2* tw = (const float2*)(p.ws + OFF_TW);
  float2 Kr[32];
  float* k1buf_base = (float*)(p.ws + OFF_FILT);
  {
    const float* kf0 = filt + (size_t)(0 * 512 + ch) * 4096;
    const float* kf1 = filt + (size_t)(1 * 512 + ch) * 4096;
    const float* kb0 = filt + (size_t)(2 * 512 + ch) * 4096;
    const float* kb1 = filt + (size_t)(3 * 512 + ch) * 4096;
    const float fb0 = p.filt_bias[ch], fb1 = p.filt_bias[512 + ch];
    __syncthreads();
#pragma unroll
    for (int g = 0; g < 4; ++g) {
      const int n0 = g * 1024 + tid * 4;
      float4 v0 = *(const float4*)(kf0 + n0), v1 = *(const float4*)(kf1 + n0);
      if (n0 == 0) { v0.x += fb0; v1.x += fb1; }
      const float4 r0 = *(const float4*)(kb0 + 4092 - n0), r1 = *(const float4*)(kb1 + 4092 - n0);
      const float e00 = (n0 == 0) ? 0.f : kb0[4096 - n0], e01 = (n0 == 0) ? 0.f : kb1[4096 - n0];
      *(float4*)(buf + n0) = make_float4(v0.x, v1.x, v0.y, v1.y);
      *(float4*)(buf + n0 + 2) = make_float4(v0.z, v1.z, v0.w, v1.w);
      *(float4*)(buf + 4096 + n0) = make_float4(e00, e01, r0.w, r1.w);
      *(float4*)(buf + 4096 + n0 + 2) = make_float4(r0.z, r1.z, r0.y, r1.y);
    }
    fft_fwd(buf, tid, tw);
    const float sc = 0.5f / 8192.f;
#pragma unroll
    for (int j = 0; j < 32; ++j) {
      const int P = tid + 256 * j;
      const int f = (int)(__brev((unsigned)lx(P)) >> 19);
      const int Pq = lx((int)(__brev((unsigned)((8192 - f) & 8191)) >> 19));
      const float2 zp = buf[P], zq = buf[Pq];
      Kr[j] = make_float2(sc * (zp.x + zq.x), sc * (zp.y - zq.y));
      const float2 k1 = make_float2(sc * (zp.y + zq.y), sc * (zq.x - zp.x));
      *(float2*)(k1buf_base + ((size_t)((P >> 11) * 512 + ch)) * 4096 + (P & 2047) * 2) = k1;
    }
  }
#pragma unroll 1
  for (int ord = 0; ord < 2; ++ord) {
    if (ord == 1) {
#pragma unroll
      for (int j = 0; j < 32; ++j) {
        const int P = tid + 256 * j;
        Kr[j] = *(const float2*)(k1buf_base + ((size_t)((P >> 11) * 512 + ch)) * 4096 + (P & 2047) * 2);
      }
    }
    const int gcol = 1024 + (1 + ord) * 512 + ch;
    const float gw0 = p.conv_w[gcol], gw1 = p.conv_w[2560 + gcol], gw2 = p.conv_w[5120 + gcol], gcb = p.conv_b[gcol];
    const int vcol = 1024 + ch;
    const float vw0 = p.conv_w[vcol], vw1 = p.conv_w[2560 + vcol], vw2 = p.conv_w[5120 + vcol], vcb = p.conv_b[vcol];
#pragma unroll 1
    for (int pr = 0; pr < 2; ++pr) {
      const int b0 = 2 * pr, b1 = 2 * pr + 1;
      __syncthreads();
      if (ord == 0) {
        const u16* u0 = hyT + ((size_t)((0 * 4 + b0) * 512 + ch)) * 4096;
        const u16* u1 = hyT + ((size_t)((0 * 4 + b1) * 512 + ch)) * 4096;
#pragma unroll
        for (int g = 0; g < 4; ++g) {
          const int t0 = g * 1024 + tid * 4;
          float a[4], b[4];
          hy_conv4(u0, t0, vw0, vw1, vw2, vcb, a);
          hy_conv4(u1, t0, vw0, vw1, vw2, vcb, b);
          *(float4*)(buf + t0) = make_float4(a[0], b[0], a[1], b[1]);
          *(float4*)(buf + t0 + 2) = make_float4(a[2], b[2], a[3], b[3]);
        }
      } else {
        const float* u0 = z2T + ((size_t)(b0 * 512 + ch)) * 4096;
        const float* u1 = z2T + ((size_t)(b1 * 512 + ch)) * 4096;
#pragma unroll
        for (int g = 0; g < 4; ++g) {
          const int t0 = g * 1024 + tid * 4;
          const float4 a = *(const float4*)(u0 + t0);
          const float4 b = *(const float4*)(u1 + t0);
          *(float4*)(buf + t0) = make_float4(a.x, b.x, a.y, b.y);
          *(float4*)(buf + t0 + 2) = make_float4(a.z, b.z, a.w, b.w);
        }
      }
      fft_fwd<true>(buf, tid, tw);
#pragma unroll
      for (int j = 0; j < 32; ++j) {
        const float2 v = buf[tid + 256 * j];
        buf[tid + 256 * j] = make_float2(v.x * Kr[j].x - v.y * Kr[j].y, v.x * Kr[j].y + v.y * Kr[j].x);
      }
      fft_inv<true>(buf, tid, tw);
      const u16* g0 = hyT + ((size_t)(((1 + ord) * 4 + b0) * 512 + ch)) * 4096;
      const u16* g1 = hyT + ((size_t)(((1 + ord) * 4 + b1) * 512 + ch)) * 4096;
      float* o0 = z2T + ((size_t)(b0 * 512 + ch)) * 4096;
      float* o1 = z2T + ((size_t)(b1 * 512 + ch)) * 4096;
#pragma unroll
      for (int g = 0; g < 4; ++g) {
        const int t0 = g * 1024 + tid * 4;
        const float4 y01 = *(const float4*)(buf + t0);
        const float4 y23 = *(const float4*)(buf + t0 + 2);
        float ga[4], gb[4];
        hy_conv4(g0, t0, gw0, gw1, gw2, gcb, ga);
        hy_conv4(g1, t0, gw0, gw1, gw2, gcb, gb);
        *(float4*)(o0 + t0) = make_float4(ga[0] * y01.x, ga[1] * y01.z, ga[2] * y23.x, ga[3] * y23.z);
        *(float4*)(o1 + t0) = make_float4(gb[0] * y01.y, gb[1] * y01.w, gb[2] * y23.y, gb[3] * y23.w);
      }
    }
  }
  __syncthreads();
}

DI void mlstm_local_unit(const Params& p, int u, char* smem) {
  float* s_gi = (float*)smem;
  float* s_lf = s_gi + 128;
  float* s_a = s_lf + 128;
  float* s_w = s_a + 128;
  const int tid = opaque_tid(), lane = tid & 63, wave = tid >> 6, lr = lane & 31, hh = lane >> 5;
  const int j = u & 31, dir = (u >> 5) & 1, bh = u >> 6, h = bh & 3, b = bh >> 2;
  const int T0 = b * 4096 + j * 128;
  const float* gates = (const float*)(p.ws + OFF_GATES);
  const u16* vT = (const u16*)(p.ws + OFF_VT);
  const u16* kaT = (const u16*)(p.ws + OFF_KAT);
  float* CL = p.out;
  float* nl = (float*)(p.ws + OFF_NL);
  float* mloc = (float*)(p.ws + OFF_MLOC);
  float* gsum = (float*)(p.ws + OFF_GSUM);
  __syncthreads();
  if (tid < 128) {
    const int T = T0 + tid;
    s_gi[tid] = gates[(size_t)T * 16 + dir * 8 + h] + p.b_gates[dir * 8 + h];
    s_lf[tid] = log_sigmoid(gates[(size_t)T * 16 + dir * 8 + 4 + h] + p.b_gates[dir * 8 + 4 + h]);
  }
  __syncthreads();
  float gtot = 0.f;
  if (tid < 128) {
    float pre = 0.f;
#pragma unroll 4
    for (int m = 0; m < 128; ++m) {
      const float v = s_lf[m];
      if (m < tid) pre += v;
      gtot += v;
    }
    s_a[tid] = (dir == 0) ? (gtot - pre - s_lf[tid] + s_gi[tid]) : (pre + s_gi[tid]);
  }
  __syncthreads();
  if (tid < 128) {
    float mx = -3.0e38f;
#pragma unroll 4
    for (int m = 0; m < 128; ++m) mx = fmaxf(mx, s_a[m]);
    s_w[tid] = expf(s_a[tid] - mx);
    if (tid == 0) { mloc[u] = mx; gsum[u] = gtot; }
  }
  __syncthreads();
  f32x16 acc[4];
#pragma unroll
  for (int d = 0; d < 4; ++d)
#pragma unroll
    for (int r = 0; r < 16; ++r) acc[d][r] = 0.f;
  const u16* vrow = vT + ((size_t)(bh * 128 + wave * 32 + lr)) * 4096 + j * 128 + hh * 8;
  const u16* kbase = kaT + ((size_t)(bh * 128 + lr)) * 4096 + j * 128 + hh * 8;
#pragma unroll 4
  for (int ks = 0; ks < 8; ++ks) {
    const bf16x8 av = *(const bf16x8*)(vrow + ks * 16);
    bf16x8 a;
#pragma unroll
    for (int i = 0; i < 8; ++i) a[i] = (short)f2bf(bf2f((u16)av[i]) * s_w[ks * 16 + hh * 8 + i]);
#pragma unroll
    for (int dt = 0; dt < 4; ++dt) {
      const bf16x8 bk = *(const bf16x8*)(kbase + (size_t)(dt * 32) * 4096 + ks * 16);
      acc[dt] = MFMA(a, bk, acc[dt]);
    }
  }
  {
    char* wl = smem + 4096 + wave * 8192;
#pragma unroll
    for (int dt = 0; dt < 4; ++dt)
#pragma unroll
      for (int r = 0; r < 16; ++r) *(u16*)(wl + crow(r, hh) * 256 + (dt * 32 + lr) * 2) = f2bf(acc[dt][r]);
    wave_lds_sync();
    u16* dst = (u16*)CL + (size_t)u * 16384 + (size_t)(wave * 32) * 128;
#pragma unroll
    for (int i = 0; i < 8; ++i) {
      const int q = lane + 64 * i, row = q >> 4, ch = q & 15;
      *(uint4*)(dst + row * 128 + ch * 8) = *(const uint4*)(wl + row * 256 + ch * 16);
    }
  }
  if (tid < 128) {
    const u16* kr = kaT + ((size_t)(bh * 128 + tid)) * 4096 + j * 128;
    float s = 0.f;
#pragma unroll 2
    for (int l = 0; l < 128; l += 8) {
      const bf16x8 kv = *(const bf16x8*)(kr + l);
#pragma unroll
      for (int i = 0; i < 8; ++i) s += s_w[l + i] * bf2f((u16)kv[i]);
    }
    nl[(size_t)u * 128 + tid] = s;
  }
}

DI void scan_unit(const Params& p, int unit) {
  const int tid = opaque_tid();
  const int sc = unit >> 4, part = unit & 15, dir = sc & 1;
  u16* CL = (u16*)p.out;
  float* nl = (float*)(p.ws + OFF_NL);
  const float* mloc = (const float*)(p.ws + OFF_MLOC);
  const float* gsum = (const float*)(p.ws + OFF_GSUM);
  float* ms = (float*)(p.ws + OFF_MS);
  const int idx = part * 1024 + tid * 4;
  float4 C = make_float4(0.f, 0.f, 0.f, 0.f);
  float nst = 0.f, m = 0.f;
  const bool do_n = (part == 0) && (tid < 128);
  ushort4 pf[4];
#pragma unroll
  for (int q = 0; q < 4; ++q) {
    const int jj = dir ? 31 - q : q;
    pf[q] = *(const ushort4*)(CL + (size_t)(sc * 32 + jj) * 16384 + idx);
  }
#pragma unroll 1
  for (int c0 = 0; c0 < 32; c0 += 4) {
#pragma unroll
    for (int q = 0; q < 4; ++q) {
      const int c = c0 + q;
      const int jj = dir ? 31 - c : c;
      const int u = sc * 32 + jj;
      const float4 cl = make_float4(bf2f(pf[q].x), bf2f(pf[q].y), bf2f(pf[q].z), bf2f(pf[q].w));
      { ushort4 cs; cs.x = f2bf(C.x); cs.y = f2bf(C.y); cs.z = f2bf(C.z); cs.w = f2bf(C.w); *(ushort4*)(CL + (size_t)u * 16384 + idx) = cs; }
      if (c + 4 < 32) {
        const int j2 = dir ? 31 - (c + 4) : (c + 4);
        pf[q] = *(const ushort4*)(CL + (size_t)(sc * 32 + j2) * 16384 + idx);
      }
      const float g = gsum[u], ml = mloc[u];
      const float mn = fmaxf(g + m, ml);
      const float dec = expf(g + m - mn), scl = expf(ml - mn);
      C.x = dec * C.x + scl * cl.x; C.y = dec * C.y + scl * cl.y; C.z = dec * C.z + scl * cl.z; C.w = dec * C.w + scl * cl.w;
      if (do_n) {
        const float nv = nl[(size_t)u * 128 + tid];
        nl[(size_t)u * 128 + tid] = nst;
        nst = dec * nst + scl * nv;
      }
      if (part == 0 && tid == 0) ms[u] = m;
      m = mn;
    }
  }
}

template <int DIR>
DI void mlstm_dir(const Params& p, int bh, int j, char* smem, f32x16 (&hs)[4]) {
  float* s_gi = (float*)smem;
  float* s_lf = s_gi + 128;
  float* s_bc = s_lf + 128;
  float* s_r = s_bc + 128;
  float* s_al = s_r + 128;
  float* s_fl = s_al + 128;
  float* s_is = s_fl + 128;
  const int tid = opaque_tid(), lane = tid & 63, wave = tid >> 6, lr = lane & 31, hh = lane >> 5;
  u16* Pl = (u16*)(smem + 4096) + wave * (32 * 136);
  const int h = bh & 3, b = bh >> 2;
  const int T0 = b * 4096 + j * 128;
  const float* gates = (const float*)(p.ws + OFF_GATES);
  const u16* qa = (const u16*)(p.ws + OFF_QA);
  const u16* ka = (const u16*)(p.ws + OFF_KA);
  const u16* vT = (const u16*)(p.ws + OFF_VT);
  const float* CS = p.out;
  const float* ns = (const float*)(p.ws + OFF_NL);
  const float* ms = (const float*)(p.ws + OFF_MS);
  u16* A2 = (u16*)(p.ws + OFF_A2);
  bf16x8 ones;
#pragma unroll
  for (int i = 0; i < 8; ++i) ones[i] = (short)0x3F80;
  const u16* qrow = qa + (size_t)(T0 + wave * 32 + lr) * 512 + h * 128 + hh * 8;
  const int u = (bh * 2 + DIR) * 32 + j;
  const float msu = ms[u];
  __syncthreads();
  if (tid < 128) {
    const int T = T0 + tid;
    s_gi[tid] = gates[(size_t)T * 16 + DIR * 8 + h] + p.b_gates[DIR * 8 + h];
    s_lf[tid] = log_sigmoid(gates[(size_t)T * 16 + DIR * 8 + 4 + h] + p.b_gates[DIR * 8 + 4 + h]);
  }
  __syncthreads();
  if (tid < 128) {
    float a = 0.f;
#pragma unroll 4
    for (int m = 0; m < 128; ++m) {
      const bool in = (DIR == 0) ? (m <= tid) : (m >= tid);
      a += in ? s_lf[m] : 0.f;
    }
    s_bc[tid] = a;
    s_r[tid] = s_gi[tid] - a;
  }
  __syncthreads();
  if (tid < 128) {
    float cm = -3.0e38f;
#pragma unroll 4
    for (int m = 0; m < 128; ++m) {
      const bool in = (DIR == 0) ? (m <= tid) : (m >= tid);
      cm = in ? fmaxf(cm, s_r[m]) : cm;
    }
    const float bc = s_bc[tid];
    const float mt = bc + fmaxf(msu, cm);
    s_al[tid] = bc - mt;
    s_fl[tid] = expf(-mt);
    s_is[tid] = expf(bc + msu - mt);
  }
  __syncthreads();
  char* Kt = smem + 4096;
  char* R2 = smem + 40960;
  {
#pragma unroll
    for (int bt = 0; bt < 2; ++bt) {
      uint4 kq[4];
#pragma unroll
      for (int i = 0; i < 4; ++i) {
        const int q = tid + 256 * (bt * 4 + i), row = q >> 4, ch = q & 15;
        kq[i] = *(const uint4*)(ka + (size_t)(T0 + row) * 512 + h * 128 + ch * 8);
      }
#pragma unroll
      for (int i = 0; i < 4; ++i) {
        const int q = tid + 256 * (bt * 4 + i), row = q >> 4, ch = q & 15;
        *(uint4*)(Kt + row * 256 + ((ch ^ (row & 15)) << 4)) = kq[i];
      }
    }
  }
  __syncthreads();
  {
    f32x16 S[4];
#pragma unroll
    for (int st = 0; st < 4; ++st)
#pragma unroll
      for (int r = 0; r < 16; ++r) S[st][r] = 0.f;
#pragma unroll 4
    for (int ks = 0; ks < 8; ++ks) {
      const bf16x8 a = *(const bf16x8*)(qrow + ks * 16);
#pragma unroll
      for (int st = 0; st < 4; ++st) {
        const int krow = st * 32 + lr;
        const bf16x8 bk = *(const bf16x8*)(Kt + krow * 256 + (((ks * 2 + hh) ^ (krow & 15)) << 4));
        S[st] = MFMA(a, bk, S[st]);
      }
    }
    __syncthreads();
#pragma unroll
    for (int st = 0; st < 4; ++st) {
      const int sl = st * 32 + lr;
      const float rs = s_r[sl];
#pragma unroll
      for (int r = 0; r < 16; ++r) {
        const int tl = wave * 32 + crow(r, hh);
        const bool valid = (DIR == 0) ? (sl <= tl) : (sl >= tl);
        const float pv = valid ? S[st][r] * __expf(s_al[tl] + rs) : 0.f;
        Pl[crow(r, hh) * 136 + sl] = f2bf(pv);
      }
    }
  }
#pragma unroll
  for (int eh = 0; eh < 2; ++eh) {
    f32x16 N[3];
#pragma unroll
    for (int e = 0; e < 3; ++e)
#pragma unroll
      for (int r = 0; r < 16; ++r) N[e][r] = 0.f;
    {
      uint4 vq[4];
#pragma unroll
      for (int i = 0; i < 4; ++i) {
        const int q = tid + 256 * i, row = q >> 4, ch = q & 15;
        vq[i] = *(const uint4*)(vT + ((size_t)(bh * 128 + eh * 64 + row)) * 4096 + j * 128 + ch * 8);
      }
#pragma unroll
      for (int i = 0; i < 4; ++i) {
        const int q = tid + 256 * i, row = q >> 4, ch = q & 15;
        *(uint4*)(R2 + row * 256 + ((ch ^ (row & 15)) << 4)) = vq[i];
      }
    }
    __syncthreads();
    {
#pragma unroll 4
      for (int ks = 0; ks < 8; ++ks) {
        const bf16x8 a = *(const bf16x8*)(Pl + lr * 136 + ks * 16 + hh * 8);
#pragma unroll
        for (int e2 = 0; e2 < 2; ++e2) {
          const int vrow = e2 * 32 + lr;
          const bf16x8 bv = *(const bf16x8*)(R2 + vrow * 256 + (((ks * 2 + hh) ^ (vrow & 15)) << 4));
          N[e2] = MFMA(a, bv, N[e2]);
        }
        N[2] = MFMA(a, ones, N[2]);
      }
    }
    {
      bf16x8 cq[4];
#pragma unroll
      for (int i = 0; i < 4; ++i) {
        const int q = tid + 256 * i, row = q >> 4, ch = q & 15;
        cq[i] = *(const bf16x8*)((const u16*)CS + (size_t)u * 16384 + (size_t)(eh * 64 + row) * 128 + ch * 8);
      }
      __syncthreads();
#pragma unroll
      for (int i = 0; i < 4; ++i) {
        const int q = tid + 256 * i, row = q >> 4, ch = q & 15;
        *(bf16x8*)(R2 + row * 256 + ((ch ^ (row & 15)) << 4)) = cq[i];
      }
    }
    __syncthreads();
    {
      const float isc = s_is[wave * 32 + lr];
      const float* nbase = ns + (size_t)u * 128 + hh * 8;
#pragma unroll 4
      for (int ks = 0; ks < 8; ++ks) {
        const bf16x8 aq = *(const bf16x8*)(qrow + ks * 16);
        const bf16x8 a = scale8(aq, isc);
#pragma unroll
        for (int e2 = 0; e2 < 2; ++e2) {
          const int crw = e2 * 32 + lr;
          const bf16x8 bc = *(const bf16x8*)(R2 + crw * 256 + (((ks * 2 + hh) ^ (crw & 15)) << 4));
          N[e2] = MFMA(a, bc, N[e2]);
        }
        const float4 n0 = *(const float4*)(nbase + ks * 16);
        const float4 n1 = *(const float4*)(nbase + ks * 16 + 4);
        const float nv[8] = {n0.x, n0.y, n0.z, n0.w, n1.x, n1.y, n1.z, n1.w};
        N[2] = MFMA(a, pack8(nv), N[2]);
      }
    }
    __syncthreads();
    u16* park = (u16*)(p.ws + OFF_HYT) + ((size_t)(bh * 32 + j) * 256 + tid) * 64 + eh * 32;
    bf16x8 pk[4];
    if (DIR == 1) {
#pragma unroll
      for (int q = 0; q < 4; ++q) pk[q] = *(const bf16x8*)(park + q * 8);
    }
#pragma unroll
    for (int r = 0; r < 16; ++r) {
      const int tl = wave * 32 + crow(r, hh);
      const float den = fmaxf(fabsf(N[2][r]), s_fl[tl]);
      const float inv = 1.f / den;
#pragma unroll
      for (int e2 = 0; e2 < 2; ++e2) {
        const float hv = N[e2][r] * inv;
        const int v = e2 * 16 + r;
        if (DIR == 0) pk[v >> 3][v & 7] = (short)f2bf(hv);
        else hs[eh * 2 + e2][r] = hv + bf2f((u16)pk[v >> 3][v & 7]);
      }
    }
    if (DIR == 0) {
#pragma unroll
      for (int q = 0; q < 4; ++q) *(bf16x8*)(park + q * 8) = pk[q];
    }
  }
}

DI void mlstm_out_unit(const Params& p, int unit, char* smem) {
  const int tid = opaque_tid(), lane = tid & 63, wave = tid >> 6, lr = lane & 31, hh = lane >> 5;
  const int j = unit & 31, bh = unit >> 5, h = bh & 3, b = bh >> 2;
  const int T0 = b * 4096 + j * 128;
  const u16* og = (const u16*)(p.ws + OFF_OG);
  u16* A2 = (u16*)(p.ws + OFF_A2);
  f32x16 hs[4];
  mlstm_dir<0>(p, bh, j, smem, hs);
  mlstm_dir<1>(p, bh, j, smem, hs);
  __syncthreads();
  float* wl = (float*)(smem + wave * 16384);
#pragma unroll
  for (int et = 0; et < 4; ++et)
#pragma unroll
    for (int r = 0; r < 16; ++r) wl[crow(r, hh) * 128 + et * 32 + lr] = hs[et][r];
  wave_lds_sync();
  {
    const int row = lane >> 1, half = lane & 1;
    const size_t T = (size_t)(T0 + wave * 32 + row);
    const u16* ogp = og + T * 512 + h * 128 + half * 64;
    const float* src = wl + row * 128 + half * 64;
    float g[64];
    float ss = 0.f;
#pragma unroll
    for (int q = 0; q < 8; ++q) {
      const bf16x8 o8 = *(const bf16x8*)(ogp + q * 8);
      const float4 h0 = *(const float4*)(src + q * 8), h1 = *(const float4*)(src + q * 8 + 4);
      g[q * 8 + 0] = h0.x * bf2f((u16)o8[0]); g[q * 8 + 1] = h0.y * bf2f((u16)o8[1]); g[q * 8 + 2] = h0.z * bf2f((u16)o8[2]); g[q * 8 + 3] = h0.w * bf2f((u16)o8[3]);
      g[q * 8 + 4] = h1.x * bf2f((u16)o8[4]); g[q * 8 + 5] = h1.y * bf2f((u16)o8[5]); g[q * 8 + 6] = h1.z * bf2f((u16)o8[6]); g[q * 8 + 7] = h1.w * bf2f((u16)o8[7]);
#pragma unroll
      for (int i = 0; i < 8; ++i) ss += g[q * 8 + i] * g[q * 8 + i];
    }
    ss += __shfl_xor(ss, 1, 64);
    const float rs = rsqrtf(ss * (1.f / 128.f) + EPS);
    const float* mw = p.mlstm_norm_w + h * 128 + half * 64;
    u16* dst = A2 + T * 1024 + h * 128 + half * 64;
#pragma unroll
    for (int q = 0; q < 8; ++q) {
      const float4 w0 = *(const float4*)(mw + q * 8), w1 = *(const float4*)(mw + q * 8 + 4);
      float o[8];
      o[0] = g[q * 8 + 0] * rs * w0.x; o[1] = g[q * 8 + 1] * rs * w0.y; o[2] = g[q * 8 + 2] * rs * w0.z; o[3] = g[q * 8 + 3] * rs * w0.w;
      o[4] = g[q * 8 + 4] * rs * w1.x; o[5] = g[q * 8 + 5] * rs * w1.y; o[6] = g[q * 8 + 6] * rs * w1.z; o[7] = g[q * 8 + 7] * rs * w1.w;
      *(bf16x8*)(dst + q * 8) = pack8(o);
    }
  }
}

DI void hyena_norm_unit(const Params& p, int unit, char* smem) {
  float* tile = (float*)smem;
  const int tid = opaque_tid();
  const int tt = unit & 63, g = (unit >> 6) & 7, b = unit >> 9;
  const float* z2T = (const float*)(p.ws + OFF_Z2T);
  u16* A2 = (u16*)(p.ws + OFF_A2);
  __syncthreads();
#pragma unroll 4
  for (int i = 0; i < 16; ++i) {
    const int cl = (tid >> 6) + 4 * i, tl = tid & 63;
    tile[cl * 65 + tl] = z2T[((size_t)(b * 512 + g * 64 + cl)) * 4096 + tt * 64 + tl];
  }
  __syncthreads();
  const int tl = tid >> 2, qd = tid & 3;
  float v[16];
  float ss = 0.f;
#pragma unroll
  for (int i = 0; i < 16; ++i) {
    v[i] = tile[(qd * 16 + i) * 65 + tl];
    ss += v[i] * v[i];
  }
  ss += __shfl_xor(ss, 1, 64);
  ss += __shfl_xor(ss, 2, 64);
  const float rs = rsqrtf(ss * (1.f / 64.f) + EPS);
  const size_t T = (size_t)b * 4096 + tt * 64 + tl;
  u16* dst = A2 + T * 1024 + 512 + g * 64 + qd * 16;
  const float* w = p.hyena_norm_w + g * 64 + qd * 16;
  float o[16];
#pragma unroll
  for (int i = 0; i < 16; ++i) o[i] = v[i] * rs * w[i];
  *(bf16x8*)(dst) = pack8(o);
  *(bf16x8*)(dst + 8) = pack8(o + 8);
}

template <int EPI>
DI void gemm_phase(const u16* A, const u16* Bt, int K, int ntn, void* outp, char* smem) {
  const int tid = threadIdx.x, lane = tid & 63, wave = tid >> 6, wr = wave >> 1, wc = wave & 1, lr = lane & 31, hh = lane >> 5;
  const int ntiles = tile_count(ntn);
  for (int id = blockIdx.x; id < ntiles; id += gridDim.x) {
    int mt, nt;
    tile_map(id, ntn, mt, nt);
    if (nt >= ntn) continue;
    const int m0 = mt * 256, n0 = nt * 128;
    f32x16 acc[4][2];
    gemm_core<false>(A, Bt, K, m0, n0, smem, acc);
    if (EPI == 0) {
#pragma unroll
      for (int i = 0; i < 4; ++i)
#pragma unroll
        for (int j = 0; j < 2; ++j)
#pragma unroll
          for (int r = 0; r < 16; ++r) {
            const int row = m0 + wr * 128 + i * 32 + crow(r, hh);
            const int col = n0 + wc * 64 + j * 32 + lr;
            ((float*)outp)[(size_t)row * 1024 + col] = acc[i][j][r];
          }
    } else {
      char* wl = smem + wave * 16384;
      stage_tile_ns<2>(acc, wl, lr, hh);
      wave_lds_sync();
      flush_tile_ns(wl, (u16*)outp + (size_t)(m0 + wr * 128) * 4096 + n0 + wc * 64, 4096, lane);
    }
  }
}

DI void phase_post_mix(const Params& p) {
  const int tid = threadIdx.x, lane = tid & 63, wave = tid >> 6;
  const float* mix = p.out;
  float* x1 = (float*)(p.ws + OFF_X1);
  u16* hm = (u16*)(p.ws + OFF_HM);
  for (int u = blockIdx.x; u < 1024; u += gridDim.x) {
#pragma unroll 2
    for (int rr = 0; rr < 4; ++rr) {
      const size_t row = (size_t)u * 16 + wave * 4 + rr;
      float4 mv[4], xv[4];
      float ss = 0.f;
#pragma unroll
      for (int i = 0; i < 4; ++i) {
        mv[i] = ((const float4*)(mix + row * DM))[lane + 64 * i];
        xv[i] = ((const float4*)(p.x + row * DM))[lane + 64 * i];
        ss += mv[i].x * mv[i].x + mv[i].y * mv[i].y + mv[i].z * mv[i].z + mv[i].w * mv[i].w;
      }
      ss = wave_sum(ss);
      const float rs = rsqrtf(ss * (1.f / DM) + EPS);
      float s2 = 0.f;
#pragma unroll
      for (int i = 0; i < 4; ++i) {
        const float4 w = ((const float4*)p.norm_mix_post)[lane + 64 * i];
        xv[i].x += mv[i].x * rs * w.x; xv[i].y += mv[i].y * rs * w.y; xv[i].z += mv[i].z * rs * w.z; xv[i].w += mv[i].w * rs * w.w;
        s2 += xv[i].x * xv[i].x + xv[i].y * xv[i].y + xv[i].z * xv[i].z + xv[i].w * xv[i].w;
        ((float4*)(x1 + row * DM))[lane + 64 * i] = xv[i];
      }
      s2 = wave_sum(s2);
      const float r2 = rsqrtf(s2 * (1.f / DM) + EPS);
#pragma unroll
      for (int i = 0; i < 4; ++i) {
        const float4 w = ((const float4*)p.norm_mlp_pre)[lane + 64 * i];
        ushort4 o;
        o.x = f2bf(xv[i].x * r2 * w.x); o.y = f2bf(xv[i].y * r2 * w.y); o.z = f2bf(xv[i].z * r2 * w.z); o.w = f2bf(xv[i].w * r2 * w.w);
        *(ushort4*)(hm + row * DM + (lane + 64 * i) * 4) = o;
      }
    }
  }
}

DI void phase_final(const Params& p) {
  const int tid = threadIdx.x, lane = tid & 63, wave = tid >> 6;
  const float* x1 = (const float*)(p.ws + OFF_X1);
  for (int u = blockIdx.x; u < 1024; u += gridDim.x) {
#pragma unroll 2
    for (int rr = 0; rr < 4; ++rr) {
      const size_t row = (size_t)u * 16 + wave * 4 + rr;
      float4 fv[4];
      float ss = 0.f;
#pragma unroll
      for (int i = 0; i < 4; ++i) {
        fv[i] = ((const float4*)(p.out + row * DM))[lane + 64 * i];
        ss += fv[i].x * fv[i].x + fv[i].y * fv[i].y + fv[i].z * fv[i].z + fv[i].w * fv[i].w;
      }
      ss = wave_sum(ss);
      const float rs = rsqrtf(ss * (1.f / DM) + EPS);
#pragma unroll
      for (int i = 0; i < 4; ++i) {
        const float4 w = ((const float4*)p.norm_mlp_post)[lane + 64 * i];
        const float4 xv = ((const float4*)(x1 + row * DM))[lane + 64 * i];
        float4 o;
        o.x = xv.x + fv[i].x * rs * w.x; o.y = xv.y + fv[i].y * rs * w.y; o.z = xv.z + fv[i].z * rs * w.z; o.w = xv.w + fv[i].w * rs * w.w;
        ((float4*)(p.out + row * DM))[lane + 64 * i] = o;
      }
    }
  }
}

DI void run_phase(const Params& p, int ph, char* smem) {
  switch (ph) {
    case 0: phase0(p, smem); break;
    case 1: phase1(p, smem); break;
    case 2: phase_qk(p, smem); break;
    case 3:
#ifdef DBL_HYONLY
      for (int u = blockIdx.x; u < 512; u += gridDim.x) hyena_unit(p, u, smem);
#endif
#ifdef DBL_MLONLY
      for (int u = blockIdx.x; u < 1024; u += gridDim.x) mlstm_local_unit(p, u, smem);
#endif
      for (int u = blockIdx.x; u < 512 + 1024; u += gridDim.x) {
        if (u < 512) hyena_unit(p, u, smem);
        else mlstm_local_unit(p, u - 512, smem);
      }
      break;
    case 4:
      for (int u = blockIdx.x; u < 512; u += gridDim.x) scan_unit(p, u);
      break;
    case 5:
      for (int u = blockIdx.x; u < 512 + 2048; u += gridDim.x) {
#ifndef DBG_SKIP_MLSTM
        if (u < 512) mlstm_out_unit(p, u, smem);
#else
        if (u < 512) { u16* A2 = (u16*)(p.ws + OFF_A2); const int T0 = (u >> 5 >> 2) * 4096 + (u & 31) * 128, hq = (u >> 5) & 3;
          for (int i = threadIdx.x; i < 128 * 128; i += 256) A2[(size_t)(T0 + (i >> 7)) * 1024 + hq * 128 + (i & 127)] = 0; }
#endif
#ifndef DBG_SKIP_HYENA
        else hyena_norm_unit(p, u - 512, smem);
#else
        else { const int un = u - 512; const int tt = un & 63, g = (un >> 6) & 7, b = un >> 9; u16* A2 = (u16*)(p.ws + OFF_A2);
          for (int i = threadIdx.x; i < 64 * 64; i += 256) A2[((size_t)b * 4096 + tt * 64 + (i >> 6)) * 1024 + 512 + g * 64 + (i & 63)] = 0x3F80; }
#endif
      }
      break;
    case 6: gemm_phase<0>((const u16*)(p.ws + OFF_A2), (const u16*)(p.ws + OFF_WOUTT), 1024, 8, p.out, smem); break;
    case 7: phase_post_mix(p); break;
    case 8: gemm_phase<1>((const u16*)(p.ws + OFF_HM), (const u16*)(p.ws + OFF_W1T), 1024, 32, p.ws + OFF_H, smem); break;
    case 9: gemm_phase<0>((const u16*)(p.ws + OFF_H), (const u16*)(p.ws + OFF_W2T), 4096, 8, p.out, smem); break;
    case 10: phase_final(p); break;
  }
}
constexpr int NPHASE = 11;

#define XB_XCNT(j)  (256  + 64 * (j))
#define XB_XSUB(j)  (1280 + 64 * (j))
#define XB_XGEN(j)  (2304 + 64 * (j))
#define XB_TOP      3328
#define XB_TOPGEN   3392
#define XCD_BAR_WORDS 3456
DI unsigned xb_ld(unsigned* p) { return __hip_atomic_load(p, __ATOMIC_RELAXED, __HIP_MEMORY_SCOPE_AGENT); }
DI unsigned xb_add(unsigned* p, unsigned v) { return __hip_atomic_fetch_add(p, v, __ATOMIC_RELAXED, __HIP_MEMORY_SCOPE_AGENT); }
DI unsigned xb_xcc_id() { return (unsigned)__builtin_amdgcn_s_getreg((3 << 11) | 20) & 0xFu; }
struct XcdBar { unsigned* bar; unsigned x, nloc, nx; };
DI void xcd_barrier(XcdBar& b) {
  asm volatile("s_waitcnt vmcnt(0)" ::: "memory");
  __syncthreads();
  if (threadIdx.x == 0) {
    unsigned* bar = b.bar;
    __builtin_amdgcn_s_waitcnt(0);
    if (b.nloc == 0u) {
      const unsigned G = gridDim.x;
      unsigned sum, cnt, mine;
      for (;;) {
        sum = 0u; cnt = 0u; mine = 0u;
#pragma unroll
        for (unsigned j = 0; j < 16; ++j) { const unsigned c = xb_ld(&bar[XB_XCNT(j)]); sum += c; cnt += (c > 0u) ? 1u : 0u; mine = (j == b.x) ? c : mine; }
        if (sum == G) break;
        __builtin_amdgcn_s_sleep(1);
      }
      b.nloc = mine > 0u ? mine : 1u; b.nx = cnt > 0u ? cnt : 1u;
    }
    const unsigned nloc = b.nloc, nx = b.nx;
    const unsigned old = xb_add(&bar[XB_XSUB(b.x)], 1u);
    const unsigned gen = old / nloc;
    if (old + 1u == (gen + 1u) * nloc) {
      __builtin_amdgcn_fence(__ATOMIC_RELEASE, "agent");
      asm volatile("s_waitcnt vmcnt(0)" ::: "memory");
      const unsigned og = xb_add(&bar[XB_TOP], 1u);
      const unsigned tg = og / nx;
      if (og + 1u == (tg + 1u) * nx) xb_add(&bar[XB_TOPGEN], 1u);
      else while (xb_ld(&bar[XB_TOPGEN]) == tg) __builtin_amdgcn_s_sleep(1);
      __builtin_amdgcn_fence(__ATOMIC_ACQUIRE, "agent");
      xb_add(&bar[XB_XGEN(b.x)], 1u);
      asm volatile("s_waitcnt vmcnt(0)" ::: "memory");
    } else {
      while (xb_ld(&bar[XB_XGEN(b.x)]) == gen) __builtin_amdgcn_s_sleep(1);
      __builtin_amdgcn_fence(__ATOMIC_ACQUIRE, "agent");
      asm volatile("s_waitcnt vmcnt(0)" ::: "memory");
    }
  }
  __syncthreads();
}

#if MULTI_LAUNCH
template <int PH>
__global__ void __launch_bounds__(256, 2) phase_kernel(Params p) {
  __shared__ __attribute__((aligned(16))) char smem[65536];
  run_phase(p, PH, smem);
}
template <int PH>
static void launch_phase(const Params& p, hipStream_t stream) {
  hipLaunchKernelGGL(phase_kernel<PH>, dim3(512), dim3(256), 0, stream, p);
}
#else
__global__ void __launch_bounds__(256, 2) mega_kernel(Params p) {
  __shared__ __attribute__((aligned(16))) char smem[65536];
  cg::grid_group grid = cg::this_grid();
  XcdBar xb;
  xb.bar = (unsigned*)(p.ws + OFF_BAR); xb.x = xb_xcc_id(); xb.nloc = 0u; xb.nx = 0u;
  if (p.ws == nullptr) grid.sync();
  if (threadIdx.x == 0) (void)xb_add(&xb.bar[XB_XCNT(xb.x)], 1u);
#define GSYNC xcd_barrier(xb)
#ifdef DBL_P0
  run_phase(p, 0, smem);
#endif
  run_phase(p, 0, smem); GSYNC;
  run_phase(p, 1, smem); GSYNC;
#ifdef DBL_GEMM
  run_phase(p, 1, smem); grid.sync();
#endif
  run_phase(p, 2, smem); GSYNC;
#ifdef DBL_P2
  run_phase(p, 2, smem); GSYNC;
#endif
  run_phase(p, 3, smem); GSYNC;
#ifdef DBL_HY
  run_phase(p, 3, smem); GSYNC;
#endif
  run_phase(p, 4, smem); GSYNC;
  run_phase(p, 5, smem); GSYNC;
#ifdef DBL_P5
  run_phase(p, 5, smem); GSYNC;
#endif
  run_phase(p, 6, smem); GSYNC;
#ifdef DBL_GEMM
  run_phase(p, 6, smem); GSYNC;
#endif
  run_phase(p, 7, smem); GSYNC;
#ifdef DBL_P7
  run_phase(p, 7, smem); GSYNC;
#endif
  run_phase(p, 8, smem); GSYNC;
#ifdef DBL_GEMM
  run_phase(p, 8, smem); GSYNC;
#endif
  run_phase(p, 9, smem); GSYNC;
#ifdef DBL_GEMM
  run_phase(p, 9, smem); GSYNC;
#endif
#ifdef XSYNC
  for (int q = 0; q < 10; ++q) GSYNC;
#endif
  run_phase(p, 10, smem);
}
#endif

extern "C" void kernel_launch(void* const* d_in, const int* in_sizes, int n_in, void* d_out, int out_size, void* d_ws,
                              size_t ws_size, hipStream_t stream) {
  Params p{};
  const float** pp = (const float**)&p;
  for (int i = 0; i < 23; ++i) pp[i] = (const float*)d_in[i];
  p.out = (float*)d_out;
  p.ws = (char*)d_ws;
#if MULTI_LAUNCH
  launch_phase<0>(p, stream);
#ifdef DBL_P0
  launch_phase<0>(p, stream);
#endif
 launch_phase<1>(p, stream); launch_phase<2>(p, stream); launch_phase<3>(p, stream);
#ifdef DBL_HY
  launch_phase<3>(p, stream);
#endif

  launch_phase<4>(p, stream); launch_phase<5>(p, stream);
#ifdef DBL_P5
  launch_phase<5>(p, stream);
#endif
 launch_phase<6>(p, stream); launch_phase<7>(p, stream);
  launch_phase<8>(p, stream); launch_phase<9>(p, stream); launch_phase<10>(p, stream);
#else
  static int grid_blocks = 0;
  if (!grid_blocks) {
    int dev = 0, cus = 0, per_cu = 0;
    hipGetDevice(&dev);
    hipDeviceGetAttribute(&cus, hipDeviceAttributeMultiprocessorCount, dev);
    hipOccupancyMaxActiveBlocksPerMultiprocessor(&per_cu, mega_kernel, 256, 0);
    if (per_cu > 2) per_cu = 2;
    if (per_cu < 1) per_cu = 1;
#ifdef FORCE2
    per_cu = 2;
#endif
    grid_blocks = cus * per_cu;
  }
  hipMemsetAsync((char*)d_ws + OFF_BAR, 0, XCD_BAR_WORDS * 4, stream);
  void* args[] = {&p};
  hipError_t e = hipLaunchCooperativeKernel((void*)mega_kernel, dim3(grid_blocks), dim3(256), args, 0, stream);
  if (e != hipSuccess) fprintf(stderr, "cooperative launch failed: %s (grid %d)\n", hipGetErrorString(e), grid_blocks);
#endif
}
#if defined(__HIP_DEVICE_COMPILE__)
#pragma clang attribute pop
#endif
```

```cpp
#if defined(__HIP_DEVICE_COMPILE__)
#pragma clang attribute push(__attribute__((target("no-packed-fp32-ops"))), apply_to = function)
#endif
#include <hip/hip_runtime.h>
#include <hip/hip_cooperative_groups.h>
#include <cstdio>
namespace cg = cooperative_groups;

#ifndef MULTI_LAUNCH
#define MULTI_LAUNCH 0
#endif

typedef unsigned short u16;
using bf16x8 = __attribute__((ext_vector_type(8))) short;
using f32x16 = __attribute__((ext_vector_type(16))) float;
#define DI __device__ __forceinline__
#define MFMA(a, b, c) __builtin_amdgcn_mfma_f32_32x32x16_bf16((a), (b), (c), 0, 0, 0)

constexpr int SEQ = 4096, DM = 1024, NTOK = 16384, NIN = 3600, NINP = 3712, DFF = 4096;
constexpr float EPS = 1e-6f;
constexpr size_t MiB = 1u << 20;
constexpr size_t OFF_WINT = 0, OFF_WOUTT = 8 * MiB, OFF_W1T = 10 * MiB, OFF_W2T = 18 * MiB;
constexpr size_t OFF_XN = 26 * MiB, OFF_QA = 26 * MiB, OFF_KA = 42 * MiB;
constexpr size_t OFF_FILT = 58 * MiB, OFF_QKPRE = 90 * MiB, OFF_A2 = 90 * MiB;
constexpr size_t OFF_HYT = 122 * MiB, OFF_VT = 170 * MiB, OFF_OG = 186 * MiB, OFF_GATES = 202 * MiB;
constexpr size_t OFF_NL = 203 * MiB, OFF_MLOC = 203 * MiB + 512 * 1024, OFF_GSUM = OFF_MLOC + 4096, OFF_MS = OFF_GSUM + 4096;
constexpr size_t OFF_KAT = 205 * MiB, OFF_Z2T = 221 * MiB;
constexpr size_t OFF_TW = 204 * MiB, OFF_BAR = 254 * MiB;
constexpr size_t OFF_X1 = 26 * MiB, OFF_HM = 90 * MiB, OFF_H = 122 * MiB;

struct Params {
  const float *x, *norm_mix_pre, *norm_mix_post, *norm_mlp_pre, *norm_mlp_post, *w_in, *b_gates, *conv_w, *conv_b,
      *mlstm_norm_w, *hyena_norm_w, *filt_w1, *filt_b1, *filt_w2, *filt_b2, *filt_w3, *filt_b3, *filt_w4, *filt_freq,
      *filt_bias, *w_out, *w_mlp_in, *w_mlp_out;
  float* out;
  char* ws;
};

DI u16 f2bf(float x) { const __bf16 b = (__bf16)x; return __builtin_bit_cast(u16, b); }
DI float bf2f(u16 v) { return __uint_as_float(((unsigned)v) << 16); }
DI int opaque_tid() { int t = threadIdx.x; asm volatile("" : "+v"(t)); return t; }
DI int crow(int r, int hh) { return (r & 3) + 8 * (r >> 2) + 4 * hh; }
DI float log_sigmoid(float x) { return fminf(x, 0.f) - log1pf(expf(-fabsf(x))); }
DI float sigmoidf(float x) { return 1.f / (1.f + __expf(-x)); }
DI float red2pi(float x) {
  const float k = rintf(x * 0.15915494309189535f);
  float r = fmaf(-k, 6.28125f, x);
  return fmaf(-k, 1.9353071795864769e-3f, r);
}
DI float fsin(float x) { return sinf(x); }
DI float fcos(float x) { return cosf(x); }
DI bf16x8 pack8(const float* v) {
  bf16x8 r;
#pragma unroll
  for (int i = 0; i < 8; ++i) r[i] = (short)f2bf(v[i]);
  return r;
}
DI bf16x8 scale8(bf16x8 a, float s) {
  bf16x8 r;
#pragma unroll
  for (int i = 0; i < 8; ++i) r[i] = (short)f2bf(bf2f((u16)a[i]) * s);
  return r;
}

template <bool SWAP>
DI void gemm_core(const u16* __restrict__ A, const u16* __restrict__ Bt, int K, int m0, int n0, char* smem, f32x16 (&acc)[4][2]) {
  const int tid = opaque_tid(), lane = tid & 63, wave = tid >> 6, wr = wave >> 1, wc = wave & 1;
  const int lr = lane & 31, hh = lane >> 5;
#pragma unroll
  for (int i = 0; i < 4; ++i)
#pragma unroll
    for (int j = 0; j < 2; ++j)
#pragma unroll
      for (int r = 0; r < 16; ++r) acc[i][j][r] = 0.f;
  const int c = tid & 7, r0 = tid >> 3;
  const u16* Ag = A + (size_t)(m0 + r0) * K + c * 8;
  const u16* Bg = Bt + (size_t)(n0 + r0) * K + c * 8;
  const int soff = r0 * 128 + ((c ^ ((r0 >> 1) & 7)) << 4);
  char* As = smem;
  char* Bs = smem + 32768;
  uint4 ra0, ra1, ra2, ra3, ra4, ra5, ra6, ra7, rb0, rb1, rb2, rb3;
#define GLOAD_ALL(k0)                                                                                             \
  ra0 = *(const uint4*)(Ag + (size_t)(0) * K + (k0));   ra1 = *(const uint4*)(Ag + (size_t)(32) * K + (k0));      \
  ra2 = *(const uint4*)(Ag + (size_t)(64) * K + (k0));  ra3 = *(const uint4*)(Ag + (size_t)(96) * K + (k0));      \
  ra4 = *(const uint4*)(Ag + (size_t)(128) * K + (k0)); ra5 = *(const uint4*)(Ag + (size_t)(160) * K + (k0));     \
  ra6 = *(const uint4*)(Ag + (size_t)(192) * K + (k0)); ra7 = *(const uint4*)(Ag + (size_t)(224) * K + (k0));     \
  rb0 = *(const uint4*)(Bg + (size_t)(0) * K + (k0));   rb1 = *(const uint4*)(Bg + (size_t)(32) * K + (k0));      \
  rb2 = *(const uint4*)(Bg + (size_t)(64) * K + (k0));  rb3 = *(const uint4*)(Bg + (size_t)(96) * K + (k0));
  GLOAD_ALL(0)
  const int nk = K >> 6;
#pragma unroll 1
  for (int kt = 0; kt < nk; ++kt) {
    __syncthreads();
    *(uint4*)(As + soff + 0 * 4096) = ra0; *(uint4*)(As + soff + 1 * 4096) = ra1; *(uint4*)(As + soff + 2 * 4096) = ra2; *(uint4*)(As + soff + 3 * 4096) = ra3;
    *(uint4*)(As + soff + 4 * 4096) = ra4; *(uint4*)(As + soff + 5 * 4096) = ra5; *(uint4*)(As + soff + 6 * 4096) = ra6; *(uint4*)(As + soff + 7 * 4096) = ra7;
    *(uint4*)(Bs + soff + 0 * 4096) = rb0; *(uint4*)(Bs + soff + 1 * 4096) = rb1; *(uint4*)(Bs + soff + 2 * 4096) = rb2; *(uint4*)(Bs + soff + 3 * 4096) = rb3;
    __syncthreads();
    if (kt + 1 < nk) {
      const int k0 = (kt + 1) << 6;
      GLOAD_ALL(k0)
    }
#pragma unroll
    for (int kk = 0; kk < 4; ++kk) {
      bf16x8 a[4], b[2];
      const int cc = kk * 2 + hh;
#pragma unroll
      for (int i = 0; i < 4; ++i) {
        const int r = wr * 128 + i * 32 + lr;
        a[i] = *(const bf16x8*)(As + r * 128 + ((cc ^ ((r >> 1) & 7)) << 4));
      }
#pragma unroll
      for (int j = 0; j < 2; ++j) {
        const int r = wc * 64 + j * 32 + lr;
        b[j] = *(const bf16x8*)(Bs + r * 128 + ((cc ^ ((r >> 1) & 7)) << 4));
      }
#pragma unroll
      for (int i = 0; i < 4; ++i)
#pragma unroll
        for (int j = 0; j < 2; ++j) acc[i][j] = SWAP ? MFMA(b[j], a[i], acc[i][j]) : MFMA(a[i], b[j], acc[i][j]);
    }
  }
  __syncthreads();
}

DI void tile_map(int id, int ntn, int& mt, int& nt) {
  const int r = id >> 9, b = id & 511;
  const int x = b & 7, sidx = b >> 3;
  const int P = r * 8 + x;
  mt = (P & 7) * 8 + (sidx & 7);
  nt = (P >> 3) * 8 + (sidx >> 3);
}
DI int tile_count(int ntn) { return ((ntn + 7) >> 3) * 512; }

DI void transpose_tile(const float* __restrict__ src, int R, int C, u16* __restrict__ dst, int kt, int nt, char* smem) {
  float* tile = (float*)smem;
  const int tid = threadIdx.x;
  const int k0 = kt * 64, n0 = nt * 64;
#pragma unroll 4
  for (int it = 0; it < 16; ++it) {
    const int kk = it * 4 + (tid >> 6), nn = tid & 63;
    const int n = n0 + nn;
    tile[kk * 65 + nn] = (n < C) ? src[(size_t)(k0 + kk) * C + n] : 0.f;
  }
  __syncthreads();
#pragma unroll
  for (int it = 0; it < 2; ++it) {
    const int q = tid + 256 * it, nn = q >> 3, kc = q & 7;
    float o[8];
#pragma unroll
    for (int i = 0; i < 8; ++i) o[i] = tile[(kc * 8 + i) * 65 + nn];
    *(bf16x8*)(dst + (size_t)(n0 + nn) * R + k0 + kc * 8) = pack8(o);
  }
  __syncthreads();
}

DI float wave_sum(float v) {
#pragma unroll
  for (int o = 32; o; o >>= 1) v += __shfl_xor(v, o, 64);
  return v;
}

DI void filter_unit(const Params& p, int unit, char* smem) {
  float* sz = (float*)smem;
  float* hA = sz + 8 * 33 + 8;
  float* hB = hA + 8 * 64;
  float* hT = hB + 8 * 64;
  const int tid = opaque_tid();
  const int l0 = unit * 8;
  for (int idx = tid; idx < 8 * 33; idx += 256) {
    const int pp = idx / 33, f = idx - pp * 33;
    const float l = (float)(l0 + pp);
    float v;
    if (f == 0) v = l / 4095.f;
    else {
      const int jb = (f - 1) & 15;
      const float fj = 1e-4f + (float)jb * ((15.f - 1e-4f) / 15.f);
      const float ang = 6.283185307179586f * l / 4096.f;
      v = (f <= 16) ? fcos(fj * ang) : -fsin(fj * ang);
    }
    sz[idx] = v;
  }
  const int o = tid & 63, pq = tid >> 6;
  {
    const float bb = p.filt_b1[o], fr = p.filt_freq[o];
    __syncthreads();
    float s0 = bb, s1 = bb;
#pragma unroll 1
    for (int f0 = 0; f0 < 33; f0 += 11) {
      float wc[11];
#pragma unroll
      for (int f = 0; f < 11; ++f) wc[f] = p.filt_w1[(f0 + f) * 64 + o];
#pragma unroll
      for (int f = 0; f < 11; ++f) { s0 += sz[pq * 33 + f0 + f] * wc[f]; s1 += sz[(pq + 4) * 33 + f0 + f] * wc[f]; }
    }
    hA[pq * 64 + o] = fsin(fr * s0);
    hA[(pq + 4) * 64 + o] = fsin(fr * s1);
  }
  {
    const float bb = p.filt_b2[o], fr = p.filt_freq[64 + o];
    __syncthreads();
    float s0 = bb, s1 = bb;
#pragma unroll 1
    for (int k0 = 0; k0 < 64; k0 += 16) {
      float wc[16];
#pragma unroll
      for (int k = 0; k < 16; ++k) wc[k] = p.filt_w2[(k0 + k) * 64 + o];
#pragma unroll
      for (int k = 0; k < 16; ++k) { s0 += hA[pq * 64 + k0 + k] * wc[k]; s1 += hA[(pq + 4) * 64 + k0 + k] * wc[k]; }
    }
    hB[pq * 64 + o] = fsin(fr * s0);
    hB[(pq + 4) * 64 + o] = fsin(fr * s1);
  }
  {
    const float bb = p.filt_b3[o], fr = p.filt_freq[128 + o];
    __syncthreads();
    float s0 = bb, s1 = bb;
#pragma unroll 1
    for (int k0 = 0; k0 < 64; k0 += 16) {
      float wc[16];
#pragma unroll
      for (int k = 0; k < 16; ++k) wc[k] = p.filt_w3[(k0 + k) * 64 + o];
#pragma unroll
      for (int k = 0; k < 16; ++k) { s0 += hB[pq * 64 + k0 + k] * wc[k]; s1 += hB[(pq + 4) * 64 + k0 + k] * wc[k]; }
    }
    hT[o * 8 + pq] = fsin(fr * s0);
    hT[o * 8 + pq + 4] = fsin(fr * s1);
  }
  __syncthreads();
  float* filt = (float*)(p.ws + OFF_FILT);
  const float min_decay = -3.0701134573253944f, max_decay = -15.350567286626973f;
#pragma unroll 1
  for (int cc = 0; cc < 8; ++cc) {
    const int col = tid + 256 * cc;
    float acc[8];
#pragma unroll
    for (int q = 0; q < 8; ++q) acc[q] = 0.f;
#pragma unroll 1
    for (int k0 = 0; k0 < 64; k0 += 16) {
      float wc[16];
#pragma unroll
      for (int k = 0; k < 16; ++k) wc[k] = p.filt_w4[(k0 + k) * 2048 + col];
#pragma unroll
      for (int k = 0; k < 16; ++k) {
        const float4 h0 = *(const float4*)(hT + (k0 + k) * 8);
        const float4 h1 = *(const float4*)(hT + (k0 + k) * 8 + 4);
        acc[0] += h0.x * wc[k]; acc[1] += h0.y * wc[k]; acc[2] += h0.z * wc[k]; acc[3] += h0.w * wc[k];
        acc[4] += h1.x * wc[k]; acc[5] += h1.y * wc[k]; acc[6] += h1.z * wc[k]; acc[7] += h1.w * wc[k];
      }
    }
    const int ch = col & 511;
    const float delta = fabsf(min_decay + (float)ch * ((max_decay - min_decay) / 511.f));
#pragma unroll
    for (int q = 0; q < 8; ++q) {
      const float t = (float)(l0 + q) / 4095.f;
      acc[q] *= expf(-t * delta);
    }
    float4* dst = (float4*)(filt + (size_t)col * 4096 + l0);
    dst[0] = make_float4(acc[0], acc[1], acc[2], acc[3]);
    dst[1] = make_float4(acc[4], acc[5], acc[6], acc[7]);
  }
  __syncthreads();
}

DI void phase0(const Params& p, char* smem) {
  const int tid = threadIdx.x, lane = tid & 63, wave = tid >> 6;
  const int U_W = 32, U_F = 512, U_X = 1024, U_T1 = 58 * 16, U_T2 = 256, U_T3 = 1024, U_T4 = 1024;
  const int total = U_W + U_F + U_X + U_T1 + U_T2 + U_T3 + U_T4;
  for (int u = blockIdx.x; u < total; u += gridDim.x) {
    int v = u;
    if (v < U_W) {
      const int idx = v * 256 + tid;
      if (idx < 8191) {
        const int lh = 31 - __clz(idx + 1);
        const int h = 1 << lh, jj = idx + 1 - h;
        float2* twp = (float2*)(p.ws + OFF_TW);
        const float ang = -3.14159265358979f * (float)jj / (float)h;
        twp[idx] = make_float2(cosf(ang), sinf(ang));
      }
      continue;
    }
    v -= U_W;
    if (v < U_F) { filter_unit(p, v, smem); continue; }
    v -= U_F;
    if (v < U_X) {
      u16* xn = (u16*)(p.ws + OFF_XN);
#pragma unroll 4
      for (int rr = 0; rr < 4; ++rr) {
        const int row = v * 16 + wave * 4 + rr;
        const float4* xr = (const float4*)(p.x + (size_t)row * DM);
        float4 xv[4];
        float ss = 0.f;
#pragma unroll
        for (int i = 0; i < 4; ++i) {
          xv[i] = xr[lane + 64 * i];
          ss += xv[i].x * xv[i].x + xv[i].y * xv[i].y + xv[i].z * xv[i].z + xv[i].w * xv[i].w;
        }
        ss = wave_sum(ss);
        const float rs = rsqrtf(ss * (1.f / DM) + EPS);
#pragma unroll
        for (int i = 0; i < 4; ++i) {
          const float4 w = ((const float4*)p.norm_mix_pre)[lane + 64 * i];
          ushort4 o;
          o.x = f2bf(xv[i].x * rs * w.x); o.y = f2bf(xv[i].y * rs * w.y); o.z = f2bf(xv[i].z * rs * w.z); o.w = f2bf(xv[i].w * rs * w.w);
          *(ushort4*)(xn + (size_t)row * DM + (lane + 64 * i) * 4) = o;
        }
      }
      continue;
    }
    v -= U_X;
    if (v < U_T1) { transpose_tile(p.w_in, DM, NIN, (u16*)(p.ws + OFF_WINT), v & 15, v >> 4, smem); continue; }
    v -= U_T1;
    if (v < U_T2) { transpose_tile(p.w_out, DM, DM, (u16*)(p.ws + OFF_WOUTT), v & 15, v >> 4, smem); continue; }
    v -= U_T2;
    if (v < U_T3) { transpose_tile(p.w_mlp_in, DM, DFF, (u16*)(p.ws + OFF_W1T), v & 15, v >> 4, smem); continue; }
    v -= U_T3;
    transpose_tile(p.w_mlp_out, DFF, DM, (u16*)(p.ws + OFF_W2T), v & 63, v >> 6, smem);
  }
}

DI void wave_lds_sync() { asm volatile("s_waitcnt lgkmcnt(0)" ::: "memory"); __builtin_amdgcn_wave_barrier(); }
template <int MODE>
DI void stage_tile_ns(const f32x16 (&acc)[4][2], char* wl, int lr, int hh) {
#pragma unroll
  for (int i = 0; i < 4; ++i)
#pragma unroll
    for (int j = 0; j < 2; ++j)
#pragma unroll
      for (int r = 0; r < 16; ++r) {
        float v = acc[i][j][r];
        if (MODE == 1) v = sigmoidf(v);
        if (MODE == 2) { v = fmaxf(v, 0.f); v = v * v; }
        *(u16*)(wl + (i * 32 + crow(r, hh)) * 128 + (j * 32 + lr) * 2) = f2bf(v);
      }
}
DI void stage_tile_sw(const f32x16 (&acc)[4][2], char* wl, int lr, int hh) {
#pragma unroll
  for (int i = 0; i < 4; ++i)
#pragma unroll
    for (int j = 0; j < 2; ++j)
#pragma unroll
      for (int r = 0; r < 16; ++r) *(u16*)(wl + (j * 32 + crow(r, hh)) * 256 + (i * 32 + lr) * 2) = f2bf(acc[i][j][r]);
}
DI void flush_tile_ns(const char* wl, u16* dst, size_t pitch, int lane) {
#pragma unroll 4
  for (int it = 0; it < 16; ++it) {
    const int q = lane + 64 * it, row = q >> 3, c8 = q & 7;
    *(uint4*)(dst + (size_t)row * pitch + c8 * 8) = *(const uint4*)(wl + row * 128 + c8 * 16);
  }
}

DI void phase1(const Params& p, char* smem) {
  const int tid = threadIdx.x, lane = tid & 63, wave = tid >> 6, wr = wave >> 1, wc = wave & 1, lr = lane & 31, hh = lane >> 5;
  const u16* xn = (const u16*)(p.ws + OFF_XN);
  const u16* wt = (const u16*)(p.ws + OFF_WINT);
  u16* qkpre = (u16*)(p.ws + OFF_QKPRE);
  u16* hyT = (u16*)(p.ws + OFF_HYT);
  u16* vT = (u16*)(p.ws + OFF_VT);
  u16* og = (u16*)(p.ws + OFF_OG);
  float* gates = (float*)(p.ws + OFF_GATES);
  const int ntn = 29, ntiles = tile_count(ntn);
  for (int id = blockIdx.x; id < ntiles; id += gridDim.x) {
    int mt, nt;
    tile_map(id, ntn, mt, nt);
    if (nt >= ntn) continue;
    const int m0 = mt * 256, n0 = nt * 128;
    f32x16 acc[4][2];
    const bool swap = (nt >= 8 && nt < 24);
    if (swap) gemm_core<true>(xn, wt, DM, m0, n0, smem, acc);
    else gemm_core<false>(xn, wt, DM, m0, n0, smem, acc);
    char* wl = smem + wave * 16384;
    if (!swap) {
      if (nt < 28) {
        if (nt < 8) stage_tile_ns<0>(acc, wl, lr, hh); else stage_tile_ns<1>(acc, wl, lr, hh);
        wave_lds_sync();
        const size_t row0 = (size_t)(m0 + wr * 128);
        if (nt < 8) flush_tile_ns(wl, qkpre + row0 * 1024 + n0 + wc * 64, 1024, lane);
        else flush_tile_ns(wl, og + row0 * 512 + (n0 - 3072) + wc * 64, 512, lane);
      } else {
#pragma unroll
        for (int i = 0; i < 4; ++i)
#pragma unroll
          for (int r = 0; r < 16; ++r) {
            const int row = m0 + wr * 128 + i * 32 + crow(r, hh);
            if (wc == 0 && lr < 16) gates[(size_t)row * 16 + lr] = acc[i][0][r];
          }
      }
    } else {
      stage_tile_sw(acc, wl, lr, hh);
      wave_lds_sync();
      const int mrow = m0 + wr * 128, b = mrow >> 12, t0 = mrow & 4095;
#pragma unroll 4
      for (int it = 0; it < 16; ++it) {
        const int q = lane + 64 * it, chl = q >> 4, c16 = q & 15;
        const int n = n0 + wc * 64 + chl;
        u16* dst;
        if (nt < 20) { const int cc = n - 1024, g = cc >> 9, ch = cc & 511; dst = hyT + ((size_t)((g * 4 + b) * 512 + ch)) * 4096; }
        else dst = vT + ((size_t)(b * 512 + (n - 2560))) * 4096;
        *(uint4*)(dst + t0 + c16 * 8) = *(const uint4*)(wl + chl * 256 + c16 * 16);
      }
    }
  }
}

DI void phase_qk(const Params& p, char* smem) {
  const int tid = opaque_tid();
  const int cg = tid & 31, rg = tid >> 5;
  const u16* qkpre = (const u16*)(p.ws + OFF_QKPRE);
  u16* qa = (u16*)(p.ws + OFF_QA);
  u16* ka = (u16*)(p.ws + OFF_KA);
  u16* kaT = (u16*)(p.ws + OFF_KAT);
  for (int u = blockIdx.x; u < 1024; u += gridDim.x) {
    const int ct = u & 3, tt = u >> 2;
    const int C0 = ct * 256 + cg * 8;
    const int Tb = tt * 64 + rg * 8;
    const int tb = Tb & 4095;
    float w0[8], w1[8], w2[8], cb[8];
    {
      const float4 a0 = *(const float4*)(p.conv_w + C0), a1 = *(const float4*)(p.conv_w + C0 + 4);
      const float4 b0 = *(const float4*)(p.conv_w + 2560 + C0), b1 = *(const float4*)(p.conv_w + 2560 + C0 + 4);
      const float4 c0 = *(const float4*)(p.conv_w + 5120 + C0), c1 = *(const float4*)(p.conv_w + 5120 + C0 + 4);
      const float4 d0 = *(const float4*)(p.conv_b + C0), d1 = *(const float4*)(p.conv_b + C0 + 4);
      w0[0] = a0.x; w0[1] = a0.y; w0[2] = a0.z; w0[3] = a0.w; w0[4] = a1.x; w0[5] = a1.y; w0[6] = a1.z; w0[7] = a1.w;
      w1[0] = b0.x; w1[1] = b0.y; w1[2] = b0.z; w1[3] = b0.w; w1[4] = b1.x; w1[5] = b1.y; w1[6] = b1.z; w1[7] = b1.w;
      w2[0] = c0.x; w2[1] = c0.y; w2[2] = c0.z; w2[3] = c0.w; w2[4] = c1.x; w2[5] = c1.y; w2[6] = c1.z; w2[7] = c1.w;
      cb[0] = d0.x; cb[1] = d0.y; cb[2] = d0.z; cb[3] = d0.w; cb[4] = d1.x; cb[5] = d1.y; cb[6] = d1.z; cb[7] = d1.w;
    }
    bf16x8 rows[10];
    const u16* src = qkpre + (size_t)Tb * 1024 + C0;
#pragma unroll
    for (int r = 0; r < 10; ++r) {
      const int t = tb + r - 1;
      bf16x8 z;
#pragma unroll
      for (int i = 0; i < 8; ++i) z[i] = 0;
      rows[r] = (t >= 0 && t <= 4095) ? *(const bf16x8*)(src + (ptrdiff_t)(r - 1) * 1024) : z;
    }
    const bool isk = C0 >= 512;
    bf16x8 tr[8];
#pragma unroll
    for (int r = 0; r < 8; ++r) {
      bf16x8 o;
#pragma unroll
      for (int i = 0; i < 8; ++i) {
        const float val = w0[i] * bf2f((u16)rows[r][i]) + w1[i] * bf2f((u16)rows[r + 1][i]) + w2[i] * bf2f((u16)rows[r + 2][i]) + cb[i];
        float sv = val * sigmoidf(val);
        if (isk) sv *= 0.08838834764831845f;
        o[i] = (short)f2bf(sv);
        tr[i][r] = o[i];
      }
      if (!isk) *(bf16x8*)(qa + (size_t)(Tb + r) * 512 + C0) = o;
      else *(bf16x8*)(ka + (size_t)(Tb + r) * 512 + (C0 - 512)) = o;
    }
    if (isk) {
      const int b = Tb >> 12;
#pragma unroll
      for (int i = 0; i < 8; ++i) *(bf16x8*)(kaT + ((size_t)(b * 512 + (C0 - 512) + i)) * 4096 + tb) = tr[i];
    }
  }
}

DI float lz(float v) { asm volatile("" : "+v"(v)); return v; }
DI float2 mk2(float a, float b) { return make_float2(a, b); }
DI float2 cmul(float2 a, float2 w) { return mk2(a.x * w.x - a.y * w.y, a.x * w.y + a.y * w.x); }
DI float2 cmulc(float2 a, float2 w) { return mk2(a.x * w.x + a.y * w.y, a.y * w.x - a.x * w.y); }
DI int lx(int idx) { const int sw = (idx >> 5) & 3; return idx ^ (sw << 3) ^ (sw << 1); }
template <bool LX>
DI void addr4(int base, int q, int k, int& a0, int& a1, int& a2, int& a3) {
  if (!LX) { a0 = base; a1 = base + q; a2 = base + 2 * q; a3 = base + 3 * q; }
  else if (q == 8) {
    const int sw = (k >> 3) & 3, b2 = base ^ (sw << 1);
    a0 = b2 + (sw << 3); a1 = b2 + ((1 ^ sw) << 3); a2 = b2 + ((2 ^ sw) << 3); a3 = b2 + ((3 ^ sw) << 3);
  } else {
    a0 = base; a1 = (base ^ 10) + 32; a2 = (base ^ 20) + 64; a3 = (base ^ 30) + 96;
  }
}
template <int NW, bool INV, bool INLX = false, bool OUTLX = false, bool PRUNE = false>
DI void r4_pass(float2* x, int tid, int q, const float2* __restrict__ t1, const float2* __restrict__ t2) {
  constexpr int NL = NW > 4 ? 4 : NW;
  constexpr int NB = NW > 4 ? 2 : 1;
  constexpr int CNT = 8 / NB;
#pragma unroll 1
  for (int bt = 0; bt < NB; ++bt) {
    float2 w1[NL], w2[NL];
#pragma unroll
    for (int n = 0; n < NL; ++n) { const int j = (tid + ((bt * CNT + n) << 8)) & (q - 1); w1[n] = t1[j]; w2[n] = t2[j]; }
    if (bt == 0) __syncthreads();
#pragma unroll(NL == 4 ? 4 : 2)
    for (int ii = 0; ii < CNT; ++ii) {
      const int k = tid + ((bt * CNT + ii) << 8);
      const int j = k & (q - 1);
      int base = ((k - j) << 2) + j;
      asm volatile("" : "+v"(base));
      const float2 ww1 = w1[ii % NL], ww2 = w2[ii % NL];
      int i0_, i1_, i2_, i3_, o0_, o1_, o2_, o3_;
      addr4<INLX>(base, q, k, i0_, i1_, i2_, i3_);
      addr4<OUTLX>(base, q, k, o0_, o1_, o2_, o3_);
      const float2 zz = make_float2(0.f, 0.f);
      const float2 x0 = x[i0_], x1 = x[i1_];
      const float2 x2 = (PRUNE && !INV) ? zz : x[i2_], x3 = (PRUNE && !INV) ? zz : x[i3_];
      if (!INV) {
        const float2 a0 = mk2(x0.x + x2.x, x0.y + x2.y);
        const float2 a1 = mk2(x1.x + x3.x, x1.y + x3.y);
        const float2 d02 = mk2(x0.x - x2.x, x0.y - x2.y);
        const float2 d13 = mk2(x1.y - x3.y, x3.x - x1.x);
        const float2 a2 = cmul(d02, ww1);
        const float2 a3 = cmul(d13, ww1);
        x[o0_] = mk2(a0.x + a1.x, a0.y + a1.y);
        x[o1_] = cmul(mk2(a0.x - a1.x, a0.y - a1.y), ww2);
        x[o2_] = mk2(a2.x + a3.x, a2.y + a3.y);
        x[o3_] = cmul(mk2(a2.x - a3.x, a2.y - a3.y), ww2);
      } else {
        const float2 b1 = cmulc(x1, ww2), b3 = cmulc(x3, ww2);
        const float2 a0 = mk2(x0.x + b1.x, x0.y + b1.y);
        const float2 a1 = mk2(x0.x - b1.x, x0.y - b1.y);
        const float2 a2 = mk2(x2.x + b3.x, x2.y + b3.y);
        const float2 a3 = mk2(x2.x - b3.x, x2.y - b3.y);
        const float2 c2 = cmulc(a2, ww1);
        const float2 c3t = cmulc(a3, ww1);
        const float2 c3 = mk2(-c3t.y, c3t.x);
        x[o0_] = mk2(a0.x + c2.x, a0.y + c2.y);
        if (!PRUNE) x[o2_] = mk2(a0.x - c2.x, a0.y - c2.y);
        x[o1_] = mk2(a1.x + c3.x, a1.y + c3.y);
        if (!PRUNE) x[o3_] = mk2(a1.x - c3.x, a1.y - c3.y);
      }
    }
  }
}
template <bool INV>
DI void r8_tail(float2* x, int tid) {
  const float R = 0.70710678118654752f;
#pragma unroll 2
  for (int i = 0; i < 4; ++i) {
    const int G = tid + (i << 8);
    const int sw = (G >> 2) & 3;
    const int blk = (G << 3) ^ (sw << 3);
    float4* p0 = (float4*)(x + blk + ((0 ^ sw) << 1));
    float4* p1 = (float4*)(x + blk + ((1 ^ sw) << 1));
    float4* p2 = (float4*)(x + blk + ((2 ^ sw) << 1));
    float4* p3 = (float4*)(x + blk + ((3 ^ sw) << 1));
    const float4 v0 = *p0, v1 = *p1, v2 = *p2, v3 = *p3;
    float2 e0 = make_float2(v0.x, v0.y), e1 = make_float2(v0.z, v0.w), e2 = make_float2(v1.x, v1.y), e3 = make_float2(v1.z, v1.w);
    float2 e4 = make_float2(v2.x, v2.y), e5 = make_float2(v2.z, v2.w), e6 = make_float2(v3.x, v3.y), e7 = make_float2(v3.z, v3.w);
    if (!INV) {
      const float2 s0 = mk2(e0.x + e4.x, e0.y + e4.y), d0 = mk2(e0.x - e4.x, e0.y - e4.y);
      const float2 s1 = mk2(e1.x + e5.x, e1.y + e5.y), t1 = mk2(e1.x - e5.x, e1.y - e5.y);
      const float2 s2 = mk2(e2.x + e6.x, e2.y + e6.y), t2 = mk2(e2.x - e6.x, e2.y - e6.y);
      const float2 s3 = mk2(e3.x + e7.x, e3.y + e7.y), t3 = mk2(e3.x - e7.x, e3.y - e7.y);
      const float2 d1 = mk2((t1.x + t1.y) * R, (t1.y - t1.x) * R);
      const float2 d2 = mk2(t2.y, -t2.x);
      const float2 d3 = mk2((t3.y - t3.x) * R, -(t3.x + t3.y) * R);
      const float2 a0 = mk2(s0.x + s2.x, s0.y + s2.y), a2 = mk2(s0.x - s2.x, s0.y - s2.y);
      const float2 a1 = mk2(s1.x + s3.x, s1.y + s3.y), u3 = mk2(s1.x - s3.x, s1.y - s3.y);
      const float2 a3 = mk2(u3.y, -u3.x);
      const float2 a4 = mk2(d0.x + d2.x, d0.y + d2.y), a6 = mk2(d0.x - d2.x, d0.y - d2.y);
      const float2 a5 = mk2(d1.x + d3.x, d1.y + d3.y), u7 = mk2(d1.x - d3.x, d1.y - d3.y);
      const float2 a7 = mk2(u7.y, -u7.x);
      *p0 = make_float4(a0.x + a1.x, a0.y + a1.y, a0.x - a1.x, a0.y - a1.y);
      *p1 = make_float4(a2.x + a3.x, a2.y + a3.y, a2.x - a3.x, a2.y - a3.y);
      *p2 = make_float4(a4.x + a5.x, a4.y + a5.y, a4.x - a5.x, a4.y - a5.y);
      *p3 = make_float4(a6.x + a7.x, a6.y + a7.y, a6.x - a7.x, a6.y - a7.y);
    } else {
      const float2 z0 = mk2(e0.x + e1.x, e0.y + e1.y), z1 = mk2(e0.x - e1.x, e0.y - e1.y);
      const float2 z2 = mk2(e2.x + e3.x, e2.y + e3.y), z3 = mk2(e2.x - e3.x, e2.y - e3.y);
      const float2 z4 = mk2(e4.x + e5.x, e4.y + e5.y), z5 = mk2(e4.x - e5.x, e4.y - e5.y);
      const float2 z6 = mk2(e6.x + e7.x, e6.y + e7.y), z7 = mk2(e6.x - e7.x, e6.y - e7.y);
      const float2 b3 = mk2(-z3.y, z3.x), b7 = mk2(-z7.y, z7.x);
      const float2 y0 = mk2(z0.x + z2.x, z0.y + z2.y), y2 = mk2(z0.x - z2.x, z0.y - z2.y);
      const float2 y1 = mk2(z1.x + b3.x, z1.y + b3.y), y3 = mk2(z1.x - b3.x, z1.y - b3.y);
      const float2 y4 = mk2(z4.x + z6.x, z4.y + z6.y), y6 = mk2(z4.x - z6.x, z4.y - z6.y);
      const float2 y5 = mk2(z5.x + b7.x, z5.y + b7.y), y7 = mk2(z5.x - b7.x, z5.y - b7.y);
      const float2 c4 = y4;
      const float2 c5 = mk2((y5.x - y5.y) * R, (y5.x + y5.y) * R);
      const float2 c6 = mk2(-y6.y, y6.x);
      const float2 c7 = mk2(-(y7.x + y7.y) * R, (y7.x - y7.y) * R);
      *p0 = make_float4(y0.x + c4.x, y0.y + c4.y, y1.x + c5.x, y1.y + c5.y);
      *p1 = make_float4(y2.x + c6.x, y2.y + c6.y, y3.x + c7.x, y3.y + c7.y);
      *p2 = make_float4(y0.x - c4.x, y0.y - c4.y, y1.x - c5.x, y1.y - c5.y);
      *p3 = make_float4(y2.x - c6.x, y2.y - c6.y, y3.x - c7.x, y3.y - c7.y);
    }
  }
}
template <bool DATA = false>
DI void fft_fwd(float2* x, int tid, const float2* __restrict__ tw) {
  r4_pass<8, false, false, false, DATA>(x, tid, 2048, tw + 4095, tw + 2047);
  r4_pass<2, false>(x, tid, 512, tw + 1023, tw + 511);
  r4_pass<1, false>(x, tid, 128, tw + 255, tw + 127);
  r4_pass<1, false, false, true>(x, tid, 32, tw + 63, tw + 31);
  r4_pass<1, false, true, true>(x, tid, 8, tw + 15, tw + 7);
  __syncthreads();
  r8_tail<false>(x, tid);
  __syncthreads();
}
template <bool DATA = false>
DI void fft_inv(float2* x, int tid, const float2* __restrict__ tw) {
  __syncthreads();
  r8_tail<true>(x, tid);
  r4_pass<1, true, true, true>(x, tid, 8, tw + 15, tw + 7);
  r4_pass<1, true, true, false>(x, tid, 32, tw + 63, tw + 31);
  r4_pass<1, true>(x, tid, 128, tw + 255, tw + 127);
  r4_pass<2, true>(x, tid, 512, tw + 1023, tw + 511);
  r4_pass<8, true, false, false, DATA>(x, tid, 2048, tw + 4095, tw + 2047);
  __syncthreads();
}

DI float hy_conv(const u16* __restrict__ pr, int t, float w0, float w1, float w2, float cb) {
  const float a = t > 0 ? bf2f(pr[t - 1]) : 0.f;
  const float b = bf2f(pr[t]);
  const float c = t < 4095 ? bf2f(pr[t + 1]) : 0.f;
  return w0 * a + w1 * b + w2 * c + cb;
}

DI void hy_conv4(const u16* __restrict__ pr, int t0, float w0, float w1, float w2, float cb, float (&o)[4]) {
  const ushort4 c = *(const ushort4*)(pr + t0);
  const float pm = t0 > 0 ? bf2f(pr[t0 - 1]) : 0.f;
  const float pn = t0 + 4 < 4096 ? bf2f(pr[t0 + 4]) : 0.f;
  const float x0 = bf2f(c.x), x1 = bf2f(c.y), x2 = bf2f(c.z), x3 = bf2f(c.w);
  o[0] = w0 * pm + w1 * x0 + w2 * x1 + cb;
  o[1] = w0 * x0 + w1 * x1 + w2 * x2 + cb;
  o[2] = w0 * x1 + w1 * x2 + w2 * x3 + cb;
  o[3] = w0 * x2 + w1 * x3 + w2 * pn + cb;
}

DI void hyena_unit(const Params& p, int ch, char* smem) {
  float2* buf = (float2*)smem;
  const int tid = opaque_tid();
  const u16* hyT = (const u16*)(p.ws + OFF_HYT);
  const float* filt = (const float*)(p.ws + OFF_FILT);
  u16* z2T = (u16*)(p.ws + OFF_Z2T);
  const float2* tw = (const float2*)(p.ws + OFF_TW);
  float2 Kr[32];
  float* k1buf_base = (float*)(p.ws + OFF_FILT);
  {
    const float* kf0 = filt + (size_t)(0 * 512 + ch) * 4096;
    const float* kf1 = filt + (size_t)(1 * 512 + ch) * 4096;
    const float* kb0 = filt + (size_t)(2 * 512 + ch) * 4096;
    const float* kb1 = filt + (size_t)(3 * 512 + ch) * 4096;
    const float fb0 = p.filt_bias[ch], fb1 = p.filt_bias[512 + ch];
    __syncthreads();
#pragma unroll
    for (int g = 0; g < 4; ++g) {
      const int n0 = g * 1024 + tid * 4;
      float4 v0 = *(const float4*)(kf0 + n0), v1 = *(const float4*)(kf1 + n0);
      if (n0 == 0) { v0.x += fb0; v1.x += fb1; }
      const float4 r0 = *(const float4*)(kb0 + 4092 - n0), r1 = *(const float4*)(kb1 + 4092 - n0);
      const float e00 = (n0 == 0) ? 0.f : kb0[4096 - n0], e01 = (n0 == 0) ? 0.f : kb1[4096 - n0];
      *(float4*)(buf + n0) = make_float4(v0.x, v1.x, v0.y, v1.y);
      *(float4*)(buf + n0 + 2) = make_float4(v0.z, v1.z, v0.w, v1.w);
      *(float4*)(buf + 4096 + n0) = make_float4(e00, e01, r0.w, r1.w);
      *(float4*)(buf + 4096 + n0 + 2) = make_float4(r0.z, r1.z, r0.y, r1.y);
    }
    fft_fwd(buf, tid, tw);
    const float sc = 0.5f / 8192.f;
#pragma unroll
    for (int j = 0; j < 32; ++j) {
      const int P = tid + 256 * j;
      const int f = (int)(__brev((unsigned)lx(P)) >> 19);
      const int Pq = lx((int)(__brev((unsigned)((8192 - f) & 8191)) >> 19));
      const float2 zp = buf[P], zq = buf[Pq];
      Kr[j] = make_float2(sc * (zp.x + zq.x), sc * (zp.y - zq.y));
      const float2 k1 = make_float2(sc * (zp.y + zq.y), sc * (zq.x - zp.x));
      *(float2*)(k1buf_base + ((size_t)((P >> 11) * 512 + ch)) * 4096 + (P & 2047) * 2) = k1;
    }
  }
#pragma unroll 1
  for (int ord = 0; ord < 2; ++ord) {
    if (ord == 1) {
#pragma unroll
      for (int j = 0; j < 32; ++j) {
        const int P = tid + 256 * j;
        Kr[j] = *(const float2*)(k1buf_base + ((size_t)((P >> 11) * 512 + ch)) * 4096 + (P & 2047) * 2);
      }
    }
    const int gcol = 1024 + (1 + ord) * 512 + ch;
    const float gw0 = p.conv_w[gcol], gw1 = p.conv_w[2560 + gcol], gw2 = p.conv_w[5120 + gcol], gcb = p.conv_b[gcol];
    const int vcol = 1024 + ch;
    const float vw0 = p.conv_w[vcol], vw1 = p.conv_w[2560 + vcol], vw2 = p.conv_w[5120 + vcol], vcb = p.conv_b[vcol];
#pragma unroll 1
    for (int pr = 0; pr < 2; ++pr) {
      const int b0 = 2 * pr, b1 = 2 * pr + 1;
      __syncthreads();
      if (ord == 0) {
        const u16* u0 = hyT + ((size_t)((0 * 4 + b0) * 512 + ch)) * 4096;
        const u16* u1 = hyT + ((size_t)((0 * 4 + b1) * 512 + ch)) * 4096;
#pragma unroll
        for (int g = 0; g < 4; ++g) {
          const int t0 = g * 1024 + tid * 4;
          float a[4], b[4];
          hy_conv4(u0, t0, vw0, vw1, vw2, vcb, a);
          hy_conv4(u1, t0, vw0, vw1, vw2, vcb, b);
          *(float4*)(buf + t0) = make_float4(a[0], b[0], a[1], b[1]);
          *(float4*)(buf + t0 + 2) = make_float4(a[2], b[2], a[3], b[3]);
        }
      } else {
        const u16* u0 = z2T + ((size_t)(b0 * 512 + ch)) * 4096;
        const u16* u1 = z2T + ((size_t)(b1 * 512 + ch)) * 4096;
#pragma unroll
        for (int g = 0; g < 4; ++g) {
          const int t0 = g * 1024 + tid * 4;
          const ushort4 a = *(const ushort4*)(u0 + t0);
          const ushort4 b = *(const ushort4*)(u1 + t0);
          *(float4*)(buf + t0) = make_float4(bf2f(a.x), bf2f(b.x), bf2f(a.y), bf2f(b.y));
          *(float4*)(buf + t0 + 2) = make_float4(bf2f(a.z), bf2f(b.z), bf2f(a.w), bf2f(b.w));
        }
      }
      fft_fwd<true>(buf, tid, tw);
#pragma unroll
      for (int j = 0; j < 32; ++j) {
        const float2 v = buf[tid + 256 * j];
        buf[tid + 256 * j] = make_float2(v.x * Kr[j].x - v.y * Kr[j].y, v.x * Kr[j].y + v.y * Kr[j].x);
      }
      fft_inv<true>(buf, tid, tw);
      const u16* g0 = hyT + ((size_t)(((1 + ord) * 4 + b0) * 512 + ch)) * 4096;
      const u16* g1 = hyT + ((size_t)(((1 + ord) * 4 + b1) * 512 + ch)) * 4096;
      u16* o0 = z2T + ((size_t)(b0 * 512 + ch)) * 4096;
      u16* o1 = z2T + ((size_t)(b1 * 512 + ch)) * 4096;
#pragma unroll
      for (int g = 0; g < 4; ++g) {
        const int t0 = g * 1024 + tid * 4;
        const float4 y01 = *(const float4*)(buf + t0);
        const float4 y23 = *(const float4*)(buf + t0 + 2);
        float ga[4], gb[4];
        hy_conv4(g0, t0, gw0, gw1, gw2, gcb, ga);
        hy_conv4(g1, t0, gw0, gw1, gw2, gcb, gb);
        { ushort4 o; o.x = f2bf(ga[0] * y01.x); o.y = f2bf(ga[1] * y01.z); o.z = f2bf(ga[2] * y23.x); o.w = f2bf(ga[3] * y23.z); *(ushort4*)(o0 + t0) = o; }
        { ushort4 o; o.x = f2bf(gb[0] * y01.y); o.y = f2bf(gb[1] * y01.w); o.z = f2bf(gb[2] * y23.y); o.w = f2bf(gb[3] * y23.w); *(ushort4*)(o1 + t0) = o; }
      }
    }
  }
  __syncthreads();
}

DI void mlstm_local_unit(const Params& p, int u, char* smem) {
  float* s_gi = (float*)smem;
  float* s_lf = s_gi + 128;
  float* s_a = s_lf + 128;
  float* s_w = s_a + 128;
  const int tid = opaque_tid(), lane = tid & 63, wave = tid >> 6, lr = lane & 31, hh = lane >> 5;
  const int j = u & 31, dir = (u >> 5) & 1, bh = u >> 6, h = bh & 3, b = bh >> 2;
  const int T0 = b * 4096 + j * 128;
  const float* gates = (const float*)(p.ws + OFF_GATES);
  const u16* vT = (const u16*)(p.ws + OFF_VT);
  const u16* kaT = (const u16*)(p.ws + OFF_KAT);
  float* CL = p.out;
  float* nl = (float*)(p.ws + OFF_NL);
  float* mloc = (float*)(p.ws + OFF_MLOC);
  float* gsum = (float*)(p.ws + OFF_GSUM);
  __syncthreads();
  if (tid < 128) {
    const int T = T0 + tid;
    s_gi[tid] = gates[(size_t)T * 16 + dir * 8 + h] + p.b_gates[dir * 8 + h];
    s_lf[tid] = log_sigmoid(gates[(size_t)T * 16 + dir * 8 + 4 + h] + p.b_gates[dir * 8 + 4 + h]);
  }
  __syncthreads();
  float gtot = 0.f;
  if (tid < 128) {
    float pre = 0.f;
#pragma unroll 4
    for (int m = 0; m < 128; ++m) {
      const float v = s_lf[m];
      if (m < tid) pre += v;
      gtot += v;
    }
    s_a[tid] = (dir == 0) ? (gtot - pre - s_lf[tid] + s_gi[tid]) : (pre + s_gi[tid]);
  }
  __syncthreads();
  if (tid < 128) {
    float mx = -3.0e38f;
#pragma unroll 4
    for (int m = 0; m < 128; ++m) mx = fmaxf(mx, s_a[m]);
    s_w[tid] = expf(s_a[tid] - mx);
    if (tid == 0) { mloc[u] = mx; gsum[u] = gtot; }
  }
  __syncthreads();
  f32x16 acc[4];
#pragma unroll
  for (int d = 0; d < 4; ++d)
#pragma unroll
    for (int r = 0; r < 16; ++r) acc[d][r] = 0.f;
  const u16* vrow = vT + ((size_t)(bh * 128 + wave * 32 + lr)) * 4096 + j * 128 + hh * 8;
  const u16* kbase = kaT + ((size_t)(bh * 128 + lr)) * 4096 + j * 128 + hh * 8;
#pragma unroll 4
  for (int ks = 0; ks < 8; ++ks) {
    const bf16x8 av = *(const bf16x8*)(vrow + ks * 16);
    bf16x8 a;
#pragma unroll
    for (int i = 0; i < 8; ++i) a[i] = (short)f2bf(bf2f((u16)av[i]) * s_w[ks * 16 + hh * 8 + i]);
#pragma unroll
    for (int dt = 0; dt < 4; ++dt) {
      const bf16x8 bk = *(const bf16x8*)(kbase + (size_t)(dt * 32) * 4096 + ks * 16);
      acc[dt] = MFMA(a, bk, acc[dt]);
    }
  }
  {
    char* wl = smem + 4096 + wave * 8192;
#pragma unroll
    for (int dt = 0; dt < 4; ++dt)
#pragma unroll
      for (int r = 0; r < 16; ++r) *(u16*)(wl + crow(r, hh) * 256 + (dt * 32 + lr) * 2) = f2bf(acc[dt][r]);
    wave_lds_sync();
    u16* dst = (u16*)CL + (size_t)u * 16384 + (size_t)(wave * 32) * 128;
#pragma unroll
    for (int i = 0; i < 8; ++i) {
      const int q = lane + 64 * i, row = q >> 4, ch = q & 15;
      *(uint4*)(dst + row * 128 + ch * 8) = *(const uint4*)(wl + row * 256 + ch * 16);
    }
  }
  if (tid < 128) {
    const u16* kr = kaT + ((size_t)(bh * 128 + tid)) * 4096 + j * 128;
    float s = 0.f;
#pragma unroll 2
    for (int l = 0; l < 128; l += 8) {
      const bf16x8 kv = *(const bf16x8*)(kr + l);
#pragma unroll
      for (int i = 0; i < 8; ++i) s += s_w[l + i] * bf2f((u16)kv[i]);
    }
    nl[(size_t)u * 128 + tid] = s;
  }
}

DI void scan_unit(const Params& p, int unit) {
  const int tid = opaque_tid();
  const int sc = unit >> 4, part = unit & 15, dir = sc & 1;
  u16* CL = (u16*)p.out;
  float* nl = (float*)(p.ws + OFF_NL);
  const float* mloc = (const float*)(p.ws + OFF_MLOC);
  const float* gsum = (const float*)(p.ws + OFF_GSUM);
  float* ms = (float*)(p.ws + OFF_MS);
  const int idx = part * 1024 + tid * 4;
  float4 C = make_float4(0.f, 0.f, 0.f, 0.f);
  float nst = 0.f, m = 0.f;
  const bool do_n = (part == 0) && (tid < 128);
  ushort4 pf[4];
#pragma unroll
  for (int q = 0; q < 4; ++q) {
    const int jj = dir ? 31 - q : q;
    pf[q] = *(const ushort4*)(CL + (size_t)(sc * 32 + jj) * 16384 + idx);
  }
#pragma unroll 1
  for (int c0 = 0; c0 < 32; c0 += 4) {
#pragma unroll
    for (int q = 0; q < 4; ++q) {
      const int c = c0 + q;
      const int jj = dir ? 31 - c : c;
      const int u = sc * 32 + jj;
      const float4 cl = make_float4(bf2f(pf[q].x), bf2f(pf[q].y), bf2f(pf[q].z), bf2f(pf[q].w));
      { ushort4 cs; cs.x = f2bf(C.x); cs.y = f2bf(C.y); cs.z = f2bf(C.z); cs.w = f2bf(C.w); *(ushort4*)(CL + (size_t)u * 16384 + idx) = cs; }
      if (c + 4 < 32) {
        const int j2 = dir ? 31 - (c + 4) : (c + 4);
        pf[q] = *(const ushort4*)(CL + (size_t)(sc * 32 + j2) * 16384 + idx);
      }
      const float g = gsum[u], ml = mloc[u];
      const float mn = fmaxf(g + m, ml);
      const float dec = expf(g + m - mn), scl = expf(ml - mn);
      C.x = dec * C.x + scl * cl.x; C.y = dec * C.y + scl * cl.y; C.z = dec * C.z + scl * cl.z; C.w = dec * C.w + scl * cl.w;
      if (do_n) {
        const float nv = nl[(size_t)u * 128 + tid];
        nl[(size_t)u * 128 + tid] = nst;
        nst = dec * nst + scl * nv;
      }
      if (part == 0 && tid == 0) ms[u] = m;
      m = mn;
    }
  }
}

template <int DIR>
DI void mlstm_dir(const Params& p, int bh, int j, char* smem, f32x16 (&hs)[4]) {
  float* s_gi = (float*)smem;
  float* s_lf = s_gi + 128;
  float* s_bc = s_lf + 128;
  float* s_r = s_bc + 128;
  float* s_al = s_r + 128;
  float* s_fl = s_al + 128;
  float* s_is = s_fl + 128;
  const int tid = opaque_tid(), lane = tid & 63, wave = tid >> 6, lr = lane & 31, hh = lane >> 5;
  u16* Pl = (u16*)(smem + 4096) + wave * (32 * 136);
  const int h = bh & 3, b = bh >> 2;
  const int T0 = b * 4096 + j * 128;
  const float* gates = (const float*)(p.ws + OFF_GATES);
  const u16* qa = (const u16*)(p.ws + OFF_QA);
  const u16* ka = (const u16*)(p.ws + OFF_KA);
  const u16* vT = (const u16*)(p.ws + OFF_VT);
  const float* CS = p.out;
  const float* ns = (const float*)(p.ws + OFF_NL);
  const float* ms = (const float*)(p.ws + OFF_MS);
  u16* A2 = (u16*)(p.ws + OFF_A2);
  bf16x8 ones;
#pragma unroll
  for (int i = 0; i < 8; ++i) ones[i] = (short)0x3F80;
  const u16* qrow = qa + (size_t)(T0 + wave * 32 + lr) * 512 + h * 128 + hh * 8;
  const int u = (bh * 2 + DIR) * 32 + j;
  const float msu = ms[u];
  __syncthreads();
  if (tid < 128) {
    const int T = T0 + tid;
    s_gi[tid] = gates[(size_t)T * 16 + DIR * 8 + h] + p.b_gates[DIR * 8 + h];
    s_lf[tid] = log_sigmoid(gates[(size_t)T * 16 + DIR * 8 + 4 + h] + p.b_gates[DIR * 8 + 4 + h]);
  }
  __syncthreads();
  if (tid < 128) {
    float a = 0.f;
#pragma unroll 4
    for (int m = 0; m < 128; ++m) {
      const bool in = (DIR == 0) ? (m <= tid) : (m >= tid);
      a += in ? s_lf[m] : 0.f;
    }
    s_bc[tid] = a;
    s_r[tid] = s_gi[tid] - a;
  }
  __syncthreads();
  if (tid < 128) {
    float cm = -3.0e38f;
#pragma unroll 4
    for (int m = 0; m < 128; ++m) {
      const bool in = (DIR == 0) ? (m <= tid) : (m >= tid);
      cm = in ? fmaxf(cm, s_r[m]) : cm;
    }
    const float bc = s_bc[tid];
    const float mt = bc + fmaxf(msu, cm);
    s_al[tid] = bc - mt;
    s_fl[tid] = expf(-mt);
    s_is[tid] = expf(bc + msu - mt);
  }
  __syncthreads();
  char* Kt = smem + 4096;
  char* R2 = smem + 40960;
  {
#pragma unroll
    for (int bt = 0; bt < 2; ++bt) {
      uint4 kq[4];
#pragma unroll
      for (int i = 0; i < 4; ++i) {
        const int q = tid + 256 * (bt * 4 + i), row = q >> 4, ch = q & 15;
        kq[i] = *(const uint4*)(ka + (size_t)(T0 + row) * 512 + h * 128 + ch * 8);
      }
#pragma unroll
      for (int i = 0; i < 4; ++i) {
        const int q = tid + 256 * (bt * 4 + i), row = q >> 4, ch = q & 15;
        *(uint4*)(Kt + row * 256 + ((ch ^ (row & 15)) << 4)) = kq[i];
      }
    }
  }
  __syncthreads();
  {
    f32x16 S[4];
#pragma unroll
    for (int st = 0; st < 4; ++st)
#pragma unroll
      for (int r = 0; r < 16; ++r) S[st][r] = 0.f;
#pragma unroll 4
    for (int ks = 0; ks < 8; ++ks) {
      const bf16x8 a = *(const bf16x8*)(qrow + ks * 16);
#pragma unroll
      for (int st = 0; st < 4; ++st) {
        const int krow = st * 32 + lr;
        const bf16x8 bk = *(const bf16x8*)(Kt + krow * 256 + (((ks * 2 + hh) ^ (krow & 15)) << 4));
        S[st] = MFMA(a, bk, S[st]);
      }
    }
    __syncthreads();
#pragma unroll
    for (int st = 0; st < 4; ++st) {
      const int sl = st * 32 + lr;
      const float rs = s_r[sl];
#pragma unroll
      for (int r = 0; r < 16; ++r) {
        const int tl = wave * 32 + crow(r, hh);
        const bool valid = (DIR == 0) ? (sl <= tl) : (sl >= tl);
        const float pv = valid ? S[st][r] * __expf(s_al[tl] + rs) : 0.f;
        Pl[crow(r, hh) * 136 + sl] = f2bf(pv);
      }
    }
  }
#pragma unroll
  for (int eh = 0; eh < 2; ++eh) {
    f32x16 N[3];
#pragma unroll
    for (int e = 0; e < 3; ++e)
#pragma unroll
      for (int r = 0; r < 16; ++r) N[e][r] = 0.f;
    {
      uint4 vq[4];
#pragma unroll
      for (int i = 0; i < 4; ++i) {
        const int q = tid + 256 * i, row = q >> 4, ch = q & 15;
        vq[i] = *(const uint4*)(vT + ((size_t)(bh * 128 + eh * 64 + row)) * 4096 + j * 128 + ch * 8);
      }
#pragma unroll
      for (int i = 0; i < 4; ++i) {
        const int q = tid + 256 * i, row = q >> 4, ch = q & 15;
        *(uint4*)(R2 + row * 256 + ((ch ^ (row & 15)) << 4)) = vq[i];
      }
    }
    __syncthreads();
    {
#pragma unroll 4
      for (int ks = 0; ks < 8; ++ks) {
        const bf16x8 a = *(const bf16x8*)(Pl + lr * 136 + ks * 16 + hh * 8);
#pragma unroll
        for (int e2 = 0; e2 < 2; ++e2) {
          const int vrow = e2 * 32 + lr;
          const bf16x8 bv = *(const bf16x8*)(R2 + vrow * 256 + (((ks * 2 + hh) ^ (vrow & 15)) << 4));
          N[e2] = MFMA(a, bv, N[e2]);
        }
        N[2] = MFMA(a, ones, N[2]);
      }
    }
    {
      bf16x8 cq[4];
#pragma unroll
      for (int i = 0; i < 4; ++i) {
        const int q = tid + 256 * i, row = q >> 4, ch = q & 15;
        cq[i] = *(const bf16x8*)((const u16*)CS + (size_t)u * 16384 + (size_t)(eh * 64 + row) * 128 + ch * 8);
      }
      __syncthreads();
#pragma unroll
      for (int i = 0; i < 4; ++i) {
        const int q = tid + 256 * i, row = q >> 4, ch = q & 15;
        *(bf16x8*)(R2 + row * 256 + ((ch ^ (row & 15)) << 4)) = cq[i];
      }
    }
    __syncthreads();
    {
      const float isc = s_is[wave * 32 + lr];
      const float* nbase = ns + (size_t)u * 128 + hh * 8;
#pragma unroll 4
      for (int ks = 0; ks < 8; ++ks) {
        const bf16x8 aq = *(const bf16x8*)(qrow + ks * 16);
        const bf16x8 a = scale8(aq, isc);
#pragma unroll
        for (int e2 = 0; e2 < 2; ++e2) {
          const int crw = e2 * 32 + lr;
          const bf16x8 bc = *(const bf16x8*)(R2 + crw * 256 + (((ks * 2 + hh) ^ (crw & 15)) << 4));
          N[e2] = MFMA(a, bc, N[e2]);
        }
        const float4 n0 = *(const float4*)(nbase + ks * 16);
        const float4 n1 = *(const float4*)(nbase + ks * 16 + 4);
        const float nv[8] = {n0.x, n0.y, n0.z, n0.w, n1.x, n1.y, n1.z, n1.w};
        N[2] = MFMA(a, pack8(nv), N[2]);
      }
    }
    __syncthreads();
    u16* park = (u16*)(p.ws + OFF_HYT) + ((size_t)(bh * 32 + j) * 256 + tid) * 64 + eh * 32;
    bf16x8 pk[4];
    if (DIR == 1) {
#pragma unroll
      for (int q = 0; q < 4; ++q) pk[q] = *(const bf16x8*)(park + q * 8);
    }
#pragma unroll
    for (int r = 0; r < 16; ++r) {
      const int tl = wave * 32 + crow(r, hh);
      const float den = fmaxf(fabsf(N[2][r]), s_fl[tl]);
      const float inv = 1.f / den;
#pragma unroll
      for (int e2 = 0; e2 < 2; ++e2) {
        const float hv = N[e2][r] * inv;
        const int v = e2 * 16 + r;
        if (DIR == 0) pk[v >> 3][v & 7] = (short)f2bf(hv);
        else hs[eh * 2 + e2][r] = hv + bf2f((u16)pk[v >> 3][v & 7]);
      }
    }
    if (DIR == 0) {
#pragma unroll
      for (int q = 0; q < 4; ++q) *(bf16x8*)(park + q * 8) = pk[q];
    }
  }
}

DI void mlstm_out_unit(const Params& p, int unit, char* smem) {
  const int tid = opaque_tid(), lane = tid & 63, wave = tid >> 6, lr = lane & 31, hh = lane >> 5;
  const int j = unit & 31, bh = unit >> 5, h = bh & 3, b = bh >> 2;
  const int T0 = b * 4096 + j * 128;
  const u16* og = (const u16*)(p.ws + OFF_OG);
  u16* A2 = (u16*)(p.ws + OFF_A2);
  f32x16 hs[4];
  mlstm_dir<0>(p, bh, j, smem, hs);
  mlstm_dir<1>(p, bh, j, smem, hs);
  __syncthreads();
  float* wl = (float*)(smem + wave * 16384);
#pragma unroll
  for (int et = 0; et < 4; ++et)
#pragma unroll
    for (int r = 0; r < 16; ++r) wl[crow(r, hh) * 128 + et * 32 + lr] = hs[et][r];
  wave_lds_sync();
  {
    const int row = lane >> 1, half = lane & 1;
    const size_t T = (size_t)(T0 + wave * 32 + row);
    const u16* ogp = og + T * 512 + h * 128 + half * 64;
    const float* src = wl + row * 128 + half * 64;
    float g[64];
    float ss = 0.f;
#pragma unroll
    for (int q = 0; q < 8; ++q) {
      const bf16x8 o8 = *(const bf16x8*)(ogp + q * 8);
      const float4 h0 = *(const float4*)(src + q * 8), h1 = *(const float4*)(src + q * 8 + 4);
      g[q * 8 + 0] = h0.x * bf2f((u16)o8[0]); g[q * 8 + 1] = h0.y * bf2f((u16)o8[1]); g[q * 8 + 2] = h0.z * bf2f((u16)o8[2]); g[q * 8 + 3] = h0.w * bf2f((u16)o8[3]);
      g[q * 8 + 4] = h1.x * bf2f((u16)o8[4]); g[q * 8 + 5] = h1.y * bf2f((u16)o8[5]); g[q * 8 + 6] = h1.z * bf2f((u16)o8[6]); g[q * 8 + 7] = h1.w * bf2f((u16)o8[7]);
#pragma unroll
      for (int i = 0; i < 8; ++i) ss += g[q * 8 + i] * g[q * 8 + i];
    }
    ss += __shfl_xor(ss, 1, 64);
    const float rs = rsqrtf(ss * (1.f / 128.f) + EPS);
    const float* mw = p.mlstm_norm_w + h * 128 + half * 64;
    u16* dst = A2 + T * 1024 + h * 128 + half * 64;
#pragma unroll
    for (int q = 0; q < 8; ++q) {
      const float4 w0 = *(const float4*)(mw + q * 8), w1 = *(const float4*)(mw + q * 8 + 4);
      float o[8];
      o[0] = g[q * 8 + 0] * rs * w0.x; o[1] = g[q * 8 + 1] * rs * w0.y; o[2] = g[q * 8 + 2] * rs * w0.z; o[3] = g[q * 8 + 3] * rs * w0.w;
      o[4] = g[q * 8 + 4] * rs * w1.x; o[5] = g[q * 8 + 5] * rs * w1.y; o[6] = g[q * 8 + 6] * rs * w1.z; o[7] = g[q * 8 + 7] * rs * w1.w;
      *(bf16x8*)(dst + q * 8) = pack8(o);
    }
  }
}

DI void hyena_norm_unit(const Params& p, int unit, char* smem) {
  float* tile = (float*)smem;
  const int tid = opaque_tid();
  const int tt = unit & 63, g = (unit >> 6) & 7, b = unit >> 9;
  const u16* z2T = (const u16*)(p.ws + OFF_Z2T);
  u16* A2 = (u16*)(p.ws + OFF_A2);
  __syncthreads();
#pragma unroll
  for (int i = 0; i < 4; ++i) {
    const int q = tid + 256 * i, cl = q >> 4, t4 = q & 15;
    const ushort4 v4 = *(const ushort4*)(z2T + ((size_t)(b * 512 + g * 64 + cl)) * 4096 + tt * 64 + t4 * 4);
    float* d = tile + cl * 65 + t4 * 4;
    d[0] = bf2f(v4.x); d[1] = bf2f(v4.y); d[2] = bf2f(v4.z); d[3] = bf2f(v4.w);
  }
  __syncthreads();
  const int tl = tid >> 2, qd = tid & 3;
  float v[16];
  float ss = 0.f;
#pragma unroll
  for (int i = 0; i < 16; ++i) {
    v[i] = tile[(qd * 16 + i) * 65 + tl];
    ss += v[i] * v[i];
  }
  ss += __shfl_xor(ss, 1, 64);
  ss += __shfl_xor(ss, 2, 64);
  const float rs = rsqrtf(ss * (1.f / 64.f) + EPS);
  const size_t T = (size_t)b * 4096 + tt * 64 + tl;
  u16* dst = A2 + T * 1024 + 512 + g * 64 + qd * 16;
  const float* w = p.hyena_norm_w + g * 64 + qd * 16;
  float o[16];
#pragma unroll
  for (int i = 0; i < 16; ++i) o[i] = v[i] * rs * w[i];
  *(bf16x8*)(dst) = pack8(o);
  *(bf16x8*)(dst + 8) = pack8(o + 8);
}

template <int EPI>
DI void gemm_phase(const u16* A, const u16* Bt, int K, int ntn, void* outp, char* smem) {
  const int tid = threadIdx.x, lane = tid & 63, wave = tid >> 6, wr = wave >> 1, wc = wave & 1, lr = lane & 31, hh = lane >> 5;
  const int ntiles = tile_count(ntn);
  for (int id = blockIdx.x; id < ntiles; id += gridDim.x) {
    int mt, nt;
    tile_map(id, ntn, mt, nt);
    if (nt >= ntn) continue;
    const int m0 = mt * 256, n0 = nt * 128;
    f32x16 acc[4][2];
    gemm_core<false>(A, Bt, K, m0, n0, smem, acc);
    if (EPI == 0) {
#pragma unroll
      for (int i = 0; i < 4; ++i)
#pragma unroll
        for (int j = 0; j < 2; ++j)
#pragma unroll
          for (int r = 0; r < 16; ++r) {
            const int row = m0 + wr * 128 + i * 32 + crow(r, hh);
            const int col = n0 + wc * 64 + j * 32 + lr;
            ((float*)outp)[(size_t)row * 1024 + col] = acc[i][j][r];
          }
    } else {
      char* wl = smem + wave * 16384;
      stage_tile_ns<2>(acc, wl, lr, hh);
      wave_lds_sync();
      flush_tile_ns(wl, (u16*)outp + (size_t)(m0 + wr * 128) * 4096 + n0 + wc * 64, 4096, lane);
    }
  }
}

DI void phase_post_mix(const Params& p) {
  const int tid = threadIdx.x, lane = tid & 63, wave = tid >> 6;
  const float* mix = p.out;
  float* x1 = (float*)(p.ws + OFF_X1);
  u16* hm = (u16*)(p.ws + OFF_HM);
  for (int u = blockIdx.x; u < 1024; u += gridDim.x) {
#pragma unroll 2
    for (int rr = 0; rr < 4; ++rr) {
      const size_t row = (size_t)u * 16 + wave * 4 + rr;
      float4 mv[4], xv[4];
      float ss = 0.f;
#pragma unroll
      for (int i = 0; i < 4; ++i) {
        mv[i] = ((const float4*)(mix + row * DM))[lane + 64 * i];
        xv[i] = ((const float4*)(p.x + row * DM))[lane + 64 * i];
        ss += mv[i].x * mv[i].x + mv[i].y * mv[i].y + mv[i].z * mv[i].z + mv[i].w * mv[i].w;
      }
      ss = wave_sum(ss);
      const float rs = rsqrtf(ss * (1.f / DM) + EPS);
      float s2 = 0.f;
#pragma unroll
      for (int i = 0; i < 4; ++i) {
        const float4 w = ((const float4*)p.norm_mix_post)[lane + 64 * i];
        xv[i].x += mv[i].x * rs * w.x; xv[i].y += mv[i].y * rs * w.y; xv[i].z += mv[i].z * rs * w.z; xv[i].w += mv[i].w * rs * w.w;
        s2 += xv[i].x * xv[i].x + xv[i].y * xv[i].y + xv[i].z * xv[i].z + xv[i].w * xv[i].w;
        ((float4*)(x1 + row * DM))[lane + 64 * i] = xv[i];
      }
      s2 = wave_sum(s2);
      const float r2 = rsqrtf(s2 * (1.f / DM) + EPS);
#pragma unroll
      for (int i = 0; i < 4; ++i) {
        const float4 w = ((const float4*)p.norm_mlp_pre)[lane + 64 * i];
        ushort4 o;
        o.x = f2bf(xv[i].x * r2 * w.x); o.y = f2bf(xv[i].y * r2 * w.y); o.z = f2bf(xv[i].z * r2 * w.z); o.w = f2bf(xv[i].w * r2 * w.w);
        *(ushort4*)(hm + row * DM + (lane + 64 * i) * 4) = o;
      }
    }
  }
}

DI void phase_final(const Params& p) {
  const int tid = threadIdx.x, lane = tid & 63, wave = tid >> 6;
  const float* x1 = (const float*)(p.ws + OFF_X1);
  for (int u = blockIdx.x; u < 1024; u += gridDim.x) {
#pragma unroll 2
    for (int rr = 0; rr < 4; ++rr) {
      const size_t row = (size_t)u * 16 + wave * 4 + rr;
      float4 fv[4];
      float ss = 0.f;
#pragma unroll
      for (int i = 0; i < 4; ++i) {
        fv[i] = ((const float4*)(p.out + row * DM))[lane + 64 * i];
        ss += fv[i].x * fv[i].x + fv[i].y * fv[i].y + fv[i].z * fv[i].z + fv[i].w * fv[i].w;
      }
      ss = wave_sum(ss);
      const float rs = rsqrtf(ss * (1.f / DM) + EPS);
#pragma unroll
      for (int i = 0; i < 4; ++i) {
        const float4 w = ((const float4*)p.norm_mlp_post)[lane + 64 * i];
        const float4 xv = ((const float4*)(x1 + row * DM))[lane + 64 * i];
        float4 o;
        o.x = xv.x + fv[i].x * rs * w.x; o.y = xv.y + fv[i].y * rs * w.y; o.z = xv.z + fv[i].z * rs * w.z; o.w = xv.w + fv[i].w * rs * w.w;
        ((float4*)(p.out + row * DM))[lane + 64 * i] = o;
      }
    }
  }
}

DI void run_phase(const Params& p, int ph, char* smem) {
  switch (ph) {
    case 0: phase0(p, smem); break;
    case 1: phase1(p, smem); break;
    case 2: phase_qk(p, smem); break;
    case 3:
#ifdef DBL_HYONLY
      for (int u = blockIdx.x; u < 512; u += gridDim.x) hyena_unit(p, u, smem);
#endif
#ifdef DBL_MLONLY
      for (int u = blockIdx.x; u < 1024; u += gridDim.x) mlstm_local_unit(p, u, smem);
#endif
      for (int u = blockIdx.x; u < 512 + 1024; u += gridDim.x) {
        if (u < 512) hyena_unit(p, u, smem);
        else mlstm_local_unit(p, u - 512, smem);
      }
      break;
    case 4:
      for (int u = blockIdx.x; u < 512; u += gridDim.x) scan_unit(p, u);
      break;
    case 5:
      for (int u = blockIdx.x; u < 512 + 2048; u += gridDim.x) {
#ifndef DBG_SKIP_MLSTM
        if (u < 512) mlstm_out_unit(p, u, smem);
#else
        if (u < 512) { u16* A2 = (u16*)(p.ws + OFF_A2); const int T0 = (u >> 5 >> 2) * 4096 + (u & 31) * 128, hq = (u >> 5) & 3;
          for (int i = threadIdx.x; i < 128 * 128; i += 256) A2[(size_t)(T0 + (i >> 7)) * 1024 + hq * 128 + (i & 127)] = 0; }
#endif
#ifndef DBG_SKIP_HYENA
        else hyena_norm_unit(p, u - 512, smem);
#else
        else { const int un = u - 512; const int tt = un & 63, g = (un >> 6) & 7, b = un >> 9; u16* A2 = (u16*)(p.ws + OFF_A2);
          for (int i = threadIdx.x; i < 64 * 64; i += 256) A2[((size_t)b * 4096 + tt * 64 + (i >> 6)) * 1024 + 512 + g * 64 + (i & 63)] = 0x3F80; }
#endif
      }
      break;
    case 6: gemm_phase<0>((const u16*)(p.ws + OFF_A2), (const u16*)(p.ws + OFF_WOUTT), 1024, 8, p.out, smem); break;
    case 7: phase_post_mix(p); break;
    case 8: gemm_phase<1>((const u16*)(p.ws + OFF_HM), (const u16*)(p.ws + OFF_W1T), 1024, 32, p.ws + OFF_H, smem); break;
    case 9: gemm_phase<0>((const u16*)(p.ws + OFF_H), (const u16*)(p.ws + OFF_W2T), 4096, 8, p.out, smem); break;
    case 10: phase_final(p); break;
  }
}
constexpr int NPHASE = 11;

#define XB_XCNT(j)  (256  + 64 * (j))
#define XB_XSUB(j)  (1280 + 64 * (j))
#define XB_XGEN(j)  (2304 + 64 * (j))
#define XB_TOP      3328
#define XB_TOPGEN   3392
#define XCD_BAR_WORDS 3456
DI unsigned xb_ld(unsigned* p) { return __hip_atomic_load(p, __ATOMIC_RELAXED, __HIP_MEMORY_SCOPE_AGENT); }
DI unsigned xb_add(unsigned* p, unsigned v) { return __hip_atomic_fetch_add(p, v, __ATOMIC_RELAXED, __HIP_MEMORY_SCOPE_AGENT); }
DI unsigned xb_xcc_id() { return (unsigned)__builtin_amdgcn_s_getreg((3 << 11) | 20) & 0xFu; }
struct XcdBar { unsigned* bar; unsigned x, nloc, nx; };
DI void xcd_barrier(XcdBar& b) {
  asm volatile("s_waitcnt vmcnt(0)" ::: "memory");
  __syncthreads();
  if (threadIdx.x == 0) {
    unsigned* bar = b.bar;
    __builtin_amdgcn_s_waitcnt(0);
    if (b.nloc == 0u) {
      const unsigned G = gridDim.x;
      unsigned sum, cnt, mine;
      for (;;) {
        sum = 0u; cnt = 0u; mine = 0u;
#pragma unroll
        for (unsigned j = 0; j < 16; ++j) { const unsigned c = xb_ld(&bar[XB_XCNT(j)]); sum += c; cnt += (c > 0u) ? 1u : 0u; mine = (j == b.x) ? c : mine; }
        if (sum == G) break;
        __builtin_amdgcn_s_sleep(1);
      }
      b.nloc = mine > 0u ? mine : 1u; b.nx = cnt > 0u ? cnt : 1u;
    }
    const unsigned nloc = b.nloc, nx = b.nx;
    const unsigned old = xb_add(&bar[XB_XSUB(b.x)], 1u);
    const unsigned gen = old / nloc;
    if (old + 1u == (gen + 1u) * nloc) {
      __builtin_amdgcn_fence(__ATOMIC_RELEASE, "agent");
      asm volatile("s_waitcnt vmcnt(0)" ::: "memory");
      const unsigned og = xb_add(&bar[XB_TOP], 1u);
      const unsigned tg = og / nx;
      if (og + 1u == (tg + 1u) * nx) xb_add(&bar[XB_TOPGEN], 1u);
      else while (xb_ld(&bar[XB_TOPGEN]) == tg) __builtin_amdgcn_s_sleep(1);
      __builtin_amdgcn_fence(__ATOMIC_ACQUIRE, "agent");
      xb_add(&bar[XB_XGEN(b.x)], 1u);
      asm volatile("s_waitcnt vmcnt(0)" ::: "memory");
    } else {
      while (xb_ld(&bar[XB_XGEN(b.x)]) == gen) __builtin_amdgcn_s_sleep(1);
      __builtin_amdgcn_fence(__ATOMIC_ACQUIRE, "agent");
      asm volatile("s_waitcnt vmcnt(0)" ::: "memory");
    }
  }
  __syncthreads();
}

#if MULTI_LAUNCH
template <int PH>
__global__ void __launch_bounds__(256, 2) phase_kernel(Params p) {
  __shared__ __attribute__((aligned(16))) char smem[65536];
  run_phase(p, PH, smem);
}
template <int PH>
static void launch_phase(const Params& p, hipStream_t stream) {
  hipLaunchKernelGGL(phase_kernel<PH>, dim3(512), dim3(256), 0, stream, p);
}
#else
__global__ void __launch_bounds__(256, 2) mega_kernel(Params p) {
  __shared__ __attribute__((aligned(16))) char smem[65536];
  cg::grid_group grid = cg::this_grid();
  XcdBar xb;
  xb.bar = (unsigned*)(p.ws + OFF_BAR); xb.x = xb_xcc_id(); xb.nloc = 0u; xb.nx = 0u;
  if (p.ws == nullptr) grid.sync();
  if (threadIdx.x == 0) (void)xb_add(&xb.bar[XB_XCNT(xb.x)], 1u);
#define GSYNC xcd_barrier(xb)
#ifdef DBL_P0
  run_phase(p, 0, smem);
#endif
  run_phase(p, 0, smem); GSYNC;
  run_phase(p, 1, smem); GSYNC;
#ifdef DBL_GEMM
  run_phase(p, 1, smem); grid.sync();
#endif
  run_phase(p, 2, smem); GSYNC;
#ifdef DBL_P2
  run_phase(p, 2, smem); GSYNC;
#endif
  run_phase(p, 3, smem); GSYNC;
#ifdef DBL_HY
  run_phase(p, 3, smem); GSYNC;
#endif
  run_phase(p, 4, smem); GSYNC;
  run_phase(p, 5, smem); GSYNC;
#ifdef DBL_P5
  run_phase(p, 5, smem); GSYNC;
#endif
  run_phase(p, 6, smem); GSYNC;
#ifdef DBL_GEMM
  run_phase(p, 6, smem); GSYNC;
#endif
  run_phase(p, 7, smem); GSYNC;
#ifdef DBL_P7
  run_phase(p, 7, smem); GSYNC;
#endif
  run_phase(p, 8, smem); GSYNC;
#ifdef DBL_GEMM
  run_phase(p, 8, smem); GSYNC;
#endif
  run_phase(p, 9, smem); GSYNC;
#ifdef DBL_GEMM
  run_phase(p, 9, smem); GSYNC;
#endif
#ifdef XSYNC
  for (int q = 0; q < 10; ++q) GSYNC;
#endif
  run_phase(p, 10, smem);
}
#endif

extern "C" void kernel_launch(void* const* d_in, const int* in_sizes, int n_in, void* d_out, int out_size, void* d_ws,
                              size_t ws_size, hipStream_t stream) {
  Params p{};
  const float** pp = (const float**)&p;
  for (int i = 0; i < 23; ++i) pp[i] = (const float*)d_in[i];
  p.out = (float*)d_out;
  p.ws = (char*)d_ws;
#if MULTI_LAUNCH
  launch_phase<0>(p, stream);
#ifdef DBL_P0
  launch_phase<0>(p, stream);
#endif
 launch_phase<1>(p, stream); launch_phase<2>(p, stream); launch_phase<3>(p, stream);
#ifdef DBL_HY
  launch_phase<3>(p, stream);
#endif

  launch_phase<4>(p, stream); launch_phase<5>(p, stream);
#ifdef DBL_P5
  launch_phase<5>(p, stream);
#endif
 launch_phase<6>(p, stream); launch_phase<7>(p, stream);
  launch_phase<8>(p, stream); launch_phase<9>(p, stream); launch_phase<10>(p, stream);
#else
  static int grid_blocks = 0;
  if (!grid_blocks) {
    int dev = 0, cus = 0, per_cu = 0;
    hipGetDevice(&dev);
    hipDeviceGetAttribute(&cus, hipDeviceAttributeMultiprocessorCount, dev);
    hipOccupancyMaxActiveBlocksPerMultiprocessor(&per_cu, mega_kernel, 256, 0);
    if (per_cu > 2) per_cu = 2;
    if (per_cu < 1) per_cu = 1;
#ifdef FORCE2
    per_cu = 2;
#endif
    grid_blocks = cus * per_cu;
  }
  hipMemsetAsync((char*)d_ws + OFF_BAR, 0, XCD_BAR_WORDS * 4, stream);
  void* args[] = {&p};
  hipError_t e = hipLaunchCooperativeKernel((void*)mega_kernel, dim3(grid_blocks), dim3(256), args, 0, stream);
  if (e != hipSuccess) fprintf(stderr, "cooperative launch failed: %s (grid %d)\n", hipGetErrorString(e), grid_blocks);
#endif
}
#if defined(__HIP_DEVICE_COMPILE__)
#pragma clang attribute pop
#endif
```

```cpp
#if defined(__HIP_DEVICE_COMPILE__)
#pragma clang attribute push(__attribute__((target("no-packed-fp32-ops"))), apply_to = function)
#endif
#include <hip/hip_runtime.h>
#include <hip/hip_cooperative_groups.h>
#include <cstdio>
namespace cg = cooperative_groups;

#ifndef MULTI_LAUNCH
#define MULTI_LAUNCH 0
#endif

typedef unsigned short u16;
using bf16x8 = __attribute__((ext_vector_type(8))) short;
using f32x16 = __attribute__((ext_vector_type(16))) float;
#define DI __device__ __forceinline__
#define MFMA(a, b, c) __builtin_amdgcn_mfma_f32_32x32x16_bf16((a), (b), (c), 0, 0, 0)

constexpr int SEQ = 4096, DM = 1024, NTOK = 16384, NIN = 3600, NINP = 3712, DFF = 4096;
constexpr float EPS = 1e-6f;
constexpr size_t MiB = 1u << 20;
constexpr size_t OFF_WINT = 0, OFF_WOUTT = 8 * MiB, OFF_W1T = 10 * MiB, OFF_W2T = 18 * MiB;
constexpr size_t OFF_XN = 26 * MiB, OFF_QA = 26 * MiB, OFF_KA = 42 * MiB;
constexpr size_t OFF_FILT = 58 * MiB, OFF_QKPRE = 90 * MiB, OFF_A2 = 90 * MiB;
constexpr size_t OFF_HYT = 122 * MiB, OFF_VT = 170 * MiB, OFF_OG = 186 * MiB, OFF_GATES = 202 * MiB;
constexpr size_t OFF_NL = 203 * MiB, OFF_MLOC = 203 * MiB + 512 * 1024, OFF_GSUM = OFF_MLOC + 4096, OFF_MS = OFF_GSUM + 4096;
constexpr size_t OFF_KAT = 205 * MiB, OFF_Z2T = 221 * MiB;
constexpr size_t OFF_TW = 204 * MiB, OFF_BAR = 254 * MiB;
constexpr size_t OFF_X1 = 26 * MiB, OFF_HM = 90 * MiB, OFF_H = 122 * MiB;

struct Params {
  const float *x, *norm_mix_pre, *norm_mix_post, *norm_mlp_pre, *norm_mlp_post, *w_in, *b_gates, *conv_w, *conv_b,
      *mlstm_norm_w, *hyena_norm_w, *filt_w1, *filt_b1, *filt_w2, *filt_b2, *filt_w3, *filt_b3, *filt_w4, *filt_freq,
      *filt_bias, *w_out, *w_mlp_in, *w_mlp_out;
  float* out;
  char* ws;
};

DI u16 f2bf(float x) { const __bf16 b = (__bf16)x; return __builtin_bit_cast(u16, b); }
DI float bf2f(u16 v) { return __uint_as_float(((unsigned)v) << 16); }
DI int opaque_tid() { int t = threadIdx.x; asm volatile("" : "+v"(t)); return t; }
DI int crow(int r, int hh) { return (r & 3) + 8 * (r >> 2) + 4 * hh; }
DI float log_sigmoid(float x) { return fminf(x, 0.f) - log1pf(expf(-fabsf(x))); }
DI float sigmoidf(float x) { return 1.f / (1.f + __expf(-x)); }
DI float red2pi(float x) {
  const float k = rintf(x * 0.15915494309189535f);
  float r = fmaf(-k, 6.28125f, x);
  return fmaf(-k, 1.9353071795864769e-3f, r);
}
DI float fsin(float x) { return sinf(x); }
DI float fcos(float x) { return cosf(x); }
DI bf16x8 pack8(const float* v) {
  bf16x8 r;
#pragma unroll
  for (int i = 0; i < 8; ++i) r[i] = (short)f2bf(v[i]);
  return r;
}
DI bf16x8 scale8(bf16x8 a, float s) {
  bf16x8 r;
#pragma unroll
  for (int i = 0; i < 8; ++i) r[i] = (short)f2bf(bf2f((u16)a[i]) * s);
  return r;
}

template <bool SWAP>
DI void gemm_core(const u16* __restrict__ A, const u16* __restrict__ Bt, int K, int m0, int n0, char* smem, f32x16 (&acc)[4][2]) {
  const int tid = opaque_tid(), lane = tid & 63, wave = tid >> 6, wr = wave >> 1, wc = wave & 1;
  const int lr = lane & 31, hh = lane >> 5;
#pragma unroll
  for (int i = 0; i < 4; ++i)
#pragma unroll
    for (int j = 0; j < 2; ++j)
#pragma unroll
      for (int r = 0; r < 16; ++r) acc[i][j][r] = 0.f;
  const int c = tid & 7, r0 = tid >> 3;
  const u16* Ag = A + (size_t)(m0 + r0) * K + c * 8;
  const u16* Bg = Bt + (size_t)(n0 + r0) * K + c * 8;
  const int soff = r0 * 128 + ((c ^ ((r0 >> 1) & 7)) << 4);
  char* As = smem;
  char* Bs = smem + 32768;
  uint4 ra0, ra1, ra2, ra3, ra4, ra5, ra6, ra7, rb0, rb1, rb2, rb3;
#define GLOAD_ALL(k0)                                                                                             \
  ra0 = *(const uint4*)(Ag + (size_t)(0) * K + (k0));   ra1 = *(const uint4*)(Ag + (size_t)(32) * K + (k0));      \
  ra2 = *(const uint4*)(Ag + (size_t)(64) * K + (k0));  ra3 = *(const uint4*)(Ag + (size_t)(96) * K + (k0));      \
  ra4 = *(const uint4*)(Ag + (size_t)(128) * K + (k0)); ra5 = *(const uint4*)(Ag + (size_t)(160) * K + (k0));     \
  ra6 = *(const uint4*)(Ag + (size_t)(192) * K + (k0)); ra7 = *(const uint4*)(Ag + (size_t)(224) * K + (k0));     \
  rb0 = *(const uint4*)(Bg + (size_t)(0) * K + (k0));   rb1 = *(const uint4*)(Bg + (size_t)(32) * K + (k0));      \
  rb2 = *(const uint4*)(Bg + (size_t)(64) * K + (k0));  rb3 = *(const uint4*)(Bg + (size_t)(96) * K + (k0));
  GLOAD_ALL(0)
  const int nk = K >> 6;
#pragma unroll 1
  for (int kt = 0; kt < nk; ++kt) {
    __syncthreads();
    *(uint4*)(As + soff + 0 * 4096) = ra0; *(uint4*)(As + soff + 1 * 4096) = ra1; *(uint4*)(As + soff + 2 * 4096) = ra2; *(uint4*)(As + soff + 3 * 4096) = ra3;
    *(uint4*)(As + soff + 4 * 4096) = ra4; *(uint4*)(As + soff + 5 * 4096) = ra5; *(uint4*)(As + soff + 6 * 4096) = ra6; *(uint4*)(As + soff + 7 * 4096) = ra7;
    *(uint4*)(Bs + soff + 0 * 4096) = rb0; *(uint4*)(Bs + soff + 1 * 4096) = rb1; *(uint4*)(Bs + soff + 2 * 4096) = rb2; *(uint4*)(Bs + soff + 3 * 4096) = rb3;
    __syncthreads();
    if (kt + 1 < nk) {
      const int k0 = (kt + 1) << 6;
      GLOAD_ALL(k0)
    }
#pragma unroll
    for (int kk = 0; kk < 4; ++kk) {
      bf16x8 a[4], b[2];
      const int cc = kk * 2 + hh;
#pragma unroll
      for (int i = 0; i < 4; ++i) {
        const int r = wr * 128 + i * 32 + lr;
        a[i] = *(const bf16x8*)(As + r * 128 + ((cc ^ ((r >> 1) & 7)) << 4));
      }
#pragma unroll
      for (int j = 0; j < 2; ++j) {
        const int r = wc * 64 + j * 32 + lr;
        b[j] = *(const bf16x8*)(Bs + r * 128 + ((cc ^ ((r >> 1) & 7)) << 4));
      }
#pragma unroll
      for (int i = 0; i < 4; ++i)
#pragma unroll
        for (int j = 0; j < 2; ++j) acc[i][j] = SWAP ? MFMA(b[j], a[i], acc[i][j]) : MFMA(a[i], b[j], acc[i][j]);
    }
  }
  __syncthreads();
}

DI void tile_map(int id, int ntn, int& mt, int& nt) {
  const int r = id >> 9, b = id & 511;
  const int x = b & 7, sidx = b >> 3;
  const int P = r * 8 + x;
  mt = (P & 7) * 8 + (sidx & 7);
  nt = (P >> 3) * 8 + (sidx >> 3);
}
DI int tile_count(int ntn) { return ((ntn + 7) >> 3) * 512; }

DI void transpose_tile(const float* __restrict__ src, int R, int C, u16* __restrict__ dst, int kt, int nt, char* smem) {
  float* tile = (float*)smem;
  const int tid = threadIdx.x;
  const int k0 = kt * 64, n0 = nt * 64;
#pragma unroll 4
  for (int it = 0; it < 16; ++it) {
    const int kk = it * 4 + (tid >> 6), nn = tid & 63;
    const int n = n0 + nn;
    tile[kk * 65 + nn] = (n < C) ? src[(size_t)(k0 + kk) * C + n] : 0.f;
  }
  __syncthreads();
#pragma unroll
  for (int it = 0; it < 2; ++it) {
    const int q = tid + 256 * it, nn = q >> 3, kc = q & 7;
    float o[8];
#pragma unroll
    for (int i = 0; i < 8; ++i) o[i] = tile[(kc * 8 + i) * 65 + nn];
    *(bf16x8*)(dst + (size_t)(n0 + nn) * R + k0 + kc * 8) = pack8(o);
  }
  __syncthreads();
}

DI float wave_sum(float v) {
#pragma unroll
  for (int o = 32; o; o >>= 1) v += __shfl_xor(v, o, 64);
  return v;
}

DI void filter_unit(const Params& p, int unit, char* smem) {
  float* sz = (float*)smem;
  float* hA = sz + 8 * 33 + 8;
  float* hB = hA + 8 * 64;
  float* hT = hB + 8 * 64;
  const int tid = opaque_tid();
  const int l0 = unit * 8;
  for (int idx = tid; idx < 8 * 33; idx += 256) {
    const int pp = idx / 33, f = idx - pp * 33;
    const float l = (float)(l0 + pp);
    float v;
    if (f == 0) v = l / 4095.f;
    else {
      const int jb = (f - 1) & 15;
      const float fj = 1e-4f + (float)jb * ((15.f - 1e-4f) / 15.f);
      const float ang = 6.283185307179586f * l / 4096.f;
      v = (f <= 16) ? fcos(fj * ang) : -fsin(fj * ang);
    }
    sz[idx] = v;
  }
  const int o = tid & 63, pq = tid >> 6;
  {
    const float bb = p.filt_b1[o], fr = p.filt_freq[o];
    __syncthreads();
    float s0 = bb, s1 = bb;
#pragma unroll 1
    for (int f0 = 0; f0 < 33; f0 += 11) {
      float wc[11];
#pragma unroll
      for (int f = 0; f < 11; ++f) wc[f] = p.filt_w1[(f0 + f) * 64 + o];
#pragma unroll
      for (int f = 0; f < 11; ++f) { s0 += sz[pq * 33 + f0 + f] * wc[f]; s1 += sz[(pq + 4) * 33 + f0 + f] * wc[f]; }
    }
    hA[pq * 64 + o] = fsin(fr * s0);
    hA[(pq + 4) * 64 + o] = fsin(fr * s1);
  }
  {
    const float bb = p.filt_b2[o], fr = p.filt_freq[64 + o];
    __syncthreads();
    float s0 = bb, s1 = bb;
#pragma unroll 1
    for (int k0 = 0; k0 < 64; k0 += 16) {
      float wc[16];
#pragma unroll
      for (int k = 0; k < 16; ++k) wc[k] = p.filt_w2[(k0 + k) * 64 + o];
#pragma unroll
      for (int k = 0; k < 16; ++k) { s0 += hA[pq * 64 + k0 + k] * wc[k]; s1 += hA[(pq + 4) * 64 + k0 + k] * wc[k]; }
    }
    hB[pq * 64 + o] = fsin(fr * s0);
    hB[(pq + 4) * 64 + o] = fsin(fr * s1);
  }
  {
    const float bb = p.filt_b3[o], fr = p.filt_freq[128 + o];
    __syncthreads();
    float s0 = bb, s1 = bb;
#pragma unroll 1
    for (int k0 = 0; k0 < 64; k0 += 16) {
      float wc[16];
#pragma unroll
      for (int k = 0; k < 16; ++k) wc[k] = p.filt_w3[(k0 + k) * 64 + o];
#pragma unroll
      for (int k = 0; k < 16; ++k) { s0 += hB[pq * 64 + k0 + k] * wc[k]; s1 += hB[(pq + 4) * 64 + k0 + k] * wc[k]; }
    }
    hT[o * 8 + pq] = fsin(fr * s0);
    hT[o * 8 + pq + 4] = fsin(fr * s1);
  }
  __syncthreads();
  float* filt = (float*)(p.ws + OFF_FILT);
  const float min_decay = -3.0701134573253944f, max_decay = -15.350567286626973f;
#pragma unroll 1
  for (int cc = 0; cc < 8; ++cc) {
    const int col = tid + 256 * cc;
    float acc[8];
#pragma unroll
    for (int q = 0; q < 8; ++q) acc[q] = 0.f;
#pragma unroll 1
    for (int k0 = 0; k0 < 64; k0 += 16) {
      float wc[16];
#pragma unroll
      for (int k = 0; k < 16; ++k) wc[k] = p.filt_w4[(k0 + k) * 2048 + col];
#pragma unroll
      for (int k = 0; k < 16; ++k) {
        const float4 h0 = *(const float4*)(hT + (k0 + k) * 8);
        const float4 h1 = *(const float4*)(hT + (k0 + k) * 8 + 4);
        acc[0] += h0.x * wc[k]; acc[1] += h0.y * wc[k]; acc[2] += h0.z * wc[k]; acc[3] += h0.w * wc[k];
        acc[4] += h1.x * wc[k]; acc[5] += h1.y * wc[k]; acc[6] += h1.z * wc[k]; acc[7] += h1.w * wc[k];
      }
    }
    const int ch = col & 511;
    const float delta = fabsf(min_decay + (float)ch * ((max_decay - min_decay) / 511.f));
#pragma unroll
    for (int q = 0; q < 8; ++q) {
      const float t = (float)(l0 + q) / 4095.f;
      acc[q] *= expf(-t * delta);
    }
    float4* dst = (float4*)(filt + (size_t)col * 4096 + l0);
    dst[0] = make_float4(acc[0], acc[1], acc[2], acc[3]);
    dst[1] = make_float4(acc[4], acc[5], acc[6], acc[7]);
  }
  __syncthreads();
}

DI void phase0(const Params& p, char* smem) {
  const int tid = threadIdx.x, lane = tid & 63, wave = tid >> 6;
  const int U_W = 32, U_F = 512, U_X = 1024, U_T1 = 58 * 16, U_T2 = 256, U_T3 = 1024, U_T4 = 1024;
  const int total = U_W + U_F + U_X + U_T1 + U_T2 + U_T3 + U_T4;
  for (int u = blockIdx.x; u < total; u += gridDim.x) {
    int v = u;
    if (v < U_W) {
      const int idx = v * 256 + tid;
      if (idx < 8191) {
        const int lh = 31 - __clz(idx + 1);
        const int h = 1 << lh, jj = idx + 1 - h;
        float2* twp = (float2*)(p.ws + OFF_TW);
        const float ang = -3.14159265358979f * (float)jj / (float)h;
        twp[idx] = make_float2(cosf(ang), sinf(ang));
      }
      continue;
    }
    v -= U_W;
    if (v < U_F) { filter_unit(p, v, smem); continue; }
    v -= U_F;
    if (v < U_X) {
      u16* xn = (u16*)(p.ws + OFF_XN);
#pragma unroll 4
      for (int rr = 0; rr < 4; ++rr) {
        const int row = v * 16 + wave * 4 + rr;
        const float4* xr = (const float4*)(p.x + (size_t)row * DM);
        float4 xv[4];
        float ss = 0.f;
#pragma unroll
        for (int i = 0; i < 4; ++i) {
          xv[i] = xr[lane + 64 * i];
          ss += xv[i].x * xv[i].x + xv[i].y * xv[i].y + xv[i].z * xv[i].z + xv[i].w * xv[i].w;
        }
        ss = wave_sum(ss);
        const float rs = rsqrtf(ss * (1.f / DM) + EPS);
#pragma unroll
        for (int i = 0; i < 4; ++i) {
          const float4 w = ((const float4*)p.norm_mix_pre)[lane + 64 * i];
          ushort4 o;
          o.x = f2bf(xv[i].x * rs * w.x); o.y = f2bf(xv[i].y * rs * w.y); o.z = f2bf(xv[i].z * rs * w.z); o.w = f2bf(xv[i].w * rs * w.w);
          *(ushort4*)(xn + (size_t)row * DM + (lane + 64 * i) * 4) = o;
        }
      }
      continue;
    }
    v -= U_X;
    if (v < U_T1) { transpose_tile(p.w_in, DM, NIN, (u16*)(p.ws + OFF_WINT), v & 15, v >> 4, smem); continue; }
    v -= U_T1;
    if (v < U_T2) { transpose_tile(p.w_out, DM, DM, (u16*)(p.ws + OFF_WOUTT), v & 15, v >> 4, smem); continue; }
    v -= U_T2;
    if (v < U_T3) { transpose_tile(p.w_mlp_in, DM, DFF, (u16*)(p.ws + OFF_W1T), v & 15, v >> 4, smem); continue; }
    v -= U_T3;
    transpose_tile(p.w_mlp_out, DFF, DM, (u16*)(p.ws + OFF_W2T), v & 63, v >> 6, smem);
  }
}

DI void wave_lds_sync() { asm volatile("s_waitcnt lgkmcnt(0)" ::: "memory"); __builtin_amdgcn_wave_barrier(); }
template <int MODE>
DI void stage_tile_ns(const f32x16 (&acc)[4][2], char* wl, int lr, int hh) {
#pragma unroll
  for (int i = 0; i < 4; ++i)
#pragma unroll
    for (int j = 0; j < 2; ++j)
#pragma unroll
      for (int r = 0; r < 16; ++r) {
        float v = acc[i][j][r];
        if (MODE == 1) v = sigmoidf(v);
        if (MODE == 2) { v = fmaxf(v, 0.f); v = v * v; }
        *(u16*)(wl + (i * 32 + crow(r, hh)) * 128 + (j * 32 + lr) * 2) = f2bf(v);
      }
}
DI void stage_tile_sw(const f32x16 (&acc)[4][2], char* wl, int lr, int hh) {
#pragma unroll
  for (int i = 0; i < 4; ++i)
#pragma unroll
    for (int j = 0; j < 2; ++j)
#pragma unroll
      for (int r = 0; r < 16; ++r) *(u16*)(wl + (j * 32 + crow(r, hh)) * 256 + (i * 32 + lr) * 2) = f2bf(acc[i][j][r]);
}
DI void flush_tile_ns(const char* wl, u16* dst, size_t pitch, int lane) {
#pragma unroll 4
  for (int it = 0; it < 16; ++it) {
    const int q = lane + 64 * it, row = q >> 3, c8 = q & 7;
    *(uint4*)(dst + (size_t)row * pitch + c8 * 8) = *(const uint4*)(wl + row * 128 + c8 * 16);
  }
}

DI void phase1(const Params& p, char* smem) {
  const int tid = threadIdx.x, lane = tid & 63, wave = tid >> 6, wr = wave >> 1, wc = wave & 1, lr = lane & 31, hh = lane >> 5;
  const u16* xn = (const u16*)(p.ws + OFF_XN);
  const u16* wt = (const u16*)(p.ws + OFF_WINT);
  u16* qkpre = (u16*)(p.ws + OFF_QKPRE);
  u16* hyT = (u16*)(p.ws + OFF_HYT);
  u16* vT = (u16*)(p.ws + OFF_VT);
  u16* og = (u16*)(p.ws + OFF_OG);
  float* gates = (float*)(p.ws + OFF_GATES);
  const int ntn = 29, ntiles = tile_count(ntn);
  for (int id = blockIdx.x; id < ntiles; id += gridDim.x) {
    int mt, nt;
    tile_map(id, ntn, mt, nt);
    if (nt >= ntn) continue;
    const int m0 = mt * 256, n0 = nt * 128;
    f32x16 acc[4][2];
    const bool swap = (nt >= 8 && nt < 24);
    if (swap) gemm_core<true>(xn, wt, DM, m0, n0, smem, acc);
    else gemm_core<false>(xn, wt, DM, m0, n0, smem, acc);
    char* wl = smem + wave * 16384;
    if (!swap) {
      if (nt < 28) {
        if (nt < 8) stage_tile_ns<0>(acc, wl, lr, hh); else stage_tile_ns<1>(acc, wl, lr, hh);
        wave_lds_sync();
        const size_t row0 = (size_t)(m0 + wr * 128);
        if (nt < 8) flush_tile_ns(wl, qkpre + row0 * 1024 + n0 + wc * 64, 1024, lane);
        else flush_tile_ns(wl, og + row0 * 512 + (n0 - 3072) + wc * 64, 512, lane);
      } else {
#pragma unroll
        for (int i = 0; i < 4; ++i)
#pragma unroll
          for (int r = 0; r < 16; ++r) {
            const int row = m0 + wr * 128 + i * 32 + crow(r, hh);
            if (wc == 0 && lr < 16) gates[(size_t)row * 16 + lr] = acc[i][0][r];
          }
      }
    } else {
      stage_tile_sw(acc, wl, lr, hh);
      wave_lds_sync();
      const int mrow = m0 + wr * 128, b = mrow >> 12, t0 = mrow & 4095;
#pragma unroll 4
      for (int it = 0; it < 16; ++it) {
        const int q = lane + 64 * it, chl = q >> 4, c16 = q & 15;
        const int n = n0 + wc * 64 + chl;
        u16* dst;
        if (nt < 20) { const int cc = n - 1024, g = cc >> 9, ch = cc & 511; dst = hyT + ((size_t)((g * 4 + b) * 512 + ch)) * 4096; }
        else dst = vT + ((size_t)(b * 512 + (n - 2560))) * 4096;
        *(uint4*)(dst + t0 + c16 * 8) = *(const uint4*)(wl + chl * 256 + c16 * 16);
      }
    }
  }
}

DI void phase_qk(const Params& p, char* smem) {
  const int tid = opaque_tid();
  const int cg = tid & 31, rg = tid >> 5;
  const u16* qkpre = (const u16*)(p.ws + OFF_QKPRE);
  u16* qa = (u16*)(p.ws + OFF_QA);
  u16* ka = (u16*)(p.ws + OFF_KA);
  u16* kaT = (u16*)(p.ws + OFF_KAT);
  for (int u = blockIdx.x; u < 1024; u += gridDim.x) {
    const int ct = u & 3, tt = u >> 2;
    const int C0 = ct * 256 + cg * 8;
    const int Tb = tt * 64 + rg * 8;
    const int tb = Tb & 4095;
    float w0[8], w1[8], w2[8], cb[8];
    {
      const float4 a0 = *(const float4*)(p.conv_w + C0), a1 = *(const float4*)(p.conv_w + C0 + 4);
      const float4 b0 = *(const float4*)(p.conv_w + 2560 + C0), b1 = *(const float4*)(p.conv_w + 2560 + C0 + 4);
      const float4 c0 = *(const float4*)(p.conv_w + 5120 + C0), c1 = *(const float4*)(p.conv_w + 5120 + C0 + 4);
      const float4 d0 = *(const float4*)(p.conv_b + C0), d1 = *(const float4*)(p.conv_b + C0 + 4);
      w0[0] = a0.x; w0[1] = a0.y; w0[2] = a0.z; w0[3] = a0.w; w0[4] = a1.x; w0[5] = a1.y; w0[6] = a1.z; w0[7] = a1.w;
      w1[0] = b0.x; w1[1] = b0.y; w1[2] = b0.z; w1[3] = b0.w; w1[4] = b1.x; w1[5] = b1.y; w1[6] = b1.z; w1[7] = b1.w;
      w2[0] = c0.x; w2[1] = c0.y; w2[2] = c0.z; w2[3] = c0.w; w2[4] = c1.x; w2[5] = c1.y; w2[6] = c1.z; w2[7] = c1.w;
      cb[0] = d0.x; cb[1] = d0.y; cb[2] = d0.z; cb[3] = d0.w; cb[4] = d1.x; cb[5] = d1.y; cb[6] = d1.z; cb[7] = d1.w;
    }
    bf16x8 rows[10];
    const u16* src = qkpre + (size_t)Tb * 1024 + C0;
#pragma unroll
    for (int r = 0; r < 10; ++r) {
      const int t = tb + r - 1;
      bf16x8 z;
#pragma unroll
      for (int i = 0; i < 8; ++i) z[i] = 0;
      rows[r] = (t >= 0 && t <= 4095) ? *(const bf16x8*)(src + (ptrdiff_t)(r - 1) * 1024) : z;
    }
    const bool isk = C0 >= 512;
    bf16x8 tr[8];
#pragma unroll
    for (int r = 0; r < 8; ++r) {
      bf16x8 o;
#pragma unroll
      for (int i = 0; i < 8; ++i) {
        const float val = w0[i] * bf2f((u16)rows[r][i]) + w1[i] * bf2f((u16)rows[r + 1][i]) + w2[i] * bf2f((u16)rows[r + 2][i]) + cb[i];
        float sv = val * sigmoidf(val);
        if (isk) sv *= 0.08838834764831845f;
        o[i] = (short)f2bf(sv);
        tr[i][r] = o[i];
      }
      if (!isk) *(bf16x8*)(qa + (size_t)(Tb + r) * 512 + C0) = o;
      else *(bf16x8*)(ka + (size_t)(Tb + r) * 512 + (C0 - 512)) = o;
    }
    if (isk) {
      const int b = Tb >> 12;
#pragma unroll
      for (int i = 0; i < 8; ++i) *(bf16x8*)(kaT + ((size_t)(b * 512 + (C0 - 512) + i)) * 4096 + tb) = tr[i];
    }
  }
}

DI float lz(float v) { asm volatile("" : "+v"(v)); return v; }
DI float2 mk2(float a, float b) { return make_float2(a, b); }
DI float2 cmul(float2 a, float2 w) { return mk2(a.x * w.x - a.y * w.y, a.x * w.y + a.y * w.x); }
DI float2 cmulc(float2 a, float2 w) { return mk2(a.x * w.x + a.y * w.y, a.y * w.x - a.x * w.y); }
DI int lx(int idx) { const int sw = (idx >> 5) & 3; return idx ^ (sw << 3) ^ (sw << 1); }
template <bool LX>
DI void addr4(int base, int q, int k, int& a0, int& a1, int& a2, int& a3) {
  if (!LX) { a0 = base; a1 = base + q; a2 = base + 2 * q; a3 = base + 3 * q; }
  else if (q == 8) {
    const int sw = (k >> 3) & 3, b2 = base ^ (sw << 1);
    a0 = b2 + (sw << 3); a1 = b2 + ((1 ^ sw) << 3); a2 = b2 + ((2 ^ sw) << 3); a3 = b2 + ((3 ^ sw) << 3);
  } else {
    a0 = base; a1 = (base ^ 10) + 32; a2 = (base ^ 20) + 64; a3 = (base ^ 30) + 96;
  }
}
template <int NW, bool INV, bool INLX = false, bool OUTLX = false, bool PRUNE = false>
DI void r4_pass(float2* x, int tid, int q, const float2* __restrict__ t1, const float2* __restrict__ t2) {
  constexpr int NL = NW > 4 ? 4 : NW;
  constexpr int NB = NW > 4 ? 2 : 1;
  constexpr int CNT = 8 / NB;
#pragma unroll 1
  for (int bt = 0; bt < NB; ++bt) {
    float2 w1[NL], w2[NL];
#pragma unroll
    for (int n = 0; n < NL; ++n) { const int j = (tid + ((bt * CNT + n) << 8)) & (q - 1); w1[n] = t1[j]; w2[n] = t2[j]; }
    if (bt == 0) __syncthreads();
#pragma unroll(NL == 4 ? 4 : 2)
    for (int ii = 0; ii < CNT; ++ii) {
      const int k = tid + ((bt * CNT + ii) << 8);
      const int j = k & (q - 1);
      int base = ((k - j) << 2) + j;
      asm volatile("" : "+v"(base));
      const float2 ww1 = w1[ii % NL], ww2 = w2[ii % NL];
      int i0_, i1_, i2_, i3_, o0_, o1_, o2_, o3_;
      addr4<INLX>(base, q, k, i0_, i1_, i2_, i3_);
      addr4<OUTLX>(base, q, k, o0_, o1_, o2_, o3_);
      const float2 zz = make_float2(0.f, 0.f);
      const float2 x0 = x[i0_], x1 = x[i1_];
      const float2 x2 = (PRUNE && !INV) ? zz : x[i2_], x3 = (PRUNE && !INV) ? zz : x[i3_];
      if (!INV) {
        const float2 a0 = mk2(x0.x + x2.x, x0.y + x2.y);
        const float2 a1 = mk2(x1.x + x3.x, x1.y + x3.y);
        const float2 d02 = mk2(x0.x - x2.x, x0.y - x2.y);
        const float2 d13 = mk2(x1.y - x3.y, x3.x - x1.x);
        const float2 a2 = cmul(d02, ww1);
        const float2 a3 = cmul(d13, ww1);
        x[o0_] = mk2(a0.x + a1.x, a0.y + a1.y);
        x[o1_] = cmul(mk2(a0.x - a1.x, a0.y - a1.y), ww2);
        x[o2_] = mk2(a2.x + a3.x, a2.y + a3.y);
        x[o3_] = cmul(mk2(a2.x - a3.x, a2.y - a3.y), ww2);
      } else {
        const float2 b1 = cmulc(x1, ww2), b3 = cmulc(x3, ww2);
        const float2 a0 = mk2(x0.x + b1.x, x0.y + b1.y);
        const float2 a1 = mk2(x0.x - b1.x, x0.y - b1.y);
        const float2 a2 = mk2(x2.x + b3.x, x2.y + b3.y);
        const float2 a3 = mk2(x2.x - b3.x, x2.y - b3.y);
        const float2 c2 = cmulc(a2, ww1);
        const float2 c3t = cmulc(a3, ww1);
        const float2 c3 = mk2(-c3t.y, c3t.x);
        x[o0_] = mk2(a0.x + c2.x, a0.y + c2.y);
        if (!PRUNE) x[o2_] = mk2(a0.x - c2.x, a0.y - c2.y);
        x[o1_] = mk2(a1.x + c3.x, a1.y + c3.y);
        if (!PRUNE) x[o3_] = mk2(a1.x - c3.x, a1.y - c3.y);
      }
    }
  }
}
template <bool INV>
DI void r8_tail(float2* x, int tid) {
  const float R = 0.70710678118654752f;
#pragma unroll 2
  for (int i = 0; i < 4; ++i) {
    const int G = tid + (i << 8);
    const int sw = (G >> 2) & 3;
    const int blk = (G << 3) ^ (sw << 3);
    float4* p0 = (float4*)(x + blk + ((0 ^ sw) << 1));
    float4* p1 = (float4*)(x + blk + ((1 ^ sw) << 1));
    float4* p2 = (float4*)(x + blk + ((2 ^ sw) << 1));
    float4* p3 = (float4*)(x + blk + ((3 ^ sw) << 1));
    const float4 v0 = *p0, v1 = *p1, v2 = *p2, v3 = *p3;
    float2 e0 = make_float2(v0.x, v0.y), e1 = make_float2(v0.z, v0.w), e2 = make_float2(v1.x, v1.y), e3 = make_float2(v1.z, v1.w);
    float2 e4 = make_float2(v2.x, v2.y), e5 = make_float2(v2.z, v2.w), e6 = make_float2(v3.x, v3.y), e7 = make_float2(v3.z, v3.w);
    if (!INV) {
      const float2 s0 = mk2(e0.x + e4.x, e0.y + e4.y), d0 = mk2(e0.x - e4.x, e0.y - e4.y);
      const float2 s1 = mk2(e1.x + e5.x, e1.y + e5.y), t1 = mk2(e1.x - e5.x, e1.y - e5.y);
      const float2 s2 = mk2(e2.x + e6.x, e2.y + e6.y), t2 = mk2(e2.x - e6.x, e2.y - e6.y);
      const float2 s3 = mk2(e3.x + e7.x, e3.y + e7.y), t3 = mk2(e3.x - e7.x, e3.y - e7.y);
      const float2 d1 = mk2((t1.x + t1.y) * R, (t1.y - t1.x) * R);
      const float2 d2 = mk2(t2.y, -t2.x);
      const float2 d3 = mk2((t3.y - t3.x) * R, -(t3.x + t3.y) * R);
      const float2 a0 = mk2(s0.x + s2.x, s0.y + s2.y), a2 = mk2(s0.x - s2.x, s0.y - s2.y);
      const float2 a1 = mk2(s1.x + s3.x, s1.y + s3.y), u3 = mk2(s1.x - s3.x, s1.y - s3.y);
      const float2 a3 = mk2(u3.y, -u3.x);
      const float2 a4 = mk2(d0.x + d2.x, d0.y + d2.y), a6 = mk2(d0.x - d2.x, d0.y - d2.y);
      const float2 a5 = mk2(d1.x + d3.x, d1.y + d3.y), u7 = mk2(d1.x - d3.x, d1.y - d3.y);
      const float2 a7 = mk2(u7.y, -u7.x);
      *p0 = make_float4(a0.x + a1.x, a0.y + a1.y, a0.x - a1.x, a0.y - a1.y);
      *p1 = make_float4(a2.x + a3.x, a2.y + a3.y, a2.x - a3.x, a2.y - a3.y);
      *p2 = make_float4(a4.x + a5.x, a4.y + a5.y, a4.x - a5.x, a4.y - a5.y);
      *p3 = make_float4(a6.x + a7.x, a6.y + a7.y, a6.x - a7.x, a6.y - a7.y);
    } else {
      const float2 z0 = mk2(e0.x + e1.x, e0.y + e1.y), z1 = mk2(e0.x - e1.x, e0.y - e1.y);
      const float2 z2 = mk2(e2.x + e3.x, e2.y + e3.y), z3 = mk2(e2.x - e3.x, e2.y - e3.y);
      const float2 z4 = mk2(e4.x + e5.x, e4.y + e5.y), z5 = mk2(e4.x - e5.x, e4.y - e5.y);
      const float2 z6 = mk2(e6.x + e7.x, e6.y + e7.y), z7 = mk2(e6.x - e7.x, e6.y - e7.y);
      const float2 b3 = mk2(-z3.y, z3.x), b7 = mk2(-z7.y, z7.x);
      const float2 y0 = mk2(z0.x + z2.x, z0.y + z2.y), y2 = mk2(z0.x - z2.x, z0.y - z2.y);
      const float2 y1 = mk2(z1.x + b3.x, z1.y + b3.y), y3 = mk2(z1.x - b3.x, z1.y - b3.y);
      const float2 y4 = mk2(z4.x + z6.x, z4.y + z6.y), y6 = mk2(z4.x - z6.x, z4.y - z6.y);
      const float2 y5 = mk2(z5.x + b7.x, z5.y + b7.y), y7 = mk2(z5.x - b7.x, z5.y - b7.y);
      const float2 c4 = y4;
      const float2 c5 = mk2((y5.x - y5.y) * R, (y5.x + y5.y) * R);
      const float2 c6 = mk2(-y6.y, y6.x);
      const float2 c7 = mk2(-(y7.x + y7.y) * R, (y7.x - y7.y) * R);
      *p0 = make_float4(y0.x + c4.x, y0.y + c4.y, y1.x + c5.x, y1.y + c5.y);
      *p1 = make_float4(y2.x + c6.x, y2.y + c6.y, y3.x + c7.x, y3.y + c7.y);
      *p2 = make_float4(y0.x - c4.x, y0.y - c4.y, y1.x - c5.x, y1.y - c5.y);
      *p3 = make_float4(y2.x - c6.x, y2.y - c6.y, y3.x - c7.x, y3.y - c7.y);
    }
  }
}
template <bool DATA = false>
DI void fft_fwd(float2* x, int tid, const float2* __restrict__ tw) {
  r4_pass<8, false, false, false, DATA>(x, tid, 2048, tw + 4095, tw + 2047);
  r4_pass<2, false>(x, tid, 512, tw + 1023, tw + 511);
  r4_pass<1, false>(x, tid, 128, tw + 255, tw + 127);
  r4_pass<1, false, false, true>(x, tid, 32, tw + 63, tw + 31);
  r4_pass<1, false, true, true>(x, tid, 8, tw + 15, tw + 7);
  __syncthreads();
  r8_tail<false>(x, tid);
  __syncthreads();
}
template <bool DATA = false>
DI void fft_inv(float2* x, int tid, const float2* __restrict__ tw) {
  __syncthreads();
  r8_tail<true>(x, tid);
  r4_pass<1, true, true, true>(x, tid, 8, tw + 15, tw + 7);
  r4_pass<1, true, true, false>(x, tid, 32, tw + 63, tw + 31);
  r4_pass<1, true>(x, tid, 128, tw + 255, tw + 127);
  r4_pass<2, true>(x, tid, 512, tw + 1023, tw + 511);
  r4_pass<8, true, false, false, DATA>(x, tid, 2048, tw + 4095, tw + 2047);
  __syncthreads();
}

DI float hy_conv(const u16* __restrict__ pr, int t, float w0, float w1, float w2, float cb) {
  const float a = t > 0 ? bf2f(pr[t - 1]) : 0.f;
  const float b = bf2f(pr[t]);
  const float c = t < 4095 ? bf2f(pr[t + 1]) : 0.f;
  return w0 * a + w1 * b + w2 * c + cb;
}

DI void hy_conv4(const u16* __restrict__ pr, int t0, float w0, float w1, float w2, float cb, float (&o)[4]) {
  const ushort4 c = *(const ushort4*)(pr + t0);
  const float pm = t0 > 0 ? bf2f(pr[t0 - 1]) : 0.f;
  const float pn = t0 + 4 < 4096 ? bf2f(pr[t0 + 4]) : 0.f;
  const float x0 = bf2f(c.x), x1 = bf2f(c.y), x2 = bf2f(c.z), x3 = bf2f(c.w);
  o[0] = w0 * pm + w1 * x0 + w2 * x1 + cb;
  o[1] = w0 * x0 + w1 * x1 + w2 * x2 + cb;
  o[2] = w0 * x1 + w1 * x2 + w2 * x3 + cb;
  o[3] = w0 * x2 + w1 * x3 + w2 * pn + cb;
}

DI void hyena_unit(const Params& p, int ch, char* smem) {
  float2* buf = (float2*)smem;
  const int tid = opaque_tid();
  const u16* hyT = (const u16*)(p.ws + OFF_HYT);
  const float* filt = (const float*)(p.ws + OFF_FILT);
  u16* z2T = (u16*)(p.ws + OFF_Z2T);
  const float2* tw = (const float2*)(p.ws + OFF_TW);
  float2 Kr[32];
  float* k1buf_base = (float*)(p.ws + OFF_FILT);
  {
    const float* kf0 = filt + (size_t)(0 * 512 + ch) * 4096;
    const float* kf1 = filt + (size_t)(1 * 512 + ch) * 4096;
    const float* kb0 = filt + (size_t)(2 * 512 + ch) * 4096;
    const float* kb1 = filt + (size_t)(3 * 512 + ch) * 4096;
    const float fb0 = p.filt_bias[ch], fb1 = p.filt_bias[512 + ch];
    __syncthreads();
#pragma unroll
    for (int g = 0; g < 4; ++g) {
      const int n0 = g * 1024 + tid * 4;
      float4 v0 = *(const float4*)(kf0 + n0), v1 = *(const float4*)(kf1 + n0);
      if (n0 == 0) { v0.x += fb0; v1.x += fb1; }
      const float4 r0 = *(const float4*)(kb0 + 4092 - n0), r1 = *(const float4*)(kb1 + 4092 - n0);
      const float e00 = (n0 == 0) ? 0.f : kb0[4096 - n0], e01 = (n0 == 0) ? 0.f : kb1[4096 - n0];
      *(float4*)(buf + n0) = make_float4(v0.x, v1.x, v0.y, v1.y);
      *(float4*)(buf + n0 + 2) = make_float4(v0.z, v1.z, v0.w, v1.w);
      *(float4*)(buf + 4096 + n0) = make_float4(e00, e01, r0.w, r1.w);
      *(float4*)(buf + 4096 + n0 + 2) = make_float4(r0.z, r1.z, r0.y, r1.y);
    }
    fft_fwd(buf, tid, tw);
    const float sc = 0.5f / 8192.f;
#pragma unroll
    for (int j = 0; j < 32; ++j) {
      const int P = tid + 256 * j;
      const int f = (int)(__brev((unsigned)lx(P)) >> 19);
      const int Pq = lx((int)(__brev((unsigned)((8192 - f) & 8191)) >> 19));
      const float2 zp = buf[P], zq = buf[Pq];
      Kr[j] = make_float2(sc * (zp.x + zq.x), sc * (zp.y - zq.y));
      const float2 k1 = make_float2(sc * (zp.y + zq.y), sc * (zq.x - zp.x));
      *(float2*)(k1buf_base + ((size_t)((P >> 11) * 512 + ch)) * 4096 + (P & 2047) * 2) = k1;
    }
  }
#pragma unroll 1
  for (int ord = 0; ord < 2; ++ord) {
    if (ord == 1) {
#pragma unroll
      for (int j = 0; j < 32; ++j) {
        const int P = tid + 256 * j;
        Kr[j] = *(const float2*)(k1buf_base + ((size_t)((P >> 11) * 512 + ch)) * 4096 + (P & 2047) * 2);
      }
    }
    const int gcol = 1024 + (1 + ord) * 512 + ch;
    const float gw0 = p.conv_w[gcol], gw1 = p.conv_w[2560 + gcol], gw2 = p.conv_w[5120 + gcol], gcb = p.conv_b[gcol];
    const int vcol = 1024 + ch;
    const float vw0 = p.conv_w[vcol], vw1 = p.conv_w[2560 + vcol], vw2 = p.conv_w[5120 + vcol], vcb = p.conv_b[vcol];
#pragma unroll 1
    for (int pr = 0; pr < 2; ++pr) {
      const int b0 = 2 * pr, b1 = 2 * pr + 1;
      __syncthreads();
      if (ord == 0) {
        const u16* u0 = hyT + ((size_t)((0 * 4 + b0) * 512 + ch)) * 4096;
        const u16* u1 = hyT + ((size_t)((0 * 4 + b1) * 512 + ch)) * 4096;
#pragma unroll
        for (int g = 0; g < 4; ++g) {
          const int t0 = g * 1024 + tid * 4;
          float a[4], b[4];
          hy_conv4(u0, t0, vw0, vw1, vw2, vcb, a);
          hy_conv4(u1, t0, vw0, vw1, vw2, vcb, b);
          *(float4*)(buf + t0) = make_float4(a[0], b[0], a[1], b[1]);
          *(float4*)(buf + t0 + 2) = make_float4(a[2], b[2], a[3], b[3]);
        }
      } else {
        const u16* u0 = z2T + ((size_t)(b0 * 512 + ch)) * 4096;
        const u16* u1 = z2T + ((size_t)(b1 * 512 + ch)) * 4096;
#pragma unroll
        for (int g = 0; g < 4; ++g) {
          const int t0 = g * 1024 + tid * 4;
          const ushort4 a = *(const ushort4*)(u0 + t0);
          const ushort4 b = *(const ushort4*)(u1 + t0);
          *(float4*)(buf + t0) = make_float4(bf2f(a.x), bf2f(b.x), bf2f(a.y), bf2f(b.y));
          *(float4*)(buf + t0 + 2) = make_float4(bf2f(a.z), bf2f(b.z), bf2f(a.w), bf2f(b.w));
        }
      }
      fft_fwd<true>(buf, tid, tw);
#pragma unroll
      for (int j = 0; j < 32; ++j) {
        const float2 v = buf[tid + 256 * j];
        buf[tid + 256 * j] = make_float2(v.x * Kr[j].x - v.y * Kr[j].y, v.x * Kr[j].y + v.y * Kr[j].x);
      }
      fft_inv<true>(buf, tid, tw);
      const u16* g0 = hyT + ((size_t)(((1 + ord) * 4 + b0) * 512 + ch)) * 4096;
      const u16* g1 = hyT + ((size_t)(((1 + ord) * 4 + b1) * 512 + ch)) * 4096;
      u16* o0 = z2T + ((size_t)(b0 * 512 + ch)) * 4096;
      u16* o1 = z2T + ((size_t)(b1 * 512 + ch)) * 4096;
#pragma unroll
      for (int g = 0; g < 4; ++g) {
        const int t0 = g * 1024 + tid * 4;
        const float4 y01 = *(const float4*)(buf + t0);
        const float4 y23 = *(const float4*)(buf + t0 + 2);
        float ga[4], gb[4];
        hy_conv4(g0, t0, gw0, gw1, gw2, gcb, ga);
        hy_conv4(g1, t0, gw0, gw1, gw2, gcb, gb);
        { ushort4 o; o.x = f2bf(ga[0] * y01.x); o.y = f2bf(ga[1] * y01.z); o.z = f2bf(ga[2] * y23.x); o.w = f2bf(ga[3] * y23.z); *(ushort4*)(o0 + t0) = o; }
        { ushort4 o; o.x = f2bf(gb[0] * y01.y); o.y = f2bf(gb[1] * y01.w); o.z = f2bf(gb[2] * y23.y); o.w = f2bf(gb[3] * y23.w); *(ushort4*)(o1 + t0) = o; }
      }
    }
  }
  __syncthreads();
}

DI void mlstm_local_unit(const Params& p, int u, char* smem) {
  float* s_gi = (float*)smem;
  float* s_lf = s_gi + 128;
  float* s_a = s_lf + 128;
  float* s_w = s_a + 128;
  const int tid = opaque_tid(), lane = tid & 63, wave = tid >> 6, lr = lane & 31, hh = lane >> 5;
  const int j = u & 31, dir = (u >> 5) & 1, bh = u >> 6, h = bh & 3, b = bh >> 2;
  const int T0 = b * 4096 + j * 128;
  const float* gates = (const float*)(p.ws + OFF_GATES);
  const u16* vT = (const u16*)(p.ws + OFF_VT);
  const u16* kaT = (const u16*)(p.ws + OFF_KAT);
  float* CL = p.out;
  float* nl = (float*)(p.ws + OFF_NL);
  float* mloc = (float*)(p.ws + OFF_MLOC);
  float* gsum = (float*)(p.ws + OFF_GSUM);
  __syncthreads();
  if (tid < 128) {
    const int T = T0 + tid;
    s_gi[tid] = gates[(size_t)T * 16 + dir * 8 + h] + p.b_gates[dir * 8 + h];
    s_lf[tid] = log_sigmoid(gates[(size_t)T * 16 + dir * 8 + 4 + h] + p.b_gates[dir * 8 + 4 + h]);
  }
  __syncthreads();
  float gtot = 0.f;
  if (tid < 128) {
    float pre = 0.f;
#pragma unroll 4
    for (int m = 0; m < 128; ++m) {
      const float v = s_lf[m];
      if (m < tid) pre += v;
      gtot += v;
    }
    s_a[tid] = (dir == 0) ? (gtot - pre - s_lf[tid] + s_gi[tid]) : (pre + s_gi[tid]);
  }
  __syncthreads();
  if (tid < 128) {
    float mx = -3.0e38f;
#pragma unroll 4
    for (int m = 0; m < 128; ++m) mx = fmaxf(mx, s_a[m]);
    s_w[tid] = expf(s_a[tid] - mx);
    if (tid == 0) { mloc[u] = mx; gsum[u] = gtot; }
  }
  __syncthreads();
  f32x16 acc[4];
#pragma unroll
  for (int d = 0; d < 4; ++d)
#pragma unroll
    for (int r = 0; r < 16; ++r) acc[d][r] = 0.f;
  const u16* vrow = vT + ((size_t)(bh * 128 + wave * 32 + lr)) * 4096 + j * 128 + hh * 8;
  const u16* kbase = kaT + ((size_t)(bh * 128 + lr)) * 4096 + j * 128 + hh * 8;
#pragma unroll 4
  for (int ks = 0; ks < 8; ++ks) {
    const bf16x8 av = *(const bf16x8*)(vrow + ks * 16);
    bf16x8 a;
#pragma unroll
    for (int i = 0; i < 8; ++i) a[i] = (short)f2bf(bf2f((u16)av[i]) * s_w[ks * 16 + hh * 8 + i]);
#pragma unroll
    for (int dt = 0; dt < 4; ++dt) {
      const bf16x8 bk = *(const bf16x8*)(kbase + (size_t)(dt * 32) * 4096 + ks * 16);
      acc[dt] = MFMA(a, bk, acc[dt]);
    }
  }
  {
    char* wl = smem + 4096 + wave * 8192;
#pragma unroll
    for (int dt = 0; dt < 4; ++dt)
#pragma unroll
      for (int r = 0; r < 16; ++r) *(u16*)(wl + crow(r, hh) * 256 + (dt * 32 + lr) * 2) = f2bf(acc[dt][r]);
    wave_lds_sync();
    u16* dst = (u16*)CL + (size_t)u * 16384 + (size_t)(wave * 32) * 128;
#pragma unroll
    for (int i = 0; i < 8; ++i) {
      const int q = lane + 64 * i, row = q >> 4, ch = q & 15;
      *(uint4*)(dst + row * 128 + ch * 8) = *(const uint4*)(wl + row * 256 + ch * 16);
    }
  }
  if (tid < 128) {
    const u16* kr = kaT + ((size_t)(bh * 128 + tid)) * 4096 + j * 128;
    float s = 0.f;
#pragma unroll 2
    for (int l = 0; l < 128; l += 8) {
      const bf16x8 kv = *(const bf16x8*)(kr + l);
#pragma unroll
      for (int i = 0; i < 8; ++i) s += s_w[l + i] * bf2f((u16)kv[i]);
    }
    nl[(size_t)u * 128 + tid] = s;
  }
}

DI void scan_unit(const Params& p, int unit) {
  const int tid = opaque_tid();
  const int sc = unit >> 4, part = unit & 15, dir = sc & 1;
  u16* CL = (u16*)p.out;
  float* nl = (float*)(p.ws + OFF_NL);
  const float* mloc = (const float*)(p.ws + OFF_MLOC);
  const float* gsum = (const float*)(p.ws + OFF_GSUM);
  float* ms = (float*)(p.ws + OFF_MS);
  const int idx = part * 1024 + tid * 4;
  float4 C = make_float4(0.f, 0.f, 0.f, 0.f);
  float nst = 0.f, m = 0.f;
  const bool do_n = (part == 0) && (tid < 128);
  ushort4 pf[4];
#pragma unroll
  for (int q = 0; q < 4; ++q) {
    const int jj = dir ? 31 - q : q;
    pf[q] = *(const ushort4*)(CL + (size_t)(sc * 32 + jj) * 16384 + idx);
  }
#pragma unroll 1
  for (int c0 = 0; c0 < 32; c0 += 4) {
#pragma unroll
    for (int q = 0; q < 4; ++q) {
      const int c = c0 + q;
      const int jj = dir ? 31 - c : c;
      const int u = sc * 32 + jj;
      const float4 cl = make_float4(bf2f(pf[q].x), bf2f(pf[q].y), bf2f(pf[q].z), bf2f(pf[q].w));
      { ushort4 cs; cs.x = f2bf(C.x); cs.y = f2bf(C.y); cs.z = f2bf(C.z); cs.w = f2bf(C.w); *(ushort4*)(CL + (size_t)u * 16384 + idx) = cs; }
      if (c + 4 < 32) {
        const int j2 = dir ? 31 - (c + 4) : (c + 4);
        pf[q] = *(const ushort4*)(CL + (size_t)(sc * 32 + j2) * 16384 + idx);
      }
      const float g = gsum[u], ml = mloc[u];
      const float mn = fmaxf(g + m, ml);
      const float dec = expf(g + m - mn), scl = expf(ml - mn);
      C.x = dec * C.x + scl * cl.x; C.y = dec * C.y + scl * cl.y; C.z = dec * C.z + scl * cl.z; C.w = dec * C.w + scl * cl.w;
      if (do_n) {
        const float nv = nl[(size_t)u * 128 + tid];
        nl[(size_t)u * 128 + tid] = nst;
        nst = dec * nst + scl * nv;
      }
      if (part == 0 && tid == 0) ms[u] = m;
      m = mn;
    }
  }
}

template <int DIR>
DI void mlstm_dir(const Params& p, int bh, int j, char* smem, f32x16 (&hs)[4]) {
  float* s_gi = (float*)smem;
  float* s_lf = s_gi + 128;
  float* s_bc = s_lf + 128;
  float* s_r = s_bc + 128;
  float* s_al = s_r + 128;
  float* s_fl = s_al + 128;
  float* s_is = s_fl + 128;
  const int tid = opaque_tid(), lane = tid & 63, wave = tid >> 6, lr = lane & 31, hh = lane >> 5;
  u16* Pl = (u16*)(smem + 4096) + wave * (32 * 136);
  const int h = bh & 3, b = bh >> 2;
  const int T0 = b * 4096 + j * 128;
  const float* gates = (const float*)(p.ws + OFF_GATES);
  const u16* qa = (const u16*)(p.ws + OFF_QA);
  const u16* ka = (const u16*)(p.ws + OFF_KA);
  const u16* vT = (const u16*)(p.ws + OFF_VT);
  const float* CS = p.out;
  const float* ns = (const float*)(p.ws + OFF_NL);
  const float* ms = (const float*)(p.ws + OFF_MS);
  u16* A2 = (u16*)(p.ws + OFF_A2);
  bf16x8 ones;
#pragma unroll
  for (int i = 0; i < 8; ++i) ones[i] = (short)0x3F80;
  const u16* qrow = qa + (size_t)(T0 + wave * 32 + lr) * 512 + h * 128 + hh * 8;
  const int u = (bh * 2 + DIR) * 32 + j;
  const float msu = ms[u];
  __syncthreads();
  if (tid < 128) {
    const int T = T0 + tid;
    s_gi[tid] = gates[(size_t)T * 16 + DIR * 8 + h] + p.b_gates[DIR * 8 + h];
    s_lf[tid] = log_sigmoid(gates[(size_t)T * 16 + DIR * 8 + 4 + h] + p.b_gates[DIR * 8 + 4 + h]);
  }
  __syncthreads();
  if (tid < 128) {
    float a = 0.f;
#pragma unroll 4
    for (int m = 0; m < 128; ++m) {
      const bool in = (DIR == 0) ? (m <= tid) : (m >= tid);
      a += in ? s_lf[m] : 0.f;
    }
    s_bc[tid] = a;
    s_r[tid] = s_gi[tid] - a;
  }
  __syncthreads();
  if (tid < 128) {
    float cm = -3.0e38f;
#pragma unroll 4
    for (int m = 0; m < 128; ++m) {
      const bool in = (DIR == 0) ? (m <= tid) : (m >= tid);
      cm = in ? fmaxf(cm, s_r[m]) : cm;
    }
    const float bc = s_bc[tid];
    const float mt = bc + fmaxf(msu, cm);
    s_al[tid] = bc - mt;
    s_fl[tid] = expf(-mt);
    s_is[tid] = expf(bc + msu - mt);
  }
  __syncthreads();
  char* Kt = smem + 4096;
  char* R2 = smem + 40960;
  {
#pragma unroll
    for (int bt = 0; bt < 2; ++bt) {
      uint4 kq[4];
#pragma unroll
      for (int i = 0; i < 4; ++i) {
        const int q = tid + 256 * (bt * 4 + i), row = q >> 4, ch = q & 15;
        kq[i] = *(const uint4*)(ka + (size_t)(T0 + row) * 512 + h * 128 + ch * 8);
      }
#pragma unroll
      for (int i = 0; i < 4; ++i) {
        const int q = tid + 256 * (bt * 4 + i), row = q >> 4, ch = q & 15;
        *(uint4*)(Kt + row * 256 + ((ch ^ (row & 15)) << 4)) = kq[i];
      }
    }
  }
  __syncthreads();
  {
    f32x16 S[4];
#pragma unroll
    for (int st = 0; st < 4; ++st)
#pragma unroll
      for (int r = 0; r < 16; ++r) S[st][r] = 0.f;
#pragma unroll 4
    for (int ks = 0; ks < 8; ++ks) {
      const bf16x8 a = *(const bf16x8*)(qrow + ks * 16);
#pragma unroll
      for (int st = 0; st < 4; ++st) {
        if ((DIR == 0) ? (st <= wave) : (st >= wave)) {
          const int krow = st * 32 + lr;
          const bf16x8 bk = *(const bf16x8*)(Kt + krow * 256 + (((ks * 2 + hh) ^ (krow & 15)) << 4));
          S[st] = MFMA(a, bk, S[st]);
        }
      }
    }
    __syncthreads();
#pragma unroll
    for (int st = 0; st < 4; ++st) {
      const int sl = st * 32 + lr;
      const float rs = s_r[sl];
#pragma unroll
      for (int r = 0; r < 16; ++r) {
        const int tl = wave * 32 + crow(r, hh);
        const bool valid = (DIR == 0) ? (sl <= tl) : (sl >= tl);
        const float pv = valid ? S[st][r] * __expf(s_al[tl] + rs) : 0.f;
        Pl[crow(r, hh) * 136 + sl] = f2bf(pv);
      }
    }
  }
#pragma unroll
  for (int eh = 0; eh < 2; ++eh) {
    f32x16 N[3];
#pragma unroll
    for (int e = 0; e < 3; ++e)
#pragma unroll
      for (int r = 0; r < 16; ++r) N[e][r] = 0.f;
    {
      uint4 vq[4];
#pragma unroll
      for (int i = 0; i < 4; ++i) {
        const int q = tid + 256 * i, row = q >> 4, ch = q & 15;
        vq[i] = *(const uint4*)(vT + ((size_t)(bh * 128 + eh * 64 + row)) * 4096 + j * 128 + ch * 8);
      }
#pragma unroll
      for (int i = 0; i < 4; ++i) {
        const int q = tid + 256 * i, row = q >> 4, ch = q & 15;
        *(uint4*)(R2 + row * 256 + ((ch ^ (row & 15)) << 4)) = vq[i];
      }
    }
    __syncthreads();
    {
      const int ks_lo = (DIR == 0) ? 0 : 2 * wave, ks_hi = (DIR == 0) ? 2 * wave + 2 : 8;
#pragma unroll 2
      for (int ks = ks_lo; ks < ks_hi; ++ks) {
        const bf16x8 a = *(const bf16x8*)(Pl + lr * 136 + ks * 16 + hh * 8);
#pragma unroll
        for (int e2 = 0; e2 < 2; ++e2) {
          const int vrow = e2 * 32 + lr;
          const bf16x8 bv = *(const bf16x8*)(R2 + vrow * 256 + (((ks * 2 + hh) ^ (vrow & 15)) << 4));
          N[e2] = MFMA(a, bv, N[e2]);
        }
        N[2] = MFMA(a, ones, N[2]);
      }
    }
    {
      bf16x8 cq[4];
#pragma unroll
      for (int i = 0; i < 4; ++i) {
        const int q = tid + 256 * i, row = q >> 4, ch = q & 15;
        cq[i] = *(const bf16x8*)((const u16*)CS + (size_t)u * 16384 + (size_t)(eh * 64 + row) * 128 + ch * 8);
      }
      __syncthreads();
#pragma unroll
      for (int i = 0; i < 4; ++i) {
        const int q = tid + 256 * i, row = q >> 4, ch = q & 15;
        *(bf16x8*)(R2 + row * 256 + ((ch ^ (row & 15)) << 4)) = cq[i];
      }
    }
    __syncthreads();
    {
      const float isc = s_is[wave * 32 + lr];
      const float* nbase = ns + (size_t)u * 128 + hh * 8;
#pragma unroll 4
      for (int ks = 0; ks < 8; ++ks) {
        const bf16x8 aq = *(const bf16x8*)(qrow + ks * 16);
        const bf16x8 a = scale8(aq, isc);
#pragma unroll
        for (int e2 = 0; e2 < 2; ++e2) {
          const int crw = e2 * 32 + lr;
          const bf16x8 bc = *(const bf16x8*)(R2 + crw * 256 + (((ks * 2 + hh) ^ (crw & 15)) << 4));
          N[e2] = MFMA(a, bc, N[e2]);
        }
        const float4 n0 = *(const float4*)(nbase + ks * 16);
        const float4 n1 = *(const float4*)(nbase + ks * 16 + 4);
        const float nv[8] = {n0.x, n0.y, n0.z, n0.w, n1.x, n1.y, n1.z, n1.w};
        N[2] = MFMA(a, pack8(nv), N[2]);
      }
    }
    __syncthreads();
    u16* park = (u16*)(p.ws + OFF_HYT) + ((size_t)(bh * 32 + j) * 256 + tid) * 64 + eh * 32;
    bf16x8 pk[4];
    if (DIR == 1) {
#pragma unroll
      for (int q = 0; q < 4; ++q) pk[q] = *(const bf16x8*)(park + q * 8);
    }
#pragma unroll
    for (int r = 0; r < 16; ++r) {
      const int tl = wave * 32 + crow(r, hh);
      const float den = fmaxf(fabsf(N[2][r]), s_fl[tl]);
      const float inv = 1.f / den;
#pragma unroll
      for (int e2 = 0; e2 < 2; ++e2) {
        const float hv = N[e2][r] * inv;
        const int v = e2 * 16 + r;
        if (DIR == 0) pk[v >> 3][v & 7] = (short)f2bf(hv);
        else hs[eh * 2 + e2][r] = hv + bf2f((u16)pk[v >> 3][v & 7]);
      }
    }
    if (DIR == 0) {
#pragma unroll
      for (int q = 0; q < 4; ++q) *(bf16x8*)(park + q * 8) = pk[q];
    }
  }
}

DI void mlstm_out_unit(const Params& p, int unit, char* smem) {
  const int tid = opaque_tid(), lane = tid & 63, wave = tid >> 6, lr = lane & 31, hh = lane >> 5;
  const int j = unit & 31, bh = unit >> 5, h = bh & 3, b = bh >> 2;
  const int T0 = b * 4096 + j * 128;
  const u16* og = (const u16*)(p.ws + OFF_OG);
  u16* A2 = (u16*)(p.ws + OFF_A2);
  f32x16 hs[4];
  mlstm_dir<0>(p, bh, j, smem, hs);
  mlstm_dir<1>(p, bh, j, smem, hs);
  __syncthreads();
  float* wl = (float*)(smem + wave * 16384);
#pragma unroll
  for (int et = 0; et < 4; ++et)
#pragma unroll
    for (int r = 0; r < 16; ++r) wl[crow(r, hh) * 128 + et * 32 + lr] = hs[et][r];
  wave_lds_sync();
  {
    const int row = lane >> 1, half = lane & 1;
    const size_t T = (size_t)(T0 + wave * 32 + row);
    const u16* ogp = og + T * 512 + h * 128 + half * 64;
    const float* src = wl + row * 128 + half * 64;
    float g[64];
    float ss = 0.f;
#pragma unroll
    for (int q = 0; q < 8; ++q) {
      const bf16x8 o8 = *(const bf16x8*)(ogp + q * 8);
      const float4 h0 = *(const float4*)(src + q * 8), h1 = *(const float4*)(src + q * 8 + 4);
      g[q * 8 + 0] = h0.x * bf2f((u16)o8[0]); g[q * 8 + 1] = h0.y * bf2f((u16)o8[1]); g[q * 8 + 2] = h0.z * bf2f((u16)o8[2]); g[q * 8 + 3] = h0.w * bf2f((u16)o8[3]);
      g[q * 8 + 4] = h1.x * bf2f((u16)o8[4]); g[q * 8 + 5] = h1.y * bf2f((u16)o8[5]); g[q * 8 + 6] = h1.z * bf2f((u16)o8[6]); g[q * 8 + 7] = h1.w * bf2f((u16)o8[7]);
#pragma unroll
      for (int i = 0; i < 8; ++i) ss += g[q * 8 + i] * g[q * 8 + i];
    }
    ss += __shfl_xor(ss, 1, 64);
    const float rs = rsqrtf(ss * (1.f / 128.f) + EPS);
    const float* mw = p.mlstm_norm_w + h * 128 + half * 64;
    u16* dst = A2 + T * 1024 + h * 128 + half * 64;
#pragma unroll
    for (int q = 0; q < 8; ++q) {
      const float4 w0 = *(const float4*)(mw + q * 8), w1 = *(const float4*)(mw + q * 8 + 4);
      float o[8];
      o[0] = g[q * 8 + 0] * rs * w0.x; o[1] = g[q * 8 + 1] * rs * w0.y; o[2] = g[q * 8 + 2] * rs * w0.z; o[3] = g[q * 8 + 3] * rs * w0.w;
      o[4] = g[q * 8 + 4] * rs * w1.x; o[5] = g[q * 8 + 5] * rs * w1.y; o[6] = g[q * 8 + 6] * rs * w1.z; o[7] = g[q * 8 + 7] * rs * w1.w;
      *(bf16x8*)(dst + q * 8) = pack8(o);
    }
  }
}

DI void hyena_norm_unit(const Params& p, int unit, char* smem) {
  float* tile = (float*)smem;
  const int tid = opaque_tid();
  const int tt = unit & 63, g = (unit >> 6) & 7, b = unit >> 9;
  const u16* z2T = (const u16*)(p.ws + OFF_Z2T);
  u16* A2 = (u16*)(p.ws + OFF_A2);
  __syncthreads();
#pragma unroll
  for (int i = 0; i < 4; ++i) {
    const int q = tid + 256 * i, cl = q >> 4, t4 = q & 15;
    const ushort4 v4 = *(const ushort4*)(z2T + ((size_t)(b * 512 + g * 64 + cl)) * 4096 + tt * 64 + t4 * 4);
    float* d = tile + cl * 65 + t4 * 4;
    d[0] = bf2f(v4.x); d[1] = bf2f(v4.y); d[2] = bf2f(v4.z); d[3] = bf2f(v4.w);
  }
  __syncthreads();
  const int tl = tid >> 2, qd = tid & 3;
  float v[16];
  float ss = 0.f;
#pragma unroll
  for (int i = 0; i < 16; ++i) {
    v[i] = tile[(qd * 16 + i) * 65 + tl];
    ss += v[i] * v[i];
  }
  ss += __shfl_xor(ss, 1, 64);
  ss += __shfl_xor(ss, 2, 64);
  const float rs = rsqrtf(ss * (1.f / 64.f) + EPS);
  const size_t T = (size_t)b * 4096 + tt * 64 + tl;
  u16* dst = A2 + T * 1024 + 512 + g * 64 + qd * 16;
  const float* w = p.hyena_norm_w + g * 64 + qd * 16;
  float o[16];
#pragma unroll
  for (int i = 0; i < 16; ++i) o[i] = v[i] * rs * w[i];
  *(bf16x8*)(dst) = pack8(o);
  *(bf16x8*)(dst + 8) = pack8(o + 8);
}

template <int EPI>
DI void gemm_phase(const u16* A, const u16* Bt, int K, int ntn, void* outp, char* smem) {
  const int tid = threadIdx.x, lane = tid & 63, wave = tid >> 6, wr = wave >> 1, wc = wave & 1, lr = lane & 31, hh = lane >> 5;
  const int ntiles = tile_count(ntn);
  for (int id = blockIdx.x; id < ntiles; id += gridDim.x) {
    int mt, nt;
    tile_map(id, ntn, mt, nt);
    if (nt >= ntn) continue;
    const int m0 = mt * 256, n0 = nt * 128;
    f32x16 acc[4][2];
    gemm_core<false>(A, Bt, K, m0, n0, smem, acc);
    if (EPI == 0) {
#pragma unroll
      for (int i = 0; i < 4; ++i)
#pragma unroll
        for (int j = 0; j < 2; ++j)
#pragma unroll
          for (int r = 0; r < 16; ++r) {
            const int row = m0 + wr * 128 + i * 32 + crow(r, hh);
            const int col = n0 + wc * 64 + j * 32 + lr;
            ((float*)outp)[(size_t)row * 1024 + col] = acc[i][j][r];
          }
    } else {
      char* wl = smem + wave * 16384;
      stage_tile_ns<2>(acc, wl, lr, hh);
      wave_lds_sync();
      flush_tile_ns(wl, (u16*)outp + (size_t)(m0 + wr * 128) * 4096 + n0 + wc * 64, 4096, lane);
    }
  }
}

DI void phase_post_mix(const Params& p) {
  const int tid = threadIdx.x, lane = tid & 63, wave = tid >> 6;
  const float* mix = p.out;
  float* x1 = (float*)(p.ws + OFF_X1);
  u16* hm = (u16*)(p.ws + OFF_HM);
  for (int u = blockIdx.x; u < 1024; u += gridDim.x) {
#pragma unroll 2
    for (int rr = 0; rr < 4; ++rr) {
      const size_t row = (size_t)u * 16 + wave * 4 + rr;
      float4 mv[4], xv[4];
      float ss = 0.f;
#pragma unroll
      for (int i = 0; i < 4; ++i) {
        mv[i] = ((const float4*)(mix + row * DM))[lane + 64 * i];
        xv[i] = ((const float4*)(p.x + row * DM))[lane + 64 * i];
        ss += mv[i].x * mv[i].x + mv[i].y * mv[i].y + mv[i].z * mv[i].z + mv[i].w * mv[i].w;
      }
      ss = wave_sum(ss);
      const float rs = rsqrtf(ss * (1.f / DM) + EPS);
      float s2 = 0.f;
#pragma unroll
      for (int i = 0; i < 4; ++i) {
        const float4 w = ((const float4*)p.norm_mix_post)[lane + 64 * i];
        xv[i].x += mv[i].x * rs * w.x; xv[i].y += mv[i].y * rs * w.y; xv[i].z += mv[i].z * rs * w.z; xv[i].w += mv[i].w * rs * w.w;
        s2 += xv[i].x * xv[i].x + xv[i].y * xv[i].y + xv[i].z * xv[i].z + xv[i].w * xv[i].w;
        ((float4*)(x1 + row * DM))[lane + 64 * i] = xv[i];
      }
      s2 = wave_sum(s2);
      const float r2 = rsqrtf(s2 * (1.f / DM) + EPS);
#pragma unroll
      for (int i = 0; i < 4; ++i) {
        const float4 w = ((const float4*)p.norm_mlp_pre)[lane + 64 * i];
        ushort4 o;
        o.x = f2bf(xv[i].x * r2 * w.x); o.y = f2bf(xv[i].y * r2 * w.y); o.z = f2bf(xv[i].z * r2 * w.z); o.w = f2bf(xv[i].w * r2 * w.w);
        *(ushort4*)(hm + row * DM + (lane + 64 * i) * 4) = o;
      }
    }
  }
}

DI void phase_final(const Params& p) {
  const int tid = threadIdx.x, lane = tid & 63, wave = tid >> 6;
  const float* x1 = (const float*)(p.ws + OFF_X1);
  for (int u = blockIdx.x; u < 1024; u += gridDim.x) {
#pragma unroll 2
    for (int rr = 0; rr < 4; ++rr) {
      const size_t row = (size_t)u * 16 + wave * 4 + rr;
      float4 fv[4];
      float ss = 0.f;
#pragma unroll
      for (int i = 0; i < 4; ++i) {
        fv[i] = ((const float4*)(p.out + row * DM))[lane + 64 * i];
        ss += fv[i].x * fv[i].x + fv[i].y * fv[i].y + fv[i].z * fv[i].z + fv[i].w * fv[i].w;
      }
      ss = wave_sum(ss);
      const float rs = rsqrtf(ss * (1.f / DM) + EPS);
#pragma unroll
      for (int i = 0; i < 4; ++i) {
        const float4 w = ((const float4*)p.norm_mlp_post)[lane + 64 * i];
        const float4 xv = ((const float4*)(x1 + row * DM))[lane + 64 * i];
        float4 o;
        o.x = xv.x + fv[i].x * rs * w.x; o.y = xv.y + fv[i].y * rs * w.y; o.z = xv.z + fv[i].z * rs * w.z; o.w = xv.w + fv[i].w * rs * w.w;
        ((float4*)(p.out + row * DM))[lane + 64 * i] = o;
      }
    }
  }
}

DI void run_phase(const Params& p, int ph, char* smem) {
  switch (ph) {
    case 0: phase0(p, smem); break;
    case 1: phase1(p, smem); break;
    case 2: phase_qk(p, smem); break;
    case 3:
#ifdef DBL_HYONLY
      for (int u = blockIdx.x; u < 512; u += gridDim.x) hyena_unit(p, u, smem);
#endif
#ifdef DBL_MLONLY
      for (int u = blockIdx.x; u < 1024; u += gridDim.x) mlstm_local_unit(p, u, smem);
#endif
      for (int u = blockIdx.x; u < 512 + 1024; u += gridDim.x) {
        if (u < 512) hyena_unit(p, u, smem);
        else mlstm_local_unit(p, u - 512, smem);
      }
      break;
    case 4:
      for (int u = blockIdx.x; u < 512; u += gridDim.x) scan_unit(p, u);
      break;
    case 5:
      for (int u = blockIdx.x; u < 512 + 2048; u += gridDim.x) {
#ifndef DBG_SKIP_MLSTM
        if (u < 512) mlstm_out_unit(p, u, smem);
#else
        if (u < 512) { u16* A2 = (u16*)(p.ws + OFF_A2); const int T0 = (u >> 5 >> 2) * 4096 + (u & 31) * 128, hq = (u >> 5) & 3;
          for (int i = threadIdx.x; i < 128 * 128; i += 256) A2[(size_t)(T0 + (i >> 7)) * 1024 + hq * 128 + (i & 127)] = 0; }
#endif
#ifndef DBG_SKIP_HYENA
        else hyena_norm_unit(p, u - 512, smem);
#else
        else { const int un = u - 512; const int tt = un & 63, g = (un >> 6) & 7, b = un >> 9; u16* A2 = (u16*)(p.ws + OFF_A2);
          for (int i = threadIdx.x; i < 64 * 64; i += 256) A2[((size_t)b * 4096 + tt * 64 + (i >> 6)) * 1024 + 512 + g * 64 + (i & 63)] = 0x3F80; }
#endif
      }
      break;
    case 6: gemm_phase<0>((const u16*)(p.ws + OFF_A2), (const u16*)(p.ws + OFF_WOUTT), 1024, 8, p.out, smem); break;
    case 7: phase_post_mix(p); break;
    case 8: gemm_phase<1>((const u16*)(p.ws + OFF_HM), (const u16*)(p.ws + OFF_W1T), 1024, 32, p.ws + OFF_H, smem); break;
    case 9: gemm_phase<0>((const u16*)(p.ws + OFF_H), (const u16*)(p.ws + OFF_W2T), 4096, 8, p.out, smem); break;
    case 10: phase_final(p); break;
  }
}
constexpr int NPHASE = 11;

#define XB_XCNT(j)  (256  + 64 * (j))
#define XB_XSUB(j)  (1280 + 64 * (j))
#define XB_XGEN(j)  (2304 + 64 * (j))
#define XB_TOP      3328
#define XB_TOPGEN   3392
#define XCD_BAR_WORDS 3456
DI unsigned xb_ld(unsigned* p) { return __hip_atomic_load(p, __ATOMIC_RELAXED, __HIP_MEMORY_SCOPE_AGENT); }
DI unsigned xb_add(unsigned* p, unsigned v) { return __hip_atomic_fetch_add(p, v, __ATOMIC_RELAXED, __HIP_MEMORY_SCOPE_AGENT); }
DI unsigned xb_xcc_id() { return (unsigned)__builtin_amdgcn_s_getreg((3 << 11) | 20) & 0xFu; }
struct XcdBar { unsigned* bar; unsigned x, nloc, nx; };
DI void xcd_barrier(XcdBar& b) {
  asm volatile("s_waitcnt vmcnt(0)" ::: "memory");
  __syncthreads();
  if (threadIdx.x == 0) {
    unsigned* bar = b.bar;
    __builtin_amdgcn_s_waitcnt(0);
    if (b.nloc == 0u) {
      const unsigned G = gridDim.x;
      unsigned sum, cnt, mine;
      for (;;) {
        sum = 0u; cnt = 0u; mine = 0u;
#pragma unroll
        for (unsigned j = 0; j < 16; ++j) { const unsigned c = xb_ld(&bar[XB_XCNT(j)]); sum += c; cnt += (c > 0u) ? 1u : 0u; mine = (j == b.x) ? c : mine; }
        if (sum == G) break;
        __builtin_amdgcn_s_sleep(1);
      }
      b.nloc = mine > 0u ? mine : 1u; b.nx = cnt > 0u ? cnt : 1u;
    }
    const unsigned nloc = b.nloc, nx = b.nx;
    const unsigned old = xb_add(&bar[XB_XSUB(b.x)], 1u);
    const unsigned gen = old / nloc;
    if (old + 1u == (gen + 1u) * nloc) {
      __builtin_amdgcn_fence(__ATOMIC_RELEASE, "agent");
      asm volatile("s_waitcnt vmcnt(0)" ::: "memory");
      const unsigned og = xb_add(&bar[XB_TOP], 1u);
      const unsigned tg = og / nx;
      if (og + 1u == (tg + 1u) * nx) xb_add(&bar[XB_TOPGEN], 1u);
      else while (xb_ld(&bar[XB_TOPGEN]) == tg) __builtin_amdgcn_s_sleep(1);
      __builtin_amdgcn_fence(__ATOMIC_ACQUIRE, "agent");
      xb_add(&bar[XB_XGEN(b.x)], 1u);
      asm volatile("s_waitcnt vmcnt(0)" ::: "memory");
    } else {
      while (xb_ld(&bar[XB_XGEN(b.x)]) == gen) __builtin_amdgcn_s_sleep(1);
      __builtin_amdgcn_fence(__ATOMIC_ACQUIRE, "agent");
      asm volatile("s_waitcnt vmcnt(0)" ::: "memory");
    }
  }
  __syncthreads();
}

#if MULTI_LAUNCH
template <int PH>
__global__ void __launch_bounds__(256, 2) phase_kernel(Params p) {
  __shared__ __attribute__((aligned(16))) char smem[65536];
  run_phase(p, PH, smem);
}
template <int PH>
static void launch_phase(const Params& p, hipStream_t stream) {
  hipLaunchKernelGGL(phase_kernel<PH>, dim3(512), dim3(256), 0, stream, p);
}
#else
__global__ void __launch_bounds__(256, 2) mega_kernel(Params p) {
  __shared__ __attribute__((aligned(16))) char smem[65536];
  cg::grid_group grid = cg::this_grid();
  XcdBar xb;
  xb.bar = (unsigned*)(p.ws + OFF_BAR); xb.x = xb_xcc_id(); xb.nloc = 0u; xb.nx = 0u;
  if (p.ws == nullptr) grid.sync();
  if (threadIdx.x == 0) (void)xb_add(&xb.bar[XB_XCNT(xb.x)], 1u);
#define GSYNC xcd_barrier(xb)
#ifdef DBL_P0
  run_phase(p, 0, smem);
#endif
  run_phase(p, 0, smem); GSYNC;
  run_phase(p, 1, smem); GSYNC;
#ifdef DBL_GEMM
  run_phase(p, 1, smem); grid.sync();
#endif
  run_phase(p, 2, smem); GSYNC;
#ifdef DBL_P2
  run_phase(p, 2, smem); GSYNC;
#endif
  run_phase(p, 3, smem); GSYNC;
#ifdef DBL_HY
  run_phase(p, 3, smem); GSYNC;
#endif
  run_phase(p, 4, smem); GSYNC;
  run_phase(p, 5, smem); GSYNC;
#ifdef DBL_P5
  run_phase(p, 5, smem); GSYNC;
#endif
  run_phase(p, 6, smem); GSYNC;
#ifdef DBL_GEMM
  run_phase(p, 6, smem); GSYNC;
#endif
  run_phase(p, 7, smem); GSYNC;
#ifdef DBL_P7
  run_phase(p, 7, smem); GSYNC;
#endif
  run_phase(p, 8, smem); GSYNC;
#ifdef DBL_GEMM
  run_phase(p, 8, smem); GSYNC;
#endif
  run_phase(p, 9, smem); GSYNC;
#ifdef DBL_GEMM
  run_phase(p, 9, smem); GSYNC;
#endif
#ifdef XSYNC
  for (int q = 0; q < 10; ++q) GSYNC;
#endif
  run_phase(p, 10, smem);
}
#endif

extern "C" void kernel_launch(void* const* d_in, const int* in_sizes, int n_in, void* d_out, int out_size, void* d_ws,
                              size_t ws_size, hipStream_t stream) {
  Params p{};
  const float** pp = (const float**)&p;
  for (int i = 0; i < 23; ++i) pp[i] = (const float*)d_in[i];
  p.out = (float*)d_out;
  p.ws = (char*)d_ws;
#if MULTI_LAUNCH
  launch_phase<0>(p, stream);
#ifdef DBL_P0
  launch_phase<0>(p, stream);
#endif
 launch_phase<1>(p, stream); launch_phase<2>(p, stream); launch_phase<3>(p, stream);
#ifdef DBL_HY
  launch_phase<3>(p, stream);
#endif

  launch_phase<4>(p, stream); launch_phase<5>(p, stream);
#ifdef DBL_P5
  launch_phase<5>(p, stream);
#endif
 launch_phase<6>(p, stream); launch_phase<7>(p, stream);
  launch_phase<8>(p, stream); launch_phase<9>(p, stream); launch_phase<10>(p, stream);
#else
  static int grid_blocks = 0;
  if (!grid_blocks) {
    int dev = 0, cus = 0, per_cu = 0;
    hipGetDevice(&dev);
    hipDeviceGetAttribute(&cus, hipDeviceAttributeMultiprocessorCount, dev);
    hipOccupancyMaxActiveBlocksPerMultiprocessor(&per_cu, mega_kernel, 256, 0);
    if (per_cu > 2) per_cu = 2;
    if (per_cu < 1) per_cu = 1;
#ifdef FORCE2
    per_cu = 2;
#endif
    grid_blocks = cus * per_cu;
  }
  hipMemsetAsync((char*)d_ws + OFF_BAR, 0, XCD_BAR_WORDS * 4, stream);
  void* args[] = {&p};
  hipError_t e = hipLaunchCooperativeKernel((void*)mega_kernel, dim3(grid_blocks), dim3(256), args, 0, stream);
  if (e != hipSuccess) fprintf(stderr, "cooperative launch failed: %s (grid %d)\n", hipGetErrorString(e), grid_blocks);
#endif
}
#if defined(__HIP_DEVICE_COMPILE__)
#pragma clang attribute pop
#endif
```
